# Optimizing an MI355X kernel written in HIP

```python
import math
import jax, jax.numpy as jnp
from jax import lax
import numpy as np

D_MODEL = 2048
BATCH = 4
SEQ = 2048
DEPTH = 1
DEC_BATCH = 128
DEC_SEQ = 1
PAST_LEN = 16384
PAGE_SIZE = 128

GLA_HEADS = 4
GLA_DK = (D_MODEL // 2) // GLA_HEADS
GLA_DV = D_MODEL // GLA_HEADS
GLA_RANK = 16
GLA_TAU = 16
GLA_CHUNK = 64
CONV_DIM = D_MODEL
CONV_WIDTH = 3
PEER_HEADS = 8
N_KEYS = 128
N_EXPERTS = N_KEYS * N_KEYS
PEER_TOPK = 16
DQ_HALF = 128
PEER_BLOCK = 128
EPS = 1e-6

W_IN_WIDTHS = (GLA_HEADS * GLA_DK, GLA_HEADS * GLA_DK, GLA_HEADS * GLA_DV, GLA_HEADS * GLA_DV,
               GLA_RANK, CONV_DIM, CONV_DIM, CONV_DIM, D_MODEL, D_MODEL)
D_IN = sum(W_IN_WIDTHS)

kernel_name = "gla_shortconv_peer_hybrid_step"


def rmsnorm(x, g):
    xf = x.astype(jnp.float32)
    xf = xf * lax.rsqrt(jnp.mean(xf * xf, axis=-1, keepdims=True) + EPS)
    return (xf * g.astype(jnp.float32)).astype(x.dtype)


def gla_chunked(q, k, v, loga, s0):
    B, L, H, DK = q.shape
    DV = v.shape[-1]
    C = math.gcd(L, GLA_CHUNK)
    n = L // C

    def to_chunks(t):
        return t.astype(jnp.float32).reshape(B, n, C, H, t.shape[-1]).transpose(1, 0, 3, 2, 4)

    qs, ks, vs, gs = to_chunks(q), to_chunks(k), to_chunks(v), to_chunks(loga)
    causal = jnp.tril(jnp.ones((C, C), dtype=bool))

    def step(S, inp):
        qc, kc, vc, gc = inp
        b = jnp.cumsum(gc, axis=2)
        diff = b[:, :, :, None, :] - b[:, :, None, :, :]
        decay = jnp.exp(jnp.where(causal[None, None, :, :, None], diff, -jnp.inf))
        attn = jnp.einsum('bhid,bhjd,bhijd->bhij', qc, kc, decay)
        o = (jnp.einsum('bhij,bhjv->bhiv', attn, vc)
             + jnp.einsum('bhid,bhdv->bhiv', qc * jnp.exp(b), S))
        bl = b[:, :, -1:, :]
        S_new = (jnp.exp(bl[:, :, 0, :])[..., None] * S
                 + jnp.einsum('bhjd,bhjv->bhdv', kc * jnp.exp(bl - b), vc))
        return S_new, o

    S_fin, o = lax.scan(step, s0.astype(jnp.float32), (qs, ks, vs, gs))
    o = o.transpose(1, 0, 3, 2, 4).reshape(B, L, H, DV)
    return o.astype(q.dtype), S_fin.astype(s0.dtype)


def peer(h, w_query, sub_keys, expert_u, expert_v):
    B, L, D = h.shape
    T = B * L
    ht = h.reshape(T, D)
    q = (ht @ w_query).reshape(T, PEER_HEADS, 2, DQ_HALF)
    s1 = jnp.einsum('thd,nd->thn', q[:, :, 0], sub_keys[0]).astype(jnp.float32)
    s2 = jnp.einsum('thd,nd->thn', q[:, :, 1], sub_keys[1]).astype(jnp.float32)
    v1, i1 = lax.top_k(s1, PEER_TOPK)
    v2, i2 = lax.top_k(s2, PEER_TOPK)
    cand = (v1[..., :, None] + v2[..., None, :]).reshape(T, PEER_HEADS, PEER_TOPK * PEER_TOPK)
    cidx = (i1[..., :, None] * N_KEYS + i2[..., None, :]).reshape(T, PEER_HEADS, PEER_TOPK * PEER_TOPK)
    top, pos = lax.top_k(cand, PEER_TOPK)
    idx = jnp.take_along_axis(cidx, pos, axis=-1)
    g = jax.nn.softmax(top, axis=-1).astype(h.dtype)

    blk = math.gcd(T, PEER_BLOCK)
    nb = T // blk

    def one_block(args):
        xb, ib, gb = args
        u = jnp.take(expert_u, ib, axis=0)
        a = jnp.einsum('thkd,td->thk', u, xb)
        w = gb * jax.nn.gelu(a, approximate=False)
        vg = jnp.take(expert_v, ib, axis=0)
        return jnp.einsum('thk,thkd->td', w, vg)

    out = lax.map(one_block, (ht.reshape(nb, blk, D),
                              idx.reshape(nb, blk, PEER_HEADS, PEER_TOPK),
                              g.reshape(nb, blk, PEER_HEADS, PEER_TOPK)))
    return out.reshape(B, L, D)


def layer(x, s_gla, s_conv, norm1_g, w_in, w_alpha_up, b_alpha, gla_norm_g, conv_w, conv_b,
          w_out, norm2_g, w_query, sub_keys, expert_u, expert_v):
    B, L, _ = x.shape
    h = rmsnorm(x, norm1_g)
    p = h @ w_in
    points = []
    acc = 0
    for w in W_IN_WIDTHS[:-1]:
        acc += w
        points.append(acc)
    q, k, v, r, alr, cb, cc, cx, ga, gb = jnp.split(p, points, axis=-1)

    loga = jax.nn.log_sigmoid((alr @ w_alpha_up + b_alpha).astype(jnp.float32)) / GLA_TAU
    q = q.reshape(B, L, GLA_HEADS, GLA_DK) * (GLA_DK ** -0.5)
    k = k.reshape(B, L, GLA_HEADS, GLA_DK)
    v = v.reshape(B, L, GLA_HEADS, GLA_DV)
    loga = loga.reshape(B, L, GLA_HEADS, GLA_DK)
    o, s_gla_new = gla_chunked(q, k, v, loga, s_gla)
    o = rmsnorm(o, gla_norm_g.reshape(GLA_HEADS, GLA_DV))
    y_a = jax.nn.silu(r) * o.reshape(B, L, GLA_HEADS * GLA_DV)

    u = cc * cx
    buf = jnp.concatenate([s_conv.astype(u.dtype), u], axis=1)
    z = conv_b
    for j in range(CONV_WIDTH):
        z = z + buf[:, j:j + L] * conv_w[j]
    y_b = cb * z
    s_conv_new = buf[:, L:]

    m = jax.nn.sigmoid(ga) * y_a + jax.nn.sigmoid(gb) * y_b
    x = x + m @ w_out

    x = x + peer(rmsnorm(x, norm2_g), w_query, sub_keys, expert_u, expert_v)
    return x, s_gla_new, s_conv_new.astype(s_conv.dtype)


def setup_inputs(seed: int = 0) -> dict:
    key = jax.random.key(seed)
    ks = jax.random.split(key, 20)
    nrm = jax.random.normal
    f32 = jnp.float32
    return {
        "x_prompt": nrm(ks[0], (BATCH, SEQ, D_MODEL), f32),
        "x_sample": nrm(ks[1], (DEC_BATCH, DEC_SEQ, D_MODEL), f32),
        "state_gla": 0.5 * nrm(ks[2], (DEPTH, DEC_BATCH, GLA_HEADS, GLA_DK, GLA_DV), f32),
        "state_conv": nrm(ks[3], (DEPTH, DEC_BATCH, CONV_WIDTH - 1, CONV_DIM), f32),
        "norm1_g": 1.0 + 0.02 * nrm(ks[4], (DEPTH, D_MODEL), f32),
        "w_in": nrm(ks[5], (DEPTH, D_MODEL, D_IN), f32) * D_MODEL ** -0.5,
        "w_alpha_up": nrm(ks[6], (DEPTH, GLA_RANK, GLA_HEADS * GLA_DK), f32) * GLA_RANK ** -0.5,
        "b_alpha": 1.0 + 0.1 * nrm(ks[7], (DEPTH, GLA_HEADS * GLA_DK), f32),
        "gla_norm_g": 1.0 + 0.02 * nrm(ks[8], (DEPTH, GLA_HEADS * GLA_DV), f32),
        "conv_w": nrm(ks[9], (DEPTH, CONV_WIDTH, CONV_DIM), f32) * CONV_WIDTH ** -0.5,
        "conv_b": 0.02 * nrm(ks[10], (DEPTH, CONV_DIM), f32),
        "w_out": nrm(ks[11], (DEPTH, D_MODEL, D_MODEL), f32) * D_MODEL ** -0.5,
        "norm2_g": 1.0 + 0.02 * nrm(ks[12], (DEPTH, D_MODEL), f32),
        "w_query": nrm(ks[13], (DEPTH, D_MODEL, PEER_HEADS * 2 * DQ_HALF), f32) * D_MODEL ** -0.5,
        "sub_keys": nrm(ks[14], (DEPTH, 2, N_KEYS, DQ_HALF), f32) * DQ_HALF ** -0.5,
        "expert_u": nrm(ks[15], (DEPTH, N_EXPERTS, D_MODEL), f32) * D_MODEL ** -0.5,
        "expert_v": 0.1 * nrm(ks[16], (DEPTH, N_EXPERTS, D_MODEL), f32),
        "norm_f_g": 1.0 + 0.02 * nrm(ks[17], (D_MODEL,), f32),
    }


def reference(x_prompt, x_sample, state_gla, state_conv, norm1_g, w_in, w_alpha_up, b_alpha,
              gla_norm_g, conv_w, conv_b, w_out, norm2_g, w_query, sub_keys, expert_u, expert_v,
              norm_f_g):
    xp, xs = x_prompt, x_sample
    zero_gla = jnp.zeros((BATCH, GLA_HEADS, GLA_DK, GLA_DV), state_gla.dtype)
    zero_conv = jnp.zeros((BATCH, CONV_WIDTH - 1, CONV_DIM), state_conv.dtype)
    gla_p, conv_p, gla_s, conv_s = [], [], [], []
    for l in range(DEPTH):
        wts = (norm1_g[l], w_in[l], w_alpha_up[l], b_alpha[l], gla_norm_g[l], conv_w[l], conv_b[l],
               w_out[l], norm2_g[l], w_query[l], sub_keys[l], expert_u[l], expert_v[l])
        xp, sg, sc = layer(xp, zero_gla, zero_conv, *wts)
        gla_p.append(sg)
        conv_p.append(sc)
        xs, sg, sc = layer(xs, state_gla[l], state_conv[l], *wts)
        gla_s.append(sg)
        conv_s.append(sc)
    y_prompt = rmsnorm(xp, norm_f_g)
    y_sample = rmsnorm(xs, norm_f_g)
    return (y_prompt, y_sample, jnp.stack(gla_p), jnp.stack(conv_p), jnp.stack(gla_s), jnp.stack(conv_s))
```

```cpp
#include <hip/hip_runtime.h>
#include <cstdio>
#include <cstdint>
#include <cmath>
#define MK_N_LAUNCHES 1
namespace pg8 {
#define PG8_LAS __attribute__((address_space(3)))
typedef unsigned short bf16_t;
typedef short bf16x8 __attribute__((ext_vector_type(8)));
typedef float f32x4 __attribute__((ext_vector_type(4)));
typedef unsigned u32x4 __attribute__((ext_vector_type(4)));
constexpr int BM = 256, BK = 64, HALF = 128, HTB = HALF * BK * 2  , STAGE_BYTES = 8 * HTB, NXCD = 8, WGM = 8;

__host__ __device__ __forceinline__ int lds_byte(int r, int c) { const int st = (r >> 4) * 2 + (c >> 5), rr = r & 15, cc = c & 31, ob = rr * 64 + cc * 2; return st * 1024 + (ob ^ (((ob >> 9) & 1) << 5)); }
__host__ __device__ __forceinline__ void stage_rc(int b, int& R, int& C) { const int st = b / 1024, sb = b % 1024, swz = sb ^ (((sb >> 9) & 1) << 5); R = (st >> 1) * 16 + swz / 64; C = (st & 1) * 32 + (swz % 64) / 2; }
__host__ __device__ __forceinline__ int perm32(int rho) { const int n = rho >> 4, i = rho & 15; return 8 * (i >> 2) + 4 * n + (i & 3); }

struct Unit { int pm, pn; };
struct Gemm { const bf16_t* A; const bf16_t* Bt; int M, N, K; };

struct StaticOrder {
    int nM, nN, nwg, G, c;
    __host__ __device__ void init(int M, int N, int G_, int c_) { nM = M / BM; nN = N / BM; nwg = nM * nN; G = G_; c = c_; }
    __host__ __device__ bool next(int i, Unit& u) const {
        const long L = (long)i * G + c; if (L >= nwg) return false;
        int wgid = (int)L; { const int q = nwg / NXCD, r = nwg % NXCD, xcd = wgid % NXCD, off = wgid / NXCD; wgid = (xcd < r ? xcd * (q + 1) : r * (q + 1) + (xcd - r) * q) + off; }
        const int nig = WGM * nN, gid = wgid / nig, fm = gid * WGM, gsz = (nM - fm) < WGM ? (nM - fm) : WGM;
        u.pm = fm + ((wgid % nig) % gsz); u.pn = (wgid % nig) / gsz; return true;
    }
    __device__ __forceinline__ void a_ready(const Unit&) const {}
    __device__ __forceinline__ void done(const Unit&) const {}
};

__device__ __forceinline__ unsigned cvt_pk_bf16(float lo, float hi) { unsigned r; asm volatile("v_cvt_pk_bf16_f32 %0, %1, %2" : "=v"(r) : "v"(lo), "v"(hi)); return r; }
typedef float f32x2 __attribute__((ext_vector_type(2)));
__device__ __forceinline__ f32x2 gelu_pk(f32x2 v) {
    const f32x2 av = __builtin_elementwise_abs(v), d = av * 0.2316418882f + 1.0f;
    f32x2 t; t.x = __builtin_amdgcn_rcpf(d.x); t.y = __builtin_amdgcn_rcpf(d.y);
    f32x2 q = t * 0.5307027145f + (-0.7265760135f); q = q * t + 0.7107068705f; q = q * t + (-0.142248368f); q = q * t + 0.127414796f; q = q * t;
    const f32x2 s = (v * v) * (-0.72134752044f);
    f32x2 e; e.x = __builtin_amdgcn_exp2f(s.x); e.y = __builtin_amdgcn_exp2f(s.y);
    const f32x2 m = v * (q * e), r = v - m;
    f32x2 o; o.x = v.x < 0.f ? m.x : r.x; o.y = v.y < 0.f ? m.y : r.y; return o;
}

template <int ACT  > struct EpiBf16 {
    static constexpr bool PERM = true, AFTER_DRAIN = false; static_assert(ACT == 0 || ACT == 1, "EpiBf16: ACT is 0 (none) or 1 (gelu_pk)");
    bf16_t* O; int ldc; const float* bias; int split_cols; size_t split_stride; float scale0;
    __device__ __forceinline__ void operator()(const f32x4 (&acc)[2][2][4][2], const Unit& u, int wr, int wc, int fr, int fq) const {
        const int row0 = u.pm * BM + wr * 64 + fr; int colt = u.pn * BM; bf16_t* base = O;
        float sc = 1.f; if (split_cols) { const int t = colt / split_cols; base += (size_t)t * split_stride; colt -= t * split_cols; if (t == 0) sc = scale0; }
        const int col0 = colt + wc * 32 + 8 * fq, bcol0 = u.pn * BM + wc * 32 + 8 * fq;
        f32x4 bv[2][2];
#pragma unroll
        for (int bj = 0; bj < 2; ++bj)
#pragma unroll
            for (int n = 0; n < 2; ++n) bv[bj][n] = bias ? *(const f32x4*)(bias + bcol0 + bj * HALF + 4 * n) : (f32x4){0.f, 0.f, 0.f, 0.f};
#pragma unroll
        for (int ai = 0; ai < 2; ++ai)
#pragma unroll
            for (int m = 0; m < 4; ++m) { bf16_t* rowp = base + (size_t)(row0 + ai * HALF + m * 16) * ldc + col0;
#pragma unroll
                for (int bj = 0; bj < 2; ++bj) { f32x4 v0 = acc[ai][bj][m][0] + bv[bj][0], v1 = acc[ai][bj][m][1] + bv[bj][1];
                    if (ACT == 1) { f32x2 a = gelu_pk((f32x2){v0[0], v0[1]}), b = gelu_pk((f32x2){v0[2], v0[3]}), c = gelu_pk((f32x2){v1[0], v1[1]}), d = gelu_pk((f32x2){v1[2], v1[3]});
                        v0 = (f32x4){a.x, a.y, b.x, b.y}; v1 = (f32x4){c.x, c.y, d.x, d.y}; }
                    v0 = v0 * sc; v1 = v1 * sc; u32x4 w; w.x = cvt_pk_bf16(v0[0], v0[1]); w.y = cvt_pk_bf16(v0[2], v0[3]); w.z = cvt_pk_bf16(v1[0], v1[1]); w.w = cvt_pk_bf16(v1[2], v1[3]);
                    *(u32x4*)(rowp + bj * HALF) = w; } }
    }
};
template <class Epi, class Sched, bool ALIGN_EPI = false, bool SP2 = false>
__device__ __forceinline__ void gemm_phase(PG8_LAS unsigned char* lds, const Gemm g, const Sched& S, const Epi& E) {
    const int tid = threadIdx.x, wid = __builtin_amdgcn_readfirstlane(tid >> 6), lane = tid & 63, wr = wid >> 2, wc = wid & 3, fr = lane & 15, fq = lane >> 4;
    const int K = g.K, nt = K / BK;
    unsigned voffA[2], voffB[2];
#pragma unroll
    for (int i = 0; i < 2; ++i) { int R, C; stage_rc(tid * 16 + i * 8192, R, C); const int Rb = Epi::PERM ? ((R & ~31) + perm32(R & 31)) : R;
        voffA[i] = (unsigned)(R * K + C) * 2u; voffB[i] = (unsigned)(Rb * K + C) * 2u; }
    const size_t kstep = (size_t)(BK * 2);
    const size_t hstep = (size_t)HALF * K * 2;
    const size_t tstep = 2 * hstep;
    const unsigned ldsw = (unsigned)wid * 1024u;
    const int aoff = lds_byte(wr * 64 + fr, fq * 8), boff = lds_byte(wc * 32 + fr, fq * 8);
#define PG8_SA(b, h) (((b) * 2 + (h)) * HTB)
#define PG8_SB(b, h) ((4 + (b) * 2 + (h)) * HTB)
#define PG8_STAGE(bufoff, gbase, voff) do { _Pragma("unroll") for (int _i = 0; _i < 2; ++_i) \
        __builtin_amdgcn_global_load_lds((const unsigned*)((const char*)(gbase) + (voff)[_i]), (PG8_LAS unsigned*)(lds + (bufoff) + ldsw + _i * 8192), 16, 0, 0); } while (0)
#define PG8_LDA(dst, b, h) do { _Pragma("unroll") for (int m = 0; m < 4; ++m) _Pragma("unroll") for (int k = 0; k < 2; ++k) dst[m][k] = *(const PG8_LAS bf16x8*)(lds + PG8_SA(b, h) + aoff + m * 2048 + k * 1024); } while (0)
#define PG8_LDB(dst, b, h) do { _Pragma("unroll") for (int n = 0; n < 2; ++n) _Pragma("unroll") for (int k = 0; k < 2; ++k) dst[n][k] = *(const PG8_LAS bf16x8*)(lds + PG8_SB(b, h) + boff + n * 2048 + k * 1024); } while (0)
#define PG8_MMA(ai, bj, At, Bt) do { __builtin_amdgcn_s_setprio(1); _Pragma("unroll") for (int m = 0; m < 4; ++m) _Pragma("unroll") for (int n = 0; n < 2; ++n) _Pragma("unroll") for (int k = 0; k < 2; ++k) \
        acc[ai][bj][m][n] = __builtin_amdgcn_mfma_f32_16x16x32_bf16(Bt[n][k], At[m][k], acc[ai][bj][m][n], 0, 0, 0); __builtin_amdgcn_s_setprio(0); } while (0)
#define PG8_WAIT_V(n) asm volatile("s_waitcnt vmcnt(" #n ")" ::: "memory")
#define PG8_WAIT_L(n) asm volatile("s_waitcnt lgkmcnt(" #n ")" ::: "memory")
#define PG8_BAR __builtin_amdgcn_s_barrier()
#define PG8_SCHED __builtin_amdgcn_sched_barrier(0)
    Unit cur, nxt; int ui = 0;
    if (!S.next(0, cur)) return;
    f32x4 acc[2][2][4][2];
#pragma unroll
    for (int a = 0; a < 2; ++a)
#pragma unroll
        for (int b = 0; b < 2; ++b)
#pragma unroll
            for (int m = 0; m < 4; ++m)
#pragma unroll
                for (int n = 0; n < 2; ++n) acc[a][b][m][n] = (f32x4){0.f, 0.f, 0.f, 0.f};
    bf16x8 At[4][2], B0[2][2], B1[2][2];
    const char* cA = (const char*)g.A + (size_t)cur.pm * tstep; const char* cB = (const char*)g.Bt + (size_t)cur.pn * tstep;
    S.a_ready(cur);
    if constexpr (SP2) {
        PG8_STAGE(PG8_SB(0, 0), cB, voffB); PG8_STAGE(PG8_SB(0, 1), cB + hstep, voffB); PG8_STAGE(PG8_SA(0, 0), cA, voffA); PG8_STAGE(PG8_SA(0, 1), cA + hstep, voffA);
        if (wr == 1) PG8_BAR;
        PG8_WAIT_V(2); PG8_BAR;
        PG8_STAGE(PG8_SB(1, 0), cB + kstep, voffB); PG8_STAGE(PG8_SA(1, 0), cA + kstep, voffA); PG8_STAGE(PG8_SB(1, 1), cB + hstep + kstep, voffB);
        PG8_WAIT_V(6); PG8_BAR;
    } else {
        PG8_STAGE(PG8_SB(0, 0), cB, voffB); PG8_STAGE(PG8_SA(0, 0), cA, voffA); PG8_STAGE(PG8_SB(0, 1), cB + hstep, voffB); PG8_STAGE(PG8_SA(0, 1), cA + hstep, voffA);
        if (wr == 1) PG8_BAR;
        PG8_WAIT_V(4); PG8_BAR;
        PG8_STAGE(PG8_SB(1, 0), cB + kstep, voffB); PG8_STAGE(PG8_SA(1, 0), cA + kstep, voffA); PG8_STAGE(PG8_SB(1, 1), cB + hstep + kstep, voffB);
        PG8_WAIT_V(6); PG8_BAR;
    }
    for (;;) {
        const bool has_next = S.next(ui + 1, nxt);
        const char* nA = has_next ? (const char*)g.A + (size_t)nxt.pm * tstep : cA; const char* nB = has_next ? (const char*)g.Bt + (size_t)nxt.pn * tstep : cB;
        for (int t = 0; t < nt; t += 2) {
            const bool last = (t == nt - 2);
            const char* a1 = cA + (size_t)(t + 1) * kstep;
            const char* a2 = last ? nA : cA + (size_t)(t + 2) * kstep; const char* b2 = last ? nB : cB + (size_t)(t + 2) * kstep;
            const char* a3 = a2 + kstep; const char* b3 = b2 + kstep;
            if (last && has_next) S.a_ready(nxt);
            if constexpr (SP2) {
            PG8_LDB(B0, 0, 0); PG8_LDB(B1, 0, 1); PG8_SCHED; PG8_LDA(At, 0, 0); PG8_STAGE(PG8_SA(1, 1), a1 + hstep, voffA);
            PG8_WAIT_V(8); PG8_WAIT_L(0); PG8_BAR; PG8_MMA(0, 0, At, B0); PG8_MMA(0, 1, At, B1); PG8_BAR; PG8_SCHED;
            PG8_LDA(At, 0, 1); PG8_STAGE(PG8_SB(0, 0), b2, voffB); PG8_STAGE(PG8_SB(0, 1), b2 + hstep, voffB); PG8_STAGE(PG8_SA(0, 0), a2, voffA);
            PG8_WAIT_V(8); PG8_WAIT_L(0); PG8_BAR; PG8_MMA(1, 0, At, B0); PG8_MMA(1, 1, At, B1); PG8_BAR; PG8_SCHED;
            PG8_LDB(B0, 1, 0); PG8_LDB(B1, 1, 1); PG8_SCHED; PG8_LDA(At, 1, 0); PG8_STAGE(PG8_SA(0, 1), a2 + hstep, voffA);
            PG8_WAIT_V(8); PG8_WAIT_L(0); PG8_BAR; PG8_MMA(0, 0, At, B0); PG8_MMA(0, 1, At, B1); PG8_BAR; PG8_SCHED;
            PG8_LDA(At, 1, 1); PG8_STAGE(PG8_SB(1, 0), b3, voffB); PG8_STAGE(PG8_SB(1, 1), b3 + hstep, voffB); PG8_STAGE(PG8_SA(1, 0), a3, voffA);
            PG8_WAIT_V(8); PG8_WAIT_L(0); PG8_BAR; PG8_MMA(1, 0, At, B0); PG8_MMA(1, 1, At, B1); PG8_BAR; PG8_SCHED;
            } else {
            PG8_LDB(B0, 0, 0); PG8_SCHED; PG8_LDA(At, 0, 0); PG8_STAGE(PG8_SA(1, 1), a1 + hstep, voffA);
            PG8_WAIT_L(8); PG8_BAR; PG8_WAIT_L(0); PG8_MMA(0, 0, At, B0); PG8_BAR; PG8_SCHED;
            PG8_LDB(B1, 0, 1); PG8_STAGE(PG8_SB(0, 0), b2, voffB);
            PG8_BAR; PG8_WAIT_L(0); PG8_MMA(0, 1, At, B1); PG8_BAR;
            PG8_LDA(At, 0, 1); PG8_STAGE(PG8_SA(0, 0), a2, voffA);
            PG8_BAR; PG8_WAIT_L(0); PG8_MMA(1, 0, At, B0); PG8_BAR; PG8_SCHED;
            PG8_STAGE(PG8_SB(0, 1), b2 + hstep, voffB);
            PG8_WAIT_V(6); PG8_BAR; PG8_MMA(1, 1, At, B1); PG8_BAR;
            PG8_LDB(B0, 1, 0); PG8_SCHED; PG8_LDA(At, 1, 0); PG8_STAGE(PG8_SA(0, 1), a2 + hstep, voffA);
            PG8_WAIT_L(8); PG8_BAR; PG8_WAIT_L(0); PG8_MMA(0, 0, At, B0); PG8_BAR; PG8_SCHED;
            PG8_LDB(B1, 1, 1); PG8_STAGE(PG8_SB(1, 0), b3, voffB);
            PG8_BAR; PG8_WAIT_L(0); PG8_MMA(0, 1, At, B1); PG8_BAR;
            PG8_LDA(At, 1, 1); PG8_STAGE(PG8_SA(1, 0), a3, voffA);
            PG8_BAR; PG8_WAIT_L(0); PG8_MMA(1, 0, At, B0); PG8_BAR; PG8_SCHED;
            PG8_STAGE(PG8_SB(1, 1), b3 + hstep, voffB);
            PG8_WAIT_V(6); PG8_BAR; PG8_MMA(1, 1, At, B1); PG8_BAR;
            }
        }
        if constexpr (ALIGN_EPI) { if (wr == 0) PG8_BAR; }
        if constexpr (!Epi::AFTER_DRAIN) { E(acc, cur, wr, wc, fr, fq); S.done(cur); }
        if (!has_next) break;
#pragma unroll
        for (int a = 0; a < 2; ++a)
#pragma unroll
            for (int b = 0; b < 2; ++b)
#pragma unroll
                for (int m = 0; m < 4; ++m)
#pragma unroll
                    for (int n = 0; n < 2; ++n) acc[a][b][m][n] = (f32x4){0.f, 0.f, 0.f, 0.f};
        cur = nxt; cA = nA; cB = nB; ++ui;
        if constexpr (ALIGN_EPI) { if (wr == 1) PG8_BAR; }
    }
    PG8_WAIT_V(0);
    if constexpr (!ALIGN_EPI) { if (wr == 0) PG8_BAR; }
    PG8_BAR;
    if constexpr (Epi::AFTER_DRAIN) { E.fused(acc, cur, wr, wc, fr, fq, lds, wid, lane); S.done(cur); }
#undef PG8_SA
#undef PG8_SB
#undef PG8_STAGE
#undef PG8_LDA
#undef PG8_LDB
#undef PG8_MMA
#undef PG8_WAIT_V
#undef PG8_WAIT_L
#undef PG8_BAR
#undef PG8_SCHED
}
}
namespace pg8 {
__device__ __forceinline__ unsigned f2bf_(float f) { unsigned u = __builtin_bit_cast(unsigned, f); return (u + 0x7fffu + ((u >> 16) & 1u)) >> 16; }
struct EpiF32Res {
    static constexpr bool PERM = false, AFTER_DRAIN = false;
    const float* xp; float* out; bf16_t* outb; float* ssq; int ldc;
    __device__ __forceinline__ void operator()(const f32x4 (&acc)[2][2][4][2], const Unit& u, int wr, int wc, int fr, int fq) const {
        const int col0 = u.pn * BM + wc * 32 + 4 * fq;
#pragma unroll
        for (int ai = 0; ai < 2; ++ai)
#pragma unroll
            for (int m = 0; m < 4; ++m) {
                const int row = u.pm * BM + ai * HALF + wr * 64 + m * 16 + fr;
                const float* src = xp + (size_t)row * ldc; float* dst = out + (size_t)row * ldc; bf16_t* dstb = outb + (size_t)row * ldc;
                float s = 0.f;
#pragma unroll
                for (int bj = 0; bj < 2; ++bj)
#pragma unroll
                    for (int n = 0; n < 2; ++n) { const int c = col0 + bj * HALF + n * 16; const f32x4 v = *(const f32x4*)(src + c) + acc[ai][bj][m][n]; *(f32x4*)(dst + c) = v;
                        s += (v[0] * v[0] + v[1] * v[1]) + (v[2] * v[2] + v[3] * v[3]);
                        unsigned w0 = f2bf_(v[0]) | (f2bf_(v[1]) << 16), w1 = f2bf_(v[2]) | (f2bf_(v[3]) << 16);
                        typedef unsigned u32x2 __attribute__((ext_vector_type(2))); *(u32x2*)(dstb + c) = (u32x2){w0, w1}; }
                s += __shfl_xor(s, 16); s += __shfl_xor(s, 32);
                if (fq == 0) ssq[(size_t)row * 32 + u.pn * 4 + wc] = s;
            }
    }
};
struct EpiBf16RowScale {
    static constexpr bool PERM = true, AFTER_DRAIN = false;
    bf16_t* O; int ldc; const float* rs;
    __device__ __forceinline__ void operator()(const f32x4 (&acc)[2][2][4][2], const Unit& u, int wr, int wc, int fr, int fq) const {
        const int row0 = u.pm * BM + wr * 64 + fr, col0 = u.pn * BM + wc * 32 + 8 * fq;
#pragma unroll
        for (int ai = 0; ai < 2; ++ai)
#pragma unroll
            for (int m = 0; m < 4; ++m) { const int rl = wr * 64 + fr + ai * HALF + m * 16; const float sc = rs[rl]; bf16_t* rowp = O + (size_t)(row0 + ai * HALF + m * 16) * ldc + col0;
#pragma unroll
                for (int bj = 0; bj < 2; ++bj) { const f32x4 v0 = acc[ai][bj][m][0] * sc, v1 = acc[ai][bj][m][1] * sc;
                    u32x4 w; w.x = cvt_pk_bf16(v0[0], v0[1]); w.y = cvt_pk_bf16(v0[2], v0[3]); w.z = cvt_pk_bf16(v1[0], v1[1]); w.w = cvt_pk_bf16(v1[2], v1[3]);
                    *(u32x4*)(rowp + bj * HALF) = w; } }
    }
};
}

#ifndef MK_N_LAUNCHES
#define MK_N_LAUNCHES 1
#endif
constexpr int N_PHASES = 9;
constexpr int N_LAUNCHES = MK_N_LAUNCHES;
constexpr int NWAVES = 8;

constexpr int DM = 2048;
constexpr int TP = 8192, TS = 128, TT = TP + TS;
constexpr int MP = 8448;
constexpr int NP = 16384;
constexpr int PLD = NP + 64;
constexpr int C_Q = 0, C_K = 1024, C_V = 2048, C_R = 4096, C_CB = 6144, C_CC = 8192, C_CX = 10240, C_GA = 12288, C_GB = 14336;
constexpr int DIN = 16400;
constexpr int NEXP = 16384;
constexpr float EPS = 1e-6f;

constexpr size_t MiB = 1u << 20;
constexpr size_t WS_CTL = 0, CTL_ZERO_BYTES = 1 * MiB;
constexpr size_t WS_WINT = 2 * MiB;
constexpr size_t WS_WOUTT = 68 * MiB;
constexpr size_t WS_WQT = 76 * MiB;
constexpr size_t WS_EU = 84 * MiB;
constexpr size_t WS_EV = 148 * MiB;
constexpr size_t WS_XN = 212 * MiB;
constexpr size_t WS_P = 246 * MiB;
constexpr size_t WS_QT = 516 * MiB;
constexpr size_t WS_KT = 532 * MiB;
constexpr size_t WS_VT = 548 * MiB;
constexpr size_t WS_ATT = 580 * MiB;
constexpr size_t WS_EBL = 584 * MiB;
constexpr size_t WS_SKB = 585 * MiB;
constexpr size_t WS_O = 586 * MiB;
constexpr size_t WS_MM = 620 * MiB;
constexpr size_t WS_X2 = 654 * MiB;
constexpr size_t WS_H2 = 720 * MiB;
constexpr size_t WS_SSQ = 799 * MiB;
constexpr size_t WS_QP = 754 * MiB;
constexpr size_t WS_IDX = 788 * MiB;
constexpr size_t WS_GW = 793 * MiB;
constexpr size_t WS_ALR = 798 * MiB;
constexpr size_t WS_SSQS = 799 * MiB + 1100 * 1024;
constexpr size_t WS_RS2 = 799 * MiB + 1200 * 1024;
constexpr size_t WS_END = 801 * MiB;
constexpr int CW_TMO = 0, CW_CODE = 1, CW_BAR = 4096;

constexpr size_t OUT_Y = 0;
constexpr size_t OUT_GLAP = (size_t)TT * DM;
constexpr size_t OUT_CONVP = OUT_GLAP + (size_t)4 * 4 * 256 * 512;
constexpr size_t OUT_GLAS = OUT_CONVP + (size_t)4 * 2 * 2048;
constexpr size_t OUT_CONVS = OUT_GLAS + (size_t)128 * 4 * 256 * 512;

constexpr int LDS_BYTES = 163840;
constexpr int LDSCTL_OFF = 162816, MISC_OFF = LDSCTL_OFF + 320;
constexpr int RING_OFF = 0;

#define GAS __attribute__((address_space(1)))
#define LAS __attribute__((address_space(3)))
typedef unsigned short bf16;
typedef unsigned v4u __attribute__((ext_vector_type(4)));
typedef unsigned v2u __attribute__((ext_vector_type(2)));
typedef float f32x4 __attribute__((ext_vector_type(4)));
typedef short bf16x8 __attribute__((ext_vector_type(8)));
typedef GAS unsigned gu32;
typedef float v32f __attribute__((ext_vector_type(32)));
typedef float v16f __attribute__((ext_vector_type(16)));
typedef unsigned v6u __attribute__((ext_vector_type(6)));
constexpr int ROW6 = 1536;
#define RLX_AGENT __ATOMIC_RELAXED, __HIP_MEMORY_SCOPE_AGENT
#define LDS_WAIT() asm volatile("s_waitcnt lgkmcnt(0)" ::: "memory")
#define VM_WAIT() asm volatile("s_waitcnt vmcnt(0)" ::: "memory")
#define MFMA16(a, b, c) __builtin_amdgcn_mfma_f32_16x16x32_bf16((a), (b), (c), 0, 0, 0)
__device__ __forceinline__ unsigned f2bf(float f) { unsigned u = __builtin_bit_cast(unsigned, f); return (u + 0x7fffu + ((u >> 16) & 1u)) >> 16; }
__device__ __forceinline__ unsigned pk2(float lo, float hi) { return f2bf(lo) | (f2bf(hi) << 16); }
__device__ __forceinline__ float bf2f(unsigned b) { return __builtin_bit_cast(float, b << 16); }
__device__ __forceinline__ float bflo(unsigned w) { return __builtin_bit_cast(float, w << 16); }
__device__ __forceinline__ float bfhi(unsigned w) { return __builtin_bit_cast(float, w & 0xffff0000u); }
__device__ __forceinline__ void unpack8(const v4u w, float (&f)[8]) { f[0] = bflo(w.x); f[1] = bfhi(w.x); f[2] = bflo(w.y); f[3] = bfhi(w.y); f[4] = bflo(w.z); f[5] = bfhi(w.z); f[6] = bflo(w.w); f[7] = bfhi(w.w); }
__device__ __forceinline__ v4u pack8(const float (&f)[8]) { v4u w; w.x = pk2(f[0], f[1]); w.y = pk2(f[2], f[3]); w.z = pk2(f[4], f[5]); w.w = pk2(f[6], f[7]); return w; }
__device__ __forceinline__ float wave_sum(float v) {
#pragma unroll
    for (int o = 1; o < 64; o <<= 1) v += __shfl_xor(v, o);
    return v;
}
__device__ __forceinline__ float sigmoidf_(float x) { return 1.0f / (1.0f + __expf(-x)); }
#define XB_TMO      128
#define XB_XCNT(j)  (256  + 64 * (j))
#define XB_XSUB(j)  (1280 + 64 * (j))
#define XB_XGEN(j)  (2304 + 64 * (j))
#define XB_TOP      3328
#define XB_TOPGEN   3392
#define XCD_BAR_WORDS 3456
#define XB_SPIN_CAP (1u << 18)

__device__ __forceinline__ unsigned xb_ld(unsigned* p)              { return __hip_atomic_load(p, __ATOMIC_RELAXED, __HIP_MEMORY_SCOPE_AGENT); }
__device__ __forceinline__ unsigned xb_add(unsigned* p, unsigned v) { return __hip_atomic_fetch_add(p, v, __ATOMIC_RELAXED, __HIP_MEMORY_SCOPE_AGENT); }
__device__ __forceinline__ unsigned xb_xcc_id() { return (unsigned)__builtin_amdgcn_s_getreg((3 << 11) | 20) & 0xFu; }
#define XB_SPIN(cond, bar) do { unsigned _sp = 0; while (cond) { __builtin_amdgcn_s_sleep(1); \
    if ((++_sp & 255u) == 0u) { if (xb_ld(&(bar)[XB_TMO])) break; if (_sp > XB_SPIN_CAP) { atomicAdd(&(bar)[XB_TMO], 1u); break; } } } } while (0)

struct XcdBarrier {
    unsigned* bar; unsigned x;
    volatile LAS unsigned* st;
};

__device__ __forceinline__ XcdBarrier xcd_barrier_post(unsigned* bar, volatile LAS unsigned* st) {
    XcdBarrier b; b.bar = bar; b.x = xb_xcc_id(); b.st = st;
    if (threadIdx.x == 0) (void)xb_add(&bar[XB_XCNT(b.x)], 1u);
    return b;
}
__device__ __forceinline__ void xcd_barrier_complete(unsigned* bar, unsigned x, unsigned& nloc, unsigned& nx) {
    const unsigned G = gridDim.x * gridDim.y * gridDim.z;
    unsigned sum, cnt, mine, sp = 0u;
    for (;;) {
        sum = 0u; cnt = 0u; mine = 0u;
#pragma unroll
        for (unsigned j = 0; j < 16; ++j) { const unsigned c = xb_ld(&bar[XB_XCNT(j)]); sum += c; cnt += (c > 0u) ? 1u : 0u; mine = (j == x) ? c : mine; }
        if (sum == G) break;
        __builtin_amdgcn_s_sleep(1);
        if ((++sp & 255u) == 0u) { if (xb_ld(&bar[XB_TMO])) break; if (sp > XB_SPIN_CAP) { atomicAdd(&bar[XB_TMO], 1u); break; } }
    }
    nloc = mine > 0u ? mine : 1u; nx = cnt > 0u ? cnt : 1u;
}

__device__ __forceinline__ void xcd_barrier(const XcdBarrier& b) {
    asm volatile("s_waitcnt vmcnt(0)" ::: "memory");
    __syncthreads();
    if (threadIdx.x == 0) {
        unsigned* bar = b.bar;
        __builtin_amdgcn_s_waitcnt(0);
        unsigned nloc = b.st[0], nx = b.st[1];
        if (nloc == 0u) { xcd_barrier_complete(bar, b.x, nloc, nx); b.st[0] = nloc; b.st[1] = nx; }
        const unsigned old = xb_add(&bar[XB_XSUB(b.x)], 1u);
        const unsigned gen = old / nloc;
        if (old + 1u == (gen + 1u) * nloc) {
            __builtin_amdgcn_fence(__ATOMIC_RELEASE, "agent");
            asm volatile("s_waitcnt vmcnt(0)" ::: "memory");
            const unsigned og = xb_add(&bar[XB_TOP], 1u);
            const unsigned tg = og / nx;
            if (og + 1u == (tg + 1u) * nx) xb_add(&bar[XB_TOPGEN], 1u);
            else XB_SPIN(xb_ld(&bar[XB_TOPGEN]) == tg, bar);
            __builtin_amdgcn_fence(__ATOMIC_ACQUIRE, "agent");
            xb_add(&bar[XB_XGEN(b.x)], 1u);
            asm volatile("s_waitcnt vmcnt(0)" ::: "memory");
        } else {
            XB_SPIN(xb_ld(&bar[XB_XGEN(b.x)]) == gen, bar);
            __builtin_amdgcn_fence(__ATOMIC_ACQUIRE, "agent");
            asm volatile("s_waitcnt vmcnt(0)" ::: "memory");
        }
    }
    __syncthreads();
}
struct Frame {
    unsigned char* lds;
    int tid, lane, wave, vcu, G;
    const float *xp, *xs, *sgla, *sconv, *n1g, *win, *wau, *bal, *gng, *cw, *cb, *wout, *n2g, *wq, *sk, *eu, *ev, *nfg;
    float* out;
    unsigned char* ws;
};

__device__ __forceinline__ void p0_transpose_item(const float* W, int ldw, int src_col0, int k0, bf16* WT, int K, int dst_row0, float* scr, int lane, const float* kscale = nullptr) {
#pragma unroll 8
    for (int i = 0; i < 32; ++i) { const int kk = 2 * i + (lane >> 5); scr[kk * 33 + (lane & 31)] = W[(size_t)(k0 + kk) * ldw + src_col0 + (lane & 31)] * (kscale ? kscale[k0 + kk] : 1.0f); }
    LDS_WAIT(); asm volatile("" ::: "memory");
    const int c = lane & 7;
#pragma unroll
    for (int j = 0; j < 4; ++j) { const int n = (lane >> 3) + 8 * j; const float* s = scr + (8 * c) * 33 + n;
        v4u o; o.x = pk2(s[0 * 33], s[1 * 33]); o.y = pk2(s[2 * 33], s[3 * 33]); o.z = pk2(s[4 * 33], s[5 * 33]); o.w = pk2(s[6 * 33], s[7 * 33]);
        *(v4u*)(WT + (size_t)(dst_row0 + n) * K + k0 + 8 * c) = o; }
    LDS_WAIT(); asm volatile("" ::: "memory");
}
__device__ __forceinline__ void rms_row_to_bf16(const float* xrow, const float* g, bf16* orow, int lane) {
    const f32x4* xr = (const f32x4*)xrow + lane; const f32x4* gr = (const f32x4*)g + lane;
    f32x4 v[8]; float s = 0.f;
#pragma unroll
    for (int j = 0; j < 8; ++j) { v[j] = xr[64 * j]; s += (v[j].x * v[j].x + v[j].y * v[j].y) + (v[j].z * v[j].z + v[j].w * v[j].w); }
    const float rstd = 1.0f / sqrtf(wave_sum(s) * (1.0f / DM) + EPS);
    v2u* o8 = (v2u*)orow + lane;
#pragma unroll
    for (int j = 0; j < 8; ++j) { const f32x4 gg = gr[64 * j]; v2u w; w.x = pk2(v[j].x * rstd * gg.x, v[j].y * rstd * gg.y); w.y = pk2(v[j].z * rstd * gg.z, v[j].w * rstd * gg.w); o8[64 * j] = w; }
}
__device__ __forceinline__ void zero_row_bf16(bf16* orow, int lane) {
    v2u* o8 = (v2u*)orow + lane; const v2u z = {0u, 0u};
#pragma unroll
    for (int j = 0; j < 8; ++j) o8[64 * j] = z;
}
__device__ __forceinline__ void p0_prologue(Frame& F) {
    bf16* WINT = (bf16*)(F.ws + WS_WINT); bf16* WOUTT = (bf16*)(F.ws + WS_WOUTT); bf16* WQT = (bf16*)(F.ws + WS_WQT);
    float* scr = (float*)(F.lds + F.wave * 8448);
    const int gw = F.vcu * NWAVES + F.wave, NGW = F.G * NWAVES;
    constexpr int I_IN = 32 * 512, I_SQ = 32 * 64;
    for (int it = gw; it < I_IN + 2 * I_SQ; it += NGW) {
        int r = it;
        if (r < I_IN) { const int kb = r >> 9, nb = r & 511, n0 = 32 * nb; p0_transpose_item(F.win, DIN, n0 + (n0 >= 6144 ? 16 : 0), 64 * kb, WINT, DM, n0, scr, F.lane); continue; }
        r -= I_IN;
        if (r < I_SQ) { const int kb = r >> 6, nb = r & 63; p0_transpose_item(F.wout, DM, 32 * nb, 64 * kb, WOUTT, DM, 32 * nb, scr, F.lane); continue; }
        r -= I_SQ;
        { const int kb = r >> 6, nb = r & 63; p0_transpose_item(F.wq, DM, 32 * nb, 64 * kb, WQT, DM, 32 * nb, scr, F.lane, F.n2g); }
    }
    const size_t gt = (size_t)F.vcu * 512 + F.tid, NGT = (size_t)F.G * 512;
    { bf16* SKB = (bf16*)(F.ws + WS_SKB); for (size_t e = gt; e < (size_t)2 * 128 * 128; e += NGT) SKB[e] = (bf16)f2bf(F.sk[e]); }
    { unsigned char* U6 = F.ws + WS_EU; unsigned char* V6 = F.ws + WS_EV; float* SU = (float*)(F.ws + WS_EU + 32 * MiB); float* SV = (float*)(F.ws + WS_EV + 32 * MiB);
      for (int r = gw; r < 2 * NEXP; r += NGW) {
          const bool isv = r >= NEXP; const int row = isv ? r - NEXP : r;
          const float* src = (isv ? F.ev : F.eu) + (size_t)row * DM;
          f32x4 x[8]; float amax = 0.f;
#pragma unroll
          for (int j = 0; j < 8; ++j) { x[j] = *(const f32x4*)(src + 256 * j + 4 * F.lane); if (!isv) x[j] = x[j] * *(const f32x4*)(F.n2g + 256 * j + 4 * F.lane);
              amax = fmaxf(amax, fmaxf(fmaxf(fabsf(x[j].x), fabsf(x[j].y)), fmaxf(fabsf(x[j].z), fabsf(x[j].w)))); }
#pragma unroll
          for (int o = 1; o < 64; o <<= 1) amax = fmaxf(amax, __shfl_xor(amax, o));
          const float sc = amax > 0.f ? 7.5f / amax : 1.0f;
          v16f pa, pb;
#pragma unroll
          for (int j = 0; j < 8; ++j) { pa[2 * j] = x[j].x * sc; pb[2 * j] = x[j].y * sc; pa[2 * j + 1] = x[j].z * sc; pb[2 * j + 1] = x[j].w * sc; }
          const v6u p = __builtin_amdgcn_cvt_scalef32_2xpk16_fp6_f32(pa, pb, 1.0f);
          unsigned char* dst = (isv ? V6 : U6) + (size_t)row * ROW6 + 8 * F.lane;
          *(v2u*)(dst) = (v2u){p[0], p[1]}; *(v2u*)(dst + 512) = (v2u){p[2], p[3]}; *(v2u*)(dst + 1024) = (v2u){p[4], p[5]};
          if (F.lane == 0) (isv ? SV : SU)[row] = amax > 0.f ? amax / 7.5f : 1.0f;
      } }
    __syncthreads();
    { bf16* wt_s = (bf16*)F.lds; constexpr int WLD = DM + 8;
      for (int k = F.tid; k < DM; k += 512) { const float* src = F.win + (size_t)k * DIN + 6144;
#pragma unroll
          for (int q = 0; q < 4; ++q) { const f32x4 w4 = *(const f32x4*)(src + 4 * q); wt_s[(4 * q + 0) * WLD + k] = (bf16)f2bf(w4.x); wt_s[(4 * q + 1) * WLD + k] = (bf16)f2bf(w4.y); wt_s[(4 * q + 2) * WLD + k] = (bf16)f2bf(w4.z); wt_s[(4 * q + 3) * WLD + k] = (bf16)f2bf(w4.w); } }
      bf16* XN = (bf16*)(F.ws + WS_XN); float* ALR = (float*)(F.ws + WS_ALR);
      const int r0 = (int)(((long)F.vcu * TT) / F.G), r1 = (int)(((long)(F.vcu + 1) * TT) / F.G);
      for (int m = r0 + F.wave; m < r1; m += NWAVES) rms_row_to_bf16(m < TP ? F.xp + (size_t)m * DM : F.xs + (size_t)(m - TP) * DM, F.n1g, XN + (size_t)m * DM, F.lane);
      for (int m = TT + gw; m < MP; m += NGW) zero_row_bf16(XN + (size_t)m * DM, F.lane);
      VM_WAIT(); __syncthreads();
      const int l15 = F.lane & 15, lq = F.lane >> 4;
      for (int t0 = r0 + 16 * F.wave; t0 < r1; t0 += 16 * NWAVES) {
          const int row = min(t0 + l15, r1 - 1);
          f32x4 acc = {0.f, 0.f, 0.f, 0.f};
#pragma unroll 8
          for (int ks = 0; ks < 64; ++ks) { const bf16x8 a = *(const bf16x8*)(XN + (size_t)row * DM + 32 * ks + 8 * lq); const bf16x8 bq = *(const bf16x8*)(wt_s + l15 * WLD + 32 * ks + 8 * lq); acc = MFMA16(a, bq, acc); }
#pragma unroll
          for (int r = 0; r < 4; ++r) { const int m = t0 + 4 * lq + r; if (m < r1) ALR[(size_t)m * 16 + l15] = acc[r]; }
      } }
}

template <int NT, class Epi>
__device__ __forceinline__ void skinny_gemm(Frame& F, const bf16* A, const bf16* Bt, int n0, const Epi& E) {
    constexpr int ROWS = NT * 16, NPC = (ROWS * 32 + 511) / 512, BLD = 264;
    bf16* Bs = (bf16*)F.lds;
    const int tid = F.tid, wv = F.wave, l15 = F.lane & 15, lq = F.lane >> 4;
    f32x4 acc[NT];
#pragma unroll
    for (int nt = 0; nt < NT; ++nt) acc[nt] = (f32x4){0.f, 0.f, 0.f, 0.f};
    v4u breg[NPC];
#pragma unroll
    for (int i = 0; i < NPC; ++i) { const int p = tid + 512 * i; if (p < ROWS * 32) breg[i] = *(const v4u*)(Bt + (size_t)(n0 + (p >> 5)) * DM + 8 * (p & 31)); }
#pragma unroll
    for (int i = 0; i < NPC; ++i) { const int p = tid + 512 * i; if (p < ROWS * 32) *(v4u*)(Bs + (p >> 5) * BLD + 8 * (p & 31)) = breg[i]; }
    __syncthreads();
    const bf16* Arow = A + (size_t)(16 * wv + l15) * DM + 8 * lq;
    bf16x8 a[8], an[8];
#pragma unroll
    for (int ks = 0; ks < 8; ++ks) a[ks] = *(const bf16x8*)(Arow + 32 * ks);
#pragma unroll 1
    for (int kc = 0; kc < 8; ++kc) {
        if (kc < 7) {
#pragma unroll
            for (int i = 0; i < NPC; ++i) { const int p = tid + 512 * i; if (p < ROWS * 32) breg[i] = *(const v4u*)(Bt + (size_t)(n0 + (p >> 5)) * DM + (kc + 1) * 256 + 8 * (p & 31)); }
#pragma unroll
            for (int ks = 0; ks < 8; ++ks) an[ks] = *(const bf16x8*)(Arow + (kc + 1) * 256 + 32 * ks); }
        const bf16* Bc = Bs + (kc & 1) * ROWS * BLD;
#pragma unroll
        for (int ks = 0; ks < 8; ++ks)
#pragma unroll
            for (int nt = 0; nt < NT; ++nt) { const bf16x8 bq = *(const bf16x8*)(Bc + (16 * nt + l15) * BLD + 32 * ks + 8 * lq); acc[nt] = MFMA16(a[ks], bq, acc[nt]); }
        if (kc < 7) { bf16* Bn = Bs + ((kc + 1) & 1) * ROWS * BLD;
#pragma unroll
            for (int i = 0; i < NPC; ++i) { const int p = tid + 512 * i; if (p < ROWS * 32) *(v4u*)(Bn + (p >> 5) * BLD + 8 * (p & 31)) = breg[i]; }
#pragma unroll
            for (int ks = 0; ks < 8; ++ks) a[ks] = an[ks]; }
        __syncthreads();
    }
    E.template tile<NT>(acc, wv, l15, lq, n0);
}
struct EpiSkBf16 { bf16* out; int ldc; const float* rs;
    template <int NT> __device__ __forceinline__ void tile(const f32x4 (&acc)[NT], int wv, int l15, int lq, int n0) const {
#pragma unroll
        for (int r = 0; r < 4; ++r) { const int row = 16 * wv + 4 * lq + r; const float sc = rs ? rs[row] : 1.0f;
#pragma unroll
            for (int nt = 0; nt < NT; ++nt) out[(size_t)row * ldc + n0 + 16 * nt + l15] = (bf16)f2bf(acc[nt][r] * sc); } } };
struct EpiSkF32Res { const float* xs; float* out; bf16* outb; float* ssqs;
    template <int NT> __device__ __forceinline__ void tile(const f32x4 (&acc)[NT], int wv, int l15, int lq, int n0) const {
        static_assert(NT == 1, "one 16-column group");
#pragma unroll
        for (int r = 0; r < 4; ++r) { const int row = 16 * wv + 4 * lq + r; const size_t o = (size_t)row * DM + n0 + l15; const float v = xs[o] + acc[0][r]; out[o] = v; outb[o] = (bf16)f2bf(v);
            float s = v * v; s += __shfl_xor(s, 1); s += __shfl_xor(s, 2); s += __shfl_xor(s, 4); s += __shfl_xor(s, 8);
            if (l15 == 0) ssqs[row * 128 + (n0 >> 4)] = s; } } };

__device__ __forceinline__ float logsig(float x) { return fminf(x, 0.f) - log1pf(__expf(-fabsf(x))); }
__device__ __forceinline__ void gla_prep_unit(Frame& F, int u) {
    const bf16* P = (const bf16*)(F.ws + WS_P); bf16* QT = (bf16*)(F.ws + WS_QT); bf16* KT = (bf16*)(F.ws + WS_KT); bf16* VT = (bf16*)(F.ws + WS_VT);
    bf16* ATT = (bf16*)(F.ws + WS_ATT); float* EBL = (float*)(F.ws + WS_EBL);
    const int b = u >> 7, h = (u >> 5) & 3, c = u & 31, tid = F.tid;
    const int row0 = b * 2048 + c * 64;
    float* alr_s = (float*)F.lds;
    float* tot_s = (float*)(F.lds + 4096);
    bf16* q_s = (bf16*)(F.lds + 8192);
    bf16* k_s = q_s + 64 * 264;
    for (int e = tid; e < 1024; e += 512) { const int j = e >> 4, r = e & 15; alr_s[e] = ((const float*)(F.ws + WS_ALR))[(size_t)(row0 + j) * 16 + r]; }
    const int d = tid & 255, half = tid >> 8;
    float w[16];
#pragma unroll
    for (int r = 0; r < 16; ++r) w[r] = F.wau[r * 1024 + h * 256 + d];
    const float bias = F.bal[h * 256 + d];
    __syncthreads();
    float bb[32]; float run = 0.f;
#pragma unroll
    for (int jj = 0; jj < 32; ++jj) { const int j = half * 32 + jj; float x = bias;
#pragma unroll
        for (int r = 0; r < 16; ++r) x += alr_s[j * 16 + r] * w[r];
        run += logsig(x) * 0.0625f; bb[jj] = run; }
    if (half == 0) tot_s[d] = run;
    __syncthreads();
    if (half == 1) { const float t = tot_s[d];
#pragma unroll
        for (int jj = 0; jj < 32; ++jj) bb[jj] += t; }
    unsigned ktp[16];
#pragma unroll
    for (int jj = 0; jj < 32; ++jj) { const int j = half * 32 + jj; const size_t row = (size_t)(row0 + j);
        const float qv = bf2f(P[row * PLD + C_Q + h * 256 + d]), kv = bf2f(P[row * PLD + C_K + h * 256 + d]);
        const float e = __expf(bb[jj]), ei = __expf(-bb[jj]);
        const unsigned qb = f2bf(qv * 0.0625f * e), kb = f2bf(kv * ei);
        QT[row * 1024 + h * 256 + d] = (bf16)qb; q_s[j * 264 + d] = (bf16)qb; k_s[j * 264 + d] = (bf16)kb;
        if (jj & 1) ktp[jj >> 1] |= kb << 16; else ktp[jj >> 1] = kb; }
    { v4u* dst = (v4u*)(KT + ((size_t)u * 256 + d) * 64 + half * 32);
#pragma unroll
      for (int i = 0; i < 4; ++i) { v4u o; o.x = ktp[4 * i]; o.y = ktp[4 * i + 1]; o.z = ktp[4 * i + 2]; o.w = ktp[4 * i + 3]; dst[i] = o; } }
    if (half == 1) EBL[u * 256 + d] = __expf(bb[31]);
    __syncthreads();
    { const int wv = F.wave, l15 = F.lane & 15, lq = F.lane >> 4, mi = wv >> 1;
#pragma unroll
      for (int nn = 0; nn < 2; ++nn) { const int ni = (wv & 1) * 2 + nn; f32x4 acc = {0.f, 0.f, 0.f, 0.f};
#pragma unroll
          for (int ks = 0; ks < 8; ++ks) { const bf16x8 a = *(const bf16x8*)(q_s + (16 * mi + l15) * 264 + 32 * ks + 8 * lq); const bf16x8 bq = *(const bf16x8*)(k_s + (16 * ni + l15) * 264 + 32 * ks + 8 * lq); acc = MFMA16(a, bq, acc); }
#pragma unroll
          for (int r = 0; r < 4; ++r) { const int i = 16 * mi + 4 * lq + r, jn = 16 * ni + l15; ATT[(size_t)u * 4096 + i * 64 + jn] = (bf16)f2bf(jn <= i ? acc[r] : 0.f); } } }
    { const int dv = tid; unsigned vp[32];
#pragma unroll
      for (int j = 0; j < 64; ++j) { const unsigned v = P[(size_t)(row0 + j) * PLD + C_V + h * 512 + dv]; if (j & 1) vp[j >> 1] |= v << 16; else vp[j >> 1] = v; }
      v4u* dst = (v4u*)(VT + ((size_t)u * 512 + dv) * 64);
#pragma unroll
      for (int i = 0; i < 8; ++i) { v4u o; o.x = vp[4 * i]; o.y = vp[4 * i + 1]; o.z = vp[4 * i + 2]; o.w = vp[4 * i + 3]; dst[i] = o; } }
    __syncthreads();
}

__device__ __forceinline__ void gla_sample_unit(Frame& F, int u) {
    const bf16* P = (const bf16*)(F.ws + WS_P); bf16* O = (bf16*)(F.ws + WS_O);
    const int n = u >> 2, h = u & 3, tid = F.tid, lane = F.lane, wv = F.wave;
    const size_t m = (size_t)(TP + n);
    float* e_s = (float*)F.lds;
    float* qe_s = e_s + 256;
    float* k_s = qe_s + 256;
    float* v_s = k_s + 256;
    float* red_s = v_s + 512;
    float* op_s = red_s + 64;
    float part = 0.f;
    if (tid < 256) { const int d = tid; float x = F.bal[h * 256 + d];
#pragma unroll
        for (int r = 0; r < 16; ++r) x += ((const float*)(F.ws + WS_ALR))[m * 16 + r] * F.wau[r * 1024 + h * 256 + d];
        const float la = logsig(x) * 0.0625f, e = __expf(la);
        const float q = bf2f(P[m * PLD + C_Q + h * 256 + d]) * 0.0625f, k = bf2f(P[m * PLD + C_K + h * 256 + d]);
        e_s[d] = e; qe_s[d] = q * e; k_s[d] = k; part = q * k; }
    v_s[tid] = bf2f(P[m * PLD + C_V + h * 512 + tid]);
    part = wave_sum(part);
    if (lane == 0) red_s[wv] = part;
    __syncthreads();
    const float attn = (red_s[0] + red_s[1]) + (red_s[2] + red_s[3]);
    const float* Sin = F.sgla + ((size_t)(n * 4 + h) * 256) * 512; float* Sout = F.out + OUT_GLAS + ((size_t)(n * 4 + h) * 256) * 512;
    const f32x4 v0 = *(const f32x4*)(v_s + 4 * lane), v1 = *(const f32x4*)(v_s + 256 + 4 * lane);
    f32x4 o0 = {0.f, 0.f, 0.f, 0.f}, o1 = {0.f, 0.f, 0.f, 0.f};
#pragma unroll 1
    for (int g = 0; g < 4; ++g) {
        f32x4 s0[8], s1[8];
#pragma unroll
        for (int i = 0; i < 8; ++i) { const int d = 32 * wv + 8 * g + i; s0[i] = *(const f32x4*)(Sin + (size_t)d * 512 + 4 * lane); s1[i] = *(const f32x4*)(Sin + (size_t)d * 512 + 256 + 4 * lane); }
#pragma unroll
        for (int i = 0; i < 8; ++i) { const int d = 32 * wv + 8 * g + i; const float e = e_s[d], qe = qe_s[d], k = k_s[d];
            o0 += s0[i] * qe; o1 += s1[i] * qe;
            *(f32x4*)(Sout + (size_t)d * 512 + 4 * lane) = s0[i] * e + v0 * k; *(f32x4*)(Sout + (size_t)d * 512 + 256 + 4 * lane) = s1[i] * e + v1 * k; }
    }
    *(f32x4*)(op_s + wv * 512 + 4 * lane) = o0; *(f32x4*)(op_s + wv * 512 + 256 + 4 * lane) = o1;
    __syncthreads();
    { float o = attn * v_s[tid];
#pragma unroll
      for (int w8 = 0; w8 < 8; ++w8) o += op_s[w8 * 512 + tid];
      O[m * DM + h * 512 + tid] = (bf16)f2bf(o); }
    __syncthreads();
}

struct GlaRegs { bf16x8 kt[2][2], vt[2][2], at, q[4]; f32x4 eb[2]; };
__device__ __forceinline__ void gla_load(GlaRegs& R, const bf16* QT, const bf16* KT, const bf16* VT, const bf16* ATT, const float* EBL, int bh, int s, int c, int wv, int l15, int lq) {
    const size_t u = (size_t)bh * 32 + c; const int b = bh >> 2, h = bh & 3, mi = wv >> 1, kh = wv & 1;
    R.at = *(const bf16x8*)(ATT + u * 4096 + (16 * mi + l15) * 64 + 32 * kh + 8 * lq);
#pragma unroll
    for (int t = 0; t < 2; ++t)
#pragma unroll
        for (int ks = 0; ks < 2; ++ks) R.vt[t][ks] = *(const bf16x8*)(VT + (u * 512 + 32 * s + 16 * t + l15) * 64 + 32 * ks + 8 * lq);
#pragma unroll
    for (int ks = 0; ks < 4; ++ks) R.q[ks] = *(const bf16x8*)(QT + ((size_t)b * 2048 + 64 * c + 16 * mi + l15) * 1024 + h * 256 + 128 * kh + 32 * ks + 8 * lq);
#pragma unroll
    for (int t = 0; t < 2; ++t)
#pragma unroll
        for (int ks = 0; ks < 2; ++ks) R.kt[t][ks] = *(const bf16x8*)(KT + (u * 256 + 32 * wv + 16 * t + l15) * 64 + 32 * ks + 8 * lq);
#pragma unroll
    for (int t = 0; t < 2; ++t) R.eb[t] = *(const f32x4*)(EBL + u * 256 + 32 * wv + 16 * t + 4 * lq);
}
__device__ __forceinline__ void gla_step(const GlaRegs& R, f32x4 (&S)[2][2], f32x4 (&o)[2], const bf16* STp, bf16* STn, float* xo, int wv, int lane, int l15, int lq) {
    const int mi = wv >> 1, kh = wv & 1;
#pragma unroll
    for (int nt = 0; nt < 2; ++nt) {
        f32x4 acc = {0.f, 0.f, 0.f, 0.f};
        acc = MFMA16(R.at, kh ? R.vt[nt][1] : R.vt[nt][0], acc);
#pragma unroll
        for (int ks = 0; ks < 4; ++ks) { const bf16x8 sf = *(const bf16x8*)(STp + (16 * nt + l15) * 264 + 128 * kh + 32 * ks + 8 * lq); acc = MFMA16(R.q[ks], sf, acc); }
        o[nt] = acc;
    }
    if (kh) { *(f32x4*)(xo + ((mi * 2 + 0) * 64 + lane) * 4) = o[0]; *(f32x4*)(xo + ((mi * 2 + 1) * 64 + lane) * 4) = o[1]; }
#pragma unroll
    for (int mt = 0; mt < 2; ++mt)
#pragma unroll
        for (int nt = 0; nt < 2; ++nt) {
#pragma unroll
            for (int ks = 0; ks < 2; ++ks) S[mt][nt] = MFMA16(R.kt[mt][ks], R.vt[nt][ks], S[mt][nt]);
            S[mt][nt] = S[mt][nt] * R.eb[mt];
            v2u w; w.x = pk2(S[mt][nt][0], S[mt][nt][1]); w.y = pk2(S[mt][nt][2], S[mt][nt][3]);
            *(v2u*)(STn + (16 * nt + l15) * 264 + 32 * wv + 16 * mt + 4 * lq) = w; }
}
__device__ __forceinline__ void gla_store_o(const f32x4 (&o)[2], const float* xo, bf16* O, int b, int h, int s, int c, int wv, int lane, int l15, int lq) {
    const int mi = wv >> 1;
#pragma unroll
    for (int nt = 0; nt < 2; ++nt) { const f32x4 t = o[nt] + *(const f32x4*)(xo + ((mi * 2 + nt) * 64 + lane) * 4);
#pragma unroll
        for (int r = 0; r < 4; ++r) O[((size_t)b * 2048 + 64 * c + 16 * mi + 4 * lq + r) * DM + h * 512 + 32 * s + 16 * nt + l15] = (bf16)f2bf(t[r]); }
}
#define GLA_BAR() do { asm volatile("s_waitcnt lgkmcnt(0)" ::: "memory"); __builtin_amdgcn_s_barrier(); asm volatile("" ::: "memory"); } while (0)
__device__ __forceinline__ void gla_main_unit(Frame& F, int bh, int s) {
    const bf16* QT = (const bf16*)(F.ws + WS_QT); const bf16* KT = (const bf16*)(F.ws + WS_KT); const bf16* VT = (const bf16*)(F.ws + WS_VT);
    const bf16* ATT = (const bf16*)(F.ws + WS_ATT); const float* EBL = (const float*)(F.ws + WS_EBL); bf16* O = (bf16*)(F.ws + WS_O);
    const int b = bh >> 2, h = bh & 3, wv = F.wave, lane = F.lane, l15 = lane & 15, lq = lane >> 4, kh = wv & 1;
    bf16* ST = (bf16*)F.lds;
    float* XO = (float*)(F.lds + 34816);
    for (int e = F.tid; e < 2 * 32 * 264 / 2; e += 512) ((unsigned*)ST)[e] = 0u;
    __syncthreads();
    f32x4 S[2][2];
#pragma unroll
    for (int a = 0; a < 2; ++a)
#pragma unroll
        for (int c2 = 0; c2 < 2; ++c2) S[a][c2] = (f32x4){0.f, 0.f, 0.f, 0.f};
    GlaRegs RA, RB;
    gla_load(RA, QT, KT, VT, ATT, EBL, bh, s, 0, wv, l15, lq);
    f32x4 o[2], oprev[2];
    oprev[0] = oprev[1] = (f32x4){0.f, 0.f, 0.f, 0.f};
#define GLA_ITER(c, RCUR, RLD) do { \
            gla_load(RLD, QT, KT, VT, ATT, EBL, bh, s, (c) + 1 < 32 ? (c) + 1 : 31, wv, l15, lq); \
            gla_step(RCUR, S, o, ST + ((c) & 1) * 32 * 264, ST + (((c) + 1) & 1) * 32 * 264, XO + ((c) & 1) * 2048, wv, lane, l15, lq); \
            if (!kh && (c) > 0) gla_store_o(oprev, XO + (((c) + 1) & 1) * 2048, O, b, h, s, (c) - 1, wv, lane, l15, lq); \
            oprev[0] = o[0]; oprev[1] = o[1]; \
            GLA_BAR(); \
        } while (0)
#pragma unroll 1
    for (int c = 0; c < 32; c += 2) { GLA_ITER(c, RA, RB); GLA_ITER(c + 1, RB, RA); }
#undef GLA_ITER
    if (!kh) gla_store_o(oprev, XO + (31 & 1) * 2048, O, b, h, s, 31, wv, lane, l15, lq);
    float* So = F.out + OUT_GLAP + ((size_t)bh * 256) * 512;
#pragma unroll
    for (int mt = 0; mt < 2; ++mt)
#pragma unroll
        for (int nt = 0; nt < 2; ++nt)
#pragma unroll
            for (int r = 0; r < 4; ++r) So[(size_t)(32 * wv + 16 * mt + 4 * lq + r) * 512 + 32 * s + 16 * nt + l15] = S[mt][nt][r];
    __syncthreads();
}

__device__ __forceinline__ void mixer_row(Frame& F, int m) {
    const bf16* P = (const bf16*)(F.ws + WS_P); const bf16* O = (const bf16*)(F.ws + WS_O); bf16* MM = (bf16*)(F.ws + WS_MM);
    const int lane = F.lane; const bf16* Pr = P + (size_t)m * PLD;
    const bool prompt = m < TP; const int t = m & 2047, n = m - TP, bidx = m >> 11;
#pragma unroll 1
    for (int j = 0; j < 4; ++j) {
        const int col = 512 * j + 8 * lane;
        float o[8], r[8], cbv[8], cc[8], cx[8], ga[8], gb[8], u[8], u1[8], u2[8];
        unpack8(*(const v4u*)(O + (size_t)m * DM + col), o);
        float ss = 0.f;
#pragma unroll
        for (int e = 0; e < 8; ++e) ss += o[e] * o[e];
        const float rstd = 1.0f / sqrtf(wave_sum(ss) * (1.0f / 512.0f) + EPS);
        unpack8(*(const v4u*)(Pr + C_R + col), r); unpack8(*(const v4u*)(Pr + C_CB + col), cbv); unpack8(*(const v4u*)(Pr + C_CC + col), cc); unpack8(*(const v4u*)(Pr + C_CX + col), cx);
        unpack8(*(const v4u*)(Pr + C_GA + col), ga); unpack8(*(const v4u*)(Pr + C_GB + col), gb);
#pragma unroll
        for (int e = 0; e < 8; ++e) u[e] = cc[e] * cx[e];
        if (prompt) {
            if (t >= 1) { float a[8], b2[8]; unpack8(*(const v4u*)(Pr - PLD + C_CC + col), a); unpack8(*(const v4u*)(Pr - PLD + C_CX + col), b2);
#pragma unroll
                for (int e = 0; e < 8; ++e) u1[e] = a[e] * b2[e]; }
            else {
#pragma unroll
                for (int e = 0; e < 8; ++e) u1[e] = 0.f; }
            if (t >= 2) { float a[8], b2[8]; unpack8(*(const v4u*)(Pr - 2 * PLD + C_CC + col), a); unpack8(*(const v4u*)(Pr - 2 * PLD + C_CX + col), b2);
#pragma unroll
                for (int e = 0; e < 8; ++e) u2[e] = a[e] * b2[e]; }
            else {
#pragma unroll
                for (int e = 0; e < 8; ++e) u2[e] = 0.f; }
            if (t >= 2046) { float* dst = F.out + OUT_CONVP + ((size_t)bidx * 2 + (t - 2046)) * DM + col;
                *(f32x4*)dst = (f32x4){u[0], u[1], u[2], u[3]}; *(f32x4*)(dst + 4) = (f32x4){u[4], u[5], u[6], u[7]}; }
        } else {
            const float* sc = F.sconv + (size_t)n * 2 * DM + col;
            const f32x4 a0 = *(const f32x4*)sc, a1 = *(const f32x4*)(sc + 4), b0 = *(const f32x4*)(sc + DM), b1 = *(const f32x4*)(sc + DM + 4);
            u2[0] = a0.x; u2[1] = a0.y; u2[2] = a0.z; u2[3] = a0.w; u2[4] = a1.x; u2[5] = a1.y; u2[6] = a1.z; u2[7] = a1.w;
            u1[0] = b0.x; u1[1] = b0.y; u1[2] = b0.z; u1[3] = b0.w; u1[4] = b1.x; u1[5] = b1.y; u1[6] = b1.z; u1[7] = b1.w;
            float* dst = F.out + OUT_CONVS + (size_t)n * 2 * DM + col;
            *(f32x4*)dst = b0; *(f32x4*)(dst + 4) = b1;
            *(f32x4*)(dst + DM) = (f32x4){u[0], u[1], u[2], u[3]}; *(f32x4*)(dst + DM + 4) = (f32x4){u[4], u[5], u[6], u[7]};
        }
        float mv[8];
#pragma unroll
        for (int e = 0; e < 8; ++e) {
            const int cidx = col + e;
            const float ya = (r[e] * sigmoidf_(r[e])) * (o[e] * rstd * F.gng[cidx]);
            const float z = F.cb[cidx] + F.cw[cidx] * u2[e] + F.cw[DM + cidx] * u1[e] + F.cw[2 * DM + cidx] * u[e];
            mv[e] = sigmoidf_(ga[e]) * ya + sigmoidf_(gb[e]) * (cbv[e] * z);
        }
        *(v4u*)(MM + (size_t)m * DM + col) = pack8(mv);
    }
}

constexpr int SC_LD = 130;
__device__ __forceinline__ int f2sort(float f) { const int b = __float_as_int(f); return b ^ ((b >> 31) & 0x7fffffff); }
__device__ __forceinline__ float sort2f(int s) { return __int_as_float(s ^ ((s >> 31) & 0x7fffffff)); }
#define CE_DESC(x, y) do { const int mx_ = max(x, y), mn_ = min(x, y); x = mx_; y = mn_; } while (0)
template <int N> __device__ __forceinline__ void bitonic_sort_desc(int (&a)[N]) {
#pragma unroll
    for (int k = 2; k <= N; k <<= 1)
#pragma unroll
        for (int j = k >> 1; j > 0; j >>= 1)
#pragma unroll
            for (int i = 0; i < N; ++i) { const int l = i ^ j; if (l > i) { if ((i & k) == 0) CE_DESC(a[i], a[l]); else CE_DESC(a[l], a[i]); } }
}
template <int N> __device__ __forceinline__ void bitonic_merge_desc(int (&a)[N]) {
#pragma unroll
    for (int j = N >> 1; j > 0; j >>= 1)
#pragma unroll
        for (int i = 0; i < N; ++i) { const int l = i ^ j; if (l > i) CE_DESC(a[i], a[l]); }
}
__device__ __forceinline__ void top16_merge(int (&a)[16], const int (&b)[16]) {
#pragma unroll
    for (int i = 0; i < 16; ++i) a[i] = max(a[i], b[15 - i]);
    bitonic_merge_desc<16>(a);
}
__device__ __attribute__((aligned(16))) const unsigned char PK_CAND[64] = {
    0x00, 0x01, 0x02, 0x03, 0x04, 0x05, 0x06, 0x07, 0x08, 0x09, 0x0a, 0x0b, 0x0c, 0x0d, 0x0e, 0x0f,
    0x10, 0x11, 0x12, 0x13, 0x14, 0x15, 0x16, 0x17, 0x20, 0x21, 0x22, 0x23, 0x24, 0x50, 0x51, 0xff,
    0x30, 0x31, 0x32, 0x33, 0x40, 0x41, 0x42, 0x60, 0x61, 0x70, 0x71, 0xff, 0xff, 0xff, 0xff, 0xff,
    0x80, 0x90, 0xa0, 0xb0, 0xc0, 0xd0, 0xe0, 0xf0, 0xff, 0xff, 0xff, 0xff, 0xff, 0xff, 0xff, 0xff};
constexpr int SC8_LD = 132, SK_LD = 136;
constexpr int SC8_BYTES = 128 * SC8_LD * 4, TV8_OFF = SC8_BYTES, SK_OFF = TV8_OFF + 128 * 16 * 4;
__device__ __forceinline__ void peer_load_subkeys(Frame& F) {
    const bf16* SKB = (const bf16*)(F.ws + WS_SKB); bf16* sk_s = (bf16*)(F.lds + SK_OFF);
    for (int e = F.tid; e < 256 * 16; e += 512) { const int row = e >> 4, ch = e & 15; *(v4u*)(sk_s + row * SK_LD + 8 * ch) = *(const v4u*)(SKB + (size_t)row * 128 + 8 * ch); }
    __syncthreads();
}
__device__ __forceinline__ void peer_qfrags(Frame& F, int tb, bf16x8 (&a)[2][4]) {
    const bf16* QP = (const bf16*)(F.ws + WS_QP); const int tok = min(tb + (F.lane & 7), TT - 1), lq = F.lane >> 4;
#pragma unroll
    for (int hf = 0; hf < 2; ++hf)
#pragma unroll
        for (int ks = 0; ks < 4; ++ks) a[hf][ks] = *(const bf16x8*)(QP + (size_t)tok * DM + F.wave * 256 + hf * 128 + 32 * ks + 8 * lq);
}
#define PK_BAR() do { asm volatile("s_waitcnt lgkmcnt(0)" ::: "memory"); __builtin_amdgcn_s_barrier(); asm volatile("" ::: "memory"); } while (0)
__device__ __forceinline__ void peer_topk_tile(Frame& F, int tb, int tend, bf16x8 (&a)[2][4]) {
    int* IDX = (int*)(F.ws + WS_IDX); float* GW = (float*)(F.ws + WS_GW);
    float* sc_s = (float*)F.lds;
    int* tv_s = (int*)(F.lds + TV8_OFF);
    const bf16* sk_s = (const bf16*)(F.lds + SK_OFF);
    const int wv = F.wave, lane = F.lane, l15 = lane & 15, lq = lane >> 4, tid = F.tid;
    {
#pragma unroll
      for (int hf = 0; hf < 2; ++hf) {
#pragma unroll
          for (int nt = 0; nt < 8; ++nt) { f32x4 acc = {0.f, 0.f, 0.f, 0.f};
#pragma unroll
              for (int ks = 0; ks < 4; ++ks) { const bf16x8 bq = *(const bf16x8*)(sk_s + (hf * 128 + 16 * nt + l15) * SK_LD + 32 * ks + 8 * lq); acc = MFMA16(a[hf][ks], bq, acc); }
              if (lq < 2) {
#pragma unroll
                  for (int r = 0; r < 4; ++r) sc_s[((wv * 2 + hf) * 8 + 4 * lq + r) * SC8_LD + 16 * nt + l15] = acc[r]; } } } }
    if (tb + 8 < tend) peer_qfrags(F, tb + 8, a);
    PK_BAR();
    { const int row = tid >> 2, sub = tid & 3; const float* rp = sc_s + row * SC8_LD;
      int top[16], v[16];
#pragma unroll
      for (int i = 0; i < 16; ++i) { const int key = 4 * i + sub; top[i] = (f2sort(rp[key]) & ~127) | (127 - key); }
      bitonic_sort_desc<16>(top);
#pragma unroll
      for (int i = 0; i < 16; ++i) { const int key = 4 * (16 + i) + sub; v[i] = (f2sort(rp[key]) & ~127) | (127 - key); }
      bitonic_sort_desc<16>(v);
      top16_merge(top, v);
#pragma unroll
      for (int sh = 1; sh < 4; sh <<= 1) {
#pragma unroll
          for (int i = 0; i < 16; ++i) v[i] = __shfl_xor(top[i], sh);
          top16_merge(top, v); }
      if (sub == 0) {
#pragma unroll
          for (int q = 0; q < 4; ++q) *(int __attribute__((ext_vector_type(4)))*)(tv_s + row * 16 + 4 * q) = (int __attribute__((ext_vector_type(4)))){top[4 * q], top[4 * q + 1], top[4 * q + 2], top[4 * q + 3]}; }
    }
    PK_BAR();
    if (tid < 256) { const int it = tid >> 2, qd = tid & 3, tl = it & 7, hd = it >> 3;
      const int* r1 = tv_s + ((hd * 2 + 0) * 8 + tl) * 16; const int* r2 = tv_s + ((hd * 2 + 1) * 8 + tl) * 16;
      int c[16];
      const v4u cw = *(const v4u*)(PK_CAND + qd * 16);
#pragma unroll
      for (int t = 0; t < 16; ++t) { const int ab = (int)((cw[t >> 2] >> (8 * (t & 3))) & 0xffu); const int abc = ab != 0xff ? ab : 0;
          const float sv = sort2f(r1[abc >> 4] & ~127) + sort2f(r2[abc & 15] & ~127); const int packed = (f2sort(sv) & ~255) | (255 - ab);
          c[t] = ab != 0xff ? packed : (int)0x80000000; }
      bitonic_sort_desc<16>(c);
#pragma unroll
      for (int sh = 1; sh < 4; sh <<= 1) { int oth[16];
#pragma unroll
          for (int i = 0; i < 16; ++i) oth[i] = __shfl_xor(c[i], sh);
          top16_merge(c, oth); }
      const int tok = tb + tl;
      if (tok < tend) {
          float ev[16], sum = 0.f; const float mx = sort2f(c[0] & ~255);
#pragma unroll
          for (int k = 0; k < 16; ++k) { ev[k] = __expf(sort2f(c[k] & ~255) - mx); sum += ev[k]; }
          const float inv = 1.0f / sum;
#pragma unroll
          for (int k = 0; k < 16; ++k) if ((k >> 2) == qd) { const int ab = 255 - (c[k] & 255); const int i1 = 127 - (r1[ab >> 4] & 127), i2 = 127 - (r2[ab & 15] & 127);
              IDX[(size_t)tok * 128 + hd * 16 + k] = i1 * 128 + i2; GW[(size_t)tok * 128 + hd * 16 + k] = ev[k] * inv; }
      }
    }
    PK_BAR();
}

__device__ __forceinline__ void peer_phase(Frame& F, int tok0, int tok1) {
    const unsigned char* U6 = F.ws + WS_EU; const unsigned char* V6 = F.ws + WS_EV; const float* SU = (const float*)(F.ws + WS_EU + 32 * MiB); const float* SV = (const float*)(F.ws + WS_EV + 32 * MiB);
    const float* X2 = (const float*)(F.ws + WS_X2); const float* RS2 = (const float*)(F.ws + WS_RS2); const int* IDX = (const int*)(F.ws + WS_IDX); const float* GW = (const float*)(F.ws + WS_GW);
    const int wv = F.wave, lane = F.lane, tid = F.tid;
    float* red_s = (float*)F.lds;
    float* ss_s = (float*)(F.lds + 131072);
    const f32x4 gfin = *(const f32x4*)(F.nfg + 4 * tid);
    f32x4 x3p = {0.f, 0.f, 0.f, 0.f}; int buf = 0;
#pragma unroll 1
    for (int m = tok0; m <= tok1; ++m) {
        if (m < tok1) {
            const int myidx = IDX[(size_t)m * 128 + wv * 16 + (lane & 15)]; float myg = GW[(size_t)m * 128 + wv * 16 + (lane & 15)];
            const float mysu = SU[myidx] * RS2[m]; myg *= SV[myidx];
            float hf[32];
#pragma unroll
            for (int j = 0; j < 8; ++j) { const f32x4 w = *(const f32x4*)(X2 + (size_t)m * DM + 256 * j + 4 * lane); hf[4 * j] = w.x; hf[4 * j + 1] = w.y; hf[4 * j + 2] = w.z; hf[4 * j + 3] = w.w; }
            float acc[32];
#pragma unroll
            for (int k = 0; k < 32; ++k) acc[k] = 0.f;
#pragma unroll 1
            for (int kg = 0; kg < 4; ++kg) {
                v2u ul[4][3], vl[4][3]; float gk[4], su[4];
#pragma unroll
                for (int kk = 0; kk < 4; ++kk) { const int ex = __shfl(myidx, kg * 4 + kk); gk[kk] = __shfl(myg, kg * 4 + kk); su[kk] = __shfl(mysu, kg * 4 + kk);
                    const unsigned char* ur = U6 + (size_t)ex * ROW6 + 8 * lane; const unsigned char* vr = V6 + (size_t)ex * ROW6 + 8 * lane;
#pragma unroll
                    for (int pp = 0; pp < 3; ++pp) { ul[kk][pp] = *(const v2u*)(ur + 512 * pp); vl[kk][pp] = *(const v2u*)(vr + 512 * pp); } }
#pragma unroll
                for (int kk = 0; kk < 4; ++kk) {
                    const v32f uf = __builtin_amdgcn_cvt_scalef32_pk32_f32_fp6((v6u){ul[kk][0].x, ul[kk][0].y, ul[kk][1].x, ul[kk][1].y, ul[kk][2].x, ul[kk][2].y}, 1.0f);
                    float dot = 0.f;
#pragma unroll
                    for (int k = 0; k < 32; ++k) dot += uf[k] * hf[k];
                    const float a = wave_sum(dot) * su[kk];
                    const float wgt = gk[kk] * (0.5f * a * (1.0f + erff(a * 0.70710678118654752f)));
                    const v32f vf = __builtin_amdgcn_cvt_scalef32_pk32_f32_fp6((v6u){vl[kk][0].x, vl[kk][0].y, vl[kk][1].x, vl[kk][1].y, vl[kk][2].x, vl[kk][2].y}, 1.0f);
#pragma unroll
                    for (int k = 0; k < 32; ++k) acc[k] += wgt * vf[k];
                }
            }
#pragma unroll
            for (int j = 0; j < 8; ++j) *(f32x4*)(red_s + (buf * 8 + wv) * 2048 + 256 * j + 4 * lane) = (f32x4){acc[4 * j], acc[4 * j + 1], acc[4 * j + 2], acc[4 * j + 3]};
        }
        __syncthreads();
        if (m > tok0) {
            float tot = 0.f;
#pragma unroll
            for (int w8 = 0; w8 < 8; ++w8) tot += ss_s[(buf ^ 1) * 8 + w8];
            const float rstd = 1.0f / sqrtf(tot * (1.0f / DM) + EPS);
            *(f32x4*)(F.out + OUT_Y + (size_t)(m - 1) * DM + 4 * tid) = x3p * rstd * gfin;
        }
        if (m < tok1) {
            f32x4 x3 = *(const f32x4*)(X2 + (size_t)m * DM + 4 * tid);
#pragma unroll
            for (int w8 = 0; w8 < 8; ++w8) x3 += *(const f32x4*)(red_s + (buf * 8 + w8) * 2048 + 4 * tid);
            const float ss = wave_sum((x3.x * x3.x + x3.y * x3.y) + (x3.z * x3.z + x3.w * x3.w));
            if (lane == 0) ss_s[buf * 8 + wv] = ss;
            x3p = x3;
        }
        buf ^= 1;
    }
    __syncthreads();
}
struct Args { const float* in[18]; float* out; unsigned char* ws; int ph_lo, ph_hi; };
__global__ void __launch_bounds__(NWAVES * 64, 2) mk_fwd(Args args) {
    extern __shared__ __attribute__((aligned(16))) unsigned char lds[];
    Frame F;
    F.lds = lds;
    F.tid = threadIdx.x; F.lane = F.tid & 63; F.wave = __builtin_amdgcn_readfirstlane(F.tid >> 6);
    F.G = gridDim.x; { const int bx = blockIdx.x; F.vcu = (F.G % 8 == 0) ? (bx % 8) * (F.G / 8) + bx / 8 : bx; }
    F.xp = args.in[0]; F.xs = args.in[1]; F.sgla = args.in[2]; F.sconv = args.in[3]; F.n1g = args.in[4]; F.win = args.in[5]; F.wau = args.in[6]; F.bal = args.in[7];
    F.gng = args.in[8]; F.cw = args.in[9]; F.cb = args.in[10]; F.wout = args.in[11]; F.n2g = args.in[12]; F.wq = args.in[13]; F.sk = args.in[14]; F.eu = args.in[15];
    F.ev = args.in[16]; F.nfg = args.in[17]; F.out = args.out; F.ws = args.ws;
    for (int u = F.tid; u < (LDS_BYTES - LDSCTL_OFF) / 4; u += NWAVES * 64) ((LAS unsigned*)((LAS unsigned char*)lds + LDSCTL_OFF))[u] = 0u;
    __syncthreads();
    gu32* ctl = (gu32*)(F.ws + WS_CTL);
    XcdBarrier bar; bar.bar = (unsigned*)(ctl + CW_BAR); bar.x = 0; bar.st = nullptr;
    if (N_LAUNCHES == 1) bar = xcd_barrier_post((unsigned*)(ctl + CW_BAR), (volatile LAS unsigned*)((LAS unsigned char*)lds + MISC_OFF) + 8);
    const int lo = args.ph_lo, hi = args.ph_hi;
#ifndef SKREP
#define SKREP 1
#endif
#ifndef PROBE_DBL
#define PROBE_DBL -1
#endif
#define IN(k) (lo <= (k) && (k) < hi)
#define REP(k) for (int rep_ = 0; rep_ < ((k) == PROBE_DBL ? 2 : 1); ++rep_)
#define SEAM(k) do { if (IN(k) && IN((k) + 1)) xcd_barrier(bar); } while (0)
    const int gw = F.vcu * NWAVES + F.wave, NGW = F.G * NWAVES;
    const int tok0 = (int)(((long)F.vcu * TT) / F.G), tok1 = (int)(((long)(F.vcu + 1) * TT) / F.G);

    if (IN(0)) REP(0) { p0_prologue(F); __syncthreads(); }
    SEAM(0);
    if (IN(1)) REP(1) {
        pg8::Gemm g{(const pg8::bf16_t*)(F.ws + WS_XN), (const pg8::bf16_t*)(F.ws + WS_WINT), TP, NP, DM}; pg8::StaticOrder S; S.init(TP, NP, F.G, (int)blockIdx.x);
        pg8::EpiBf16<0> E{(pg8::bf16_t*)(F.ws + WS_P), PLD, nullptr, 0, 0, 1.f};
        pg8::gemm_phase<pg8::EpiBf16<0>, pg8::StaticOrder, true, true>((PG8_LAS unsigned char*)lds + RING_OFF, g, S, E);
#ifdef GEMM1_TWICE
        pg8::gemm_phase<pg8::EpiBf16<0>, pg8::StaticOrder, true, true>((PG8_LAS unsigned char*)lds + RING_OFF, g, S, E);
#endif
        { EpiSkBf16 Es{(bf16*)(F.ws + WS_P) + (size_t)TP * PLD, PLD, nullptr};
          for (int skr = 0; skr < SKREP; ++skr) for (int ng = F.vcu; ng < NP / 64; ng += F.G) skinny_gemm<4>(F, (const bf16*)(F.ws + WS_XN) + (size_t)TP * DM, (const bf16*)(F.ws + WS_WINT), 64 * ng, Es); }
    }
    SEAM(1);
    if (IN(2)) REP(2) {
        for (int u = F.vcu; u < 512; u += F.G) gla_prep_unit(F, u);
        for (int u = F.vcu; u < 512; u += F.G) gla_sample_unit(F, u);
    }
    SEAM(2);
    if (IN(3)) REP(3) { for (int u = F.vcu; u < 256; u += F.G) gla_main_unit(F, u >> 4, u & 15); }
    SEAM(3);
    if (IN(4)) REP(4) {
        bf16* MM = (bf16*)(F.ws + WS_MM);
        for (int m = gw; m < MP; m += NGW) { if (m < TT) mixer_row(F, m); else zero_row_bf16(MM + (size_t)m * DM, F.lane); }
    }
    SEAM(4);
    if (IN(5)) REP(5) {
        pg8::Gemm g{(const pg8::bf16_t*)(F.ws + WS_MM), (const pg8::bf16_t*)(F.ws + WS_WOUTT), TP, DM, DM}; pg8::StaticOrder S; S.init(TP, DM, F.G, (int)blockIdx.x);
        pg8::EpiF32Res E{F.xp, (float*)(F.ws + WS_X2), (pg8::bf16_t*)(F.ws + WS_H2), (float*)(F.ws + WS_SSQ), DM};
        pg8::gemm_phase<pg8::EpiF32Res, pg8::StaticOrder, true, true>((PG8_LAS unsigned char*)lds + RING_OFF, g, S, E);
        { EpiSkF32Res Es{F.xs, (float*)(F.ws + WS_X2) + (size_t)TP * DM, (bf16*)(F.ws + WS_H2) + (size_t)TP * DM, (float*)(F.ws + WS_SSQS)};
          for (int skr = 0; skr < SKREP; ++skr) for (int ng = F.vcu; ng < DM / 16; ng += F.G) skinny_gemm<1>(F, (const bf16*)(F.ws + WS_MM) + (size_t)TP * DM, (const bf16*)(F.ws + WS_WOUTT), 16 * ng, Es); }
    }
    SEAM(5);
    if (IN(6)) REP(6) {
        float* rs_s = (float*)(lds + 131072);
        float* rss_s = rs_s + 512;
        float* RS2 = (float*)(F.ws + WS_RS2);
        pg8::Gemm g{(const pg8::bf16_t*)(F.ws + WS_H2), (const pg8::bf16_t*)(F.ws + WS_WQT), TP, DM, DM}; pg8::StaticOrder S; S.init(TP, DM, F.G, (int)blockIdx.x);
        { pg8::Unit u0;
          if (S.next(0, u0) && F.tid < 256) { const int row = u0.pm * 256 + F.tid; const f32x4* p = (const f32x4*)((const float*)(F.ws + WS_SSQ) + (size_t)row * 32); f32x4 a4 = p[0];
#pragma unroll
              for (int i = 1; i < 8; ++i) a4 += p[i];
              const float rstd = 1.0f / sqrtf(((a4.x + a4.y) + (a4.z + a4.w)) * (1.0f / DM) + EPS); rs_s[F.tid] = rstd; if (u0.pn == 0) RS2[row] = rstd; }
          if (F.tid >= 256 && F.tid < 384 && F.vcu < DM / 16) { const int row = F.tid - 256; const f32x4* p = (const f32x4*)((const float*)(F.ws + WS_SSQS) + (size_t)row * 128); f32x4 a4 = p[0];
#pragma unroll
              for (int i = 1; i < 32; ++i) a4 += p[i];
              const float rstd = 1.0f / sqrtf(((a4.x + a4.y) + (a4.z + a4.w)) * (1.0f / DM) + EPS); rss_s[row] = rstd; if (F.vcu == 0) RS2[TP + row] = rstd; }
          __syncthreads(); }
        pg8::EpiBf16RowScale E{(pg8::bf16_t*)(F.ws + WS_QP), DM, rs_s};
        pg8::gemm_phase<pg8::EpiBf16RowScale, pg8::StaticOrder, true, true>((PG8_LAS unsigned char*)lds + RING_OFF, g, S, E);
        { EpiSkBf16 Es{(bf16*)(F.ws + WS_QP) + (size_t)TP * DM, DM, rss_s};
          for (int skr = 0; skr < SKREP; ++skr) for (int ng = F.vcu; ng < DM / 16; ng += F.G) skinny_gemm<1>(F, (const bf16*)(F.ws + WS_H2) + (size_t)TP * DM, (const bf16*)(F.ws + WS_WQT), 16 * ng, Es); }
    }
    SEAM(6);
    if (IN(7)) REP(7) { bf16x8 qa[2][4]; peer_qfrags(F, tok0, qa); peer_load_subkeys(F); for (int tb = tok0; tb < tok1; tb += 8) peer_topk_tile(F, tb, tok1, qa); __syncthreads(); }
    SEAM(7);
    if (IN(8)) REP(8) { peer_phase(F, tok0, tok1); }
#undef IN
#undef SEAM
}

extern "C" void kernel_launch(void* const* d_in, const int* in_sizes, int n_in, void* d_out, int out_size, void* d_ws, size_t ws_size, hipStream_t stream) {
    static int grid = 0;
    if (grid == 0) {
        if (n_in != 18 || ws_size < WS_END) { fprintf(stderr, "kernel_launch: expected 18 inputs and >= %zu bytes of workspace; got %d, %zu\n", (size_t)WS_END, n_in, ws_size); grid = -1; return; }
        int dev = 0, cus = 0;
        if (hipGetDevice(&dev) != hipSuccess || hipDeviceGetAttribute(&cus, hipDeviceAttributeMultiprocessorCount, dev) != hipSuccess) { grid = -1; return; }
        if (hipFuncSetAttribute((const void*)mk_fwd, hipFuncAttributeMaxDynamicSharedMemorySize, LDS_BYTES) != hipSuccess) { fprintf(stderr, "kernel_launch: hipFuncSetAttribute failed\n"); grid = -1; return; }
        (void)hipGetLastError();
        grid = cus;
    }
    if (grid < 0) return;
    (void)hipMemsetAsync((char*)d_ws + WS_CTL, 0, CTL_ZERO_BYTES, stream);
    Args a{};
    for (int i = 0; i < 18; ++i) a.in[i] = (const float*)d_in[i];
    a.out = (float*)d_out; a.ws = (unsigned char*)d_ws;
    if (N_LAUNCHES == 1) { a.ph_lo = 0; a.ph_hi = N_PHASES; hipLaunchKernelGGL(mk_fwd, dim3(grid), dim3(NWAVES * 64), LDS_BYTES, stream, a); }
    else { for (int li = 0; li < N_PHASES; ++li) { a.ph_lo = li; a.ph_hi = li + 1; hipLaunchKernelGGL(mk_fwd, dim3(grid), dim3(NWAVES * 64), LDS_BYTES, stream, a); } }
}
```

```cpp
#include <hip/hip_runtime.h>
#include <cstdio>
#include <cstdint>
#include <cmath>
#define MK_N_LAUNCHES 1
namespace pg8 {
#define PG8_LAS __attribute__((address_space(3)))
typedef unsigned short bf16_t;
typedef short bf16x8 __attribute__((ext_vector_type(8)));
typedef float f32x4 __attribute__((ext_vector_type(4)));
typedef unsigned u32x4 __attribute__((ext_vector_type(4)));
constexpr int BM = 256, BK = 64, HALF = 128, HTB = HALF * BK * 2  , STAGE_BYTES = 8 * HTB, NXCD = 8, WGM = 8;

__host__ __device__ __forceinline__ int lds_byte(int r, int c) { const int st = (r >> 4) * 2 + (c >> 5), rr = r & 15, cc = c & 31, ob = rr * 64 + cc * 2; return st * 1024 + (ob ^ (((ob >> 9) & 1) << 5)); }
__host__ __device__ __forceinline__ void stage_rc(int b, int& R, int& C) { const int st = b / 1024, sb = b % 1024, swz = sb ^ (((sb >> 9) & 1) << 5); R = (st >> 1) * 16 + swz / 64; C = (st & 1) * 32 + (swz % 64) / 2; }
__host__ __device__ __forceinline__ int perm32(int rho) { const int n = rho >> 4, i = rho & 15; return 8 * (i >> 2) + 4 * n + (i & 3); }

struct Unit { int pm, pn; };
struct Gemm { const bf16_t* A; const bf16_t* Bt; int M, N, K; };

struct StaticOrder {
    int nM, nN, nwg, G, c;
    __host__ __device__ void init(int M, int N, int G_, int c_) { nM = M / BM; nN = N / BM; nwg = nM * nN; G = G_; c = c_; }
    __host__ __device__ bool next(int i, Unit& u) const {
        const long L = (long)i * G + c; if (L >= nwg) return false;
        int wgid = (int)L; { const int q = nwg / NXCD, r = nwg % NXCD, xcd = wgid % NXCD, off = wgid / NXCD; wgid = (xcd < r ? xcd * (q + 1) : r * (q + 1) + (xcd - r) * q) + off; }
        const int nig = WGM * nN, gid = wgid / nig, fm = gid * WGM, gsz = (nM - fm) < WGM ? (nM - fm) : WGM;
        u.pm = fm + ((wgid % nig) % gsz); u.pn = (wgid % nig) / gsz; return true;
    }
    __device__ __forceinline__ void a_ready(const Unit&) const {}
    __device__ __forceinline__ void done(const Unit&) const {}
};

__device__ __forceinline__ unsigned cvt_pk_bf16(float lo, float hi) { unsigned r; asm volatile("v_cvt_pk_bf16_f32 %0, %1, %2" : "=v"(r) : "v"(lo), "v"(hi)); return r; }
typedef float f32x2 __attribute__((ext_vector_type(2)));
__device__ __forceinline__ f32x2 gelu_pk(f32x2 v) {
    const f32x2 av = __builtin_elementwise_abs(v), d = av * 0.2316418882f + 1.0f;
    f32x2 t; t.x = __builtin_amdgcn_rcpf(d.x); t.y = __builtin_amdgcn_rcpf(d.y);
    f32x2 q = t * 0.5307027145f + (-0.7265760135f); q = q * t + 0.7107068705f; q = q * t + (-0.142248368f); q = q * t + 0.127414796f; q = q * t;
    const f32x2 s = (v * v) * (-0.72134752044f);
    f32x2 e; e.x = __builtin_amdgcn_exp2f(s.x); e.y = __builtin_amdgcn_exp2f(s.y);
    const f32x2 m = v * (q * e), r = v - m;
    f32x2 o; o.x = v.x < 0.f ? m.x : r.x; o.y = v.y < 0.f ? m.y : r.y; return o;
}

template <int ACT  > struct EpiBf16 {
    static constexpr bool PERM = true, AFTER_DRAIN = false; static_assert(ACT == 0 || ACT == 1, "EpiBf16: ACT is 0 (none) or 1 (gelu_pk)");
    bf16_t* O; int ldc; const float* bias; int split_cols; size_t split_stride; float scale0;
    __device__ __forceinline__ void operator()(const f32x4 (&acc)[2][2][4][2], const Unit& u, int wr, int wc, int fr, int fq) const {
        const int row0 = u.pm * BM + wr * 64 + fr; int colt = u.pn * BM; bf16_t* base = O;
        float sc = 1.f; if (split_cols) { const int t = colt / split_cols; base += (size_t)t * split_stride; colt -= t * split_cols; if (t == 0) sc = scale0; }
        const int col0 = colt + wc * 32 + 8 * fq, bcol0 = u.pn * BM + wc * 32 + 8 * fq;
        f32x4 bv[2][2];
#pragma unroll
        for (int bj = 0; bj < 2; ++bj)
#pragma unroll
            for (int n = 0; n < 2; ++n) bv[bj][n] = bias ? *(const f32x4*)(bias + bcol0 + bj * HALF + 4 * n) : (f32x4){0.f, 0.f, 0.f, 0.f};
#pragma unroll
        for (int ai = 0; ai < 2; ++ai)
#pragma unroll
            for (int m = 0; m < 4; ++m) { bf16_t* rowp = base + (size_t)(row0 + ai * HALF + m * 16) * ldc + col0;
#pragma unroll
                for (int bj = 0; bj < 2; ++bj) { f32x4 v0 = acc[ai][bj][m][0] + bv[bj][0], v1 = acc[ai][bj][m][1] + bv[bj][1];
                    if (ACT == 1) { f32x2 a = gelu_pk((f32x2){v0[0], v0[1]}), b = gelu_pk((f32x2){v0[2], v0[3]}), c = gelu_pk((f32x2){v1[0], v1[1]}), d = gelu_pk((f32x2){v1[2], v1[3]});
                        v0 = (f32x4){a.x, a.y, b.x, b.y}; v1 = (f32x4){c.x, c.y, d.x, d.y}; }
                    v0 = v0 * sc; v1 = v1 * sc; u32x4 w; w.x = cvt_pk_bf16(v0[0], v0[1]); w.y = cvt_pk_bf16(v0[2], v0[3]); w.z = cvt_pk_bf16(v1[0], v1[1]); w.w = cvt_pk_bf16(v1[2], v1[3]);
                    *(u32x4*)(rowp + bj * HALF) = w; } }
    }
};
template <class Epi, class Sched, bool ALIGN_EPI = false, bool SP2 = false>
__device__ __forceinline__ void gemm_phase(PG8_LAS unsigned char* lds, const Gemm g, const Sched& S, const Epi& E) {
    const int tid = threadIdx.x, wid = __builtin_amdgcn_readfirstlane(tid >> 6), lane = tid & 63, wr = wid >> 2, wc = wid & 3, fr = lane & 15, fq = lane >> 4;
    const int K = g.K, nt = K / BK;
    unsigned voffA[2], voffB[2];
#pragma unroll
    for (int i = 0; i < 2; ++i) { int R, C; stage_rc(tid * 16 + i * 8192, R, C); const int Rb = Epi::PERM ? ((R & ~31) + perm32(R & 31)) : R;
        voffA[i] = (unsigned)(R * K + C) * 2u; voffB[i] = (unsigned)(Rb * K + C) * 2u; }
    const size_t kstep = (size_t)(BK * 2);
    const size_t hstep = (size_t)HALF * K * 2;
    const size_t tstep = 2 * hstep;
    const unsigned ldsw = (unsigned)wid * 1024u;
    const int aoff = lds_byte(wr * 64 + fr, fq * 8), boff = lds_byte(wc * 32 + fr, fq * 8);
#define PG8_SA(b, h) (((b) * 2 + (h)) * HTB)
#define PG8_SB(b, h) ((4 + (b) * 2 + (h)) * HTB)
#define PG8_STAGE(bufoff, gbase, voff) do { _Pragma("unroll") for (int _i = 0; _i < 2; ++_i) \
        __builtin_amdgcn_global_load_lds((const unsigned*)((const char*)(gbase) + (voff)[_i]), (PG8_LAS unsigned*)(lds + (bufoff) + ldsw + _i * 8192), 16, 0, 0); } while (0)
#define PG8_LDA(dst, b, h) do { _Pragma("unroll") for (int m = 0; m < 4; ++m) _Pragma("unroll") for (int k = 0; k < 2; ++k) dst[m][k] = *(const PG8_LAS bf16x8*)(lds + PG8_SA(b, h) + aoff + m * 2048 + k * 1024); } while (0)
#define PG8_LDB(dst, b, h) do { _Pragma("unroll") for (int n = 0; n < 2; ++n) _Pragma("unroll") for (int k = 0; k < 2; ++k) dst[n][k] = *(const PG8_LAS bf16x8*)(lds + PG8_SB(b, h) + boff + n * 2048 + k * 1024); } while (0)
#define PG8_MMA(ai, bj, At, Bt) do { __builtin_amdgcn_s_setprio(1); _Pragma("unroll") for (int m = 0; m < 4; ++m) _Pragma("unroll") for (int n = 0; n < 2; ++n) _Pragma("unroll") for (int k = 0; k < 2; ++k) \
        acc[ai][bj][m][n] = __builtin_amdgcn_mfma_f32_16x16x32_bf16(Bt[n][k], At[m][k], acc[ai][bj][m][n], 0, 0, 0); __builtin_amdgcn_s_setprio(0); } while (0)
#define PG8_WAIT_V(n) asm volatile("s_waitcnt vmcnt(" #n ")" ::: "memory")
#define PG8_WAIT_L(n) asm volatile("s_waitcnt lgkmcnt(" #n ")" ::: "memory")
#define PG8_BAR __builtin_amdgcn_s_barrier()
#define PG8_SCHED __builtin_amdgcn_sched_barrier(0)
    Unit cur, nxt; int ui = 0;
    if (!S.next(0, cur)) return;
    f32x4 acc[2][2][4][2];
#pragma unroll
    for (int a = 0; a < 2; ++a)
#pragma unroll
        for (int b = 0; b < 2; ++b)
#pragma unroll
            for (int m = 0; m < 4; ++m)
#pragma unroll
                for (int n = 0; n < 2; ++n) acc[a][b][m][n] = (f32x4){0.f, 0.f, 0.f, 0.f};
    bf16x8 At[4][2], B0[2][2], B1[2][2];
    const char* cA = (const char*)g.A + (size_t)cur.pm * tstep; const char* cB = (const char*)g.Bt + (size_t)cur.pn * tstep;
    S.a_ready(cur);
    if constexpr (SP2) {
        PG8_STAGE(PG8_SB(0, 0), cB, voffB); PG8_STAGE(PG8_SB(0, 1), cB + hstep, voffB); PG8_STAGE(PG8_SA(0, 0), cA, voffA); PG8_STAGE(PG8_SA(0, 1), cA + hstep, voffA);
        if (wr == 1) PG8_BAR;
        PG8_WAIT_V(2); PG8_BAR;
        PG8_STAGE(PG8_SB(1, 0), cB + kstep, voffB); PG8_STAGE(PG8_SA(1, 0), cA + kstep, voffA); PG8_STAGE(PG8_SB(1, 1), cB + hstep + kstep, voffB);
        PG8_WAIT_V(6); PG8_BAR;
    } else {
        PG8_STAGE(PG8_SB(0, 0), cB, voffB); PG8_STAGE(PG8_SA(0, 0), cA, voffA); PG8_STAGE(PG8_SB(0, 1), cB + hstep, voffB); PG8_STAGE(PG8_SA(0, 1), cA + hstep, voffA);
        if (wr == 1) PG8_BAR;
        PG8_WAIT_V(4); PG8_BAR;
        PG8_STAGE(PG8_SB(1, 0), cB + kstep, voffB); PG8_STAGE(PG8_SA(1, 0), cA + kstep, voffA); PG8_STAGE(PG8_SB(1, 1), cB + hstep + kstep, voffB);
        PG8_WAIT_V(6); PG8_BAR;
    }
    for (;;) {
        const bool has_next = S.next(ui + 1, nxt);
        const char* nA = has_next ? (const char*)g.A + (size_t)nxt.pm * tstep : cA; const char* nB = has_next ? (const char*)g.Bt + (size_t)nxt.pn * tstep : cB;
        for (int t = 0; t < nt; t += 2) {
            const bool last = (t == nt - 2);
            const char* a1 = cA + (size_t)(t + 1) * kstep;
            const char* a2 = last ? nA : cA + (size_t)(t + 2) * kstep; const char* b2 = last ? nB : cB + (size_t)(t + 2) * kstep;
            const char* a3 = a2 + kstep; const char* b3 = b2 + kstep;
            if (last && has_next) S.a_ready(nxt);
            if constexpr (SP2) {
            PG8_LDB(B0, 0, 0); PG8_LDB(B1, 0, 1); PG8_SCHED; PG8_LDA(At, 0, 0); PG8_STAGE(PG8_SA(1, 1), a1 + hstep, voffA);
            PG8_WAIT_V(8); PG8_WAIT_L(0); PG8_BAR; PG8_MMA(0, 0, At, B0); PG8_MMA(0, 1, At, B1); PG8_BAR; PG8_SCHED;
            PG8_LDA(At, 0, 1); PG8_STAGE(PG8_SB(0, 0), b2, voffB); PG8_STAGE(PG8_SB(0, 1), b2 + hstep, voffB); PG8_STAGE(PG8_SA(0, 0), a2, voffA);
            PG8_WAIT_V(8); PG8_WAIT_L(0); PG8_BAR; PG8_MMA(1, 0, At, B0); PG8_MMA(1, 1, At, B1); PG8_BAR; PG8_SCHED;
            PG8_LDB(B0, 1, 0); PG8_LDB(B1, 1, 1); PG8_SCHED; PG8_LDA(At, 1, 0); PG8_STAGE(PG8_SA(0, 1), a2 + hstep, voffA);
            PG8_WAIT_V(8); PG8_WAIT_L(0); PG8_BAR; PG8_MMA(0, 0, At, B0); PG8_MMA(0, 1, At, B1); PG8_BAR; PG8_SCHED;
            PG8_LDA(At, 1, 1); PG8_STAGE(PG8_SB(1, 0), b3, voffB); PG8_STAGE(PG8_SB(1, 1), b3 + hstep, voffB); PG8_STAGE(PG8_SA(1, 0), a3, voffA);
            PG8_WAIT_V(8); PG8_WAIT_L(0); PG8_BAR; PG8_MMA(1, 0, At, B0); PG8_MMA(1, 1, At, B1); PG8_BAR; PG8_SCHED;
            } else {
            PG8_LDB(B0, 0, 0); PG8_SCHED; PG8_LDA(At, 0, 0); PG8_STAGE(PG8_SA(1, 1), a1 + hstep, voffA);
            PG8_WAIT_L(8); PG8_BAR; PG8_WAIT_L(0); PG8_MMA(0, 0, At, B0); PG8_BAR; PG8_SCHED;
            PG8_LDB(B1, 0, 1); PG8_STAGE(PG8_SB(0, 0), b2, voffB);
            PG8_BAR; PG8_WAIT_L(0); PG8_MMA(0, 1, At, B1); PG8_BAR;
            PG8_LDA(At, 0, 1); PG8_STAGE(PG8_SA(0, 0), a2, voffA);
            PG8_BAR; PG8_WAIT_L(0); PG8_MMA(1, 0, At, B0); PG8_BAR; PG8_SCHED;
            PG8_STAGE(PG8_SB(0, 1), b2 + hstep, voffB);
            PG8_WAIT_V(6); PG8_BAR; PG8_MMA(1, 1, At, B1); PG8_BAR;
            PG8_LDB(B0, 1, 0); PG8_SCHED; PG8_LDA(At, 1, 0); PG8_STAGE(PG8_SA(0, 1), a2 + hstep, voffA);
            PG8_WAIT_L(8); PG8_BAR; PG8_WAIT_L(0); PG8_MMA(0, 0, At, B0); PG8_BAR; PG8_SCHED;
            PG8_LDB(B1, 1, 1); PG8_STAGE(PG8_SB(1, 0), b3, voffB);
            PG8_BAR; PG8_WAIT_L(0); PG8_MMA(0, 1, At, B1); PG8_BAR;
            PG8_LDA(At, 1, 1); PG8_STAGE(PG8_SA(1, 0), a3, voffA);
            PG8_BAR; PG8_WAIT_L(0); PG8_MMA(1, 0, At, B0); PG8_BAR; PG8_SCHED;
            PG8_STAGE(PG8_SB(1, 1), b3 + hstep, voffB);
            PG8_WAIT_V(6); PG8_BAR; PG8_MMA(1, 1, At, B1); PG8_BAR;
            }
        }
        if constexpr (ALIGN_EPI) { if (wr == 0) PG8_BAR; }
        if constexpr (!Epi::AFTER_DRAIN) { E(acc, cur, wr, wc, fr, fq); S.done(cur); }
        if (!has_next) break;
#pragma unroll
        for (int a = 0; a < 2; ++a)
#pragma unroll
            for (int b = 0; b < 2; ++b)
#pragma unroll
                for (int m = 0; m < 4; ++m)
#pragma unroll
                    for (int n = 0; n < 2; ++n) acc[a][b][m][n] = (f32x4){0.f, 0.f, 0.f, 0.f};
        cur = nxt; cA = nA; cB = nB; ++ui;
        if constexpr (ALIGN_EPI) { if (wr == 1) PG8_BAR; }
    }
    PG8_WAIT_V(0);
    if constexpr (!ALIGN_EPI) { if (wr == 0) PG8_BAR; }
    PG8_BAR;
    if constexpr (Epi::AFTER_DRAIN) { E.fused(acc, cur, wr, wc, fr, fq, lds, wid, lane); S.done(cur); }
#undef PG8_SA
#undef PG8_SB
#undef PG8_STAGE
#undef PG8_LDA
#undef PG8_LDB
#undef PG8_MMA
#undef PG8_WAIT_V
#undef PG8_WAIT_L
#undef PG8_BAR
#undef PG8_SCHED
}
}
namespace pg8 {
__device__ __forceinline__ unsigned f2bf_(float f) { unsigned u = __builtin_bit_cast(unsigned, f); return (u + 0x7fffu + ((u >> 16) & 1u)) >> 16; }
struct EpiF32Res {
    static constexpr bool PERM = false, AFTER_DRAIN = false;
    const float* xp; float* out; bf16_t* outb; float* ssq; int ldc;
    __device__ __forceinline__ void operator()(const f32x4 (&acc)[2][2][4][2], const Unit& u, int wr, int wc, int fr, int fq) const {
        const int col0 = u.pn * BM + wc * 32 + 4 * fq;
#pragma unroll
        for (int ai = 0; ai < 2; ++ai)
#pragma unroll
            for (int m = 0; m < 4; ++m) {
                const int row = u.pm * BM + ai * HALF + wr * 64 + m * 16 + fr;
                const float* src = xp + (size_t)row * ldc; float* dst = out + (size_t)row * ldc; bf16_t* dstb = outb + (size_t)row * ldc;
                float s = 0.f;
#pragma unroll
                for (int bj = 0; bj < 2; ++bj)
#pragma unroll
                    for (int n = 0; n < 2; ++n) { const int c = col0 + bj * HALF + n * 16; const f32x4 v = *(const f32x4*)(src + c) + acc[ai][bj][m][n]; *(f32x4*)(dst + c) = v;
                        s += (v[0] * v[0] + v[1] * v[1]) + (v[2] * v[2] + v[3] * v[3]);
                        unsigned w0 = f2bf_(v[0]) | (f2bf_(v[1]) << 16), w1 = f2bf_(v[2]) | (f2bf_(v[3]) << 16);
                        typedef unsigned u32x2 __attribute__((ext_vector_type(2))); *(u32x2*)(dstb + c) = (u32x2){w0, w1}; }
                s += __shfl_xor(s, 16); s += __shfl_xor(s, 32);
                if (fq == 0) ssq[(size_t)row * 32 + u.pn * 4 + wc] = s;
            }
    }
};
struct EpiBf16RowScale {
    static constexpr bool PERM = true, AFTER_DRAIN = false;
    bf16_t* O; int ldc; const float* rs;
    __device__ __forceinline__ void operator()(const f32x4 (&acc)[2][2][4][2], const Unit& u, int wr, int wc, int fr, int fq) const {
        const int row0 = u.pm * BM + wr * 64 + fr, col0 = u.pn * BM + wc * 32 + 8 * fq;
#pragma unroll
        for (int ai = 0; ai < 2; ++ai)
#pragma unroll
            for (int m = 0; m < 4; ++m) { const int rl = wr * 64 + fr + ai * HALF + m * 16; const float sc = rs[rl]; bf16_t* rowp = O + (size_t)(row0 + ai * HALF + m * 16) * ldc + col0;
#pragma unroll
                for (int bj = 0; bj < 2; ++bj) { const f32x4 v0 = acc[ai][bj][m][0] * sc, v1 = acc[ai][bj][m][1] * sc;
                    u32x4 w; w.x = cvt_pk_bf16(v0[0], v0[1]); w.y = cvt_pk_bf16(v0[2], v0[3]); w.z = cvt_pk_bf16(v1[0], v1[1]); w.w = cvt_pk_bf16(v1[2], v1[3]);
                    *(u32x4*)(rowp + bj * HALF) = w; } }
    }
};
}

#ifndef MK_N_LAUNCHES
#define MK_N_LAUNCHES 1
#endif
constexpr int N_PHASES = 9;
constexpr int N_LAUNCHES = MK_N_LAUNCHES;
constexpr int NWAVES = 8;

constexpr int DM = 2048;
constexpr int TP = 8192, TS = 128, TT = TP + TS;
constexpr int MP = 8448;
constexpr int NP = 16384;
constexpr int PLD = NP + 64;
constexpr int C_Q = 0, C_K = 1024, C_V = 2048, C_R = 4096, C_CB = 6144, C_CC = 8192, C_CX = 10240, C_GA = 12288, C_GB = 14336;
constexpr int DIN = 16400;
constexpr int NEXP = 16384;
constexpr float EPS = 1e-6f;

constexpr size_t MiB = 1u << 20;
constexpr size_t WS_CTL = 0, CTL_ZERO_BYTES = 1 * MiB;
constexpr size_t WS_WINT = 2 * MiB;
constexpr size_t WS_WOUTT = 68 * MiB;
constexpr size_t WS_WQT = 76 * MiB;
constexpr size_t WS_EU = 84 * MiB;
constexpr size_t WS_EV = 148 * MiB;
constexpr size_t WS_XN = 212 * MiB;
constexpr size_t WS_P = 246 * MiB;
constexpr size_t WS_QT = 516 * MiB;
constexpr size_t WS_KT = 532 * MiB;
constexpr size_t WS_VT = 548 * MiB;
constexpr size_t WS_ATT = 580 * MiB;
constexpr size_t WS_EBL = 584 * MiB;
constexpr size_t WS_SKB = 585 * MiB;
constexpr size_t WS_O = 586 * MiB;
constexpr size_t WS_MM = 620 * MiB;
constexpr size_t WS_X2 = 654 * MiB;
constexpr size_t WS_H2 = 720 * MiB;
constexpr size_t WS_SSQ = 799 * MiB;
constexpr size_t WS_QP = 754 * MiB;
constexpr size_t WS_IDX = 788 * MiB;
constexpr size_t WS_GW = 793 * MiB;
constexpr size_t WS_ALR = 798 * MiB;
constexpr size_t WS_SSQS = 799 * MiB + 1100 * 1024;
constexpr size_t WS_RS2 = 799 * MiB + 1200 * 1024;
constexpr size_t WS_END = 801 * MiB;
constexpr int CW_TMO = 0, CW_CODE = 1, CW_BAR = 4096, CW_QUEUE = 16384;

constexpr size_t OUT_Y = 0;
constexpr size_t OUT_GLAP = (size_t)TT * DM;
constexpr size_t OUT_CONVP = OUT_GLAP + (size_t)4 * 4 * 256 * 512;
constexpr size_t OUT_GLAS = OUT_CONVP + (size_t)4 * 2 * 2048;
constexpr size_t OUT_CONVS = OUT_GLAS + (size_t)128 * 4 * 256 * 512;

constexpr int LDS_BYTES = 163840;
constexpr int LDSCTL_OFF = 162816, MISC_OFF = LDSCTL_OFF + 320;
constexpr int RING_OFF = 0;

#define GAS __attribute__((address_space(1)))
#define LAS __attribute__((address_space(3)))
typedef unsigned short bf16;
typedef unsigned v4u __attribute__((ext_vector_type(4)));
typedef unsigned v2u __attribute__((ext_vector_type(2)));
typedef float f32x4 __attribute__((ext_vector_type(4)));
typedef short bf16x8 __attribute__((ext_vector_type(8)));
typedef GAS unsigned gu32;
typedef float v32f __attribute__((ext_vector_type(32)));
typedef float v16f __attribute__((ext_vector_type(16)));
typedef unsigned v6u __attribute__((ext_vector_type(6)));
constexpr int ROW6 = 1536;
#define RLX_AGENT __ATOMIC_RELAXED, __HIP_MEMORY_SCOPE_AGENT
#define LDS_WAIT() asm volatile("s_waitcnt lgkmcnt(0)" ::: "memory")
#define VM_WAIT() asm volatile("s_waitcnt vmcnt(0)" ::: "memory")
#define MFMA16(a, b, c) __builtin_amdgcn_mfma_f32_16x16x32_bf16((a), (b), (c), 0, 0, 0)
__device__ __forceinline__ unsigned f2bf(float f) { unsigned u = __builtin_bit_cast(unsigned, f); return (u + 0x7fffu + ((u >> 16) & 1u)) >> 16; }
__device__ __forceinline__ unsigned pk2(float lo, float hi) { return f2bf(lo) | (f2bf(hi) << 16); }
__device__ __forceinline__ float bf2f(unsigned b) { return __builtin_bit_cast(float, b << 16); }
__device__ __forceinline__ float bflo(unsigned w) { return __builtin_bit_cast(float, w << 16); }
__device__ __forceinline__ float bfhi(unsigned w) { return __builtin_bit_cast(float, w & 0xffff0000u); }
__device__ __forceinline__ void unpack8(const v4u w, float (&f)[8]) { f[0] = bflo(w.x); f[1] = bfhi(w.x); f[2] = bflo(w.y); f[3] = bfhi(w.y); f[4] = bflo(w.z); f[5] = bfhi(w.z); f[6] = bflo(w.w); f[7] = bfhi(w.w); }
__device__ __forceinline__ v4u pack8(const float (&f)[8]) { v4u w; w.x = pk2(f[0], f[1]); w.y = pk2(f[2], f[3]); w.z = pk2(f[4], f[5]); w.w = pk2(f[6], f[7]); return w; }
__device__ __forceinline__ float wave_sum(float v) {
#pragma unroll
    for (int o = 1; o < 64; o <<= 1) v += __shfl_xor(v, o);
    return v;
}
__device__ __forceinline__ float sigmoidf_(float x) { return 1.0f / (1.0f + __expf(-x)); }
#define XB_TMO      128
#define XB_XCNT(j)  (256  + 64 * (j))
#define XB_XSUB(j)  (1280 + 64 * (j))
#define XB_XGEN(j)  (2304 + 64 * (j))
#define XB_TOP      3328
#define XB_TOPGEN   3392
#define XCD_BAR_WORDS 3456
#define XB_SPIN_CAP (1u << 18)

__device__ __forceinline__ unsigned xb_ld(unsigned* p)              { return __hip_atomic_load(p, __ATOMIC_RELAXED, __HIP_MEMORY_SCOPE_AGENT); }
__device__ __forceinline__ unsigned xb_add(unsigned* p, unsigned v) { return __hip_atomic_fetch_add(p, v, __ATOMIC_RELAXED, __HIP_MEMORY_SCOPE_AGENT); }
__device__ __forceinline__ unsigned xb_xcc_id() { return (unsigned)__builtin_amdgcn_s_getreg((3 << 11) | 20) & 0xFu; }
#define XB_SPIN(cond, bar) do { unsigned _sp = 0; while (cond) { __builtin_amdgcn_s_sleep(1); \
    if ((++_sp & 255u) == 0u) { if (xb_ld(&(bar)[XB_TMO])) break; if (_sp > XB_SPIN_CAP) { atomicAdd(&(bar)[XB_TMO], 1u); break; } } } } while (0)

struct XcdBarrier {
    unsigned* bar; unsigned x;
    volatile LAS unsigned* st;
};

__device__ __forceinline__ XcdBarrier xcd_barrier_post(unsigned* bar, volatile LAS unsigned* st) {
    XcdBarrier b; b.bar = bar; b.x = xb_xcc_id(); b.st = st;
    if (threadIdx.x == 0) (void)xb_add(&bar[XB_XCNT(b.x)], 1u);
    return b;
}
__device__ __forceinline__ void xcd_barrier_complete(unsigned* bar, unsigned x, unsigned& nloc, unsigned& nx) {
    const unsigned G = gridDim.x * gridDim.y * gridDim.z;
    unsigned sum, cnt, mine, sp = 0u;
    for (;;) {
        sum = 0u; cnt = 0u; mine = 0u;
#pragma unroll
        for (unsigned j = 0; j < 16; ++j) { const unsigned c = xb_ld(&bar[XB_XCNT(j)]); sum += c; cnt += (c > 0u) ? 1u : 0u; mine = (j == x) ? c : mine; }
        if (sum == G) break;
        __builtin_amdgcn_s_sleep(1);
        if ((++sp & 255u) == 0u) { if (xb_ld(&bar[XB_TMO])) break; if (sp > XB_SPIN_CAP) { atomicAdd(&bar[XB_TMO], 1u); break; } }
    }
    nloc = mine > 0u ? mine : 1u; nx = cnt > 0u ? cnt : 1u;
}

__device__ __forceinline__ void xcd_barrier(const XcdBarrier& b) {
    asm volatile("s_waitcnt vmcnt(0)" ::: "memory");
    __syncthreads();
    if (threadIdx.x == 0) {
        unsigned* bar = b.bar;
        __builtin_amdgcn_s_waitcnt(0);
        unsigned nloc = b.st[0], nx = b.st[1];
        if (nloc == 0u) { xcd_barrier_complete(bar, b.x, nloc, nx); b.st[0] = nloc; b.st[1] = nx; }
        const unsigned old = xb_add(&bar[XB_XSUB(b.x)], 1u);
        const unsigned gen = old / nloc;
        if (old + 1u == (gen + 1u) * nloc) {
            __builtin_amdgcn_fence(__ATOMIC_RELEASE, "agent");
            asm volatile("s_waitcnt vmcnt(0)" ::: "memory");
            const unsigned og = xb_add(&bar[XB_TOP], 1u);
            const unsigned tg = og / nx;
            if (og + 1u == (tg + 1u) * nx) xb_add(&bar[XB_TOPGEN], 1u);
            else XB_SPIN(xb_ld(&bar[XB_TOPGEN]) == tg, bar);
            __builtin_amdgcn_fence(__ATOMIC_ACQUIRE, "agent");
            xb_add(&bar[XB_XGEN(b.x)], 1u);
            asm volatile("s_waitcnt vmcnt(0)" ::: "memory");
        } else {
            XB_SPIN(xb_ld(&bar[XB_XGEN(b.x)]) == gen, bar);
            __builtin_amdgcn_fence(__ATOMIC_ACQUIRE, "agent");
            asm volatile("s_waitcnt vmcnt(0)" ::: "memory");
        }
    }
    __syncthreads();
}
struct Frame {
    unsigned char* lds;
    int tid, lane, wave, vcu, G;
    const float *xp, *xs, *sgla, *sconv, *n1g, *win, *wau, *bal, *gng, *cw, *cb, *wout, *n2g, *wq, *sk, *eu, *ev, *nfg;
    float* out;
    unsigned char* ws;
};

__device__ __forceinline__ void p0_transpose_item(const float* W, int ldw, int src_col0, int k0, bf16* WT, int K, int dst_row0, float* scr, int lane, const float* kscale = nullptr) {
#pragma unroll 8
    for (int i = 0; i < 32; ++i) { const int kk = 2 * i + (lane >> 5); scr[kk * 33 + (lane & 31)] = W[(size_t)(k0 + kk) * ldw + src_col0 + (lane & 31)] * (kscale ? kscale[k0 + kk] : 1.0f); }
    LDS_WAIT(); asm volatile("" ::: "memory");
    const int c = lane & 7;
#pragma unroll
    for (int j = 0; j < 4; ++j) { const int n = (lane >> 3) + 8 * j; const float* s = scr + (8 * c) * 33 + n;
        v4u o; o.x = pk2(s[0 * 33], s[1 * 33]); o.y = pk2(s[2 * 33], s[3 * 33]); o.z = pk2(s[4 * 33], s[5 * 33]); o.w = pk2(s[6 * 33], s[7 * 33]);
        *(v4u*)(WT + (size_t)(dst_row0 + n) * K + k0 + 8 * c) = o; }
    LDS_WAIT(); asm volatile("" ::: "memory");
}
__device__ __forceinline__ void rms_row_to_bf16(const float* xrow, const float* g, bf16* orow, int lane) {
    const f32x4* xr = (const f32x4*)xrow + lane; const f32x4* gr = (const f32x4*)g + lane;
    f32x4 v[8]; float s = 0.f;
#pragma unroll
    for (int j = 0; j < 8; ++j) { v[j] = xr[64 * j]; s += (v[j].x * v[j].x + v[j].y * v[j].y) + (v[j].z * v[j].z + v[j].w * v[j].w); }
    const float rstd = 1.0f / sqrtf(wave_sum(s) * (1.0f / DM) + EPS);
    v2u* o8 = (v2u*)orow + lane;
#pragma unroll
    for (int j = 0; j < 8; ++j) { const f32x4 gg = gr[64 * j]; v2u w; w.x = pk2(v[j].x * rstd * gg.x, v[j].y * rstd * gg.y); w.y = pk2(v[j].z * rstd * gg.z, v[j].w * rstd * gg.w); o8[64 * j] = w; }
}
__device__ __forceinline__ void zero_row_bf16(bf16* orow, int lane) {
    v2u* o8 = (v2u*)orow + lane; const v2u z = {0u, 0u};
#pragma unroll
    for (int j = 0; j < 8; ++j) o8[64 * j] = z;
}
__device__ __forceinline__ void p0_prologue(Frame& F) {
    bf16* WINT = (bf16*)(F.ws + WS_WINT); bf16* WOUTT = (bf16*)(F.ws + WS_WOUTT); bf16* WQT = (bf16*)(F.ws + WS_WQT);
    float* scr = (float*)(F.lds + F.wave * 8448);
    const int gw = F.vcu * NWAVES + F.wave, NGW = F.G * NWAVES;
    constexpr int I_IN = 32 * 512, I_SQ = 32 * 64;
    for (int it = gw; it < I_IN + 2 * I_SQ; it += NGW) {
        int r = it;
        if (r < I_IN) { const int kb = r >> 9, nb = r & 511, n0 = 32 * nb; p0_transpose_item(F.win, DIN, n0 + (n0 >= 6144 ? 16 : 0), 64 * kb, WINT, DM, n0, scr, F.lane); continue; }
        r -= I_IN;
        if (r < I_SQ) { const int kb = r >> 6, nb = r & 63; p0_transpose_item(F.wout, DM, 32 * nb, 64 * kb, WOUTT, DM, 32 * nb, scr, F.lane); continue; }
        r -= I_SQ;
        { const int kb = r >> 6, nb = r & 63; p0_transpose_item(F.wq, DM, 32 * nb, 64 * kb, WQT, DM, 32 * nb, scr, F.lane, F.n2g); }
    }
    const size_t gt = (size_t)F.vcu * 512 + F.tid, NGT = (size_t)F.G * 512;
    { bf16* SKB = (bf16*)(F.ws + WS_SKB); for (size_t e = gt; e < (size_t)2 * 128 * 128; e += NGT) SKB[e] = (bf16)f2bf(F.sk[e]); }
    { unsigned char* U6 = F.ws + WS_EU; unsigned char* V6 = F.ws + WS_EV; float* SU = (float*)(F.ws + WS_EU + 32 * MiB); float* SV = (float*)(F.ws + WS_EV + 32 * MiB);
      for (int r = gw; r < 2 * NEXP; r += NGW) {
          const bool isv = r >= NEXP; const int row = isv ? r - NEXP : r;
          const float* src = (isv ? F.ev : F.eu) + (size_t)row * DM;
          f32x4 x[8]; float amax = 0.f;
#pragma unroll
          for (int j = 0; j < 8; ++j) { x[j] = *(const f32x4*)(src + 256 * j + 4 * F.lane); if (!isv) x[j] = x[j] * *(const f32x4*)(F.n2g + 256 * j + 4 * F.lane);
              amax = fmaxf(amax, fmaxf(fmaxf(fabsf(x[j].x), fabsf(x[j].y)), fmaxf(fabsf(x[j].z), fabsf(x[j].w)))); }
#pragma unroll
          for (int o = 1; o < 64; o <<= 1) amax = fmaxf(amax, __shfl_xor(amax, o));
          const float sc = amax > 0.f ? 7.5f / amax : 1.0f;
          v16f pa, pb;
#pragma unroll
          for (int j = 0; j < 8; ++j) { pa[2 * j] = x[j].x * sc; pb[2 * j] = x[j].y * sc; pa[2 * j + 1] = x[j].z * sc; pb[2 * j + 1] = x[j].w * sc; }
          const v6u p = __builtin_amdgcn_cvt_scalef32_2xpk16_fp6_f32(pa, pb, 1.0f);
          unsigned char* dst = (isv ? V6 : U6) + (size_t)row * ROW6 + 8 * F.lane;
          *(v2u*)(dst) = (v2u){p[0], p[1]}; *(v2u*)(dst + 512) = (v2u){p[2], p[3]}; *(v2u*)(dst + 1024) = (v2u){p[4], p[5]};
          if (F.lane == 0) (isv ? SV : SU)[row] = amax > 0.f ? amax / 7.5f : 1.0f;
      } }
    __syncthreads();
    { bf16* wt_s = (bf16*)F.lds; constexpr int WLD = DM + 8;
      for (int k = F.tid; k < DM; k += 512) { const float* src = F.win + (size_t)k * DIN + 6144;
#pragma unroll
          for (int q = 0; q < 4; ++q) { const f32x4 w4 = *(const f32x4*)(src + 4 * q); wt_s[(4 * q + 0) * WLD + k] = (bf16)f2bf(w4.x); wt_s[(4 * q + 1) * WLD + k] = (bf16)f2bf(w4.y); wt_s[(4 * q + 2) * WLD + k] = (bf16)f2bf(w4.z); wt_s[(4 * q + 3) * WLD + k] = (bf16)f2bf(w4.w); } }
      bf16* XN = (bf16*)(F.ws + WS_XN); float* ALR = (float*)(F.ws + WS_ALR);
      const int r0 = (int)(((long)F.vcu * TT) / F.G), r1 = (int)(((long)(F.vcu + 1) * TT) / F.G);
      for (int m = r0 + F.wave; m < r1; m += NWAVES) rms_row_to_bf16(m < TP ? F.xp + (size_t)m * DM : F.xs + (size_t)(m - TP) * DM, F.n1g, XN + (size_t)m * DM, F.lane);
      for (int m = TT + gw; m < MP; m += NGW) zero_row_bf16(XN + (size_t)m * DM, F.lane);
      VM_WAIT(); __syncthreads();
      const int l15 = F.lane & 15, lq = F.lane >> 4;
      for (int t0 = r0 + 16 * F.wave; t0 < r1; t0 += 16 * NWAVES) {
          const int row = min(t0 + l15, r1 - 1);
          f32x4 acc = {0.f, 0.f, 0.f, 0.f};
#pragma unroll 8
          for (int ks = 0; ks < 64; ++ks) { const bf16x8 a = *(const bf16x8*)(XN + (size_t)row * DM + 32 * ks + 8 * lq); const bf16x8 bq = *(const bf16x8*)(wt_s + l15 * WLD + 32 * ks + 8 * lq); acc = MFMA16(a, bq, acc); }
#pragma unroll
          for (int r = 0; r < 4; ++r) { const int m = t0 + 4 * lq + r; if (m < r1) ALR[(size_t)m * 16 + l15] = acc[r]; }
      } }
}

template <int NT, class Epi>
__device__ __forceinline__ void skinny_gemm(Frame& F, const bf16* A, const bf16* Bt, int n0, const Epi& E) {
    constexpr int ROWS = NT * 16, NPC = (ROWS * 32 + 511) / 512, BLD = 264;
    bf16* Bs = (bf16*)F.lds;
    const int tid = F.tid, wv = F.wave, l15 = F.lane & 15, lq = F.lane >> 4;
    f32x4 acc[NT];
#pragma unroll
    for (int nt = 0; nt < NT; ++nt) acc[nt] = (f32x4){0.f, 0.f, 0.f, 0.f};
    v4u breg[NPC];
#pragma unroll
    for (int i = 0; i < NPC; ++i) { const int p = tid + 512 * i; if (p < ROWS * 32) breg[i] = *(const v4u*)(Bt + (size_t)(n0 + (p >> 5)) * DM + 8 * (p & 31)); }
#pragma unroll
    for (int i = 0; i < NPC; ++i) { const int p = tid + 512 * i; if (p < ROWS * 32) *(v4u*)(Bs + (p >> 5) * BLD + 8 * (p & 31)) = breg[i]; }
    __syncthreads();
    const bf16* Arow = A + (size_t)(16 * wv + l15) * DM + 8 * lq;
    bf16x8 a[8], an[8];
#pragma unroll
    for (int ks = 0; ks < 8; ++ks) a[ks] = *(const bf16x8*)(Arow + 32 * ks);
#pragma unroll 1
    for (int kc = 0; kc < 8; ++kc) {
        if (kc < 7) {
#pragma unroll
            for (int i = 0; i < NPC; ++i) { const int p = tid + 512 * i; if (p < ROWS * 32) breg[i] = *(const v4u*)(Bt + (size_t)(n0 + (p >> 5)) * DM + (kc + 1) * 256 + 8 * (p & 31)); }
#pragma unroll
            for (int ks = 0; ks < 8; ++ks) an[ks] = *(const bf16x8*)(Arow + (kc + 1) * 256 + 32 * ks); }
        const bf16* Bc = Bs + (kc & 1) * ROWS * BLD;
#pragma unroll
        for (int ks = 0; ks < 8; ++ks)
#pragma unroll
            for (int nt = 0; nt < NT; ++nt) { const bf16x8 bq = *(const bf16x8*)(Bc + (16 * nt + l15) * BLD + 32 * ks + 8 * lq); acc[nt] = MFMA16(a[ks], bq, acc[nt]); }
        if (kc < 7) { bf16* Bn = Bs + ((kc + 1) & 1) * ROWS * BLD;
#pragma unroll
            for (int i = 0; i < NPC; ++i) { const int p = tid + 512 * i; if (p < ROWS * 32) *(v4u*)(Bn + (p >> 5) * BLD + 8 * (p & 31)) = breg[i]; }
#pragma unroll
            for (int ks = 0; ks < 8; ++ks) a[ks] = an[ks]; }
        __syncthreads();
    }
    E.template tile<NT>(acc, wv, l15, lq, n0);
}
struct EpiSkBf16 { bf16* out; int ldc; const float* rs;
    template <int NT> __device__ __forceinline__ void tile(const f32x4 (&acc)[NT], int wv, int l15, int lq, int n0) const {
#pragma unroll
        for (int r = 0; r < 4; ++r) { const int row = 16 * wv + 4 * lq + r; const float sc = rs ? rs[row] : 1.0f;
#pragma unroll
            for (int nt = 0; nt < NT; ++nt) out[(size_t)row * ldc + n0 + 16 * nt + l15] = (bf16)f2bf(acc[nt][r] * sc); } } };
struct EpiSkF32Res { const float* xs; float* out; bf16* outb; float* ssqs;
    template <int NT> __device__ __forceinline__ void tile(const f32x4 (&acc)[NT], int wv, int l15, int lq, int n0) const {
        static_assert(NT == 1, "one 16-column group");
#pragma unroll
        for (int r = 0; r < 4; ++r) { const int row = 16 * wv + 4 * lq + r; const size_t o = (size_t)row * DM + n0 + l15; const float v = xs[o] + acc[0][r]; out[o] = v; outb[o] = (bf16)f2bf(v);
            float s = v * v; s += __shfl_xor(s, 1); s += __shfl_xor(s, 2); s += __shfl_xor(s, 4); s += __shfl_xor(s, 8);
            if (l15 == 0) ssqs[row * 128 + (n0 >> 4)] = s; } } };

__device__ __forceinline__ float logsig(float x) { return fminf(x, 0.f) - __logf(1.0f + __expf(-fabsf(x))); }
__device__ __forceinline__ void gla_prep_unit(Frame& F, int u) {
    const bf16* P = (const bf16*)(F.ws + WS_P); bf16* QT = (bf16*)(F.ws + WS_QT); bf16* KT = (bf16*)(F.ws + WS_KT); bf16* VT = (bf16*)(F.ws + WS_VT);
    bf16* ATT = (bf16*)(F.ws + WS_ATT); float* EBL = (float*)(F.ws + WS_EBL);
    const int b = u >> 7, h = (u >> 5) & 3, c = u & 31, tid = F.tid;
    const int row0 = b * 2048 + c * 64;
    float* alr_s = (float*)F.lds;
    float* tot_s = (float*)(F.lds + 4096);
    bf16* q_s = (bf16*)(F.lds + 8192);
    bf16* k_s = q_s + 64 * 264;
    bf16* v_s = k_s + 64 * 264;
    { v4u tq[4], tk[4], tv[8];
#pragma unroll
      for (int i = 0; i < 4; ++i) { const int p = tid + 512 * i, row = p >> 5, ch = p & 31; const bf16* src = P + (size_t)(row0 + row) * PLD + h * 256 + 8 * ch; tq[i] = *(const v4u*)(src + C_Q); tk[i] = *(const v4u*)(src + C_K); }
#pragma unroll
      for (int i = 0; i < 8; ++i) { const int p = tid + 512 * i, row = p >> 6, ch = p & 63; tv[i] = *(const v4u*)(P + (size_t)(row0 + row) * PLD + C_V + h * 512 + 8 * ch); }
      for (int e = tid; e < 1024; e += 512) alr_s[e] = ((const float*)(F.ws + WS_ALR))[(size_t)row0 * 16 + e];
#pragma unroll
      for (int i = 0; i < 4; ++i) { const int p = tid + 512 * i, row = p >> 5, ch = p & 31; *(v4u*)(q_s + row * 264 + 8 * ch) = tq[i]; *(v4u*)(k_s + row * 264 + 8 * ch) = tk[i]; }
#pragma unroll
      for (int i = 0; i < 8; ++i) { const int p = tid + 512 * i, row = p >> 6, ch = p & 63; *(v4u*)(v_s + row * 520 + 8 * ch) = tv[i]; } }
    const int d = tid & 255, half = tid >> 8;
    float w[16];
#pragma unroll
    for (int r = 0; r < 16; ++r) w[r] = F.wau[r * 1024 + h * 256 + d];
    const float bias = F.bal[h * 256 + d];
    __syncthreads();
    float bb[32]; float run = 0.f;
#pragma unroll
    for (int jj = 0; jj < 32; ++jj) { const int j = half * 32 + jj; float x = bias;
#pragma unroll
        for (int r = 0; r < 16; ++r) x += alr_s[j * 16 + r] * w[r];
        run += logsig(x) * 0.0625f; bb[jj] = run; }
    if (half == 0) tot_s[d] = run;
    __syncthreads();
    if (half == 1) { const float t = tot_s[d];
#pragma unroll
        for (int jj = 0; jj < 32; ++jj) bb[jj] += t; }
    unsigned ktp[16];
#pragma unroll
    for (int jj = 0; jj < 32; ++jj) { const int j = half * 32 + jj;
        const float qv = bf2f(q_s[j * 264 + d]), kv = bf2f(k_s[j * 264 + d]);
        const float e = __expf(bb[jj]), ei = __expf(-bb[jj]);
        const unsigned qb = f2bf(qv * 0.0625f * e), kb = f2bf(kv * ei);
        q_s[j * 264 + d] = (bf16)qb; k_s[j * 264 + d] = (bf16)kb;
        if (jj & 1) ktp[jj >> 1] |= kb << 16; else ktp[jj >> 1] = kb; }
    { v4u* dst = (v4u*)(KT + ((size_t)u * 256 + d) * 64 + half * 32);
#pragma unroll
      for (int i = 0; i < 4; ++i) { v4u o; o.x = ktp[4 * i]; o.y = ktp[4 * i + 1]; o.z = ktp[4 * i + 2]; o.w = ktp[4 * i + 3]; dst[i] = o; } }
    if (half == 1) EBL[u * 256 + d] = __expf(bb[31]);
    __syncthreads();
#pragma unroll
    for (int i = 0; i < 4; ++i) { const int p = tid + 512 * i, row = p >> 5, ch = p & 31; *(v4u*)(QT + (size_t)(row0 + row) * 1024 + h * 256 + 8 * ch) = *(const v4u*)(q_s + row * 264 + 8 * ch); }
    { const int wv = F.wave, l15 = F.lane & 15, lq = F.lane >> 4, mi = wv >> 1;
#pragma unroll
      for (int nn = 0; nn < 2; ++nn) { const int ni = (wv & 1) * 2 + nn; f32x4 acc = {0.f, 0.f, 0.f, 0.f};
#pragma unroll
          for (int ks = 0; ks < 8; ++ks) { const bf16x8 a = *(const bf16x8*)(q_s + (16 * mi + l15) * 264 + 32 * ks + 8 * lq); const bf16x8 bq = *(const bf16x8*)(k_s + (16 * ni + l15) * 264 + 32 * ks + 8 * lq); acc = MFMA16(a, bq, acc); }
#pragma unroll
          for (int r = 0; r < 4; ++r) { const int i = 16 * mi + 4 * lq + r, jn = 16 * ni + l15; ATT[(size_t)u * 4096 + i * 64 + jn] = (bf16)f2bf(jn <= i ? acc[r] : 0.f); } } }
    { const int dv = tid; unsigned vp[32];
#pragma unroll
      for (int j = 0; j < 64; ++j) { const unsigned v = v_s[j * 520 + dv]; if (j & 1) vp[j >> 1] |= v << 16; else vp[j >> 1] = v; }
      v4u* dst = (v4u*)(VT + ((size_t)u * 512 + dv) * 64);
#pragma unroll
      for (int i = 0; i < 8; ++i) { v4u o; o.x = vp[4 * i]; o.y = vp[4 * i + 1]; o.z = vp[4 * i + 2]; o.w = vp[4 * i + 3]; dst[i] = o; } }
    __syncthreads();
}

__device__ __forceinline__ void gla_sample_unit(Frame& F, int u) {
    const bf16* P = (const bf16*)(F.ws + WS_P); bf16* O = (bf16*)(F.ws + WS_O);
    const int n = u >> 2, h = u & 3, tid = F.tid, lane = F.lane, wv = F.wave;
    const size_t m = (size_t)(TP + n);
    float* e_s = (float*)F.lds;
    float* qe_s = e_s + 256;
    float* k_s = qe_s + 256;
    float* v_s = k_s + 256;
    float* red_s = v_s + 512;
    float* op_s = red_s + 64;
    float part = 0.f;
    if (tid < 256) { const int d = tid; float x = F.bal[h * 256 + d];
#pragma unroll
        for (int r = 0; r < 16; ++r) x += ((const float*)(F.ws + WS_ALR))[m * 16 + r] * F.wau[r * 1024 + h * 256 + d];
        const float la = logsig(x) * 0.0625f, e = __expf(la);
        const float q = bf2f(P[m * PLD + C_Q + h * 256 + d]) * 0.0625f, k = bf2f(P[m * PLD + C_K + h * 256 + d]);
        e_s[d] = e; qe_s[d] = q * e; k_s[d] = k; part = q * k; }
    v_s[tid] = bf2f(P[m * PLD + C_V + h * 512 + tid]);
    part = wave_sum(part);
    if (lane == 0) red_s[wv] = part;
    __syncthreads();
    const float attn = (red_s[0] + red_s[1]) + (red_s[2] + red_s[3]);
    const float* Sin = F.sgla + ((size_t)(n * 4 + h) * 256) * 512; float* Sout = F.out + OUT_GLAS + ((size_t)(n * 4 + h) * 256) * 512;
    const f32x4 v0 = *(const f32x4*)(v_s + 4 * lane), v1 = *(const f32x4*)(v_s + 256 + 4 * lane);
    f32x4 o0 = {0.f, 0.f, 0.f, 0.f}, o1 = {0.f, 0.f, 0.f, 0.f};
#pragma unroll 1
    for (int g = 0; g < 4; ++g) {
        f32x4 s0[8], s1[8];
#pragma unroll
        for (int i = 0; i < 8; ++i) { const int d = 32 * wv + 8 * g + i; s0[i] = *(const f32x4*)(Sin + (size_t)d * 512 + 4 * lane); s1[i] = *(const f32x4*)(Sin + (size_t)d * 512 + 256 + 4 * lane); }
#pragma unroll
        for (int i = 0; i < 8; ++i) { const int d = 32 * wv + 8 * g + i; const float e = e_s[d], qe = qe_s[d], k = k_s[d];
            o0 += s0[i] * qe; o1 += s1[i] * qe;
            *(f32x4*)(Sout + (size_t)d * 512 + 4 * lane) = s0[i] * e + v0 * k; *(f32x4*)(Sout + (size_t)d * 512 + 256 + 4 * lane) = s1[i] * e + v1 * k; }
    }
    *(f32x4*)(op_s + wv * 512 + 4 * lane) = o0; *(f32x4*)(op_s + wv * 512 + 256 + 4 * lane) = o1;
    __syncthreads();
    { float o = attn * v_s[tid];
#pragma unroll
      for (int w8 = 0; w8 < 8; ++w8) o += op_s[w8 * 512 + tid];
      O[m * DM + h * 512 + tid] = (bf16)f2bf(o); }
    __syncthreads();
}

struct GlaRegs { bf16x8 kt[2][2], at, q[4]; f32x4 eb[2]; v4u vpiece; };
template <int NT>
__device__ __forceinline__ void gla_load(GlaRegs& R, const bf16* QT, const bf16* KT, const bf16* VT, const bf16* ATT, const float* EBL, int bh, int s, int c, int wv, int l15, int lq, int tid) {
    const size_t u = (size_t)bh * 32 + c; const int b = bh >> 2, h = bh & 3, mi = wv >> 1, kh = wv & 1;
    R.at = *(const bf16x8*)(ATT + u * 4096 + (16 * mi + l15) * 64 + 32 * kh + 8 * lq);
    { const int tv = tid & (NT * 128 - 1); R.vpiece = *(const v4u*)(VT + (u * 512 + 16 * NT * s + (tv >> 3)) * 64 + 8 * (tv & 7)); }
#pragma unroll
    for (int ks = 0; ks < 4; ++ks) R.q[ks] = *(const bf16x8*)(QT + ((size_t)b * 2048 + 64 * c + 16 * mi + l15) * 1024 + h * 256 + 128 * kh + 32 * ks + 8 * lq);
#pragma unroll
    for (int t = 0; t < 2; ++t)
#pragma unroll
        for (int ks = 0; ks < 2; ++ks) R.kt[t][ks] = *(const bf16x8*)(KT + (u * 256 + 32 * wv + 16 * t + l15) * 64 + 32 * ks + 8 * lq);
#pragma unroll
    for (int t = 0; t < 2; ++t) R.eb[t] = *(const f32x4*)(EBL + u * 256 + 32 * wv + 16 * t + 4 * lq);
}
constexpr int VT_LD = 72;
template <int NT>
__device__ __forceinline__ void gla_step(const GlaRegs& R, f32x4 (&S)[2][NT], const bf16* vts, const bf16* STp, bf16* STn, float* xo, int wv, int lane, int l15, int lq) {
    const int mi = wv >> 1, kh = wv & 1;
#pragma unroll
    for (int nt = 0; nt < NT; ++nt) {
        f32x4 acc = {0.f, 0.f, 0.f, 0.f};
        { const bf16x8 vsel = *(const bf16x8*)(vts + (16 * nt + l15) * VT_LD + 32 * kh + 8 * lq); acc = MFMA16(R.at, vsel, acc); }
#pragma unroll
        for (int ks = 0; ks < 4; ++ks) { const bf16x8 sf = *(const bf16x8*)(STp + (16 * nt + l15) * 264 + 128 * kh + 32 * ks + 8 * lq); acc = MFMA16(R.q[ks], sf, acc); }
        *(f32x4*)(xo + (((mi * 2 + kh) * NT + nt) * 64 + lane) * 4) = acc;
    }
#pragma unroll
    for (int nt = 0; nt < NT; ++nt) {
        bf16x8 vt[2];
#pragma unroll
        for (int ks = 0; ks < 2; ++ks) vt[ks] = *(const bf16x8*)(vts + (16 * nt + l15) * VT_LD + 32 * ks + 8 * lq);
#pragma unroll
        for (int mt = 0; mt < 2; ++mt) {
#pragma unroll
            for (int ks = 0; ks < 2; ++ks) S[mt][nt] = MFMA16(R.kt[mt][ks], vt[ks], S[mt][nt]);
            S[mt][nt] = S[mt][nt] * R.eb[mt];
            v2u w; w.x = pk2(S[mt][nt][0], S[mt][nt][1]); w.y = pk2(S[mt][nt][2], S[mt][nt][3]);
            *(v2u*)(STn + (16 * nt + l15) * 264 + 32 * wv + 16 * mt + 4 * lq) = w; } }
}
template <int NT>
__device__ __forceinline__ void gla_store_o(const float* xo, bf16* O, int b, int h, int s, int c, int wv, int lane, int l15, int lq) {
    const int mi = wv >> 1;
#pragma unroll
    for (int nt = 0; nt < NT; ++nt) { const f32x4 t = *(const f32x4*)(xo + (((mi * 2 + 0) * NT + nt) * 64 + lane) * 4) + *(const f32x4*)(xo + (((mi * 2 + 1) * NT + nt) * 64 + lane) * 4);
#pragma unroll
        for (int r = 0; r < 4; ++r) O[((size_t)b * 2048 + 64 * c + 16 * mi + 4 * lq + r) * DM + h * 512 + 16 * NT * s + 16 * nt + l15] = (bf16)f2bf(t[r]); }
}
#define GLA_BAR() do { asm volatile("s_waitcnt lgkmcnt(0)" ::: "memory"); __builtin_amdgcn_s_barrier(); asm volatile("" ::: "memory"); } while (0)
template <int NT>
__device__ __forceinline__ void gla_main_unit(Frame& F, int bh, int s) {
    const bf16* QT = (const bf16*)(F.ws + WS_QT); const bf16* KT = (const bf16*)(F.ws + WS_KT); const bf16* VT = (const bf16*)(F.ws + WS_VT);
    const bf16* ATT = (const bf16*)(F.ws + WS_ATT); const float* EBL = (const float*)(F.ws + WS_EBL); bf16* O = (bf16*)(F.ws + WS_O);
    const int b = bh >> 2, h = bh & 3, wv = F.wave, lane = F.lane, l15 = lane & 15, lq = lane >> 4, kh = wv & 1, tid = F.tid;
    constexpr int ST_ELEMS = NT * 16 * 264, XO_FLOATS = 8 * NT * 256, VTS_ELEMS = NT * 16 * VT_LD;
    bf16* ST = (bf16*)F.lds;
    float* XO = (float*)(F.lds + 2 * ST_ELEMS * 2);
    bf16* VTS = (bf16*)(F.lds + 2 * ST_ELEMS * 2 + 2 * XO_FLOATS * 4);
    for (int e = tid; e < ST_ELEMS; e += 512) ((unsigned*)ST)[e] = 0u;
    f32x4 S[2][NT];
#pragma unroll
    for (int a = 0; a < 2; ++a)
#pragma unroll
        for (int c2 = 0; c2 < NT; ++c2) S[a][c2] = (f32x4){0.f, 0.f, 0.f, 0.f};
    GlaRegs RA, RB;
    gla_load<NT>(RA, QT, KT, VT, ATT, EBL, bh, s, 0, wv, l15, lq, tid);
    if (tid < NT * 128) *(v4u*)(VTS + (tid >> 3) * VT_LD + 8 * (tid & 7)) = RA.vpiece;
    __syncthreads();
#define GLA_ITER(c, RCUR, RLD) do { \
            gla_load<NT>(RLD, QT, KT, VT, ATT, EBL, bh, s, (c) + 1 < 32 ? (c) + 1 : 31, wv, l15, lq, tid); \
            gla_step<NT>(RCUR, S, VTS + ((c) & 1) * VTS_ELEMS, ST + ((c) & 1) * ST_ELEMS, ST + (((c) + 1) & 1) * ST_ELEMS, XO + ((c) & 1) * XO_FLOATS, wv, lane, l15, lq); \
            if (!kh && (c) > 0) gla_store_o<NT>(XO + (((c) + 1) & 1) * XO_FLOATS, O, b, h, s, (c) - 1, wv, lane, l15, lq); \
            if (tid < NT * 128) *(v4u*)(VTS + (((c) + 1) & 1) * VTS_ELEMS + (tid >> 3) * VT_LD + 8 * (tid & 7)) = RLD.vpiece; \
            GLA_BAR(); \
        } while (0)
#pragma unroll 1
    for (int c = 0; c < 32; c += 2) { GLA_ITER(c, RA, RB); GLA_ITER(c + 1, RB, RA); }
#undef GLA_ITER
    if (!kh) gla_store_o<NT>(XO + (31 & 1) * XO_FLOATS, O, b, h, s, 31, wv, lane, l15, lq);
    float* So = F.out + OUT_GLAP + ((size_t)bh * 256) * 512;
#pragma unroll
    for (int mt = 0; mt < 2; ++mt)
#pragma unroll
        for (int nt = 0; nt < NT; ++nt)
#pragma unroll
            for (int r = 0; r < 4; ++r) So[(size_t)(32 * wv + 16 * mt + 4 * lq + r) * 512 + 16 * NT * s + 16 * nt + l15] = S[mt][nt][r];
    __syncthreads();
}

__device__ __forceinline__ void mixer_row(Frame& F, int m) {
    const bf16* P = (const bf16*)(F.ws + WS_P); const bf16* O = (const bf16*)(F.ws + WS_O); bf16* MM = (bf16*)(F.ws + WS_MM);
    const int lane = F.lane; const bf16* Pr = P + (size_t)m * PLD;
    const bool prompt = m < TP; const int t = m & 2047, n = m - TP, bidx = m >> 11;
#pragma unroll 1
    for (int j = 0; j < 4; ++j) {
        const int col = 512 * j + 8 * lane;
        float o[8], r[8], cbv[8], cc[8], cx[8], ga[8], gb[8], u[8], u1[8], u2[8];
        unpack8(*(const v4u*)(O + (size_t)m * DM + col), o);
        float ss = 0.f;
#pragma unroll
        for (int e = 0; e < 8; ++e) ss += o[e] * o[e];
        const float rstd = 1.0f / sqrtf(wave_sum(ss) * (1.0f / 512.0f) + EPS);
        unpack8(*(const v4u*)(Pr + C_R + col), r); unpack8(*(const v4u*)(Pr + C_CB + col), cbv); unpack8(*(const v4u*)(Pr + C_CC + col), cc); unpack8(*(const v4u*)(Pr + C_CX + col), cx);
        unpack8(*(const v4u*)(Pr + C_GA + col), ga); unpack8(*(const v4u*)(Pr + C_GB + col), gb);
#pragma unroll
        for (int e = 0; e < 8; ++e) u[e] = cc[e] * cx[e];
        if (prompt) {
            if (t >= 1) { float a[8], b2[8]; unpack8(*(const v4u*)(Pr - PLD + C_CC + col), a); unpack8(*(const v4u*)(Pr - PLD + C_CX + col), b2);
#pragma unroll
                for (int e = 0; e < 8; ++e) u1[e] = a[e] * b2[e]; }
            else {
#pragma unroll
                for (int e = 0; e < 8; ++e) u1[e] = 0.f; }
            if (t >= 2) { float a[8], b2[8]; unpack8(*(const v4u*)(Pr - 2 * PLD + C_CC + col), a); unpack8(*(const v4u*)(Pr - 2 * PLD + C_CX + col), b2);
#pragma unroll
                for (int e = 0; e < 8; ++e) u2[e] = a[e] * b2[e]; }
            else {
#pragma unroll
                for (int e = 0; e < 8; ++e) u2[e] = 0.f; }
            if (t >= 2046) { float* dst = F.out + OUT_CONVP + ((size_t)bidx * 2 + (t - 2046)) * DM + col;
                *(f32x4*)dst = (f32x4){u[0], u[1], u[2], u[3]}; *(f32x4*)(dst + 4) = (f32x4){u[4], u[5], u[6], u[7]}; }
        } else {
            const float* sc = F.sconv + (size_t)n * 2 * DM + col;
            const f32x4 a0 = *(const f32x4*)sc, a1 = *(const f32x4*)(sc + 4), b0 = *(const f32x4*)(sc + DM), b1 = *(const f32x4*)(sc + DM + 4);
            u2[0] = a0.x; u2[1] = a0.y; u2[2] = a0.z; u2[3] = a0.w; u2[4] = a1.x; u2[5] = a1.y; u2[6] = a1.z; u2[7] = a1.w;
            u1[0] = b0.x; u1[1] = b0.y; u1[2] = b0.z; u1[3] = b0.w; u1[4] = b1.x; u1[5] = b1.y; u1[6] = b1.z; u1[7] = b1.w;
            float* dst = F.out + OUT_CONVS + (size_t)n * 2 * DM + col;
            *(f32x4*)dst = b0; *(f32x4*)(dst + 4) = b1;
            *(f32x4*)(dst + DM) = (f32x4){u[0], u[1], u[2], u[3]}; *(f32x4*)(dst + DM + 4) = (f32x4){u[4], u[5], u[6], u[7]};
        }
        float mv[8];
#pragma unroll
        for (int e = 0; e < 8; ++e) {
            const int cidx = col + e;
            const float ya = (r[e] * sigmoidf_(r[e])) * (o[e] * rstd * F.gng[cidx]);
            const float z = F.cb[cidx] + F.cw[cidx] * u2[e] + F.cw[DM + cidx] * u1[e] + F.cw[2 * DM + cidx] * u[e];
            mv[e] = sigmoidf_(ga[e]) * ya + sigmoidf_(gb[e]) * (cbv[e] * z);
        }
        *(v4u*)(MM + (size_t)m * DM + col) = pack8(mv);
    }
}

constexpr int SC_LD = 130;
__device__ __forceinline__ int f2sort(float f) { const int b = __float_as_int(f); return b ^ ((b >> 31) & 0x7fffffff); }
__device__ __forceinline__ float sort2f(int s) { return __int_as_float(s ^ ((s >> 31) & 0x7fffffff)); }
#define CE_DESC(x, y) do { const int mx_ = max(x, y), mn_ = min(x, y); x = mx_; y = mn_; } while (0)
template <int N> __device__ __forceinline__ void bitonic_sort_desc(int (&a)[N]) {
#pragma unroll
    for (int k = 2; k <= N; k <<= 1)
#pragma unroll
        for (int j = k >> 1; j > 0; j >>= 1)
#pragma unroll
            for (int i = 0; i < N; ++i) { const int l = i ^ j; if (l > i) { if ((i & k) == 0) CE_DESC(a[i], a[l]); else CE_DESC(a[l], a[i]); } }
}
template <int N> __device__ __forceinline__ void bitonic_merge_desc(int (&a)[N]) {
#pragma unroll
    for (int j = N >> 1; j > 0; j >>= 1)
#pragma unroll
        for (int i = 0; i < N; ++i) { const int l = i ^ j; if (l > i) CE_DESC(a[i], a[l]); }
}
__device__ __forceinline__ void top16_merge(int (&a)[16], const int (&b)[16]) {
#pragma unroll
    for (int i = 0; i < 16; ++i) a[i] = max(a[i], b[15 - i]);
    bitonic_merge_desc<16>(a);
}
__device__ __attribute__((aligned(16))) const unsigned char PK_CAND[64] = {
    0x00, 0x01, 0x02, 0x03, 0x04, 0x05, 0x06, 0x07, 0x08, 0x09, 0x0a, 0x0b, 0x0c, 0x0d, 0x0e, 0x0f,
    0x10, 0x11, 0x12, 0x13, 0x14, 0x15, 0x16, 0x17, 0x20, 0x21, 0x22, 0x23, 0x24, 0x50, 0x51, 0xff,
    0x30, 0x31, 0x32, 0x33, 0x40, 0x41, 0x42, 0x60, 0x61, 0x70, 0x71, 0xff, 0xff, 0xff, 0xff, 0xff,
    0x80, 0x90, 0xa0, 0xb0, 0xc0, 0xd0, 0xe0, 0xf0, 0xff, 0xff, 0xff, 0xff, 0xff, 0xff, 0xff, 0xff};
constexpr int SC8_LD = 132, SK_LD = 136;
constexpr int SC8_BYTES = 128 * SC8_LD * 4, TV8_OFF = SC8_BYTES, SK_OFF = TV8_OFF + 128 * 16 * 4;
__device__ __forceinline__ void peer_load_subkeys(Frame& F) {
    const bf16* SKB = (const bf16*)(F.ws + WS_SKB); bf16* sk_s = (bf16*)(F.lds + SK_OFF);
    for (int e = F.tid; e < 256 * 16; e += 512) { const int row = e >> 4, ch = e & 15; *(v4u*)(sk_s + row * SK_LD + 8 * ch) = *(const v4u*)(SKB + (size_t)row * 128 + 8 * ch); }
    __syncthreads();
}
__device__ __forceinline__ void peer_qfrags(Frame& F, int tb, bf16x8 (&a)[2][4]) {
    const bf16* QP = (const bf16*)(F.ws + WS_QP); const int tok = min(tb + (F.lane & 7), TT - 1), lq = F.lane >> 4;
#pragma unroll
    for (int hf = 0; hf < 2; ++hf)
#pragma unroll
        for (int ks = 0; ks < 4; ++ks) a[hf][ks] = *(const bf16x8*)(QP + (size_t)tok * DM + F.wave * 256 + hf * 128 + 32 * ks + 8 * lq);
}
#define PK_BAR() do { asm volatile("s_waitcnt lgkmcnt(0)" ::: "memory"); __builtin_amdgcn_s_barrier(); asm volatile("" ::: "memory"); } while (0)
__device__ __forceinline__ void peer_topk_tile(Frame& F, int tb, int tend, bf16x8 (&a)[2][4]) {
    int* IDX = (int*)(F.ws + WS_IDX); float* GW = (float*)(F.ws + WS_GW);
    float* sc_s = (float*)F.lds;
    int* tv_s = (int*)(F.lds + TV8_OFF);
    const bf16* sk_s = (const bf16*)(F.lds + SK_OFF);
    const int wv = F.wave, lane = F.lane, l15 = lane & 15, lq = lane >> 4, tid = F.tid;
    {
#pragma unroll
      for (int hf = 0; hf < 2; ++hf) {
#pragma unroll
          for (int nt = 0; nt < 8; ++nt) { f32x4 acc = {0.f, 0.f, 0.f, 0.f};
#pragma unroll
              for (int ks = 0; ks < 4; ++ks) { const bf16x8 bq = *(const bf16x8*)(sk_s + (hf * 128 + 16 * nt + l15) * SK_LD + 32 * ks + 8 * lq); acc = MFMA16(a[hf][ks], bq, acc); }
              if (lq < 2) {
#pragma unroll
                  for (int r = 0; r < 4; ++r) sc_s[((wv * 2 + hf) * 8 + 4 * lq + r) * SC8_LD + 16 * nt + l15] = acc[r]; } } } }
    if (tb + 8 < tend) peer_qfrags(F, tb + 8, a);
    PK_BAR();
    { const int row = tid >> 2, sub = tid & 3; const float* rp = sc_s + row * SC8_LD;
      int top[16], v[16];
#pragma unroll
      for (int i = 0; i < 16; ++i) { const int key = 4 * i + sub; top[i] = (f2sort(rp[key]) & ~127) | (127 - key); }
      bitonic_sort_desc<16>(top);
#pragma unroll
      for (int i = 0; i < 16; ++i) { const int key = 4 * (16 + i) + sub; v[i] = (f2sort(rp[key]) & ~127) | (127 - key); }
      bitonic_sort_desc<16>(v);
      top16_merge(top, v);
#pragma unroll
      for (int sh = 1; sh < 4; sh <<= 1) {
#pragma unroll
          for (int i = 0; i < 16; ++i) v[i] = __shfl_xor(top[i], sh);
          top16_merge(top, v); }
      if (sub == 0) {
#pragma unroll
          for (int q = 0; q < 4; ++q) *(int __attribute__((ext_vector_type(4)))*)(tv_s + row * 16 + 4 * q) = (int __attribute__((ext_vector_type(4)))){top[4 * q], top[4 * q + 1], top[4 * q + 2], top[4 * q + 3]}; }
    }
    PK_BAR();
    if (tid < 256) { const int it = tid >> 2, qd = tid & 3, tl = it & 7, hd = it >> 3;
      const int* r1 = tv_s + ((hd * 2 + 0) * 8 + tl) * 16; const int* r2 = tv_s + ((hd * 2 + 1) * 8 + tl) * 16;
      int c[16];
      const v4u cw = *(const v4u*)(PK_CAND + qd * 16);
#pragma unroll
      for (int t = 0; t < 16; ++t) { const int ab = (int)((cw[t >> 2] >> (8 * (t & 3))) & 0xffu); const int abc = ab != 0xff ? ab : 0;
          const float sv = sort2f(r1[abc >> 4] & ~127) + sort2f(r2[abc & 15] & ~127); const int packed = (f2sort(sv) & ~255) | (255 - ab);
          c[t] = ab != 0xff ? packed : (int)0x80000000; }
      bitonic_sort_desc<16>(c);
#pragma unroll
      for (int sh = 1; sh < 4; sh <<= 1) { int oth[16];
#pragma unroll
          for (int i = 0; i < 16; ++i) oth[i] = __shfl_xor(c[i], sh);
          top16_merge(c, oth); }
      const int tok = tb + tl;
      if (tok < tend) {
          float ev[16], sum = 0.f; const float mx = sort2f(c[0] & ~255);
#pragma unroll
          for (int k = 0; k < 16; ++k) { ev[k] = __expf(sort2f(c[k] & ~255) - mx); sum += ev[k]; }
          const float inv = 1.0f / sum;
#pragma unroll
          for (int k = 0; k < 16; ++k) if ((k >> 2) == qd) { const int ab = 255 - (c[k] & 255); const int i1 = 127 - (r1[ab >> 4] & 127), i2 = 127 - (r2[ab & 15] & 127);
              IDX[(size_t)tok * 128 + hd * 16 + k] = i1 * 128 + i2; GW[(size_t)tok * 128 + hd * 16 + k] = ev[k] * inv; }
      }
    }
    PK_BAR();
}

__device__ __forceinline__ void peer_phase(Frame& F, int tok0, int tok1) {
    const unsigned char* U6 = F.ws + WS_EU; const unsigned char* V6 = F.ws + WS_EV; const float* SU = (const float*)(F.ws + WS_EU + 32 * MiB); const float* SV = (const float*)(F.ws + WS_EV + 32 * MiB);
    const float* X2 = (const float*)(F.ws + WS_X2); const float* RS2 = (const float*)(F.ws + WS_RS2); const int* IDX = (const int*)(F.ws + WS_IDX); const float* GW = (const float*)(F.ws + WS_GW);
    const int wv = F.wave, lane = F.lane, tid = F.tid;
    float* red_s = (float*)F.lds;
    float* ss_s = (float*)(F.lds + 131072);
    const f32x4 gfin = *(const f32x4*)(F.nfg + 4 * tid);
    f32x4 x3p = {0.f, 0.f, 0.f, 0.f}; int buf = 0;
#pragma unroll 1
    for (int m = tok0; m <= tok1; ++m) {
        if (m < tok1) {
            const int myidx = IDX[(size_t)m * 128 + wv * 16 + (lane & 15)]; float myg = GW[(size_t)m * 128 + wv * 16 + (lane & 15)];
            const float mysu = SU[myidx] * RS2[m]; myg *= SV[myidx];
            float hf[32];
#pragma unroll
            for (int j = 0; j < 8; ++j) { const f32x4 w = *(const f32x4*)(X2 + (size_t)m * DM + 256 * j + 4 * lane); hf[4 * j] = w.x; hf[4 * j + 1] = w.y; hf[4 * j + 2] = w.z; hf[4 * j + 3] = w.w; }
            float acc[32];
#pragma unroll
            for (int k = 0; k < 32; ++k) acc[k] = 0.f;
#pragma unroll 1
            for (int kg = 0; kg < 4; ++kg) {
                v2u ul[4][3], vl[4][3]; float gk[4], su[4];
#pragma unroll
                for (int kk = 0; kk < 4; ++kk) { const int ex = __shfl(myidx, kg * 4 + kk); gk[kk] = __shfl(myg, kg * 4 + kk); su[kk] = __shfl(mysu, kg * 4 + kk);
                    const unsigned char* ur = U6 + (size_t)ex * ROW6 + 8 * lane; const unsigned char* vr = V6 + (size_t)ex * ROW6 + 8 * lane;
#pragma unroll
                    for (int pp = 0; pp < 3; ++pp) { ul[kk][pp] = *(const v2u*)(ur + 512 * pp); vl[kk][pp] = *(const v2u*)(vr + 512 * pp); } }
#pragma unroll
                for (int kk = 0; kk < 4; ++kk) {
                    const v32f uf = __builtin_amdgcn_cvt_scalef32_pk32_f32_fp6((v6u){ul[kk][0].x, ul[kk][0].y, ul[kk][1].x, ul[kk][1].y, ul[kk][2].x, ul[kk][2].y}, 1.0f);
                    float dot = 0.f;
#pragma unroll
                    for (int k = 0; k < 32; ++k) dot += uf[k] * hf[k];
                    const float a = wave_sum(dot) * su[kk];
                    const float wgt = gk[kk] * (0.5f * a * (1.0f + erff(a * 0.70710678118654752f)));
                    const v32f vf = __builtin_amdgcn_cvt_scalef32_pk32_f32_fp6((v6u){vl[kk][0].x, vl[kk][0].y, vl[kk][1].x, vl[kk][1].y, vl[kk][2].x, vl[kk][2].y}, 1.0f);
#pragma unroll
                    for (int k = 0; k < 32; ++k) acc[k] += wgt * vf[k];
                }
            }
#pragma unroll
            for (int j = 0; j < 8; ++j) *(f32x4*)(red_s + (buf * 8 + wv) * 2048 + 256 * j + 4 * lane) = (f32x4){acc[4 * j], acc[4 * j + 1], acc[4 * j + 2], acc[4 * j + 3]};
        }
        __syncthreads();
        if (m > tok0) {
            float tot = 0.f;
#pragma unroll
            for (int w8 = 0; w8 < 8; ++w8) tot += ss_s[(buf ^ 1) * 8 + w8];
            const float rstd = 1.0f / sqrtf(tot * (1.0f / DM) + EPS);
            *(f32x4*)(F.out + OUT_Y + (size_t)(m - 1) * DM + 4 * tid) = x3p * rstd * gfin;
        }
        if (m < tok1) {
            f32x4 x3 = *(const f32x4*)(X2 + (size_t)m * DM + 4 * tid);
#pragma unroll
            for (int w8 = 0; w8 < 8; ++w8) x3 += *(const f32x4*)(red_s + (buf * 8 + w8) * 2048 + 4 * tid);
            const float ss = wave_sum((x3.x * x3.x + x3.y * x3.y) + (x3.z * x3.z + x3.w * x3.w));
            if (lane == 0) ss_s[buf * 8 + wv] = ss;
            x3p = x3;
        }
        buf ^= 1;
    }
    __syncthreads();
}
struct Args { const float* in[18]; float* out; unsigned char* ws; int ph_lo, ph_hi; };
__global__ void __launch_bounds__(NWAVES * 64, 2) mk_fwd(Args args) {
    extern __shared__ __attribute__((aligned(16))) unsigned char lds[];
    Frame F;
    F.lds = lds;
    F.tid = threadIdx.x; F.lane = F.tid & 63; F.wave = __builtin_amdgcn_readfirstlane(F.tid >> 6);
    F.G = gridDim.x; { const int bx = blockIdx.x; F.vcu = (F.G % 8 == 0) ? (bx % 8) * (F.G / 8) + bx / 8 : bx; }
    F.xp = args.in[0]; F.xs = args.in[1]; F.sgla = args.in[2]; F.sconv = args.in[3]; F.n1g = args.in[4]; F.win = args.in[5]; F.wau = args.in[6]; F.bal = args.in[7];
    F.gng = args.in[8]; F.cw = args.in[9]; F.cb = args.in[10]; F.wout = args.in[11]; F.n2g = args.in[12]; F.wq = args.in[13]; F.sk = args.in[14]; F.eu = args.in[15];
    F.ev = args.in[16]; F.nfg = args.in[17]; F.out = args.out; F.ws = args.ws;
    for (int u = F.tid; u < (LDS_BYTES - LDSCTL_OFF) / 4; u += NWAVES * 64) ((LAS unsigned*)((LAS unsigned char*)lds + LDSCTL_OFF))[u] = 0u;
    __syncthreads();
    gu32* ctl = (gu32*)(F.ws + WS_CTL);
    XcdBarrier bar; bar.bar = (unsigned*)(ctl + CW_BAR); bar.x = 0; bar.st = nullptr;
    if (N_LAUNCHES == 1) bar = xcd_barrier_post((unsigned*)(ctl + CW_BAR), (volatile LAS unsigned*)((LAS unsigned char*)lds + MISC_OFF) + 8);
    const int lo = args.ph_lo, hi = args.ph_hi;
#ifndef SKREP
#define SKREP 1
#endif
#ifndef PROBE_DBL
#define PROBE_DBL -1
#endif
#define IN(k) (lo <= (k) && (k) < hi)
#define REP(k) for (int rep_ = 0; rep_ < ((k) == PROBE_DBL ? 2 : 1); ++rep_)
#define SEAM(k) do { if (IN(k) && IN((k) + 1)) xcd_barrier(bar); } while (0)
    const int gw = F.vcu * NWAVES + F.wave, NGW = F.G * NWAVES;
    const int tok0 = (int)(((long)F.vcu * TT) / F.G), tok1 = (int)(((long)(F.vcu + 1) * TT) / F.G);

    if (IN(0)) REP(0) { p0_prologue(F); __syncthreads(); }
    SEAM(0);
    if (IN(1)) REP(1) {
        pg8::Gemm g{(const pg8::bf16_t*)(F.ws + WS_XN), (const pg8::bf16_t*)(F.ws + WS_WINT), TP, NP, DM}; pg8::StaticOrder S; S.init(TP, NP, F.G, (int)blockIdx.x);
        pg8::EpiBf16<0> E{(pg8::bf16_t*)(F.ws + WS_P), PLD, nullptr, 0, 0, 1.f};
        pg8::gemm_phase<pg8::EpiBf16<0>, pg8::StaticOrder, true, true>((PG8_LAS unsigned char*)lds + RING_OFF, g, S, E);
#ifdef GEMM1_TWICE
        pg8::gemm_phase<pg8::EpiBf16<0>, pg8::StaticOrder, true, true>((PG8_LAS unsigned char*)lds + RING_OFF, g, S, E);
#endif
        { EpiSkBf16 Es{(bf16*)(F.ws + WS_P) + (size_t)TP * PLD, PLD, nullptr};
          for (int skr = 0; skr < SKREP; ++skr) for (int ng = F.vcu; ng < NP / 64; ng += F.G) skinny_gemm<4>(F, (const bf16*)(F.ws + WS_XN) + (size_t)TP * DM, (const bf16*)(F.ws + WS_WINT), 64 * ng, Es); }
    }
    SEAM(1);
    if (IN(2)) REP(2) { for (int u = F.vcu; u < 512; u += F.G) gla_prep_unit(F, u); }
    SEAM(2);
    if (IN(3)) REP(3) {
        if ((F.vcu & 1) == 0) { for (int g = F.vcu >> 1; g < 128; g += (F.G + 1) >> 1) gla_main_unit<4>(F, g >> 3, g & 7); }
        volatile LAS unsigned* qslot = (volatile LAS unsigned*)((LAS unsigned char*)lds + LDSCTL_OFF + 16);
        for (;;) {
            if (F.tid == 0) *qslot = __hip_atomic_fetch_add((unsigned*)(ctl + CW_QUEUE + 64 * rep_), 1u, __ATOMIC_RELAXED, __HIP_MEMORY_SCOPE_AGENT);
            __syncthreads();
            const unsigned u = *qslot;
            __syncthreads();
            if (u >= 512u) break;
            gla_sample_unit(F, (int)u);
        }
    }
    SEAM(3);
    if (IN(4)) REP(4) {
        bf16* MM = (bf16*)(F.ws + WS_MM);
        for (int m = gw; m < MP; m += NGW) { if (m < TT) mixer_row(F, m); else zero_row_bf16(MM + (size_t)m * DM, F.lane); }
    }
    SEAM(4);
    if (IN(5)) REP(5) {
        pg8::Gemm g{(const pg8::bf16_t*)(F.ws + WS_MM), (const pg8::bf16_t*)(F.ws + WS_WOUTT), TP, DM, DM}; pg8::StaticOrder S; S.init(TP, DM, F.G, (int)blockIdx.x);
        pg8::EpiF32Res E{F.xp, (float*)(F.ws + WS_X2), (pg8::bf16_t*)(F.ws + WS_H2), (float*)(F.ws + WS_SSQ), DM};
        pg8::gemm_phase<pg8::EpiF32Res, pg8::StaticOrder, true, true>((PG8_LAS unsigned char*)lds + RING_OFF, g, S, E);
#ifdef GEMM2_TWICE
        pg8::gemm_phase<pg8::EpiF32Res, pg8::StaticOrder, true, true>((PG8_LAS unsigned char*)lds + RING_OFF, g, S, E);
#endif
        { EpiSkF32Res Es{F.xs, (float*)(F.ws + WS_X2) + (size_t)TP * DM, (bf16*)(F.ws + WS_H2) + (size_t)TP * DM, (float*)(F.ws + WS_SSQS)};
          for (int skr = 0; skr < SKREP; ++skr) for (int ng = F.vcu; ng < DM / 16; ng += F.G) skinny_gemm<1>(F, (const bf16*)(F.ws + WS_MM) + (size_t)TP * DM, (const bf16*)(F.ws + WS_WOUTT), 16 * ng, Es); }
    }
    SEAM(5);
    if (IN(6)) REP(6) {
        float* rs_s = (float*)(lds + 131072);
        float* rss_s = rs_s + 512;
        float* RS2 = (float*)(F.ws + WS_RS2);
        pg8::Gemm g{(const pg8::bf16_t*)(F.ws + WS_H2), (const pg8::bf16_t*)(F.ws + WS_WQT), TP, DM, DM}; pg8::StaticOrder S; S.init(TP, DM, F.G, (int)blockIdx.x);
        { pg8::Unit u0;
          if (S.next(0, u0) && F.tid < 256) { const int row = u0.pm * 256 + F.tid; const f32x4* p = (const f32x4*)((const float*)(F.ws + WS_SSQ) + (size_t)row * 32); f32x4 a4 = p[0];
#pragma unroll
              for (int i = 1; i < 8; ++i) a4 += p[i];
              const float rstd = 1.0f / sqrtf(((a4.x + a4.y) + (a4.z + a4.w)) * (1.0f / DM) + EPS); rs_s[F.tid] = rstd; if (u0.pn == 0) RS2[row] = rstd; }
          if (F.tid >= 256 && F.tid < 384 && F.vcu < DM / 16) { const int row = F.tid - 256; const f32x4* p = (const f32x4*)((const float*)(F.ws + WS_SSQS) + (size_t)row * 128); f32x4 a4 = p[0];
#pragma unroll
              for (int i = 1; i < 32; ++i) a4 += p[i];
              const float rstd = 1.0f / sqrtf(((a4.x + a4.y) + (a4.z + a4.w)) * (1.0f / DM) + EPS); rss_s[row] = rstd; if (F.vcu == 0) RS2[TP + row] = rstd; }
          __syncthreads(); }
        pg8::EpiBf16RowScale E{(pg8::bf16_t*)(F.ws + WS_QP), DM, rs_s};
        pg8::gemm_phase<pg8::EpiBf16RowScale, pg8::StaticOrder, true, true>((PG8_LAS unsigned char*)lds + RING_OFF, g, S, E);
#ifdef GEMM3_TWICE
        pg8::gemm_phase<pg8::EpiBf16RowScale, pg8::StaticOrder, true, true>((PG8_LAS unsigned char*)lds + RING_OFF, g, S, E);
#endif
        { EpiSkBf16 Es{(bf16*)(F.ws + WS_QP) + (size_t)TP * DM, DM, rss_s};
          for (int skr = 0; skr < SKREP; ++skr) for (int ng = F.vcu; ng < DM / 16; ng += F.G) skinny_gemm<1>(F, (const bf16*)(F.ws + WS_H2) + (size_t)TP * DM, (const bf16*)(F.ws + WS_WQT), 16 * ng, Es); }
    }
    SEAM(6);
    if (IN(7)) REP(7) { bf16x8 qa[2][4]; peer_qfrags(F, tok0, qa); peer_load_subkeys(F); for (int tb = tok0; tb < tok1; tb += 8) peer_topk_tile(F, tb, tok1, qa); __syncthreads(); }
    SEAM(7);
    if (IN(8)) REP(8) { peer_phase(F, tok0, tok1); }
#undef IN
#undef SEAM
}

extern "C" void kernel_launch(void* const* d_in, const int* in_sizes, int n_in, void* d_out, int out_size, void* d_ws, size_t ws_size, hipStream_t stream) {
    static int grid = 0;
    if (grid == 0) {
        if (n_in != 18 || ws_size < WS_END) { fprintf(stderr, "kernel_launch: expected 18 inputs and >= %zu bytes of workspace; got %d, %zu\n", (size_t)WS_END, n_in, ws_size); grid = -1; return; }
        int dev = 0, cus = 0;
        if (hipGetDevice(&dev) != hipSuccess || hipDeviceGetAttribute(&cus, hipDeviceAttributeMultiprocessorCount, dev) != hipSuccess) { grid = -1; return; }
        if (hipFuncSetAttribute((const void*)mk_fwd, hipFuncAttributeMaxDynamicSharedMemorySize, LDS_BYTES) != hipSuccess) { fprintf(stderr, "kernel_launch: hipFuncSetAttribute failed\n"); grid = -1; return; }
        (void)hipGetLastError();
        grid = cus;
    }
    if (grid < 0) return;
    (void)hipMemsetAsync((char*)d_ws + WS_CTL, 0, CTL_ZERO_BYTES, stream);
    Args a{};
    for (int i = 0; i < 18; ++i) a.in[i] = (const float*)d_in[i];
    a.out = (float*)d_out; a.ws = (unsigned char*)d_ws;
    if (N_LAUNCHES == 1) { a.ph_lo = 0; a.ph_hi = N_PHASES; hipLaunchKernelGGL(mk_fwd, dim3(grid), dim3(NWAVES * 64), LDS_BYTES, stream, a); }
    else { for (int li = 0; li < N_PHASES; ++li) { a.ph_lo = li; a.ph_hi = li + 1; hipLaunchKernelGGL(mk_fwd, dim3(grid), dim3(NWAVES * 64), LDS_BYTES, stream, a); } }
}
```

```cpp
#include <hip/hip_runtime.h>
#include <cstdio>
#include <cstdint>
#include <cmath>
#define MK_N_LAUNCHES 1
namespace pg8 {
#define PG8_LAS __attribute__((address_space(3)))
typedef unsigned short bf16_t;
typedef short bf16x8 __attribute__((ext_vector_type(8)));
typedef float f32x4 __attribute__((ext_vector_type(4)));
typedef unsigned u32x4 __attribute__((ext_vector_type(4)));
constexpr int BM = 256, BK = 64, HALF = 128, HTB = HALF * BK * 2  , STAGE_BYTES = 8 * HTB, NXCD = 8, WGM = 8;

__host__ __device__ __forceinline__ int lds_byte(int r, int c) { const int st = (r >> 4) * 2 + (c >> 5), rr = r & 15, cc = c & 31, ob = rr * 64 + cc * 2; return st * 1024 + (ob ^ (((ob >> 9) & 1) << 5)); }
__host__ __device__ __forceinline__ void stage_rc(int b, int& R, int& C) { const int st = b / 1024, sb = b % 1024, swz = sb ^ (((sb >> 9) & 1) << 5); R = (st >> 1) * 16 + swz / 64; C = (st & 1) * 32 + (swz % 64) / 2; }
__host__ __device__ __forceinline__ int perm32(int rho) { const int n = rho >> 4, i = rho & 15; return 8 * (i >> 2) + 4 * n + (i & 3); }

struct Unit { int pm, pn; };
struct Gemm { const bf16_t* A; const bf16_t* Bt; int M, N, K; };

struct StaticOrder {
    int nM, nN, nwg, G, c;
    __host__ __device__ void init(int M, int N, int G_, int c_) { nM = M / BM; nN = N / BM; nwg = nM * nN; G = G_; c = c_; }
    __host__ __device__ bool next(int i, Unit& u) const {
        const long L = (long)i * G + c; if (L >= nwg) return false;
        int wgid = (int)L; { const int q = nwg / NXCD, r = nwg % NXCD, xcd = wgid % NXCD, off = wgid / NXCD; wgid = (xcd < r ? xcd * (q + 1) : r * (q + 1) + (xcd - r) * q) + off; }
        const int nig = WGM * nN, gid = wgid / nig, fm = gid * WGM, gsz = (nM - fm) < WGM ? (nM - fm) : WGM;
        u.pm = fm + ((wgid % nig) % gsz); u.pn = (wgid % nig) / gsz; return true;
    }
    __device__ __forceinline__ void a_ready(const Unit&) const {}
    __device__ __forceinline__ void done(const Unit&) const {}
};

__device__ __forceinline__ unsigned cvt_pk_bf16(float lo, float hi) { unsigned r; asm volatile("v_cvt_pk_bf16_f32 %0, %1, %2" : "=v"(r) : "v"(lo), "v"(hi)); return r; }
typedef float f32x2 __attribute__((ext_vector_type(2)));
__device__ __forceinline__ f32x2 gelu_pk(f32x2 v) {
    const f32x2 av = __builtin_elementwise_abs(v), d = av * 0.2316418882f + 1.0f;
    f32x2 t; t.x = __builtin_amdgcn_rcpf(d.x); t.y = __builtin_amdgcn_rcpf(d.y);
    f32x2 q = t * 0.5307027145f + (-0.7265760135f); q = q * t + 0.7107068705f; q = q * t + (-0.142248368f); q = q * t + 0.127414796f; q = q * t;
    const f32x2 s = (v * v) * (-0.72134752044f);
    f32x2 e; e.x = __builtin_amdgcn_exp2f(s.x); e.y = __builtin_amdgcn_exp2f(s.y);
    const f32x2 m = v * (q * e), r = v - m;
    f32x2 o; o.x = v.x < 0.f ? m.x : r.x; o.y = v.y < 0.f ? m.y : r.y; return o;
}

template <int ACT  > struct EpiBf16 {
    static constexpr bool PERM = true, AFTER_DRAIN = false; static_assert(ACT == 0 || ACT == 1, "EpiBf16: ACT is 0 (none) or 1 (gelu_pk)");
    bf16_t* O; int ldc; const float* bias; int split_cols; size_t split_stride; float scale0;
    __device__ __forceinline__ void operator()(const f32x4 (&acc)[2][2][4][2], const Unit& u, int wr, int wc, int fr, int fq) const {
        const int row0 = u.pm * BM + wr * 64 + fr; int colt = u.pn * BM; bf16_t* base = O;
        float sc = 1.f; if (split_cols) { const int t = colt / split_cols; base += (size_t)t * split_stride; colt -= t * split_cols; if (t == 0) sc = scale0; }
        const int col0 = colt + wc * 32 + 8 * fq, bcol0 = u.pn * BM + wc * 32 + 8 * fq;
        f32x4 bv[2][2];
#pragma unroll
        for (int bj = 0; bj < 2; ++bj)
#pragma unroll
            for (int n = 0; n < 2; ++n) bv[bj][n] = bias ? *(const f32x4*)(bias + bcol0 + bj * HALF + 4 * n) : (f32x4){0.f, 0.f, 0.f, 0.f};
#pragma unroll
        for (int ai = 0; ai < 2; ++ai)
#pragma unroll
            for (int m = 0; m < 4; ++m) { bf16_t* rowp = base + (size_t)(row0 + ai * HALF + m * 16) * ldc + col0;
#pragma unroll
                for (int bj = 0; bj < 2; ++bj) { f32x4 v0 = acc[ai][bj][m][0] + bv[bj][0], v1 = acc[ai][bj][m][1] + bv[bj][1];
                    if (ACT == 1) { f32x2 a = gelu_pk((f32x2){v0[0], v0[1]}), b = gelu_pk((f32x2){v0[2], v0[3]}), c = gelu_pk((f32x2){v1[0], v1[1]}), d = gelu_pk((f32x2){v1[2], v1[3]});
                        v0 = (f32x4){a.x, a.y, b.x, b.y}; v1 = (f32x4){c.x, c.y, d.x, d.y}; }
                    v0 = v0 * sc; v1 = v1 * sc; u32x4 w; w.x = cvt_pk_bf16(v0[0], v0[1]); w.y = cvt_pk_bf16(v0[2], v0[3]); w.z = cvt_pk_bf16(v1[0], v1[1]); w.w = cvt_pk_bf16(v1[2], v1[3]);
                    *(u32x4*)(rowp + bj * HALF) = w; } }
    }
};
template <class Epi, class Sched, bool ALIGN_EPI = false, bool SP2 = false>
__device__ __forceinline__ void gemm_phase(PG8_LAS unsigned char* lds, const Gemm g, const Sched& S, const Epi& E) {
    const int tid = threadIdx.x, wid = __builtin_amdgcn_readfirstlane(tid >> 6), lane = tid & 63, wr = wid >> 2, wc = wid & 3, fr = lane & 15, fq = lane >> 4;
    const int K = g.K, nt = K / BK;
    unsigned voffA[2], voffB[2];
#pragma unroll
    for (int i = 0; i < 2; ++i) { int R, C; stage_rc(tid * 16 + i * 8192, R, C); const int Rb = Epi::PERM ? ((R & ~31) + perm32(R & 31)) : R;
        voffA[i] = (unsigned)(R * K + C) * 2u; voffB[i] = (unsigned)(Rb * K + C) * 2u; }
    const size_t kstep = (size_t)(BK * 2);
    const size_t hstep = (size_t)HALF * K * 2;
    const size_t tstep = 2 * hstep;
    const unsigned ldsw = (unsigned)wid * 1024u;
    const int aoff = lds_byte(wr * 64 + fr, fq * 8), boff = lds_byte(wc * 32 + fr, fq * 8);
#define PG8_SA(b, h) (((b) * 2 + (h)) * HTB)
#define PG8_SB(b, h) ((4 + (b) * 2 + (h)) * HTB)
#define PG8_STAGE(bufoff, gbase, voff) do { _Pragma("unroll") for (int _i = 0; _i < 2; ++_i) \
        __builtin_amdgcn_global_load_lds((const unsigned*)((const char*)(gbase) + (voff)[_i]), (PG8_LAS unsigned*)(lds + (bufoff) + ldsw + _i * 8192), 16, 0, 0); } while (0)
#define PG8_LDA(dst, b, h) do { _Pragma("unroll") for (int m = 0; m < 4; ++m) _Pragma("unroll") for (int k = 0; k < 2; ++k) dst[m][k] = *(const PG8_LAS bf16x8*)(lds + PG8_SA(b, h) + aoff + m * 2048 + k * 1024); } while (0)
#define PG8_LDB(dst, b, h) do { _Pragma("unroll") for (int n = 0; n < 2; ++n) _Pragma("unroll") for (int k = 0; k < 2; ++k) dst[n][k] = *(const PG8_LAS bf16x8*)(lds + PG8_SB(b, h) + boff + n * 2048 + k * 1024); } while (0)
#define PG8_MMA(ai, bj, At, Bt) do { __builtin_amdgcn_s_setprio(1); _Pragma("unroll") for (int m = 0; m < 4; ++m) _Pragma("unroll") for (int n = 0; n < 2; ++n) _Pragma("unroll") for (int k = 0; k < 2; ++k) \
        acc[ai][bj][m][n] = __builtin_amdgcn_mfma_f32_16x16x32_bf16(Bt[n][k], At[m][k], acc[ai][bj][m][n], 0, 0, 0); __builtin_amdgcn_s_setprio(0); } while (0)
#define PG8_WAIT_V(n) asm volatile("s_waitcnt vmcnt(" #n ")" ::: "memory")
#define PG8_WAIT_L(n) asm volatile("s_waitcnt lgkmcnt(" #n ")" ::: "memory")
#define PG8_BAR __builtin_amdgcn_s_barrier()
#define PG8_SCHED __builtin_amdgcn_sched_barrier(0)
    Unit cur, nxt; int ui = 0;
    if (!S.next(0, cur)) return;
    f32x4 acc[2][2][4][2];
#pragma unroll
    for (int a = 0; a < 2; ++a)
#pragma unroll
        for (int b = 0; b < 2; ++b)
#pragma unroll
            for (int m = 0; m < 4; ++m)
#pragma unroll
                for (int n = 0; n < 2; ++n) acc[a][b][m][n] = (f32x4){0.f, 0.f, 0.f, 0.f};
    bf16x8 At[4][2], B0[2][2], B1[2][2];
    const char* cA = (const char*)g.A + (size_t)cur.pm * tstep; const char* cB = (const char*)g.Bt + (size_t)cur.pn * tstep;
    S.a_ready(cur);
    if constexpr (SP2) {
        PG8_STAGE(PG8_SB(0, 0), cB, voffB); PG8_STAGE(PG8_SB(0, 1), cB + hstep, voffB); PG8_STAGE(PG8_SA(0, 0), cA, voffA); PG8_STAGE(PG8_SA(0, 1), cA + hstep, voffA);
        if (wr == 1) PG8_BAR;
        PG8_WAIT_V(2); PG8_BAR;
        PG8_STAGE(PG8_SB(1, 0), cB + kstep, voffB); PG8_STAGE(PG8_SA(1, 0), cA + kstep, voffA); PG8_STAGE(PG8_SB(1, 1), cB + hstep + kstep, voffB);
        PG8_WAIT_V(6); PG8_BAR;
    } else {
        PG8_STAGE(PG8_SB(0, 0), cB, voffB); PG8_STAGE(PG8_SA(0, 0), cA, voffA); PG8_STAGE(PG8_SB(0, 1), cB + hstep, voffB); PG8_STAGE(PG8_SA(0, 1), cA + hstep, voffA);
        if (wr == 1) PG8_BAR;
        PG8_WAIT_V(4); PG8_BAR;
        PG8_STAGE(PG8_SB(1, 0), cB + kstep, voffB); PG8_STAGE(PG8_SA(1, 0), cA + kstep, voffA); PG8_STAGE(PG8_SB(1, 1), cB + hstep + kstep, voffB);
        PG8_WAIT_V(6); PG8_BAR;
    }
    for (;;) {
        const bool has_next = S.next(ui + 1, nxt);
        const char* nA = has_next ? (const char*)g.A + (size_t)nxt.pm * tstep : cA; const char* nB = has_next ? (const char*)g.Bt + (size_t)nxt.pn * tstep : cB;
        for (int t = 0; t < nt; t += 2) {
            const bool last = (t == nt - 2);
            const char* a1 = cA + (size_t)(t + 1) * kstep;
            const char* a2 = last ? nA : cA + (size_t)(t + 2) * kstep; const char* b2 = last ? nB : cB + (size_t)(t + 2) * kstep;
            const char* a3 = a2 + kstep; const char* b3 = b2 + kstep;
            if (last && has_next) S.a_ready(nxt);
            if constexpr (SP2) {
            PG8_LDB(B0, 0, 0); PG8_LDB(B1, 0, 1); PG8_SCHED; PG8_LDA(At, 0, 0); PG8_STAGE(PG8_SA(1, 1), a1 + hstep, voffA);
            PG8_WAIT_V(8); PG8_WAIT_L(0); PG8_BAR; PG8_MMA(0, 0, At, B0); PG8_MMA(0, 1, At, B1); PG8_BAR; PG8_SCHED;
            PG8_LDA(At, 0, 1); PG8_STAGE(PG8_SB(0, 0), b2, voffB); PG8_STAGE(PG8_SB(0, 1), b2 + hstep, voffB); PG8_STAGE(PG8_SA(0, 0), a2, voffA);
            PG8_WAIT_V(8); PG8_WAIT_L(0); PG8_BAR; PG8_MMA(1, 0, At, B0); PG8_MMA(1, 1, At, B1); PG8_BAR; PG8_SCHED;
            PG8_LDB(B0, 1, 0); PG8_LDB(B1, 1, 1); PG8_SCHED; PG8_LDA(At, 1, 0); PG8_STAGE(PG8_SA(0, 1), a2 + hstep, voffA);
            PG8_WAIT_V(8); PG8_WAIT_L(0); PG8_BAR; PG8_MMA(0, 0, At, B0); PG8_MMA(0, 1, At, B1); PG8_BAR; PG8_SCHED;
            PG8_LDA(At, 1, 1); PG8_STAGE(PG8_SB(1, 0), b3, voffB); PG8_STAGE(PG8_SB(1, 1), b3 + hstep, voffB); PG8_STAGE(PG8_SA(1, 0), a3, voffA);
            PG8_WAIT_V(8); PG8_WAIT_L(0); PG8_BAR; PG8_MMA(1, 0, At, B0); PG8_MMA(1, 1, At, B1); PG8_BAR; PG8_SCHED;
            } else {
            PG8_LDB(B0, 0, 0); PG8_SCHED; PG8_LDA(At, 0, 0); PG8_STAGE(PG8_SA(1, 1), a1 + hstep, voffA);
            PG8_WAIT_L(8); PG8_BAR; PG8_WAIT_L(0); PG8_MMA(0, 0, At, B0); PG8_BAR; PG8_SCHED;
            PG8_LDB(B1, 0, 1); PG8_STAGE(PG8_SB(0, 0), b2, voffB);
            PG8_BAR; PG8_WAIT_L(0); PG8_MMA(0, 1, At, B1); PG8_BAR;
            PG8_LDA(At, 0, 1); PG8_STAGE(PG8_SA(0, 0), a2, voffA);
            PG8_BAR; PG8_WAIT_L(0); PG8_MMA(1, 0, At, B0); PG8_BAR; PG8_SCHED;
            PG8_STAGE(PG8_SB(0, 1), b2 + hstep, voffB);
            PG8_WAIT_V(6); PG8_BAR; PG8_MMA(1, 1, At, B1); PG8_BAR;
            PG8_LDB(B0, 1, 0); PG8_SCHED; PG8_LDA(At, 1, 0); PG8_STAGE(PG8_SA(0, 1), a2 + hstep, voffA);
            PG8_WAIT_L(8); PG8_BAR; PG8_WAIT_L(0); PG8_MMA(0, 0, At, B0); PG8_BAR; PG8_SCHED;
            PG8_LDB(B1, 1, 1); PG8_STAGE(PG8_SB(1, 0), b3, voffB);
            PG8_BAR; PG8_WAIT_L(0); PG8_MMA(0, 1, At, B1); PG8_BAR;
            PG8_LDA(At, 1, 1); PG8_STAGE(PG8_SA(1, 0), a3, voffA);
            PG8_BAR; PG8_WAIT_L(0); PG8_MMA(1, 0, At, B0); PG8_BAR; PG8_SCHED;
            PG8_STAGE(PG8_SB(1, 1), b3 + hstep, voffB);
            PG8_WAIT_V(6); PG8_BAR; PG8_MMA(1, 1, At, B1); PG8_BAR;
            }
        }
        if constexpr (ALIGN_EPI) { if (wr == 0) PG8_BAR; }
        if constexpr (!Epi::AFTER_DRAIN) { E(acc, cur, wr, wc, fr, fq); S.done(cur); }
        if (!has_next) break;
#pragma unroll
        for (int a = 0; a < 2; ++a)
#pragma unroll
            for (int b = 0; b < 2; ++b)
#pragma unroll
                for (int m = 0; m < 4; ++m)
#pragma unroll
                    for (int n = 0; n < 2; ++n) acc[a][b][m][n] = (f32x4){0.f, 0.f, 0.f, 0.f};
        cur = nxt; cA = nA; cB = nB; ++ui;
        if constexpr (ALIGN_EPI) { if (wr == 1) PG8_BAR; }
    }
    PG8_WAIT_V(0);
    if constexpr (!ALIGN_EPI) { if (wr == 0) PG8_BAR; }
    PG8_BAR;
    if constexpr (Epi::AFTER_DRAIN) { E.fused(acc, cur, wr, wc, fr, fq, lds, wid, lane); S.done(cur); }
#undef PG8_SA
#undef PG8_SB
#undef PG8_STAGE
#undef PG8_LDA
#undef PG8_LDB
#undef PG8_MMA
#undef PG8_WAIT_V
#undef PG8_WAIT_L
#undef PG8_BAR
#undef PG8_SCHED
}
}
namespace pg8 {
__device__ __forceinline__ unsigned f2bf_(float f) { unsigned u = __builtin_bit_cast(unsigned, f); return (u + 0x7fffu + ((u >> 16) & 1u)) >> 16; }
struct EpiF32Res {
    static constexpr bool PERM = false, AFTER_DRAIN = false;
    const float* xp; float* out; bf16_t* outb; float* ssq; int ldc;
    __device__ __forceinline__ void operator()(const f32x4 (&acc)[2][2][4][2], const Unit& u, int wr, int wc, int fr, int fq) const {
        const int col0 = u.pn * BM + wc * 32 + 4 * fq;
#pragma unroll
        for (int ai = 0; ai < 2; ++ai)
#pragma unroll
            for (int m = 0; m < 4; ++m) {
                const int row = u.pm * BM + ai * HALF + wr * 64 + m * 16 + fr;
                const float* src = xp + (size_t)row * ldc; float* dst = out + (size_t)row * ldc; bf16_t* dstb = outb + (size_t)row * ldc;
                float s = 0.f;
#pragma unroll
                for (int bj = 0; bj < 2; ++bj)
#pragma unroll
                    for (int n = 0; n < 2; ++n) { const int c = col0 + bj * HALF + n * 16; const f32x4 v = *(const f32x4*)(src + c) + acc[ai][bj][m][n]; *(f32x4*)(dst + c) = v;
                        s += (v[0] * v[0] + v[1] * v[1]) + (v[2] * v[2] + v[3] * v[3]);
                        unsigned w0 = f2bf_(v[0]) | (f2bf_(v[1]) << 16), w1 = f2bf_(v[2]) | (f2bf_(v[3]) << 16);
                        typedef unsigned u32x2 __attribute__((ext_vector_type(2))); *(u32x2*)(dstb + c) = (u32x2){w0, w1}; }
                s += __shfl_xor(s, 16); s += __shfl_xor(s, 32);
                if (fq == 0) ssq[(size_t)row * 32 + u.pn * 4 + wc] = s;
            }
    }
};
struct EpiBf16RowScale {
    static constexpr bool PERM = true, AFTER_DRAIN = false;
    bf16_t* O; int ldc; const float* rs;
    __device__ __forceinline__ void operator()(const f32x4 (&acc)[2][2][4][2], const Unit& u, int wr, int wc, int fr, int fq) const {
        const int row0 = u.pm * BM + wr * 64 + fr, col0 = u.pn * BM + wc * 32 + 8 * fq;
#pragma unroll
        for (int ai = 0; ai < 2; ++ai)
#pragma unroll
            for (int m = 0; m < 4; ++m) { const int rl = wr * 64 + fr + ai * HALF + m * 16; const float sc = rs[rl]; bf16_t* rowp = O + (size_t)(row0 + ai * HALF + m * 16) * ldc + col0;
#pragma unroll
                for (int bj = 0; bj < 2; ++bj) { const f32x4 v0 = acc[ai][bj][m][0] * sc, v1 = acc[ai][bj][m][1] * sc;
                    u32x4 w; w.x = cvt_pk_bf16(v0[0], v0[1]); w.y = cvt_pk_bf16(v0[2], v0[3]); w.z = cvt_pk_bf16(v1[0], v1[1]); w.w = cvt_pk_bf16(v1[2], v1[3]);
                    *(u32x4*)(rowp + bj * HALF) = w; } }
    }
};
}

#ifndef MK_N_LAUNCHES
#define MK_N_LAUNCHES 1
#endif
constexpr int N_PHASES = 9;
constexpr int N_LAUNCHES = MK_N_LAUNCHES;
constexpr int NWAVES = 8;

constexpr int DM = 2048;
constexpr int TP = 8192, TS = 128, TT = TP + TS;
constexpr int MP = 8448;
constexpr int NP = 16384;
constexpr int PLD = NP + 64;
constexpr int C_Q = 0, C_K = 1024, C_V = 2048, C_R = 4096, C_CB = 6144, C_CC = 8192, C_CX = 10240, C_GA = 12288, C_GB = 14336;
constexpr int DIN = 16400;
constexpr int NEXP = 16384;
constexpr float EPS = 1e-6f;

constexpr size_t MiB = 1u << 20;
constexpr size_t WS_CTL = 0, CTL_ZERO_BYTES = 1 * MiB;
constexpr size_t WS_WINT = 2 * MiB;
constexpr size_t WS_WOUTT = 68 * MiB;
constexpr size_t WS_WQT = 76 * MiB;
constexpr size_t WS_EU = 84 * MiB;
constexpr size_t WS_EV = 148 * MiB;
constexpr size_t WS_XN = 212 * MiB;
constexpr size_t WS_P = 246 * MiB;
constexpr size_t WS_QT = 516 * MiB;
constexpr size_t WS_KT = 532 * MiB;
constexpr size_t WS_VT = 548 * MiB;
constexpr size_t WS_ATT = 580 * MiB;
constexpr size_t WS_EBL = 584 * MiB;
constexpr size_t WS_SKB = 585 * MiB;
constexpr size_t WS_O = 586 * MiB;
constexpr size_t WS_MM = 620 * MiB;
constexpr size_t WS_X2 = 654 * MiB;
constexpr size_t WS_H2 = 720 * MiB;
constexpr size_t WS_SSQ = 799 * MiB;
constexpr size_t WS_QP = 754 * MiB;
constexpr size_t WS_IDX = 788 * MiB;
constexpr size_t WS_GW = 793 * MiB;
constexpr size_t WS_ALR = 798 * MiB;
constexpr size_t WS_SSQS = 799 * MiB + 1100 * 1024;
constexpr size_t WS_RS2 = 799 * MiB + 1200 * 1024;
constexpr size_t WS_END = 801 * MiB;
constexpr int CW_TMO = 0, CW_CODE = 1, CW_BAR = 4096, CW_QUEUE = 16384;

constexpr size_t OUT_Y = 0;
constexpr size_t OUT_GLAP = (size_t)TT * DM;
constexpr size_t OUT_CONVP = OUT_GLAP + (size_t)4 * 4 * 256 * 512;
constexpr size_t OUT_GLAS = OUT_CONVP + (size_t)4 * 2 * 2048;
constexpr size_t OUT_CONVS = OUT_GLAS + (size_t)128 * 4 * 256 * 512;

constexpr int LDS_BYTES = 163840;
constexpr int LDSCTL_OFF = 162816, MISC_OFF = LDSCTL_OFF + 320;
constexpr int RING_OFF = 0;

#define GAS __attribute__((address_space(1)))
#define LAS __attribute__((address_space(3)))
typedef unsigned short bf16;
typedef unsigned v4u __attribute__((ext_vector_type(4)));
typedef unsigned v2u __attribute__((ext_vector_type(2)));
typedef float f32x4 __attribute__((ext_vector_type(4)));
typedef short bf16x8 __attribute__((ext_vector_type(8)));
typedef GAS unsigned gu32;
typedef float v32f __attribute__((ext_vector_type(32)));
typedef float v16f __attribute__((ext_vector_type(16)));
typedef unsigned v6u __attribute__((ext_vector_type(6)));
constexpr int ROW6 = 1536;
#define RLX_AGENT __ATOMIC_RELAXED, __HIP_MEMORY_SCOPE_AGENT
#define LDS_WAIT() asm volatile("s_waitcnt lgkmcnt(0)" ::: "memory")
#define VM_WAIT() asm volatile("s_waitcnt vmcnt(0)" ::: "memory")
#define MFMA16(a, b, c) __builtin_amdgcn_mfma_f32_16x16x32_bf16((a), (b), (c), 0, 0, 0)
__device__ __forceinline__ unsigned f2bf(float f) { unsigned u = __builtin_bit_cast(unsigned, f); return (u + 0x7fffu + ((u >> 16) & 1u)) >> 16; }
__device__ __forceinline__ unsigned pk2(float lo, float hi) { return f2bf(lo) | (f2bf(hi) << 16); }
__device__ __forceinline__ float bf2f(unsigned b) { return __builtin_bit_cast(float, b << 16); }
__device__ __forceinline__ float bflo(unsigned w) { return __builtin_bit_cast(float, w << 16); }
__device__ __forceinline__ float bfhi(unsigned w) { return __builtin_bit_cast(float, w & 0xffff0000u); }
__device__ __forceinline__ void unpack8(const v4u w, float (&f)[8]) { f[0] = bflo(w.x); f[1] = bfhi(w.x); f[2] = bflo(w.y); f[3] = bfhi(w.y); f[4] = bflo(w.z); f[5] = bfhi(w.z); f[6] = bflo(w.w); f[7] = bfhi(w.w); }
__device__ __forceinline__ v4u pack8(const float (&f)[8]) { v4u w; w.x = pk2(f[0], f[1]); w.y = pk2(f[2], f[3]); w.z = pk2(f[4], f[5]); w.w = pk2(f[6], f[7]); return w; }
__device__ __forceinline__ float wave_sum(float v) {
#pragma unroll
    for (int o = 1; o < 64; o <<= 1) v += __shfl_xor(v, o);
    return v;
}
__device__ __forceinline__ float sigmoidf_(float x) { return 1.0f / (1.0f + __expf(-x)); }
#define XB_TMO      128
#define XB_XCNT(j)  (256  + 64 * (j))
#define XB_XSUB(j)  (1280 + 64 * (j))
#define XB_XGEN(j)  (2304 + 64 * (j))
#define XB_TOP      3328
#define XB_TOPGEN   3392
#define XCD_BAR_WORDS 3456
#define XB_SPIN_CAP (1u << 18)

__device__ __forceinline__ unsigned xb_ld(unsigned* p)              { return __hip_atomic_load(p, __ATOMIC_RELAXED, __HIP_MEMORY_SCOPE_AGENT); }
__device__ __forceinline__ unsigned xb_add(unsigned* p, unsigned v) { return __hip_atomic_fetch_add(p, v, __ATOMIC_RELAXED, __HIP_MEMORY_SCOPE_AGENT); }
__device__ __forceinline__ unsigned xb_xcc_id() { return (unsigned)__builtin_amdgcn_s_getreg((3 << 11) | 20) & 0xFu; }
#define XB_SPIN(cond, bar) do { unsigned _sp = 0; while (cond) { __builtin_amdgcn_s_sleep(1); \
    if ((++_sp & 255u) == 0u) { if (xb_ld(&(bar)[XB_TMO])) break; if (_sp > XB_SPIN_CAP) { atomicAdd(&(bar)[XB_TMO], 1u); break; } } } } while (0)

struct XcdBarrier {
    unsigned* bar; unsigned x;
    volatile LAS unsigned* st;
};

__device__ __forceinline__ XcdBarrier xcd_barrier_post(unsigned* bar, volatile LAS unsigned* st) {
    XcdBarrier b; b.bar = bar; b.x = xb_xcc_id(); b.st = st;
    if (threadIdx.x == 0) (void)xb_add(&bar[XB_XCNT(b.x)], 1u);
    return b;
}
__device__ __forceinline__ void xcd_barrier_complete(unsigned* bar, unsigned x, unsigned& nloc, unsigned& nx) {
    const unsigned G = gridDim.x * gridDim.y * gridDim.z;
    unsigned sum, cnt, mine, sp = 0u;
    for (;;) {
        sum = 0u; cnt = 0u; mine = 0u;
#pragma unroll
        for (unsigned j = 0; j < 16; ++j) { const unsigned c = xb_ld(&bar[XB_XCNT(j)]); sum += c; cnt += (c > 0u) ? 1u : 0u; mine = (j == x) ? c : mine; }
        if (sum == G) break;
        __builtin_amdgcn_s_sleep(1);
        if ((++sp & 255u) == 0u) { if (xb_ld(&bar[XB_TMO])) break; if (sp > XB_SPIN_CAP) { atomicAdd(&bar[XB_TMO], 1u); break; } }
    }
    nloc = mine > 0u ? mine : 1u; nx = cnt > 0u ? cnt : 1u;
}

__device__ __forceinline__ void xcd_barrier(const XcdBarrier& b) {
    asm volatile("s_waitcnt vmcnt(0)" ::: "memory");
    __syncthreads();
    if (threadIdx.x == 0) {
        unsigned* bar = b.bar;
        __builtin_amdgcn_s_waitcnt(0);
        unsigned nloc = b.st[0], nx = b.st[1];
        if (nloc == 0u) { xcd_barrier_complete(bar, b.x, nloc, nx); b.st[0] = nloc; b.st[1] = nx; }
        const unsigned old = xb_add(&bar[XB_XSUB(b.x)], 1u);
        const unsigned gen = old / nloc;
        if (old + 1u == (gen + 1u) * nloc) {
            __builtin_amdgcn_fence(__ATOMIC_RELEASE, "agent");
            asm volatile("s_waitcnt vmcnt(0)" ::: "memory");
            const unsigned og = xb_add(&bar[XB_TOP], 1u);
            const unsigned tg = og / nx;
            if (og + 1u == (tg + 1u) * nx) xb_add(&bar[XB_TOPGEN], 1u);
            else XB_SPIN(xb_ld(&bar[XB_TOPGEN]) == tg, bar);
            __builtin_amdgcn_fence(__ATOMIC_ACQUIRE, "agent");
            xb_add(&bar[XB_XGEN(b.x)], 1u);
            asm volatile("s_waitcnt vmcnt(0)" ::: "memory");
        } else {
            XB_SPIN(xb_ld(&bar[XB_XGEN(b.x)]) == gen, bar);
            __builtin_amdgcn_fence(__ATOMIC_ACQUIRE, "agent");
            asm volatile("s_waitcnt vmcnt(0)" ::: "memory");
        }
    }
    __syncthreads();
}
struct Frame {
    unsigned char* lds;
    int tid, lane, wave, vcu, G;
    const float *xp, *xs, *sgla, *sconv, *n1g, *win, *wau, *bal, *gng, *cw, *cb, *wout, *n2g, *wq, *sk, *eu, *ev, *nfg;
    float* out;
    unsigned char* ws;
};

__device__ __forceinline__ void p0_transpose_item(const float* W, int ldw, int src_col0, int k0, bf16* WT, int K, int dst_row0, float* scr, int lane, const float* kscale = nullptr) {
    const int n4 = lane & 15, kr = lane >> 4;
#pragma unroll 8
    for (int i = 0; i < 16; ++i) { const int kk = 4 * i + kr; f32x4 v = *(const f32x4*)(W + (size_t)(k0 + kk) * ldw + src_col0 + 4 * n4); if (kscale) v = v * kscale[k0 + kk];
        float* d = scr + kk * 65 + 4 * n4; d[0] = v.x; d[1] = v.y; d[2] = v.z; d[3] = v.w; }
    LDS_WAIT(); asm volatile("" ::: "memory");
    const int c = lane & 7, nr = lane >> 3;
#pragma unroll
    for (int j = 0; j < 8; ++j) { const int n = nr + 8 * j; const float* s = scr + (8 * c) * 65 + n;
        v4u o; o.x = pk2(s[0 * 65], s[1 * 65]); o.y = pk2(s[2 * 65], s[3 * 65]); o.z = pk2(s[4 * 65], s[5 * 65]); o.w = pk2(s[6 * 65], s[7 * 65]);
        *(v4u*)(WT + (size_t)(dst_row0 + n) * K + k0 + 8 * c) = o; }
    LDS_WAIT(); asm volatile("" ::: "memory");
}
__device__ __forceinline__ void rms_row_to_bf16(const float* xrow, const float* g, bf16* orow, int lane) {
    const f32x4* xr = (const f32x4*)xrow + lane; const f32x4* gr = (const f32x4*)g + lane;
    f32x4 v[8]; float s = 0.f;
#pragma unroll
    for (int j = 0; j < 8; ++j) { v[j] = xr[64 * j]; s += (v[j].x * v[j].x + v[j].y * v[j].y) + (v[j].z * v[j].z + v[j].w * v[j].w); }
    const float rstd = 1.0f / sqrtf(wave_sum(s) * (1.0f / DM) + EPS);
    v2u* o8 = (v2u*)orow + lane;
#pragma unroll
    for (int j = 0; j < 8; ++j) { const f32x4 gg = gr[64 * j]; v2u w; w.x = pk2(v[j].x * rstd * gg.x, v[j].y * rstd * gg.y); w.y = pk2(v[j].z * rstd * gg.z, v[j].w * rstd * gg.w); o8[64 * j] = w; }
}
__device__ __forceinline__ void zero_row_bf16(bf16* orow, int lane) {
    v2u* o8 = (v2u*)orow + lane; const v2u z = {0u, 0u};
#pragma unroll
    for (int j = 0; j < 8; ++j) o8[64 * j] = z;
}
__device__ __forceinline__ void p0_prologue(Frame& F) {
    bf16* WINT = (bf16*)(F.ws + WS_WINT); bf16* WOUTT = (bf16*)(F.ws + WS_WOUTT); bf16* WQT = (bf16*)(F.ws + WS_WQT);
    float* scr = (float*)(F.lds + F.wave * 16640);
    const int gw = F.vcu * NWAVES + F.wave, NGW = F.G * NWAVES;
    constexpr int I_IN = 32 * 256, I_SQ = 32 * 32;
    for (int it = gw; it < I_IN + 2 * I_SQ; it += NGW) {
        int r = it;
        if (r < I_IN) { const int kb = r >> 8, nb = r & 255, n0 = 64 * nb; p0_transpose_item(F.win, DIN, n0 + (n0 >= 6144 ? 16 : 0), 64 * kb, WINT, DM, n0, scr, F.lane); continue; }
        r -= I_IN;
        if (r < I_SQ) { const int kb = r >> 5, nb = r & 31; p0_transpose_item(F.wout, DM, 64 * nb, 64 * kb, WOUTT, DM, 64 * nb, scr, F.lane); continue; }
        r -= I_SQ;
        { const int kb = r >> 5, nb = r & 31; p0_transpose_item(F.wq, DM, 64 * nb, 64 * kb, WQT, DM, 64 * nb, scr, F.lane, F.n2g); }
    }
    const size_t gt = (size_t)F.vcu * 512 + F.tid, NGT = (size_t)F.G * 512;
    { bf16* SKB = (bf16*)(F.ws + WS_SKB); for (size_t e = gt; e < (size_t)2 * 128 * 128; e += NGT) SKB[e] = (bf16)f2bf(F.sk[e]); }
    { unsigned char* U6 = F.ws + WS_EU; unsigned char* V6 = F.ws + WS_EV; float* SU = (float*)(F.ws + WS_EU + 32 * MiB); float* SV = (float*)(F.ws + WS_EV + 32 * MiB);
      for (int r = gw; r < 2 * NEXP; r += NGW) {
          const bool isv = r >= NEXP; const int row = isv ? r - NEXP : r;
          const float* src = (isv ? F.ev : F.eu) + (size_t)row * DM;
          f32x4 x[8]; float amax = 0.f;
#pragma unroll
          for (int j = 0; j < 8; ++j) { x[j] = *(const f32x4*)(src + 256 * j + 4 * F.lane); if (!isv) x[j] = x[j] * *(const f32x4*)(F.n2g + 256 * j + 4 * F.lane);
              amax = fmaxf(amax, fmaxf(fmaxf(fabsf(x[j].x), fabsf(x[j].y)), fmaxf(fabsf(x[j].z), fabsf(x[j].w)))); }
#pragma unroll
          for (int o = 1; o < 64; o <<= 1) amax = fmaxf(amax, __shfl_xor(amax, o));
          const float sc = amax > 0.f ? 7.5f / amax : 1.0f;
          v16f pa, pb;
#pragma unroll
          for (int j = 0; j < 8; ++j) { pa[2 * j] = x[j].x * sc; pb[2 * j] = x[j].y * sc; pa[2 * j + 1] = x[j].z * sc; pb[2 * j + 1] = x[j].w * sc; }
          const v6u p = __builtin_amdgcn_cvt_scalef32_2xpk16_fp6_f32(pa, pb, 1.0f);
          unsigned char* dst2 = (isv ? V6 : U6) + (size_t)row * ROW6;
          *(v4u*)(dst2 + 16 * F.lane) = (v4u){p[0], p[1], p[2], p[3]}; *(v2u*)(dst2 + 1024 + 8 * F.lane) = (v2u){p[4], p[5]};
          if (F.lane == 0) (isv ? SV : SU)[row] = amax > 0.f ? amax / 7.5f : 1.0f;
      } }
    __syncthreads();
    { bf16* wt_s = (bf16*)F.lds; constexpr int WLD = DM + 8;
      for (int k = F.tid; k < DM; k += 512) { const float* src = F.win + (size_t)k * DIN + 6144;
#pragma unroll
          for (int q = 0; q < 4; ++q) { const f32x4 w4 = *(const f32x4*)(src + 4 * q); wt_s[(4 * q + 0) * WLD + k] = (bf16)f2bf(w4.x); wt_s[(4 * q + 1) * WLD + k] = (bf16)f2bf(w4.y); wt_s[(4 * q + 2) * WLD + k] = (bf16)f2bf(w4.z); wt_s[(4 * q + 3) * WLD + k] = (bf16)f2bf(w4.w); } }
      bf16* XN = (bf16*)(F.ws + WS_XN); float* ALR = (float*)(F.ws + WS_ALR);
      const int r0 = (int)(((long)F.vcu * TT) / F.G), r1 = (int)(((long)(F.vcu + 1) * TT) / F.G);
      for (int m = r0 + F.wave; m < r1; m += NWAVES) rms_row_to_bf16(m < TP ? F.xp + (size_t)m * DM : F.xs + (size_t)(m - TP) * DM, F.n1g, XN + (size_t)m * DM, F.lane);
      for (int m = TT + gw; m < MP; m += NGW) zero_row_bf16(XN + (size_t)m * DM, F.lane);
      VM_WAIT(); __syncthreads();
      const int l15 = F.lane & 15, lq = F.lane >> 4;
      for (int t0 = r0 + 16 * F.wave; t0 < r1; t0 += 16 * NWAVES) {
          const int row = min(t0 + l15, r1 - 1);
          f32x4 acc = {0.f, 0.f, 0.f, 0.f};
#pragma unroll 8
          for (int ks = 0; ks < 64; ++ks) { const bf16x8 a = *(const bf16x8*)(XN + (size_t)row * DM + 32 * ks + 8 * lq); const bf16x8 bq = *(const bf16x8*)(wt_s + l15 * WLD + 32 * ks + 8 * lq); acc = MFMA16(a, bq, acc); }
#pragma unroll
          for (int r = 0; r < 4; ++r) { const int m = t0 + 4 * lq + r; if (m < r1) ALR[(size_t)m * 16 + l15] = acc[r]; }
      } }
}

template <int NT, class Epi>
__device__ __forceinline__ void skinny_gemm(Frame& F, const bf16* A, const bf16* Bt, int n0, const Epi& E) {
    constexpr int ROWS = NT * 16, NPC = (ROWS * 32 + 511) / 512, BLD = 264;
    bf16* Bs = (bf16*)F.lds;
    const int tid = F.tid, wv = F.wave, l15 = F.lane & 15, lq = F.lane >> 4;
    f32x4 acc[NT];
#pragma unroll
    for (int nt = 0; nt < NT; ++nt) acc[nt] = (f32x4){0.f, 0.f, 0.f, 0.f};
    v4u breg[NPC];
#pragma unroll
    for (int i = 0; i < NPC; ++i) { const int p = tid + 512 * i; if (p < ROWS * 32) breg[i] = *(const v4u*)(Bt + (size_t)(n0 + (p >> 5)) * DM + 8 * (p & 31)); }
#pragma unroll
    for (int i = 0; i < NPC; ++i) { const int p = tid + 512 * i; if (p < ROWS * 32) *(v4u*)(Bs + (p >> 5) * BLD + 8 * (p & 31)) = breg[i]; }
    __syncthreads();
    const bf16* Arow = A + (size_t)(16 * wv + l15) * DM + 8 * lq;
    bf16x8 a[8], an[8];
#pragma unroll
    for (int ks = 0; ks < 8; ++ks) a[ks] = *(const bf16x8*)(Arow + 32 * ks);
#pragma unroll 1
    for (int kc = 0; kc < 8; ++kc) {
        if (kc < 7) {
#pragma unroll
            for (int i = 0; i < NPC; ++i) { const int p = tid + 512 * i; if (p < ROWS * 32) breg[i] = *(const v4u*)(Bt + (size_t)(n0 + (p >> 5)) * DM + (kc + 1) * 256 + 8 * (p & 31)); }
#pragma unroll
            for (int ks = 0; ks < 8; ++ks) an[ks] = *(const bf16x8*)(Arow + (kc + 1) * 256 + 32 * ks); }
        const bf16* Bc = Bs + (kc & 1) * ROWS * BLD;
#pragma unroll
        for (int ks = 0; ks < 8; ++ks)
#pragma unroll
            for (int nt = 0; nt < NT; ++nt) { const bf16x8 bq = *(const bf16x8*)(Bc + (16 * nt + l15) * BLD + 32 * ks + 8 * lq); acc[nt] = MFMA16(a[ks], bq, acc[nt]); }
        if (kc < 7) { bf16* Bn = Bs + ((kc + 1) & 1) * ROWS * BLD;
#pragma unroll
            for (int i = 0; i < NPC; ++i) { const int p = tid + 512 * i; if (p < ROWS * 32) *(v4u*)(Bn + (p >> 5) * BLD + 8 * (p & 31)) = breg[i]; }
#pragma unroll
            for (int ks = 0; ks < 8; ++ks) a[ks] = an[ks]; }
        __syncthreads();
    }
    E.template tile<NT>(acc, wv, l15, lq, n0);
}
struct EpiSkBf16 { bf16* out; int ldc; const float* rs;
    template <int NT> __device__ __forceinline__ void tile(const f32x4 (&acc)[NT], int wv, int l15, int lq, int n0) const {
#pragma unroll
        for (int r = 0; r < 4; ++r) { const int row = 16 * wv + 4 * lq + r; const float sc = rs ? rs[row] : 1.0f;
#pragma unroll
            for (int nt = 0; nt < NT; ++nt) out[(size_t)row * ldc + n0 + 16 * nt + l15] = (bf16)f2bf(acc[nt][r] * sc); } } };
struct EpiSkF32Res { const float* xs; float* out; bf16* outb; float* ssqs;
    template <int NT> __device__ __forceinline__ void tile(const f32x4 (&acc)[NT], int wv, int l15, int lq, int n0) const {
        static_assert(NT == 1, "one 16-column group");
#pragma unroll
        for (int r = 0; r < 4; ++r) { const int row = 16 * wv + 4 * lq + r; const size_t o = (size_t)row * DM + n0 + l15; const float v = xs[o] + acc[0][r]; out[o] = v; outb[o] = (bf16)f2bf(v);
            float s = v * v; s += __shfl_xor(s, 1); s += __shfl_xor(s, 2); s += __shfl_xor(s, 4); s += __shfl_xor(s, 8);
            if (l15 == 0) ssqs[row * 128 + (n0 >> 4)] = s; } } };

__device__ __forceinline__ float logsig(float x) { return fminf(x, 0.f) - __logf(1.0f + __expf(-fabsf(x))); }
__device__ __forceinline__ void gla_prep_unit(Frame& F, int u) {
    const bf16* P = (const bf16*)(F.ws + WS_P); bf16* QT = (bf16*)(F.ws + WS_QT); bf16* KT = (bf16*)(F.ws + WS_KT); bf16* VT = (bf16*)(F.ws + WS_VT);
    bf16* ATT = (bf16*)(F.ws + WS_ATT); float* EBL = (float*)(F.ws + WS_EBL);
    const int b = u >> 7, h = (u >> 5) & 3, c = u & 31, tid = F.tid;
    const int row0 = b * 2048 + c * 64;
    float* alr_s = (float*)F.lds;
    float* tot_s = (float*)(F.lds + 4096);
    bf16* q_s = (bf16*)(F.lds + 8192);
    bf16* k_s = q_s + 64 * 264;
    bf16* v_s = k_s + 64 * 264;
    { v4u tq[4], tk[4], tv[8];
#pragma unroll
      for (int i = 0; i < 4; ++i) { const int p = tid + 512 * i, row = p >> 5, ch = p & 31; const bf16* src = P + (size_t)(row0 + row) * PLD + h * 256 + 8 * ch; tq[i] = *(const v4u*)(src + C_Q); tk[i] = *(const v4u*)(src + C_K); }
#pragma unroll
      for (int i = 0; i < 8; ++i) { const int p = tid + 512 * i, row = p >> 6, ch = p & 63; tv[i] = *(const v4u*)(P + (size_t)(row0 + row) * PLD + C_V + h * 512 + 8 * ch); }
      for (int e = tid; e < 1024; e += 512) alr_s[e] = ((const float*)(F.ws + WS_ALR))[(size_t)row0 * 16 + e];
#pragma unroll
      for (int i = 0; i < 4; ++i) { const int p = tid + 512 * i, row = p >> 5, ch = p & 31; *(v4u*)(q_s + row * 264 + 8 * ch) = tq[i]; *(v4u*)(k_s + row * 264 + 8 * ch) = tk[i]; }
#pragma unroll
      for (int i = 0; i < 8; ++i) { const int p = tid + 512 * i, row = p >> 6, ch = p & 63; *(v4u*)(v_s + row * 520 + 8 * ch) = tv[i]; } }
    const int d = tid & 255, half = tid >> 8;
    float w[16];
#pragma unroll
    for (int r = 0; r < 16; ++r) w[r] = F.wau[r * 1024 + h * 256 + d];
    const float bias = F.bal[h * 256 + d];
    __syncthreads();
    float bb[32]; float run = 0.f;
#pragma unroll
    for (int jj = 0; jj < 32; ++jj) { const int j = half * 32 + jj; float x = bias;
#pragma unroll
        for (int r = 0; r < 16; ++r) x += alr_s[j * 16 + r] * w[r];
        run += logsig(x) * 0.0625f; bb[jj] = run; }
    if (half == 0) tot_s[d] = run;
    __syncthreads();
    if (half == 1) { const float t = tot_s[d];
#pragma unroll
        for (int jj = 0; jj < 32; ++jj) bb[jj] += t; }
    unsigned ktp[16];
#pragma unroll
    for (int jj = 0; jj < 32; ++jj) { const int j = half * 32 + jj;
        const float qv = bf2f(q_s[j * 264 + d]), kv = bf2f(k_s[j * 264 + d]);
        const float e = __expf(bb[jj]), ei = __expf(-bb[jj]);
        const unsigned qb = f2bf(qv * 0.0625f * e), kb = f2bf(kv * ei);
        q_s[j * 264 + d] = (bf16)qb; k_s[j * 264 + d] = (bf16)kb;
        if (jj & 1) ktp[jj >> 1] |= kb << 16; else ktp[jj >> 1] = kb; }
    { v4u* dst = (v4u*)(KT + ((size_t)u * 256 + d) * 64 + half * 32);
#pragma unroll
      for (int i = 0; i < 4; ++i) { v4u o; o.x = ktp[4 * i]; o.y = ktp[4 * i + 1]; o.z = ktp[4 * i + 2]; o.w = ktp[4 * i + 3]; dst[i] = o; } }
    if (half == 1) EBL[u * 256 + d] = __expf(bb[31]);
    __syncthreads();
#pragma unroll
    for (int i = 0; i < 4; ++i) { const int p = tid + 512 * i, row = p >> 5, ch = p & 31; *(v4u*)(QT + (size_t)(row0 + row) * 1024 + h * 256 + 8 * ch) = *(const v4u*)(q_s + row * 264 + 8 * ch); }
    { const int wv = F.wave, l15 = F.lane & 15, lq = F.lane >> 4, mi = wv >> 1;
#pragma unroll
      for (int nn = 0; nn < 2; ++nn) { const int ni = (wv & 1) * 2 + nn; f32x4 acc = {0.f, 0.f, 0.f, 0.f};
#pragma unroll
          for (int ks = 0; ks < 8; ++ks) { const bf16x8 a = *(const bf16x8*)(q_s + (16 * mi + l15) * 264 + 32 * ks + 8 * lq); const bf16x8 bq = *(const bf16x8*)(k_s + (16 * ni + l15) * 264 + 32 * ks + 8 * lq); acc = MFMA16(a, bq, acc); }
#pragma unroll
          for (int r = 0; r < 4; ++r) { const int i = 16 * mi + 4 * lq + r, jn = 16 * ni + l15; ATT[(size_t)u * 4096 + i * 64 + jn] = (bf16)f2bf(jn <= i ? acc[r] : 0.f); } } }
    { const int dv = tid; unsigned vp[32];
#pragma unroll
      for (int j = 0; j < 64; ++j) { const unsigned v = v_s[j * 520 + dv]; if (j & 1) vp[j >> 1] |= v << 16; else vp[j >> 1] = v; }
      v4u* dst = (v4u*)(VT + ((size_t)u * 512 + dv) * 64);
#pragma unroll
      for (int i = 0; i < 8; ++i) { v4u o; o.x = vp[4 * i]; o.y = vp[4 * i + 1]; o.z = vp[4 * i + 2]; o.w = vp[4 * i + 3]; dst[i] = o; } }
    __syncthreads();
}

__device__ __forceinline__ void gla_sample_unit(Frame& F, int u) {
    const bf16* P = (const bf16*)(F.ws + WS_P); bf16* O = (bf16*)(F.ws + WS_O);
    const int n = u >> 2, h = u & 3, tid = F.tid, lane = F.lane, wv = F.wave;
    const size_t m = (size_t)(TP + n);
    float* e_s = (float*)F.lds;
    float* qe_s = e_s + 256;
    float* k_s = qe_s + 256;
    float* v_s = k_s + 256;
    float* red_s = v_s + 512;
    float* op_s = red_s + 64;
    float part = 0.f;
    if (tid < 256) { const int d = tid; float x = F.bal[h * 256 + d];
#pragma unroll
        for (int r = 0; r < 16; ++r) x += ((const float*)(F.ws + WS_ALR))[m * 16 + r] * F.wau[r * 1024 + h * 256 + d];
        const float la = logsig(x) * 0.0625f, e = __expf(la);
        const float q = bf2f(P[m * PLD + C_Q + h * 256 + d]) * 0.0625f, k = bf2f(P[m * PLD + C_K + h * 256 + d]);
        e_s[d] = e; qe_s[d] = q * e; k_s[d] = k; part = q * k; }
    v_s[tid] = bf2f(P[m * PLD + C_V + h * 512 + tid]);
    part = wave_sum(part);
    if (lane == 0) red_s[wv] = part;
    __syncthreads();
    const float attn = (red_s[0] + red_s[1]) + (red_s[2] + red_s[3]);
    const float* Sin = F.sgla + ((size_t)(n * 4 + h) * 256) * 512; float* Sout = F.out + OUT_GLAS + ((size_t)(n * 4 + h) * 256) * 512;
    const f32x4 v0 = *(const f32x4*)(v_s + 4 * lane), v1 = *(const f32x4*)(v_s + 256 + 4 * lane);
    f32x4 o0 = {0.f, 0.f, 0.f, 0.f}, o1 = {0.f, 0.f, 0.f, 0.f};
#pragma unroll 1
    for (int g = 0; g < 4; ++g) {
        f32x4 s0[8], s1[8];
#pragma unroll
        for (int i = 0; i < 8; ++i) { const int d = 32 * wv + 8 * g + i; s0[i] = *(const f32x4*)(Sin + (size_t)d * 512 + 4 * lane); s1[i] = *(const f32x4*)(Sin + (size_t)d * 512 + 256 + 4 * lane); }
#pragma unroll
        for (int i = 0; i < 8; ++i) { const int d = 32 * wv + 8 * g + i; const float e = e_s[d], qe = qe_s[d], k = k_s[d];
            o0 += s0[i] * qe; o1 += s1[i] * qe;
            *(f32x4*)(Sout + (size_t)d * 512 + 4 * lane) = s0[i] * e + v0 * k; *(f32x4*)(Sout + (size_t)d * 512 + 256 + 4 * lane) = s1[i] * e + v1 * k; }
    }
    *(f32x4*)(op_s + wv * 512 + 4 * lane) = o0; *(f32x4*)(op_s + wv * 512 + 256 + 4 * lane) = o1;
    __syncthreads();
    { float o = attn * v_s[tid];
#pragma unroll
      for (int w8 = 0; w8 < 8; ++w8) o += op_s[w8 * 512 + tid];
      O[m * DM + h * 512 + tid] = (bf16)f2bf(o); }
    __syncthreads();
}

struct GlaRegs { bf16x8 kt[2][2], at, q[4]; v4u vpiece; };
struct GlaOffs { unsigned att, vt, qt, kt, eb; };
template <int NT>
__device__ __forceinline__ GlaOffs gla_offs(int wv, int l15, int lq, int tid) {
    const int mi = wv >> 1, kh = wv & 1, tv = tid & (NT * 128 - 1); GlaOffs o;
    o.att = (unsigned)(((16 * mi + l15) * 64 + 32 * kh + 8 * lq) * 2);
    o.vt = (unsigned)(((tv >> 3) * 64 + 8 * (tv & 7)) * 2);
    o.qt = (unsigned)(((16 * mi + l15) * 1024 + 128 * kh + 8 * lq) * 2);
    o.kt = (unsigned)(((32 * wv + l15) * 64 + 8 * lq) * 2);
    o.eb = (unsigned)((32 * wv + 4 * lq) * 4);
    return o;
}
template <int NT>
__device__ __forceinline__ void gla_load(GlaRegs& R, const GlaOffs& o, const bf16* QT, const bf16* KT, const bf16* VT, const bf16* ATT, int bh, int s, int c) {
    const size_t u = (size_t)bh * 32 + c; const int b = bh >> 2, h = bh & 3;
    const char* pa = (const char*)(ATT + u * 4096); const char* pv = (const char*)(VT + (u * 512 + 16 * NT * s) * 64);
    const char* pq = (const char*)(QT + ((size_t)b * 2048 + 64 * c) * 1024 + h * 256); const char* pk = (const char*)(KT + u * 256 * 64);
    R.at = *(const bf16x8*)(pa + o.att);
    R.vpiece = *(const v4u*)(pv + o.vt);
#pragma unroll
    for (int ks = 0; ks < 4; ++ks) R.q[ks] = *(const bf16x8*)(pq + o.qt + 64 * ks);
#pragma unroll
    for (int t = 0; t < 2; ++t)
#pragma unroll
        for (int ks = 0; ks < 2; ++ks) R.kt[t][ks] = *(const bf16x8*)(pk + o.kt + 2048 * t + 64 * ks);
}
constexpr int VT_LD = 72;
template <int NT>
__device__ __forceinline__ void gla_step(const GlaRegs& R, const f32x4 (&eb)[2], f32x4 (&S)[2][NT], const bf16* vts, const bf16* STp, bf16* STn, float* xo, int wv, int lane, int l15, int lq) {
    const int mi = wv >> 1, kh = wv & 1;
#pragma unroll
    for (int nt = 0; nt < NT; ++nt) {
        f32x4 acc = {0.f, 0.f, 0.f, 0.f};
        { const bf16x8 vsel = *(const bf16x8*)(vts + (16 * nt + l15) * VT_LD + 32 * kh + 8 * lq); acc = MFMA16(R.at, vsel, acc); }
#pragma unroll
        for (int ks = 0; ks < 4; ++ks) { const bf16x8 sf = *(const bf16x8*)(STp + (16 * nt + l15) * 264 + 128 * kh + 32 * ks + 8 * lq); acc = MFMA16(R.q[ks], sf, acc); }
        *(f32x4*)(xo + (((mi * 2 + kh) * NT + nt) * 64 + lane) * 4) = acc;
    }
#pragma unroll
    for (int nt = 0; nt < NT; ++nt) {
        bf16x8 vt[2];
#pragma unroll
        for (int ks = 0; ks < 2; ++ks) vt[ks] = *(const bf16x8*)(vts + (16 * nt + l15) * VT_LD + 32 * ks + 8 * lq);
#pragma unroll
        for (int mt = 0; mt < 2; ++mt) {
#pragma unroll
            for (int ks = 0; ks < 2; ++ks) S[mt][nt] = MFMA16(R.kt[mt][ks], vt[ks], S[mt][nt]);
            S[mt][nt] = S[mt][nt] * eb[mt];
            v2u w; w.x = pk2(S[mt][nt][0], S[mt][nt][1]); w.y = pk2(S[mt][nt][2], S[mt][nt][3]);
            *(v2u*)(STn + (16 * nt + l15) * 264 + 32 * wv + 16 * mt + 4 * lq) = w; } }
}
template <int NT>
__device__ __forceinline__ void gla_store_o(const float* xo, bf16* O, int b, int h, int s, int c, int wv, int lane, int l15, int lq) {
    const int mi = wv >> 1;
#pragma unroll
    for (int nt = 0; nt < NT; ++nt) { const f32x4 t = *(const f32x4*)(xo + (((mi * 2 + 0) * NT + nt) * 64 + lane) * 4) + *(const f32x4*)(xo + (((mi * 2 + 1) * NT + nt) * 64 + lane) * 4);
#pragma unroll
        for (int r = 0; r < 4; ++r) O[((size_t)b * 2048 + 64 * c + 16 * mi + 4 * lq + r) * DM + h * 512 + 16 * NT * s + 16 * nt + l15] = (bf16)f2bf(t[r]); }
}
#define GLA_BAR() do { asm volatile("s_waitcnt lgkmcnt(0)" ::: "memory"); __builtin_amdgcn_s_barrier(); asm volatile("" ::: "memory"); } while (0)
template <int NT>
__device__ __forceinline__ void gla_main_unit(Frame& F, int bh, int s) {
    const bf16* QT = (const bf16*)(F.ws + WS_QT); const bf16* KT = (const bf16*)(F.ws + WS_KT); const bf16* VT = (const bf16*)(F.ws + WS_VT);
    const bf16* ATT = (const bf16*)(F.ws + WS_ATT); const float* EBL = (const float*)(F.ws + WS_EBL); bf16* O = (bf16*)(F.ws + WS_O);
    const int b = bh >> 2, h = bh & 3, wv = F.wave, lane = F.lane, l15 = lane & 15, lq = lane >> 4, kh = wv & 1, tid = F.tid;
    constexpr int ST_ELEMS = NT * 16 * 264, XO_FLOATS = 8 * NT * 256, VTS_ELEMS = NT * 16 * VT_LD;
    bf16* ST = (bf16*)F.lds;
    float* XO = (float*)(F.lds + 2 * ST_ELEMS * 2);
    bf16* VTS = (bf16*)(F.lds + 2 * ST_ELEMS * 2 + 2 * XO_FLOATS * 4);
    for (int e = tid; e < ST_ELEMS; e += 512) ((unsigned*)ST)[e] = 0u;
    f32x4 S[2][NT];
#pragma unroll
    for (int a = 0; a < 2; ++a)
#pragma unroll
        for (int c2 = 0; c2 < NT; ++c2) S[a][c2] = (f32x4){0.f, 0.f, 0.f, 0.f};
    const GlaOffs go = gla_offs<NT>(wv, l15, lq, tid);
    GlaRegs RA, RB, RC;
    gla_load<NT>(RA, go, QT, KT, VT, ATT, bh, s, 0);
    gla_load<NT>(RB, go, QT, KT, VT, ATT, bh, s, 1);
    if (tid < NT * 128) *(v4u*)(VTS + (tid >> 3) * VT_LD + 8 * (tid & 7)) = RA.vpiece;
    __syncthreads();
#define GLA_ITER(c, RCUR, RNXT, RLD) do { if ((c) < 32) { \
            f32x4 eb[2]; { const char* pe = (const char*)(EBL + ((size_t)bh * 32 + (c)) * 256); eb[0] = *(const f32x4*)(pe + go.eb); eb[1] = *(const f32x4*)(pe + go.eb + 64); } \
            gla_load<NT>(RLD, go, QT, KT, VT, ATT, bh, s, (c) + 2 < 32 ? (c) + 2 : 31); \
            gla_step<NT>(RCUR, eb, S, VTS + ((c) & 1) * VTS_ELEMS, ST + ((c) & 1) * ST_ELEMS, ST + (((c) + 1) & 1) * ST_ELEMS, XO + ((c) & 1) * XO_FLOATS, wv, lane, l15, lq); \
            if (!kh && (c) > 0) gla_store_o<NT>(XO + (((c) + 1) & 1) * XO_FLOATS, O, b, h, s, (c) - 1, wv, lane, l15, lq); \
            if (tid < NT * 128) *(v4u*)(VTS + (((c) + 1) & 1) * VTS_ELEMS + (tid >> 3) * VT_LD + 8 * (tid & 7)) = RNXT.vpiece; \
            GLA_BAR(); \
        } } while (0)
#pragma unroll 1
    for (int c = 0; c < 33; c += 3) { GLA_ITER(c, RA, RB, RC); GLA_ITER(c + 1, RB, RC, RA); GLA_ITER(c + 2, RC, RA, RB); }
#undef GLA_ITER
    if (!kh) gla_store_o<NT>(XO + (31 & 1) * XO_FLOATS, O, b, h, s, 31, wv, lane, l15, lq);
    float* So = F.out + OUT_GLAP + ((size_t)bh * 256) * 512;
#pragma unroll
    for (int mt = 0; mt < 2; ++mt)
#pragma unroll
        for (int nt = 0; nt < NT; ++nt)
#pragma unroll
            for (int r = 0; r < 4; ++r) So[(size_t)(32 * wv + 16 * mt + 4 * lq + r) * 512 + 16 * NT * s + 16 * nt + l15] = S[mt][nt][r];
    __syncthreads();
}

__device__ __forceinline__ void mixer_rows(Frame& F, int m0, int nr) {
    const bf16* P = (const bf16*)(F.ws + WS_P); const bf16* O = (const bf16*)(F.ws + WS_O); bf16* MM = (bf16*)(F.ws + WS_MM);
    const int lane = F.lane; const bool prompt = m0 < TP;
#pragma unroll 1
    for (int j = 0; j < 4; ++j) {
        const int col = 512 * j + 8 * lane;
        float u1[8], u2[8], gn[8], cbi[8], w0[8], w1[8], w2[8];
        { const f32x4 a = *(const f32x4*)(F.gng + col), b2 = *(const f32x4*)(F.gng + col + 4); gn[0] = a.x; gn[1] = a.y; gn[2] = a.z; gn[3] = a.w; gn[4] = b2.x; gn[5] = b2.y; gn[6] = b2.z; gn[7] = b2.w; }
        { const f32x4 a = *(const f32x4*)(F.cb + col), b2 = *(const f32x4*)(F.cb + col + 4); cbi[0] = a.x; cbi[1] = a.y; cbi[2] = a.z; cbi[3] = a.w; cbi[4] = b2.x; cbi[5] = b2.y; cbi[6] = b2.z; cbi[7] = b2.w; }
        { const f32x4 a = *(const f32x4*)(F.cw + col), b2 = *(const f32x4*)(F.cw + col + 4); w0[0] = a.x; w0[1] = a.y; w0[2] = a.z; w0[3] = a.w; w0[4] = b2.x; w0[5] = b2.y; w0[6] = b2.z; w0[7] = b2.w; }
        { const f32x4 a = *(const f32x4*)(F.cw + DM + col), b2 = *(const f32x4*)(F.cw + DM + col + 4); w1[0] = a.x; w1[1] = a.y; w1[2] = a.z; w1[3] = a.w; w1[4] = b2.x; w1[5] = b2.y; w1[6] = b2.z; w1[7] = b2.w; }
        { const f32x4 a = *(const f32x4*)(F.cw + 2 * DM + col), b2 = *(const f32x4*)(F.cw + 2 * DM + col + 4); w2[0] = a.x; w2[1] = a.y; w2[2] = a.z; w2[3] = a.w; w2[4] = b2.x; w2[5] = b2.y; w2[6] = b2.z; w2[7] = b2.w; }
        if (prompt) {
            const int t0 = m0 & 2047; const bf16* Pr = P + (size_t)m0 * PLD;
            if (t0 >= 1) { float a[8], b2[8]; unpack8(*(const v4u*)(Pr - PLD + C_CC + col), a); unpack8(*(const v4u*)(Pr - PLD + C_CX + col), b2);
#pragma unroll
                for (int e = 0; e < 8; ++e) u1[e] = a[e] * b2[e]; }
            else {
#pragma unroll
                for (int e = 0; e < 8; ++e) u1[e] = 0.f; }
            if (t0 >= 2) { float a[8], b2[8]; unpack8(*(const v4u*)(Pr - 2 * PLD + C_CC + col), a); unpack8(*(const v4u*)(Pr - 2 * PLD + C_CX + col), b2);
#pragma unroll
                for (int e = 0; e < 8; ++e) u2[e] = a[e] * b2[e]; }
            else {
#pragma unroll
                for (int e = 0; e < 8; ++e) u2[e] = 0.f; }
        } else {
            const int n = m0 - TP; const float* sc = F.sconv + (size_t)n * 2 * DM + col;
            const f32x4 a0 = *(const f32x4*)sc, a1 = *(const f32x4*)(sc + 4), b0 = *(const f32x4*)(sc + DM), b1 = *(const f32x4*)(sc + DM + 4);
            u2[0] = a0.x; u2[1] = a0.y; u2[2] = a0.z; u2[3] = a0.w; u2[4] = a1.x; u2[5] = a1.y; u2[6] = a1.z; u2[7] = a1.w;
            u1[0] = b0.x; u1[1] = b0.y; u1[2] = b0.z; u1[3] = b0.w; u1[4] = b1.x; u1[5] = b1.y; u1[6] = b1.z; u1[7] = b1.w;
        }
#pragma unroll 1
        for (int r = 0; r < nr; ++r) {
            const int m = m0 + r; const bf16* Pr = P + (size_t)m * PLD;
            float o[8], rr[8], cbv[8], cc[8], cx[8], ga[8], gb[8], u[8];
            unpack8(*(const v4u*)(O + (size_t)m * DM + col), o);
            unpack8(*(const v4u*)(Pr + C_R + col), rr); unpack8(*(const v4u*)(Pr + C_CB + col), cbv); unpack8(*(const v4u*)(Pr + C_CC + col), cc); unpack8(*(const v4u*)(Pr + C_CX + col), cx);
            unpack8(*(const v4u*)(Pr + C_GA + col), ga); unpack8(*(const v4u*)(Pr + C_GB + col), gb);
            float ss = 0.f;
#pragma unroll
            for (int e = 0; e < 8; ++e) ss += o[e] * o[e];
            const float rstd = 1.0f / sqrtf(wave_sum(ss) * (1.0f / 512.0f) + EPS);
#pragma unroll
            for (int e = 0; e < 8; ++e) u[e] = cc[e] * cx[e];
            if (prompt) { const int t = m & 2047;
                if (t >= 2046) { float* dst = F.out + OUT_CONVP + ((size_t)(m >> 11) * 2 + (t - 2046)) * DM + col;
                    *(f32x4*)dst = (f32x4){u[0], u[1], u[2], u[3]}; *(f32x4*)(dst + 4) = (f32x4){u[4], u[5], u[6], u[7]}; }
            } else { float* dst = F.out + OUT_CONVS + (size_t)(m - TP) * 2 * DM + col;
                *(f32x4*)dst = (f32x4){u1[0], u1[1], u1[2], u1[3]}; *(f32x4*)(dst + 4) = (f32x4){u1[4], u1[5], u1[6], u1[7]};
                *(f32x4*)(dst + DM) = (f32x4){u[0], u[1], u[2], u[3]}; *(f32x4*)(dst + DM + 4) = (f32x4){u[4], u[5], u[6], u[7]}; }
            float mv[8];
#pragma unroll
            for (int e = 0; e < 8; ++e) {
                const float ya = (rr[e] * sigmoidf_(rr[e])) * (o[e] * rstd * gn[e]);
                const float z = cbi[e] + w0[e] * u2[e] + w1[e] * u1[e] + w2[e] * u[e];
                mv[e] = sigmoidf_(ga[e]) * ya + sigmoidf_(gb[e]) * (cbv[e] * z);
                u2[e] = u1[e]; u1[e] = u[e];
            }
            *(v4u*)(MM + (size_t)m * DM + col) = pack8(mv);
        }
    }
}

constexpr int SC_LD = 130;
__device__ __forceinline__ int f2sort(float f) { const int b = __float_as_int(f); return b ^ ((b >> 31) & 0x7fffffff); }
__device__ __forceinline__ float sort2f(int s) { return __int_as_float(s ^ ((s >> 31) & 0x7fffffff)); }
#define CE_DESC(x, y) do { const int mx_ = max(x, y), mn_ = min(x, y); x = mx_; y = mn_; } while (0)
template <int N> __device__ __forceinline__ void bitonic_sort_desc(int (&a)[N]) {
#pragma unroll
    for (int k = 2; k <= N; k <<= 1)
#pragma unroll
        for (int j = k >> 1; j > 0; j >>= 1)
#pragma unroll
            for (int i = 0; i < N; ++i) { const int l = i ^ j; if (l > i) { if ((i & k) == 0) CE_DESC(a[i], a[l]); else CE_DESC(a[l], a[i]); } }
}
template <int N> __device__ __forceinline__ void bitonic_merge_desc(int (&a)[N]) {
#pragma unroll
    for (int j = N >> 1; j > 0; j >>= 1)
#pragma unroll
        for (int i = 0; i < N; ++i) { const int l = i ^ j; if (l > i) CE_DESC(a[i], a[l]); }
}
__device__ __forceinline__ void top16_merge(int (&a)[16], const int (&b)[16]) {
#pragma unroll
    for (int i = 0; i < 16; ++i) a[i] = max(a[i], b[15 - i]);
    bitonic_merge_desc<16>(a);
}
__device__ __attribute__((aligned(16))) const unsigned char PK_CAND[64] = {
    0x00, 0x01, 0x02, 0x03, 0x04, 0x05, 0x06, 0x07, 0x08, 0x09, 0x0a, 0x0b, 0x0c, 0x0d, 0x0e, 0x0f,
    0x10, 0x11, 0x12, 0x13, 0x14, 0x15, 0x16, 0x17, 0x20, 0x21, 0x22, 0x23, 0x24, 0x50, 0x51, 0xff,
    0x30, 0x31, 0x32, 0x33, 0x40, 0x41, 0x42, 0x60, 0x61, 0x70, 0x71, 0xff, 0xff, 0xff, 0xff, 0xff,
    0x80, 0x90, 0xa0, 0xb0, 0xc0, 0xd0, 0xe0, 0xf0, 0xff, 0xff, 0xff, 0xff, 0xff, 0xff, 0xff, 0xff};
constexpr int SC8_LD = 132, SK_LD = 136;
constexpr int SC8_BYTES = 128 * SC8_LD * 4, TV8_OFF = SC8_BYTES, SK_OFF = TV8_OFF + 128 * 16 * 4;
__device__ __forceinline__ void peer_load_subkeys(Frame& F) {
    const bf16* SKB = (const bf16*)(F.ws + WS_SKB); bf16* sk_s = (bf16*)(F.lds + SK_OFF);
    for (int e = F.tid; e < 256 * 16; e += 512) { const int row = e >> 4, ch = e & 15; *(v4u*)(sk_s + row * SK_LD + 8 * ch) = *(const v4u*)(SKB + (size_t)row * 128 + 8 * ch); }
    __syncthreads();
}
__device__ __forceinline__ void peer_qfrags(Frame& F, int tb, bf16x8 (&a)[2][4]) {
    const bf16* QP = (const bf16*)(F.ws + WS_QP); const int tok = min(tb + (F.lane & 7), TT - 1), lq = F.lane >> 4;
#pragma unroll
    for (int hf = 0; hf < 2; ++hf)
#pragma unroll
        for (int ks = 0; ks < 4; ++ks) a[hf][ks] = *(const bf16x8*)(QP + (size_t)tok * DM + F.wave * 256 + hf * 128 + 32 * ks + 8 * lq);
}
#define PK_BAR() do { asm volatile("s_waitcnt lgkmcnt(0)" ::: "memory"); __builtin_amdgcn_s_barrier(); asm volatile("" ::: "memory"); } while (0)
__device__ __forceinline__ void peer_topk_tile(Frame& F, int tb, int tend, bf16x8 (&a)[2][4]) {
    int* IDX = (int*)(F.ws + WS_IDX); float* GW = (float*)(F.ws + WS_GW);
    float* sc_s = (float*)F.lds;
    int* tv_s = (int*)(F.lds + TV8_OFF);
    const bf16* sk_s = (const bf16*)(F.lds + SK_OFF);
    const int wv = F.wave, lane = F.lane, l15 = lane & 15, lq = lane >> 4, tid = F.tid;
    {
#pragma unroll
      for (int hf = 0; hf < 2; ++hf) {
#pragma unroll
          for (int nt = 0; nt < 8; ++nt) { f32x4 acc = {0.f, 0.f, 0.f, 0.f};
#pragma unroll
              for (int ks = 0; ks < 4; ++ks) { const bf16x8 bq = *(const bf16x8*)(sk_s + (hf * 128 + 16 * nt + l15) * SK_LD + 32 * ks + 8 * lq); acc = MFMA16(a[hf][ks], bq, acc); }
              if (lq < 2) {
#pragma unroll
                  for (int r = 0; r < 4; ++r) sc_s[((wv * 2 + hf) * 8 + 4 * lq + r) * SC8_LD + 16 * nt + l15] = acc[r]; } } } }
    if (tb + 8 < tend) peer_qfrags(F, tb + 8, a);
    PK_BAR();
    { const int row = tid >> 2, sub = tid & 3; const float* rp = sc_s + row * SC8_LD;
      int top[16], v[16];
#pragma unroll
      for (int i = 0; i < 16; ++i) { const int key = 4 * i + sub; top[i] = (f2sort(rp[key]) & ~127) | (127 - key); }
      bitonic_sort_desc<16>(top);
#pragma unroll
      for (int i = 0; i < 16; ++i) { const int key = 4 * (16 + i) + sub; v[i] = (f2sort(rp[key]) & ~127) | (127 - key); }
      bitonic_sort_desc<16>(v);
      top16_merge(top, v);
#pragma unroll
      for (int sh = 1; sh < 4; sh <<= 1) {
#pragma unroll
          for (int i = 0; i < 16; ++i) v[i] = __shfl_xor(top[i], sh);
          top16_merge(top, v); }
      if (sub == 0) {
#pragma unroll
          for (int q = 0; q < 4; ++q) *(int __attribute__((ext_vector_type(4)))*)(tv_s + row * 16 + 4 * q) = (int __attribute__((ext_vector_type(4)))){top[4 * q], top[4 * q + 1], top[4 * q + 2], top[4 * q + 3]}; }
    }
    PK_BAR();
    if (tid < 256) { const int it = tid >> 2, qd = tid & 3, tl = it & 7, hd = it >> 3;
      const int* r1 = tv_s + ((hd * 2 + 0) * 8 + tl) * 16; const int* r2 = tv_s + ((hd * 2 + 1) * 8 + tl) * 16;
      int c[16];
      const v4u cw = *(const v4u*)(PK_CAND + qd * 16);
#pragma unroll
      for (int t = 0; t < 16; ++t) { const int ab = (int)((cw[t >> 2] >> (8 * (t & 3))) & 0xffu); const int abc = ab != 0xff ? ab : 0;
          const float sv = sort2f(r1[abc >> 4] & ~127) + sort2f(r2[abc & 15] & ~127); const int packed = (f2sort(sv) & ~255) | (255 - ab);
          c[t] = ab != 0xff ? packed : (int)0x80000000; }
      bitonic_sort_desc<16>(c);
#pragma unroll
      for (int sh = 1; sh < 4; sh <<= 1) { int oth[16];
#pragma unroll
          for (int i = 0; i < 16; ++i) oth[i] = __shfl_xor(c[i], sh);
          top16_merge(c, oth); }
      const int tok = tb + tl;
      if (tok < tend) {
          float ev[16], sum = 0.f; const float mx = sort2f(c[0] & ~255);
#pragma unroll
          for (int k = 0; k < 16; ++k) { ev[k] = __expf(sort2f(c[k] & ~255) - mx); sum += ev[k]; }
          const float inv = 1.0f / sum;
#pragma unroll
          for (int k = 0; k < 16; ++k) if ((k >> 2) == qd) { const int ab = 255 - (c[k] & 255); const int i1 = 127 - (r1[ab >> 4] & 127), i2 = 127 - (r2[ab & 15] & 127);
              IDX[(size_t)tok * 128 + hd * 16 + k] = i1 * 128 + i2; GW[(size_t)tok * 128 + hd * 16 + k] = ev[k] * inv; }
      }
    }
    PK_BAR();
}

__device__ __forceinline__ void peer_phase(Frame& F, int tok0, int tok1) {
    const unsigned char* U6 = F.ws + WS_EU; const unsigned char* V6 = F.ws + WS_EV; const float* SU = (const float*)(F.ws + WS_EU + 32 * MiB); const float* SV = (const float*)(F.ws + WS_EV + 32 * MiB);
    const float* X2 = (const float*)(F.ws + WS_X2); const float* RS2 = (const float*)(F.ws + WS_RS2); const int* IDX = (const int*)(F.ws + WS_IDX); const float* GW = (const float*)(F.ws + WS_GW);
    const int wv = F.wave, lane = F.lane, tid = F.tid;
    float* red_s = (float*)F.lds;
    float* ss_s = (float*)(F.lds + 131072);
    const f32x4 gfin = *(const f32x4*)(F.nfg + 4 * tid);
    f32x4 x3p = {0.f, 0.f, 0.f, 0.f}; int buf = 0;
#pragma unroll 1
    for (int m = tok0; m <= tok1; ++m) {
        if (m < tok1) {
            const int myidx = IDX[(size_t)m * 128 + wv * 16 + (lane & 15)]; float myg = GW[(size_t)m * 128 + wv * 16 + (lane & 15)];
            const float mysu = SU[myidx] * RS2[m]; myg *= SV[myidx];
            float hf[32];
#pragma unroll
            for (int j = 0; j < 8; ++j) { const f32x4 w = *(const f32x4*)(X2 + (size_t)m * DM + 256 * j + 4 * lane); hf[4 * j] = w.x; hf[4 * j + 1] = w.y; hf[4 * j + 2] = w.z; hf[4 * j + 3] = w.w; }
            float acc[32];
#pragma unroll
            for (int k = 0; k < 32; ++k) acc[k] = 0.f;
#pragma unroll 1
            for (int kg = 0; kg < 4; ++kg) {
                v4u ul4[4], vl4[4]; v2u ul2[4], vl2[4]; float gk[4], su[4];
#pragma unroll
                for (int kk = 0; kk < 4; ++kk) { const int ex = __shfl(myidx, kg * 4 + kk); gk[kk] = __shfl(myg, kg * 4 + kk); su[kk] = __shfl(mysu, kg * 4 + kk);
                    const unsigned char* ur = U6 + (size_t)ex * ROW6; const unsigned char* vr = V6 + (size_t)ex * ROW6;
                    ul4[kk] = *(const v4u*)(ur + 16 * lane); ul2[kk] = *(const v2u*)(ur + 1024 + 8 * lane); vl4[kk] = *(const v4u*)(vr + 16 * lane); vl2[kk] = *(const v2u*)(vr + 1024 + 8 * lane); }
#pragma unroll
                for (int kk = 0; kk < 4; ++kk) {
                    const v32f uf = __builtin_amdgcn_cvt_scalef32_pk32_f32_fp6((v6u){ul4[kk].x, ul4[kk].y, ul4[kk].z, ul4[kk].w, ul2[kk].x, ul2[kk].y}, 1.0f);
                    float dot = 0.f;
#pragma unroll
                    for (int k = 0; k < 32; ++k) dot += uf[k] * hf[k];
                    const float a = wave_sum(dot) * su[kk];
                    const float wgt = gk[kk] * (0.5f * a * (1.0f + erff(a * 0.70710678118654752f)));
                    const v32f vf = __builtin_amdgcn_cvt_scalef32_pk32_f32_fp6((v6u){vl4[kk].x, vl4[kk].y, vl4[kk].z, vl4[kk].w, vl2[kk].x, vl2[kk].y}, 1.0f);
#pragma unroll
                    for (int k = 0; k < 32; ++k) acc[k] += wgt * vf[k];
                }
            }
#pragma unroll
            for (int j = 0; j < 8; ++j) *(f32x4*)(red_s + (buf * 8 + wv) * 2048 + 256 * j + 4 * lane) = (f32x4){acc[4 * j], acc[4 * j + 1], acc[4 * j + 2], acc[4 * j + 3]};
        }
        __syncthreads();
        if (m > tok0) {
            float tot = 0.f;
#pragma unroll
            for (int w8 = 0; w8 < 8; ++w8) tot += ss_s[(buf ^ 1) * 8 + w8];
            const float rstd = 1.0f / sqrtf(tot * (1.0f / DM) + EPS);
            *(f32x4*)(F.out + OUT_Y + (size_t)(m - 1) * DM + 4 * tid) = x3p * rstd * gfin;
        }
        if (m < tok1) {
            f32x4 x3 = *(const f32x4*)(X2 + (size_t)m * DM + 4 * tid);
#pragma unroll
            for (int w8 = 0; w8 < 8; ++w8) x3 += *(const f32x4*)(red_s + (buf * 8 + w8) * 2048 + 4 * tid);
            const float ss = wave_sum((x3.x * x3.x + x3.y * x3.y) + (x3.z * x3.z + x3.w * x3.w));
            if (lane == 0) ss_s[buf * 8 + wv] = ss;
            x3p = x3;
        }
        buf ^= 1;
    }
    __syncthreads();
}
struct Args { const float* in[18]; float* out; unsigned char* ws; int ph_lo, ph_hi; };
__global__ void __launch_bounds__(NWAVES * 64, 2) mk_fwd(Args args) {
    extern __shared__ __attribute__((aligned(16))) unsigned char lds[];
    Frame F;
    F.lds = lds;
    F.tid = threadIdx.x; F.lane = F.tid & 63; F.wave = __builtin_amdgcn_readfirstlane(F.tid >> 6);
    F.G = gridDim.x; { const int bx = blockIdx.x; F.vcu = (F.G % 8 == 0) ? (bx % 8) * (F.G / 8) + bx / 8 : bx; }
    F.xp = args.in[0]; F.xs = args.in[1]; F.sgla = args.in[2]; F.sconv = args.in[3]; F.n1g = args.in[4]; F.win = args.in[5]; F.wau = args.in[6]; F.bal = args.in[7];
    F.gng = args.in[8]; F.cw = args.in[9]; F.cb = args.in[10]; F.wout = args.in[11]; F.n2g = args.in[12]; F.wq = args.in[13]; F.sk = args.in[14]; F.eu = args.in[15];
    F.ev = args.in[16]; F.nfg = args.in[17]; F.out = args.out; F.ws = args.ws;
    for (int u = F.tid; u < (LDS_BYTES - LDSCTL_OFF) / 4; u += NWAVES * 64) ((LAS unsigned*)((LAS unsigned char*)lds + LDSCTL_OFF))[u] = 0u;
    __syncthreads();
    gu32* ctl = (gu32*)(F.ws + WS_CTL);
    XcdBarrier bar; bar.bar = (unsigned*)(ctl + CW_BAR); bar.x = 0; bar.st = nullptr;
    if (N_LAUNCHES == 1) bar = xcd_barrier_post((unsigned*)(ctl + CW_BAR), (volatile LAS unsigned*)((LAS unsigned char*)lds + MISC_OFF) + 8);
    const int lo = args.ph_lo, hi = args.ph_hi;
#ifndef SKREP
#define SKREP 1
#endif
#ifndef PROBE_DBL
#define PROBE_DBL -1
#endif
#define IN(k) (lo <= (k) && (k) < hi)
#define REP(k) for (int rep_ = 0; rep_ < ((k) == PROBE_DBL ? 2 : 1); ++rep_)
#define SEAM(k) do { if (IN(k) && IN((k) + 1)) xcd_barrier(bar); } while (0)
    const int gw = F.vcu * NWAVES + F.wave, NGW = F.G * NWAVES;
    const int tok0 = (int)(((long)F.vcu * TT) / F.G), tok1 = (int)(((long)(F.vcu + 1) * TT) / F.G);

    if (IN(0)) REP(0) { p0_prologue(F); __syncthreads(); }
    SEAM(0);
    if (IN(1)) REP(1) {
        pg8::Gemm g{(const pg8::bf16_t*)(F.ws + WS_XN), (const pg8::bf16_t*)(F.ws + WS_WINT), TP, NP, DM}; pg8::StaticOrder S; S.init(TP, NP, F.G, (int)blockIdx.x);
        pg8::EpiBf16<0> E{(pg8::bf16_t*)(F.ws + WS_P), PLD, nullptr, 0, 0, 1.f};
        pg8::gemm_phase<pg8::EpiBf16<0>, pg8::StaticOrder, true, true>((PG8_LAS unsigned char*)lds + RING_OFF, g, S, E);
#ifdef GEMM1_TWICE
        pg8::gemm_phase<pg8::EpiBf16<0>, pg8::StaticOrder, true, true>((PG8_LAS unsigned char*)lds + RING_OFF, g, S, E);
#endif
        { EpiSkBf16 Es{(bf16*)(F.ws + WS_P) + (size_t)TP * PLD, PLD, nullptr};
          for (int skr = 0; skr < SKREP; ++skr) for (int ng = F.vcu; ng < NP / 64; ng += F.G) skinny_gemm<4>(F, (const bf16*)(F.ws + WS_XN) + (size_t)TP * DM, (const bf16*)(F.ws + WS_WINT), 64 * ng, Es); }
    }
    SEAM(1);
    if (IN(2)) REP(2) { for (int u = F.vcu; u < 512; u += F.G) gla_prep_unit(F, u); }
    SEAM(2);
    if (IN(3)) REP(3) {
        if ((F.vcu & 1) == 0) { for (int g = F.vcu >> 1; g < 128; g += (F.G + 1) >> 1) gla_main_unit<4>(F, g >> 3, g & 7); }
        volatile LAS unsigned* qslot = (volatile LAS unsigned*)((LAS unsigned char*)lds + LDSCTL_OFF + 16);
        for (;;) {
            if (F.tid == 0) *qslot = __hip_atomic_fetch_add((unsigned*)(ctl + CW_QUEUE + 64 * rep_), 1u, __ATOMIC_RELAXED, __HIP_MEMORY_SCOPE_AGENT);
            __syncthreads();
            const unsigned u = *qslot;
            __syncthreads();
            if (u >= 512u) break;
            gla_sample_unit(F, (int)u);
        }
    }
    SEAM(3);
    if (IN(4)) REP(4) {
        bf16* MM = (bf16*)(F.ws + WS_MM);
        for (int g = gw; g < TP / 4; g += NGW) mixer_rows(F, 4 * g, 4);
        for (int n = gw; n < TS; n += NGW) mixer_rows(F, TP + n, 1);
        for (int m = TT + gw; m < MP; m += NGW) zero_row_bf16(MM + (size_t)m * DM, F.lane);
    }
    SEAM(4);
    if (IN(5)) REP(5) {
        pg8::Gemm g{(const pg8::bf16_t*)(F.ws + WS_MM), (const pg8::bf16_t*)(F.ws + WS_WOUTT), TP, DM, DM}; pg8::StaticOrder S; S.init(TP, DM, F.G, (int)blockIdx.x);
        pg8::EpiF32Res E{F.xp, (float*)(F.ws + WS_X2), (pg8::bf16_t*)(F.ws + WS_H2), (float*)(F.ws + WS_SSQ), DM};
        pg8::gemm_phase<pg8::EpiF32Res, pg8::StaticOrder, true, true>((PG8_LAS unsigned char*)lds + RING_OFF, g, S, E);
#ifdef GEMM2_TWICE
        pg8::gemm_phase<pg8::EpiF32Res, pg8::StaticOrder, true, true>((PG8_LAS unsigned char*)lds + RING_OFF, g, S, E);
#endif
        { EpiSkF32Res Es{F.xs, (float*)(F.ws + WS_X2) + (size_t)TP * DM, (bf16*)(F.ws + WS_H2) + (size_t)TP * DM, (float*)(F.ws + WS_SSQS)};
          for (int skr = 0; skr < SKREP; ++skr) for (int ng = F.vcu; ng < DM / 16; ng += F.G) skinny_gemm<1>(F, (const bf16*)(F.ws + WS_MM) + (size_t)TP * DM, (const bf16*)(F.ws + WS_WOUTT), 16 * ng, Es); }
    }
    SEAM(5);
    if (IN(6)) REP(6) {
        float* rs_s = (float*)(lds + 131072);
        float* rss_s = rs_s + 512;
        float* RS2 = (float*)(F.ws + WS_RS2);
        pg8::Gemm g{(const pg8::bf16_t*)(F.ws + WS_H2), (const pg8::bf16_t*)(F.ws + WS_WQT), TP, DM, DM}; pg8::StaticOrder S; S.init(TP, DM, F.G, (int)blockIdx.x);
        { pg8::Unit u0;
          if (S.next(0, u0) && F.tid < 256) { const int row = u0.pm * 256 + F.tid; const f32x4* p = (const f32x4*)((const float*)(F.ws + WS_SSQ) + (size_t)row * 32); f32x4 a4 = p[0];
#pragma unroll
              for (int i = 1; i < 8; ++i) a4 += p[i];
              const float rstd = 1.0f / sqrtf(((a4.x + a4.y) + (a4.z + a4.w)) * (1.0f / DM) + EPS); rs_s[F.tid] = rstd; if (u0.pn == 0) RS2[row] = rstd; }
          if (F.tid >= 256 && F.tid < 384 && F.vcu < DM / 16) { const int row = F.tid - 256; const f32x4* p = (const f32x4*)((const float*)(F.ws + WS_SSQS) + (size_t)row * 128); f32x4 a4 = p[0];
#pragma unroll
              for (int i = 1; i < 32; ++i) a4 += p[i];
              const float rstd = 1.0f / sqrtf(((a4.x + a4.y) + (a4.z + a4.w)) * (1.0f / DM) + EPS); rss_s[row] = rstd; if (F.vcu == 0) RS2[TP + row] = rstd; }
          __syncthreads(); }
        pg8::EpiBf16RowScale E{(pg8::bf16_t*)(F.ws + WS_QP), DM, rs_s};
        pg8::gemm_phase<pg8::EpiBf16RowScale, pg8::StaticOrder, true, true>((PG8_LAS unsigned char*)lds + RING_OFF, g, S, E);
#ifdef GEMM3_TWICE
        pg8::gemm_phase<pg8::EpiBf16RowScale, pg8::StaticOrder, true, true>((PG8_LAS unsigned char*)lds + RING_OFF, g, S, E);
#endif
        { EpiSkBf16 Es{(bf16*)(F.ws + WS_QP) + (size_t)TP * DM, DM, rss_s};
          for (int skr = 0; skr < SKREP; ++skr) for (int ng = F.vcu; ng < DM / 16; ng += F.G) skinny_gemm<1>(F, (const bf16*)(F.ws + WS_H2) + (size_t)TP * DM, (const bf16*)(F.ws + WS_WQT), 16 * ng, Es); }
    }
    SEAM(6);
    if (IN(7)) REP(7) { bf16x8 qa[2][4]; peer_qfrags(F, tok0, qa); peer_load_subkeys(F); for (int tb = tok0; tb < tok1; tb += 8) peer_topk_tile(F, tb, tok1, qa); __syncthreads(); }
    SEAM(7);
    if (IN(8)) REP(8) { peer_phase(F, tok0, tok1); }
#undef IN
#undef SEAM
}

extern "C" void kernel_launch(void* const* d_in, const int* in_sizes, int n_in, void* d_out, int out_size, void* d_ws, size_t ws_size, hipStream_t stream) {
    static int grid = 0;
    if (grid == 0) {
        if (n_in != 18 || ws_size < WS_END) { fprintf(stderr, "kernel_launch: expected 18 inputs and >= %zu bytes of workspace; got %d, %zu\n", (size_t)WS_END, n_in, ws_size); grid = -1; return; }
        int dev = 0, cus = 0;
        if (hipGetDevice(&dev) != hipSuccess || hipDeviceGetAttribute(&cus, hipDeviceAttributeMultiprocessorCount, dev) != hipSuccess) { grid = -1; return; }
        if (hipFuncSetAttribute((const void*)mk_fwd, hipFuncAttributeMaxDynamicSharedMemorySize, LDS_BYTES) != hipSuccess) { fprintf(stderr, "kernel_launch: hipFuncSetAttribute failed\n"); grid = -1; return; }
        (void)hipGetLastError();
        grid = cus;
    }
    if (grid < 0) return;
    (void)hipMemsetAsync((char*)d_ws + WS_CTL, 0, CTL_ZERO_BYTES, stream);
    Args a{};
    for (int i = 0; i < 18; ++i) a.in[i] = (const float*)d_in[i];
    a.out = (float*)d_out; a.ws = (unsigned char*)d_ws;
    if (N_LAUNCHES == 1) { a.ph_lo = 0; a.ph_hi = N_PHASES; hipLaunchKernelGGL(mk_fwd, dim3(grid), dim3(NWAVES * 64), LDS_BYTES, stream, a); }
    else { for (int li = 0; li < N_PHASES; ++li) { a.ph_lo = li; a.ph_hi = li + 1; hipLaunchKernelGGL(mk_fwd, dim3(grid), dim3(NWAVES * 64), LDS_BYTES, stream, a); } }
}
```

```cpp
#include <hip/hip_runtime.h>
#include <cstdio>
#include <cstdint>
#include <cmath>
#define MK_N_LAUNCHES 1
namespace pg8 {
#define PG8_LAS __attribute__((address_space(3)))
typedef unsigned short bf16_t;
typedef short bf16x8 __attribute__((ext_vector_type(8)));
typedef float f32x4 __attribute__((ext_vector_type(4)));
typedef unsigned u32x4 __attribute__((ext_vector_type(4)));
constexpr int BM = 256, BK = 64, HALF = 128, HTB = HALF * BK * 2  , STAGE_BYTES = 8 * HTB, NXCD = 8, WGM = 8;

__host__ __device__ __forceinline__ int lds_byte(int r, int c) { const int st = (r >> 4) * 2 + (c >> 5), rr = r & 15, cc = c & 31, ob = rr * 64 + cc * 2; return st * 1024 + (ob ^ (((ob >> 9) & 1) << 5)); }
__host__ __device__ __forceinline__ void stage_rc(int b, int& R, int& C) { const int st = b / 1024, sb = b % 1024, swz = sb ^ (((sb >> 9) & 1) << 5); R = (st >> 1) * 16 + swz / 64; C = (st & 1) * 32 + (swz % 64) / 2; }
__host__ __device__ __forceinline__ int perm32(int rho) { const int n = rho >> 4, i = rho & 15; return 8 * (i >> 2) + 4 * n + (i & 3); }

struct Unit { int pm, pn; };
struct Gemm { const bf16_t* A; const bf16_t* Bt; int M, N, K; };

struct StaticOrder {
    int nM, nN, nwg, G, c;
    __host__ __device__ void init(int M, int N, int G_, int c_) { nM = M / BM; nN = N / BM; nwg = nM * nN; G = G_; c = c_; }
    __host__ __device__ bool next(int i, Unit& u) const {
        const long L = (long)i * G + c; if (L >= nwg) return false;
        int wgid = (int)L; { const int q = nwg / NXCD, r = nwg % NXCD, xcd = wgid % NXCD, off = wgid / NXCD; wgid = (xcd < r ? xcd * (q + 1) : r * (q + 1) + (xcd - r) * q) + off; }
        const int nig = WGM * nN, gid = wgid / nig, fm = gid * WGM, gsz = (nM - fm) < WGM ? (nM - fm) : WGM;
        u.pm = fm + ((wgid % nig) % gsz); u.pn = (wgid % nig) / gsz; return true;
    }
    __device__ __forceinline__ void a_ready(const Unit&) const {}
    __device__ __forceinline__ void done(const Unit&) const {}
};

__device__ __forceinline__ unsigned cvt_pk_bf16(float lo, float hi) { unsigned r; asm volatile("v_cvt_pk_bf16_f32 %0, %1, %2" : "=v"(r) : "v"(lo), "v"(hi)); return r; }
typedef float f32x2 __attribute__((ext_vector_type(2)));
__device__ __forceinline__ f32x2 gelu_pk(f32x2 v) {
    const f32x2 av = __builtin_elementwise_abs(v), d = av * 0.2316418882f + 1.0f;
    f32x2 t; t.x = __builtin_amdgcn_rcpf(d.x); t.y = __builtin_amdgcn_rcpf(d.y);
    f32x2 q = t * 0.5307027145f + (-0.7265760135f); q = q * t + 0.7107068705f; q = q * t + (-0.142248368f); q = q * t + 0.127414796f; q = q * t;
    const f32x2 s = (v * v) * (-0.72134752044f);
    f32x2 e; e.x = __builtin_amdgcn_exp2f(s.x); e.y = __builtin_amdgcn_exp2f(s.y);
    const f32x2 m = v * (q * e), r = v - m;
    f32x2 o; o.x = v.x < 0.f ? m.x : r.x; o.y = v.y < 0.f ? m.y : r.y; return o;
}

template <int ACT  > struct EpiBf16 {
    static constexpr bool PERM = true, AFTER_DRAIN = false; static_assert(ACT == 0 || ACT == 1, "EpiBf16: ACT is 0 (none) or 1 (gelu_pk)");
    bf16_t* O; int ldc; const float* bias; int split_cols; size_t split_stride; float scale0;
    __device__ __forceinline__ void operator()(const f32x4 (&acc)[2][2][4][2], const Unit& u, int wr, int wc, int fr, int fq) const {
        const int row0 = u.pm * BM + wr * 64 + fr; int colt = u.pn * BM; bf16_t* base = O;
        float sc = 1.f; if (split_cols) { const int t = colt / split_cols; base += (size_t)t * split_stride; colt -= t * split_cols; if (t == 0) sc = scale0; }
        const int col0 = colt + wc * 32 + 8 * fq, bcol0 = u.pn * BM + wc * 32 + 8 * fq;
        f32x4 bv[2][2];
#pragma unroll
        for (int bj = 0; bj < 2; ++bj)
#pragma unroll
            for (int n = 0; n < 2; ++n) bv[bj][n] = bias ? *(const f32x4*)(bias + bcol0 + bj * HALF + 4 * n) : (f32x4){0.f, 0.f, 0.f, 0.f};
#pragma unroll
        for (int ai = 0; ai < 2; ++ai)
#pragma unroll
            for (int m = 0; m < 4; ++m) { bf16_t* rowp = base + (size_t)(row0 + ai * HALF + m * 16) * ldc + col0;
#pragma unroll
                for (int bj = 0; bj < 2; ++bj) { f32x4 v0 = acc[ai][bj][m][0] + bv[bj][0], v1 = acc[ai][bj][m][1] + bv[bj][1];
                    if (ACT == 1) { f32x2 a = gelu_pk((f32x2){v0[0], v0[1]}), b = gelu_pk((f32x2){v0[2], v0[3]}), c = gelu_pk((f32x2){v1[0], v1[1]}), d = gelu_pk((f32x2){v1[2], v1[3]});
                        v0 = (f32x4){a.x, a.y, b.x, b.y}; v1 = (f32x4){c.x, c.y, d.x, d.y}; }
                    v0 = v0 * sc; v1 = v1 * sc; u32x4 w; w.x = cvt_pk_bf16(v0[0], v0[1]); w.y = cvt_pk_bf16(v0[2], v0[3]); w.z = cvt_pk_bf16(v1[0], v1[1]); w.w = cvt_pk_bf16(v1[2], v1[3]);
                    *(u32x4*)(rowp + bj * HALF) = w; } }
    }
};
template <class Epi, class Sched, bool ALIGN_EPI = false, bool SP2 = false>
__device__ __forceinline__ void gemm_phase(PG8_LAS unsigned char* lds, const Gemm g, const Sched& S, const Epi& E) {
    const int tid = threadIdx.x, wid = __builtin_amdgcn_readfirstlane(tid >> 6), lane = tid & 63, wr = wid >> 2, wc = wid & 3, fr = lane & 15, fq = lane >> 4;
    const int K = g.K, nt = K / BK;
    unsigned voffA[2], voffB[2];
#pragma unroll
    for (int i = 0; i < 2; ++i) { int R, C; stage_rc(tid * 16 + i * 8192, R, C); const int Rb = Epi::PERM ? ((R & ~31) + perm32(R & 31)) : R;
        voffA[i] = (unsigned)(R * K + C) * 2u; voffB[i] = (unsigned)(Rb * K + C) * 2u; }
    const size_t kstep = (size_t)(BK * 2);
    const size_t hstep = (size_t)HALF * K * 2;
    const size_t tstep = 2 * hstep;
    const unsigned ldsw = (unsigned)wid * 1024u;
    const int aoff = lds_byte(wr * 64 + fr, fq * 8), boff = lds_byte(wc * 32 + fr, fq * 8);
#define PG8_SA(b, h) (((b) * 2 + (h)) * HTB)
#define PG8_SB(b, h) ((4 + (b) * 2 + (h)) * HTB)
#define PG8_STAGE(bufoff, gbase, voff) do { _Pragma("unroll") for (int _i = 0; _i < 2; ++_i) \
        __builtin_amdgcn_global_load_lds((const unsigned*)((const char*)(gbase) + (voff)[_i]), (PG8_LAS unsigned*)(lds + (bufoff) + ldsw + _i * 8192), 16, 0, 0); } while (0)
#define PG8_LDA(dst, b, h) do { _Pragma("unroll") for (int m = 0; m < 4; ++m) _Pragma("unroll") for (int k = 0; k < 2; ++k) dst[m][k] = *(const PG8_LAS bf16x8*)(lds + PG8_SA(b, h) + aoff + m * 2048 + k * 1024); } while (0)
#define PG8_LDB(dst, b, h) do { _Pragma("unroll") for (int n = 0; n < 2; ++n) _Pragma("unroll") for (int k = 0; k < 2; ++k) dst[n][k] = *(const PG8_LAS bf16x8*)(lds + PG8_SB(b, h) + boff + n * 2048 + k * 1024); } while (0)
#define PG8_MMA(ai, bj, At, Bt) do { __builtin_amdgcn_s_setprio(1); _Pragma("unroll") for (int m = 0; m < 4; ++m) _Pragma("unroll") for (int n = 0; n < 2; ++n) _Pragma("unroll") for (int k = 0; k < 2; ++k) \
        acc[ai][bj][m][n] = __builtin_amdgcn_mfma_f32_16x16x32_bf16(Bt[n][k], At[m][k], acc[ai][bj][m][n], 0, 0, 0); __builtin_amdgcn_s_setprio(0); } while (0)
#define PG8_WAIT_V(n) asm volatile("s_waitcnt vmcnt(" #n ")" ::: "memory")
#define PG8_WAIT_L(n) asm volatile("s_waitcnt lgkmcnt(" #n ")" ::: "memory")
#define PG8_BAR __builtin_amdgcn_s_barrier()
#define PG8_SCHED __builtin_amdgcn_sched_barrier(0)
    Unit cur, nxt; int ui = 0;
    if (!S.next(0, cur)) return;
    f32x4 acc[2][2][4][2];
#pragma unroll
    for (int a = 0; a < 2; ++a)
#pragma unroll
        for (int b = 0; b < 2; ++b)
#pragma unroll
            for (int m = 0; m < 4; ++m)
#pragma unroll
                for (int n = 0; n < 2; ++n) acc[a][b][m][n] = (f32x4){0.f, 0.f, 0.f, 0.f};
    bf16x8 At[4][2], B0[2][2], B1[2][2];
    const char* cA = (const char*)g.A + (size_t)cur.pm * tstep; const char* cB = (const char*)g.Bt + (size_t)cur.pn * tstep;
    S.a_ready(cur);
    if constexpr (SP2) {
        PG8_STAGE(PG8_SB(0, 0), cB, voffB); PG8_STAGE(PG8_SB(0, 1), cB + hstep, voffB); PG8_STAGE(PG8_SA(0, 0), cA, voffA); PG8_STAGE(PG8_SA(0, 1), cA + hstep, voffA);
        if (wr == 1) PG8_BAR;
        PG8_WAIT_V(2); PG8_BAR;
        PG8_STAGE(PG8_SB(1, 0), cB + kstep, voffB); PG8_STAGE(PG8_SA(1, 0), cA + kstep, voffA); PG8_STAGE(PG8_SB(1, 1), cB + hstep + kstep, voffB);
        PG8_WAIT_V(6); PG8_BAR;
    } else {
        PG8_STAGE(PG8_SB(0, 0), cB, voffB); PG8_STAGE(PG8_SA(0, 0), cA, voffA); PG8_STAGE(PG8_SB(0, 1), cB + hstep, voffB); PG8_STAGE(PG8_SA(0, 1), cA + hstep, voffA);
        if (wr == 1) PG8_BAR;
        PG8_WAIT_V(4); PG8_BAR;
        PG8_STAGE(PG8_SB(1, 0), cB + kstep, voffB); PG8_STAGE(PG8_SA(1, 0), cA + kstep, voffA); PG8_STAGE(PG8_SB(1, 1), cB + hstep + kstep, voffB);
        PG8_WAIT_V(6); PG8_BAR;
    }
    for (;;) {
        const bool has_next = S.next(ui + 1, nxt);
        const char* nA = has_next ? (const char*)g.A + (size_t)nxt.pm * tstep : cA; const char* nB = has_next ? (const char*)g.Bt + (size_t)nxt.pn * tstep : cB;
        for (int t = 0; t < nt; t += 2) {
            const bool last = (t == nt - 2);
            const char* a1 = cA + (size_t)(t + 1) * kstep;
            const char* a2 = last ? nA : cA + (size_t)(t + 2) * kstep; const char* b2 = last ? nB : cB + (size_t)(t + 2) * kstep;
            const char* a3 = a2 + kstep; const char* b3 = b2 + kstep;
            if (last && has_next) S.a_ready(nxt);
            if constexpr (SP2) {
            PG8_LDB(B0, 0, 0); PG8_LDB(B1, 0, 1); PG8_SCHED; PG8_LDA(At, 0, 0); PG8_STAGE(PG8_SA(1, 1), a1 + hstep, voffA);
            PG8_WAIT_V(8); PG8_WAIT_L(0); PG8_BAR; PG8_MMA(0, 0, At, B0); PG8_MMA(0, 1, At, B1); PG8_BAR; PG8_SCHED;
            PG8_LDA(At, 0, 1); PG8_STAGE(PG8_SB(0, 0), b2, voffB); PG8_STAGE(PG8_SB(0, 1), b2 + hstep, voffB); PG8_STAGE(PG8_SA(0, 0), a2, voffA);
            PG8_WAIT_V(8); PG8_WAIT_L(0); PG8_BAR; PG8_MMA(1, 0, At, B0); PG8_MMA(1, 1, At, B1); PG8_BAR; PG8_SCHED;
            PG8_LDB(B0, 1, 0); PG8_LDB(B1, 1, 1); PG8_SCHED; PG8_LDA(At, 1, 0); PG8_STAGE(PG8_SA(0, 1), a2 + hstep, voffA);
            PG8_WAIT_V(8); PG8_WAIT_L(0); PG8_BAR; PG8_MMA(0, 0, At, B0); PG8_MMA(0, 1, At, B1); PG8_BAR; PG8_SCHED;
            PG8_LDA(At, 1, 1); PG8_STAGE(PG8_SB(1, 0), b3, voffB); PG8_STAGE(PG8_SB(1, 1), b3 + hstep, voffB); PG8_STAGE(PG8_SA(1, 0), a3, voffA);
            PG8_WAIT_V(8); PG8_WAIT_L(0); PG8_BAR; PG8_MMA(1, 0, At, B0); PG8_MMA(1, 1, At, B1); PG8_BAR; PG8_SCHED;
            } else {
            PG8_LDB(B0, 0, 0); PG8_SCHED; PG8_LDA(At, 0, 0); PG8_STAGE(PG8_SA(1, 1), a1 + hstep, voffA);
            PG8_WAIT_L(8); PG8_BAR; PG8_WAIT_L(0); PG8_MMA(0, 0, At, B0); PG8_BAR; PG8_SCHED;
            PG8_LDB(B1, 0, 1); PG8_STAGE(PG8_SB(0, 0), b2, voffB);
            PG8_BAR; PG8_WAIT_L(0); PG8_MMA(0, 1, At, B1); PG8_BAR;
            PG8_LDA(At, 0, 1); PG8_STAGE(PG8_SA(0, 0), a2, voffA);
            PG8_BAR; PG8_WAIT_L(0); PG8_MMA(1, 0, At, B0); PG8_BAR; PG8_SCHED;
            PG8_STAGE(PG8_SB(0, 1), b2 + hstep, voffB);
            PG8_WAIT_V(6); PG8_BAR; PG8_MMA(1, 1, At, B1); PG8_BAR;
            PG8_LDB(B0, 1, 0); PG8_SCHED; PG8_LDA(At, 1, 0); PG8_STAGE(PG8_SA(0, 1), a2 + hstep, voffA);
            PG8_WAIT_L(8); PG8_BAR; PG8_WAIT_L(0); PG8_MMA(0, 0, At, B0); PG8_BAR; PG8_SCHED;
            PG8_LDB(B1, 1, 1); PG8_STAGE(PG8_SB(1, 0), b3, voffB);
            PG8_BAR; PG8_WAIT_L(0); PG8_MMA(0, 1, At, B1); PG8_BAR;
            PG8_LDA(At, 1, 1); PG8_STAGE(PG8_SA(1, 0), a3, voffA);
            PG8_BAR; PG8_WAIT_L(0); PG8_MMA(1, 0, At, B0); PG8_BAR; PG8_SCHED;
            PG8_STAGE(PG8_SB(1, 1), b3 + hstep, voffB);
            PG8_WAIT_V(6); PG8_BAR; PG8_MMA(1, 1, At, B1); PG8_BAR;
            }
        }
        if constexpr (ALIGN_EPI) { if (wr == 0) PG8_BAR; }
        if constexpr (!Epi::AFTER_DRAIN) { E(acc, cur, wr, wc, fr, fq); S.done(cur); }
        if (!has_next) break;
#pragma unroll
        for (int a = 0; a < 2; ++a)
#pragma unroll
            for (int b = 0; b < 2; ++b)
#pragma unroll
                for (int m = 0; m < 4; ++m)
#pragma unroll
                    for (int n = 0; n < 2; ++n) acc[a][b][m][n] = (f32x4){0.f, 0.f, 0.f, 0.f};
        cur = nxt; cA = nA; cB = nB; ++ui;
        if constexpr (ALIGN_EPI) { if (wr == 1) PG8_BAR; }
    }
    PG8_WAIT_V(0);
    if constexpr (!ALIGN_EPI) { if (wr == 0) PG8_BAR; }
    PG8_BAR;
    if constexpr (Epi::AFTER_DRAIN) { E.fused(acc, cur, wr, wc, fr, fq, lds, wid, lane); S.done(cur); }
#undef PG8_SA
#undef PG8_SB
#undef PG8_STAGE
#undef PG8_LDA
#undef PG8_LDB
#undef PG8_MMA
#undef PG8_WAIT_V
#undef PG8_WAIT_L
#undef PG8_BAR
#undef PG8_SCHED
}
}
namespace pg8 {
__device__ __forceinline__ unsigned f2bf_(float f) { unsigned u = __builtin_bit_cast(unsigned, f); return (u + 0x7fffu + ((u >> 16) & 1u)) >> 16; }
struct EpiF32Res {
    static constexpr bool PERM = false, AFTER_DRAIN = false;
    const float* xp; float* out; bf16_t* outb; float* ssq; int ldc;
    __device__ __forceinline__ void operator()(const f32x4 (&acc)[2][2][4][2], const Unit& u, int wr, int wc, int fr, int fq) const {
        const int col0 = u.pn * BM + wc * 32 + 4 * fq;
#pragma unroll
        for (int ai = 0; ai < 2; ++ai)
#pragma unroll
            for (int m = 0; m < 4; ++m) {
                const int row = u.pm * BM + ai * HALF + wr * 64 + m * 16 + fr;
                const float* src = xp + (size_t)row * ldc; float* dst = out + (size_t)row * ldc; bf16_t* dstb = outb + (size_t)row * ldc;
                float s = 0.f;
#pragma unroll
                for (int bj = 0; bj < 2; ++bj)
#pragma unroll
                    for (int n = 0; n < 2; ++n) { const int c = col0 + bj * HALF + n * 16; const f32x4 v = *(const f32x4*)(src + c) + acc[ai][bj][m][n]; *(f32x4*)(dst + c) = v;
                        s += (v[0] * v[0] + v[1] * v[1]) + (v[2] * v[2] + v[3] * v[3]);
                        unsigned w0 = f2bf_(v[0]) | (f2bf_(v[1]) << 16), w1 = f2bf_(v[2]) | (f2bf_(v[3]) << 16);
                        typedef unsigned u32x2 __attribute__((ext_vector_type(2))); *(u32x2*)(dstb + c) = (u32x2){w0, w1}; }
                s += __shfl_xor(s, 16); s += __shfl_xor(s, 32);
                if (fq == 0) ssq[(size_t)row * 32 + u.pn * 4 + wc] = s;
            }
    }
};
struct EpiBf16RowScale {
    static constexpr bool PERM = true, AFTER_DRAIN = false;
    bf16_t* O; int ldc; const float* rs;
    __device__ __forceinline__ void operator()(const f32x4 (&acc)[2][2][4][2], const Unit& u, int wr, int wc, int fr, int fq) const {
        const int row0 = u.pm * BM + wr * 64 + fr, col0 = u.pn * BM + wc * 32 + 8 * fq;
#pragma unroll
        for (int ai = 0; ai < 2; ++ai)
#pragma unroll
            for (int m = 0; m < 4; ++m) { const int rl = wr * 64 + fr + ai * HALF + m * 16; const float sc = rs[rl]; bf16_t* rowp = O + (size_t)(row0 + ai * HALF + m * 16) * ldc + col0;
#pragma unroll
                for (int bj = 0; bj < 2; ++bj) { const f32x4 v0 = acc[ai][bj][m][0] * sc, v1 = acc[ai][bj][m][1] * sc;
                    u32x4 w; w.x = cvt_pk_bf16(v0[0], v0[1]); w.y = cvt_pk_bf16(v0[2], v0[3]); w.z = cvt_pk_bf16(v1[0], v1[1]); w.w = cvt_pk_bf16(v1[2], v1[3]);
                    *(u32x4*)(rowp + bj * HALF) = w; } }
    }
};
}

#ifndef MK_N_LAUNCHES
#define MK_N_LAUNCHES 1
#endif
constexpr int N_PHASES = 9;
constexpr int N_LAUNCHES = MK_N_LAUNCHES;
constexpr int NWAVES = 8;

constexpr int DM = 2048;
constexpr int TP = 8192, TS = 128, TT = TP + TS;
constexpr int MP = 8448;
constexpr int NP = 16384;
constexpr int PLD = NP + 64;
constexpr int C_Q = 0, C_K = 1024, C_V = 2048, C_R = 4096, C_CB = 6144, C_CC = 8192, C_CX = 10240, C_GA = 12288, C_GB = 14336;
constexpr int DIN = 16400;
constexpr int NEXP = 16384;
constexpr float EPS = 1e-6f;

constexpr size_t MiB = 1u << 20;
constexpr size_t WS_CTL = 0, CTL_ZERO_BYTES = 1 * MiB;
constexpr size_t WS_WINT = 2 * MiB;
constexpr size_t WS_WOUTT = 68 * MiB;
constexpr size_t WS_WQT = 76 * MiB;
constexpr size_t WS_EU = 84 * MiB;
constexpr size_t WS_EV = 148 * MiB;
constexpr size_t WS_XN = 212 * MiB;
constexpr size_t WS_P = 246 * MiB;
constexpr size_t WS_QT = 516 * MiB;
constexpr size_t WS_KT = 532 * MiB;
constexpr size_t WS_VT = 548 * MiB;
constexpr size_t WS_ATT = 580 * MiB;
constexpr size_t WS_EBL = 584 * MiB;
constexpr size_t WS_SKB = 585 * MiB;
constexpr size_t WS_O = 586 * MiB;
constexpr size_t WS_MM = 620 * MiB;
constexpr size_t WS_X2 = 654 * MiB;
constexpr size_t WS_H2 = 720 * MiB;
constexpr size_t WS_SSQ = 799 * MiB;
constexpr size_t WS_QP = 754 * MiB;
constexpr size_t WS_IDX = 788 * MiB;
constexpr size_t WS_GW = 793 * MiB;
constexpr size_t WS_ALR = 798 * MiB;
constexpr size_t WS_SSQS = 799 * MiB + 1100 * 1024;
constexpr size_t WS_RS2 = 799 * MiB + 1200 * 1024;
constexpr size_t WS_END = 801 * MiB;
constexpr int CW_TMO = 0, CW_CODE = 1, CW_BAR = 4096, CW_QUEUE = 16384;

constexpr size_t OUT_Y = 0;
constexpr size_t OUT_GLAP = (size_t)TT * DM;
constexpr size_t OUT_CONVP = OUT_GLAP + (size_t)4 * 4 * 256 * 512;
constexpr size_t OUT_GLAS = OUT_CONVP + (size_t)4 * 2 * 2048;
constexpr size_t OUT_CONVS = OUT_GLAS + (size_t)128 * 4 * 256 * 512;

constexpr int LDS_BYTES = 163840;
constexpr int LDSCTL_OFF = 162816, MISC_OFF = LDSCTL_OFF + 320;
constexpr int RING_OFF = 0;

#define GAS __attribute__((address_space(1)))
#define LAS __attribute__((address_space(3)))
typedef unsigned short bf16;
typedef unsigned v4u __attribute__((ext_vector_type(4)));
typedef unsigned v2u __attribute__((ext_vector_type(2)));
typedef float f32x4 __attribute__((ext_vector_type(4)));
typedef short bf16x8 __attribute__((ext_vector_type(8)));
typedef GAS unsigned gu32;
typedef float v32f __attribute__((ext_vector_type(32)));
typedef float v16f __attribute__((ext_vector_type(16)));
typedef unsigned v6u __attribute__((ext_vector_type(6)));
constexpr int ROW6 = 1536;
#define RLX_AGENT __ATOMIC_RELAXED, __HIP_MEMORY_SCOPE_AGENT
#define LDS_WAIT() asm volatile("s_waitcnt lgkmcnt(0)" ::: "memory")
#define VM_WAIT() asm volatile("s_waitcnt vmcnt(0)" ::: "memory")
#define MFMA16(a, b, c) __builtin_amdgcn_mfma_f32_16x16x32_bf16((a), (b), (c), 0, 0, 0)
__device__ __forceinline__ unsigned f2bf(float f) { unsigned u = __builtin_bit_cast(unsigned, f); return (u + 0x7fffu + ((u >> 16) & 1u)) >> 16; }
__device__ __forceinline__ unsigned pk2(float lo, float hi) { return f2bf(lo) | (f2bf(hi) << 16); }
__device__ __forceinline__ float bf2f(unsigned b) { return __builtin_bit_cast(float, b << 16); }
__device__ __forceinline__ float bflo(unsigned w) { return __builtin_bit_cast(float, w << 16); }
__device__ __forceinline__ float bfhi(unsigned w) { return __builtin_bit_cast(float, w & 0xffff0000u); }
__device__ __forceinline__ void unpack8(const v4u w, float (&f)[8]) { f[0] = bflo(w.x); f[1] = bfhi(w.x); f[2] = bflo(w.y); f[3] = bfhi(w.y); f[4] = bflo(w.z); f[5] = bfhi(w.z); f[6] = bflo(w.w); f[7] = bfhi(w.w); }
__device__ __forceinline__ v4u pack8(const float (&f)[8]) { v4u w; w.x = pk2(f[0], f[1]); w.y = pk2(f[2], f[3]); w.z = pk2(f[4], f[5]); w.w = pk2(f[6], f[7]); return w; }
__device__ __forceinline__ float wave_sum(float v) {
#pragma unroll
    for (int o = 1; o < 64; o <<= 1) v += __shfl_xor(v, o);
    return v;
}
__device__ __forceinline__ float sigmoidf_(float x) { return 1.0f / (1.0f + __expf(-x)); }
#define XB_TMO      128
#define XB_XCNT(j)  (256  + 64 * (j))
#define XB_XSUB(j)  (1280 + 64 * (j))
#define XB_XGEN(j)  (2304 + 64 * (j))
#define XB_TOP      3328
#define XB_TOPGEN   3392
#define XCD_BAR_WORDS 3456
#define XB_SPIN_CAP (1u << 18)

__device__ __forceinline__ unsigned xb_ld(unsigned* p)              { return __hip_atomic_load(p, __ATOMIC_RELAXED, __HIP_MEMORY_SCOPE_AGENT); }
__device__ __forceinline__ unsigned xb_add(unsigned* p, unsigned v) { return __hip_atomic_fetch_add(p, v, __ATOMIC_RELAXED, __HIP_MEMORY_SCOPE_AGENT); }
__device__ __forceinline__ unsigned xb_xcc_id() { return (unsigned)__builtin_amdgcn_s_getreg((3 << 11) | 20) & 0xFu; }
#define XB_SPIN(cond, bar) do { unsigned _sp = 0; while (cond) { __builtin_amdgcn_s_sleep(1); \
    if ((++_sp & 255u) == 0u) { if (xb_ld(&(bar)[XB_TMO])) break; if (_sp > XB_SPIN_CAP) { atomicAdd(&(bar)[XB_TMO], 1u); break; } } } } while (0)

struct XcdBarrier {
    unsigned* bar; unsigned x;
    volatile LAS unsigned* st;
};

__device__ __forceinline__ XcdBarrier xcd_barrier_post(unsigned* bar, volatile LAS unsigned* st) {
    XcdBarrier b; b.bar = bar; b.x = xb_xcc_id(); b.st = st;
    if (threadIdx.x == 0) (void)xb_add(&bar[XB_XCNT(b.x)], 1u);
    return b;
}
__device__ __forceinline__ void xcd_barrier_complete(unsigned* bar, unsigned x, unsigned& nloc, unsigned& nx) {
    const unsigned G = gridDim.x * gridDim.y * gridDim.z;
    unsigned sum, cnt, mine, sp = 0u;
    for (;;) {
        sum = 0u; cnt = 0u; mine = 0u;
#pragma unroll
        for (unsigned j = 0; j < 16; ++j) { const unsigned c = xb_ld(&bar[XB_XCNT(j)]); sum += c; cnt += (c > 0u) ? 1u : 0u; mine = (j == x) ? c : mine; }
        if (sum == G) break;
        __builtin_amdgcn_s_sleep(1);
        if ((++sp & 255u) == 0u) { if (xb_ld(&bar[XB_TMO])) break; if (sp > XB_SPIN_CAP) { atomicAdd(&bar[XB_TMO], 1u); break; } }
    }
    nloc = mine > 0u ? mine : 1u; nx = cnt > 0u ? cnt : 1u;
}

__device__ __forceinline__ void xcd_barrier(const XcdBarrier& b) {
    asm volatile("s_waitcnt vmcnt(0)" ::: "memory");
    __syncthreads();
    if (threadIdx.x == 0) {
        unsigned* bar = b.bar;
        __builtin_amdgcn_s_waitcnt(0);
        unsigned nloc = b.st[0], nx = b.st[1];
        if (nloc == 0u) { xcd_barrier_complete(bar, b.x, nloc, nx); b.st[0] = nloc; b.st[1] = nx; }
        const unsigned old = xb_add(&bar[XB_XSUB(b.x)], 1u);
        const unsigned gen = old / nloc;
        if (old + 1u == (gen + 1u) * nloc) {
            __builtin_amdgcn_fence(__ATOMIC_RELEASE, "agent");
            asm volatile("s_waitcnt vmcnt(0)" ::: "memory");
            const unsigned og = xb_add(&bar[XB_TOP], 1u);
            const unsigned tg = og / nx;
            if (og + 1u == (tg + 1u) * nx) xb_add(&bar[XB_TOPGEN], 1u);
            else XB_SPIN(xb_ld(&bar[XB_TOPGEN]) == tg, bar);
            __builtin_amdgcn_fence(__ATOMIC_ACQUIRE, "agent");
            xb_add(&bar[XB_XGEN(b.x)], 1u);
            asm volatile("s_waitcnt vmcnt(0)" ::: "memory");
        } else {
            XB_SPIN(xb_ld(&bar[XB_XGEN(b.x)]) == gen, bar);
            __builtin_amdgcn_fence(__ATOMIC_ACQUIRE, "agent");
            asm volatile("s_waitcnt vmcnt(0)" ::: "memory");
        }
    }
    __syncthreads();
}
struct Frame {
    unsigned char* lds;
    int tid, lane, wave, vcu, G;
    const float *xp, *xs, *sgla, *sconv, *n1g, *win, *wau, *bal, *gng, *cw, *cb, *wout, *n2g, *wq, *sk, *eu, *ev, *nfg;
    float* out;
    unsigned char* ws;
};

__device__ __forceinline__ void p0_transpose_item(const float* W, int ldw, int src_col0, int k0, bf16* WT, int K, int dst_row0, float* scr, int lane, const float* kscale = nullptr) {
    const int n4 = lane & 15, kr = lane >> 4;
#pragma unroll 8
    for (int i = 0; i < 16; ++i) { const int kk = 4 * i + kr; f32x4 v = __builtin_nontemporal_load((const f32x4*)(W + (size_t)(k0 + kk) * ldw + src_col0 + 4 * n4)); if (kscale) v = v * kscale[k0 + kk];
        float* d = scr + kk * 65 + 4 * n4; d[0] = v.x; d[1] = v.y; d[2] = v.z; d[3] = v.w; }
    LDS_WAIT(); asm volatile("" ::: "memory");
    const int c = lane & 7, nr = lane >> 3;
#pragma unroll
    for (int j = 0; j < 8; ++j) { const int n = nr + 8 * j; const float* s = scr + (8 * c) * 65 + n;
        v4u o; o.x = pk2(s[0 * 65], s[1 * 65]); o.y = pk2(s[2 * 65], s[3 * 65]); o.z = pk2(s[4 * 65], s[5 * 65]); o.w = pk2(s[6 * 65], s[7 * 65]);
        *(v4u*)(WT + (size_t)(dst_row0 + n) * K + k0 + 8 * c) = o; }
    LDS_WAIT(); asm volatile("" ::: "memory");
}
__device__ __forceinline__ void rms_row_to_bf16(const float* xrow, const float* g, bf16* orow, int lane) {
    const f32x4* xr = (const f32x4*)xrow + lane; const f32x4* gr = (const f32x4*)g + lane;
    f32x4 v[8]; float s = 0.f;
#pragma unroll
    for (int j = 0; j < 8; ++j) { v[j] = __builtin_nontemporal_load(xr + 64 * j); s += (v[j].x * v[j].x + v[j].y * v[j].y) + (v[j].z * v[j].z + v[j].w * v[j].w); }
    const float rstd = 1.0f / sqrtf(wave_sum(s) * (1.0f / DM) + EPS);
    v2u* o8 = (v2u*)orow + lane;
#pragma unroll
    for (int j = 0; j < 8; ++j) { const f32x4 gg = gr[64 * j]; v2u w; w.x = pk2(v[j].x * rstd * gg.x, v[j].y * rstd * gg.y); w.y = pk2(v[j].z * rstd * gg.z, v[j].w * rstd * gg.w); o8[64 * j] = w; }
}
__device__ __forceinline__ void zero_row_bf16(bf16* orow, int lane) {
    v2u* o8 = (v2u*)orow + lane; const v2u z = {0u, 0u};
#pragma unroll
    for (int j = 0; j < 8; ++j) o8[64 * j] = z;
}
__device__ __forceinline__ void p0_prologue(Frame& F) {
    bf16* WINT = (bf16*)(F.ws + WS_WINT); bf16* WOUTT = (bf16*)(F.ws + WS_WOUTT); bf16* WQT = (bf16*)(F.ws + WS_WQT);
    float* scr = (float*)(F.lds + F.wave * 16640);
    const int gw = F.vcu * NWAVES + F.wave, NGW = F.G * NWAVES;
    constexpr int I_IN = 32 * 256, I_SQ = 32 * 32;
    for (int it = gw; it < I_IN + 2 * I_SQ; it += NGW) {
        int r = it;
        if (r < I_IN) { const int kb = r >> 8, nb = r & 255, n0 = 64 * nb; p0_transpose_item(F.win, DIN, n0 + (n0 >= 6144 ? 16 : 0), 64 * kb, WINT, DM, n0, scr, F.lane); continue; }
        r -= I_IN;
        if (r < I_SQ) { const int kb = r >> 5, nb = r & 31; p0_transpose_item(F.wout, DM, 64 * nb, 64 * kb, WOUTT, DM, 64 * nb, scr, F.lane); continue; }
        r -= I_SQ;
        { const int kb = r >> 5, nb = r & 31; p0_transpose_item(F.wq, DM, 64 * nb, 64 * kb, WQT, DM, 64 * nb, scr, F.lane, F.n2g); }
    }
    const size_t gt = (size_t)F.vcu * 512 + F.tid, NGT = (size_t)F.G * 512;
    { bf16* SKB = (bf16*)(F.ws + WS_SKB); for (size_t e = gt; e < (size_t)2 * 128 * 128; e += NGT) SKB[e] = (bf16)f2bf(F.sk[e]); }
    { unsigned char* U6 = F.ws + WS_EU; unsigned char* V6 = F.ws + WS_EV; float* SU = (float*)(F.ws + WS_EU + 32 * MiB); float* SV = (float*)(F.ws + WS_EV + 32 * MiB);
      for (int r = gw; r < 2 * NEXP; r += NGW) {
          const bool isv = r >= NEXP; const int row = isv ? r - NEXP : r;
          const float* src = (isv ? F.ev : F.eu) + (size_t)row * DM;
          f32x4 x[8]; float amax = 0.f;
#pragma unroll
          for (int j = 0; j < 8; ++j) { x[j] = __builtin_nontemporal_load((const f32x4*)(src + 256 * j + 4 * F.lane)); if (!isv) x[j] = x[j] * *(const f32x4*)(F.n2g + 256 * j + 4 * F.lane);
              amax = fmaxf(amax, fmaxf(fmaxf(fabsf(x[j].x), fabsf(x[j].y)), fmaxf(fabsf(x[j].z), fabsf(x[j].w)))); }
#pragma unroll
          for (int o = 1; o < 64; o <<= 1) amax = fmaxf(amax, __shfl_xor(amax, o));
          const float sc = amax > 0.f ? 7.5f / amax : 1.0f;
          v16f pa, pb;
#pragma unroll
          for (int j = 0; j < 8; ++j) { pa[2 * j] = x[j].x * sc; pb[2 * j] = x[j].y * sc; pa[2 * j + 1] = x[j].z * sc; pb[2 * j + 1] = x[j].w * sc; }
          const v6u p = __builtin_amdgcn_cvt_scalef32_2xpk16_fp6_f32(pa, pb, 1.0f);
          unsigned char* dst2 = (isv ? V6 : U6) + (size_t)row * ROW6;
          __builtin_nontemporal_store((v4u){p[0], p[1], p[2], p[3]}, (v4u*)(dst2 + 16 * F.lane)); __builtin_nontemporal_store((v2u){p[4], p[5]}, (v2u*)(dst2 + 1024 + 8 * F.lane));
          if (F.lane == 0) (isv ? SV : SU)[row] = amax > 0.f ? amax / 7.5f : 1.0f;
      } }
    __syncthreads();
    { bf16* wt_s = (bf16*)F.lds; constexpr int WLD = DM + 8;
      for (int k = F.tid; k < DM; k += 512) { const float* src = F.win + (size_t)k * DIN + 6144;
#pragma unroll
          for (int q = 0; q < 4; ++q) { const f32x4 w4 = *(const f32x4*)(src + 4 * q); wt_s[(4 * q + 0) * WLD + k] = (bf16)f2bf(w4.x); wt_s[(4 * q + 1) * WLD + k] = (bf16)f2bf(w4.y); wt_s[(4 * q + 2) * WLD + k] = (bf16)f2bf(w4.z); wt_s[(4 * q + 3) * WLD + k] = (bf16)f2bf(w4.w); } }
      bf16* XN = (bf16*)(F.ws + WS_XN); float* ALR = (float*)(F.ws + WS_ALR);
      const int r0 = (int)(((long)F.vcu * TT) / F.G), r1 = (int)(((long)(F.vcu + 1) * TT) / F.G);
      for (int m = r0 + F.wave; m < r1; m += NWAVES) rms_row_to_bf16(m < TP ? F.xp + (size_t)m * DM : F.xs + (size_t)(m - TP) * DM, F.n1g, XN + (size_t)m * DM, F.lane);
      for (int m = TT + gw; m < MP; m += NGW) zero_row_bf16(XN + (size_t)m * DM, F.lane);
      VM_WAIT(); __syncthreads();
      const int l15 = F.lane & 15, lq = F.lane >> 4;
      for (int t0 = r0 + 16 * F.wave; t0 < r1; t0 += 16 * NWAVES) {
          const int row = min(t0 + l15, r1 - 1);
          f32x4 acc = {0.f, 0.f, 0.f, 0.f};
#pragma unroll 8
          for (int ks = 0; ks < 64; ++ks) { const bf16x8 a = *(const bf16x8*)(XN + (size_t)row * DM + 32 * ks + 8 * lq); const bf16x8 bq = *(const bf16x8*)(wt_s + l15 * WLD + 32 * ks + 8 * lq); acc = MFMA16(a, bq, acc); }
#pragma unroll
          for (int r = 0; r < 4; ++r) { const int m = t0 + 4 * lq + r; if (m < r1) ALR[(size_t)m * 16 + l15] = acc[r]; }
      } }
}

template <int NT, class Epi>
__device__ __forceinline__ void skinny_gemm(Frame& F, const bf16* A, const bf16* Bt, int n0, const Epi& E) {
    constexpr int ROWS = NT * 16, NPC = (ROWS * 32 + 511) / 512, BLD = 264;
    bf16* Bs = (bf16*)F.lds;
    const int tid = F.tid, wv = F.wave, l15 = F.lane & 15, lq = F.lane >> 4;
    f32x4 acc[NT];
#pragma unroll
    for (int nt = 0; nt < NT; ++nt) acc[nt] = (f32x4){0.f, 0.f, 0.f, 0.f};
    v4u breg[NPC];
#pragma unroll
    for (int i = 0; i < NPC; ++i) { const int p = tid + 512 * i; if (p < ROWS * 32) breg[i] = *(const v4u*)(Bt + (size_t)(n0 + (p >> 5)) * DM + 8 * (p & 31)); }
#pragma unroll
    for (int i = 0; i < NPC; ++i) { const int p = tid + 512 * i; if (p < ROWS * 32) *(v4u*)(Bs + (p >> 5) * BLD + 8 * (p & 31)) = breg[i]; }
    __syncthreads();
    const bf16* Arow = A + (size_t)(16 * wv + l15) * DM + 8 * lq;
    bf16x8 a[8], an[8];
#pragma unroll
    for (int ks = 0; ks < 8; ++ks) a[ks] = *(const bf16x8*)(Arow + 32 * ks);
#pragma unroll 1
    for (int kc = 0; kc < 8; ++kc) {
        if (kc < 7) {
#pragma unroll
            for (int i = 0; i < NPC; ++i) { const int p = tid + 512 * i; if (p < ROWS * 32) breg[i] = *(const v4u*)(Bt + (size_t)(n0 + (p >> 5)) * DM + (kc + 1) * 256 + 8 * (p & 31)); }
#pragma unroll
            for (int ks = 0; ks < 8; ++ks) an[ks] = *(const bf16x8*)(Arow + (kc + 1) * 256 + 32 * ks); }
        const bf16* Bc = Bs + (kc & 1) * ROWS * BLD;
#pragma unroll
        for (int ks = 0; ks < 8; ++ks)
#pragma unroll
            for (int nt = 0; nt < NT; ++nt) { const bf16x8 bq = *(const bf16x8*)(Bc + (16 * nt + l15) * BLD + 32 * ks + 8 * lq); acc[nt] = MFMA16(a[ks], bq, acc[nt]); }
        if (kc < 7) { bf16* Bn = Bs + ((kc + 1) & 1) * ROWS * BLD;
#pragma unroll
            for (int i = 0; i < NPC; ++i) { const int p = tid + 512 * i; if (p < ROWS * 32) *(v4u*)(Bn + (p >> 5) * BLD + 8 * (p & 31)) = breg[i]; }
#pragma unroll
            for (int ks = 0; ks < 8; ++ks) a[ks] = an[ks]; }
        __syncthreads();
    }
    E.template tile<NT>(acc, wv, l15, lq, n0);
}
struct EpiSkBf16 { bf16* out; int ldc; const float* rs;
    template <int NT> __device__ __forceinline__ void tile(const f32x4 (&acc)[NT], int wv, int l15, int lq, int n0) const {
#pragma unroll
        for (int r = 0; r < 4; ++r) { const int row = 16 * wv + 4 * lq + r; const float sc = rs ? rs[row] : 1.0f;
#pragma unroll
            for (int nt = 0; nt < NT; ++nt) out[(size_t)row * ldc + n0 + 16 * nt + l15] = (bf16)f2bf(acc[nt][r] * sc); } } };
struct EpiSkF32Res { const float* xs; float* out; bf16* outb; float* ssqs;
    template <int NT> __device__ __forceinline__ void tile(const f32x4 (&acc)[NT], int wv, int l15, int lq, int n0) const {
        static_assert(NT == 1, "one 16-column group");
#pragma unroll
        for (int r = 0; r < 4; ++r) { const int row = 16 * wv + 4 * lq + r; const size_t o = (size_t)row * DM + n0 + l15; const float v = xs[o] + acc[0][r]; out[o] = v; outb[o] = (bf16)f2bf(v);
            float s = v * v; s += __shfl_xor(s, 1); s += __shfl_xor(s, 2); s += __shfl_xor(s, 4); s += __shfl_xor(s, 8);
            if (l15 == 0) ssqs[row * 128 + (n0 >> 4)] = s; } } };

__device__ __forceinline__ float logsig(float x) { return fminf(x, 0.f) - __logf(1.0f + __expf(-fabsf(x))); }
__device__ __forceinline__ void gla_prep_unit(Frame& F, int u) {
    const bf16* P = (const bf16*)(F.ws + WS_P); bf16* QT = (bf16*)(F.ws + WS_QT); bf16* KT = (bf16*)(F.ws + WS_KT); bf16* VT = (bf16*)(F.ws + WS_VT);
    bf16* ATT = (bf16*)(F.ws + WS_ATT); float* EBL = (float*)(F.ws + WS_EBL);
    const int b = u >> 7, h = (u >> 5) & 3, c = u & 31, tid = F.tid;
    const int row0 = b * 2048 + c * 64;
    float* alr_s = (float*)F.lds;
    float* tot_s = (float*)(F.lds + 4096);
    bf16* q_s = (bf16*)(F.lds + 8192);
    bf16* k_s = q_s + 64 * 264;
    bf16* v_s = k_s + 64 * 264;
    { v4u tq[4], tk[4], tv[8];
#pragma unroll
      for (int i = 0; i < 4; ++i) { const int p = tid + 512 * i, row = p >> 5, ch = p & 31; const bf16* src = P + (size_t)(row0 + row) * PLD + h * 256 + 8 * ch; tq[i] = *(const v4u*)(src + C_Q); tk[i] = *(const v4u*)(src + C_K); }
#pragma unroll
      for (int i = 0; i < 8; ++i) { const int p = tid + 512 * i, row = p >> 6, ch = p & 63; tv[i] = *(const v4u*)(P + (size_t)(row0 + row) * PLD + C_V + h * 512 + 8 * ch); }
      for (int e = tid; e < 1024; e += 512) alr_s[e] = ((const float*)(F.ws + WS_ALR))[(size_t)row0 * 16 + e];
#pragma unroll
      for (int i = 0; i < 4; ++i) { const int p = tid + 512 * i, row = p >> 5, ch = p & 31; *(v4u*)(q_s + row * 264 + 8 * ch) = tq[i]; *(v4u*)(k_s + row * 264 + 8 * ch) = tk[i]; }
#pragma unroll
      for (int i = 0; i < 8; ++i) { const int p = tid + 512 * i, row = p >> 6, ch = p & 63; *(v4u*)(v_s + row * 520 + 8 * ch) = tv[i]; } }
    const int d = tid & 255, half = tid >> 8;
    float w[16];
#pragma unroll
    for (int r = 0; r < 16; ++r) w[r] = F.wau[r * 1024 + h * 256 + d];
    const float bias = F.bal[h * 256 + d];
    __syncthreads();
    float bb[32]; float run = 0.f;
#pragma unroll
    for (int jj = 0; jj < 32; ++jj) { const int j = half * 32 + jj; float x = bias;
#pragma unroll
        for (int r = 0; r < 16; ++r) x += alr_s[j * 16 + r] * w[r];
        run += logsig(x) * 0.0625f; bb[jj] = run; }
    if (half == 0) tot_s[d] = run;
    __syncthreads();
    if (half == 1) { const float t = tot_s[d];
#pragma unroll
        for (int jj = 0; jj < 32; ++jj) bb[jj] += t; }
    unsigned ktp[16];
#pragma unroll
    for (int jj = 0; jj < 32; ++jj) { const int j = half * 32 + jj;
        const float qv = bf2f(q_s[j * 264 + d]), kv = bf2f(k_s[j * 264 + d]);
        const float e = __expf(bb[jj]), ei = __expf(-bb[jj]);
        const unsigned qb = f2bf(qv * 0.0625f * e), kb = f2bf(kv * ei);
        q_s[j * 264 + d] = (bf16)qb; k_s[j * 264 + d] = (bf16)kb;
        if (jj & 1) ktp[jj >> 1] |= kb << 16; else ktp[jj >> 1] = kb; }
    { v4u* dst = (v4u*)(KT + ((size_t)u * 256 + d) * 64 + half * 32);
#pragma unroll
      for (int i = 0; i < 4; ++i) { v4u o; o.x = ktp[4 * i]; o.y = ktp[4 * i + 1]; o.z = ktp[4 * i + 2]; o.w = ktp[4 * i + 3]; dst[i] = o; } }
    if (half == 1) EBL[u * 256 + d] = __expf(bb[31]);
    __syncthreads();
#pragma unroll
    for (int i = 0; i < 4; ++i) { const int p = tid + 512 * i, row = p >> 5, ch = p & 31; *(v4u*)(QT + (size_t)(row0 + row) * 1024 + h * 256 + 8 * ch) = *(const v4u*)(q_s + row * 264 + 8 * ch); }
    { const int wv = F.wave, l15 = F.lane & 15, lq = F.lane >> 4, mi = wv >> 1;
#pragma unroll
      for (int nn = 0; nn < 2; ++nn) { const int ni = (wv & 1) * 2 + nn; f32x4 acc = {0.f, 0.f, 0.f, 0.f};
#pragma unroll
          for (int ks = 0; ks < 8; ++ks) { const bf16x8 a = *(const bf16x8*)(q_s + (16 * mi + l15) * 264 + 32 * ks + 8 * lq); const bf16x8 bq = *(const bf16x8*)(k_s + (16 * ni + l15) * 264 + 32 * ks + 8 * lq); acc = MFMA16(a, bq, acc); }
#pragma unroll
          for (int r = 0; r < 4; ++r) { const int i = 16 * mi + 4 * lq + r, jn = 16 * ni + l15; ATT[(size_t)u * 4096 + i * 64 + jn] = (bf16)f2bf(jn <= i ? acc[r] : 0.f); } } }
    { const int dv = tid; unsigned vp[32];
#pragma unroll
      for (int j = 0; j < 64; ++j) { const unsigned v = v_s[j * 520 + dv]; if (j & 1) vp[j >> 1] |= v << 16; else vp[j >> 1] = v; }
      v4u* dst = (v4u*)(VT + ((size_t)u * 512 + dv) * 64);
#pragma unroll
      for (int i = 0; i < 8; ++i) { v4u o; o.x = vp[4 * i]; o.y = vp[4 * i + 1]; o.z = vp[4 * i + 2]; o.w = vp[4 * i + 3]; dst[i] = o; } }
    __syncthreads();
}

__device__ __forceinline__ void gla_sample_unit(Frame& F, int u) {
    const bf16* P = (const bf16*)(F.ws + WS_P); bf16* O = (bf16*)(F.ws + WS_O);
    const int n = u >> 2, h = u & 3, tid = F.tid, lane = F.lane, wv = F.wave;
    const size_t m = (size_t)(TP + n);
    float* e_s = (float*)F.lds;
    float* qe_s = e_s + 256;
    float* k_s = qe_s + 256;
    float* v_s = k_s + 256;
    float* red_s = v_s + 512;
    float* op_s = red_s + 64;
    float part = 0.f;
    if (tid < 256) { const int d = tid; float x = F.bal[h * 256 + d];
#pragma unroll
        for (int r = 0; r < 16; ++r) x += ((const float*)(F.ws + WS_ALR))[m * 16 + r] * F.wau[r * 1024 + h * 256 + d];
        const float la = logsig(x) * 0.0625f, e = __expf(la);
        const float q = bf2f(P[m * PLD + C_Q + h * 256 + d]) * 0.0625f, k = bf2f(P[m * PLD + C_K + h * 256 + d]);
        e_s[d] = e; qe_s[d] = q * e; k_s[d] = k; part = q * k; }
    v_s[tid] = bf2f(P[m * PLD + C_V + h * 512 + tid]);
    part = wave_sum(part);
    if (lane == 0) red_s[wv] = part;
    __syncthreads();
    const float attn = (red_s[0] + red_s[1]) + (red_s[2] + red_s[3]);
    const float* Sin = F.sgla + ((size_t)(n * 4 + h) * 256) * 512; float* Sout = F.out + OUT_GLAS + ((size_t)(n * 4 + h) * 256) * 512;
    const f32x4 v0 = *(const f32x4*)(v_s + 4 * lane), v1 = *(const f32x4*)(v_s + 256 + 4 * lane);
    f32x4 o0 = {0.f, 0.f, 0.f, 0.f}, o1 = {0.f, 0.f, 0.f, 0.f};
#pragma unroll 1
    for (int g = 0; g < 4; ++g) {
        f32x4 s0[8], s1[8];
#pragma unroll
        for (int i = 0; i < 8; ++i) { const int d = 32 * wv + 8 * g + i; s0[i] = __builtin_nontemporal_load((const f32x4*)(Sin + (size_t)d * 512 + 4 * lane)); s1[i] = __builtin_nontemporal_load((const f32x4*)(Sin + (size_t)d * 512 + 256 + 4 * lane)); }
#pragma unroll
        for (int i = 0; i < 8; ++i) { const int d = 32 * wv + 8 * g + i; const float e = e_s[d], qe = qe_s[d], k = k_s[d];
            o0 += s0[i] * qe; o1 += s1[i] * qe;
            __builtin_nontemporal_store(s0[i] * e + v0 * k, (f32x4*)(Sout + (size_t)d * 512 + 4 * lane)); __builtin_nontemporal_store(s1[i] * e + v1 * k, (f32x4*)(Sout + (size_t)d * 512 + 256 + 4 * lane)); }
    }
    *(f32x4*)(op_s + wv * 512 + 4 * lane) = o0; *(f32x4*)(op_s + wv * 512 + 256 + 4 * lane) = o1;
    __syncthreads();
    { float o = attn * v_s[tid];
#pragma unroll
      for (int w8 = 0; w8 < 8; ++w8) o += op_s[w8 * 512 + tid];
      O[m * DM + h * 512 + tid] = (bf16)f2bf(o); }
    __syncthreads();
}

struct GlaRegs { bf16x8 kt[2][2], at, q[4]; v4u vpiece; };
struct GlaOffs { unsigned att, vt, qt, kt, eb; };
template <int NT>
__device__ __forceinline__ GlaOffs gla_offs(int wv, int l15, int lq, int tid) {
    const int mi = wv >> 1, kh = wv & 1, tv = tid & (NT * 128 - 1); GlaOffs o;
    o.att = (unsigned)(((16 * mi + l15) * 64 + 32 * kh + 8 * lq) * 2);
    o.vt = (unsigned)(((tv >> 3) * 64 + 8 * (tv & 7)) * 2);
    o.qt = (unsigned)(((16 * mi + l15) * 1024 + 128 * kh + 8 * lq) * 2);
    o.kt = (unsigned)(((32 * wv + l15) * 64 + 8 * lq) * 2);
    o.eb = (unsigned)((32 * wv + 4 * lq) * 4);
    return o;
}
template <int NT>
__device__ __forceinline__ void gla_load(GlaRegs& R, const GlaOffs& o, const bf16* QT, const bf16* KT, const bf16* VT, const bf16* ATT, int bh, int s, int c) {
    const size_t u = (size_t)bh * 32 + c; const int b = bh >> 2, h = bh & 3;
    const char* pa = (const char*)(ATT + u * 4096); const char* pv = (const char*)(VT + (u * 512 + 16 * NT * s) * 64);
    const char* pq = (const char*)(QT + ((size_t)b * 2048 + 64 * c) * 1024 + h * 256); const char* pk = (const char*)(KT + u * 256 * 64);
    R.at = *(const bf16x8*)(pa + o.att);
    R.vpiece = *(const v4u*)(pv + o.vt);
#pragma unroll
    for (int ks = 0; ks < 4; ++ks) R.q[ks] = *(const bf16x8*)(pq + o.qt + 64 * ks);
#pragma unroll
    for (int t = 0; t < 2; ++t)
#pragma unroll
        for (int ks = 0; ks < 2; ++ks) R.kt[t][ks] = *(const bf16x8*)(pk + o.kt + 2048 * t + 64 * ks);
}
constexpr int VT_LD = 72;
template <int NT>
__device__ __forceinline__ void gla_step(const GlaRegs& R, const f32x4 (&eb)[2], f32x4 (&S)[2][NT], const bf16* vts, const bf16* STp, bf16* STn, float* xo, int wv, int lane, int l15, int lq) {
    const int mi = wv >> 1, kh = wv & 1;
#pragma unroll
    for (int nt = 0; nt < NT; ++nt) {
        f32x4 acc = {0.f, 0.f, 0.f, 0.f};
        { const bf16x8 vsel = *(const bf16x8*)(vts + (16 * nt + l15) * VT_LD + 32 * kh + 8 * lq); acc = MFMA16(R.at, vsel, acc); }
#pragma unroll
        for (int ks = 0; ks < 4; ++ks) { const bf16x8 sf = *(const bf16x8*)(STp + (16 * nt + l15) * 264 + 128 * kh + 32 * ks + 8 * lq); acc = MFMA16(R.q[ks], sf, acc); }
        *(f32x4*)(xo + (((mi * 2 + kh) * NT + nt) * 64 + lane) * 4) = acc;
    }
#pragma unroll
    for (int nt = 0; nt < NT; ++nt) {
        bf16x8 vt[2];
#pragma unroll
        for (int ks = 0; ks < 2; ++ks) vt[ks] = *(const bf16x8*)(vts + (16 * nt + l15) * VT_LD + 32 * ks + 8 * lq);
#pragma unroll
        for (int mt = 0; mt < 2; ++mt) {
#pragma unroll
            for (int ks = 0; ks < 2; ++ks) S[mt][nt] = MFMA16(R.kt[mt][ks], vt[ks], S[mt][nt]);
            S[mt][nt] = S[mt][nt] * eb[mt];
            v2u w; w.x = pk2(S[mt][nt][0], S[mt][nt][1]); w.y = pk2(S[mt][nt][2], S[mt][nt][3]);
            *(v2u*)(STn + (16 * nt + l15) * 264 + 32 * wv + 16 * mt + 4 * lq) = w; } }
}
template <int NT>
__device__ __forceinline__ void gla_store_o(const float* xo, bf16* O, int b, int h, int s, int c, int wv, int lane, int l15, int lq) {
    const int mi = wv >> 1;
#pragma unroll
    for (int nt = 0; nt < NT; ++nt) { const f32x4 t = *(const f32x4*)(xo + (((mi * 2 + 0) * NT + nt) * 64 + lane) * 4) + *(const f32x4*)(xo + (((mi * 2 + 1) * NT + nt) * 64 + lane) * 4);
#pragma unroll
        for (int r = 0; r < 4; ++r) O[((size_t)b * 2048 + 64 * c + 16 * mi + 4 * lq + r) * DM + h * 512 + 16 * NT * s + 16 * nt + l15] = (bf16)f2bf(t[r]); }
}
#define GLA_BAR() do { asm volatile("s_waitcnt lgkmcnt(0)" ::: "memory"); __builtin_amdgcn_s_barrier(); asm volatile("" ::: "memory"); } while (0)
template <int NT>
__device__ __forceinline__ void gla_main_unit(Frame& F, int bh, int s) {
    const bf16* QT = (const bf16*)(F.ws + WS_QT); const bf16* KT = (const bf16*)(F.ws + WS_KT); const bf16* VT = (const bf16*)(F.ws + WS_VT);
    const bf16* ATT = (const bf16*)(F.ws + WS_ATT); const float* EBL = (const float*)(F.ws + WS_EBL); bf16* O = (bf16*)(F.ws + WS_O);
    const int b = bh >> 2, h = bh & 3, wv = F.wave, lane = F.lane, l15 = lane & 15, lq = lane >> 4, kh = wv & 1, tid = F.tid;
    constexpr int ST_ELEMS = NT * 16 * 264, XO_FLOATS = 8 * NT * 256, VTS_ELEMS = NT * 16 * VT_LD;
    bf16* ST = (bf16*)F.lds;
    float* XO = (float*)(F.lds + 2 * ST_ELEMS * 2);
    bf16* VTS = (bf16*)(F.lds + 2 * ST_ELEMS * 2 + 2 * XO_FLOATS * 4);
    for (int e = tid; e < ST_ELEMS; e += 512) ((unsigned*)ST)[e] = 0u;
    f32x4 S[2][NT];
#pragma unroll
    for (int a = 0; a < 2; ++a)
#pragma unroll
        for (int c2 = 0; c2 < NT; ++c2) S[a][c2] = (f32x4){0.f, 0.f, 0.f, 0.f};
    const GlaOffs go = gla_offs<NT>(wv, l15, lq, tid);
    GlaRegs RA, RB, RC;
    gla_load<NT>(RA, go, QT, KT, VT, ATT, bh, s, 0);
    gla_load<NT>(RB, go, QT, KT, VT, ATT, bh, s, 1);
    if (tid < NT * 128) *(v4u*)(VTS + (tid >> 3) * VT_LD + 8 * (tid & 7)) = RA.vpiece;
    __syncthreads();
#define GLA_ITER(c, RCUR, RNXT, RLD) do { if ((c) < 32) { \
            f32x4 eb[2]; { const char* pe = (const char*)(EBL + ((size_t)bh * 32 + (c)) * 256); eb[0] = *(const f32x4*)(pe + go.eb); eb[1] = *(const f32x4*)(pe + go.eb + 64); } \
            gla_load<NT>(RLD, go, QT, KT, VT, ATT, bh, s, (c) + 2 < 32 ? (c) + 2 : 31); \
            gla_step<NT>(RCUR, eb, S, VTS + ((c) & 1) * VTS_ELEMS, ST + ((c) & 1) * ST_ELEMS, ST + (((c) + 1) & 1) * ST_ELEMS, XO + ((c) & 1) * XO_FLOATS, wv, lane, l15, lq); \
            if (!kh && (c) > 0) gla_store_o<NT>(XO + (((c) + 1) & 1) * XO_FLOATS, O, b, h, s, (c) - 1, wv, lane, l15, lq); \
            if (tid < NT * 128) *(v4u*)(VTS + (((c) + 1) & 1) * VTS_ELEMS + (tid >> 3) * VT_LD + 8 * (tid & 7)) = RNXT.vpiece; \
            GLA_BAR(); \
        } } while (0)
#pragma unroll 1
    for (int c = 0; c < 33; c += 3) { GLA_ITER(c, RA, RB, RC); GLA_ITER(c + 1, RB, RC, RA); GLA_ITER(c + 2, RC, RA, RB); }
#undef GLA_ITER
    if (!kh) gla_store_o<NT>(XO + (31 & 1) * XO_FLOATS, O, b, h, s, 31, wv, lane, l15, lq);
    float* So = F.out + OUT_GLAP + ((size_t)bh * 256) * 512;
#pragma unroll
    for (int mt = 0; mt < 2; ++mt)
#pragma unroll
        for (int nt = 0; nt < NT; ++nt)
#pragma unroll
            for (int r = 0; r < 4; ++r) So[(size_t)(32 * wv + 16 * mt + 4 * lq + r) * 512 + 16 * NT * s + 16 * nt + l15] = S[mt][nt][r];
    __syncthreads();
}

__device__ __forceinline__ void mixer_rows(Frame& F, int m0, int nr) {
    const bf16* P = (const bf16*)(F.ws + WS_P); const bf16* O = (const bf16*)(F.ws + WS_O); bf16* MM = (bf16*)(F.ws + WS_MM);
    const int lane = F.lane; const bool prompt = m0 < TP;
#pragma unroll 1
    for (int j = 0; j < 4; ++j) {
        const int col = 512 * j + 8 * lane;
        float u1[8], u2[8], gn[8], cbi[8], w0[8], w1[8], w2[8];
        { const f32x4 a = *(const f32x4*)(F.gng + col), b2 = *(const f32x4*)(F.gng + col + 4); gn[0] = a.x; gn[1] = a.y; gn[2] = a.z; gn[3] = a.w; gn[4] = b2.x; gn[5] = b2.y; gn[6] = b2.z; gn[7] = b2.w; }
        { const f32x4 a = *(const f32x4*)(F.cb + col), b2 = *(const f32x4*)(F.cb + col + 4); cbi[0] = a.x; cbi[1] = a.y; cbi[2] = a.z; cbi[3] = a.w; cbi[4] = b2.x; cbi[5] = b2.y; cbi[6] = b2.z; cbi[7] = b2.w; }
        { const f32x4 a = *(const f32x4*)(F.cw + col), b2 = *(const f32x4*)(F.cw + col + 4); w0[0] = a.x; w0[1] = a.y; w0[2] = a.z; w0[3] = a.w; w0[4] = b2.x; w0[5] = b2.y; w0[6] = b2.z; w0[7] = b2.w; }
        { const f32x4 a = *(const f32x4*)(F.cw + DM + col), b2 = *(const f32x4*)(F.cw + DM + col + 4); w1[0] = a.x; w1[1] = a.y; w1[2] = a.z; w1[3] = a.w; w1[4] = b2.x; w1[5] = b2.y; w1[6] = b2.z; w1[7] = b2.w; }
        { const f32x4 a = *(const f32x4*)(F.cw + 2 * DM + col), b2 = *(const f32x4*)(F.cw + 2 * DM + col + 4); w2[0] = a.x; w2[1] = a.y; w2[2] = a.z; w2[3] = a.w; w2[4] = b2.x; w2[5] = b2.y; w2[6] = b2.z; w2[7] = b2.w; }
        if (prompt) {
            const int t0 = m0 & 2047; const bf16* Pr = P + (size_t)m0 * PLD;
            if (t0 >= 1) { float a[8], b2[8]; unpack8(*(const v4u*)(Pr - PLD + C_CC + col), a); unpack8(*(const v4u*)(Pr - PLD + C_CX + col), b2);
#pragma unroll
                for (int e = 0; e < 8; ++e) u1[e] = a[e] * b2[e]; }
            else {
#pragma unroll
                for (int e = 0; e < 8; ++e) u1[e] = 0.f; }
            if (t0 >= 2) { float a[8], b2[8]; unpack8(*(const v4u*)(Pr - 2 * PLD + C_CC + col), a); unpack8(*(const v4u*)(Pr - 2 * PLD + C_CX + col), b2);
#pragma unroll
                for (int e = 0; e < 8; ++e) u2[e] = a[e] * b2[e]; }
            else {
#pragma unroll
                for (int e = 0; e < 8; ++e) u2[e] = 0.f; }
        } else {
            const int n = m0 - TP; const float* sc = F.sconv + (size_t)n * 2 * DM + col;
            const f32x4 a0 = *(const f32x4*)sc, a1 = *(const f32x4*)(sc + 4), b0 = *(const f32x4*)(sc + DM), b1 = *(const f32x4*)(sc + DM + 4);
            u2[0] = a0.x; u2[1] = a0.y; u2[2] = a0.z; u2[3] = a0.w; u2[4] = a1.x; u2[5] = a1.y; u2[6] = a1.z; u2[7] = a1.w;
            u1[0] = b0.x; u1[1] = b0.y; u1[2] = b0.z; u1[3] = b0.w; u1[4] = b1.x; u1[5] = b1.y; u1[6] = b1.z; u1[7] = b1.w;
        }
#pragma unroll 1
        for (int r = 0; r < nr; ++r) {
            const int m = m0 + r; const bf16* Pr = P + (size_t)m * PLD;
            float o[8], rr[8], cbv[8], cc[8], cx[8], ga[8], gb[8], u[8];
            unpack8(*(const v4u*)(O + (size_t)m * DM + col), o);
            unpack8(*(const v4u*)(Pr + C_R + col), rr); unpack8(*(const v4u*)(Pr + C_CB + col), cbv); unpack8(*(const v4u*)(Pr + C_CC + col), cc); unpack8(*(const v4u*)(Pr + C_CX + col), cx);
            unpack8(*(const v4u*)(Pr + C_GA + col), ga); unpack8(*(const v4u*)(Pr + C_GB + col), gb);
            float ss = 0.f;
#pragma unroll
            for (int e = 0; e < 8; ++e) ss += o[e] * o[e];
            const float rstd = 1.0f / sqrtf(wave_sum(ss) * (1.0f / 512.0f) + EPS);
#pragma unroll
            for (int e = 0; e < 8; ++e) u[e] = cc[e] * cx[e];
            if (prompt) { const int t = m & 2047;
                if (t >= 2046) { float* dst = F.out + OUT_CONVP + ((size_t)(m >> 11) * 2 + (t - 2046)) * DM + col;
                    *(f32x4*)dst = (f32x4){u[0], u[1], u[2], u[3]}; *(f32x4*)(dst + 4) = (f32x4){u[4], u[5], u[6], u[7]}; }
            } else { float* dst = F.out + OUT_CONVS + (size_t)(m - TP) * 2 * DM + col;
                *(f32x4*)dst = (f32x4){u1[0], u1[1], u1[2], u1[3]}; *(f32x4*)(dst + 4) = (f32x4){u1[4], u1[5], u1[6], u1[7]};
                *(f32x4*)(dst + DM) = (f32x4){u[0], u[1], u[2], u[3]}; *(f32x4*)(dst + DM + 4) = (f32x4){u[4], u[5], u[6], u[7]}; }
            float mv[8];
#pragma unroll
            for (int e = 0; e < 8; ++e) {
                const float ya = (rr[e] * sigmoidf_(rr[e])) * (o[e] * rstd * gn[e]);
                const float z = cbi[e] + w0[e] * u2[e] + w1[e] * u1[e] + w2[e] * u[e];
                mv[e] = sigmoidf_(ga[e]) * ya + sigmoidf_(gb[e]) * (cbv[e] * z);
                u2[e] = u1[e]; u1[e] = u[e];
            }
            *(v4u*)(MM + (size_t)m * DM + col) = pack8(mv);
        }
    }
}

constexpr int SC_LD = 130;
__device__ __forceinline__ int f2sort(float f) { const int b = __float_as_int(f); return b ^ ((b >> 31) & 0x7fffffff); }
__device__ __forceinline__ float sort2f(int s) { return __int_as_float(s ^ ((s >> 31) & 0x7fffffff)); }
#define CE_DESC(x, y) do { const int mx_ = max(x, y), mn_ = min(x, y); x = mx_; y = mn_; } while (0)
template <int N> __device__ __forceinline__ void bitonic_sort_desc(int (&a)[N]) {
#pragma unroll
    for (int k = 2; k <= N; k <<= 1)
#pragma unroll
        for (int j = k >> 1; j > 0; j >>= 1)
#pragma unroll
            for (int i = 0; i < N; ++i) { const int l = i ^ j; if (l > i) { if ((i & k) == 0) CE_DESC(a[i], a[l]); else CE_DESC(a[l], a[i]); } }
}
template <int N> __device__ __forceinline__ void bitonic_merge_desc(int (&a)[N]) {
#pragma unroll
    for (int j = N >> 1; j > 0; j >>= 1)
#pragma unroll
        for (int i = 0; i < N; ++i) { const int l = i ^ j; if (l > i) CE_DESC(a[i], a[l]); }
}
__device__ __forceinline__ void top16_merge(int (&a)[16], const int (&b)[16]) {
#pragma unroll
    for (int i = 0; i < 16; ++i) a[i] = max(a[i], b[15 - i]);
    bitonic_merge_desc<16>(a);
}
__device__ __attribute__((aligned(16))) const unsigned char PK_CAND[64] = {
    0x00, 0x01, 0x02, 0x03, 0x04, 0x05, 0x06, 0x07, 0x08, 0x09, 0x0a, 0x0b, 0x0c, 0x0d, 0x0e, 0x0f,
    0x10, 0x11, 0x12, 0x13, 0x14, 0x15, 0x16, 0x17, 0x20, 0x21, 0x22, 0x23, 0x24, 0x50, 0x51, 0xff,
    0x30, 0x31, 0x32, 0x33, 0x40, 0x41, 0x42, 0x60, 0x61, 0x70, 0x71, 0xff, 0xff, 0xff, 0xff, 0xff,
    0x80, 0x90, 0xa0, 0xb0, 0xc0, 0xd0, 0xe0, 0xf0, 0xff, 0xff, 0xff, 0xff, 0xff, 0xff, 0xff, 0xff};
constexpr int SC8_LD = 132, SK_LD = 136;
constexpr int SC8_BYTES = 128 * SC8_LD * 4, TV8_OFF = SC8_BYTES, SK_OFF = TV8_OFF + 128 * 16 * 4;
__device__ __forceinline__ void peer_load_subkeys(Frame& F) {
    const bf16* SKB = (const bf16*)(F.ws + WS_SKB); bf16* sk_s = (bf16*)(F.lds + SK_OFF);
    for (int e = F.tid; e < 256 * 16; e += 512) { const int row = e >> 4, ch = e & 15; *(v4u*)(sk_s + row * SK_LD + 8 * ch) = *(const v4u*)(SKB + (size_t)row * 128 + 8 * ch); }
    __syncthreads();
}
__device__ __forceinline__ void peer_qfrags(Frame& F, int tb, bf16x8 (&a)[2][4]) {
    const bf16* QP = (const bf16*)(F.ws + WS_QP); const int tok = min(tb + (F.lane & 7), TT - 1), lq = F.lane >> 4;
#pragma unroll
    for (int hf = 0; hf < 2; ++hf)
#pragma unroll
        for (int ks = 0; ks < 4; ++ks) a[hf][ks] = *(const bf16x8*)(QP + (size_t)tok * DM + F.wave * 256 + hf * 128 + 32 * ks + 8 * lq);
}
#define PK_BAR() do { asm volatile("s_waitcnt lgkmcnt(0)" ::: "memory"); __builtin_amdgcn_s_barrier(); asm volatile("" ::: "memory"); } while (0)
__device__ __forceinline__ void peer_topk_tile(Frame& F, int tb, int tend, bf16x8 (&a)[2][4]) {
    int* IDX = (int*)(F.ws + WS_IDX); float* GW = (float*)(F.ws + WS_GW);
    float* sc_s = (float*)F.lds;
    int* tv_s = (int*)(F.lds + TV8_OFF);
    const bf16* sk_s = (const bf16*)(F.lds + SK_OFF);
    const int wv = F.wave, lane = F.lane, l15 = lane & 15, lq = lane >> 4, tid = F.tid;
    {
#pragma unroll
      for (int hf = 0; hf < 2; ++hf) {
#pragma unroll
          for (int nt = 0; nt < 8; ++nt) { f32x4 acc = {0.f, 0.f, 0.f, 0.f};
#pragma unroll
              for (int ks = 0; ks < 4; ++ks) { const bf16x8 bq = *(const bf16x8*)(sk_s + (hf * 128 + 16 * nt + l15) * SK_LD + 32 * ks + 8 * lq); acc = MFMA16(a[hf][ks], bq, acc); }
              if (lq < 2) {
#pragma unroll
                  for (int r = 0; r < 4; ++r) sc_s[((wv * 2 + hf) * 8 + 4 * lq + r) * SC8_LD + 16 * nt + l15] = acc[r]; } } } }
    if (tb + 8 < tend) peer_qfrags(F, tb + 8, a);
    PK_BAR();
    { const int row = tid >> 2, sub = tid & 3; const float* rp = sc_s + row * SC8_LD;
      int top[16], v[16];
#pragma unroll
      for (int i = 0; i < 16; ++i) { const int key = 4 * i + sub; top[i] = (f2sort(rp[key]) & ~127) | (127 - key); }
      bitonic_sort_desc<16>(top);
#pragma unroll
      for (int i = 0; i < 16; ++i) { const int key = 4 * (16 + i) + sub; v[i] = (f2sort(rp[key]) & ~127) | (127 - key); }
      bitonic_sort_desc<16>(v);
      top16_merge(top, v);
#pragma unroll
      for (int sh = 1; sh < 4; sh <<= 1) {
#pragma unroll
          for (int i = 0; i < 16; ++i) v[i] = __shfl_xor(top[i], sh);
          top16_merge(top, v); }
      if (sub == 0) {
#pragma unroll
          for (int q = 0; q < 4; ++q) *(int __attribute__((ext_vector_type(4)))*)(tv_s + row * 16 + 4 * q) = (int __attribute__((ext_vector_type(4)))){top[4 * q], top[4 * q + 1], top[4 * q + 2], top[4 * q + 3]}; }
    }
    PK_BAR();
    if (tid < 256) { const int it = tid >> 2, qd = tid & 3, tl = it & 7, hd = it >> 3;
      const int* r1 = tv_s + ((hd * 2 + 0) * 8 + tl) * 16; const int* r2 = tv_s + ((hd * 2 + 1) * 8 + tl) * 16;
      int c[16];
      const v4u cw = *(const v4u*)(PK_CAND + qd * 16);
#pragma unroll
      for (int t = 0; t < 16; ++t) { const int ab = (int)((cw[t >> 2] >> (8 * (t & 3))) & 0xffu); const int abc = ab != 0xff ? ab : 0;
          const float sv = sort2f(r1[abc >> 4] & ~127) + sort2f(r2[abc & 15] & ~127); const int packed = (f2sort(sv) & ~255) | (255 - ab);
          c[t] = ab != 0xff ? packed : (int)0x80000000; }
      bitonic_sort_desc<16>(c);
#pragma unroll
      for (int sh = 1; sh < 4; sh <<= 1) { int oth[16];
#pragma unroll
          for (int i = 0; i < 16; ++i) oth[i] = __shfl_xor(c[i], sh);
          top16_merge(c, oth); }
      const int tok = tb + tl;
      if (tok < tend) {
          float ev[16], sum = 0.f; const float mx = sort2f(c[0] & ~255);
#pragma unroll
          for (int k = 0; k < 16; ++k) { ev[k] = __expf(sort2f(c[k] & ~255) - mx); sum += ev[k]; }
          const float inv = 1.0f / sum;
#pragma unroll
          for (int k = 0; k < 16; ++k) if ((k >> 2) == qd) { const int ab = 255 - (c[k] & 255); const int i1 = 127 - (r1[ab >> 4] & 127), i2 = 127 - (r2[ab & 15] & 127);
              IDX[(size_t)tok * 128 + hd * 16 + k] = i1 * 128 + i2; GW[(size_t)tok * 128 + hd * 16 + k] = ev[k] * inv; }
      }
    }
    PK_BAR();
}

__device__ __forceinline__ void peer_phase(Frame& F, int tok0, int tok1) {
    const unsigned char* U6 = F.ws + WS_EU; const unsigned char* V6 = F.ws + WS_EV; const float* SU = (const float*)(F.ws + WS_EU + 32 * MiB); const float* SV = (const float*)(F.ws + WS_EV + 32 * MiB);
    const float* X2 = (const float*)(F.ws + WS_X2); const float* RS2 = (const float*)(F.ws + WS_RS2); const int* IDX = (const int*)(F.ws + WS_IDX); const float* GW = (const float*)(F.ws + WS_GW);
    const int wv = F.wave, lane = F.lane, tid = F.tid;
    float* red_s = (float*)F.lds;
    float* ss_s = (float*)(F.lds + 131072);
    const f32x4 gfin = *(const f32x4*)(F.nfg + 4 * tid);
    f32x4 x3p = {0.f, 0.f, 0.f, 0.f}; int buf = 0;
#pragma unroll 1
    for (int m = tok0; m <= tok1; ++m) {
        if (m < tok1) {
            const int myidx = IDX[(size_t)m * 128 + wv * 16 + (lane & 15)]; float myg = GW[(size_t)m * 128 + wv * 16 + (lane & 15)];
            const float mysu = SU[myidx] * RS2[m]; myg *= SV[myidx];
            float hf[32];
#pragma unroll
            for (int j = 0; j < 8; ++j) { const f32x4 w = *(const f32x4*)(X2 + (size_t)m * DM + 256 * j + 4 * lane); hf[4 * j] = w.x; hf[4 * j + 1] = w.y; hf[4 * j + 2] = w.z; hf[4 * j + 3] = w.w; }
            float acc[32];
#pragma unroll
            for (int k = 0; k < 32; ++k) acc[k] = 0.f;
#pragma unroll 1
            for (int kg = 0; kg < 4; ++kg) {
                v4u ul4[4], vl4[4]; v2u ul2[4], vl2[4]; float gk[4], su[4];
#pragma unroll
                for (int kk = 0; kk < 4; ++kk) { const int ex = __shfl(myidx, kg * 4 + kk); gk[kk] = __shfl(myg, kg * 4 + kk); su[kk] = __shfl(mysu, kg * 4 + kk);
                    const unsigned char* ur = U6 + (size_t)ex * ROW6; const unsigned char* vr = V6 + (size_t)ex * ROW6;
                    ul4[kk] = *(const v4u*)(ur + 16 * lane); ul2[kk] = *(const v2u*)(ur + 1024 + 8 * lane); vl4[kk] = *(const v4u*)(vr + 16 * lane); vl2[kk] = *(const v2u*)(vr + 1024 + 8 * lane); }
#pragma unroll
                for (int kk = 0; kk < 4; ++kk) {
                    const v32f uf = __builtin_amdgcn_cvt_scalef32_pk32_f32_fp6((v6u){ul4[kk].x, ul4[kk].y, ul4[kk].z, ul4[kk].w, ul2[kk].x, ul2[kk].y}, 1.0f);
                    float dot = 0.f;
#pragma unroll
                    for (int k = 0; k < 32; ++k) dot += uf[k] * hf[k];
                    const float a = wave_sum(dot) * su[kk];
                    const float wgt = gk[kk] * (0.5f * a * (1.0f + erff(a * 0.70710678118654752f)));
                    const v32f vf = __builtin_amdgcn_cvt_scalef32_pk32_f32_fp6((v6u){vl4[kk].x, vl4[kk].y, vl4[kk].z, vl4[kk].w, vl2[kk].x, vl2[kk].y}, 1.0f);
#pragma unroll
                    for (int k = 0; k < 32; ++k) acc[k] += wgt * vf[k];
                }
            }
#pragma unroll
            for (int j = 0; j < 8; ++j) *(f32x4*)(red_s + (buf * 8 + wv) * 2048 + 256 * j + 4 * lane) = (f32x4){acc[4 * j], acc[4 * j + 1], acc[4 * j + 2], acc[4 * j + 3]};
        }
        __syncthreads();
        if (m > tok0) {
            float tot = 0.f;
#pragma unroll
            for (int w8 = 0; w8 < 8; ++w8) tot += ss_s[(buf ^ 1) * 8 + w8];
            const float rstd = 1.0f / sqrtf(tot * (1.0f / DM) + EPS);
            *(f32x4*)(F.out + OUT_Y + (size_t)(m - 1) * DM + 4 * tid) = x3p * rstd * gfin;
        }
        if (m < tok1) {
            f32x4 x3 = *(const f32x4*)(X2 + (size_t)m * DM + 4 * tid);
#pragma unroll
            for (int w8 = 0; w8 < 8; ++w8) x3 += *(const f32x4*)(red_s + (buf * 8 + w8) * 2048 + 4 * tid);
            const float ss = wave_sum((x3.x * x3.x + x3.y * x3.y) + (x3.z * x3.z + x3.w * x3.w));
            if (lane == 0) ss_s[buf * 8 + wv] = ss;
            x3p = x3;
        }
        buf ^= 1;
    }
    __syncthreads();
}
struct Args { const float* in[18]; float* out; unsigned char* ws; int ph_lo, ph_hi; };
__global__ void __launch_bounds__(NWAVES * 64, 2) mk_fwd(Args args) {
    extern __shared__ __attribute__((aligned(16))) unsigned char lds[];
    Frame F;
    F.lds = lds;
    F.tid = threadIdx.x; F.lane = F.tid & 63; F.wave = __builtin_amdgcn_readfirstlane(F.tid >> 6);
    F.G = gridDim.x; { const int bx = blockIdx.x; F.vcu = (F.G % 8 == 0) ? (bx % 8) * (F.G / 8) + bx / 8 : bx; }
    F.xp = args.in[0]; F.xs = args.in[1]; F.sgla = args.in[2]; F.sconv = args.in[3]; F.n1g = args.in[4]; F.win = args.in[5]; F.wau = args.in[6]; F.bal = args.in[7];
    F.gng = args.in[8]; F.cw = args.in[9]; F.cb = args.in[10]; F.wout = args.in[11]; F.n2g = args.in[12]; F.wq = args.in[13]; F.sk = args.in[14]; F.eu = args.in[15];
    F.ev = args.in[16]; F.nfg = args.in[17]; F.out = args.out; F.ws = args.ws;
    for (int u = F.tid; u < (LDS_BYTES - LDSCTL_OFF) / 4; u += NWAVES * 64) ((LAS unsigned*)((LAS unsigned char*)lds + LDSCTL_OFF))[u] = 0u;
    __syncthreads();
    gu32* ctl = (gu32*)(F.ws + WS_CTL);
    XcdBarrier bar; bar.bar = (unsigned*)(ctl + CW_BAR); bar.x = 0; bar.st = nullptr;
    if (N_LAUNCHES == 1) bar = xcd_barrier_post((unsigned*)(ctl + CW_BAR), (volatile LAS unsigned*)((LAS unsigned char*)lds + MISC_OFF) + 8);
    const int lo = args.ph_lo, hi = args.ph_hi;
#ifndef SKREP
#define SKREP 1
#endif
#ifndef PROBE_DBL
#define PROBE_DBL -1
#endif
#define IN(k) (lo <= (k) && (k) < hi)
#define REP(k) for (int rep_ = 0; rep_ < ((k) == PROBE_DBL ? 2 : 1); ++rep_)
#define SEAM(k) do { if (IN(k) && IN((k) + 1)) xcd_barrier(bar); } while (0)
    const int gw = F.vcu * NWAVES + F.wave, NGW = F.G * NWAVES;
    const int tok0 = (int)(((long)F.vcu * TT) / F.G), tok1 = (int)(((long)(F.vcu + 1) * TT) / F.G);

    if (IN(0)) REP(0) { p0_prologue(F); __syncthreads(); }
    SEAM(0);
    if (IN(1)) REP(1) {
        pg8::Gemm g{(const pg8::bf16_t*)(F.ws + WS_XN), (const pg8::bf16_t*)(F.ws + WS_WINT), TP, NP, DM}; pg8::StaticOrder S; S.init(TP, NP, F.G, (int)blockIdx.x);
        pg8::EpiBf16<0> E{(pg8::bf16_t*)(F.ws + WS_P), PLD, nullptr, 0, 0, 1.f};
        pg8::gemm_phase<pg8::EpiBf16<0>, pg8::StaticOrder, true, true>((PG8_LAS unsigned char*)lds + RING_OFF, g, S, E);
#ifdef GEMM1_TWICE
        pg8::gemm_phase<pg8::EpiBf16<0>, pg8::StaticOrder, true, true>((PG8_LAS unsigned char*)lds + RING_OFF, g, S, E);
#endif
        { EpiSkBf16 Es{(bf16*)(F.ws + WS_P) + (size_t)TP * PLD, PLD, nullptr};
          for (int skr = 0; skr < SKREP; ++skr) for (int ng = F.vcu; ng < NP / 64; ng += F.G) skinny_gemm<4>(F, (const bf16*)(F.ws + WS_XN) + (size_t)TP * DM, (const bf16*)(F.ws + WS_WINT), 64 * ng, Es); }
    }
    SEAM(1);
    if (IN(2)) REP(2) { for (int u = F.vcu; u < 512; u += F.G) gla_prep_unit(F, u); }
    SEAM(2);
    if (IN(3)) REP(3) {
        if ((F.vcu & 1) == 0) { for (int g = F.vcu >> 1; g < 128; g += (F.G + 1) >> 1) gla_main_unit<4>(F, g >> 3, g & 7); }
        volatile LAS unsigned* qslot = (volatile LAS unsigned*)((LAS unsigned char*)lds + LDSCTL_OFF + 16);
        for (;;) {
            if (F.tid == 0) *qslot = __hip_atomic_fetch_add((unsigned*)(ctl + CW_QUEUE + 64 * rep_), 1u, __ATOMIC_RELAXED, __HIP_MEMORY_SCOPE_AGENT);
            __syncthreads();
            const unsigned u = *qslot;
            __syncthreads();
            if (u >= 512u) break;
            gla_sample_unit(F, (int)u);
        }
    }
    SEAM(3);
    if (IN(4)) REP(4) {
        bf16* MM = (bf16*)(F.ws + WS_MM);
        for (int g = gw; g < TP / 4; g += NGW) mixer_rows(F, 4 * g, 4);
        for (int n = gw; n < TS; n += NGW) mixer_rows(F, TP + n, 1);
        for (int m = TT + gw; m < MP; m += NGW) zero_row_bf16(MM + (size_t)m * DM, F.lane);
    }
    SEAM(4);
    if (IN(5)) REP(5) {
        pg8::Gemm g{(const pg8::bf16_t*)(F.ws + WS_MM), (const pg8::bf16_t*)(F.ws + WS_WOUTT), TP, DM, DM}; pg8::StaticOrder S; S.init(TP, DM, F.G, (int)blockIdx.x);
        pg8::EpiF32Res E{F.xp, (float*)(F.ws + WS_X2), (pg8::bf16_t*)(F.ws + WS_H2), (float*)(F.ws + WS_SSQ), DM};
        pg8::gemm_phase<pg8::EpiF32Res, pg8::StaticOrder, true, true>((PG8_LAS unsigned char*)lds + RING_OFF, g, S, E);
#ifdef GEMM2_TWICE
        pg8::gemm_phase<pg8::EpiF32Res, pg8::StaticOrder, true, true>((PG8_LAS unsigned char*)lds + RING_OFF, g, S, E);
#endif
        { EpiSkF32Res Es{F.xs, (float*)(F.ws + WS_X2) + (size_t)TP * DM, (bf16*)(F.ws + WS_H2) + (size_t)TP * DM, (float*)(F.ws + WS_SSQS)};
          for (int skr = 0; skr < SKREP; ++skr) for (int ng = F.vcu; ng < DM / 16; ng += F.G) skinny_gemm<1>(F, (const bf16*)(F.ws + WS_MM) + (size_t)TP * DM, (const bf16*)(F.ws + WS_WOUTT), 16 * ng, Es); }
    }
    SEAM(5);
    if (IN(6)) REP(6) {
        float* rs_s = (float*)(lds + 131072);
        float* rss_s = rs_s + 512;
        float* RS2 = (float*)(F.ws + WS_RS2);
        pg8::Gemm g{(const pg8::bf16_t*)(F.ws + WS_H2), (const pg8::bf16_t*)(F.ws + WS_WQT), TP, DM, DM}; pg8::StaticOrder S; S.init(TP, DM, F.G, (int)blockIdx.x);
        { pg8::Unit u0;
          if (S.next(0, u0) && F.tid < 256) { const int row = u0.pm * 256 + F.tid; const f32x4* p = (const f32x4*)((const float*)(F.ws + WS_SSQ) + (size_t)row * 32); f32x4 a4 = p[0];
#pragma unroll
              for (int i = 1; i < 8; ++i) a4 += p[i];
              const float rstd = 1.0f / sqrtf(((a4.x + a4.y) + (a4.z + a4.w)) * (1.0f / DM) + EPS); rs_s[F.tid] = rstd; if (u0.pn == 0) RS2[row] = rstd; }
          if (F.tid >= 256 && F.tid < 384 && F.vcu < DM / 16) { const int row = F.tid - 256; const f32x4* p = (const f32x4*)((const float*)(F.ws + WS_SSQS) + (size_t)row * 128); f32x4 a4 = p[0];
#pragma unroll
              for (int i = 1; i < 32; ++i) a4 += p[i];
              const float rstd = 1.0f / sqrtf(((a4.x + a4.y) + (a4.z + a4.w)) * (1.0f / DM) + EPS); rss_s[row] = rstd; if (F.vcu == 0) RS2[TP + row] = rstd; }
          __syncthreads(); }
        pg8::EpiBf16RowScale E{(pg8::bf16_t*)(F.ws + WS_QP), DM, rs_s};
        pg8::gemm_phase<pg8::EpiBf16RowScale, pg8::StaticOrder, true, true>((PG8_LAS unsigned char*)lds + RING_OFF, g, S, E);
#ifdef GEMM3_TWICE
        pg8::gemm_phase<pg8::EpiBf16RowScale, pg8::StaticOrder, true, true>((PG8_LAS unsigned char*)lds + RING_OFF, g, S, E);
#endif
        { EpiSkBf16 Es{(bf16*)(F.ws + WS_QP) + (size_t)TP * DM, DM, rss_s};
          for (int skr = 0; skr < SKREP; ++skr) for (int ng = F.vcu; ng < DM / 16; ng += F.G) skinny_gemm<1>(F, (const bf16*)(F.ws + WS_H2) + (size_t)TP * DM, (const bf16*)(F.ws + WS_WQT), 16 * ng, Es); }
    }
    SEAM(6);
    if (IN(7)) REP(7) { bf16x8 qa[2][4]; peer_qfrags(F, tok0, qa); peer_load_subkeys(F); for (int tb = tok0; tb < tok1; tb += 8) peer_topk_tile(F, tb, tok1, qa); __syncthreads(); }
    SEAM(7);
    if (IN(8)) REP(8) { peer_phase(F, tok0, tok1); }
#undef IN
#undef SEAM
}

extern "C" void kernel_launch(void* const* d_in, const int* in_sizes, int n_in, void* d_out, int out_size, void* d_ws, size_t ws_size, hipStream_t stream) {
    static int grid = 0;
    if (grid == 0) {
        if (n_in != 18 || ws_size < WS_END) { fprintf(stderr, "kernel_launch: expected 18 inputs and >= %zu bytes of workspace; got %d, %zu\n", (size_t)WS_END, n_in, ws_size); grid = -1; return; }
        int dev = 0, cus = 0;
        if (hipGetDevice(&dev) != hipSuccess || hipDeviceGetAttribute(&cus, hipDeviceAttributeMultiprocessorCount, dev) != hipSuccess) { grid = -1; return; }
        if (hipFuncSetAttribute((const void*)mk_fwd, hipFuncAttributeMaxDynamicSharedMemorySize, LDS_BYTES) != hipSuccess) { fprintf(stderr, "kernel_launch: hipFuncSetAttribute failed\n"); grid = -1; return; }
        (void)hipGetLastError();
        grid = cus;
    }
    if (grid < 0) return;
    (void)hipMemsetAsync((char*)d_ws + WS_CTL, 0, CTL_ZERO_BYTES, stream);
    Args a{};
    for (int i = 0; i < 18; ++i) a.in[i] = (const float*)d_in[i];
    a.out = (float*)d_out; a.ws = (unsigned char*)d_ws;
    if (N_LAUNCHES == 1) { a.ph_lo = 0; a.ph_hi = N_PHASES; hipLaunchKernelGGL(mk_fwd, dim3(grid), dim3(NWAVES * 64), LDS_BYTES, stream, a); }
    else { for (int li = 0; li < N_PHASES; ++li) { a.ph_lo = li; a.ph_hi = li + 1; hipLaunchKernelGGL(mk_fwd, dim3(grid), dim3(NWAVES * 64), LDS_BYTES, stream, a); } }
}
```

```cpp
#include <hip/hip_runtime.h>
#include <cstdio>
#include <cstdint>
#include <cmath>
#define MK_N_LAUNCHES 1
namespace pg8 {
#define PG8_LAS __attribute__((address_space(3)))
typedef unsigned short bf16_t;
typedef short bf16x8 __attribute__((ext_vector_type(8)));
typedef float f32x4 __attribute__((ext_vector_type(4)));
typedef unsigned u32x4 __attribute__((ext_vector_type(4)));
constexpr int BM = 256, BK = 64, HALF = 128, HTB = HALF * BK * 2  , STAGE_BYTES = 8 * HTB, NXCD = 8, WGM = 8;

__host__ __device__ __forceinline__ int lds_byte(int r, int c) { const int st = (r >> 4) * 2 + (c >> 5), rr = r & 15, cc = c & 31, ob = rr * 64 + cc * 2; return st * 1024 + (ob ^ (((ob >> 9) & 1) << 5)); }
__host__ __device__ __forceinline__ void stage_rc(int b, int& R, int& C) { const int st = b / 1024, sb = b % 1024, swz = sb ^ (((sb >> 9) & 1) << 5); R = (st >> 1) * 16 + swz / 64; C = (st & 1) * 32 + (swz % 64) / 2; }
__host__ __device__ __forceinline__ int perm32(int rho) { const int n = rho >> 4, i = rho & 15; return 8 * (i >> 2) + 4 * n + (i & 3); }

struct Unit { int pm, pn; };
struct Gemm { const bf16_t* A; const bf16_t* Bt; int M, N, K; };

struct StaticOrder {
    int nM, nN, nwg, G, c;
    __host__ __device__ void init(int M, int N, int G_, int c_) { nM = M / BM; nN = N / BM; nwg = nM * nN; G = G_; c = c_; }
    __host__ __device__ bool next(int i, Unit& u) const {
        const long L = (long)i * G + c; if (L >= nwg) return false;
        int wgid = (int)L; { const int q = nwg / NXCD, r = nwg % NXCD, xcd = wgid % NXCD, off = wgid / NXCD; wgid = (xcd < r ? xcd * (q + 1) : r * (q + 1) + (xcd - r) * q) + off; }
        const int nig = WGM * nN, gid = wgid / nig, fm = gid * WGM, gsz = (nM - fm) < WGM ? (nM - fm) : WGM;
        u.pm = fm + ((wgid % nig) % gsz); u.pn = (wgid % nig) / gsz; return true;
    }
    __device__ __forceinline__ void a_ready(const Unit&) const {}
    __device__ __forceinline__ void done(const Unit&) const {}
};

__device__ __forceinline__ unsigned cvt_pk_bf16(float lo, float hi) { unsigned r; asm volatile("v_cvt_pk_bf16_f32 %0, %1, %2" : "=v"(r) : "v"(lo), "v"(hi)); return r; }
typedef float f32x2 __attribute__((ext_vector_type(2)));
__device__ __forceinline__ f32x2 gelu_pk(f32x2 v) {
    const f32x2 av = __builtin_elementwise_abs(v), d = av * 0.2316418882f + 1.0f;
    f32x2 t; t.x = __builtin_amdgcn_rcpf(d.x); t.y = __builtin_amdgcn_rcpf(d.y);
    f32x2 q = t * 0.5307027145f + (-0.7265760135f); q = q * t + 0.7107068705f; q = q * t + (-0.142248368f); q = q * t + 0.127414796f; q = q * t;
    const f32x2 s = (v * v) * (-0.72134752044f);
    f32x2 e; e.x = __builtin_amdgcn_exp2f(s.x); e.y = __builtin_amdgcn_exp2f(s.y);
    const f32x2 m = v * (q * e), r = v - m;
    f32x2 o; o.x = v.x < 0.f ? m.x : r.x; o.y = v.y < 0.f ? m.y : r.y; return o;
}

template <int ACT  > struct EpiBf16 {
    static constexpr bool PERM = true, AFTER_DRAIN = false; static_assert(ACT == 0 || ACT == 1, "EpiBf16: ACT is 0 (none) or 1 (gelu_pk)");
    bf16_t* O; int ldc; const float* bias; int split_cols; size_t split_stride; float scale0;
    __device__ __forceinline__ void operator()(const f32x4 (&acc)[2][2][4][2], const Unit& u, int wr, int wc, int fr, int fq) const {
        const int row0 = u.pm * BM + wr * 64 + fr; int colt = u.pn * BM; bf16_t* base = O;
        float sc = 1.f; if (split_cols) { const int t = colt / split_cols; base += (size_t)t * split_stride; colt -= t * split_cols; if (t == 0) sc = scale0; }
        const int col0 = colt + wc * 32 + 8 * fq, bcol0 = u.pn * BM + wc * 32 + 8 * fq;
        f32x4 bv[2][2];
#pragma unroll
        for (int bj = 0; bj < 2; ++bj)
#pragma unroll
            for (int n = 0; n < 2; ++n) bv[bj][n] = bias ? *(const f32x4*)(bias + bcol0 + bj * HALF + 4 * n) : (f32x4){0.f, 0.f, 0.f, 0.f};
#pragma unroll
        for (int ai = 0; ai < 2; ++ai)
#pragma unroll
            for (int m = 0; m < 4; ++m) { bf16_t* rowp = base + (size_t)(row0 + ai * HALF + m * 16) * ldc + col0;
#pragma unroll
                for (int bj = 0; bj < 2; ++bj) { f32x4 v0 = acc[ai][bj][m][0] + bv[bj][0], v1 = acc[ai][bj][m][1] + bv[bj][1];
                    if (ACT == 1) { f32x2 a = gelu_pk((f32x2){v0[0], v0[1]}), b = gelu_pk((f32x2){v0[2], v0[3]}), c = gelu_pk((f32x2){v1[0], v1[1]}), d = gelu_pk((f32x2){v1[2], v1[3]});
                        v0 = (f32x4){a.x, a.y, b.x, b.y}; v1 = (f32x4){c.x, c.y, d.x, d.y}; }
                    v0 = v0 * sc; v1 = v1 * sc; u32x4 w; w.x = cvt_pk_bf16(v0[0], v0[1]); w.y = cvt_pk_bf16(v0[2], v0[3]); w.z = cvt_pk_bf16(v1[0], v1[1]); w.w = cvt_pk_bf16(v1[2], v1[3]);
                    __builtin_nontemporal_store(w, (u32x4*)(rowp + bj * HALF)); } }
    }
};
template <class Epi, class Sched, bool ALIGN_EPI = false, bool SP2 = false>
__device__ __forceinline__ void gemm_phase(PG8_LAS unsigned char* lds, const Gemm g, const Sched& S, const Epi& E) {
    const int tid = threadIdx.x, wid = __builtin_amdgcn_readfirstlane(tid >> 6), lane = tid & 63, wr = wid >> 2, wc = wid & 3, fr = lane & 15, fq = lane >> 4;
    const int K = g.K, nt = K / BK;
    unsigned voffA[2], voffB[2];
#pragma unroll
    for (int i = 0; i < 2; ++i) { int R, C; stage_rc(tid * 16 + i * 8192, R, C); const int Rb = Epi::PERM ? ((R & ~31) + perm32(R & 31)) : R;
        voffA[i] = (unsigned)(R * K + C) * 2u; voffB[i] = (unsigned)(Rb * K + C) * 2u; }
    const size_t kstep = (size_t)(BK * 2);
    const size_t hstep = (size_t)HALF * K * 2;
    const size_t tstep = 2 * hstep;
    const unsigned ldsw = (unsigned)wid * 1024u;
    const int aoff = lds_byte(wr * 64 + fr, fq * 8), boff = lds_byte(wc * 32 + fr, fq * 8);
#define PG8_SA(b, h) (((b) * 2 + (h)) * HTB)
#define PG8_SB(b, h) ((4 + (b) * 2 + (h)) * HTB)
#define PG8_STAGE(bufoff, gbase, voff) do { _Pragma("unroll") for (int _i = 0; _i < 2; ++_i) \
        __builtin_amdgcn_global_load_lds((const unsigned*)((const char*)(gbase) + (voff)[_i]), (PG8_LAS unsigned*)(lds + (bufoff) + ldsw + _i * 8192), 16, 0, 0); } while (0)
#define PG8_LDA(dst, b, h) do { _Pragma("unroll") for (int m = 0; m < 4; ++m) _Pragma("unroll") for (int k = 0; k < 2; ++k) dst[m][k] = *(const PG8_LAS bf16x8*)(lds + PG8_SA(b, h) + aoff + m * 2048 + k * 1024); } while (0)
#define PG8_LDB(dst, b, h) do { _Pragma("unroll") for (int n = 0; n < 2; ++n) _Pragma("unroll") for (int k = 0; k < 2; ++k) dst[n][k] = *(const PG8_LAS bf16x8*)(lds + PG8_SB(b, h) + boff + n * 2048 + k * 1024); } while (0)
#define PG8_MMA(ai, bj, At, Bt) do { __builtin_amdgcn_s_setprio(1); _Pragma("unroll") for (int m = 0; m < 4; ++m) _Pragma("unroll") for (int n = 0; n < 2; ++n) _Pragma("unroll") for (int k = 0; k < 2; ++k) \
        acc[ai][bj][m][n] = __builtin_amdgcn_mfma_f32_16x16x32_bf16(Bt[n][k], At[m][k], acc[ai][bj][m][n], 0, 0, 0); __builtin_amdgcn_s_setprio(0); } while (0)
#define PG8_WAIT_V(n) asm volatile("s_waitcnt vmcnt(" #n ")" ::: "memory")
#define PG8_WAIT_L(n) asm volatile("s_waitcnt lgkmcnt(" #n ")" ::: "memory")
#define PG8_BAR __builtin_amdgcn_s_barrier()
#define PG8_SCHED __builtin_amdgcn_sched_barrier(0)
    Unit cur, nxt; int ui = 0;
    if (!S.next(0, cur)) return;
    f32x4 acc[2][2][4][2];
#pragma unroll
    for (int a = 0; a < 2; ++a)
#pragma unroll
        for (int b = 0; b < 2; ++b)
#pragma unroll
            for (int m = 0; m < 4; ++m)
#pragma unroll
                for (int n = 0; n < 2; ++n) acc[a][b][m][n] = (f32x4){0.f, 0.f, 0.f, 0.f};
    bf16x8 At[4][2], B0[2][2], B1[2][2];
    const char* cA = (const char*)g.A + (size_t)cur.pm * tstep; const char* cB = (const char*)g.Bt + (size_t)cur.pn * tstep;
    S.a_ready(cur);
    if constexpr (SP2) {
        PG8_STAGE(PG8_SB(0, 0), cB, voffB); PG8_STAGE(PG8_SB(0, 1), cB + hstep, voffB); PG8_STAGE(PG8_SA(0, 0), cA, voffA); PG8_STAGE(PG8_SA(0, 1), cA + hstep, voffA);
        if (wr == 1) PG8_BAR;
        PG8_WAIT_V(2); PG8_BAR;
        PG8_STAGE(PG8_SB(1, 0), cB + kstep, voffB); PG8_STAGE(PG8_SA(1, 0), cA + kstep, voffA); PG8_STAGE(PG8_SB(1, 1), cB + hstep + kstep, voffB);
        PG8_WAIT_V(6); PG8_BAR;
    } else {
        PG8_STAGE(PG8_SB(0, 0), cB, voffB); PG8_STAGE(PG8_SA(0, 0), cA, voffA); PG8_STAGE(PG8_SB(0, 1), cB + hstep, voffB); PG8_STAGE(PG8_SA(0, 1), cA + hstep, voffA);
        if (wr == 1) PG8_BAR;
        PG8_WAIT_V(4); PG8_BAR;
        PG8_STAGE(PG8_SB(1, 0), cB + kstep, voffB); PG8_STAGE(PG8_SA(1, 0), cA + kstep, voffA); PG8_STAGE(PG8_SB(1, 1), cB + hstep + kstep, voffB);
        PG8_WAIT_V(6); PG8_BAR;
    }
    for (;;) {
        const bool has_next = S.next(ui + 1, nxt);
        const char* nA = has_next ? (const char*)g.A + (size_t)nxt.pm * tstep : cA; const char* nB = has_next ? (const char*)g.Bt + (size_t)nxt.pn * tstep : cB;
        for (int t = 0; t < nt; t += 2) {
            const bool last = (t == nt - 2);
            const char* a1 = cA + (size_t)(t + 1) * kstep;
            const char* a2 = last ? nA : cA + (size_t)(t + 2) * kstep; const char* b2 = last ? nB : cB + (size_t)(t + 2) * kstep;
            const char* a3 = a2 + kstep; const char* b3 = b2 + kstep;
            if (last && has_next) S.a_ready(nxt);
            if constexpr (SP2) {
            PG8_LDB(B0, 0, 0); PG8_LDB(B1, 0, 1); PG8_SCHED; PG8_LDA(At, 0, 0); PG8_STAGE(PG8_SA(1, 1), a1 + hstep, voffA);
            PG8_WAIT_V(8); PG8_WAIT_L(0); PG8_BAR; PG8_MMA(0, 0, At, B0); PG8_MMA(0, 1, At, B1); PG8_BAR; PG8_SCHED;
            PG8_LDA(At, 0, 1); PG8_STAGE(PG8_SB(0, 0), b2, voffB); PG8_STAGE(PG8_SB(0, 1), b2 + hstep, voffB); PG8_STAGE(PG8_SA(0, 0), a2, voffA);
            PG8_WAIT_V(8); PG8_WAIT_L(0); PG8_BAR; PG8_MMA(1, 0, At, B0); PG8_MMA(1, 1, At, B1); PG8_BAR; PG8_SCHED;
            PG8_LDB(B0, 1, 0); PG8_LDB(B1, 1, 1); PG8_SCHED; PG8_LDA(At, 1, 0); PG8_STAGE(PG8_SA(0, 1), a2 + hstep, voffA);
            PG8_WAIT_V(8); PG8_WAIT_L(0); PG8_BAR; PG8_MMA(0, 0, At, B0); PG8_MMA(0, 1, At, B1); PG8_BAR; PG8_SCHED;
            PG8_LDA(At, 1, 1); PG8_STAGE(PG8_SB(1, 0), b3, voffB); PG8_STAGE(PG8_SB(1, 1), b3 + hstep, voffB); PG8_STAGE(PG8_SA(1, 0), a3, voffA);
            PG8_WAIT_V(8); PG8_WAIT_L(0); PG8_BAR; PG8_MMA(1, 0, At, B0); PG8_MMA(1, 1, At, B1); PG8_BAR; PG8_SCHED;
            } else {
            PG8_LDB(B0, 0, 0); PG8_SCHED; PG8_LDA(At, 0, 0); PG8_STAGE(PG8_SA(1, 1), a1 + hstep, voffA);
            PG8_WAIT_L(8); PG8_BAR; PG8_WAIT_L(0); PG8_MMA(0, 0, At, B0); PG8_BAR; PG8_SCHED;
            PG8_LDB(B1, 0, 1); PG8_STAGE(PG8_SB(0, 0), b2, voffB);
            PG8_BAR; PG8_WAIT_L(0); PG8_MMA(0, 1, At, B1); PG8_BAR;
            PG8_LDA(At, 0, 1); PG8_STAGE(PG8_SA(0, 0), a2, voffA);
            PG8_BAR; PG8_WAIT_L(0); PG8_MMA(1, 0, At, B0); PG8_BAR; PG8_SCHED;
            PG8_STAGE(PG8_SB(0, 1), b2 + hstep, voffB);
            PG8_WAIT_V(6); PG8_BAR; PG8_MMA(1, 1, At, B1); PG8_BAR;
            PG8_LDB(B0, 1, 0); PG8_SCHED; PG8_LDA(At, 1, 0); PG8_STAGE(PG8_SA(0, 1), a2 + hstep, voffA);
            PG8_WAIT_L(8); PG8_BAR; PG8_WAIT_L(0); PG8_MMA(0, 0, At, B0); PG8_BAR; PG8_SCHED;
            PG8_LDB(B1, 1, 1); PG8_STAGE(PG8_SB(1, 0), b3, voffB);
            PG8_BAR; PG8_WAIT_L(0); PG8_MMA(0, 1, At, B1); PG8_BAR;
            PG8_LDA(At, 1, 1); PG8_STAGE(PG8_SA(1, 0), a3, voffA);
            PG8_BAR; PG8_WAIT_L(0); PG8_MMA(1, 0, At, B0); PG8_BAR; PG8_SCHED;
            PG8_STAGE(PG8_SB(1, 1), b3 + hstep, voffB);
            PG8_WAIT_V(6); PG8_BAR; PG8_MMA(1, 1, At, B1); PG8_BAR;
            }
        }
        if constexpr (ALIGN_EPI) { if (wr == 0) PG8_BAR; }
        if constexpr (!Epi::AFTER_DRAIN) { E(acc, cur, wr, wc, fr, fq); S.done(cur); }
        if (!has_next) break;
#pragma unroll
        for (int a = 0; a < 2; ++a)
#pragma unroll
            for (int b = 0; b < 2; ++b)
#pragma unroll
                for (int m = 0; m < 4; ++m)
#pragma unroll
                    for (int n = 0; n < 2; ++n) acc[a][b][m][n] = (f32x4){0.f, 0.f, 0.f, 0.f};
        cur = nxt; cA = nA; cB = nB; ++ui;
        if constexpr (ALIGN_EPI) { if (wr == 1) PG8_BAR; }
    }
    PG8_WAIT_V(0);
    if constexpr (!ALIGN_EPI) { if (wr == 0) PG8_BAR; }
    PG8_BAR;
    if constexpr (Epi::AFTER_DRAIN) { E.fused(acc, cur, wr, wc, fr, fq, lds, wid, lane); S.done(cur); }
#undef PG8_SA
#undef PG8_SB
#undef PG8_STAGE
#undef PG8_LDA
#undef PG8_LDB
#undef PG8_MMA
#undef PG8_WAIT_V
#undef PG8_WAIT_L
#undef PG8_BAR
#undef PG8_SCHED
}
}
namespace pg8 {
__device__ __forceinline__ unsigned f2bf_(float f) { unsigned u = __builtin_bit_cast(unsigned, f); return (u + 0x7fffu + ((u >> 16) & 1u)) >> 16; }
struct EpiF32Res {
    static constexpr bool PERM = false, AFTER_DRAIN = false;
    const float* xp; float* out; bf16_t* outb; float* ssq; int ldc;
    __device__ __forceinline__ void operator()(const f32x4 (&acc)[2][2][4][2], const Unit& u, int wr, int wc, int fr, int fq) const {
        const int col0 = u.pn * BM + wc * 32 + 4 * fq;
#pragma unroll
        for (int ai = 0; ai < 2; ++ai)
#pragma unroll
            for (int m = 0; m < 4; ++m) {
                const int row = u.pm * BM + ai * HALF + wr * 64 + m * 16 + fr;
                const float* src = xp + (size_t)row * ldc; float* dst = out + (size_t)row * ldc; bf16_t* dstb = outb + (size_t)row * ldc;
                float s = 0.f;
#pragma unroll
                for (int bj = 0; bj < 2; ++bj)
#pragma unroll
                    for (int n = 0; n < 2; ++n) { const int c = col0 + bj * HALF + n * 16; const f32x4 v = *(const f32x4*)(src + c) + acc[ai][bj][m][n]; *(f32x4*)(dst + c) = v;
                        s += (v[0] * v[0] + v[1] * v[1]) + (v[2] * v[2] + v[3] * v[3]);
                        unsigned w0 = f2bf_(v[0]) | (f2bf_(v[1]) << 16), w1 = f2bf_(v[2]) | (f2bf_(v[3]) << 16);
                        typedef unsigned u32x2 __attribute__((ext_vector_type(2))); *(u32x2*)(dstb + c) = (u32x2){w0, w1}; }
                s += __shfl_xor(s, 16); s += __shfl_xor(s, 32);
                if (fq == 0) ssq[(size_t)row * 32 + u.pn * 4 + wc] = s;
            }
    }
};
struct EpiBf16RowScale {
    static constexpr bool PERM = true, AFTER_DRAIN = false;
    bf16_t* O; int ldc; const float* rs;
    __device__ __forceinline__ void operator()(const f32x4 (&acc)[2][2][4][2], const Unit& u, int wr, int wc, int fr, int fq) const {
        const int row0 = u.pm * BM + wr * 64 + fr, col0 = u.pn * BM + wc * 32 + 8 * fq;
#pragma unroll
        for (int ai = 0; ai < 2; ++ai)
#pragma unroll
            for (int m = 0; m < 4; ++m) { const int rl = wr * 64 + fr + ai * HALF + m * 16; const float sc = rs[rl]; bf16_t* rowp = O + (size_t)(row0 + ai * HALF + m * 16) * ldc + col0;
#pragma unroll
                for (int bj = 0; bj < 2; ++bj) { const f32x4 v0 = acc[ai][bj][m][0] * sc, v1 = acc[ai][bj][m][1] * sc;
                    u32x4 w; w.x = cvt_pk_bf16(v0[0], v0[1]); w.y = cvt_pk_bf16(v0[2], v0[3]); w.z = cvt_pk_bf16(v1[0], v1[1]); w.w = cvt_pk_bf16(v1[2], v1[3]);
                    *(u32x4*)(rowp + bj * HALF) = w; } }
    }
};
}

#ifndef MK_N_LAUNCHES
#define MK_N_LAUNCHES 1
#endif
constexpr int N_PHASES = 9;
constexpr int N_LAUNCHES = MK_N_LAUNCHES;
constexpr int NWAVES = 8;

constexpr int DM = 2048;
constexpr int TP = 8192, TS = 128, TT = TP + TS;
constexpr int MP = 8448;
constexpr int NP = 16384;
constexpr int PLD = NP + 64;
constexpr int C_Q = 0, C_K = 1024, C_V = 2048, C_R = 4096, C_CB = 6144, C_CC = 8192, C_CX = 10240, C_GA = 12288, C_GB = 14336;
constexpr int DIN = 16400;
constexpr int NEXP = 16384;
constexpr float EPS = 1e-6f;

constexpr size_t MiB = 1u << 20;
constexpr size_t WS_CTL = 0, CTL_ZERO_BYTES = 1 * MiB;
constexpr size_t WS_WINT = 2 * MiB;
constexpr size_t WS_WOUTT = 68 * MiB;
constexpr size_t WS_WQT = 76 * MiB;
constexpr size_t WS_EU = 84 * MiB;
constexpr size_t WS_EV = 148 * MiB;
constexpr size_t WS_XN = 212 * MiB;
constexpr size_t WS_P = 246 * MiB;
constexpr size_t WS_QT = 516 * MiB;
constexpr size_t WS_KT = 532 * MiB;
constexpr size_t WS_VT = 548 * MiB;
constexpr size_t WS_ATT = 580 * MiB;
constexpr size_t WS_EBL = 584 * MiB;
constexpr size_t WS_SKB = 585 * MiB;
constexpr size_t WS_O = 586 * MiB;
constexpr size_t WS_MM = 620 * MiB;
constexpr size_t WS_X2 = 654 * MiB;
constexpr size_t WS_H2 = 720 * MiB;
constexpr size_t WS_SSQ = 799 * MiB;
constexpr size_t WS_QP = 754 * MiB;
constexpr size_t WS_IDX = 788 * MiB;
constexpr size_t WS_GW = 793 * MiB;
constexpr size_t WS_ALR = 798 * MiB;
constexpr size_t WS_SSQS = 799 * MiB + 1100 * 1024;
constexpr size_t WS_RS2 = 799 * MiB + 1200 * 1024;
constexpr size_t WS_END = 801 * MiB;
constexpr int CW_TMO = 0, CW_CODE = 1, CW_BAR = 4096, CW_QUEUE = 16384;

constexpr size_t OUT_Y = 0;
constexpr size_t OUT_GLAP = (size_t)TT * DM;
constexpr size_t OUT_CONVP = OUT_GLAP + (size_t)4 * 4 * 256 * 512;
constexpr size_t OUT_GLAS = OUT_CONVP + (size_t)4 * 2 * 2048;
constexpr size_t OUT_CONVS = OUT_GLAS + (size_t)128 * 4 * 256 * 512;

constexpr int LDS_BYTES = 163840;
constexpr int LDSCTL_OFF = 162816, MISC_OFF = LDSCTL_OFF + 320;
constexpr int RING_OFF = 0;

#define GAS __attribute__((address_space(1)))
#define LAS __attribute__((address_space(3)))
typedef unsigned short bf16;
typedef unsigned v4u __attribute__((ext_vector_type(4)));
typedef unsigned v2u __attribute__((ext_vector_type(2)));
typedef float f32x4 __attribute__((ext_vector_type(4)));
typedef short bf16x8 __attribute__((ext_vector_type(8)));
typedef GAS unsigned gu32;
typedef float v32f __attribute__((ext_vector_type(32)));
typedef float v16f __attribute__((ext_vector_type(16)));
typedef unsigned v6u __attribute__((ext_vector_type(6)));
constexpr int ROW6 = 1536;
#define RLX_AGENT __ATOMIC_RELAXED, __HIP_MEMORY_SCOPE_AGENT
#define LDS_WAIT() asm volatile("s_waitcnt lgkmcnt(0)" ::: "memory")
#define VM_WAIT() asm volatile("s_waitcnt vmcnt(0)" ::: "memory")
#define MFMA16(a, b, c) __builtin_amdgcn_mfma_f32_16x16x32_bf16((a), (b), (c), 0, 0, 0)
__device__ __forceinline__ unsigned f2bf(float f) { unsigned u = __builtin_bit_cast(unsigned, f); return (u + 0x7fffu + ((u >> 16) & 1u)) >> 16; }
__device__ __forceinline__ unsigned pk2(float lo, float hi) { return f2bf(lo) | (f2bf(hi) << 16); }
__device__ __forceinline__ float bf2f(unsigned b) { return __builtin_bit_cast(float, b << 16); }
__device__ __forceinline__ float bflo(unsigned w) { return __builtin_bit_cast(float, w << 16); }
__device__ __forceinline__ float bfhi(unsigned w) { return __builtin_bit_cast(float, w & 0xffff0000u); }
__device__ __forceinline__ void unpack8(const v4u w, float (&f)[8]) { f[0] = bflo(w.x); f[1] = bfhi(w.x); f[2] = bflo(w.y); f[3] = bfhi(w.y); f[4] = bflo(w.z); f[5] = bfhi(w.z); f[6] = bflo(w.w); f[7] = bfhi(w.w); }
__device__ __forceinline__ v4u pack8(const float (&f)[8]) { v4u w; w.x = pk2(f[0], f[1]); w.y = pk2(f[2], f[3]); w.z = pk2(f[4], f[5]); w.w = pk2(f[6], f[7]); return w; }
__device__ __forceinline__ float wave_sum(float v) {
#pragma unroll
    for (int o = 1; o < 64; o <<= 1) v += __shfl_xor(v, o);
    return v;
}
__device__ __forceinline__ float sigmoidf_(float x) { return 1.0f / (1.0f + __expf(-x)); }
#define XB_TMO      128
#define XB_XCNT(j)  (256  + 64 * (j))
#define XB_XSUB(j)  (1280 + 64 * (j))
#define XB_XGEN(j)  (2304 + 64 * (j))
#define XB_TOP      3328
#define XB_TOPGEN   3392
#define XCD_BAR_WORDS 3456
#define XB_SPIN_CAP (1u << 18)

__device__ __forceinline__ unsigned xb_ld(unsigned* p)              { return __hip_atomic_load(p, __ATOMIC_RELAXED, __HIP_MEMORY_SCOPE_AGENT); }
__device__ __forceinline__ unsigned xb_add(unsigned* p, unsigned v) { return __hip_atomic_fetch_add(p, v, __ATOMIC_RELAXED, __HIP_MEMORY_SCOPE_AGENT); }
__device__ __forceinline__ unsigned xb_xcc_id() { return (unsigned)__builtin_amdgcn_s_getreg((3 << 11) | 20) & 0xFu; }
#define XB_SPIN(cond, bar) do { unsigned _sp = 0; while (cond) { __builtin_amdgcn_s_sleep(1); \
    if ((++_sp & 255u) == 0u) { if (xb_ld(&(bar)[XB_TMO])) break; if (_sp > XB_SPIN_CAP) { atomicAdd(&(bar)[XB_TMO], 1u); break; } } } } while (0)

struct XcdBarrier {
    unsigned* bar; unsigned x;
    volatile LAS unsigned* st;
};

__device__ __forceinline__ XcdBarrier xcd_barrier_post(unsigned* bar, volatile LAS unsigned* st) {
    XcdBarrier b; b.bar = bar; b.x = xb_xcc_id(); b.st = st;
    if (threadIdx.x == 0) (void)xb_add(&bar[XB_XCNT(b.x)], 1u);
    return b;
}
__device__ __forceinline__ void xcd_barrier_complete(unsigned* bar, unsigned x, unsigned& nloc, unsigned& nx) {
    const unsigned G = gridDim.x * gridDim.y * gridDim.z;
    unsigned sum, cnt, mine, sp = 0u;
    for (;;) {
        sum = 0u; cnt = 0u; mine = 0u;
#pragma unroll
        for (unsigned j = 0; j < 16; ++j) { const unsigned c = xb_ld(&bar[XB_XCNT(j)]); sum += c; cnt += (c > 0u) ? 1u : 0u; mine = (j == x) ? c : mine; }
        if (sum == G) break;
        __builtin_amdgcn_s_sleep(1);
        if ((++sp & 255u) == 0u) { if (xb_ld(&bar[XB_TMO])) break; if (sp > XB_SPIN_CAP) { atomicAdd(&bar[XB_TMO], 1u); break; } }
    }
    nloc = mine > 0u ? mine : 1u; nx = cnt > 0u ? cnt : 1u;
}

__device__ __forceinline__ void xcd_barrier(const XcdBarrier& b) {
    asm volatile("s_waitcnt vmcnt(0)" ::: "memory");
    __syncthreads();
    if (threadIdx.x == 0) {
        unsigned* bar = b.bar;
        __builtin_amdgcn_s_waitcnt(0);
        unsigned nloc = b.st[0], nx = b.st[1];
        if (nloc == 0u) { xcd_barrier_complete(bar, b.x, nloc, nx); b.st[0] = nloc; b.st[1] = nx; }
        const unsigned old = xb_add(&bar[XB_XSUB(b.x)], 1u);
        const unsigned gen = old / nloc;
        if (old + 1u == (gen + 1u) * nloc) {
            __builtin_amdgcn_fence(__ATOMIC_RELEASE, "agent");
            asm volatile("s_waitcnt vmcnt(0)" ::: "memory");
            const unsigned og = xb_add(&bar[XB_TOP], 1u);
            const unsigned tg = og / nx;
            if (og + 1u == (tg + 1u) * nx) xb_add(&bar[XB_TOPGEN], 1u);
            else XB_SPIN(xb_ld(&bar[XB_TOPGEN]) == tg, bar);
            __builtin_amdgcn_fence(__ATOMIC_ACQUIRE, "agent");
            xb_add(&bar[XB_XGEN(b.x)], 1u);
            asm volatile("s_waitcnt vmcnt(0)" ::: "memory");
        } else {
            XB_SPIN(xb_ld(&bar[XB_XGEN(b.x)]) == gen, bar);
            __builtin_amdgcn_fence(__ATOMIC_ACQUIRE, "agent");
            asm volatile("s_waitcnt vmcnt(0)" ::: "memory");
        }
    }
    __syncthreads();
}
struct Frame {
    unsigned char* lds;
    int tid, lane, wave, vcu, G;
    const float *xp, *xs, *sgla, *sconv, *n1g, *win, *wau, *bal, *gng, *cw, *cb, *wout, *n2g, *wq, *sk, *eu, *ev, *nfg;
    float* out;
    unsigned char* ws;
};

__device__ __forceinline__ void p0_transpose_item(const float* W, int ldw, int src_col0, int k0, bf16* WT, int K, int dst_row0, float* scr, int lane, const float* kscale = nullptr) {
    const int n4 = lane & 15, kr = lane >> 4;
#pragma unroll 8
    for (int i = 0; i < 16; ++i) { const int kk = 4 * i + kr; f32x4 v = __builtin_nontemporal_load((const f32x4*)(W + (size_t)(k0 + kk) * ldw + src_col0 + 4 * n4)); if (kscale) v = v * kscale[k0 + kk];
        float* d = scr + kk * 65 + 4 * n4; d[0] = v.x; d[1] = v.y; d[2] = v.z; d[3] = v.w; }
    LDS_WAIT(); asm volatile("" ::: "memory");
    const int c = lane & 7, nr = lane >> 3;
#pragma unroll
    for (int j = 0; j < 8; ++j) { const int n = nr + 8 * j; const float* s = scr + (8 * c) * 65 + n;
        v4u o; o.x = pk2(s[0 * 65], s[1 * 65]); o.y = pk2(s[2 * 65], s[3 * 65]); o.z = pk2(s[4 * 65], s[5 * 65]); o.w = pk2(s[6 * 65], s[7 * 65]);
        *(v4u*)(WT + (size_t)(dst_row0 + n) * K + k0 + 8 * c) = o; }
    LDS_WAIT(); asm volatile("" ::: "memory");
}
__device__ __forceinline__ void rms_row_to_bf16(const float* xrow, const float* g, bf16* orow, int lane) {
    const f32x4* xr = (const f32x4*)xrow + lane; const f32x4* gr = (const f32x4*)g + lane;
    f32x4 v[8]; float s = 0.f;
#pragma unroll
    for (int j = 0; j < 8; ++j) { v[j] = __builtin_nontemporal_load(xr + 64 * j); s += (v[j].x * v[j].x + v[j].y * v[j].y) + (v[j].z * v[j].z + v[j].w * v[j].w); }
    const float rstd = 1.0f / sqrtf(wave_sum(s) * (1.0f / DM) + EPS);
    v2u* o8 = (v2u*)orow + lane;
#pragma unroll
    for (int j = 0; j < 8; ++j) { const f32x4 gg = gr[64 * j]; v2u w; w.x = pk2(v[j].x * rstd * gg.x, v[j].y * rstd * gg.y); w.y = pk2(v[j].z * rstd * gg.z, v[j].w * rstd * gg.w); o8[64 * j] = w; }
}
__device__ __forceinline__ void zero_row_bf16(bf16* orow, int lane) {
    v2u* o8 = (v2u*)orow + lane; const v2u z = {0u, 0u};
#pragma unroll
    for (int j = 0; j < 8; ++j) o8[64 * j] = z;
}
__device__ __forceinline__ void p0_prologue(Frame& F) {
    bf16* WINT = (bf16*)(F.ws + WS_WINT); bf16* WOUTT = (bf16*)(F.ws + WS_WOUTT); bf16* WQT = (bf16*)(F.ws + WS_WQT);
    float* scr = (float*)(F.lds + F.wave * 16640);
    const int gw = F.vcu * NWAVES + F.wave, NGW = F.G * NWAVES;
    constexpr int I_IN = 32 * 256, I_SQ = 32 * 32;
    for (int it = gw; it < I_IN + 2 * I_SQ; it += NGW) {
        int r = it;
        if (r < I_IN) { const int kb = r >> 8, nb = r & 255, n0 = 64 * nb; p0_transpose_item(F.win, DIN, n0 + (n0 >= 6144 ? 16 : 0), 64 * kb, WINT, DM, n0, scr, F.lane); continue; }
        r -= I_IN;
        if (r < I_SQ) { const int kb = r >> 5, nb = r & 31; p0_transpose_item(F.wout, DM, 64 * nb, 64 * kb, WOUTT, DM, 64 * nb, scr, F.lane); continue; }
        r -= I_SQ;
        { const int kb = r >> 5, nb = r & 31; p0_transpose_item(F.wq, DM, 64 * nb, 64 * kb, WQT, DM, 64 * nb, scr, F.lane, F.n2g); }
    }
    const size_t gt = (size_t)F.vcu * 512 + F.tid, NGT = (size_t)F.G * 512;
    { bf16* SKB = (bf16*)(F.ws + WS_SKB); for (size_t e = gt; e < (size_t)2 * 128 * 128; e += NGT) SKB[e] = (bf16)f2bf(F.sk[e]); }
    { unsigned char* U6 = F.ws + WS_EU; unsigned char* V6 = F.ws + WS_EV; float* SU = (float*)(F.ws + WS_EU + 32 * MiB); float* SV = (float*)(F.ws + WS_EV + 32 * MiB);
      for (int r = gw; r < 2 * NEXP; r += NGW) {
          const bool isv = r >= NEXP; const int row = isv ? r - NEXP : r;
          const float* src = (isv ? F.ev : F.eu) + (size_t)row * DM;
          f32x4 x[8]; float amax = 0.f;
#pragma unroll
          for (int j = 0; j < 8; ++j) { x[j] = __builtin_nontemporal_load((const f32x4*)(src + 256 * j + 4 * F.lane)); if (!isv) x[j] = x[j] * *(const f32x4*)(F.n2g + 256 * j + 4 * F.lane);
              amax = fmaxf(amax, fmaxf(fmaxf(fabsf(x[j].x), fabsf(x[j].y)), fmaxf(fabsf(x[j].z), fabsf(x[j].w)))); }
#pragma unroll
          for (int o = 1; o < 64; o <<= 1) amax = fmaxf(amax, __shfl_xor(amax, o));
          const float sc = amax > 0.f ? 7.5f / amax : 1.0f;
          v16f pa, pb;
#pragma unroll
          for (int j = 0; j < 8; ++j) { pa[2 * j] = x[j].x * sc; pb[2 * j] = x[j].y * sc; pa[2 * j + 1] = x[j].z * sc; pb[2 * j + 1] = x[j].w * sc; }
          const v6u p = __builtin_amdgcn_cvt_scalef32_2xpk16_fp6_f32(pa, pb, 1.0f);
          unsigned char* dst2 = (isv ? V6 : U6) + (size_t)row * ROW6;
          __builtin_nontemporal_store((v4u){p[0], p[1], p[2], p[3]}, (v4u*)(dst2 + 16 * F.lane)); __builtin_nontemporal_store((v2u){p[4], p[5]}, (v2u*)(dst2 + 1024 + 8 * F.lane));
          if (F.lane == 0) (isv ? SV : SU)[row] = amax > 0.f ? amax / 7.5f : 1.0f;
      } }
    __syncthreads();
    { bf16* wt_s = (bf16*)F.lds; constexpr int WLD = DM + 8;
      for (int k = F.tid; k < DM; k += 512) { const float* src = F.win + (size_t)k * DIN + 6144;
#pragma unroll
          for (int q = 0; q < 4; ++q) { const f32x4 w4 = *(const f32x4*)(src + 4 * q); wt_s[(4 * q + 0) * WLD + k] = (bf16)f2bf(w4.x); wt_s[(4 * q + 1) * WLD + k] = (bf16)f2bf(w4.y); wt_s[(4 * q + 2) * WLD + k] = (bf16)f2bf(w4.z); wt_s[(4 * q + 3) * WLD + k] = (bf16)f2bf(w4.w); } }
      bf16* XN = (bf16*)(F.ws + WS_XN); float* ALR = (float*)(F.ws + WS_ALR);
      const int r0 = (int)(((long)F.vcu * TT) / F.G), r1 = (int)(((long)(F.vcu + 1) * TT) / F.G);
      for (int m = r0 + F.wave; m < r1; m += NWAVES) rms_row_to_bf16(m < TP ? F.xp + (size_t)m * DM : F.xs + (size_t)(m - TP) * DM, F.n1g, XN + (size_t)m * DM, F.lane);
      for (int m = TT + gw; m < MP; m += NGW) zero_row_bf16(XN + (size_t)m * DM, F.lane);
      VM_WAIT(); __syncthreads();
      const int l15 = F.lane & 15, lq = F.lane >> 4;
      for (int t0 = r0 + 16 * F.wave; t0 < r1; t0 += 16 * NWAVES) {
          const int row = min(t0 + l15, r1 - 1);
          f32x4 acc = {0.f, 0.f, 0.f, 0.f};
#pragma unroll 8
          for (int ks = 0; ks < 64; ++ks) { const bf16x8 a = *(const bf16x8*)(XN + (size_t)row * DM + 32 * ks + 8 * lq); const bf16x8 bq = *(const bf16x8*)(wt_s + l15 * WLD + 32 * ks + 8 * lq); acc = MFMA16(a, bq, acc); }
#pragma unroll
          for (int r = 0; r < 4; ++r) { const int m = t0 + 4 * lq + r; if (m < r1) ALR[(size_t)m * 16 + l15] = acc[r]; }
      } }
}

template <int NT, class Epi>
__device__ __forceinline__ void skinny_gemm(Frame& F, const bf16* A, const bf16* Bt, int n0, const Epi& E) {
    constexpr int ROWS = NT * 16, NPC = (ROWS * 32 + 511) / 512, BLD = 264;
    bf16* Bs = (bf16*)F.lds;
    const int tid = F.tid, wv = F.wave, l15 = F.lane & 15, lq = F.lane >> 4;
    f32x4 acc[NT];
#pragma unroll
    for (int nt = 0; nt < NT; ++nt) acc[nt] = (f32x4){0.f, 0.f, 0.f, 0.f};
    const bf16* Arow = A + (size_t)(16 * wv + l15) * DM + 8 * lq;
    v4u bX[NPC], bY[NPC]; bf16x8 aX[8], aY[8];
#define SK_LOADB(BR, kc) do { _Pragma("unroll") for (int i = 0; i < NPC; ++i) { const int p = tid + 512 * i; if (p < ROWS * 32) BR[i] = *(const v4u*)(Bt + (size_t)(n0 + (p >> 5)) * DM + (kc) * 256 + 8 * (p & 31)); } } while (0)
#define SK_LOADA(AR, kc) do { _Pragma("unroll") for (int ks = 0; ks < 8; ++ks) AR[ks] = *(const bf16x8*)(Arow + (kc) * 256 + 32 * ks); } while (0)
#define SK_STOREB(BR, kc) do { bf16* Bn = Bs + ((kc) & 1) * ROWS * BLD; _Pragma("unroll") for (int i = 0; i < NPC; ++i) { const int p = tid + 512 * i; if (p < ROWS * 32) *(v4u*)(Bn + (p >> 5) * BLD + 8 * (p & 31)) = BR[i]; } } while (0)
#define SK_COMP(AR, kc) do { const bf16* Bc = Bs + ((kc) & 1) * ROWS * BLD; _Pragma("unroll") for (int ks = 0; ks < 8; ++ks) _Pragma("unroll") for (int nt = 0; nt < NT; ++nt) { \
        const bf16x8 bq = *(const bf16x8*)(Bc + (16 * nt + l15) * BLD + 32 * ks + 8 * lq); acc[nt] = MFMA16(AR[ks], bq, acc[nt]); } } while (0)
    SK_LOADB(bX, 0); SK_LOADA(aX, 0); SK_LOADB(bY, 1); SK_LOADA(aY, 1);
    SK_STOREB(bX, 0);
    __syncthreads();
#pragma unroll 1
    for (int kc = 0; kc < 8; kc += 2) {
        SK_LOADB(bX, kc + 2 < 8 ? kc + 2 : 7);
        SK_COMP(aX, kc); SK_LOADA(aX, kc + 2 < 8 ? kc + 2 : 7);
        SK_STOREB(bY, kc + 1);
        __syncthreads();
        SK_LOADB(bY, kc + 3 < 8 ? kc + 3 : 7);
        SK_COMP(aY, kc + 1); SK_LOADA(aY, kc + 3 < 8 ? kc + 3 : 7);
        SK_STOREB(bX, kc + 2);
        __syncthreads();
    }
#undef SK_LOADB
#undef SK_LOADA
#undef SK_STOREB
#undef SK_COMP
    E.template tile<NT>(acc, wv, l15, lq, n0);
}
struct EpiSkBf16 { bf16* out; int ldc; const float* rs;
    template <int NT> __device__ __forceinline__ void tile(const f32x4 (&acc)[NT], int wv, int l15, int lq, int n0) const {
#pragma unroll
        for (int r = 0; r < 4; ++r) { const int row = 16 * wv + 4 * lq + r; const float sc = rs ? rs[row] : 1.0f;
#pragma unroll
            for (int nt = 0; nt < NT; ++nt) out[(size_t)row * ldc + n0 + 16 * nt + l15] = (bf16)f2bf(acc[nt][r] * sc); } } };
struct EpiSkF32Res { const float* xs; float* out; bf16* outb; float* ssqs;
    template <int NT> __device__ __forceinline__ void tile(const f32x4 (&acc)[NT], int wv, int l15, int lq, int n0) const {
        static_assert(NT == 1, "one 16-column group");
#pragma unroll
        for (int r = 0; r < 4; ++r) { const int row = 16 * wv + 4 * lq + r; const size_t o = (size_t)row * DM + n0 + l15; const float v = xs[o] + acc[0][r]; out[o] = v; outb[o] = (bf16)f2bf(v);
            float s = v * v; s += __shfl_xor(s, 1); s += __shfl_xor(s, 2); s += __shfl_xor(s, 4); s += __shfl_xor(s, 8);
            if (l15 == 0) ssqs[row * 128 + (n0 >> 4)] = s; } } };

__device__ __forceinline__ float logsig(float x) { return fminf(x, 0.f) - __logf(1.0f + __expf(-fabsf(x))); }
__device__ __forceinline__ void gla_prep_unit(Frame& F, int u) {
    const bf16* P = (const bf16*)(F.ws + WS_P); bf16* QT = (bf16*)(F.ws + WS_QT); bf16* KT = (bf16*)(F.ws + WS_KT); bf16* VT = (bf16*)(F.ws + WS_VT);
    bf16* ATT = (bf16*)(F.ws + WS_ATT); float* EBL = (float*)(F.ws + WS_EBL);
    const int b = u >> 7, h = (u >> 5) & 3, c = u & 31, tid = F.tid;
    const int row0 = b * 2048 + c * 64;
    float* alr_s = (float*)F.lds;
    float* tot_s = (float*)(F.lds + 4096);
    bf16* q_s = (bf16*)(F.lds + 8192);
    bf16* k_s = q_s + 64 * 264;
    bf16* v_s = k_s + 64 * 264;
    { v4u tq[4], tk[4], tv[8];
#pragma unroll
      for (int i = 0; i < 4; ++i) { const int p = tid + 512 * i, row = p >> 5, ch = p & 31; const bf16* src = P + (size_t)(row0 + row) * PLD + h * 256 + 8 * ch; tq[i] = __builtin_nontemporal_load((const v4u*)(src + C_Q)); tk[i] = __builtin_nontemporal_load((const v4u*)(src + C_K)); }
#pragma unroll
      for (int i = 0; i < 8; ++i) { const int p = tid + 512 * i, row = p >> 6, ch = p & 63; tv[i] = __builtin_nontemporal_load((const v4u*)(P + (size_t)(row0 + row) * PLD + C_V + h * 512 + 8 * ch)); }
      for (int e = tid; e < 1024; e += 512) alr_s[e] = ((const float*)(F.ws + WS_ALR))[(size_t)row0 * 16 + e];
#pragma unroll
      for (int i = 0; i < 4; ++i) { const int p = tid + 512 * i, row = p >> 5, ch = p & 31; *(v4u*)(q_s + row * 264 + 8 * ch) = tq[i]; *(v4u*)(k_s + row * 264 + 8 * ch) = tk[i]; }
#pragma unroll
      for (int i = 0; i < 8; ++i) { const int p = tid + 512 * i, row = p >> 6, ch = p & 63; *(v4u*)(v_s + row * 520 + 8 * ch) = tv[i]; } }
    const int d = tid & 255, half = tid >> 8;
    float w[16];
#pragma unroll
    for (int r = 0; r < 16; ++r) w[r] = F.wau[r * 1024 + h * 256 + d];
    const float bias = F.bal[h * 256 + d];
    __syncthreads();
    float bb[32]; float run = 0.f;
#pragma unroll
    for (int jj = 0; jj < 32; ++jj) { const int j = half * 32 + jj; float x = bias;
#pragma unroll
        for (int r = 0; r < 16; ++r) x += alr_s[j * 16 + r] * w[r];
        run += logsig(x) * 0.0625f; bb[jj] = run; }
    if (half == 0) tot_s[d] = run;
    __syncthreads();
    if (half == 1) { const float t = tot_s[d];
#pragma unroll
        for (int jj = 0; jj < 32; ++jj) bb[jj] += t; }
    unsigned ktp[16];
#pragma unroll
    for (int jj = 0; jj < 32; ++jj) { const int j = half * 32 + jj;
        const float qv = bf2f(q_s[j * 264 + d]), kv = bf2f(k_s[j * 264 + d]);
        const float e = __expf(bb[jj]), ei = __expf(-bb[jj]);
        const unsigned qb = f2bf(qv * 0.0625f * e), kb = f2bf(kv * ei);
        q_s[j * 264 + d] = (bf16)qb; k_s[j * 264 + d] = (bf16)kb;
        if (jj & 1) ktp[jj >> 1] |= kb << 16; else ktp[jj >> 1] = kb; }
    { v4u* dst = (v4u*)(KT + ((size_t)u * 256 + d) * 64 + half * 32);
#pragma unroll
      for (int i = 0; i < 4; ++i) { v4u o; o.x = ktp[4 * i]; o.y = ktp[4 * i + 1]; o.z = ktp[4 * i + 2]; o.w = ktp[4 * i + 3]; dst[i] = o; } }
    if (half == 1) EBL[u * 256 + d] = __expf(bb[31]);
    __syncthreads();
#pragma unroll
    for (int i = 0; i < 4; ++i) { const int p = tid + 512 * i, row = p >> 5, ch = p & 31; *(v4u*)(QT + (size_t)(row0 + row) * 1024 + h * 256 + 8 * ch) = *(const v4u*)(q_s + row * 264 + 8 * ch); }
    { const int wv = F.wave, l15 = F.lane & 15, lq = F.lane >> 4, mi = wv >> 1;
#pragma unroll
      for (int nn = 0; nn < 2; ++nn) { const int ni = (wv & 1) * 2 + nn; f32x4 acc = {0.f, 0.f, 0.f, 0.f};
#pragma unroll
          for (int ks = 0; ks < 8; ++ks) { const bf16x8 a = *(const bf16x8*)(q_s + (16 * mi + l15) * 264 + 32 * ks + 8 * lq); const bf16x8 bq = *(const bf16x8*)(k_s + (16 * ni + l15) * 264 + 32 * ks + 8 * lq); acc = MFMA16(a, bq, acc); }
#pragma unroll
          for (int r = 0; r < 4; ++r) { const int i = 16 * mi + 4 * lq + r, jn = 16 * ni + l15; ATT[(size_t)u * 4096 + i * 64 + jn] = (bf16)f2bf(jn <= i ? acc[r] : 0.f); } } }
    { const int dv = tid; unsigned vp[32];
#pragma unroll
      for (int j = 0; j < 64; ++j) { const unsigned v = v_s[j * 520 + dv]; if (j & 1) vp[j >> 1] |= v << 16; else vp[j >> 1] = v; }
      v4u* dst = (v4u*)(VT + ((size_t)u * 512 + dv) * 64);
#pragma unroll
      for (int i = 0; i < 8; ++i) { v4u o; o.x = vp[4 * i]; o.y = vp[4 * i + 1]; o.z = vp[4 * i + 2]; o.w = vp[4 * i + 3]; dst[i] = o; } }
    __syncthreads();
}

__device__ __forceinline__ void gla_sample_unit(Frame& F, int u) {
    const bf16* P = (const bf16*)(F.ws + WS_P); bf16* O = (bf16*)(F.ws + WS_O);
    const int n = u >> 2, h = u & 3, tid = F.tid, lane = F.lane, wv = F.wave;
    const size_t m = (size_t)(TP + n);
    float* e_s = (float*)F.lds;
    float* qe_s = e_s + 256;
    float* k_s = qe_s + 256;
    float* v_s = k_s + 256;
    float* red_s = v_s + 512;
    float* op_s = red_s + 64;
    float part = 0.f;
    if (tid < 256) { const int d = tid; float x = F.bal[h * 256 + d];
#pragma unroll
        for (int r = 0; r < 16; ++r) x += ((const float*)(F.ws + WS_ALR))[m * 16 + r] * F.wau[r * 1024 + h * 256 + d];
        const float la = logsig(x) * 0.0625f, e = __expf(la);
        const float q = bf2f(P[m * PLD + C_Q + h * 256 + d]) * 0.0625f, k = bf2f(P[m * PLD + C_K + h * 256 + d]);
        e_s[d] = e; qe_s[d] = q * e; k_s[d] = k; part = q * k; }
    v_s[tid] = bf2f(P[m * PLD + C_V + h * 512 + tid]);
    part = wave_sum(part);
    if (lane == 0) red_s[wv] = part;
    __syncthreads();
    const float attn = (red_s[0] + red_s[1]) + (red_s[2] + red_s[3]);
    const float* Sin = F.sgla + ((size_t)(n * 4 + h) * 256) * 512; float* Sout = F.out + OUT_GLAS + ((size_t)(n * 4 + h) * 256) * 512;
    const f32x4 v0 = *(const f32x4*)(v_s + 4 * lane), v1 = *(const f32x4*)(v_s + 256 + 4 * lane);
    f32x4 o0 = {0.f, 0.f, 0.f, 0.f}, o1 = {0.f, 0.f, 0.f, 0.f};
#pragma unroll 1
    for (int g = 0; g < 4; ++g) {
        f32x4 s0[8], s1[8];
#pragma unroll
        for (int i = 0; i < 8; ++i) { const int d = 32 * wv + 8 * g + i; s0[i] = __builtin_nontemporal_load((const f32x4*)(Sin + (size_t)d * 512 + 4 * lane)); s1[i] = __builtin_nontemporal_load((const f32x4*)(Sin + (size_t)d * 512 + 256 + 4 * lane)); }
#pragma unroll
        for (int i = 0; i < 8; ++i) { const int d = 32 * wv + 8 * g + i; const float e = e_s[d], qe = qe_s[d], k = k_s[d];
            o0 += s0[i] * qe; o1 += s1[i] * qe;
            __builtin_nontemporal_store(s0[i] * e + v0 * k, (f32x4*)(Sout + (size_t)d * 512 + 4 * lane)); __builtin_nontemporal_store(s1[i] * e + v1 * k, (f32x4*)(Sout + (size_t)d * 512 + 256 + 4 * lane)); }
    }
    *(f32x4*)(op_s + wv * 512 + 4 * lane) = o0; *(f32x4*)(op_s + wv * 512 + 256 + 4 * lane) = o1;
    __syncthreads();
    { float o = attn * v_s[tid];
#pragma unroll
      for (int w8 = 0; w8 < 8; ++w8) o += op_s[w8 * 512 + tid];
      O[m * DM + h * 512 + tid] = (bf16)f2bf(o); }
    __syncthreads();
}

struct GlaRegs { bf16x8 kt[2][2], at, q[4]; v4u vpiece; };
struct GlaOffs { unsigned att, vt, qt, kt, eb; };
template <int NT>
__device__ __forceinline__ GlaOffs gla_offs(int wv, int l15, int lq, int tid) {
    const int mi = wv >> 1, kh = wv & 1, tv = tid & (NT * 128 - 1); GlaOffs o;
    o.att = (unsigned)(((16 * mi + l15) * 64 + 32 * kh + 8 * lq) * 2);
    o.vt = (unsigned)(((tv >> 3) * 64 + 8 * (tv & 7)) * 2);
    o.qt = (unsigned)(((16 * mi + l15) * 1024 + 128 * kh + 8 * lq) * 2);
    o.kt = (unsigned)(((32 * wv + l15) * 64 + 8 * lq) * 2);
    o.eb = (unsigned)((32 * wv + 4 * lq) * 4);
    return o;
}
template <int NT>
__device__ __forceinline__ void gla_load(GlaRegs& R, const GlaOffs& o, const bf16* QT, const bf16* KT, const bf16* VT, const bf16* ATT, int bh, int s, int c) {
    const size_t u = (size_t)bh * 32 + c; const int b = bh >> 2, h = bh & 3;
    const char* pa = (const char*)(ATT + u * 4096); const char* pv = (const char*)(VT + (u * 512 + 16 * NT * s) * 64);
    const char* pq = (const char*)(QT + ((size_t)b * 2048 + 64 * c) * 1024 + h * 256); const char* pk = (const char*)(KT + u * 256 * 64);
    R.at = *(const bf16x8*)(pa + o.att);
    R.vpiece = *(const v4u*)(pv + o.vt);
#pragma unroll
    for (int ks = 0; ks < 4; ++ks) R.q[ks] = *(const bf16x8*)(pq + o.qt + 64 * ks);
#pragma unroll
    for (int t = 0; t < 2; ++t)
#pragma unroll
        for (int ks = 0; ks < 2; ++ks) R.kt[t][ks] = *(const bf16x8*)(pk + o.kt + 2048 * t + 64 * ks);
}
constexpr int VT_LD = 72;
template <int NT>
__device__ __forceinline__ void gla_step(const GlaRegs& R, const f32x4 (&eb)[2], f32x4 (&S)[2][NT], const bf16* vts, const bf16* STp, bf16* STn, float* xo, int wv, int lane, int l15, int lq) {
    const int mi = wv >> 1, kh = wv & 1;
#pragma unroll
    for (int nt = 0; nt < NT; ++nt) {
        f32x4 acc = {0.f, 0.f, 0.f, 0.f};
        { const bf16x8 vsel = *(const bf16x8*)(vts + (16 * nt + l15) * VT_LD + 32 * kh + 8 * lq); acc = MFMA16(R.at, vsel, acc); }
#pragma unroll
        for (int ks = 0; ks < 4; ++ks) { const bf16x8 sf = *(const bf16x8*)(STp + (16 * nt + l15) * 264 + 128 * kh + 32 * ks + 8 * lq); acc = MFMA16(R.q[ks], sf, acc); }
        *(f32x4*)(xo + (((mi * 2 + kh) * NT + nt) * 64 + lane) * 4) = acc;
    }
#pragma unroll
    for (int nt = 0; nt < NT; ++nt) {
        bf16x8 vt[2];
#pragma unroll
        for (int ks = 0; ks < 2; ++ks) vt[ks] = *(const bf16x8*)(vts + (16 * nt + l15) * VT_LD + 32 * ks + 8 * lq);
#pragma unroll
        for (int mt = 0; mt < 2; ++mt) {
#pragma unroll
            for (int ks = 0; ks < 2; ++ks) S[mt][nt] = MFMA16(R.kt[mt][ks], vt[ks], S[mt][nt]);
            S[mt][nt] = S[mt][nt] * eb[mt];
            v2u w; w.x = pk2(S[mt][nt][0], S[mt][nt][1]); w.y = pk2(S[mt][nt][2], S[mt][nt][3]);
            *(v2u*)(STn + (16 * nt + l15) * 264 + 32 * wv + 16 * mt + 4 * lq) = w; } }
}
template <int NT>
__device__ __forceinline__ void gla_store_o(const float* xo, bf16* O, int b, int h, int s, int c, int wv, int lane, int l15, int lq) {
    const int mi = wv >> 1;
#pragma unroll
    for (int nt = 0; nt < NT; ++nt) { const f32x4 t = *(const f32x4*)(xo + (((mi * 2 + 0) * NT + nt) * 64 + lane) * 4) + *(const f32x4*)(xo + (((mi * 2 + 1) * NT + nt) * 64 + lane) * 4);
#pragma unroll
        for (int r = 0; r < 4; ++r) O[((size_t)b * 2048 + 64 * c + 16 * mi + 4 * lq + r) * DM + h * 512 + 16 * NT * s + 16 * nt + l15] = (bf16)f2bf(t[r]); }
}
#define GLA_BAR() do { asm volatile("s_waitcnt lgkmcnt(0)" ::: "memory"); __builtin_amdgcn_s_barrier(); asm volatile("" ::: "memory"); } while (0)
template <int NT>
__device__ __forceinline__ void gla_main_unit(Frame& F, int bh, int s) {
    const bf16* QT = (const bf16*)(F.ws + WS_QT); const bf16* KT = (const bf16*)(F.ws + WS_KT); const bf16* VT = (const bf16*)(F.ws + WS_VT);
    const bf16* ATT = (const bf16*)(F.ws + WS_ATT); const float* EBL = (const float*)(F.ws + WS_EBL); bf16* O = (bf16*)(F.ws + WS_O);
    const int b = bh >> 2, h = bh & 3, wv = F.wave, lane = F.lane, l15 = lane & 15, lq = lane >> 4, kh = wv & 1, tid = F.tid;
    constexpr int ST_ELEMS = NT * 16 * 264, XO_FLOATS = 8 * NT * 256, VTS_ELEMS = NT * 16 * VT_LD;
    bf16* ST = (bf16*)F.lds;
    float* XO = (float*)(F.lds + 2 * ST_ELEMS * 2);
    bf16* VTS = (bf16*)(F.lds + 2 * ST_ELEMS * 2 + 2 * XO_FLOATS * 4);
    for (int e = tid; e < ST_ELEMS; e += 512) ((unsigned*)ST)[e] = 0u;
    f32x4 S[2][NT];
#pragma unroll
    for (int a = 0; a < 2; ++a)
#pragma unroll
        for (int c2 = 0; c2 < NT; ++c2) S[a][c2] = (f32x4){0.f, 0.f, 0.f, 0.f};
    const GlaOffs go = gla_offs<NT>(wv, l15, lq, tid);
    GlaRegs RA, RB, RC;
    gla_load<NT>(RA, go, QT, KT, VT, ATT, bh, s, 0);
    gla_load<NT>(RB, go, QT, KT, VT, ATT, bh, s, 1);
    if (tid < NT * 128) *(v4u*)(VTS + (tid >> 3) * VT_LD + 8 * (tid & 7)) = RA.vpiece;
    __syncthreads();
#define GLA_ITER(c, RCUR, RNXT, RLD) do { if ((c) < 32) { \
            f32x4 eb[2]; { const char* pe = (const char*)(EBL + ((size_t)bh * 32 + (c)) * 256); eb[0] = *(const f32x4*)(pe + go.eb); eb[1] = *(const f32x4*)(pe + go.eb + 64); } \
            gla_load<NT>(RLD, go, QT, KT, VT, ATT, bh, s, (c) + 2 < 32 ? (c) + 2 : 31); \
            gla_step<NT>(RCUR, eb, S, VTS + ((c) & 1) * VTS_ELEMS, ST + ((c) & 1) * ST_ELEMS, ST + (((c) + 1) & 1) * ST_ELEMS, XO + ((c) & 1) * XO_FLOATS, wv, lane, l15, lq); \
            if (!kh && (c) > 0) gla_store_o<NT>(XO + (((c) + 1) & 1) * XO_FLOATS, O, b, h, s, (c) - 1, wv, lane, l15, lq); \
            if (tid < NT * 128) *(v4u*)(VTS + (((c) + 1) & 1) * VTS_ELEMS + (tid >> 3) * VT_LD + 8 * (tid & 7)) = RNXT.vpiece; \
            GLA_BAR(); \
        } } while (0)
#pragma unroll 1
    for (int c = 0; c < 33; c += 3) { GLA_ITER(c, RA, RB, RC); GLA_ITER(c + 1, RB, RC, RA); GLA_ITER(c + 2, RC, RA, RB); }
#undef GLA_ITER
    if (!kh) gla_store_o<NT>(XO + (31 & 1) * XO_FLOATS, O, b, h, s, 31, wv, lane, l15, lq);
    float* So = F.out + OUT_GLAP + ((size_t)bh * 256) * 512;
#pragma unroll
    for (int mt = 0; mt < 2; ++mt)
#pragma unroll
        for (int nt = 0; nt < NT; ++nt)
#pragma unroll
            for (int r = 0; r < 4; ++r) So[(size_t)(32 * wv + 16 * mt + 4 * lq + r) * 512 + 16 * NT * s + 16 * nt + l15] = S[mt][nt][r];
    __syncthreads();
}

__device__ __forceinline__ void mixer_rows(Frame& F, int m0, int nr) {
    const bf16* P = (const bf16*)(F.ws + WS_P); const bf16* O = (const bf16*)(F.ws + WS_O); bf16* MM = (bf16*)(F.ws + WS_MM);
    const int lane = F.lane; const bool prompt = m0 < TP;
#pragma unroll 1
    for (int j = 0; j < 4; ++j) {
        const int col = 512 * j + 8 * lane;
        float u1[8], u2[8], gn[8], cbi[8], w0[8], w1[8], w2[8];
        { const f32x4 a = *(const f32x4*)(F.gng + col), b2 = *(const f32x4*)(F.gng + col + 4); gn[0] = a.x; gn[1] = a.y; gn[2] = a.z; gn[3] = a.w; gn[4] = b2.x; gn[5] = b2.y; gn[6] = b2.z; gn[7] = b2.w; }
        { const f32x4 a = *(const f32x4*)(F.cb + col), b2 = *(const f32x4*)(F.cb + col + 4); cbi[0] = a.x; cbi[1] = a.y; cbi[2] = a.z; cbi[3] = a.w; cbi[4] = b2.x; cbi[5] = b2.y; cbi[6] = b2.z; cbi[7] = b2.w; }
        { const f32x4 a = *(const f32x4*)(F.cw + col), b2 = *(const f32x4*)(F.cw + col + 4); w0[0] = a.x; w0[1] = a.y; w0[2] = a.z; w0[3] = a.w; w0[4] = b2.x; w0[5] = b2.y; w0[6] = b2.z; w0[7] = b2.w; }
        { const f32x4 a = *(const f32x4*)(F.cw + DM + col), b2 = *(const f32x4*)(F.cw + DM + col + 4); w1[0] = a.x; w1[1] = a.y; w1[2] = a.z; w1[3] = a.w; w1[4] = b2.x; w1[5] = b2.y; w1[6] = b2.z; w1[7] = b2.w; }
        { const f32x4 a = *(const f32x4*)(F.cw + 2 * DM + col), b2 = *(const f32x4*)(F.cw + 2 * DM + col + 4); w2[0] = a.x; w2[1] = a.y; w2[2] = a.z; w2[3] = a.w; w2[4] = b2.x; w2[5] = b2.y; w2[6] = b2.z; w2[7] = b2.w; }
        if (prompt) {
            const int t0 = m0 & 2047; const bf16* Pr = P + (size_t)m0 * PLD;
            if (t0 >= 1) { float a[8], b2[8]; unpack8(*(const v4u*)(Pr - PLD + C_CC + col), a); unpack8(*(const v4u*)(Pr - PLD + C_CX + col), b2);
#pragma unroll
                for (int e = 0; e < 8; ++e) u1[e] = a[e] * b2[e]; }
            else {
#pragma unroll
                for (int e = 0; e < 8; ++e) u1[e] = 0.f; }
            if (t0 >= 2) { float a[8], b2[8]; unpack8(*(const v4u*)(Pr - 2 * PLD + C_CC + col), a); unpack8(*(const v4u*)(Pr - 2 * PLD + C_CX + col), b2);
#pragma unroll
                for (int e = 0; e < 8; ++e) u2[e] = a[e] * b2[e]; }
            else {
#pragma unroll
                for (int e = 0; e < 8; ++e) u2[e] = 0.f; }
        } else {
            const int n = m0 - TP; const float* sc = F.sconv + (size_t)n * 2 * DM + col;
            const f32x4 a0 = *(const f32x4*)sc, a1 = *(const f32x4*)(sc + 4), b0 = *(const f32x4*)(sc + DM), b1 = *(const f32x4*)(sc + DM + 4);
            u2[0] = a0.x; u2[1] = a0.y; u2[2] = a0.z; u2[3] = a0.w; u2[4] = a1.x; u2[5] = a1.y; u2[6] = a1.z; u2[7] = a1.w;
            u1[0] = b0.x; u1[1] = b0.y; u1[2] = b0.z; u1[3] = b0.w; u1[4] = b1.x; u1[5] = b1.y; u1[6] = b1.z; u1[7] = b1.w;
        }
#pragma unroll 1
        for (int r = 0; r < nr; ++r) {
            const int m = m0 + r; const bf16* Pr = P + (size_t)m * PLD;
            float o[8], rr[8], cbv[8], cc[8], cx[8], ga[8], gb[8], u[8];
            unpack8(*(const v4u*)(O + (size_t)m * DM + col), o);
            unpack8(__builtin_nontemporal_load((const v4u*)(Pr + C_R + col)), rr); unpack8(__builtin_nontemporal_load((const v4u*)(Pr + C_CB + col)), cbv); unpack8(__builtin_nontemporal_load((const v4u*)(Pr + C_CC + col)), cc); unpack8(__builtin_nontemporal_load((const v4u*)(Pr + C_CX + col)), cx);
            unpack8(__builtin_nontemporal_load((const v4u*)(Pr + C_GA + col)), ga); unpack8(__builtin_nontemporal_load((const v4u*)(Pr + C_GB + col)), gb);
            float ss = 0.f;
#pragma unroll
            for (int e = 0; e < 8; ++e) ss += o[e] * o[e];
            const float rstd = 1.0f / sqrtf(wave_sum(ss) * (1.0f / 512.0f) + EPS);
#pragma unroll
            for (int e = 0; e < 8; ++e) u[e] = cc[e] * cx[e];
            if (prompt) { const int t = m & 2047;
                if (t >= 2046) { float* dst = F.out + OUT_CONVP + ((size_t)(m >> 11) * 2 + (t - 2046)) * DM + col;
                    *(f32x4*)dst = (f32x4){u[0], u[1], u[2], u[3]}; *(f32x4*)(dst + 4) = (f32x4){u[4], u[5], u[6], u[7]}; }
            } else { float* dst = F.out + OUT_CONVS + (size_t)(m - TP) * 2 * DM + col;
                *(f32x4*)dst = (f32x4){u1[0], u1[1], u1[2], u1[3]}; *(f32x4*)(dst + 4) = (f32x4){u1[4], u1[5], u1[6], u1[7]};
                *(f32x4*)(dst + DM) = (f32x4){u[0], u[1], u[2], u[3]}; *(f32x4*)(dst + DM + 4) = (f32x4){u[4], u[5], u[6], u[7]}; }
            float mv[8];
#pragma unroll
            for (int e = 0; e < 8; ++e) {
                const float ya = (rr[e] * sigmoidf_(rr[e])) * (o[e] * rstd * gn[e]);
                const float z = cbi[e] + w0[e] * u2[e] + w1[e] * u1[e] + w2[e] * u[e];
                mv[e] = sigmoidf_(ga[e]) * ya + sigmoidf_(gb[e]) * (cbv[e] * z);
                u2[e] = u1[e]; u1[e] = u[e];
            }
            *(v4u*)(MM + (size_t)m * DM + col) = pack8(mv);
        }
    }
}

constexpr int SC_LD = 130;
__device__ __forceinline__ int f2sort(float f) { const int b = __float_as_int(f); return b ^ ((b >> 31) & 0x7fffffff); }
__device__ __forceinline__ float sort2f(int s) { return __int_as_float(s ^ ((s >> 31) & 0x7fffffff)); }
#define CE_DESC(x, y) do { const int mx_ = max(x, y), mn_ = min(x, y); x = mx_; y = mn_; } while (0)
template <int N> __device__ __forceinline__ void bitonic_sort_desc(int (&a)[N]) {
#pragma unroll
    for (int k = 2; k <= N; k <<= 1)
#pragma unroll
        for (int j = k >> 1; j > 0; j >>= 1)
#pragma unroll
            for (int i = 0; i < N; ++i) { const int l = i ^ j; if (l > i) { if ((i & k) == 0) CE_DESC(a[i], a[l]); else CE_DESC(a[l], a[i]); } }
}
template <int N> __device__ __forceinline__ void bitonic_merge_desc(int (&a)[N]) {
#pragma unroll
    for (int j = N >> 1; j > 0; j >>= 1)
#pragma unroll
        for (int i = 0; i < N; ++i) { const int l = i ^ j; if (l > i) CE_DESC(a[i], a[l]); }
}
__device__ __forceinline__ void top16_merge(int (&a)[16], const int (&b)[16]) {
#pragma unroll
    for (int i = 0; i < 16; ++i) a[i] = max(a[i], b[15 - i]);
    bitonic_merge_desc<16>(a);
}
__device__ __attribute__((aligned(16))) const unsigned char PK_CAND[64] = {
    0x00, 0x01, 0x02, 0x03, 0x04, 0x05, 0x06, 0x07, 0x08, 0x09, 0x0a, 0x0b, 0x0c, 0x0d, 0x0e, 0x0f,
    0x10, 0x11, 0x12, 0x13, 0x14, 0x15, 0x16, 0x17, 0x20, 0x21, 0x22, 0x23, 0x24, 0x50, 0x51, 0xff,
    0x30, 0x31, 0x32, 0x33, 0x40, 0x41, 0x42, 0x60, 0x61, 0x70, 0x71, 0xff, 0xff, 0xff, 0xff, 0xff,
    0x80, 0x90, 0xa0, 0xb0, 0xc0, 0xd0, 0xe0, 0xf0, 0xff, 0xff, 0xff, 0xff, 0xff, 0xff, 0xff, 0xff};
constexpr int SC8_LD = 132, SK_LD = 136;
constexpr int SC8_BYTES = 128 * SC8_LD * 4, TV8_OFF = SC8_BYTES, SK_OFF = TV8_OFF + 128 * 16 * 4;
__device__ __forceinline__ void peer_load_subkeys(Frame& F) {
    const bf16* SKB = (const bf16*)(F.ws + WS_SKB); bf16* sk_s = (bf16*)(F.lds + SK_OFF);
    for (int e = F.tid; e < 256 * 16; e += 512) { const int row = e >> 4, ch = e & 15; *(v4u*)(sk_s + row * SK_LD + 8 * ch) = *(const v4u*)(SKB + (size_t)row * 128 + 8 * ch); }
    __syncthreads();
}
__device__ __forceinline__ void peer_qfrags(Frame& F, int tb, bf16x8 (&a)[2][4]) {
    const bf16* QP = (const bf16*)(F.ws + WS_QP); const int tok = min(tb + (F.lane & 7), TT - 1), lq = F.lane >> 4;
#pragma unroll
    for (int hf = 0; hf < 2; ++hf)
#pragma unroll
        for (int ks = 0; ks < 4; ++ks) a[hf][ks] = *(const bf16x8*)(QP + (size_t)tok * DM + F.wave * 256 + hf * 128 + 32 * ks + 8 * lq);
}
#define PK_BAR() do { asm volatile("s_waitcnt lgkmcnt(0)" ::: "memory"); __builtin_amdgcn_s_barrier(); asm volatile("" ::: "memory"); } while (0)
__device__ __forceinline__ void peer_topk_tile(Frame& F, int tb, int tend, bf16x8 (&a)[2][4]) {
    int* IDX = (int*)(F.ws + WS_IDX); float* GW = (float*)(F.ws + WS_GW);
    float* sc_s = (float*)F.lds;
    int* tv_s = (int*)(F.lds + TV8_OFF);
    const bf16* sk_s = (const bf16*)(F.lds + SK_OFF);
    const int wv = F.wave, lane = F.lane, l15 = lane & 15, lq = lane >> 4, tid = F.tid;
    {
#pragma unroll
      for (int hf = 0; hf < 2; ++hf) {
#pragma unroll
          for (int nt = 0; nt < 8; ++nt) { f32x4 acc = {0.f, 0.f, 0.f, 0.f};
#pragma unroll
              for (int ks = 0; ks < 4; ++ks) { const bf16x8 bq = *(const bf16x8*)(sk_s + (hf * 128 + 16 * nt + l15) * SK_LD + 32 * ks + 8 * lq); acc = MFMA16(a[hf][ks], bq, acc); }
              if (lq < 2) {
#pragma unroll
                  for (int r = 0; r < 4; ++r) sc_s[((wv * 2 + hf) * 8 + 4 * lq + r) * SC8_LD + 16 * nt + l15] = acc[r]; } } } }
    if (tb + 8 < tend) peer_qfrags(F, tb + 8, a);
    PK_BAR();
    { const int row = tid >> 2, sub = tid & 3; const float* rp = sc_s + row * SC8_LD;
      int top[16], v[16];
#pragma unroll
      for (int i = 0; i < 16; ++i) { const int key = 4 * i + sub; top[i] = (f2sort(rp[key]) & ~127) | (127 - key); }
      bitonic_sort_desc<16>(top);
#pragma unroll
      for (int i = 0; i < 16; ++i) { const int key = 4 * (16 + i) + sub; v[i] = (f2sort(rp[key]) & ~127) | (127 - key); }
      bitonic_sort_desc<16>(v);
      top16_merge(top, v);
#pragma unroll
      for (int sh = 1; sh < 4; sh <<= 1) {
#pragma unroll
          for (int i = 0; i < 16; ++i) v[i] = __shfl_xor(top[i], sh);
          top16_merge(top, v); }
      if (sub == 0) {
#pragma unroll
          for (int q = 0; q < 4; ++q) *(int __attribute__((ext_vector_type(4)))*)(tv_s + row * 16 + 4 * q) = (int __attribute__((ext_vector_type(4)))){top[4 * q], top[4 * q + 1], top[4 * q + 2], top[4 * q + 3]}; }
    }
    PK_BAR();
    if (tid < 256) { const int it = tid >> 2, qd = tid & 3, tl = it & 7, hd = it >> 3;
      const int* r1 = tv_s + ((hd * 2 + 0) * 8 + tl) * 16; const int* r2 = tv_s + ((hd * 2 + 1) * 8 + tl) * 16;
      int c[16];
      const v4u cw = *(const v4u*)(PK_CAND + qd * 16);
#pragma unroll
      for (int t = 0; t < 16; ++t) { const int ab = (int)((cw[t >> 2] >> (8 * (t & 3))) & 0xffu); const int abc = ab != 0xff ? ab : 0;
          const float sv = sort2f(r1[abc >> 4] & ~127) + sort2f(r2[abc & 15] & ~127); const int packed = (f2sort(sv) & ~255) | (255 - ab);
          c[t] = ab != 0xff ? packed : (int)0x80000000; }
      bitonic_sort_desc<16>(c);
#pragma unroll
      for (int sh = 1; sh < 4; sh <<= 1) { int oth[16];
#pragma unroll
          for (int i = 0; i < 16; ++i) oth[i] = __shfl_xor(c[i], sh);
          top16_merge(c, oth); }
      const int tok = tb + tl;
      if (tok < tend) {
          float ev[16], sum = 0.f; const float mx = sort2f(c[0] & ~255);
#pragma unroll
          for (int k = 0; k < 16; ++k) { ev[k] = __expf(sort2f(c[k] & ~255) - mx); sum += ev[k]; }
          const float inv = 1.0f / sum;
#pragma unroll
          for (int k = 0; k < 16; ++k) if ((k >> 2) == qd) { const int ab = 255 - (c[k] & 255); const int i1 = 127 - (r1[ab >> 4] & 127), i2 = 127 - (r2[ab & 15] & 127);
              IDX[(size_t)tok * 128 + hd * 16 + k] = i1 * 128 + i2; GW[(size_t)tok * 128 + hd * 16 + k] = ev[k] * inv; }
      }
    }
    PK_BAR();
}

__device__ __forceinline__ void peer_phase(Frame& F, int tok0, int tok1) {
    const unsigned char* U6 = F.ws + WS_EU; const unsigned char* V6 = F.ws + WS_EV; const float* SU = (const float*)(F.ws + WS_EU + 32 * MiB); const float* SV = (const float*)(F.ws + WS_EV + 32 * MiB);
    const float* X2 = (const float*)(F.ws + WS_X2); const float* RS2 = (const float*)(F.ws + WS_RS2); const int* IDX = (const int*)(F.ws + WS_IDX); const float* GW = (const float*)(F.ws + WS_GW);
    const int wv = F.wave, lane = F.lane, tid = F.tid;
    float* red_s = (float*)F.lds;
    float* ss_s = (float*)(F.lds + 131072);
    const f32x4 gfin = *(const f32x4*)(F.nfg + 4 * tid);
    f32x4 x3p = {0.f, 0.f, 0.f, 0.f}; int buf = 0;
#pragma unroll 1
    for (int m = tok0; m <= tok1; ++m) {
        if (m < tok1) {
            const int myidx = IDX[(size_t)m * 128 + wv * 16 + (lane & 15)]; float myg = GW[(size_t)m * 128 + wv * 16 + (lane & 15)];
            const float mysu = SU[myidx] * RS2[m]; myg *= SV[myidx];
            float hf[32];
#pragma unroll
            for (int j = 0; j < 8; ++j) { const f32x4 w = *(const f32x4*)(X2 + (size_t)m * DM + 256 * j + 4 * lane); hf[4 * j] = w.x; hf[4 * j + 1] = w.y; hf[4 * j + 2] = w.z; hf[4 * j + 3] = w.w; }
            float acc[32];
#pragma unroll
            for (int k = 0; k < 32; ++k) acc[k] = 0.f;
#pragma unroll 1
            for (int kg = 0; kg < 4; ++kg) {
                v4u ul4[4], vl4[4]; v2u ul2[4], vl2[4]; float gk[4], su[4];
#pragma unroll
                for (int kk = 0; kk < 4; ++kk) { const int ex = __shfl(myidx, kg * 4 + kk); gk[kk] = __shfl(myg, kg * 4 + kk); su[kk] = __shfl(mysu, kg * 4 + kk);
                    const unsigned char* ur = U6 + (size_t)ex * ROW6; const unsigned char* vr = V6 + (size_t)ex * ROW6;
                    ul4[kk] = *(const v4u*)(ur + 16 * lane); ul2[kk] = *(const v2u*)(ur + 1024 + 8 * lane); vl4[kk] = *(const v4u*)(vr + 16 * lane); vl2[kk] = *(const v2u*)(vr + 1024 + 8 * lane); }
#pragma unroll
                for (int kk = 0; kk < 4; ++kk) {
                    const v32f uf = __builtin_amdgcn_cvt_scalef32_pk32_f32_fp6((v6u){ul4[kk].x, ul4[kk].y, ul4[kk].z, ul4[kk].w, ul2[kk].x, ul2[kk].y}, 1.0f);
                    float dot = 0.f;
#pragma unroll
                    for (int k = 0; k < 32; ++k) dot += uf[k] * hf[k];
                    const float a = wave_sum(dot) * su[kk];
                    const float wgt = gk[kk] * (0.5f * a * (1.0f + erff(a * 0.70710678118654752f)));
                    const v32f vf = __builtin_amdgcn_cvt_scalef32_pk32_f32_fp6((v6u){vl4[kk].x, vl4[kk].y, vl4[kk].z, vl4[kk].w, vl2[kk].x, vl2[kk].y}, 1.0f);
#pragma unroll
                    for (int k = 0; k < 32; ++k) acc[k] += wgt * vf[k];
                }
            }
#pragma unroll
            for (int j = 0; j < 8; ++j) *(f32x4*)(red_s + (buf * 8 + wv) * 2048 + 256 * j + 4 * lane) = (f32x4){acc[4 * j], acc[4 * j + 1], acc[4 * j + 2], acc[4 * j + 3]};
        }
        __syncthreads();
        if (m > tok0) {
            float tot = 0.f;
#pragma unroll
            for (int w8 = 0; w8 < 8; ++w8) tot += ss_s[(buf ^ 1) * 8 + w8];
            const float rstd = 1.0f / sqrtf(tot * (1.0f / DM) + EPS);
            *(f32x4*)(F.out + OUT_Y + (size_t)(m - 1) * DM + 4 * tid) = x3p * rstd * gfin;
        }
        if (m < tok1) {
            f32x4 x3 = *(const f32x4*)(X2 + (size_t)m * DM + 4 * tid);
#pragma unroll
            for (int w8 = 0; w8 < 8; ++w8) x3 += *(const f32x4*)(red_s + (buf * 8 + w8) * 2048 + 4 * tid);
            const float ss = wave_sum((x3.x * x3.x + x3.y * x3.y) + (x3.z * x3.z + x3.w * x3.w));
            if (lane == 0) ss_s[buf * 8 + wv] = ss;
            x3p = x3;
        }
        buf ^= 1;
    }
    __syncthreads();
}
struct Args { const float* in[18]; float* out; unsigned char* ws; int ph_lo, ph_hi; };
__global__ void __launch_bounds__(NWAVES * 64, 2) mk_fwd(Args args) {
    extern __shared__ __attribute__((aligned(16))) unsigned char lds[];
    Frame F;
    F.lds = lds;
    F.tid = threadIdx.x; F.lane = F.tid & 63; F.wave = __builtin_amdgcn_readfirstlane(F.tid >> 6);
    F.G = gridDim.x; { const int bx = blockIdx.x; F.vcu = (F.G % 8 == 0) ? (bx % 8) * (F.G / 8) + bx / 8 : bx; }
    F.xp = args.in[0]; F.xs = args.in[1]; F.sgla = args.in[2]; F.sconv = args.in[3]; F.n1g = args.in[4]; F.win = args.in[5]; F.wau = args.in[6]; F.bal = args.in[7];
    F.gng = args.in[8]; F.cw = args.in[9]; F.cb = args.in[10]; F.wout = args.in[11]; F.n2g = args.in[12]; F.wq = args.in[13]; F.sk = args.in[14]; F.eu = args.in[15];
    F.ev = args.in[16]; F.nfg = args.in[17]; F.out = args.out; F.ws = args.ws;
    for (int u = F.tid; u < (LDS_BYTES - LDSCTL_OFF) / 4; u += NWAVES * 64) ((LAS unsigned*)((LAS unsigned char*)lds + LDSCTL_OFF))[u] = 0u;
    __syncthreads();
    gu32* ctl = (gu32*)(F.ws + WS_CTL);
    XcdBarrier bar; bar.bar = (unsigned*)(ctl + CW_BAR); bar.x = 0; bar.st = nullptr;
    if (N_LAUNCHES == 1) bar = xcd_barrier_post((unsigned*)(ctl + CW_BAR), (volatile LAS unsigned*)((LAS unsigned char*)lds + MISC_OFF) + 8);
    const int lo = args.ph_lo, hi = args.ph_hi;
#ifndef SKREP
#define SKREP 1
#endif
#ifndef PROBE_DBL
#define PROBE_DBL -1
#endif
#define IN(k) (lo <= (k) && (k) < hi)
#define REP(k) for (int rep_ = 0; rep_ < ((k) == PROBE_DBL ? 2 : 1); ++rep_)
#ifndef BAR_REP
#define BAR_REP 1
#endif
#define SEAM(k) do { if (IN(k) && IN((k) + 1)) for (int br_ = 0; br_ < BAR_REP; ++br_) xcd_barrier(bar); } while (0)
    const int gw = F.vcu * NWAVES + F.wave, NGW = F.G * NWAVES;
    const int tok0 = (int)(((long)F.vcu * TT) / F.G), tok1 = (int)(((long)(F.vcu + 1) * TT) / F.G);

    if (IN(0)) REP(0) { p0_prologue(F); __syncthreads(); }
    SEAM(0);
    if (IN(1)) REP(1) {
        pg8::Gemm g{(const pg8::bf16_t*)(F.ws + WS_XN), (const pg8::bf16_t*)(F.ws + WS_WINT), TP, NP, DM}; pg8::StaticOrder S; S.init(TP, NP, F.G, (int)blockIdx.x);
        pg8::EpiBf16<0> E{(pg8::bf16_t*)(F.ws + WS_P), PLD, nullptr, 0, 0, 1.f};
        pg8::gemm_phase<pg8::EpiBf16<0>, pg8::StaticOrder, true, true>((PG8_LAS unsigned char*)lds + RING_OFF, g, S, E);
#ifdef GEMM1_TWICE
        pg8::gemm_phase<pg8::EpiBf16<0>, pg8::StaticOrder, true, true>((PG8_LAS unsigned char*)lds + RING_OFF, g, S, E);
#endif
        { EpiSkBf16 Es{(bf16*)(F.ws + WS_P) + (size_t)TP * PLD, PLD, nullptr};
          for (int skr = 0; skr < SKREP; ++skr) for (int ng = F.vcu; ng < NP / 64; ng += F.G) skinny_gemm<4>(F, (const bf16*)(F.ws + WS_XN) + (size_t)TP * DM, (const bf16*)(F.ws + WS_WINT), 64 * ng, Es); }
    }
    SEAM(1);
    if (IN(2)) REP(2) { for (int u = F.vcu; u < 512; u += F.G) gla_prep_unit(F, u); }
    SEAM(2);
    if (IN(3)) REP(3) {
        if ((F.vcu & 1) == 0) { for (int g = F.vcu >> 1; g < 128; g += (F.G + 1) >> 1) gla_main_unit<4>(F, g >> 3, g & 7); }
        volatile LAS unsigned* qslot = (volatile LAS unsigned*)((LAS unsigned char*)lds + LDSCTL_OFF + 16);
        for (;;) {
            if (F.tid == 0) *qslot = __hip_atomic_fetch_add((unsigned*)(ctl + CW_QUEUE + 64 * rep_), 1u, __ATOMIC_RELAXED, __HIP_MEMORY_SCOPE_AGENT);
            __syncthreads();
            const unsigned u = *qslot;
            __syncthreads();
            if (u >= 512u) break;
            gla_sample_unit(F, (int)u);
        }
    }
    SEAM(3);
    if (IN(4)) REP(4) {
        bf16* MM = (bf16*)(F.ws + WS_MM);
        for (int g = gw; g < TP / 4; g += NGW) mixer_rows(F, 4 * g, 4);
        for (int n = gw; n < TS; n += NGW) mixer_rows(F, TP + n, 1);
        for (int m = TT + gw; m < MP; m += NGW) zero_row_bf16(MM + (size_t)m * DM, F.lane);
    }
    SEAM(4);
    if (IN(5)) REP(5) {
        pg8::Gemm g{(const pg8::bf16_t*)(F.ws + WS_MM), (const pg8::bf16_t*)(F.ws + WS_WOUTT), TP, DM, DM}; pg8::StaticOrder S; S.init(TP, DM, F.G, (int)blockIdx.x);
        pg8::EpiF32Res E{F.xp, (float*)(F.ws + WS_X2), (pg8::bf16_t*)(F.ws + WS_H2), (float*)(F.ws + WS_SSQ), DM};
        pg8::gemm_phase<pg8::EpiF32Res, pg8::StaticOrder, true, true>((PG8_LAS unsigned char*)lds + RING_OFF, g, S, E);
#ifdef GEMM2_TWICE
        pg8::gemm_phase<pg8::EpiF32Res, pg8::StaticOrder, true, true>((PG8_LAS unsigned char*)lds + RING_OFF, g, S, E);
#endif
        { EpiSkF32Res Es{F.xs, (float*)(F.ws + WS_X2) + (size_t)TP * DM, (bf16*)(F.ws + WS_H2) + (size_t)TP * DM, (float*)(F.ws + WS_SSQS)};
          for (int skr = 0; skr < SKREP; ++skr) for (int ng = F.vcu; ng < DM / 16; ng += F.G) skinny_gemm<1>(F, (const bf16*)(F.ws + WS_MM) + (size_t)TP * DM, (const bf16*)(F.ws + WS_WOUTT), 16 * ng, Es); }
    }
    SEAM(5);
    if (IN(6)) REP(6) {
        float* rs_s = (float*)(lds + 131072);
        float* rss_s = rs_s + 512;
        float* RS2 = (float*)(F.ws + WS_RS2);
        pg8::Gemm g{(const pg8::bf16_t*)(F.ws + WS_H2), (const pg8::bf16_t*)(F.ws + WS_WQT), TP, DM, DM}; pg8::StaticOrder S; S.init(TP, DM, F.G, (int)blockIdx.x);
        { pg8::Unit u0;
          if (S.next(0, u0) && F.tid < 256) { const int row = u0.pm * 256 + F.tid; const f32x4* p = (const f32x4*)((const float*)(F.ws + WS_SSQ) + (size_t)row * 32); f32x4 a4 = p[0];
#pragma unroll
              for (int i = 1; i < 8; ++i) a4 += p[i];
              const float rstd = 1.0f / sqrtf(((a4.x + a4.y) + (a4.z + a4.w)) * (1.0f / DM) + EPS); rs_s[F.tid] = rstd; if (u0.pn == 0) RS2[row] = rstd; }
          if (F.tid >= 256 && F.tid < 384 && F.vcu < DM / 16) { const int row = F.tid - 256; const f32x4* p = (const f32x4*)((const float*)(F.ws + WS_SSQS) + (size_t)row * 128); f32x4 a4 = p[0];
#pragma unroll
              for (int i = 1; i < 32; ++i) a4 += p[i];
              const float rstd = 1.0f / sqrtf(((a4.x + a4.y) + (a4.z + a4.w)) * (1.0f / DM) + EPS); rss_s[row] = rstd; if (F.vcu == 0) RS2[TP + row] = rstd; }
          __syncthreads(); }
        pg8::EpiBf16RowScale E{(pg8::bf16_t*)(F.ws + WS_QP), DM, rs_s};
        pg8::gemm_phase<pg8::EpiBf16RowScale, pg8::StaticOrder, true, true>((PG8_LAS unsigned char*)lds + RING_OFF, g, S, E);
#ifdef GEMM3_TWICE
        pg8::gemm_phase<pg8::EpiBf16RowScale, pg8::StaticOrder, true, true>((PG8_LAS unsigned char*)lds + RING_OFF, g, S, E);
#endif
        { EpiSkBf16 Es{(bf16*)(F.ws + WS_QP) + (size_t)TP * DM, DM, rss_s};
          for (int skr = 0; skr < SKREP; ++skr) for (int ng = F.vcu; ng < DM / 16; ng += F.G) skinny_gemm<1>(F, (const bf16*)(F.ws + WS_H2) + (size_t)TP * DM, (const bf16*)(F.ws + WS_WQT), 16 * ng, Es); }
    }
    SEAM(6);
    if (IN(7)) REP(7) { bf16x8 qa[2][4]; peer_qfrags(F, tok0, qa); peer_load_subkeys(F); for (int tb = tok0; tb < tok1; tb += 8) peer_topk_tile(F, tb, tok1, qa); __syncthreads(); }
    SEAM(7);
    if (IN(8)) REP(8) { peer_phase(F, tok0, tok1); }
#undef IN
#undef SEAM
}

extern "C" void kernel_launch(void* const* d_in, const int* in_sizes, int n_in, void* d_out, int out_size, void* d_ws, size_t ws_size, hipStream_t stream) {
    static int grid = 0;
    if (grid == 0) {
        if (n_in != 18 || ws_size < WS_END) { fprintf(stderr, "kernel_launch: expected 18 inputs and >= %zu bytes of workspace; got %d, %zu\n", (size_t)WS_END, n_in, ws_size); grid = -1; return; }
        int dev = 0, cus = 0;
        if (hipGetDevice(&dev) != hipSuccess || hipDeviceGetAttribute(&cus, hipDeviceAttributeMultiprocessorCount, dev) != hipSuccess) { grid = -1; return; }
        if (hipFuncSetAttribute((const void*)mk_fwd, hipFuncAttributeMaxDynamicSharedMemorySize, LDS_BYTES) != hipSuccess) { fprintf(stderr, "kernel_launch: hipFuncSetAttribute failed\n"); grid = -1; return; }
        (void)hipGetLastError();
        grid = cus;
    }
    if (grid < 0) return;
    (void)hipMemsetAsync((char*)d_ws + WS_CTL, 0, CTL_ZERO_BYTES, stream);
    Args a{};
    for (int i = 0; i < 18; ++i) a.in[i] = (const float*)d_in[i];
    a.out = (float*)d_out; a.ws = (unsigned char*)d_ws;
    if (N_LAUNCHES == 1) { a.ph_lo = 0; a.ph_hi = N_PHASES; hipLaunchKernelGGL(mk_fwd, dim3(grid), dim3(NWAVES * 64), LDS_BYTES, stream, a); }
    else { for (int li = 0; li < N_PHASES; ++li) { a.ph_lo = li; a.ph_hi = li + 1; hipLaunchKernelGGL(mk_fwd, dim3(grid), dim3(NWAVES * 64), LDS_BYTES, stream, a); } }
}
```

```cpp
#include <hip/hip_runtime.h>
#include <cstdio>
#include <cstdint>
#include <cmath>
#define MK_N_LAUNCHES 1
namespace pg8 {
#define PG8_LAS __attribute__((address_space(3)))
typedef unsigned short bf16_t;
typedef short bf16x8 __attribute__((ext_vector_type(8)));
typedef float f32x4 __attribute__((ext_vector_type(4)));
typedef unsigned u32x4 __attribute__((ext_vector_type(4)));
constexpr int BM = 256, BK = 64, HALF = 128, HTB = HALF * BK * 2  , STAGE_BYTES = 8 * HTB, NXCD = 8, WGM = 8;

__host__ __device__ __forceinline__ int lds_byte(int r, int c) { const int st = (r >> 4) * 2 + (c >> 5), rr = r & 15, cc = c & 31, ob = rr * 64 + cc * 2; return st * 1024 + (ob ^ (((ob >> 9) & 1) << 5)); }
__host__ __device__ __forceinline__ void stage_rc(int b, int& R, int& C) { const int st = b / 1024, sb = b % 1024, swz = sb ^ (((sb >> 9) & 1) << 5); R = (st >> 1) * 16 + swz / 64; C = (st & 1) * 32 + (swz % 64) / 2; }
__host__ __device__ __forceinline__ int perm32(int rho) { const int n = rho >> 4, i = rho & 15; return 8 * (i >> 2) + 4 * n + (i & 3); }

struct Unit { int pm, pn; };
struct Gemm { const bf16_t* A; const bf16_t* Bt; int M, N, K; };

struct StaticOrder {
    int nM, nN, nwg, G, c;
    __host__ __device__ void init(int M, int N, int G_, int c_) { nM = M / BM; nN = N / BM; nwg = nM * nN; G = G_; c = c_; }
    __host__ __device__ bool next(int i, Unit& u) const {
        const long L = (long)i * G + c; if (L >= nwg) return false;
        int wgid = (int)L; { const int q = nwg / NXCD, r = nwg % NXCD, xcd = wgid % NXCD, off = wgid / NXCD; wgid = (xcd < r ? xcd * (q + 1) : r * (q + 1) + (xcd - r) * q) + off; }
        const int nig = WGM * nN, gid = wgid / nig, fm = gid * WGM, gsz = (nM - fm) < WGM ? (nM - fm) : WGM;
        u.pm = fm + ((wgid % nig) % gsz); u.pn = (wgid % nig) / gsz; return true;
    }
    __device__ __forceinline__ void a_ready(const Unit&) const {}
    __device__ __forceinline__ void done(const Unit&) const {}
};

__device__ __forceinline__ unsigned cvt_pk_bf16(float lo, float hi) { unsigned r; asm volatile("v_cvt_pk_bf16_f32 %0, %1, %2" : "=v"(r) : "v"(lo), "v"(hi)); return r; }
typedef float f32x2 __attribute__((ext_vector_type(2)));
__device__ __forceinline__ f32x2 gelu_pk(f32x2 v) {
    const f32x2 av = __builtin_elementwise_abs(v), d = av * 0.2316418882f + 1.0f;
    f32x2 t; t.x = __builtin_amdgcn_rcpf(d.x); t.y = __builtin_amdgcn_rcpf(d.y);
    f32x2 q = t * 0.5307027145f + (-0.7265760135f); q = q * t + 0.7107068705f; q = q * t + (-0.142248368f); q = q * t + 0.127414796f; q = q * t;
    const f32x2 s = (v * v) * (-0.72134752044f);
    f32x2 e; e.x = __builtin_amdgcn_exp2f(s.x); e.y = __builtin_amdgcn_exp2f(s.y);
    const f32x2 m = v * (q * e), r = v - m;
    f32x2 o; o.x = v.x < 0.f ? m.x : r.x; o.y = v.y < 0.f ? m.y : r.y; return o;
}

template <int ACT  > struct EpiBf16 {
    static constexpr bool PERM = true, AFTER_DRAIN = false; static_assert(ACT == 0 || ACT == 1, "EpiBf16: ACT is 0 (none) or 1 (gelu_pk)");
    bf16_t* O; int ldc; const float* bias; int split_cols; size_t split_stride; float scale0;
    __device__ __forceinline__ void operator()(const f32x4 (&acc)[2][2][4][2], const Unit& u, int wr, int wc, int fr, int fq) const {
        const int row0 = u.pm * BM + wr * 64 + fr; int colt = u.pn * BM; bf16_t* base = O;
        float sc = 1.f; if (split_cols) { const int t = colt / split_cols; base += (size_t)t * split_stride; colt -= t * split_cols; if (t == 0) sc = scale0; }
        const int col0 = colt + wc * 32 + 8 * fq, bcol0 = u.pn * BM + wc * 32 + 8 * fq;
        f32x4 bv[2][2];
#pragma unroll
        for (int bj = 0; bj < 2; ++bj)
#pragma unroll
            for (int n = 0; n < 2; ++n) bv[bj][n] = bias ? *(const f32x4*)(bias + bcol0 + bj * HALF + 4 * n) : (f32x4){0.f, 0.f, 0.f, 0.f};
#pragma unroll
        for (int ai = 0; ai < 2; ++ai)
#pragma unroll
            for (int m = 0; m < 4; ++m) { bf16_t* rowp = base + (size_t)(row0 + ai * HALF + m * 16) * ldc + col0;
#pragma unroll
                for (int bj = 0; bj < 2; ++bj) { f32x4 v0 = acc[ai][bj][m][0] + bv[bj][0], v1 = acc[ai][bj][m][1] + bv[bj][1];
                    if (ACT == 1) { f32x2 a = gelu_pk((f32x2){v0[0], v0[1]}), b = gelu_pk((f32x2){v0[2], v0[3]}), c = gelu_pk((f32x2){v1[0], v1[1]}), d = gelu_pk((f32x2){v1[2], v1[3]});
                        v0 = (f32x4){a.x, a.y, b.x, b.y}; v1 = (f32x4){c.x, c.y, d.x, d.y}; }
                    v0 = v0 * sc; v1 = v1 * sc; u32x4 w; w.x = cvt_pk_bf16(v0[0], v0[1]); w.y = cvt_pk_bf16(v0[2], v0[3]); w.z = cvt_pk_bf16(v1[0], v1[1]); w.w = cvt_pk_bf16(v1[2], v1[3]);
                    __builtin_nontemporal_store(w, (u32x4*)(rowp + bj * HALF)); } }
    }
};
template <class Epi, class Sched, bool ALIGN_EPI = false, bool SP2 = false>
__device__ __forceinline__ void gemm_phase(PG8_LAS unsigned char* lds, const Gemm g, const Sched& S, const Epi& E) {
    const int tid = threadIdx.x, wid = __builtin_amdgcn_readfirstlane(tid >> 6), lane = tid & 63, wr = wid >> 2, wc = wid & 3, fr = lane & 15, fq = lane >> 4;
    const int K = g.K, nt = K / BK;
    unsigned voffA[2], voffB[2];
#pragma unroll
    for (int i = 0; i < 2; ++i) { int R, C; stage_rc(tid * 16 + i * 8192, R, C); const int Rb = Epi::PERM ? ((R & ~31) + perm32(R & 31)) : R;
        voffA[i] = (unsigned)(R * K + C) * 2u; voffB[i] = (unsigned)(Rb * K + C) * 2u; }
    const size_t kstep = (size_t)(BK * 2);
    const size_t hstep = (size_t)HALF * K * 2;
    const size_t tstep = 2 * hstep;
    const unsigned ldsw = (unsigned)wid * 1024u;
    const int aoff = lds_byte(wr * 64 + fr, fq * 8), boff = lds_byte(wc * 32 + fr, fq * 8);
#define PG8_SA(b, h) (((b) * 2 + (h)) * HTB)
#define PG8_SB(b, h) ((4 + (b) * 2 + (h)) * HTB)
#define PG8_STAGE(bufoff, gbase, voff) do { _Pragma("unroll") for (int _i = 0; _i < 2; ++_i) \
        __builtin_amdgcn_global_load_lds((const unsigned*)((const char*)(gbase) + (voff)[_i]), (PG8_LAS unsigned*)(lds + (bufoff) + ldsw + _i * 8192), 16, 0, 0); } while (0)
#define PG8_LDA(dst, b, h) do { _Pragma("unroll") for (int m = 0; m < 4; ++m) _Pragma("unroll") for (int k = 0; k < 2; ++k) dst[m][k] = *(const PG8_LAS bf16x8*)(lds + PG8_SA(b, h) + aoff + m * 2048 + k * 1024); } while (0)
#define PG8_LDB(dst, b, h) do { _Pragma("unroll") for (int n = 0; n < 2; ++n) _Pragma("unroll") for (int k = 0; k < 2; ++k) dst[n][k] = *(const PG8_LAS bf16x8*)(lds + PG8_SB(b, h) + boff + n * 2048 + k * 1024); } while (0)
#define PG8_MMA(ai, bj, At, Bt) do { __builtin_amdgcn_s_setprio(1); _Pragma("unroll") for (int m = 0; m < 4; ++m) _Pragma("unroll") for (int n = 0; n < 2; ++n) _Pragma("unroll") for (int k = 0; k < 2; ++k) \
        acc[ai][bj][m][n] = __builtin_amdgcn_mfma_f32_16x16x32_bf16(Bt[n][k], At[m][k], acc[ai][bj][m][n], 0, 0, 0); __builtin_amdgcn_s_setprio(0); } while (0)
#define PG8_WAIT_V(n) asm volatile("s_waitcnt vmcnt(" #n ")" ::: "memory")
#define PG8_WAIT_L(n) asm volatile("s_waitcnt lgkmcnt(" #n ")" ::: "memory")
#define PG8_BAR __builtin_amdgcn_s_barrier()
#define PG8_SCHED __builtin_amdgcn_sched_barrier(0)
    Unit cur, nxt; int ui = 0;
    if (!S.next(0, cur)) return;
    f32x4 acc[2][2][4][2];
#pragma unroll
    for (int a = 0; a < 2; ++a)
#pragma unroll
        for (int b = 0; b < 2; ++b)
#pragma unroll
            for (int m = 0; m < 4; ++m)
#pragma unroll
                for (int n = 0; n < 2; ++n) acc[a][b][m][n] = (f32x4){0.f, 0.f, 0.f, 0.f};
    bf16x8 At[4][2], B0[2][2], B1[2][2];
    const char* cA = (const char*)g.A + (size_t)cur.pm * tstep; const char* cB = (const char*)g.Bt + (size_t)cur.pn * tstep;
    S.a_ready(cur);
    if constexpr (SP2) {
        PG8_STAGE(PG8_SB(0, 0), cB, voffB); PG8_STAGE(PG8_SB(0, 1), cB + hstep, voffB); PG8_STAGE(PG8_SA(0, 0), cA, voffA); PG8_STAGE(PG8_SA(0, 1), cA + hstep, voffA);
        if (wr == 1) PG8_BAR;
        PG8_WAIT_V(2); PG8_BAR;
        PG8_STAGE(PG8_SB(1, 0), cB + kstep, voffB); PG8_STAGE(PG8_SA(1, 0), cA + kstep, voffA); PG8_STAGE(PG8_SB(1, 1), cB + hstep + kstep, voffB);
        PG8_WAIT_V(6); PG8_BAR;
    } else {
        PG8_STAGE(PG8_SB(0, 0), cB, voffB); PG8_STAGE(PG8_SA(0, 0), cA, voffA); PG8_STAGE(PG8_SB(0, 1), cB + hstep, voffB); PG8_STAGE(PG8_SA(0, 1), cA + hstep, voffA);
        if (wr == 1) PG8_BAR;
        PG8_WAIT_V(4); PG8_BAR;
        PG8_STAGE(PG8_SB(1, 0), cB + kstep, voffB); PG8_STAGE(PG8_SA(1, 0), cA + kstep, voffA); PG8_STAGE(PG8_SB(1, 1), cB + hstep + kstep, voffB);
        PG8_WAIT_V(6); PG8_BAR;
    }
    for (;;) {
        const bool has_next = S.next(ui + 1, nxt);
        const char* nA = has_next ? (const char*)g.A + (size_t)nxt.pm * tstep : cA; const char* nB = has_next ? (const char*)g.Bt + (size_t)nxt.pn * tstep : cB;
        for (int t = 0; t < nt; t += 2) {
            const bool last = (t == nt - 2);
            const char* a1 = cA + (size_t)(t + 1) * kstep;
            const char* a2 = last ? nA : cA + (size_t)(t + 2) * kstep; const char* b2 = last ? nB : cB + (size_t)(t + 2) * kstep;
            const char* a3 = a2 + kstep; const char* b3 = b2 + kstep;
            if (last && has_next) S.a_ready(nxt);
            if constexpr (SP2) {
            PG8_LDB(B0, 0, 0); PG8_LDB(B1, 0, 1); PG8_SCHED; PG8_LDA(At, 0, 0); PG8_STAGE(PG8_SA(1, 1), a1 + hstep, voffA);
            PG8_WAIT_V(8); PG8_WAIT_L(0); PG8_BAR; PG8_MMA(0, 0, At, B0); PG8_MMA(0, 1, At, B1); PG8_BAR; PG8_SCHED;
            PG8_LDA(At, 0, 1); PG8_STAGE(PG8_SB(0, 0), b2, voffB); PG8_STAGE(PG8_SB(0, 1), b2 + hstep, voffB); PG8_STAGE(PG8_SA(0, 0), a2, voffA);
            PG8_WAIT_V(8); PG8_WAIT_L(0); PG8_BAR; PG8_MMA(1, 0, At, B0); PG8_MMA(1, 1, At, B1); PG8_BAR; PG8_SCHED;
            PG8_LDB(B0, 1, 0); PG8_LDB(B1, 1, 1); PG8_SCHED; PG8_LDA(At, 1, 0); PG8_STAGE(PG8_SA(0, 1), a2 + hstep, voffA);
            PG8_WAIT_V(8); PG8_WAIT_L(0); PG8_BAR; PG8_MMA(0, 0, At, B0); PG8_MMA(0, 1, At, B1); PG8_BAR; PG8_SCHED;
            PG8_LDA(At, 1, 1); PG8_STAGE(PG8_SB(1, 0), b3, voffB); PG8_STAGE(PG8_SB(1, 1), b3 + hstep, voffB); PG8_STAGE(PG8_SA(1, 0), a3, voffA);
            PG8_WAIT_V(8); PG8_WAIT_L(0); PG8_BAR; PG8_MMA(1, 0, At, B0); PG8_MMA(1, 1, At, B1); PG8_BAR; PG8_SCHED;
            } else {
            PG8_LDB(B0, 0, 0); PG8_SCHED; PG8_LDA(At, 0, 0); PG8_STAGE(PG8_SA(1, 1), a1 + hstep, voffA);
            PG8_WAIT_L(8); PG8_BAR; PG8_WAIT_L(0); PG8_MMA(0, 0, At, B0); PG8_BAR; PG8_SCHED;
            PG8_LDB(B1, 0, 1); PG8_STAGE(PG8_SB(0, 0), b2, voffB);
            PG8_BAR; PG8_WAIT_L(0); PG8_MMA(0, 1, At, B1); PG8_BAR;
            PG8_LDA(At, 0, 1); PG8_STAGE(PG8_SA(0, 0), a2, voffA);
            PG8_BAR; PG8_WAIT_L(0); PG8_MMA(1, 0, At, B0); PG8_BAR; PG8_SCHED;
            PG8_STAGE(PG8_SB(0, 1), b2 + hstep, voffB);
            PG8_WAIT_V(6); PG8_BAR; PG8_MMA(1, 1, At, B1); PG8_BAR;
            PG8_LDB(B0, 1, 0); PG8_SCHED; PG8_LDA(At, 1, 0); PG8_STAGE(PG8_SA(0, 1), a2 + hstep, voffA);
            PG8_WAIT_L(8); PG8_BAR; PG8_WAIT_L(0); PG8_MMA(0, 0, At, B0); PG8_BAR; PG8_SCHED;
            PG8_LDB(B1, 1, 1); PG8_STAGE(PG8_SB(1, 0), b3, voffB);
            PG8_BAR; PG8_WAIT_L(0); PG8_MMA(0, 1, At, B1); PG8_BAR;
            PG8_LDA(At, 1, 1); PG8_STAGE(PG8_SA(1, 0), a3, voffA);
            PG8_BAR; PG8_WAIT_L(0); PG8_MMA(1, 0, At, B0); PG8_BAR; PG8_SCHED;
            PG8_STAGE(PG8_SB(1, 1), b3 + hstep, voffB);
            PG8_WAIT_V(6); PG8_BAR; PG8_MMA(1, 1, At, B1); PG8_BAR;
            }
        }
        if constexpr (ALIGN_EPI) { if (wr == 0) PG8_BAR; }
        if constexpr (!Epi::AFTER_DRAIN) { E(acc, cur, wr, wc, fr, fq); S.done(cur); }
        if (!has_next) break;
#pragma unroll
        for (int a = 0; a < 2; ++a)
#pragma unroll
            for (int b = 0; b < 2; ++b)
#pragma unroll
                for (int m = 0; m < 4; ++m)
#pragma unroll
                    for (int n = 0; n < 2; ++n) acc[a][b][m][n] = (f32x4){0.f, 0.f, 0.f, 0.f};
        cur = nxt; cA = nA; cB = nB; ++ui;
        if constexpr (ALIGN_EPI) { if (wr == 1) PG8_BAR; }
    }
    PG8_WAIT_V(0);
    if constexpr (!ALIGN_EPI) { if (wr == 0) PG8_BAR; }
    PG8_BAR;
    if constexpr (Epi::AFTER_DRAIN) { E.fused(acc, cur, wr, wc, fr, fq, lds, wid, lane); S.done(cur); }
#undef PG8_SA
#undef PG8_SB
#undef PG8_STAGE
#undef PG8_LDA
#undef PG8_LDB
#undef PG8_MMA
#undef PG8_WAIT_V
#undef PG8_WAIT_L
#undef PG8_BAR
#undef PG8_SCHED
}
}
namespace pg8 {
__device__ __forceinline__ unsigned f2bf_(float f) { unsigned u = __builtin_bit_cast(unsigned, f); return (u + 0x7fffu + ((u >> 16) & 1u)) >> 16; }
struct EpiF32Res {
    static constexpr bool PERM = false, AFTER_DRAIN = false;
    const float* xp; float* out; bf16_t* outb; float* ssq; int ldc;
    __device__ __forceinline__ void operator()(const f32x4 (&acc)[2][2][4][2], const Unit& u, int wr, int wc, int fr, int fq) const {
        const int col0 = u.pn * BM + wc * 32 + 4 * fq;
#pragma unroll
        for (int ai = 0; ai < 2; ++ai)
#pragma unroll
            for (int m = 0; m < 4; ++m) {
                const int row = u.pm * BM + ai * HALF + wr * 64 + m * 16 + fr;
                const float* src = xp + (size_t)row * ldc; float* dst = out + (size_t)row * ldc; bf16_t* dstb = outb + (size_t)row * ldc;
                float s = 0.f;
#pragma unroll
                for (int bj = 0; bj < 2; ++bj)
#pragma unroll
                    for (int n = 0; n < 2; ++n) { const int c = col0 + bj * HALF + n * 16; const f32x4 v = *(const f32x4*)(src + c) + acc[ai][bj][m][n]; *(f32x4*)(dst + c) = v;
                        s += (v[0] * v[0] + v[1] * v[1]) + (v[2] * v[2] + v[3] * v[3]);
                        unsigned w0 = f2bf_(v[0]) | (f2bf_(v[1]) << 16), w1 = f2bf_(v[2]) | (f2bf_(v[3]) << 16);
                        typedef unsigned u32x2 __attribute__((ext_vector_type(2))); *(u32x2*)(dstb + c) = (u32x2){w0, w1}; }
                s += __shfl_xor(s, 16); s += __shfl_xor(s, 32);
                if (fq == 0) ssq[(size_t)row * 32 + u.pn * 4 + wc] = s;
            }
    }
};
struct EpiBf16RowScale {
    static constexpr bool PERM = true, AFTER_DRAIN = false;
    bf16_t* O; int ldc; const float* rs;
    __device__ __forceinline__ void operator()(const f32x4 (&acc)[2][2][4][2], const Unit& u, int wr, int wc, int fr, int fq) const {
        const int row0 = u.pm * BM + wr * 64 + fr, col0 = u.pn * BM + wc * 32 + 8 * fq;
#pragma unroll
        for (int ai = 0; ai < 2; ++ai)
#pragma unroll
            for (int m = 0; m < 4; ++m) { const int rl = wr * 64 + fr + ai * HALF + m * 16; const float sc = rs[rl]; bf16_t* rowp = O + (size_t)(row0 + ai * HALF + m * 16) * ldc + col0;
#pragma unroll
                for (int bj = 0; bj < 2; ++bj) { const f32x4 v0 = acc[ai][bj][m][0] * sc, v1 = acc[ai][bj][m][1] * sc;
                    u32x4 w; w.x = cvt_pk_bf16(v0[0], v0[1]); w.y = cvt_pk_bf16(v0[2], v0[3]); w.z = cvt_pk_bf16(v1[0], v1[1]); w.w = cvt_pk_bf16(v1[2], v1[3]);
                    *(u32x4*)(rowp + bj * HALF) = w; } }
    }
};
}

#ifndef MK_N_LAUNCHES
#define MK_N_LAUNCHES 1
#endif
constexpr int N_PHASES = 9;
constexpr int N_LAUNCHES = MK_N_LAUNCHES;
constexpr int NWAVES = 8;

constexpr int DM = 2048;
constexpr int TP = 8192, TS = 128, TT = TP + TS;
constexpr int MP = 8448;
constexpr int NP = 16384;
constexpr int PLD = NP + 64;
constexpr int C_Q = 0, C_K = 1024, C_V = 2048, C_R = 4096, C_CB = 6144, C_CC = 8192, C_CX = 10240, C_GA = 12288, C_GB = 14336;
constexpr int DIN = 16400;
constexpr int NEXP = 16384;
constexpr float EPS = 1e-6f;

constexpr size_t MiB = 1u << 20;
constexpr size_t WS_CTL = 0, CTL_ZERO_BYTES = 1 * MiB;
constexpr size_t WS_WINT = 2 * MiB;
constexpr size_t WS_WOUTT = 68 * MiB;
constexpr size_t WS_WQT = 76 * MiB;
constexpr size_t WS_EU = 84 * MiB;
constexpr size_t WS_EV = 148 * MiB;
constexpr size_t WS_XN = 212 * MiB;
constexpr size_t WS_P = 246 * MiB;
constexpr size_t WS_QT = 516 * MiB;
constexpr size_t WS_KT = 532 * MiB;
constexpr size_t WS_VT = 548 * MiB;
constexpr size_t WS_ATT = 580 * MiB;
constexpr size_t WS_EBL = 584 * MiB;
constexpr size_t WS_SKB = 585 * MiB;
constexpr size_t WS_O = 586 * MiB;
constexpr size_t WS_MM = 620 * MiB;
constexpr size_t WS_X2 = 654 * MiB;
constexpr size_t WS_H2 = 720 * MiB;
constexpr size_t WS_SSQ = 799 * MiB;
constexpr size_t WS_QP = 754 * MiB;
constexpr size_t WS_IDX = 788 * MiB;
constexpr size_t WS_GW = 793 * MiB;
constexpr size_t WS_ALR = 798 * MiB;
constexpr size_t WS_SSQS = 799 * MiB + 1100 * 1024;
constexpr size_t WS_RS2 = 799 * MiB + 1200 * 1024;
constexpr size_t WS_END = 801 * MiB;
constexpr int CW_TMO = 0, CW_CODE = 1, CW_BAR = 4096, CW_QUEUE = 16384;

constexpr size_t OUT_Y = 0;
constexpr size_t OUT_GLAP = (size_t)TT * DM;
constexpr size_t OUT_CONVP = OUT_GLAP + (size_t)4 * 4 * 256 * 512;
constexpr size_t OUT_GLAS = OUT_CONVP + (size_t)4 * 2 * 2048;
constexpr size_t OUT_CONVS = OUT_GLAS + (size_t)128 * 4 * 256 * 512;

constexpr int LDS_BYTES = 163840;
constexpr int LDSCTL_OFF = 162816, MISC_OFF = LDSCTL_OFF + 320;
constexpr int RING_OFF = 0;

#define GAS __attribute__((address_space(1)))
#define LAS __attribute__((address_space(3)))
typedef unsigned short bf16;
typedef unsigned v4u __attribute__((ext_vector_type(4)));
typedef unsigned v2u __attribute__((ext_vector_type(2)));
typedef float f32x4 __attribute__((ext_vector_type(4)));
typedef short bf16x8 __attribute__((ext_vector_type(8)));
typedef GAS unsigned gu32;
typedef float v32f __attribute__((ext_vector_type(32)));
typedef float v16f __attribute__((ext_vector_type(16)));
typedef unsigned v6u __attribute__((ext_vector_type(6)));
constexpr int ROW6 = 1536;
#define RLX_AGENT __ATOMIC_RELAXED, __HIP_MEMORY_SCOPE_AGENT
#define LDS_WAIT() asm volatile("s_waitcnt lgkmcnt(0)" ::: "memory")
#define VM_WAIT() asm volatile("s_waitcnt vmcnt(0)" ::: "memory")
#define MFMA16(a, b, c) __builtin_amdgcn_mfma_f32_16x16x32_bf16((a), (b), (c), 0, 0, 0)
__device__ __forceinline__ unsigned f2bf(float f) { unsigned u = __builtin_bit_cast(unsigned, f); return (u + 0x7fffu + ((u >> 16) & 1u)) >> 16; }
__device__ __forceinline__ unsigned pk2(float lo, float hi) { return f2bf(lo) | (f2bf(hi) << 16); }
__device__ __forceinline__ float bf2f(unsigned b) { return __builtin_bit_cast(float, b << 16); }
__device__ __forceinline__ float bflo(unsigned w) { return __builtin_bit_cast(float, w << 16); }
__device__ __forceinline__ float bfhi(unsigned w) { return __builtin_bit_cast(float, w & 0xffff0000u); }
__device__ __forceinline__ void unpack8(const v4u w, float (&f)[8]) { f[0] = bflo(w.x); f[1] = bfhi(w.x); f[2] = bflo(w.y); f[3] = bfhi(w.y); f[4] = bflo(w.z); f[5] = bfhi(w.z); f[6] = bflo(w.w); f[7] = bfhi(w.w); }
__device__ __forceinline__ v4u pack8(const float (&f)[8]) { v4u w; w.x = pk2(f[0], f[1]); w.y = pk2(f[2], f[3]); w.z = pk2(f[4], f[5]); w.w = pk2(f[6], f[7]); return w; }
__device__ __forceinline__ float wave_sum(float v) {
#pragma unroll
    for (int o = 1; o < 64; o <<= 1) v += __shfl_xor(v, o);
    return v;
}
__device__ __forceinline__ float sigmoidf_(float x) { return 1.0f / (1.0f + __expf(-x)); }
#define XB_TMO      128
#define XB_XCNT(j)  (256  + 64 * (j))
#define XB_XSUB(j)  (1280 + 64 * (j))
#define XB_XGEN(j)  (2304 + 64 * (j))
#define XB_TOP      3328
#define XB_TOPGEN   3392
#define XCD_BAR_WORDS 3456
#define XB_SPIN_CAP (1u << 18)

__device__ __forceinline__ unsigned xb_ld(unsigned* p)              { return __hip_atomic_load(p, __ATOMIC_RELAXED, __HIP_MEMORY_SCOPE_AGENT); }
__device__ __forceinline__ unsigned xb_add(unsigned* p, unsigned v) { return __hip_atomic_fetch_add(p, v, __ATOMIC_RELAXED, __HIP_MEMORY_SCOPE_AGENT); }
__device__ __forceinline__ unsigned xb_xcc_id() { return (unsigned)__builtin_amdgcn_s_getreg((3 << 11) | 20) & 0xFu; }
#define XB_SPIN(cond, bar) do { unsigned _sp = 0; while (cond) { __builtin_amdgcn_s_sleep(1); \
    if ((++_sp & 255u) == 0u) { if (xb_ld(&(bar)[XB_TMO])) break; if (_sp > XB_SPIN_CAP) { atomicAdd(&(bar)[XB_TMO], 1u); break; } } } } while (0)

struct XcdBarrier {
    unsigned* bar; unsigned x;
    volatile LAS unsigned* st;
};

__device__ __forceinline__ XcdBarrier xcd_barrier_post(unsigned* bar, volatile LAS unsigned* st) {
    XcdBarrier b; b.bar = bar; b.x = xb_xcc_id(); b.st = st;
    if (threadIdx.x == 0) (void)xb_add(&bar[XB_XCNT(b.x)], 1u);
    return b;
}
__device__ __forceinline__ void xcd_barrier_complete(unsigned* bar, unsigned x, unsigned& nloc, unsigned& nx) {
    const unsigned G = gridDim.x * gridDim.y * gridDim.z;
    unsigned sum, cnt, mine, sp = 0u;
    for (;;) {
        sum = 0u; cnt = 0u; mine = 0u;
#pragma unroll
        for (unsigned j = 0; j < 16; ++j) { const unsigned c = xb_ld(&bar[XB_XCNT(j)]); sum += c; cnt += (c > 0u) ? 1u : 0u; mine = (j == x) ? c : mine; }
        if (sum == G) break;
        __builtin_amdgcn_s_sleep(1);
        if ((++sp & 255u) == 0u) { if (xb_ld(&bar[XB_TMO])) break; if (sp > XB_SPIN_CAP) { atomicAdd(&bar[XB_TMO], 1u); break; } }
    }
    nloc = mine > 0u ? mine : 1u; nx = cnt > 0u ? cnt : 1u;
}

__device__ __forceinline__ void xcd_barrier(const XcdBarrier& b) {
    asm volatile("s_waitcnt vmcnt(0)" ::: "memory");
    __syncthreads();
    if (threadIdx.x == 0) {
        unsigned* bar = b.bar;
        __builtin_amdgcn_s_waitcnt(0);
        unsigned nloc = b.st[0], nx = b.st[1];
        if (nloc == 0u) { xcd_barrier_complete(bar, b.x, nloc, nx); b.st[0] = nloc; b.st[1] = nx; }
        const unsigned old = xb_add(&bar[XB_XSUB(b.x)], 1u);
        const unsigned gen = old / nloc;
        if (old + 1u == (gen + 1u) * nloc) {
            __builtin_amdgcn_fence(__ATOMIC_RELEASE, "agent");
            asm volatile("s_waitcnt vmcnt(0)" ::: "memory");
            const unsigned og = xb_add(&bar[XB_TOP], 1u);
            const unsigned tg = og / nx;
            if (og + 1u == (tg + 1u) * nx) xb_add(&bar[XB_TOPGEN], 1u);
            else XB_SPIN(xb_ld(&bar[XB_TOPGEN]) == tg, bar);
            __builtin_amdgcn_fence(__ATOMIC_ACQUIRE, "agent");
            xb_add(&bar[XB_XGEN(b.x)], 1u);
            asm volatile("s_waitcnt vmcnt(0)" ::: "memory");
        } else {
            XB_SPIN(xb_ld(&bar[XB_XGEN(b.x)]) == gen, bar);
            __builtin_amdgcn_fence(__ATOMIC_ACQUIRE, "agent");
            asm volatile("s_waitcnt vmcnt(0)" ::: "memory");
        }
    }
    __syncthreads();
}
struct Frame {
    unsigned char* lds;
    int tid, lane, wave, vcu, G;
    const float *xp, *xs, *sgla, *sconv, *n1g, *win, *wau, *bal, *gng, *cw, *cb, *wout, *n2g, *wq, *sk, *eu, *ev, *nfg;
    float* out;
    unsigned char* ws;
};

__device__ __forceinline__ void p0_transpose_item(const float* W, int ldw, int src_col0, int k0, bf16* WT, int K, int dst_row0, float* scr, int lane, const float* kscale = nullptr) {
    const int n4 = lane & 15, kr = lane >> 4;
#pragma unroll 8
    for (int i = 0; i < 16; ++i) { const int kk = 4 * i + kr; f32x4 v = __builtin_nontemporal_load((const f32x4*)(W + (size_t)(k0 + kk) * ldw + src_col0 + 4 * n4)); if (kscale) v = v * kscale[k0 + kk];
        float* d = scr + kk * 65 + 4 * n4; d[0] = v.x; d[1] = v.y; d[2] = v.z; d[3] = v.w; }
    LDS_WAIT(); asm volatile("" ::: "memory");
    const int c = lane & 7, nr = lane >> 3;
#pragma unroll
    for (int j = 0; j < 8; ++j) { const int n = nr + 8 * j; const float* s = scr + (8 * c) * 65 + n;
        v4u o; o.x = pk2(s[0 * 65], s[1 * 65]); o.y = pk2(s[2 * 65], s[3 * 65]); o.z = pk2(s[4 * 65], s[5 * 65]); o.w = pk2(s[6 * 65], s[7 * 65]);
        *(v4u*)(WT + (size_t)(dst_row0 + n) * K + k0 + 8 * c) = o; }
    LDS_WAIT(); asm volatile("" ::: "memory");
}
__device__ __forceinline__ void rms_row_to_bf16(const float* xrow, const float* g, bf16* orow, int lane) {
    const f32x4* xr = (const f32x4*)xrow + lane; const f32x4* gr = (const f32x4*)g + lane;
    f32x4 v[8]; float s = 0.f;
#pragma unroll
    for (int j = 0; j < 8; ++j) { v[j] = __builtin_nontemporal_load(xr + 64 * j); s += (v[j].x * v[j].x + v[j].y * v[j].y) + (v[j].z * v[j].z + v[j].w * v[j].w); }
    const float rstd = 1.0f / sqrtf(wave_sum(s) * (1.0f / DM) + EPS);
    v2u* o8 = (v2u*)orow + lane;
#pragma unroll
    for (int j = 0; j < 8; ++j) { const f32x4 gg = gr[64 * j]; v2u w; w.x = pk2(v[j].x * rstd * gg.x, v[j].y * rstd * gg.y); w.y = pk2(v[j].z * rstd * gg.z, v[j].w * rstd * gg.w); o8[64 * j] = w; }
}
__device__ __forceinline__ void zero_row_bf16(bf16* orow, int lane) {
    v2u* o8 = (v2u*)orow + lane; const v2u z = {0u, 0u};
#pragma unroll
    for (int j = 0; j < 8; ++j) o8[64 * j] = z;
}
__device__ __forceinline__ void p0_prologue(Frame& F) {
    bf16* WINT = (bf16*)(F.ws + WS_WINT); bf16* WOUTT = (bf16*)(F.ws + WS_WOUTT); bf16* WQT = (bf16*)(F.ws + WS_WQT);
    float* scr = (float*)(F.lds + F.wave * 16640);
    const int gw = F.vcu * NWAVES + F.wave, NGW = F.G * NWAVES;
    constexpr int I_IN = 32 * 256, I_SQ = 32 * 32;
    for (int it = gw; it < I_IN + 2 * I_SQ; it += NGW) {
        int r = it;
        if (r < I_IN) { const int kb = r >> 8, nb = r & 255, n0 = 64 * nb; p0_transpose_item(F.win, DIN, n0 + (n0 >= 6144 ? 16 : 0), 64 * kb, WINT, DM, n0, scr, F.lane); continue; }
        r -= I_IN;
        if (r < I_SQ) { const int kb = r >> 5, nb = r & 31; p0_transpose_item(F.wout, DM, 64 * nb, 64 * kb, WOUTT, DM, 64 * nb, scr, F.lane); continue; }
        r -= I_SQ;
        { const int kb = r >> 5, nb = r & 31; p0_transpose_item(F.wq, DM, 64 * nb, 64 * kb, WQT, DM, 64 * nb, scr, F.lane, F.n2g); }
    }
    const size_t gt = (size_t)F.vcu * 512 + F.tid, NGT = (size_t)F.G * 512;
    { bf16* SKB = (bf16*)(F.ws + WS_SKB); for (size_t e = gt; e < (size_t)2 * 128 * 128; e += NGT) SKB[e] = (bf16)f2bf(F.sk[e]); }
    { unsigned char* U6 = F.ws + WS_EU; unsigned char* V6 = F.ws + WS_EV; float* SU = (float*)(F.ws + WS_EU + 32 * MiB); float* SV = (float*)(F.ws + WS_EV + 32 * MiB);
      for (int r = gw; r < 2 * NEXP; r += NGW) {
          const bool isv = r >= NEXP; const int row = isv ? r - NEXP : r;
          const float* src = (isv ? F.ev : F.eu) + (size_t)row * DM;
          f32x4 x[8]; float amax = 0.f;
#pragma unroll
          for (int j = 0; j < 8; ++j) { x[j] = __builtin_nontemporal_load((const f32x4*)(src + 256 * j + 4 * F.lane)); if (!isv) x[j] = x[j] * *(const f32x4*)(F.n2g + 256 * j + 4 * F.lane);
              amax = fmaxf(amax, fmaxf(fmaxf(fabsf(x[j].x), fabsf(x[j].y)), fmaxf(fabsf(x[j].z), fabsf(x[j].w)))); }
#pragma unroll
          for (int o = 1; o < 64; o <<= 1) amax = fmaxf(amax, __shfl_xor(amax, o));
          const float sc = amax > 0.f ? 7.5f / amax : 1.0f;
          v16f pa, pb;
#pragma unroll
          for (int j = 0; j < 8; ++j) { pa[2 * j] = x[j].x * sc; pb[2 * j] = x[j].y * sc; pa[2 * j + 1] = x[j].z * sc; pb[2 * j + 1] = x[j].w * sc; }
          const v6u p = __builtin_amdgcn_cvt_scalef32_2xpk16_fp6_f32(pa, pb, 1.0f);
          unsigned char* dst2 = (isv ? V6 : U6) + (size_t)row * ROW6;
          __builtin_nontemporal_store((v4u){p[0], p[1], p[2], p[3]}, (v4u*)(dst2 + 16 * F.lane)); __builtin_nontemporal_store((v2u){p[4], p[5]}, (v2u*)(dst2 + 1024 + 8 * F.lane));
          if (F.lane == 0) (isv ? SV : SU)[row] = amax > 0.f ? amax / 7.5f : 1.0f;
      } }
    __syncthreads();
    { bf16* wt_s = (bf16*)F.lds; constexpr int WLD = DM + 8;
      for (int k = F.tid; k < DM; k += 512) { const float* src = F.win + (size_t)k * DIN + 6144;
#pragma unroll
          for (int q = 0; q < 4; ++q) { const f32x4 w4 = *(const f32x4*)(src + 4 * q); wt_s[(4 * q + 0) * WLD + k] = (bf16)f2bf(w4.x); wt_s[(4 * q + 1) * WLD + k] = (bf16)f2bf(w4.y); wt_s[(4 * q + 2) * WLD + k] = (bf16)f2bf(w4.z); wt_s[(4 * q + 3) * WLD + k] = (bf16)f2bf(w4.w); } }
      bf16* XN = (bf16*)(F.ws + WS_XN); float* ALR = (float*)(F.ws + WS_ALR);
      const int r0 = (int)(((long)F.vcu * TT) / F.G), r1 = (int)(((long)(F.vcu + 1) * TT) / F.G);
      for (int m = r0 + F.wave; m < r1; m += NWAVES) rms_row_to_bf16(m < TP ? F.xp + (size_t)m * DM : F.xs + (size_t)(m - TP) * DM, F.n1g, XN + (size_t)m * DM, F.lane);
      for (int m = TT + gw; m < MP; m += NGW) zero_row_bf16(XN + (size_t)m * DM, F.lane);
      VM_WAIT(); __syncthreads();
      const int l15 = F.lane & 15, lq = F.lane >> 4;
      for (int t0 = r0 + 16 * F.wave; t0 < r1; t0 += 16 * NWAVES) {
          const int row = min(t0 + l15, r1 - 1);
          f32x4 acc = {0.f, 0.f, 0.f, 0.f};
#pragma unroll 8
          for (int ks = 0; ks < 64; ++ks) { const bf16x8 a = *(const bf16x8*)(XN + (size_t)row * DM + 32 * ks + 8 * lq); const bf16x8 bq = *(const bf16x8*)(wt_s + l15 * WLD + 32 * ks + 8 * lq); acc = MFMA16(a, bq, acc); }
#pragma unroll
          for (int r = 0; r < 4; ++r) { const int m = t0 + 4 * lq + r; if (m < r1) ALR[(size_t)m * 16 + l15] = acc[r]; }
      } }
}

template <int NT, class Epi>
__device__ __forceinline__ void skinny_gemm(Frame& F, const bf16* A, const bf16* Bt, int n0, const Epi& E) {
    constexpr int ROWS = NT * 16, NPC = (ROWS * 32 + 511) / 512, BLD = 264;
    bf16* Bs = (bf16*)F.lds;
    const int tid = F.tid, wv = F.wave, l15 = F.lane & 15, lq = F.lane >> 4;
    f32x4 acc[NT];
#pragma unroll
    for (int nt = 0; nt < NT; ++nt) acc[nt] = (f32x4){0.f, 0.f, 0.f, 0.f};
    const bf16* Arow = A + (size_t)(16 * wv + l15) * DM + 8 * lq;
    v4u bX[NPC], bY[NPC]; bf16x8 aX[8], aY[8];
#define SK_LOADB(BR, kc) do { _Pragma("unroll") for (int i = 0; i < NPC; ++i) { const int p = tid + 512 * i; if (p < ROWS * 32) BR[i] = *(const v4u*)(Bt + (size_t)(n0 + (p >> 5)) * DM + (kc) * 256 + 8 * (p & 31)); } } while (0)
#define SK_LOADA(AR, kc) do { _Pragma("unroll") for (int ks = 0; ks < 8; ++ks) AR[ks] = *(const bf16x8*)(Arow + (kc) * 256 + 32 * ks); } while (0)
#define SK_STOREB(BR, kc) do { bf16* Bn = Bs + ((kc) & 1) * ROWS * BLD; _Pragma("unroll") for (int i = 0; i < NPC; ++i) { const int p = tid + 512 * i; if (p < ROWS * 32) *(v4u*)(Bn + (p >> 5) * BLD + 8 * (p & 31)) = BR[i]; } } while (0)
#define SK_COMP(AR, kc) do { const bf16* Bc = Bs + ((kc) & 1) * ROWS * BLD; _Pragma("unroll") for (int ks = 0; ks < 8; ++ks) _Pragma("unroll") for (int nt = 0; nt < NT; ++nt) { \
        const bf16x8 bq = *(const bf16x8*)(Bc + (16 * nt + l15) * BLD + 32 * ks + 8 * lq); acc[nt] = MFMA16(AR[ks], bq, acc[nt]); } } while (0)
    SK_LOADB(bX, 0); SK_LOADA(aX, 0); SK_LOADB(bY, 1); SK_LOADA(aY, 1);
    SK_STOREB(bX, 0);
    __syncthreads();
#pragma unroll 1
    for (int kc = 0; kc < 8; kc += 2) {
        SK_LOADB(bX, kc + 2 < 8 ? kc + 2 : 7);
        SK_COMP(aX, kc); SK_LOADA(aX, kc + 2 < 8 ? kc + 2 : 7);
        SK_STOREB(bY, kc + 1);
        __syncthreads();
        SK_LOADB(bY, kc + 3 < 8 ? kc + 3 : 7);
        SK_COMP(aY, kc + 1); SK_LOADA(aY, kc + 3 < 8 ? kc + 3 : 7);
        SK_STOREB(bX, kc + 2);
        __syncthreads();
    }
#undef SK_LOADB
#undef SK_LOADA
#undef SK_STOREB
#undef SK_COMP
    E.template tile<NT>(acc, wv, l15, lq, n0);
}
struct EpiSkBf16 { bf16* out; int ldc; const float* rs;
    template <int NT> __device__ __forceinline__ void tile(const f32x4 (&acc)[NT], int wv, int l15, int lq, int n0) const {
#pragma unroll
        for (int r = 0; r < 4; ++r) { const int row = 16 * wv + 4 * lq + r; const float sc = rs ? rs[row] : 1.0f;
#pragma unroll
            for (int nt = 0; nt < NT; ++nt) out[(size_t)row * ldc + n0 + 16 * nt + l15] = (bf16)f2bf(acc[nt][r] * sc); } } };
struct EpiSkF32Res { const float* xs; float* out; bf16* outb; float* ssqs;
    template <int NT> __device__ __forceinline__ void tile(const f32x4 (&acc)[NT], int wv, int l15, int lq, int n0) const {
        static_assert(NT == 1, "one 16-column group");
#pragma unroll
        for (int r = 0; r < 4; ++r) { const int row = 16 * wv + 4 * lq + r; const size_t o = (size_t)row * DM + n0 + l15; const float v = xs[o] + acc[0][r]; out[o] = v; outb[o] = (bf16)f2bf(v);
            float s = v * v; s += __shfl_xor(s, 1); s += __shfl_xor(s, 2); s += __shfl_xor(s, 4); s += __shfl_xor(s, 8);
            if (l15 == 0) ssqs[row * 128 + (n0 >> 4)] = s; } } };

__device__ __forceinline__ float logsig(float x) { return fminf(x, 0.f) - __logf(1.0f + __expf(-fabsf(x))); }
__device__ __forceinline__ void gla_prep_unit(Frame& F, int u) {
    const bf16* P = (const bf16*)(F.ws + WS_P); bf16* QT = (bf16*)(F.ws + WS_QT); bf16* KT = (bf16*)(F.ws + WS_KT); bf16* VT = (bf16*)(F.ws + WS_VT);
    bf16* ATT = (bf16*)(F.ws + WS_ATT); float* EBL = (float*)(F.ws + WS_EBL);
    const int b = u >> 7, h = (u >> 5) & 3, c = u & 31, tid = F.tid;
    const int row0 = b * 2048 + c * 64;
    float* alr_s = (float*)F.lds;
    float* tot_s = (float*)(F.lds + 4096);
    bf16* q_s = (bf16*)(F.lds + 8192);
    bf16* k_s = q_s + 64 * 264;
    bf16* v_s = k_s + 64 * 264;
    bf16* a_s = v_s + 64 * 520;
    { v4u tq[4], tk[4], tv[8];
#pragma unroll
      for (int i = 0; i < 4; ++i) { const int p = tid + 512 * i, row = p >> 5, ch = p & 31; const bf16* src = P + (size_t)(row0 + row) * PLD + h * 256 + 8 * ch; tq[i] = __builtin_nontemporal_load((const v4u*)(src + C_Q)); tk[i] = __builtin_nontemporal_load((const v4u*)(src + C_K)); }
#pragma unroll
      for (int i = 0; i < 8; ++i) { const int p = tid + 512 * i, row = p >> 6, ch = p & 63; tv[i] = __builtin_nontemporal_load((const v4u*)(P + (size_t)(row0 + row) * PLD + C_V + h * 512 + 8 * ch)); }
      for (int e = tid; e < 1024; e += 512) alr_s[e] = ((const float*)(F.ws + WS_ALR))[(size_t)row0 * 16 + e];
#pragma unroll
      for (int i = 0; i < 4; ++i) { const int p = tid + 512 * i, row = p >> 5, ch = p & 31; *(v4u*)(q_s + row * 264 + 8 * ch) = tq[i]; *(v4u*)(k_s + row * 264 + 8 * ch) = tk[i]; }
#pragma unroll
      for (int i = 0; i < 8; ++i) { const int p = tid + 512 * i, row = p >> 6, ch = p & 63; *(v4u*)(v_s + row * 520 + 8 * ch) = tv[i]; } }
    const int d = tid & 255, half = tid >> 8;
    float w[16];
#pragma unroll
    for (int r = 0; r < 16; ++r) w[r] = F.wau[r * 1024 + h * 256 + d];
    const float bias = F.bal[h * 256 + d];
    __syncthreads();
    float bb[32]; float run = 0.f;
#pragma unroll
    for (int jj = 0; jj < 32; ++jj) { const int j = half * 32 + jj; float x = bias;
#pragma unroll
        for (int r = 0; r < 16; ++r) x += alr_s[j * 16 + r] * w[r];
        run += logsig(x) * 0.0625f; bb[jj] = run; }
    if (half == 0) tot_s[d] = run;
    __syncthreads();
    if (half == 1) { const float t = tot_s[d];
#pragma unroll
        for (int jj = 0; jj < 32; ++jj) bb[jj] += t; }
#pragma unroll
    for (int jj = 0; jj < 32; ++jj) { const int j = half * 32 + jj;
        const float qv = bf2f(q_s[j * 264 + d]), kv = bf2f(k_s[j * 264 + d]);
        const float e = __expf(bb[jj]), ei = __expf(-bb[jj]);
        q_s[j * 264 + d] = (bf16)f2bf(qv * 0.0625f * e); k_s[j * 264 + d] = (bf16)f2bf(kv * ei); }
    if (half == 1) EBL[u * 256 + d] = __expf(bb[31]);
    __syncthreads();
    { const int wv = F.wave, l15 = F.lane & 15, lq = F.lane >> 4, mi = wv >> 1;
#pragma unroll
      for (int nn = 0; nn < 2; ++nn) { const int ni = (wv & 1) * 2 + nn; f32x4 acc = {0.f, 0.f, 0.f, 0.f};
#pragma unroll
          for (int ks = 0; ks < 8; ++ks) { const bf16x8 a = *(const bf16x8*)(q_s + (16 * mi + l15) * 264 + 32 * ks + 8 * lq); const bf16x8 bq = *(const bf16x8*)(k_s + (16 * ni + l15) * 264 + 32 * ks + 8 * lq); acc = MFMA16(a, bq, acc); }
#pragma unroll
          for (int r = 0; r < 4; ++r) { const int i = 16 * mi + 4 * lq + r, jn = 16 * ni + l15; a_s[i * 72 + jn] = (bf16)f2bf(jn <= i ? acc[r] : 0.f); } } }
#pragma unroll
    for (int i = 0; i < 4; ++i) { const int p = tid + 512 * i, f = p >> 6, ln = p & 63, l15 = ln & 15, lq = ln >> 4;
        { const int mi = f >> 3, kh = (f >> 2) & 1, ks = f & 3; *(v4u*)(QT + (size_t)u * 16384 + (size_t)p * 8) = *(const v4u*)(q_s + (16 * mi + l15) * 264 + 128 * kh + 32 * ks + 8 * lq); }
        { const int wv2 = f >> 2, t2 = (f >> 1) & 1, ks = f & 1, dd = 32 * wv2 + 16 * t2 + l15, j0 = 32 * ks + 8 * lq; v4u o;
          o.x = (unsigned)k_s[(j0 + 0) * 264 + dd] | ((unsigned)k_s[(j0 + 1) * 264 + dd] << 16); o.y = (unsigned)k_s[(j0 + 2) * 264 + dd] | ((unsigned)k_s[(j0 + 3) * 264 + dd] << 16);
          o.z = (unsigned)k_s[(j0 + 4) * 264 + dd] | ((unsigned)k_s[(j0 + 5) * 264 + dd] << 16); o.w = (unsigned)k_s[(j0 + 6) * 264 + dd] | ((unsigned)k_s[(j0 + 7) * 264 + dd] << 16);
          *(v4u*)(KT + (size_t)u * 16384 + (size_t)p * 8) = o; } }
    __syncthreads();
    { const int p = tid, f = p >> 6, ln = p & 63, l15 = ln & 15, lq = ln >> 4, mi = f >> 1, kh = f & 1;
      *(v4u*)(ATT + (size_t)u * 4096 + (size_t)p * 8) = *(const v4u*)(a_s + (16 * mi + l15) * 72 + 32 * kh + 8 * lq); }
    { const int dv = tid; unsigned vp[32];
#pragma unroll
      for (int j = 0; j < 64; ++j) { const unsigned v = v_s[j * 520 + dv]; if (j & 1) vp[j >> 1] |= v << 16; else vp[j >> 1] = v; }
      v4u* dst = (v4u*)(VT + ((size_t)u * 512 + dv) * 64);
#pragma unroll
      for (int i = 0; i < 8; ++i) { v4u o; o.x = vp[4 * i]; o.y = vp[4 * i + 1]; o.z = vp[4 * i + 2]; o.w = vp[4 * i + 3]; dst[i] = o; } }
    __syncthreads();
}

__device__ __forceinline__ void gla_sample_unit(Frame& F, int u) {
    const bf16* P = (const bf16*)(F.ws + WS_P); bf16* O = (bf16*)(F.ws + WS_O);
    const int n = u >> 2, h = u & 3, tid = F.tid, lane = F.lane, wv = F.wave;
    const size_t m = (size_t)(TP + n);
    float* e_s = (float*)F.lds;
    float* qe_s = e_s + 256;
    float* k_s = qe_s + 256;
    float* v_s = k_s + 256;
    float* red_s = v_s + 512;
    float* op_s = red_s + 64;
    float part = 0.f;
    if (tid < 256) { const int d = tid; float x = F.bal[h * 256 + d];
#pragma unroll
        for (int r = 0; r < 16; ++r) x += ((const float*)(F.ws + WS_ALR))[m * 16 + r] * F.wau[r * 1024 + h * 256 + d];
        const float la = logsig(x) * 0.0625f, e = __expf(la);
        const float q = bf2f(P[m * PLD + C_Q + h * 256 + d]) * 0.0625f, k = bf2f(P[m * PLD + C_K + h * 256 + d]);
        e_s[d] = e; qe_s[d] = q * e; k_s[d] = k; part = q * k; }
    v_s[tid] = bf2f(P[m * PLD + C_V + h * 512 + tid]);
    part = wave_sum(part);
    if (lane == 0) red_s[wv] = part;
    __syncthreads();
    const float attn = (red_s[0] + red_s[1]) + (red_s[2] + red_s[3]);
    const float* Sin = F.sgla + ((size_t)(n * 4 + h) * 256) * 512; float* Sout = F.out + OUT_GLAS + ((size_t)(n * 4 + h) * 256) * 512;
    const f32x4 v0 = *(const f32x4*)(v_s + 4 * lane), v1 = *(const f32x4*)(v_s + 256 + 4 * lane);
    f32x4 o0 = {0.f, 0.f, 0.f, 0.f}, o1 = {0.f, 0.f, 0.f, 0.f};
#pragma unroll 1
    for (int g = 0; g < 4; ++g) {
        f32x4 s0[8], s1[8];
#pragma unroll
        for (int i = 0; i < 8; ++i) { const int d = 32 * wv + 8 * g + i; s0[i] = __builtin_nontemporal_load((const f32x4*)(Sin + (size_t)d * 512 + 4 * lane)); s1[i] = __builtin_nontemporal_load((const f32x4*)(Sin + (size_t)d * 512 + 256 + 4 * lane)); }
#pragma unroll
        for (int i = 0; i < 8; ++i) { const int d = 32 * wv + 8 * g + i; const float e = e_s[d], qe = qe_s[d], k = k_s[d];
            o0 += s0[i] * qe; o1 += s1[i] * qe;
            __builtin_nontemporal_store(s0[i] * e + v0 * k, (f32x4*)(Sout + (size_t)d * 512 + 4 * lane)); __builtin_nontemporal_store(s1[i] * e + v1 * k, (f32x4*)(Sout + (size_t)d * 512 + 256 + 4 * lane)); }
    }
    *(f32x4*)(op_s + wv * 512 + 4 * lane) = o0; *(f32x4*)(op_s + wv * 512 + 256 + 4 * lane) = o1;
    __syncthreads();
    { float o = attn * v_s[tid];
#pragma unroll
      for (int w8 = 0; w8 < 8; ++w8) o += op_s[w8 * 512 + tid];
      O[m * DM + h * 512 + tid] = (bf16)f2bf(o); }
    __syncthreads();
}

struct GlaRegs { bf16x8 kt[2][2], at, q[4]; v4u vpiece; };
struct GlaOffs { unsigned att, vt, qt, kt, eb; };
template <int NT>
__device__ __forceinline__ GlaOffs gla_offs(int wv, int lane, int lq, int tid) {
    const int mi = wv >> 1, kh = wv & 1, tv = tid & (NT * 128 - 1); GlaOffs o;
    o.att = (unsigned)((mi * 2 + kh) * 1024 + lane * 16);
    o.vt = (unsigned)(((tv >> 3) * 64 + 8 * (tv & 7)) * 2);
    o.qt = (unsigned)((mi * 2 + kh) * 4096 + lane * 16);
    o.kt = (unsigned)(wv * 4096 + lane * 16);
    o.eb = (unsigned)((32 * wv + 4 * lq) * 4);
    return o;
}
template <int NT>
__device__ __forceinline__ void gla_load(GlaRegs& R, const GlaOffs& o, const bf16* QT, const bf16* KT, const bf16* VT, const bf16* ATT, int bh, int s, int c) {
    const size_t u = (size_t)bh * 32 + c;
    const char* pa = (const char*)(ATT + u * 4096); const char* pv = (const char*)(VT + (u * 512 + 16 * NT * s) * 64);
    const char* pq = (const char*)(QT + u * 16384); const char* pk = (const char*)(KT + u * 16384);
    R.at = *(const bf16x8*)(pa + o.att);
    R.vpiece = *(const v4u*)(pv + o.vt);
#pragma unroll
    for (int ks = 0; ks < 4; ++ks) R.q[ks] = *(const bf16x8*)(pq + o.qt + 1024 * ks);
#pragma unroll
    for (int t = 0; t < 2; ++t)
#pragma unroll
        for (int ks = 0; ks < 2; ++ks) R.kt[t][ks] = *(const bf16x8*)(pk + o.kt + 2048 * t + 1024 * ks);
}
constexpr int VT_LD = 72;
template <int NT>
__device__ __forceinline__ void gla_step(const GlaRegs& R, const f32x4 (&eb)[2], f32x4 (&S)[2][NT], const bf16* vts, const bf16* STp, bf16* STn, float* xo, int wv, int lane, int l15, int lq) {
    const int mi = wv >> 1, kh = wv & 1;
#pragma unroll
    for (int nt = 0; nt < NT; ++nt) {
        f32x4 acc = {0.f, 0.f, 0.f, 0.f};
        { const bf16x8 vsel = *(const bf16x8*)(vts + (16 * nt + l15) * VT_LD + 32 * kh + 8 * lq); acc = MFMA16(R.at, vsel, acc); }
#pragma unroll
        for (int ks = 0; ks < 4; ++ks) { const bf16x8 sf = *(const bf16x8*)(STp + (16 * nt + l15) * 264 + 128 * kh + 32 * ks + 8 * lq); acc = MFMA16(R.q[ks], sf, acc); }
        *(f32x4*)(xo + (((mi * 2 + kh) * NT + nt) * 64 + lane) * 4) = acc;
    }
#pragma unroll
    for (int nt = 0; nt < NT; ++nt) {
        bf16x8 vt[2];
#pragma unroll
        for (int ks = 0; ks < 2; ++ks) vt[ks] = *(const bf16x8*)(vts + (16 * nt + l15) * VT_LD + 32 * ks + 8 * lq);
#pragma unroll
        for (int mt = 0; mt < 2; ++mt) {
#pragma unroll
            for (int ks = 0; ks < 2; ++ks) S[mt][nt] = MFMA16(R.kt[mt][ks], vt[ks], S[mt][nt]);
            S[mt][nt] = S[mt][nt] * eb[mt];
            v2u w; w.x = pk2(S[mt][nt][0], S[mt][nt][1]); w.y = pk2(S[mt][nt][2], S[mt][nt][3]);
            *(v2u*)(STn + (16 * nt + l15) * 264 + 32 * wv + 16 * mt + 4 * lq) = w; } }
}
template <int NT>
__device__ __forceinline__ void gla_store_o(const float* xo, bf16* O, int b, int h, int s, int c, int wv, int lane, int l15, int lq) {
    const int mi = wv >> 1;
#pragma unroll
    for (int nt = 0; nt < NT; ++nt) { const f32x4 t = *(const f32x4*)(xo + (((mi * 2 + 0) * NT + nt) * 64 + lane) * 4) + *(const f32x4*)(xo + (((mi * 2 + 1) * NT + nt) * 64 + lane) * 4);
#pragma unroll
        for (int r = 0; r < 4; ++r) O[((size_t)b * 2048 + 64 * c + 16 * mi + 4 * lq + r) * DM + h * 512 + 16 * NT * s + 16 * nt + l15] = (bf16)f2bf(t[r]); }
}
#define GLA_BAR() do { asm volatile("s_waitcnt lgkmcnt(0)" ::: "memory"); __builtin_amdgcn_s_barrier(); asm volatile("" ::: "memory"); } while (0)
template <int NT>
__device__ __forceinline__ void gla_main_unit(Frame& F, int bh, int s) {
    const bf16* QT = (const bf16*)(F.ws + WS_QT); const bf16* KT = (const bf16*)(F.ws + WS_KT); const bf16* VT = (const bf16*)(F.ws + WS_VT);
    const bf16* ATT = (const bf16*)(F.ws + WS_ATT); const float* EBL = (const float*)(F.ws + WS_EBL); bf16* O = (bf16*)(F.ws + WS_O);
    const int b = bh >> 2, h = bh & 3, wv = F.wave, lane = F.lane, l15 = lane & 15, lq = lane >> 4, kh = wv & 1, tid = F.tid;
    constexpr int ST_ELEMS = NT * 16 * 264, XO_FLOATS = 8 * NT * 256, VTS_ELEMS = NT * 16 * VT_LD;
    bf16* ST = (bf16*)F.lds;
    float* XO = (float*)(F.lds + 2 * ST_ELEMS * 2);
    bf16* VTS = (bf16*)(F.lds + 2 * ST_ELEMS * 2 + 2 * XO_FLOATS * 4);
    for (int e = tid; e < ST_ELEMS; e += 512) ((unsigned*)ST)[e] = 0u;
    f32x4 S[2][NT];
#pragma unroll
    for (int a = 0; a < 2; ++a)
#pragma unroll
        for (int c2 = 0; c2 < NT; ++c2) S[a][c2] = (f32x4){0.f, 0.f, 0.f, 0.f};
    const GlaOffs go = gla_offs<NT>(wv, lane, lq, tid);
    GlaRegs RA, RB, RC;
    gla_load<NT>(RA, go, QT, KT, VT, ATT, bh, s, 0);
    gla_load<NT>(RB, go, QT, KT, VT, ATT, bh, s, 1);
    if (tid < NT * 128) *(v4u*)(VTS + (tid >> 3) * VT_LD + 8 * (tid & 7)) = RA.vpiece;
    __syncthreads();
#define GLA_ITER(c, RCUR, RNXT, RLD) do { if ((c) < 32) { \
            f32x4 eb[2]; { const char* pe = (const char*)(EBL + ((size_t)bh * 32 + (c)) * 256); eb[0] = *(const f32x4*)(pe + go.eb); eb[1] = *(const f32x4*)(pe + go.eb + 64); } \
            gla_load<NT>(RLD, go, QT, KT, VT, ATT, bh, s, (c) + 2 < 32 ? (c) + 2 : 31); \
            gla_step<NT>(RCUR, eb, S, VTS + ((c) & 1) * VTS_ELEMS, ST + ((c) & 1) * ST_ELEMS, ST + (((c) + 1) & 1) * ST_ELEMS, XO + ((c) & 1) * XO_FLOATS, wv, lane, l15, lq); \
            if (!kh && (c) > 0) gla_store_o<NT>(XO + (((c) + 1) & 1) * XO_FLOATS, O, b, h, s, (c) - 1, wv, lane, l15, lq); \
            if (tid < NT * 128) *(v4u*)(VTS + (((c) + 1) & 1) * VTS_ELEMS + (tid >> 3) * VT_LD + 8 * (tid & 7)) = RNXT.vpiece; \
            GLA_BAR(); \
        } } while (0)
#pragma unroll 1
    for (int c = 0; c < 33; c += 3) { GLA_ITER(c, RA, RB, RC); GLA_ITER(c + 1, RB, RC, RA); GLA_ITER(c + 2, RC, RA, RB); }
#undef GLA_ITER
    if (!kh) gla_store_o<NT>(XO + (31 & 1) * XO_FLOATS, O, b, h, s, 31, wv, lane, l15, lq);
    float* So = F.out + OUT_GLAP + ((size_t)bh * 256) * 512;
#pragma unroll
    for (int mt = 0; mt < 2; ++mt)
#pragma unroll
        for (int nt = 0; nt < NT; ++nt)
#pragma unroll
            for (int r = 0; r < 4; ++r) So[(size_t)(32 * wv + 16 * mt + 4 * lq + r) * 512 + 16 * NT * s + 16 * nt + l15] = S[mt][nt][r];
    __syncthreads();
}

__device__ __forceinline__ void mixer_rows(Frame& F, int m0, int nr) {
    const bf16* P = (const bf16*)(F.ws + WS_P); const bf16* O = (const bf16*)(F.ws + WS_O); bf16* MM = (bf16*)(F.ws + WS_MM);
    const int lane = F.lane; const bool prompt = m0 < TP;
#pragma unroll 1
    for (int j = 0; j < 4; ++j) {
        const int col = 512 * j + 8 * lane;
        float u1[8], u2[8], gn[8], cbi[8], w0[8], w1[8], w2[8];
        { const f32x4 a = *(const f32x4*)(F.gng + col), b2 = *(const f32x4*)(F.gng + col + 4); gn[0] = a.x; gn[1] = a.y; gn[2] = a.z; gn[3] = a.w; gn[4] = b2.x; gn[5] = b2.y; gn[6] = b2.z; gn[7] = b2.w; }
        { const f32x4 a = *(const f32x4*)(F.cb + col), b2 = *(const f32x4*)(F.cb + col + 4); cbi[0] = a.x; cbi[1] = a.y; cbi[2] = a.z; cbi[3] = a.w; cbi[4] = b2.x; cbi[5] = b2.y; cbi[6] = b2.z; cbi[7] = b2.w; }
        { const f32x4 a = *(const f32x4*)(F.cw + col), b2 = *(const f32x4*)(F.cw + col + 4); w0[0] = a.x; w0[1] = a.y; w0[2] = a.z; w0[3] = a.w; w0[4] = b2.x; w0[5] = b2.y; w0[6] = b2.z; w0[7] = b2.w; }
        { const f32x4 a = *(const f32x4*)(F.cw + DM + col), b2 = *(const f32x4*)(F.cw + DM + col + 4); w1[0] = a.x; w1[1] = a.y; w1[2] = a.z; w1[3] = a.w; w1[4] = b2.x; w1[5] = b2.y; w1[6] = b2.z; w1[7] = b2.w; }
        { const f32x4 a = *(const f32x4*)(F.cw + 2 * DM + col), b2 = *(const f32x4*)(F.cw + 2 * DM + col + 4); w2[0] = a.x; w2[1] = a.y; w2[2] = a.z; w2[3] = a.w; w2[4] = b2.x; w2[5] = b2.y; w2[6] = b2.z; w2[7] = b2.w; }
        if (prompt) {
            const int t0 = m0 & 2047; const bf16* Pr = P + (size_t)m0 * PLD;
            if (t0 >= 1) { float a[8], b2[8]; unpack8(*(const v4u*)(Pr - PLD + C_CC + col), a); unpack8(*(const v4u*)(Pr - PLD + C_CX + col), b2);
#pragma unroll
                for (int e = 0; e < 8; ++e) u1[e] = a[e] * b2[e]; }
            else {
#pragma unroll
                for (int e = 0; e < 8; ++e) u1[e] = 0.f; }
            if (t0 >= 2) { float a[8], b2[8]; unpack8(*(const v4u*)(Pr - 2 * PLD + C_CC + col), a); unpack8(*(const v4u*)(Pr - 2 * PLD + C_CX + col), b2);
#pragma unroll
                for (int e = 0; e < 8; ++e) u2[e] = a[e] * b2[e]; }
            else {
#pragma unroll
                for (int e = 0; e < 8; ++e) u2[e] = 0.f; }
        } else {
            const int n = m0 - TP; const float* sc = F.sconv + (size_t)n * 2 * DM + col;
            const f32x4 a0 = *(const f32x4*)sc, a1 = *(const f32x4*)(sc + 4), b0 = *(const f32x4*)(sc + DM), b1 = *(const f32x4*)(sc + DM + 4);
            u2[0] = a0.x; u2[1] = a0.y; u2[2] = a0.z; u2[3] = a0.w; u2[4] = a1.x; u2[5] = a1.y; u2[6] = a1.z; u2[7] = a1.w;
            u1[0] = b0.x; u1[1] = b0.y; u1[2] = b0.z; u1[3] = b0.w; u1[4] = b1.x; u1[5] = b1.y; u1[6] = b1.z; u1[7] = b1.w;
        }
#pragma unroll 1
        for (int r = 0; r < nr; ++r) {
            const int m = m0 + r; const bf16* Pr = P + (size_t)m * PLD;
            float o[8], rr[8], cbv[8], cc[8], cx[8], ga[8], gb[8], u[8];
            unpack8(*(const v4u*)(O + (size_t)m * DM + col), o);
            unpack8(__builtin_nontemporal_load((const v4u*)(Pr + C_R + col)), rr); unpack8(__builtin_nontemporal_load((const v4u*)(Pr + C_CB + col)), cbv); unpack8(__builtin_nontemporal_load((const v4u*)(Pr + C_CC + col)), cc); unpack8(__builtin_nontemporal_load((const v4u*)(Pr + C_CX + col)), cx);
            unpack8(__builtin_nontemporal_load((const v4u*)(Pr + C_GA + col)), ga); unpack8(__builtin_nontemporal_load((const v4u*)(Pr + C_GB + col)), gb);
            float ss = 0.f;
#pragma unroll
            for (int e = 0; e < 8; ++e) ss += o[e] * o[e];
            const float rstd = 1.0f / sqrtf(wave_sum(ss) * (1.0f / 512.0f) + EPS);
#pragma unroll
            for (int e = 0; e < 8; ++e) u[e] = cc[e] * cx[e];
            if (prompt) { const int t = m & 2047;
                if (t >= 2046) { float* dst = F.out + OUT_CONVP + ((size_t)(m >> 11) * 2 + (t - 2046)) * DM + col;
                    *(f32x4*)dst = (f32x4){u[0], u[1], u[2], u[3]}; *(f32x4*)(dst + 4) = (f32x4){u[4], u[5], u[6], u[7]}; }
            } else { float* dst = F.out + OUT_CONVS + (size_t)(m - TP) * 2 * DM + col;
                *(f32x4*)dst = (f32x4){u1[0], u1[1], u1[2], u1[3]}; *(f32x4*)(dst + 4) = (f32x4){u1[4], u1[5], u1[6], u1[7]};
                *(f32x4*)(dst + DM) = (f32x4){u[0], u[1], u[2], u[3]}; *(f32x4*)(dst + DM + 4) = (f32x4){u[4], u[5], u[6], u[7]}; }
            float mv[8];
#pragma unroll
            for (int e = 0; e < 8; ++e) {
                const float ya = (rr[e] * sigmoidf_(rr[e])) * (o[e] * rstd * gn[e]);
                const float z = cbi[e] + w0[e] * u2[e] + w1[e] * u1[e] + w2[e] * u[e];
                mv[e] = sigmoidf_(ga[e]) * ya + sigmoidf_(gb[e]) * (cbv[e] * z);
                u2[e] = u1[e]; u1[e] = u[e];
            }
            *(v4u*)(MM + (size_t)m * DM + col) = pack8(mv);
        }
    }
}

constexpr int SC_LD = 130;
__device__ __forceinline__ int f2sort(float f) { const int b = __float_as_int(f); return b ^ ((b >> 31) & 0x7fffffff); }
__device__ __forceinline__ float sort2f(int s) { return __int_as_float(s ^ ((s >> 31) & 0x7fffffff)); }
#define CE_DESC(x, y) do { const int mx_ = max(x, y), mn_ = min(x, y); x = mx_; y = mn_; } while (0)
template <int N> __device__ __forceinline__ void bitonic_sort_desc(int (&a)[N]) {
#pragma unroll
    for (int k = 2; k <= N; k <<= 1)
#pragma unroll
        for (int j = k >> 1; j > 0; j >>= 1)
#pragma unroll
            for (int i = 0; i < N; ++i) { const int l = i ^ j; if (l > i) { if ((i & k) == 0) CE_DESC(a[i], a[l]); else CE_DESC(a[l], a[i]); } }
}
template <int N> __device__ __forceinline__ void bitonic_merge_desc(int (&a)[N]) {
#pragma unroll
    for (int j = N >> 1; j > 0; j >>= 1)
#pragma unroll
        for (int i = 0; i < N; ++i) { const int l = i ^ j; if (l > i) CE_DESC(a[i], a[l]); }
}
__device__ __forceinline__ void top16_merge(int (&a)[16], const int (&b)[16]) {
#pragma unroll
    for (int i = 0; i < 16; ++i) a[i] = max(a[i], b[15 - i]);
    bitonic_merge_desc<16>(a);
}
__device__ __attribute__((aligned(16))) const unsigned char PK_CAND[64] = {
    0x00, 0x01, 0x02, 0x03, 0x04, 0x05, 0x06, 0x07, 0x08, 0x09, 0x0a, 0x0b, 0x0c, 0x0d, 0x0e, 0x0f,
    0x10, 0x11, 0x12, 0x13, 0x14, 0x15, 0x16, 0x17, 0x20, 0x21, 0x22, 0x23, 0x24, 0x50, 0x51, 0xff,
    0x30, 0x31, 0x32, 0x33, 0x40, 0x41, 0x42, 0x60, 0x61, 0x70, 0x71, 0xff, 0xff, 0xff, 0xff, 0xff,
    0x80, 0x90, 0xa0, 0xb0, 0xc0, 0xd0, 0xe0, 0xf0, 0xff, 0xff, 0xff, 0xff, 0xff, 0xff, 0xff, 0xff};
constexpr int SC8_LD = 132, SK_LD = 136;
constexpr int SC8_BYTES = 128 * SC8_LD * 4, TV8_OFF = SC8_BYTES, SK_OFF = TV8_OFF + 128 * 16 * 4;
__device__ __forceinline__ void peer_load_subkeys(Frame& F) {
    const bf16* SKB = (const bf16*)(F.ws + WS_SKB); bf16* sk_s = (bf16*)(F.lds + SK_OFF);
    for (int e = F.tid; e < 256 * 16; e += 512) { const int row = e >> 4, ch = e & 15; *(v4u*)(sk_s + row * SK_LD + 8 * ch) = *(const v4u*)(SKB + (size_t)row * 128 + 8 * ch); }
    __syncthreads();
}
__device__ __forceinline__ void peer_qfrags(Frame& F, int tb, bf16x8 (&a)[2][4]) {
    const bf16* QP = (const bf16*)(F.ws + WS_QP); const int tok = min(tb + (F.lane & 7), TT - 1), lq = F.lane >> 4;
#pragma unroll
    for (int hf = 0; hf < 2; ++hf)
#pragma unroll
        for (int ks = 0; ks < 4; ++ks) a[hf][ks] = *(const bf16x8*)(QP + (size_t)tok * DM + F.wave * 256 + hf * 128 + 32 * ks + 8 * lq);
}
#define PK_BAR() do { asm volatile("s_waitcnt lgkmcnt(0)" ::: "memory"); __builtin_amdgcn_s_barrier(); asm volatile("" ::: "memory"); } while (0)
__device__ __forceinline__ void peer_topk_tile(Frame& F, int tb, int tend, bf16x8 (&a)[2][4]) {
    int* IDX = (int*)(F.ws + WS_IDX); float* GW = (float*)(F.ws + WS_GW);
    float* sc_s = (float*)F.lds;
    int* tv_s = (int*)(F.lds + TV8_OFF);
    const bf16* sk_s = (const bf16*)(F.lds + SK_OFF);
    const int wv = F.wave, lane = F.lane, l15 = lane & 15, lq = lane >> 4, tid = F.tid;
    {
#pragma unroll
      for (int hf = 0; hf < 2; ++hf) {
#pragma unroll
          for (int nt = 0; nt < 8; ++nt) { f32x4 acc = {0.f, 0.f, 0.f, 0.f};
#pragma unroll
              for (int ks = 0; ks < 4; ++ks) { const bf16x8 bq = *(const bf16x8*)(sk_s + (hf * 128 + 16 * nt + l15) * SK_LD + 32 * ks + 8 * lq); acc = MFMA16(a[hf][ks], bq, acc); }
              if (lq < 2) {
#pragma unroll
                  for (int r = 0; r < 4; ++r) sc_s[((wv * 2 + hf) * 8 + 4 * lq + r) * SC8_LD + 16 * nt + l15] = acc[r]; } } } }
    if (tb + 8 < tend) peer_qfrags(F, tb + 8, a);
    PK_BAR();
    { const int row = tid >> 2, sub = tid & 3; const float* rp = sc_s + row * SC8_LD;
      int top[16], v[16];
#pragma unroll
      for (int i = 0; i < 16; ++i) { const int key = 4 * i + sub; top[i] = (f2sort(rp[key]) & ~127) | (127 - key); }
      bitonic_sort_desc<16>(top);
#pragma unroll
      for (int i = 0; i < 16; ++i) { const int key = 4 * (16 + i) + sub; v[i] = (f2sort(rp[key]) & ~127) | (127 - key); }
      bitonic_sort_desc<16>(v);
      top16_merge(top, v);
#pragma unroll
      for (int sh = 1; sh < 4; sh <<= 1) {
#pragma unroll
          for (int i = 0; i < 16; ++i) v[i] = __shfl_xor(top[i], sh);
          top16_merge(top, v); }
      if (sub == 0) {
#pragma unroll
          for (int q = 0; q < 4; ++q) *(int __attribute__((ext_vector_type(4)))*)(tv_s + row * 16 + 4 * q) = (int __attribute__((ext_vector_type(4)))){top[4 * q], top[4 * q + 1], top[4 * q + 2], top[4 * q + 3]}; }
    }
    PK_BAR();
    if (tid < 256) { const int it = tid >> 2, qd = tid & 3, tl = it & 7, hd = it >> 3;
      const int* r1 = tv_s + ((hd * 2 + 0) * 8 + tl) * 16; const int* r2 = tv_s + ((hd * 2 + 1) * 8 + tl) * 16;
      int c[16];
      const v4u cw = *(const v4u*)(PK_CAND + qd * 16);
#pragma unroll
      for (int t = 0; t < 16; ++t) { const int ab = (int)((cw[t >> 2] >> (8 * (t & 3))) & 0xffu); const int abc = ab != 0xff ? ab : 0;
          const float sv = sort2f(r1[abc >> 4] & ~127) + sort2f(r2[abc & 15] & ~127); const int packed = (f2sort(sv) & ~255) | (255 - ab);
          c[t] = ab != 0xff ? packed : (int)0x80000000; }
      bitonic_sort_desc<16>(c);
#pragma unroll
      for (int sh = 1; sh < 4; sh <<= 1) { int oth[16];
#pragma unroll
          for (int i = 0; i < 16; ++i) oth[i] = __shfl_xor(c[i], sh);
          top16_merge(c, oth); }
      const int tok = tb + tl;
      if (tok < tend) {
          float ev[16], sum = 0.f; const float mx = sort2f(c[0] & ~255);
#pragma unroll
          for (int k = 0; k < 16; ++k) { ev[k] = __expf(sort2f(c[k] & ~255) - mx); sum += ev[k]; }
          const float inv = 1.0f / sum;
#pragma unroll
          for (int k = 0; k < 16; ++k) if ((k >> 2) == qd) { const int ab = 255 - (c[k] & 255); const int i1 = 127 - (r1[ab >> 4] & 127), i2 = 127 - (r2[ab & 15] & 127);
              IDX[(size_t)tok * 128 + hd * 16 + k] = i1 * 128 + i2; GW[(size_t)tok * 128 + hd * 16 + k] = ev[k] * inv; }
      }
    }
    PK_BAR();
}

__device__ __forceinline__ void peer_phase(Frame& F, int tok0, int tok1) {
    const unsigned char* U6 = F.ws + WS_EU; const unsigned char* V6 = F.ws + WS_EV; const float* SU = (const float*)(F.ws + WS_EU + 32 * MiB); const float* SV = (const float*)(F.ws + WS_EV + 32 * MiB);
    const float* X2 = (const float*)(F.ws + WS_X2); const float* RS2 = (const float*)(F.ws + WS_RS2); const int* IDX = (const int*)(F.ws + WS_IDX); const float* GW = (const float*)(F.ws + WS_GW);
    const int wv = F.wave, lane = F.lane, tid = F.tid;
    float* red_s = (float*)F.lds;
    float* ss_s = (float*)(F.lds + 131072);
    const f32x4 gfin = *(const f32x4*)(F.nfg + 4 * tid);
    f32x4 x3p = {0.f, 0.f, 0.f, 0.f}; int buf = 0;
#pragma unroll 1
    for (int m = tok0; m <= tok1; ++m) {
        if (m < tok1) {
            const int myidx = IDX[(size_t)m * 128 + wv * 16 + (lane & 15)]; float myg = GW[(size_t)m * 128 + wv * 16 + (lane & 15)];
            const float mysu = SU[myidx] * RS2[m]; myg *= SV[myidx];
            float hf[32];
#pragma unroll
            for (int j = 0; j < 8; ++j) { const f32x4 w = *(const f32x4*)(X2 + (size_t)m * DM + 256 * j + 4 * lane); hf[4 * j] = w.x; hf[4 * j + 1] = w.y; hf[4 * j + 2] = w.z; hf[4 * j + 3] = w.w; }
            float acc[32];
#pragma unroll
            for (int k = 0; k < 32; ++k) acc[k] = 0.f;
#pragma unroll 1
            for (int kg = 0; kg < 4; ++kg) {
                v4u ul4[4], vl4[4]; v2u ul2[4], vl2[4]; float gk[4], su[4];
#pragma unroll
                for (int kk = 0; kk < 4; ++kk) { const int ex = __shfl(myidx, kg * 4 + kk); gk[kk] = __shfl(myg, kg * 4 + kk); su[kk] = __shfl(mysu, kg * 4 + kk);
                    const unsigned char* ur = U6 + (size_t)ex * ROW6; const unsigned char* vr = V6 + (size_t)ex * ROW6;
                    ul4[kk] = *(const v4u*)(ur + 16 * lane); ul2[kk] = *(const v2u*)(ur + 1024 + 8 * lane); vl4[kk] = *(const v4u*)(vr + 16 * lane); vl2[kk] = *(const v2u*)(vr + 1024 + 8 * lane); }
#pragma unroll
                for (int kk = 0; kk < 4; ++kk) {
                    const v32f uf = __builtin_amdgcn_cvt_scalef32_pk32_f32_fp6((v6u){ul4[kk].x, ul4[kk].y, ul4[kk].z, ul4[kk].w, ul2[kk].x, ul2[kk].y}, 1.0f);
                    float dot = 0.f;
#pragma unroll
                    for (int k = 0; k < 32; ++k) dot += uf[k] * hf[k];
                    const float a = wave_sum(dot) * su[kk];
                    const float wgt = gk[kk] * (0.5f * a * (1.0f + erff(a * 0.70710678118654752f)));
                    const v32f vf = __builtin_amdgcn_cvt_scalef32_pk32_f32_fp6((v6u){vl4[kk].x, vl4[kk].y, vl4[kk].z, vl4[kk].w, vl2[kk].x, vl2[kk].y}, 1.0f);
#pragma unroll
                    for (int k = 0; k < 32; ++k) acc[k] += wgt * vf[k];
                }
            }
#pragma unroll
            for (int j = 0; j < 8; ++j) *(f32x4*)(red_s + (buf * 8 + wv) * 2048 + 256 * j + 4 * lane) = (f32x4){acc[4 * j], acc[4 * j + 1], acc[4 * j + 2], acc[4 * j + 3]};
        }
        __syncthreads();
        if (m > tok0) {
            float tot = 0.f;
#pragma unroll
            for (int w8 = 0; w8 < 8; ++w8) tot += ss_s[(buf ^ 1) * 8 + w8];
            const float rstd = 1.0f / sqrtf(tot * (1.0f / DM) + EPS);
            *(f32x4*)(F.out + OUT_Y + (size_t)(m - 1) * DM + 4 * tid) = x3p * rstd * gfin;
        }
        if (m < tok1) {
            f32x4 x3 = *(const f32x4*)(X2 + (size_t)m * DM + 4 * tid);
#pragma unroll
            for (int w8 = 0; w8 < 8; ++w8) x3 += *(const f32x4*)(red_s + (buf * 8 + w8) * 2048 + 4 * tid);
            const float ss = wave_sum((x3.x * x3.x + x3.y * x3.y) + (x3.z * x3.z + x3.w * x3.w));
            if (lane == 0) ss_s[buf * 8 + wv] = ss;
            x3p = x3;
        }
        buf ^= 1;
    }
    __syncthreads();
}
struct Args { const float* in[18]; float* out; unsigned char* ws; int ph_lo, ph_hi; };
__global__ void __launch_bounds__(NWAVES * 64, 2) mk_fwd(Args args) {
    extern __shared__ __attribute__((aligned(16))) unsigned char lds[];
    Frame F;
    F.lds = lds;
    F.tid = threadIdx.x; F.lane = F.tid & 63; F.wave = __builtin_amdgcn_readfirstlane(F.tid >> 6);
    F.G = gridDim.x; { const int bx = blockIdx.x; F.vcu = (F.G % 8 == 0) ? (bx % 8) * (F.G / 8) + bx / 8 : bx; }
    F.xp = args.in[0]; F.xs = args.in[1]; F.sgla = args.in[2]; F.sconv = args.in[3]; F.n1g = args.in[4]; F.win = args.in[5]; F.wau = args.in[6]; F.bal = args.in[7];
    F.gng = args.in[8]; F.cw = args.in[9]; F.cb = args.in[10]; F.wout = args.in[11]; F.n2g = args.in[12]; F.wq = args.in[13]; F.sk = args.in[14]; F.eu = args.in[15];
    F.ev = args.in[16]; F.nfg = args.in[17]; F.out = args.out; F.ws = args.ws;
    for (int u = F.tid; u < (LDS_BYTES - LDSCTL_OFF) / 4; u += NWAVES * 64) ((LAS unsigned*)((LAS unsigned char*)lds + LDSCTL_OFF))[u] = 0u;
    __syncthreads();
    gu32* ctl = (gu32*)(F.ws + WS_CTL);
    XcdBarrier bar; bar.bar = (unsigned*)(ctl + CW_BAR); bar.x = 0; bar.st = nullptr;
    if (N_LAUNCHES == 1) bar = xcd_barrier_post((unsigned*)(ctl + CW_BAR), (volatile LAS unsigned*)((LAS unsigned char*)lds + MISC_OFF) + 8);
    const int lo = args.ph_lo, hi = args.ph_hi;
#ifndef SKREP
#define SKREP 1
#endif
#ifndef PROBE_DBL
#define PROBE_DBL -1
#endif
#define IN(k) (lo <= (k) && (k) < hi)
#define REP(k) for (int rep_ = 0; rep_ < ((k) == PROBE_DBL ? 2 : 1); ++rep_)
#ifndef BAR_REP
#define BAR_REP 1
#endif
#define SEAM(k) do { if (IN(k) && IN((k) + 1)) for (int br_ = 0; br_ < BAR_REP; ++br_) xcd_barrier(bar); } while (0)
    const int gw = F.vcu * NWAVES + F.wave, NGW = F.G * NWAVES;
    const int tok0 = (int)(((long)F.vcu * TT) / F.G), tok1 = (int)(((long)(F.vcu + 1) * TT) / F.G);

    if (IN(0)) REP(0) { p0_prologue(F); __syncthreads(); }
    SEAM(0);
    if (IN(1)) REP(1) {
        pg8::Gemm g{(const pg8::bf16_t*)(F.ws + WS_XN), (const pg8::bf16_t*)(F.ws + WS_WINT), TP, NP, DM}; pg8::StaticOrder S; S.init(TP, NP, F.G, (int)blockIdx.x);
        pg8::EpiBf16<0> E{(pg8::bf16_t*)(F.ws + WS_P), PLD, nullptr, 0, 0, 1.f};
        pg8::gemm_phase<pg8::EpiBf16<0>, pg8::StaticOrder, true, true>((PG8_LAS unsigned char*)lds + RING_OFF, g, S, E);
#ifdef GEMM1_TWICE
        pg8::gemm_phase<pg8::EpiBf16<0>, pg8::StaticOrder, true, true>((PG8_LAS unsigned char*)lds + RING_OFF, g, S, E);
#endif
        { EpiSkBf16 Es{(bf16*)(F.ws + WS_P) + (size_t)TP * PLD, PLD, nullptr};
          for (int skr = 0; skr < SKREP; ++skr) for (int ng = F.vcu; ng < NP / 64; ng += F.G) skinny_gemm<4>(F, (const bf16*)(F.ws + WS_XN) + (size_t)TP * DM, (const bf16*)(F.ws + WS_WINT), 64 * ng, Es); }
    }
    SEAM(1);
    if (IN(2)) REP(2) { for (int u = F.vcu; u < 512; u += F.G) gla_prep_unit(F, u); }
    SEAM(2);
    if (IN(3)) REP(3) {
        if ((F.vcu & 1) == 0) { for (int g = F.vcu >> 1; g < 128; g += (F.G + 1) >> 1) gla_main_unit<4>(F, g >> 3, g & 7); }
        volatile LAS unsigned* qslot = (volatile LAS unsigned*)((LAS unsigned char*)lds + LDSCTL_OFF + 16);
        for (;;) {
            if (F.tid == 0) *qslot = __hip_atomic_fetch_add((unsigned*)(ctl + CW_QUEUE + 64 * rep_), 1u, __ATOMIC_RELAXED, __HIP_MEMORY_SCOPE_AGENT);
            __syncthreads();
            const unsigned u = *qslot;
            __syncthreads();
            if (u >= 512u) break;
            gla_sample_unit(F, (int)u);
        }
    }
    SEAM(3);
    if (IN(4)) REP(4) {
        bf16* MM = (bf16*)(F.ws + WS_MM);
        for (int g = gw; g < TP / 4; g += NGW) mixer_rows(F, 4 * g, 4);
        for (int n = gw; n < TS; n += NGW) mixer_rows(F, TP + n, 1);
        for (int m = TT + gw; m < MP; m += NGW) zero_row_bf16(MM + (size_t)m * DM, F.lane);
    }
    SEAM(4);
    if (IN(5)) REP(5) {
        pg8::Gemm g{(const pg8::bf16_t*)(F.ws + WS_MM), (const pg8::bf16_t*)(F.ws + WS_WOUTT), TP, DM, DM}; pg8::StaticOrder S; S.init(TP, DM, F.G, (int)blockIdx.x);
        pg8::EpiF32Res E{F.xp, (float*)(F.ws + WS_X2), (pg8::bf16_t*)(F.ws + WS_H2), (float*)(F.ws + WS_SSQ), DM};
        pg8::gemm_phase<pg8::EpiF32Res, pg8::StaticOrder, true, true>((PG8_LAS unsigned char*)lds + RING_OFF, g, S, E);
#ifdef GEMM2_TWICE
        pg8::gemm_phase<pg8::EpiF32Res, pg8::StaticOrder, true, true>((PG8_LAS unsigned char*)lds + RING_OFF, g, S, E);
#endif
        { EpiSkF32Res Es{F.xs, (float*)(F.ws + WS_X2) + (size_t)TP * DM, (bf16*)(F.ws + WS_H2) + (size_t)TP * DM, (float*)(F.ws + WS_SSQS)};
          for (int skr = 0; skr < SKREP; ++skr) for (int ng = F.vcu; ng < DM / 16; ng += F.G) skinny_gemm<1>(F, (const bf16*)(F.ws + WS_MM) + (size_t)TP * DM, (const bf16*)(F.ws + WS_WOUTT), 16 * ng, Es); }
    }
    SEAM(5);
    if (IN(6)) REP(6) {
        float* rs_s = (float*)(lds + 131072);
        float* rss_s = rs_s + 512;
        float* RS2 = (float*)(F.ws + WS_RS2);
        pg8::Gemm g{(const pg8::bf16_t*)(F.ws + WS_H2), (const pg8::bf16_t*)(F.ws + WS_WQT), TP, DM, DM}; pg8::StaticOrder S; S.init(TP, DM, F.G, (int)blockIdx.x);
        { pg8::Unit u0;
          if (S.next(0, u0) && F.tid < 256) { const int row = u0.pm * 256 + F.tid; const f32x4* p = (const f32x4*)((const float*)(F.ws + WS_SSQ) + (size_t)row * 32); f32x4 a4 = p[0];
#pragma unroll
              for (int i = 1; i < 8; ++i) a4 += p[i];
              const float rstd = 1.0f / sqrtf(((a4.x + a4.y) + (a4.z + a4.w)) * (1.0f / DM) + EPS); rs_s[F.tid] = rstd; if (u0.pn == 0) RS2[row] = rstd; }
          if (F.tid >= 256 && F.tid < 384 && F.vcu < DM / 16) { const int row = F.tid - 256; const f32x4* p = (const f32x4*)((const float*)(F.ws + WS_SSQS) + (size_t)row * 128); f32x4 a4 = p[0];
#pragma unroll
              for (int i = 1; i < 32; ++i) a4 += p[i];
              const float rstd = 1.0f / sqrtf(((a4.x + a4.y) + (a4.z + a4.w)) * (1.0f / DM) + EPS); rss_s[row] = rstd; if (F.vcu == 0) RS2[TP + row] = rstd; }
          __syncthreads(); }
        pg8::EpiBf16RowScale E{(pg8::bf16_t*)(F.ws + WS_QP), DM, rs_s};
        pg8::gemm_phase<pg8::EpiBf16RowScale, pg8::StaticOrder, true, true>((PG8_LAS unsigned char*)lds + RING_OFF, g, S, E);
#ifdef GEMM3_TWICE
        pg8::gemm_phase<pg8::EpiBf16RowScale, pg8::StaticOrder, true, true>((PG8_LAS unsigned char*)lds + RING_OFF, g, S, E);
#endif
        { EpiSkBf16 Es{(bf16*)(F.ws + WS_QP) + (size_t)TP * DM, DM, rss_s};
          for (int skr = 0; skr < SKREP; ++skr) for (int ng = F.vcu; ng < DM / 16; ng += F.G) skinny_gemm<1>(F, (const bf16*)(F.ws + WS_H2) + (size_t)TP * DM, (const bf16*)(F.ws + WS_WQT), 16 * ng, Es); }
    }
    SEAM(6);
    if (IN(7)) REP(7) { bf16x8 qa[2][4]; peer_qfrags(F, tok0, qa); peer_load_subkeys(F); for (int tb = tok0; tb < tok1; tb += 8) peer_topk_tile(F, tb, tok1, qa); __syncthreads(); }
    SEAM(7);
    if (IN(8)) REP(8) { peer_phase(F, tok0, tok1); }
#undef IN
#undef SEAM
}

extern "C" void kernel_launch(void* const* d_in, const int* in_sizes, int n_in, void* d_out, int out_size, void* d_ws, size_t ws_size, hipStream_t stream) {
    static int grid = 0;
    if (grid == 0) {
        if (n_in != 18 || ws_size < WS_END) { fprintf(stderr, "kernel_launch: expected 18 inputs and >= %zu bytes of workspace; got %d, %zu\n", (size_t)WS_END, n_in, ws_size); grid = -1; return; }
        int dev = 0, cus = 0;
        if (hipGetDevice(&dev) != hipSuccess || hipDeviceGetAttribute(&cus, hipDeviceAttributeMultiprocessorCount, dev) != hipSuccess) { grid = -1; return; }
        if (hipFuncSetAttribute((const void*)mk_fwd, hipFuncAttributeMaxDynamicSharedMemorySize, LDS_BYTES) != hipSuccess) { fprintf(stderr, "kernel_launch: hipFuncSetAttribute failed\n"); grid = -1; return; }
        (void)hipGetLastError();
        grid = cus;
    }
    if (grid < 0) return;
    (void)hipMemsetAsync((char*)d_ws + WS_CTL, 0, CTL_ZERO_BYTES, stream);
    Args a{};
    for (int i = 0; i < 18; ++i) a.in[i] = (const float*)d_in[i];
    a.out = (float*)d_out; a.ws = (unsigned char*)d_ws;
    if (N_LAUNCHES == 1) { a.ph_lo = 0; a.ph_hi = N_PHASES; hipLaunchKernelGGL(mk_fwd, dim3(grid), dim3(NWAVES * 64), LDS_BYTES, stream, a); }
    else { for (int li = 0; li < N_PHASES; ++li) { a.ph_lo = li; a.ph_hi = li + 1; hipLaunchKernelGGL(mk_fwd, dim3(grid), dim3(NWAVES * 64), LDS_BYTES, stream, a); } }
}
```

```cpp
#include <hip/hip_runtime.h>
#include <cstdio>
#include <cstdint>
#include <cmath>
#define MK_N_LAUNCHES 1
namespace pg8 {
#define PG8_LAS __attribute__((address_space(3)))
typedef unsigned short bf16_t;
typedef short bf16x8 __attribute__((ext_vector_type(8)));
typedef float f32x4 __attribute__((ext_vector_type(4)));
typedef unsigned u32x4 __attribute__((ext_vector_type(4)));
constexpr int BM = 256, BK = 64, HALF = 128, HTB = HALF * BK * 2  , STAGE_BYTES = 8 * HTB, NXCD = 8, WGM = 8;

__host__ __device__ __forceinline__ int lds_byte(int r, int c) { const int st = (r >> 4) * 2 + (c >> 5), rr = r & 15, cc = c & 31, ob = rr * 64 + cc * 2; return st * 1024 + (ob ^ (((ob >> 9) & 1) << 5)); }
__host__ __device__ __forceinline__ void stage_rc(int b, int& R, int& C) { const int st = b / 1024, sb = b % 1024, swz = sb ^ (((sb >> 9) & 1) << 5); R = (st >> 1) * 16 + swz / 64; C = (st & 1) * 32 + (swz % 64) / 2; }
__host__ __device__ __forceinline__ int perm32(int rho) { const int n = rho >> 4, i = rho & 15; return 8 * (i >> 2) + 4 * n + (i & 3); }

struct Unit { int pm, pn; };
struct Gemm { const bf16_t* A; const bf16_t* Bt; int M, N, K; };

struct StaticOrder {
    int nM, nN, nwg, G, c;
    __host__ __device__ void init(int M, int N, int G_, int c_) { nM = M / BM; nN = N / BM; nwg = nM * nN; G = G_; c = c_; }
    __host__ __device__ bool next(int i, Unit& u) const {
        const long L = (long)i * G + c; if (L >= nwg) return false;
        int wgid = (int)L; { const int q = nwg / NXCD, r = nwg % NXCD, xcd = wgid % NXCD, off = wgid / NXCD; wgid = (xcd < r ? xcd * (q + 1) : r * (q + 1) + (xcd - r) * q) + off; }
        const int nig = WGM * nN, gid = wgid / nig, fm = gid * WGM, gsz = (nM - fm) < WGM ? (nM - fm) : WGM;
        u.pm = fm + ((wgid % nig) % gsz); u.pn = (wgid % nig) / gsz; return true;
    }
    __device__ __forceinline__ void a_ready(const Unit&) const {}
    __device__ __forceinline__ void done(const Unit&) const {}
};

__device__ __forceinline__ unsigned cvt_pk_bf16(float lo, float hi) { unsigned r; asm volatile("v_cvt_pk_bf16_f32 %0, %1, %2" : "=v"(r) : "v"(lo), "v"(hi)); return r; }
typedef float f32x2 __attribute__((ext_vector_type(2)));
__device__ __forceinline__ f32x2 gelu_pk(f32x2 v) {
    const f32x2 av = __builtin_elementwise_abs(v), d = av * 0.2316418882f + 1.0f;
    f32x2 t; t.x = __builtin_amdgcn_rcpf(d.x); t.y = __builtin_amdgcn_rcpf(d.y);
    f32x2 q = t * 0.5307027145f + (-0.7265760135f); q = q * t + 0.7107068705f; q = q * t + (-0.142248368f); q = q * t + 0.127414796f; q = q * t;
    const f32x2 s = (v * v) * (-0.72134752044f);
    f32x2 e; e.x = __builtin_amdgcn_exp2f(s.x); e.y = __builtin_amdgcn_exp2f(s.y);
    const f32x2 m = v * (q * e), r = v - m;
    f32x2 o; o.x = v.x < 0.f ? m.x : r.x; o.y = v.y < 0.f ? m.y : r.y; return o;
}

template <int ACT  > struct EpiBf16 {
    static constexpr bool PERM = true, AFTER_DRAIN = false; static_assert(ACT == 0 || ACT == 1, "EpiBf16: ACT is 0 (none) or 1 (gelu_pk)");
    bf16_t* O; int ldc; const float* bias; int split_cols; size_t split_stride; float scale0;
    __device__ __forceinline__ void operator()(const f32x4 (&acc)[2][2][4][2], const Unit& u, int wr, int wc, int fr, int fq) const {
        const int row0 = u.pm * BM + wr * 64 + fr; int colt = u.pn * BM; bf16_t* base = O;
        float sc = 1.f; if (split_cols) { const int t = colt / split_cols; base += (size_t)t * split_stride; colt -= t * split_cols; if (t == 0) sc = scale0; }
        const int col0 = colt + wc * 32 + 8 * fq, bcol0 = u.pn * BM + wc * 32 + 8 * fq;
        f32x4 bv[2][2];
#pragma unroll
        for (int bj = 0; bj < 2; ++bj)
#pragma unroll
            for (int n = 0; n < 2; ++n) bv[bj][n] = bias ? *(const f32x4*)(bias + bcol0 + bj * HALF + 4 * n) : (f32x4){0.f, 0.f, 0.f, 0.f};
#pragma unroll
        for (int ai = 0; ai < 2; ++ai)
#pragma unroll
            for (int m = 0; m < 4; ++m) { bf16_t* rowp = base + (size_t)(row0 + ai * HALF + m * 16) * ldc + col0;
#pragma unroll
                for (int bj = 0; bj < 2; ++bj) { f32x4 v0 = acc[ai][bj][m][0] + bv[bj][0], v1 = acc[ai][bj][m][1] + bv[bj][1];
                    if (ACT == 1) { f32x2 a = gelu_pk((f32x2){v0[0], v0[1]}), b = gelu_pk((f32x2){v0[2], v0[3]}), c = gelu_pk((f32x2){v1[0], v1[1]}), d = gelu_pk((f32x2){v1[2], v1[3]});
                        v0 = (f32x4){a.x, a.y, b.x, b.y}; v1 = (f32x4){c.x, c.y, d.x, d.y}; }
                    v0 = v0 * sc; v1 = v1 * sc; u32x4 w; w.x = cvt_pk_bf16(v0[0], v0[1]); w.y = cvt_pk_bf16(v0[2], v0[3]); w.z = cvt_pk_bf16(v1[0], v1[1]); w.w = cvt_pk_bf16(v1[2], v1[3]);
                    __builtin_nontemporal_store(w, (u32x4*)(rowp + bj * HALF)); } }
    }
};
template <class Epi, class Sched, bool ALIGN_EPI = false, bool SP2 = false>
__device__ __forceinline__ void gemm_phase(PG8_LAS unsigned char* lds, const Gemm g, const Sched& S, const Epi& E) {
    const int tid = threadIdx.x, wid = __builtin_amdgcn_readfirstlane(tid >> 6), lane = tid & 63, wr = wid >> 2, wc = wid & 3, fr = lane & 15, fq = lane >> 4;
    const int K = g.K, nt = K / BK;
    unsigned voffA[2], voffB[2];
#pragma unroll
    for (int i = 0; i < 2; ++i) { int R, C; stage_rc(tid * 16 + i * 8192, R, C); const int Rb = Epi::PERM ? ((R & ~31) + perm32(R & 31)) : R;
        voffA[i] = (unsigned)(R * K + C) * 2u; voffB[i] = (unsigned)(Rb * K + C) * 2u; }
    const size_t kstep = (size_t)(BK * 2);
    const size_t hstep = (size_t)HALF * K * 2;
    const size_t tstep = 2 * hstep;
    const unsigned ldsw = (unsigned)wid * 1024u;
    const int aoff = lds_byte(wr * 64 + fr, fq * 8), boff = lds_byte(wc * 32 + fr, fq * 8);
#define PG8_SA(b, h) (((b) * 2 + (h)) * HTB)
#define PG8_SB(b, h) ((4 + (b) * 2 + (h)) * HTB)
#define PG8_STAGE(bufoff, gbase, voff) do { _Pragma("unroll") for (int _i = 0; _i < 2; ++_i) \
        __builtin_amdgcn_global_load_lds((const unsigned*)((const char*)(gbase) + (voff)[_i]), (PG8_LAS unsigned*)(lds + (bufoff) + ldsw + _i * 8192), 16, 0, 0); } while (0)
#define PG8_LDA(dst, b, h) do { _Pragma("unroll") for (int m = 0; m < 4; ++m) _Pragma("unroll") for (int k = 0; k < 2; ++k) dst[m][k] = *(const PG8_LAS bf16x8*)(lds + PG8_SA(b, h) + aoff + m * 2048 + k * 1024); } while (0)
#define PG8_LDB(dst, b, h) do { _Pragma("unroll") for (int n = 0; n < 2; ++n) _Pragma("unroll") for (int k = 0; k < 2; ++k) dst[n][k] = *(const PG8_LAS bf16x8*)(lds + PG8_SB(b, h) + boff + n * 2048 + k * 1024); } while (0)
#define PG8_MMA(ai, bj, At, Bt) do { __builtin_amdgcn_s_setprio(1); _Pragma("unroll") for (int m = 0; m < 4; ++m) _Pragma("unroll") for (int n = 0; n < 2; ++n) _Pragma("unroll") for (int k = 0; k < 2; ++k) \
        acc[ai][bj][m][n] = __builtin_amdgcn_mfma_f32_16x16x32_bf16(Bt[n][k], At[m][k], acc[ai][bj][m][n], 0, 0, 0); __builtin_amdgcn_s_setprio(0); } while (0)
#define PG8_WAIT_V(n) asm volatile("s_waitcnt vmcnt(" #n ")" ::: "memory")
#define PG8_WAIT_L(n) asm volatile("s_waitcnt lgkmcnt(" #n ")" ::: "memory")
#define PG8_BAR __builtin_amdgcn_s_barrier()
#define PG8_SCHED __builtin_amdgcn_sched_barrier(0)
    Unit cur, nxt; int ui = 0;
    if (!S.next(0, cur)) return;
    f32x4 acc[2][2][4][2];
#pragma unroll
    for (int a = 0; a < 2; ++a)
#pragma unroll
        for (int b = 0; b < 2; ++b)
#pragma unroll
            for (int m = 0; m < 4; ++m)
#pragma unroll
                for (int n = 0; n < 2; ++n) acc[a][b][m][n] = (f32x4){0.f, 0.f, 0.f, 0.f};
    bf16x8 At[4][2], B0[2][2], B1[2][2];
    const char* cA = (const char*)g.A + (size_t)cur.pm * tstep; const char* cB = (const char*)g.Bt + (size_t)cur.pn * tstep;
    S.a_ready(cur);
    if constexpr (SP2) {
        PG8_STAGE(PG8_SB(0, 0), cB, voffB); PG8_STAGE(PG8_SB(0, 1), cB + hstep, voffB); PG8_STAGE(PG8_SA(0, 0), cA, voffA); PG8_STAGE(PG8_SA(0, 1), cA + hstep, voffA);
        if (wr == 1) PG8_BAR;
        PG8_WAIT_V(2); PG8_BAR;
        PG8_STAGE(PG8_SB(1, 0), cB + kstep, voffB); PG8_STAGE(PG8_SA(1, 0), cA + kstep, voffA); PG8_STAGE(PG8_SB(1, 1), cB + hstep + kstep, voffB);
        PG8_WAIT_V(6); PG8_BAR;
    } else {
        PG8_STAGE(PG8_SB(0, 0), cB, voffB); PG8_STAGE(PG8_SA(0, 0), cA, voffA); PG8_STAGE(PG8_SB(0, 1), cB + hstep, voffB); PG8_STAGE(PG8_SA(0, 1), cA + hstep, voffA);
        if (wr == 1) PG8_BAR;
        PG8_WAIT_V(4); PG8_BAR;
        PG8_STAGE(PG8_SB(1, 0), cB + kstep, voffB); PG8_STAGE(PG8_SA(1, 0), cA + kstep, voffA); PG8_STAGE(PG8_SB(1, 1), cB + hstep + kstep, voffB);
        PG8_WAIT_V(6); PG8_BAR;
    }
    for (;;) {
        const bool has_next = S.next(ui + 1, nxt);
        const char* nA = has_next ? (const char*)g.A + (size_t)nxt.pm * tstep : cA; const char* nB = has_next ? (const char*)g.Bt + (size_t)nxt.pn * tstep : cB;
        for (int t = 0; t < nt; t += 2) {
            const bool last = (t == nt - 2);
            const char* a1 = cA + (size_t)(t + 1) * kstep;
            const char* a2 = last ? nA : cA + (size_t)(t + 2) * kstep; const char* b2 = last ? nB : cB + (size_t)(t + 2) * kstep;
            const char* a3 = a2 + kstep; const char* b3 = b2 + kstep;
            if (last && has_next) S.a_ready(nxt);
            if constexpr (SP2) {
            PG8_LDB(B0, 0, 0); PG8_LDB(B1, 0, 1); PG8_SCHED; PG8_LDA(At, 0, 0); PG8_STAGE(PG8_SA(1, 1), a1 + hstep, voffA);
            PG8_WAIT_V(8); PG8_WAIT_L(0); PG8_BAR; PG8_MMA(0, 0, At, B0); PG8_MMA(0, 1, At, B1); PG8_BAR; PG8_SCHED;
            PG8_LDA(At, 0, 1); PG8_STAGE(PG8_SB(0, 0), b2, voffB); PG8_STAGE(PG8_SB(0, 1), b2 + hstep, voffB); PG8_STAGE(PG8_SA(0, 0), a2, voffA);
            PG8_WAIT_V(8); PG8_WAIT_L(0); PG8_BAR; PG8_MMA(1, 0, At, B0); PG8_MMA(1, 1, At, B1); PG8_BAR; PG8_SCHED;
            PG8_LDB(B0, 1, 0); PG8_LDB(B1, 1, 1); PG8_SCHED; PG8_LDA(At, 1, 0); PG8_STAGE(PG8_SA(0, 1), a2 + hstep, voffA);
            PG8_WAIT_V(8); PG8_WAIT_L(0); PG8_BAR; PG8_MMA(0, 0, At, B0); PG8_MMA(0, 1, At, B1); PG8_BAR; PG8_SCHED;
            PG8_LDA(At, 1, 1); PG8_STAGE(PG8_SB(1, 0), b3, voffB); PG8_STAGE(PG8_SB(1, 1), b3 + hstep, voffB); PG8_STAGE(PG8_SA(1, 0), a3, voffA);
            PG8_WAIT_V(8); PG8_WAIT_L(0); PG8_BAR; PG8_MMA(1, 0, At, B0); PG8_MMA(1, 1, At, B1); PG8_BAR; PG8_SCHED;
            } else {
            PG8_LDB(B0, 0, 0); PG8_SCHED; PG8_LDA(At, 0, 0); PG8_STAGE(PG8_SA(1, 1), a1 + hstep, voffA);
            PG8_WAIT_L(8); PG8_BAR; PG8_WAIT_L(0); PG8_MMA(0, 0, At, B0); PG8_BAR; PG8_SCHED;
            PG8_LDB(B1, 0, 1); PG8_STAGE(PG8_SB(0, 0), b2, voffB);
            PG8_BAR; PG8_WAIT_L(0); PG8_MMA(0, 1, At, B1); PG8_BAR;
            PG8_LDA(At, 0, 1); PG8_STAGE(PG8_SA(0, 0), a2, voffA);
            PG8_BAR; PG8_WAIT_L(0); PG8_MMA(1, 0, At, B0); PG8_BAR; PG8_SCHED;
            PG8_STAGE(PG8_SB(0, 1), b2 + hstep, voffB);
            PG8_WAIT_V(6); PG8_BAR; PG8_MMA(1, 1, At, B1); PG8_BAR;
            PG8_LDB(B0, 1, 0); PG8_SCHED; PG8_LDA(At, 1, 0); PG8_STAGE(PG8_SA(0, 1), a2 + hstep, voffA);
            PG8_WAIT_L(8); PG8_BAR; PG8_WAIT_L(0); PG8_MMA(0, 0, At, B0); PG8_BAR; PG8_SCHED;
            PG8_LDB(B1, 1, 1); PG8_STAGE(PG8_SB(1, 0), b3, voffB);
            PG8_BAR; PG8_WAIT_L(0); PG8_MMA(0, 1, At, B1); PG8_BAR;
            PG8_LDA(At, 1, 1); PG8_STAGE(PG8_SA(1, 0), a3, voffA);
            PG8_BAR; PG8_WAIT_L(0); PG8_MMA(1, 0, At, B0); PG8_BAR; PG8_SCHED;
            PG8_STAGE(PG8_SB(1, 1), b3 + hstep, voffB);
            PG8_WAIT_V(6); PG8_BAR; PG8_MMA(1, 1, At, B1); PG8_BAR;
            }
        }
        if constexpr (ALIGN_EPI) { if (wr == 0) PG8_BAR; }
        if constexpr (!Epi::AFTER_DRAIN) { E(acc, cur, wr, wc, fr, fq); S.done(cur); }
        if (!has_next) break;
#pragma unroll
        for (int a = 0; a < 2; ++a)
#pragma unroll
            for (int b = 0; b < 2; ++b)
#pragma unroll
                for (int m = 0; m < 4; ++m)
#pragma unroll
                    for (int n = 0; n < 2; ++n) acc[a][b][m][n] = (f32x4){0.f, 0.f, 0.f, 0.f};
        cur = nxt; cA = nA; cB = nB; ++ui;
        if constexpr (ALIGN_EPI) { if (wr == 1) PG8_BAR; }
    }
    PG8_WAIT_V(0);
    if constexpr (!ALIGN_EPI) { if (wr == 0) PG8_BAR; }
    PG8_BAR;
    if constexpr (Epi::AFTER_DRAIN) { E.fused(acc, cur, wr, wc, fr, fq, lds, wid, lane); S.done(cur); }
#undef PG8_SA
#undef PG8_SB
#undef PG8_STAGE
#undef PG8_LDA
#undef PG8_LDB
#undef PG8_MMA
#undef PG8_WAIT_V
#undef PG8_WAIT_L
#undef PG8_BAR
#undef PG8_SCHED
}
}
namespace pg8 {
__device__ __forceinline__ unsigned f2bf_(float f) { unsigned u = __builtin_bit_cast(unsigned, f); return (u + 0x7fffu + ((u >> 16) & 1u)) >> 16; }
struct EpiF32Res {
    static constexpr bool PERM = false, AFTER_DRAIN = false;
    const float* xp; float* out; bf16_t* outb; float* ssq; int ldc;
    __device__ __forceinline__ void operator()(const f32x4 (&acc)[2][2][4][2], const Unit& u, int wr, int wc, int fr, int fq) const {
        const int col0 = u.pn * BM + wc * 32 + 4 * fq;
#pragma unroll
        for (int ai = 0; ai < 2; ++ai)
#pragma unroll
            for (int m = 0; m < 4; ++m) {
                const int row = u.pm * BM + ai * HALF + wr * 64 + m * 16 + fr;
                const float* src = xp + (size_t)row * ldc; float* dst = out + (size_t)row * ldc; bf16_t* dstb = outb + (size_t)row * ldc;
                float s = 0.f;
#pragma unroll
                for (int bj = 0; bj < 2; ++bj)
#pragma unroll
                    for (int n = 0; n < 2; ++n) { const int c = col0 + bj * HALF + n * 16; const f32x4 v = *(const f32x4*)(src + c) + acc[ai][bj][m][n]; *(f32x4*)(dst + c) = v;
                        s += (v[0] * v[0] + v[1] * v[1]) + (v[2] * v[2] + v[3] * v[3]);
                        unsigned w0 = f2bf_(v[0]) | (f2bf_(v[1]) << 16), w1 = f2bf_(v[2]) | (f2bf_(v[3]) << 16);
                        typedef unsigned u32x2 __attribute__((ext_vector_type(2))); *(u32x2*)(dstb + c) = (u32x2){w0, w1}; }
                s += __shfl_xor(s, 16); s += __shfl_xor(s, 32);
                if (fq == 0) ssq[(size_t)row * 32 + u.pn * 4 + wc] = s;
            }
    }
};
struct EpiBf16RowScale {
    static constexpr bool PERM = true, AFTER_DRAIN = false;
    bf16_t* O; int ldc; const float* rs;
    __device__ __forceinline__ void operator()(const f32x4 (&acc)[2][2][4][2], const Unit& u, int wr, int wc, int fr, int fq) const {
        const int row0 = u.pm * BM + wr * 64 + fr, col0 = u.pn * BM + wc * 32 + 8 * fq;
#pragma unroll
        for (int ai = 0; ai < 2; ++ai)
#pragma unroll
            for (int m = 0; m < 4; ++m) { const int rl = wr * 64 + fr + ai * HALF + m * 16; const float sc = rs[rl]; bf16_t* rowp = O + (size_t)(row0 + ai * HALF + m * 16) * ldc + col0;
#pragma unroll
                for (int bj = 0; bj < 2; ++bj) { const f32x4 v0 = acc[ai][bj][m][0] * sc, v1 = acc[ai][bj][m][1] * sc;
                    u32x4 w; w.x = cvt_pk_bf16(v0[0], v0[1]); w.y = cvt_pk_bf16(v0[2], v0[3]); w.z = cvt_pk_bf16(v1[0], v1[1]); w.w = cvt_pk_bf16(v1[2], v1[3]);
                    *(u32x4*)(rowp + bj * HALF) = w; } }
    }
};
}

#ifndef MK_N_LAUNCHES
#define MK_N_LAUNCHES 1
#endif
constexpr int N_PHASES = 9;
constexpr int N_LAUNCHES = MK_N_LAUNCHES;
constexpr int NWAVES = 8;

constexpr int DM = 2048;
constexpr int TP = 8192, TS = 128, TT = TP + TS;
constexpr int MP = 8448;
constexpr int NP = 16384;
constexpr int PLD = NP + 64;
constexpr int C_Q = 0, C_K = 1024, C_V = 2048, C_R = 4096, C_CB = 6144, C_CC = 8192, C_CX = 10240, C_GA = 12288, C_GB = 14336;
constexpr int DIN = 16400;
constexpr int NEXP = 16384;
constexpr float EPS = 1e-6f;

constexpr size_t MiB = 1u << 20;
constexpr size_t WS_CTL = 0, CTL_ZERO_BYTES = 1 * MiB;
constexpr size_t WS_WINT = 2 * MiB;
constexpr size_t WS_WOUTT = 68 * MiB;
constexpr size_t WS_WQT = 76 * MiB;
constexpr size_t WS_EU = 84 * MiB;
constexpr size_t WS_EV = 148 * MiB;
constexpr size_t WS_XN = 212 * MiB;
constexpr size_t WS_P = 246 * MiB;
constexpr size_t WS_QT = 516 * MiB;
constexpr size_t WS_KT = 532 * MiB;
constexpr size_t WS_VT = 548 * MiB;
constexpr size_t WS_ATT = 580 * MiB;
constexpr size_t WS_EBL = 584 * MiB;
constexpr size_t WS_SKB = 585 * MiB;
constexpr size_t WS_O = 586 * MiB;
constexpr size_t WS_MM = 620 * MiB;
constexpr size_t WS_X2 = 654 * MiB;
constexpr size_t WS_H2 = 720 * MiB;
constexpr size_t WS_SSQ = 799 * MiB;
constexpr size_t WS_QP = 754 * MiB;
constexpr size_t WS_IDX = 788 * MiB;
constexpr size_t WS_GW = 793 * MiB;
constexpr size_t WS_ALR = 798 * MiB;
constexpr size_t WS_SSQS = 799 * MiB + 1100 * 1024;
constexpr size_t WS_RS2 = 799 * MiB + 1200 * 1024;
constexpr size_t WS_END = 801 * MiB;
constexpr int CW_TMO = 0, CW_CODE = 1, CW_BAR = 4096, CW_QUEUE = 16384;

constexpr size_t OUT_Y = 0;
constexpr size_t OUT_GLAP = (size_t)TT * DM;
constexpr size_t OUT_CONVP = OUT_GLAP + (size_t)4 * 4 * 256 * 512;
constexpr size_t OUT_GLAS = OUT_CONVP + (size_t)4 * 2 * 2048;
constexpr size_t OUT_CONVS = OUT_GLAS + (size_t)128 * 4 * 256 * 512;

constexpr int LDS_BYTES = 163840;
constexpr int LDSCTL_OFF = 162816, MISC_OFF = LDSCTL_OFF + 320;
constexpr int RING_OFF = 0;

#define GAS __attribute__((address_space(1)))
#define LAS __attribute__((address_space(3)))
typedef unsigned short bf16;
typedef unsigned v4u __attribute__((ext_vector_type(4)));
typedef unsigned v2u __attribute__((ext_vector_type(2)));
typedef float f32x4 __attribute__((ext_vector_type(4)));
typedef short bf16x8 __attribute__((ext_vector_type(8)));
typedef GAS unsigned gu32;
typedef float v32f __attribute__((ext_vector_type(32)));
typedef float v16f __attribute__((ext_vector_type(16)));
typedef unsigned v6u __attribute__((ext_vector_type(6)));
constexpr int ROW6 = 1536;
#define RLX_AGENT __ATOMIC_RELAXED, __HIP_MEMORY_SCOPE_AGENT
#define LDS_WAIT() asm volatile("s_waitcnt lgkmcnt(0)" ::: "memory")
#define VM_WAIT() asm volatile("s_waitcnt vmcnt(0)" ::: "memory")
#define MFMA16(a, b, c) __builtin_amdgcn_mfma_f32_16x16x32_bf16((a), (b), (c), 0, 0, 0)
__device__ __forceinline__ unsigned f2bf(float f) { unsigned u = __builtin_bit_cast(unsigned, f); return (u + 0x7fffu + ((u >> 16) & 1u)) >> 16; }
__device__ __forceinline__ unsigned pk2(float lo, float hi) { return f2bf(lo) | (f2bf(hi) << 16); }
__device__ __forceinline__ float bf2f(unsigned b) { return __builtin_bit_cast(float, b << 16); }
__device__ __forceinline__ float bflo(unsigned w) { return __builtin_bit_cast(float, w << 16); }
__device__ __forceinline__ float bfhi(unsigned w) { return __builtin_bit_cast(float, w & 0xffff0000u); }
__device__ __forceinline__ void unpack8(const v4u w, float (&f)[8]) { f[0] = bflo(w.x); f[1] = bfhi(w.x); f[2] = bflo(w.y); f[3] = bfhi(w.y); f[4] = bflo(w.z); f[5] = bfhi(w.z); f[6] = bflo(w.w); f[7] = bfhi(w.w); }
__device__ __forceinline__ v4u pack8(const float (&f)[8]) { v4u w; w.x = pk2(f[0], f[1]); w.y = pk2(f[2], f[3]); w.z = pk2(f[4], f[5]); w.w = pk2(f[6], f[7]); return w; }
__device__ __forceinline__ float wave_sum(float v) {
#pragma unroll
    for (int o = 1; o < 64; o <<= 1) v += __shfl_xor(v, o);
    return v;
}
__device__ __forceinline__ float sigmoidf_(float x) { return 1.0f / (1.0f + __expf(-x)); }
#define XB_TMO      128
#define XB_XCNT(j)  (256  + 64 * (j))
#define XB_XSUB(j)  (1280 + 64 * (j))
#define XB_XGEN(j)  (2304 + 64 * (j))
#define XB_TOP      3328
#define XB_TOPGEN   3392
#define XCD_BAR_WORDS 3456
#define XB_SPIN_CAP (1u << 18)

__device__ __forceinline__ unsigned xb_ld(unsigned* p)              { return __hip_atomic_load(p, __ATOMIC_RELAXED, __HIP_MEMORY_SCOPE_AGENT); }
__device__ __forceinline__ unsigned xb_add(unsigned* p, unsigned v) { return __hip_atomic_fetch_add(p, v, __ATOMIC_RELAXED, __HIP_MEMORY_SCOPE_AGENT); }
__device__ __forceinline__ unsigned xb_xcc_id() { return (unsigned)__builtin_amdgcn_s_getreg((3 << 11) | 20) & 0xFu; }
#define XB_SPIN(cond, bar) do { unsigned _sp = 0; while (cond) { __builtin_amdgcn_s_sleep(1); \
    if ((++_sp & 255u) == 0u) { if (xb_ld(&(bar)[XB_TMO])) break; if (_sp > XB_SPIN_CAP) { atomicAdd(&(bar)[XB_TMO], 1u); break; } } } } while (0)

struct XcdBarrier {
    unsigned* bar; unsigned x;
    volatile LAS unsigned* st;
};

__device__ __forceinline__ XcdBarrier xcd_barrier_post(unsigned* bar, volatile LAS unsigned* st) {
    XcdBarrier b; b.bar = bar; b.x = xb_xcc_id(); b.st = st;
    if (threadIdx.x == 0) (void)xb_add(&bar[XB_XCNT(b.x)], 1u);
    return b;
}
__device__ __forceinline__ void xcd_barrier_complete(unsigned* bar, unsigned x, unsigned& nloc, unsigned& nx) {
    const unsigned G = gridDim.x * gridDim.y * gridDim.z;
    unsigned sum, cnt, mine, sp = 0u;
    for (;;) {
        sum = 0u; cnt = 0u; mine = 0u;
#pragma unroll
        for (unsigned j = 0; j < 16; ++j) { const unsigned c = xb_ld(&bar[XB_XCNT(j)]); sum += c; cnt += (c > 0u) ? 1u : 0u; mine = (j == x) ? c : mine; }
        if (sum == G) break;
        __builtin_amdgcn_s_sleep(1);
        if ((++sp & 255u) == 0u) { if (xb_ld(&bar[XB_TMO])) break; if (sp > XB_SPIN_CAP) { atomicAdd(&bar[XB_TMO], 1u); break; } }
    }
    nloc = mine > 0u ? mine : 1u; nx = cnt > 0u ? cnt : 1u;
}

__device__ __forceinline__ void xcd_barrier(const XcdBarrier& b) {
    asm volatile("s_waitcnt vmcnt(0)" ::: "memory");
    __syncthreads();
    if (threadIdx.x == 0) {
        unsigned* bar = b.bar;
        __builtin_amdgcn_s_waitcnt(0);
        unsigned nloc = b.st[0], nx = b.st[1];
        if (nloc == 0u) { xcd_barrier_complete(bar, b.x, nloc, nx); b.st[0] = nloc; b.st[1] = nx; }
        const unsigned old = xb_add(&bar[XB_XSUB(b.x)], 1u);
        const unsigned gen = old / nloc;
        if (old + 1u == (gen + 1u) * nloc) {
            __builtin_amdgcn_fence(__ATOMIC_RELEASE, "agent");
            asm volatile("s_waitcnt vmcnt(0)" ::: "memory");
            const unsigned og = xb_add(&bar[XB_TOP], 1u);
            const unsigned tg = og / nx;
            if (og + 1u == (tg + 1u) * nx) xb_add(&bar[XB_TOPGEN], 1u);
            else XB_SPIN(xb_ld(&bar[XB_TOPGEN]) == tg, bar);
            __builtin_amdgcn_fence(__ATOMIC_ACQUIRE, "agent");
            xb_add(&bar[XB_XGEN(b.x)], 1u);
            asm volatile("s_waitcnt vmcnt(0)" ::: "memory");
        } else {
            XB_SPIN(xb_ld(&bar[XB_XGEN(b.x)]) == gen, bar);
            __builtin_amdgcn_fence(__ATOMIC_ACQUIRE, "agent");
            asm volatile("s_waitcnt vmcnt(0)" ::: "memory");
        }
    }
    __syncthreads();
}
struct Frame {
    unsigned char* lds;
    int tid, lane, wave, vcu, G;
    const float *xp, *xs, *sgla, *sconv, *n1g, *win, *wau, *bal, *gng, *cw, *cb, *wout, *n2g, *wq, *sk, *eu, *ev, *nfg;
    float* out;
    unsigned char* ws;
};

__device__ __forceinline__ void p0_transpose_item(const float* W, int ldw, int src_col0, int k0, bf16* WT, int K, int dst_row0, float* scr, int lane, const float* kscale = nullptr) {
    const int n4 = lane & 15, kr = lane >> 4;
#pragma unroll 8
    for (int i = 0; i < 16; ++i) { const int kk = 4 * i + kr; f32x4 v = __builtin_nontemporal_load((const f32x4*)(W + (size_t)(k0 + kk) * ldw + src_col0 + 4 * n4)); if (kscale) v = v * kscale[k0 + kk];
        float* d = scr + kk * 65 + 4 * n4; d[0] = v.x; d[1] = v.y; d[2] = v.z; d[3] = v.w; }
    LDS_WAIT(); asm volatile("" ::: "memory");
    const int c = lane & 7, nr = lane >> 3;
#pragma unroll
    for (int j = 0; j < 8; ++j) { const int n = nr + 8 * j; const float* s = scr + (8 * c) * 65 + n;
        v4u o; o.x = pk2(s[0 * 65], s[1 * 65]); o.y = pk2(s[2 * 65], s[3 * 65]); o.z = pk2(s[4 * 65], s[5 * 65]); o.w = pk2(s[6 * 65], s[7 * 65]);
        *(v4u*)(WT + (size_t)(dst_row0 + n) * K + k0 + 8 * c) = o; }
    LDS_WAIT(); asm volatile("" ::: "memory");
}
__device__ __forceinline__ void rms_row_to_bf16(const float* xrow, const float* g, bf16* orow, int lane) {
    const f32x4* xr = (const f32x4*)xrow + lane; const f32x4* gr = (const f32x4*)g + lane;
    f32x4 v[8]; float s = 0.f;
#pragma unroll
    for (int j = 0; j < 8; ++j) { v[j] = __builtin_nontemporal_load(xr + 64 * j); s += (v[j].x * v[j].x + v[j].y * v[j].y) + (v[j].z * v[j].z + v[j].w * v[j].w); }
    const float rstd = 1.0f / sqrtf(wave_sum(s) * (1.0f / DM) + EPS);
    v2u* o8 = (v2u*)orow + lane;
#pragma unroll
    for (int j = 0; j < 8; ++j) { const f32x4 gg = gr[64 * j]; v2u w; w.x = pk2(v[j].x * rstd * gg.x, v[j].y * rstd * gg.y); w.y = pk2(v[j].z * rstd * gg.z, v[j].w * rstd * gg.w); o8[64 * j] = w; }
}
__device__ __forceinline__ void zero_row_bf16(bf16* orow, int lane) {
    v2u* o8 = (v2u*)orow + lane; const v2u z = {0u, 0u};
#pragma unroll
    for (int j = 0; j < 8; ++j) o8[64 * j] = z;
}
__device__ __forceinline__ void p0_prologue(Frame& F) {
    bf16* WINT = (bf16*)(F.ws + WS_WINT); bf16* WOUTT = (bf16*)(F.ws + WS_WOUTT); bf16* WQT = (bf16*)(F.ws + WS_WQT);
    float* scr = (float*)(F.lds + F.wave * 16640);
    const int gw = F.vcu * NWAVES + F.wave, NGW = F.G * NWAVES;
    constexpr int I_IN = 32 * 256, I_SQ = 32 * 32;
    for (int it = gw; it < I_IN + 2 * I_SQ; it += NGW) {
        int r = it;
        if (r < I_IN) { const int kb = r >> 8, nb = r & 255, n0 = 64 * nb; p0_transpose_item(F.win, DIN, n0 + (n0 >= 6144 ? 16 : 0), 64 * kb, WINT, DM, n0, scr, F.lane); continue; }
        r -= I_IN;
        if (r < I_SQ) { const int kb = r >> 5, nb = r & 31; p0_transpose_item(F.wout, DM, 64 * nb, 64 * kb, WOUTT, DM, 64 * nb, scr, F.lane); continue; }
        r -= I_SQ;
        { const int kb = r >> 5, nb = r & 31; p0_transpose_item(F.wq, DM, 64 * nb, 64 * kb, WQT, DM, 64 * nb, scr, F.lane, F.n2g); }
    }
    const size_t gt = (size_t)F.vcu * 512 + F.tid, NGT = (size_t)F.G * 512;
    { bf16* SKB = (bf16*)(F.ws + WS_SKB); for (size_t e = gt; e < (size_t)2 * 128 * 128; e += NGT) SKB[e] = (bf16)f2bf(F.sk[e]); }
    { unsigned char* U6 = F.ws + WS_EU; unsigned char* V6 = F.ws + WS_EV; float* SU = (float*)(F.ws + WS_EU + 32 * MiB); float* SV = (float*)(F.ws + WS_EV + 32 * MiB);
      for (int r = gw; r < 2 * NEXP; r += NGW) {
          const bool isv = r >= NEXP; const int row = isv ? r - NEXP : r;
          const float* src = (isv ? F.ev : F.eu) + (size_t)row * DM;
          f32x4 x[8]; float amax = 0.f;
#pragma unroll
          for (int j = 0; j < 8; ++j) { x[j] = __builtin_nontemporal_load((const f32x4*)(src + 256 * j + 4 * F.lane)); if (!isv) x[j] = x[j] * *(const f32x4*)(F.n2g + 256 * j + 4 * F.lane);
              amax = fmaxf(amax, fmaxf(fmaxf(fabsf(x[j].x), fabsf(x[j].y)), fmaxf(fabsf(x[j].z), fabsf(x[j].w)))); }
#pragma unroll
          for (int o = 1; o < 64; o <<= 1) amax = fmaxf(amax, __shfl_xor(amax, o));
          const float sc = amax > 0.f ? 7.5f / amax : 1.0f;
          v16f pa, pb;
#pragma unroll
          for (int j = 0; j < 8; ++j) { pa[2 * j] = x[j].x * sc; pb[2 * j] = x[j].y * sc; pa[2 * j + 1] = x[j].z * sc; pb[2 * j + 1] = x[j].w * sc; }
          const v6u p = __builtin_amdgcn_cvt_scalef32_2xpk16_fp6_f32(pa, pb, 1.0f);
          unsigned char* dst2 = (isv ? V6 : U6) + (size_t)row * ROW6;
          __builtin_nontemporal_store((v4u){p[0], p[1], p[2], p[3]}, (v4u*)(dst2 + 16 * F.lane)); __builtin_nontemporal_store((v2u){p[4], p[5]}, (v2u*)(dst2 + 1024 + 8 * F.lane));
          if (F.lane == 0) (isv ? SV : SU)[row] = amax > 0.f ? amax / 7.5f : 1.0f;
      } }
    __syncthreads();
    { bf16* wt_s = (bf16*)F.lds; constexpr int WLD = DM + 8;
      for (int k = F.tid; k < DM; k += 512) { const float* src = F.win + (size_t)k * DIN + 6144;
#pragma unroll
          for (int q = 0; q < 4; ++q) { const f32x4 w4 = *(const f32x4*)(src + 4 * q); wt_s[(4 * q + 0) * WLD + k] = (bf16)f2bf(w4.x); wt_s[(4 * q + 1) * WLD + k] = (bf16)f2bf(w4.y); wt_s[(4 * q + 2) * WLD + k] = (bf16)f2bf(w4.z); wt_s[(4 * q + 3) * WLD + k] = (bf16)f2bf(w4.w); } }
      bf16* XN = (bf16*)(F.ws + WS_XN); float* ALR = (float*)(F.ws + WS_ALR);
      const int r0 = (int)(((long)F.vcu * TT) / F.G), r1 = (int)(((long)(F.vcu + 1) * TT) / F.G);
      for (int m = r0 + F.wave; m < r1; m += NWAVES) rms_row_to_bf16(m < TP ? F.xp + (size_t)m * DM : F.xs + (size_t)(m - TP) * DM, F.n1g, XN + (size_t)m * DM, F.lane);
      for (int m = TT + gw; m < MP; m += NGW) zero_row_bf16(XN + (size_t)m * DM, F.lane);
      VM_WAIT(); __syncthreads();
      const int l15 = F.lane & 15, lq = F.lane >> 4;
      for (int t0 = r0 + 16 * F.wave; t0 < r1; t0 += 16 * NWAVES) {
          const int row = min(t0 + l15, r1 - 1);
          f32x4 acc = {0.f, 0.f, 0.f, 0.f};
#pragma unroll 8
          for (int ks = 0; ks < 64; ++ks) { const bf16x8 a = *(const bf16x8*)(XN + (size_t)row * DM + 32 * ks + 8 * lq); const bf16x8 bq = *(const bf16x8*)(wt_s + l15 * WLD + 32 * ks + 8 * lq); acc = MFMA16(a, bq, acc); }
#pragma unroll
          for (int r = 0; r < 4; ++r) { const int m = t0 + 4 * lq + r; if (m < r1) ALR[(size_t)m * 16 + l15] = acc[r]; }
      } }
}

template <int NT, class Epi>
__device__ __forceinline__ void skinny_gemm(Frame& F, const bf16* A, const bf16* Bt, int n0, const Epi& E) {
    constexpr int ROWS = NT * 16, NPC = (ROWS * 32 + 511) / 512, BLD = 264;
    bf16* Bs = (bf16*)F.lds;
    const int tid = F.tid, wv = F.wave, l15 = F.lane & 15, lq = F.lane >> 4;
    f32x4 acc[NT];
#pragma unroll
    for (int nt = 0; nt < NT; ++nt) acc[nt] = (f32x4){0.f, 0.f, 0.f, 0.f};
    const bf16* Arow = A + (size_t)(16 * wv + l15) * DM + 8 * lq;
    v4u bX[NPC], bY[NPC]; bf16x8 aX[8], aY[8];
#define SK_LOADB(BR, kc) do { _Pragma("unroll") for (int i = 0; i < NPC; ++i) { const int p = tid + 512 * i; if (p < ROWS * 32) BR[i] = *(const v4u*)(Bt + (size_t)(n0 + (p >> 5)) * DM + (kc) * 256 + 8 * (p & 31)); } } while (0)
#define SK_LOADA(AR, kc) do { _Pragma("unroll") for (int ks = 0; ks < 8; ++ks) AR[ks] = *(const bf16x8*)(Arow + (kc) * 256 + 32 * ks); } while (0)
#define SK_STOREB(BR, kc) do { bf16* Bn = Bs + ((kc) & 1) * ROWS * BLD; _Pragma("unroll") for (int i = 0; i < NPC; ++i) { const int p = tid + 512 * i; if (p < ROWS * 32) *(v4u*)(Bn + (p >> 5) * BLD + 8 * (p & 31)) = BR[i]; } } while (0)
#define SK_COMP(AR, kc) do { const bf16* Bc = Bs + ((kc) & 1) * ROWS * BLD; _Pragma("unroll") for (int ks = 0; ks < 8; ++ks) _Pragma("unroll") for (int nt = 0; nt < NT; ++nt) { \
        const bf16x8 bq = *(const bf16x8*)(Bc + (16 * nt + l15) * BLD + 32 * ks + 8 * lq); acc[nt] = MFMA16(AR[ks], bq, acc[nt]); } } while (0)
    SK_LOADB(bX, 0); SK_LOADA(aX, 0); SK_LOADB(bY, 1); SK_LOADA(aY, 1);
    SK_STOREB(bX, 0);
    __syncthreads();
#pragma unroll 1
    for (int kc = 0; kc < 8; kc += 2) {
        SK_LOADB(bX, kc + 2 < 8 ? kc + 2 : 7);
        SK_COMP(aX, kc); SK_LOADA(aX, kc + 2 < 8 ? kc + 2 : 7);
        SK_STOREB(bY, kc + 1);
        __syncthreads();
        SK_LOADB(bY, kc + 3 < 8 ? kc + 3 : 7);
        SK_COMP(aY, kc + 1); SK_LOADA(aY, kc + 3 < 8 ? kc + 3 : 7);
        SK_STOREB(bX, kc + 2);
        __syncthreads();
    }
#undef SK_LOADB
#undef SK_LOADA
#undef SK_STOREB
#undef SK_COMP
    E.template tile<NT>(acc, wv, l15, lq, n0);
}
struct EpiSkBf16 { bf16* out; int ldc; const float* rs;
    template <int NT> __device__ __forceinline__ void tile(const f32x4 (&acc)[NT], int wv, int l15, int lq, int n0) const {
#pragma unroll
        for (int r = 0; r < 4; ++r) { const int row = 16 * wv + 4 * lq + r; const float sc = rs ? rs[row] : 1.0f;
#pragma unroll
            for (int nt = 0; nt < NT; ++nt) out[(size_t)row * ldc + n0 + 16 * nt + l15] = (bf16)f2bf(acc[nt][r] * sc); } } };
struct EpiSkF32Res { const float* xs; float* out; bf16* outb; float* ssqs;
    template <int NT> __device__ __forceinline__ void tile(const f32x4 (&acc)[NT], int wv, int l15, int lq, int n0) const {
        static_assert(NT == 1, "one 16-column group");
#pragma unroll
        for (int r = 0; r < 4; ++r) { const int row = 16 * wv + 4 * lq + r; const size_t o = (size_t)row * DM + n0 + l15; const float v = xs[o] + acc[0][r]; out[o] = v; outb[o] = (bf16)f2bf(v);
            float s = v * v; s += __shfl_xor(s, 1); s += __shfl_xor(s, 2); s += __shfl_xor(s, 4); s += __shfl_xor(s, 8);
            if (l15 == 0) ssqs[row * 128 + (n0 >> 4)] = s; } } };

__device__ __forceinline__ float logsig(float x) { return fminf(x, 0.f) - __logf(1.0f + __expf(-fabsf(x))); }
__device__ __forceinline__ void gla_prep_unit(Frame& F, int u) {
    const bf16* P = (const bf16*)(F.ws + WS_P); bf16* QT = (bf16*)(F.ws + WS_QT); bf16* KT = (bf16*)(F.ws + WS_KT); bf16* VT = (bf16*)(F.ws + WS_VT);
    bf16* ATT = (bf16*)(F.ws + WS_ATT); float* EBL = (float*)(F.ws + WS_EBL);
    const int b = u >> 7, h = (u >> 5) & 3, c = u & 31, tid = F.tid;
    const int row0 = b * 2048 + c * 64;
    float* alr_s = (float*)F.lds;
    float* tot_s = (float*)(F.lds + 4096);
    bf16* q_s = (bf16*)(F.lds + 8192);
    bf16* k_s = q_s + 64 * 264;
    bf16* v_s = k_s + 64 * 264;
    bf16* a_s = v_s + 64 * 520;
    { v4u tq[4], tk[4], tv[8];
#pragma unroll
      for (int i = 0; i < 4; ++i) { const int p = tid + 512 * i, row = p >> 5, ch = p & 31; const bf16* src = P + (size_t)(row0 + row) * PLD + h * 256 + 8 * ch; tq[i] = __builtin_nontemporal_load((const v4u*)(src + C_Q)); tk[i] = __builtin_nontemporal_load((const v4u*)(src + C_K)); }
#pragma unroll
      for (int i = 0; i < 8; ++i) { const int p = tid + 512 * i, row = p >> 6, ch = p & 63; tv[i] = __builtin_nontemporal_load((const v4u*)(P + (size_t)(row0 + row) * PLD + C_V + h * 512 + 8 * ch)); }
      for (int e = tid; e < 1024; e += 512) alr_s[e] = ((const float*)(F.ws + WS_ALR))[(size_t)row0 * 16 + e];
#pragma unroll
      for (int i = 0; i < 4; ++i) { const int p = tid + 512 * i, row = p >> 5, ch = p & 31; *(v4u*)(q_s + row * 264 + 8 * ch) = tq[i]; *(v4u*)(k_s + row * 264 + 8 * ch) = tk[i]; }
#pragma unroll
      for (int i = 0; i < 8; ++i) { const int p = tid + 512 * i, row = p >> 6, ch = p & 63; *(v4u*)(v_s + row * 520 + 8 * ch) = tv[i]; } }
    const int d = tid & 255, half = tid >> 8;
    float w[16];
#pragma unroll
    for (int r = 0; r < 16; ++r) w[r] = F.wau[r * 1024 + h * 256 + d];
    const float bias = F.bal[h * 256 + d];
    __syncthreads();
    float bb[32]; float run = 0.f;
#pragma unroll
    for (int jj = 0; jj < 32; ++jj) { const int j = half * 32 + jj; float x = bias;
#pragma unroll
        for (int r = 0; r < 16; ++r) x += alr_s[j * 16 + r] * w[r];
        run += logsig(x) * 0.0625f; bb[jj] = run; }
    if (half == 0) tot_s[d] = run;
    __syncthreads();
    if (half == 1) { const float t = tot_s[d];
#pragma unroll
        for (int jj = 0; jj < 32; ++jj) bb[jj] += t; }
#pragma unroll
    for (int jj = 0; jj < 32; ++jj) { const int j = half * 32 + jj;
        const float qv = bf2f(q_s[j * 264 + d]), kv = bf2f(k_s[j * 264 + d]);
        const float e = __expf(bb[jj]), ei = __expf(-bb[jj]);
        q_s[j * 264 + d] = (bf16)f2bf(qv * 0.0625f * e); k_s[j * 264 + d] = (bf16)f2bf(kv * ei); }
    if (half == 1) EBL[u * 256 + d] = __expf(bb[31]);
    __syncthreads();
    { const int wv = F.wave, l15 = F.lane & 15, lq = F.lane >> 4, mi = wv >> 1;
#pragma unroll
      for (int nn = 0; nn < 2; ++nn) { const int ni = (wv & 1) * 2 + nn; f32x4 acc = {0.f, 0.f, 0.f, 0.f};
#pragma unroll
          for (int ks = 0; ks < 8; ++ks) { const bf16x8 a = *(const bf16x8*)(q_s + (16 * mi + l15) * 264 + 32 * ks + 8 * lq); const bf16x8 bq = *(const bf16x8*)(k_s + (16 * ni + l15) * 264 + 32 * ks + 8 * lq); acc = MFMA16(a, bq, acc); }
#pragma unroll
          for (int r = 0; r < 4; ++r) { const int i = 16 * mi + 4 * lq + r, jn = 16 * ni + l15; a_s[i * 72 + jn] = (bf16)f2bf(jn <= i ? acc[r] : 0.f); } } }
#pragma unroll
    for (int i = 0; i < 4; ++i) { const int p = tid + 512 * i, f = p >> 6, ln = p & 63, l15 = ln & 15, lq = ln >> 4;
        { const int mi = f >> 3, kh = (f >> 2) & 1, ks = f & 3; *(v4u*)(QT + (size_t)u * 16384 + (size_t)p * 8) = *(const v4u*)(q_s + (16 * mi + l15) * 264 + 128 * kh + 32 * ks + 8 * lq); }
        { const int wv2 = f >> 2, t2 = (f >> 1) & 1, ks = f & 1, dd = 32 * wv2 + 16 * t2 + l15, j0 = 32 * ks + 8 * lq; v4u o;
          o.x = (unsigned)k_s[(j0 + 0) * 264 + dd] | ((unsigned)k_s[(j0 + 1) * 264 + dd] << 16); o.y = (unsigned)k_s[(j0 + 2) * 264 + dd] | ((unsigned)k_s[(j0 + 3) * 264 + dd] << 16);
          o.z = (unsigned)k_s[(j0 + 4) * 264 + dd] | ((unsigned)k_s[(j0 + 5) * 264 + dd] << 16); o.w = (unsigned)k_s[(j0 + 6) * 264 + dd] | ((unsigned)k_s[(j0 + 7) * 264 + dd] << 16);
          *(v4u*)(KT + (size_t)u * 16384 + (size_t)p * 8) = o; } }
    __syncthreads();
    { const int p = tid, f = p >> 6, ln = p & 63, l15 = ln & 15, lq = ln >> 4, mi = f >> 1, kh = f & 1;
      *(v4u*)(ATT + (size_t)u * 4096 + (size_t)p * 8) = *(const v4u*)(a_s + (16 * mi + l15) * 72 + 32 * kh + 8 * lq); }
    { const int dv = tid; unsigned vp[32];
#pragma unroll
      for (int j = 0; j < 64; ++j) { const unsigned v = v_s[j * 520 + dv]; if (j & 1) vp[j >> 1] |= v << 16; else vp[j >> 1] = v; }
      v4u* dst = (v4u*)(VT + ((size_t)u * 512 + dv) * 64);
#pragma unroll
      for (int i = 0; i < 8; ++i) { v4u o; o.x = vp[4 * i]; o.y = vp[4 * i + 1]; o.z = vp[4 * i + 2]; o.w = vp[4 * i + 3]; dst[i] = o; } }
    __syncthreads();
}

__device__ __forceinline__ void gla_sample_unit(Frame& F, int u) {
    const bf16* P = (const bf16*)(F.ws + WS_P); bf16* O = (bf16*)(F.ws + WS_O);
    const int n = u >> 2, h = u & 3, tid = F.tid, lane = F.lane, wv = F.wave;
    const size_t m = (size_t)(TP + n);
    float* e_s = (float*)F.lds;
    float* qe_s = e_s + 256;
    float* k_s = qe_s + 256;
    float* v_s = k_s + 256;
    float* red_s = v_s + 512;
    float* op_s = red_s + 64;
    float part = 0.f;
    if (tid < 256) { const int d = tid; float x = F.bal[h * 256 + d];
#pragma unroll
        for (int r = 0; r < 16; ++r) x += ((const float*)(F.ws + WS_ALR))[m * 16 + r] * F.wau[r * 1024 + h * 256 + d];
        const float la = logsig(x) * 0.0625f, e = __expf(la);
        const float q = bf2f(P[m * PLD + C_Q + h * 256 + d]) * 0.0625f, k = bf2f(P[m * PLD + C_K + h * 256 + d]);
        e_s[d] = e; qe_s[d] = q * e; k_s[d] = k; part = q * k; }
    v_s[tid] = bf2f(P[m * PLD + C_V + h * 512 + tid]);
    part = wave_sum(part);
    if (lane == 0) red_s[wv] = part;
    __syncthreads();
    const float attn = (red_s[0] + red_s[1]) + (red_s[2] + red_s[3]);
    const float* Sin = F.sgla + ((size_t)(n * 4 + h) * 256) * 512; float* Sout = F.out + OUT_GLAS + ((size_t)(n * 4 + h) * 256) * 512;
    const f32x4 v0 = *(const f32x4*)(v_s + 4 * lane), v1 = *(const f32x4*)(v_s + 256 + 4 * lane);
    f32x4 o0 = {0.f, 0.f, 0.f, 0.f}, o1 = {0.f, 0.f, 0.f, 0.f};
#pragma unroll 1
    for (int g = 0; g < 4; ++g) {
        f32x4 s0[8], s1[8];
#pragma unroll
        for (int i = 0; i < 8; ++i) { const int d = 32 * wv + 8 * g + i; s0[i] = __builtin_nontemporal_load((const f32x4*)(Sin + (size_t)d * 512 + 4 * lane)); s1[i] = __builtin_nontemporal_load((const f32x4*)(Sin + (size_t)d * 512 + 256 + 4 * lane)); }
#pragma unroll
        for (int i = 0; i < 8; ++i) { const int d = 32 * wv + 8 * g + i; const float e = e_s[d], qe = qe_s[d], k = k_s[d];
            o0 += s0[i] * qe; o1 += s1[i] * qe;
            __builtin_nontemporal_store(s0[i] * e + v0 * k, (f32x4*)(Sout + (size_t)d * 512 + 4 * lane)); __builtin_nontemporal_store(s1[i] * e + v1 * k, (f32x4*)(Sout + (size_t)d * 512 + 256 + 4 * lane)); }
    }
    *(f32x4*)(op_s + wv * 512 + 4 * lane) = o0; *(f32x4*)(op_s + wv * 512 + 256 + 4 * lane) = o1;
    __syncthreads();
    { float o = attn * v_s[tid];
#pragma unroll
      for (int w8 = 0; w8 < 8; ++w8) o += op_s[w8 * 512 + tid];
      O[m * DM + h * 512 + tid] = (bf16)f2bf(o); }
    __syncthreads();
}

struct GlaRegs { bf16x8 kt[2][2], at, q[4]; v4u vpiece; float epiece; };
struct GlaOffs { unsigned l16, vt, eb; };
template <int NT>
__device__ __forceinline__ GlaOffs gla_offs(int lane, int tid) {
    const int tv = tid & (NT * 128 - 1); GlaOffs o;
    o.l16 = (unsigned)(lane * 16);
    o.vt = (unsigned)(((tv >> 3) * 64 + 8 * (tv & 7)) * 2);
    o.eb = (unsigned)((tid & 255) * 4);
    return o;
}
template <int NT>
__device__ __forceinline__ void gla_load(GlaRegs& R, const GlaOffs& o, const bf16* QT, const bf16* KT, const bf16* VT, const bf16* ATT, const float* EBL, int bh, int s, int c, int wv) {
    const size_t u = (size_t)bh * 32 + c;
    const char* pa = (const char*)(ATT + u * 4096) + wv * 1024; const char* pv = (const char*)(VT + (u * 512 + 16 * NT * s) * 64);
    const char* pq = (const char*)(QT + u * 16384) + wv * 4096; const char* pk = (const char*)(KT + u * 16384) + wv * 4096;
    R.at = *(const bf16x8*)(pa + o.l16);
    R.vpiece = *(const v4u*)(pv + o.vt);
    R.epiece = *(const float*)((const char*)(EBL + u * 256) + o.eb);
#pragma unroll
    for (int ks = 0; ks < 4; ++ks) R.q[ks] = *(const bf16x8*)(pq + o.l16 + 1024 * ks);
#pragma unroll
    for (int t = 0; t < 2; ++t)
#pragma unroll
        for (int ks = 0; ks < 2; ++ks) R.kt[t][ks] = *(const bf16x8*)(pk + o.l16 + 2048 * t + 1024 * ks);
}
constexpr int VT_LD = 72;
template <int NT>
__device__ __forceinline__ void gla_step(const GlaRegs& R, const float* ebs, f32x4 (&S)[2][NT], const bf16* vts, const bf16* STp, bf16* STn, float* xo, int wv, int lane, int l15, int lq) {
    const int mi = wv >> 1, kh = wv & 1;
#pragma unroll
    for (int nt = 0; nt < NT; ++nt) {
        f32x4 acc = {0.f, 0.f, 0.f, 0.f};
        { const bf16x8 vsel = *(const bf16x8*)(vts + (16 * nt + l15) * VT_LD + 32 * kh + 8 * lq); acc = MFMA16(R.at, vsel, acc); }
#pragma unroll
        for (int ks = 0; ks < 4; ++ks) { const bf16x8 sf = *(const bf16x8*)(STp + (16 * nt + l15) * 264 + 128 * kh + 32 * ks + 8 * lq); acc = MFMA16(R.q[ks], sf, acc); }
        *(f32x4*)(xo + (((mi * 2 + kh) * NT + nt) * 64 + lane) * 4) = acc;
    }
#pragma unroll
    for (int nt = 0; nt < NT; ++nt) {
        bf16x8 vt[2];
#pragma unroll
        for (int ks = 0; ks < 2; ++ks) vt[ks] = *(const bf16x8*)(vts + (16 * nt + l15) * VT_LD + 32 * ks + 8 * lq);
#pragma unroll
        for (int mt = 0; mt < 2; ++mt) {
#pragma unroll
            for (int ks = 0; ks < 2; ++ks) S[mt][nt] = MFMA16(R.kt[mt][ks], vt[ks], S[mt][nt]);
            S[mt][nt] = S[mt][nt] * *(const f32x4*)(ebs + 32 * wv + 16 * mt + 4 * lq);
            v2u w; w.x = pk2(S[mt][nt][0], S[mt][nt][1]); w.y = pk2(S[mt][nt][2], S[mt][nt][3]);
            *(v2u*)(STn + (16 * nt + l15) * 264 + 32 * wv + 16 * mt + 4 * lq) = w; } }
}
template <int NT>
__device__ __forceinline__ void gla_store_o(const float* xo, bf16* O, int b, int h, int s, int c, int wv, int lane, int l15, int lq) {
    const int mi = wv >> 1;
#pragma unroll
    for (int nt = 0; nt < NT; ++nt) { const f32x4 t = *(const f32x4*)(xo + (((mi * 2 + 0) * NT + nt) * 64 + lane) * 4) + *(const f32x4*)(xo + (((mi * 2 + 1) * NT + nt) * 64 + lane) * 4);
#pragma unroll
        for (int r = 0; r < 4; ++r) O[((size_t)b * 2048 + 64 * c + 16 * mi + 4 * lq + r) * DM + h * 512 + 16 * NT * s + 16 * nt + l15] = (bf16)f2bf(t[r]); }
}
#define GLA_BAR() do { asm volatile("s_waitcnt lgkmcnt(0)" ::: "memory"); __builtin_amdgcn_s_barrier(); asm volatile("" ::: "memory"); } while (0)
template <int NT>
__device__ __forceinline__ void gla_main_unit(Frame& F, int bh, int s) {
    const bf16* QT = (const bf16*)(F.ws + WS_QT); const bf16* KT = (const bf16*)(F.ws + WS_KT); const bf16* VT = (const bf16*)(F.ws + WS_VT);
    const bf16* ATT = (const bf16*)(F.ws + WS_ATT); const float* EBL = (const float*)(F.ws + WS_EBL); bf16* O = (bf16*)(F.ws + WS_O);
    const int b = bh >> 2, h = bh & 3, wv = F.wave, lane = F.lane, l15 = lane & 15, lq = lane >> 4, kh = wv & 1, tid = F.tid;
    constexpr int ST_ELEMS = NT * 16 * 264, XO_FLOATS = 8 * NT * 256, VTS_ELEMS = NT * 16 * VT_LD;
    bf16* ST = (bf16*)F.lds;
    float* XO = (float*)(F.lds + 2 * ST_ELEMS * 2);
    bf16* VTS = (bf16*)(F.lds + 2 * ST_ELEMS * 2 + 2 * XO_FLOATS * 4);
    float* EBS = (float*)(F.lds + 2 * ST_ELEMS * 2 + 2 * XO_FLOATS * 4 + 2 * VTS_ELEMS * 2);
    for (int e = tid; e < ST_ELEMS; e += 512) ((unsigned*)ST)[e] = 0u;
    f32x4 S[2][NT];
#pragma unroll
    for (int a = 0; a < 2; ++a)
#pragma unroll
        for (int c2 = 0; c2 < NT; ++c2) S[a][c2] = (f32x4){0.f, 0.f, 0.f, 0.f};
    const GlaOffs go = gla_offs<NT>(lane, tid);
    GlaRegs RA, RB, RC;
    gla_load<NT>(RA, go, QT, KT, VT, ATT, EBL, bh, s, 0, wv);
    gla_load<NT>(RB, go, QT, KT, VT, ATT, EBL, bh, s, 1, wv);
    if (tid < NT * 128) *(v4u*)(VTS + (tid >> 3) * VT_LD + 8 * (tid & 7)) = RA.vpiece;
    if (tid < 256) EBS[tid] = RA.epiece;
    __syncthreads();
#define GLA_ITER(c, RCUR, RNXT, RLD) do { if ((c) < 32) { \
            gla_load<NT>(RLD, go, QT, KT, VT, ATT, EBL, bh, s, (c) + 2 < 32 ? (c) + 2 : 31, wv); \
            gla_step<NT>(RCUR, EBS + ((c) & 1) * 256, S, VTS + ((c) & 1) * VTS_ELEMS, ST + ((c) & 1) * ST_ELEMS, ST + (((c) + 1) & 1) * ST_ELEMS, XO + ((c) & 1) * XO_FLOATS, wv, lane, l15, lq); \
            if (!kh && (c) > 0) gla_store_o<NT>(XO + (((c) + 1) & 1) * XO_FLOATS, O, b, h, s, (c) - 1, wv, lane, l15, lq); \
            if (tid < NT * 128) *(v4u*)(VTS + (((c) + 1) & 1) * VTS_ELEMS + (tid >> 3) * VT_LD + 8 * (tid & 7)) = RNXT.vpiece; \
            if (tid < 256) EBS[(((c) + 1) & 1) * 256 + tid] = RNXT.epiece; \
            GLA_BAR(); \
        } } while (0)
#pragma unroll 1
    for (int c = 0; c < 33; c += 3) { GLA_ITER(c, RA, RB, RC); GLA_ITER(c + 1, RB, RC, RA); GLA_ITER(c + 2, RC, RA, RB); }
#undef GLA_ITER
    if (!kh) gla_store_o<NT>(XO + (31 & 1) * XO_FLOATS, O, b, h, s, 31, wv, lane, l15, lq);
    int lq2 = lq; asm volatile("" : "+v"(lq2));
    float* So = F.out + OUT_GLAP + ((size_t)bh * 256) * 512;
#pragma unroll
    for (int mt = 0; mt < 2; ++mt)
#pragma unroll
        for (int nt = 0; nt < NT; ++nt)
#pragma unroll
            for (int r = 0; r < 4; ++r) So[(size_t)(32 * wv + 16 * mt + 4 * lq2 + r) * 512 + 16 * NT * s + 16 * nt + l15] = S[mt][nt][r];
    __syncthreads();
}

__device__ __forceinline__ void mixer_rows(Frame& F, int m0, int nr) {
    const bf16* P = (const bf16*)(F.ws + WS_P); const bf16* O = (const bf16*)(F.ws + WS_O); bf16* MM = (bf16*)(F.ws + WS_MM);
    const int lane = F.lane; const bool prompt = m0 < TP;
#pragma unroll 1
    for (int j = 0; j < 4; ++j) {
        const int col = 512 * j + 8 * lane;
        float u1[8], u2[8], gn[8], cbi[8], w0[8], w1[8], w2[8];
        { const f32x4 a = *(const f32x4*)(F.gng + col), b2 = *(const f32x4*)(F.gng + col + 4); gn[0] = a.x; gn[1] = a.y; gn[2] = a.z; gn[3] = a.w; gn[4] = b2.x; gn[5] = b2.y; gn[6] = b2.z; gn[7] = b2.w; }
        { const f32x4 a = *(const f32x4*)(F.cb + col), b2 = *(const f32x4*)(F.cb + col + 4); cbi[0] = a.x; cbi[1] = a.y; cbi[2] = a.z; cbi[3] = a.w; cbi[4] = b2.x; cbi[5] = b2.y; cbi[6] = b2.z; cbi[7] = b2.w; }
        { const f32x4 a = *(const f32x4*)(F.cw + col), b2 = *(const f32x4*)(F.cw + col + 4); w0[0] = a.x; w0[1] = a.y; w0[2] = a.z; w0[3] = a.w; w0[4] = b2.x; w0[5] = b2.y; w0[6] = b2.z; w0[7] = b2.w; }
        { const f32x4 a = *(const f32x4*)(F.cw + DM + col), b2 = *(const f32x4*)(F.cw + DM + col + 4); w1[0] = a.x; w1[1] = a.y; w1[2] = a.z; w1[3] = a.w; w1[4] = b2.x; w1[5] = b2.y; w1[6] = b2.z; w1[7] = b2.w; }
        { const f32x4 a = *(const f32x4*)(F.cw + 2 * DM + col), b2 = *(const f32x4*)(F.cw + 2 * DM + col + 4); w2[0] = a.x; w2[1] = a.y; w2[2] = a.z; w2[3] = a.w; w2[4] = b2.x; w2[5] = b2.y; w2[6] = b2.z; w2[7] = b2.w; }
        if (prompt) {
            const int t0 = m0 & 2047; const bf16* Pr = P + (size_t)m0 * PLD;
            if (t0 >= 1) { float a[8], b2[8]; unpack8(*(const v4u*)(Pr - PLD + C_CC + col), a); unpack8(*(const v4u*)(Pr - PLD + C_CX + col), b2);
#pragma unroll
                for (int e = 0; e < 8; ++e) u1[e] = a[e] * b2[e]; }
            else {
#pragma unroll
                for (int e = 0; e < 8; ++e) u1[e] = 0.f; }
            if (t0 >= 2) { float a[8], b2[8]; unpack8(*(const v4u*)(Pr - 2 * PLD + C_CC + col), a); unpack8(*(const v4u*)(Pr - 2 * PLD + C_CX + col), b2);
#pragma unroll
                for (int e = 0; e < 8; ++e) u2[e] = a[e] * b2[e]; }
            else {
#pragma unroll
                for (int e = 0; e < 8; ++e) u2[e] = 0.f; }
        } else {
            const int n = m0 - TP; const float* sc = F.sconv + (size_t)n * 2 * DM + col;
            const f32x4 a0 = *(const f32x4*)sc, a1 = *(const f32x4*)(sc + 4), b0 = *(const f32x4*)(sc + DM), b1 = *(const f32x4*)(sc + DM + 4);
            u2[0] = a0.x; u2[1] = a0.y; u2[2] = a0.z; u2[3] = a0.w; u2[4] = a1.x; u2[5] = a1.y; u2[6] = a1.z; u2[7] = a1.w;
            u1[0] = b0.x; u1[1] = b0.y; u1[2] = b0.z; u1[3] = b0.w; u1[4] = b1.x; u1[5] = b1.y; u1[6] = b1.z; u1[7] = b1.w;
        }
#pragma unroll 1
        for (int r = 0; r < nr; ++r) {
            const int m = m0 + r; const bf16* Pr = P + (size_t)m * PLD;
            float o[8], rr[8], cbv[8], cc[8], cx[8], ga[8], gb[8], u[8];
            unpack8(*(const v4u*)(O + (size_t)m * DM + col), o);
            unpack8(__builtin_nontemporal_load((const v4u*)(Pr + C_R + col)), rr); unpack8(__builtin_nontemporal_load((const v4u*)(Pr + C_CB + col)), cbv); unpack8(__builtin_nontemporal_load((const v4u*)(Pr + C_CC + col)), cc); unpack8(__builtin_nontemporal_load((const v4u*)(Pr + C_CX + col)), cx);
            unpack8(__builtin_nontemporal_load((const v4u*)(Pr + C_GA + col)), ga); unpack8(__builtin_nontemporal_load((const v4u*)(Pr + C_GB + col)), gb);
            float ss = 0.f;
#pragma unroll
            for (int e = 0; e < 8; ++e) ss += o[e] * o[e];
            const float rstd = 1.0f / sqrtf(wave_sum(ss) * (1.0f / 512.0f) + EPS);
#pragma unroll
            for (int e = 0; e < 8; ++e) u[e] = cc[e] * cx[e];
            if (prompt) { const int t = m & 2047;
                if (t >= 2046) { float* dst = F.out + OUT_CONVP + ((size_t)(m >> 11) * 2 + (t - 2046)) * DM + col;
                    *(f32x4*)dst = (f32x4){u[0], u[1], u[2], u[3]}; *(f32x4*)(dst + 4) = (f32x4){u[4], u[5], u[6], u[7]}; }
            } else { float* dst = F.out + OUT_CONVS + (size_t)(m - TP) * 2 * DM + col;
                *(f32x4*)dst = (f32x4){u1[0], u1[1], u1[2], u1[3]}; *(f32x4*)(dst + 4) = (f32x4){u1[4], u1[5], u1[6], u1[7]};
                *(f32x4*)(dst + DM) = (f32x4){u[0], u[1], u[2], u[3]}; *(f32x4*)(dst + DM + 4) = (f32x4){u[4], u[5], u[6], u[7]}; }
            float mv[8];
#pragma unroll
            for (int e = 0; e < 8; ++e) {
                const float ya = (rr[e] * sigmoidf_(rr[e])) * (o[e] * rstd * gn[e]);
                const float z = cbi[e] + w0[e] * u2[e] + w1[e] * u1[e] + w2[e] * u[e];
                mv[e] = sigmoidf_(ga[e]) * ya + sigmoidf_(gb[e]) * (cbv[e] * z);
                u2[e] = u1[e]; u1[e] = u[e];
            }
            *(v4u*)(MM + (size_t)m * DM + col) = pack8(mv);
        }
    }
}

constexpr int SC_LD = 130;
__device__ __forceinline__ int f2sort(float f) { const int b = __float_as_int(f); return b ^ ((b >> 31) & 0x7fffffff); }
__device__ __forceinline__ float sort2f(int s) { return __int_as_float(s ^ ((s >> 31) & 0x7fffffff)); }
#define CE_DESC(x, y) do { const int mx_ = max(x, y), mn_ = min(x, y); x = mx_; y = mn_; } while (0)
template <int N> __device__ __forceinline__ void bitonic_sort_desc(int (&a)[N]) {
#pragma unroll
    for (int k = 2; k <= N; k <<= 1)
#pragma unroll
        for (int j = k >> 1; j > 0; j >>= 1)
#pragma unroll
            for (int i = 0; i < N; ++i) { const int l = i ^ j; if (l > i) { if ((i & k) == 0) CE_DESC(a[i], a[l]); else CE_DESC(a[l], a[i]); } }
}
template <int N> __device__ __forceinline__ void bitonic_merge_desc(int (&a)[N]) {
#pragma unroll
    for (int j = N >> 1; j > 0; j >>= 1)
#pragma unroll
        for (int i = 0; i < N; ++i) { const int l = i ^ j; if (l > i) CE_DESC(a[i], a[l]); }
}
__device__ __forceinline__ void top16_merge(int (&a)[16], const int (&b)[16]) {
#pragma unroll
    for (int i = 0; i < 16; ++i) a[i] = max(a[i], b[15 - i]);
    bitonic_merge_desc<16>(a);
}
__device__ __attribute__((aligned(16))) const unsigned char PK_CAND[64] = {
    0x00, 0x01, 0x02, 0x03, 0x04, 0x05, 0x06, 0x07, 0x08, 0x09, 0x0a, 0x0b, 0x0c, 0x0d, 0x0e, 0x0f,
    0x10, 0x11, 0x12, 0x13, 0x14, 0x15, 0x16, 0x17, 0x20, 0x21, 0x22, 0x23, 0x24, 0x50, 0x51, 0xff,
    0x30, 0x31, 0x32, 0x33, 0x40, 0x41, 0x42, 0x60, 0x61, 0x70, 0x71, 0xff, 0xff, 0xff, 0xff, 0xff,
    0x80, 0x90, 0xa0, 0xb0, 0xc0, 0xd0, 0xe0, 0xf0, 0xff, 0xff, 0xff, 0xff, 0xff, 0xff, 0xff, 0xff};
constexpr int SC8_LD = 132, SK_LD = 136;
constexpr int SC8_BYTES = 128 * SC8_LD * 4, TV8_OFF = SC8_BYTES, SK_OFF = TV8_OFF + 128 * 16 * 4;
__device__ __forceinline__ void peer_load_subkeys(Frame& F) {
    const bf16* SKB = (const bf16*)(F.ws + WS_SKB); bf16* sk_s = (bf16*)(F.lds + SK_OFF);
    for (int e = F.tid; e < 256 * 16; e += 512) { const int row = e >> 4, ch = e & 15; *(v4u*)(sk_s + row * SK_LD + 8 * ch) = *(const v4u*)(SKB + (size_t)row * 128 + 8 * ch); }
    __syncthreads();
}
__device__ __forceinline__ void peer_qfrags(Frame& F, int tb, bf16x8 (&a)[2][4]) {
    const bf16* QP = (const bf16*)(F.ws + WS_QP); const int tok = min(tb + (F.lane & 7), TT - 1), lq = F.lane >> 4;
#pragma unroll
    for (int hf = 0; hf < 2; ++hf)
#pragma unroll
        for (int ks = 0; ks < 4; ++ks) a[hf][ks] = *(const bf16x8*)(QP + (size_t)tok * DM + F.wave * 256 + hf * 128 + 32 * ks + 8 * lq);
}
#define PK_BAR() do { asm volatile("s_waitcnt lgkmcnt(0)" ::: "memory"); __builtin_amdgcn_s_barrier(); asm volatile("" ::: "memory"); } while (0)
__device__ __forceinline__ void peer_topk_tile(Frame& F, int tb, int tend, bf16x8 (&a)[2][4]) {
    int* IDX = (int*)(F.ws + WS_IDX); float* GW = (float*)(F.ws + WS_GW);
    float* sc_s = (float*)F.lds;
    int* tv_s = (int*)(F.lds + TV8_OFF);
    const bf16* sk_s = (const bf16*)(F.lds + SK_OFF);
    const int wv = F.wave, lane = F.lane, l15 = lane & 15, lq = lane >> 4, tid = F.tid;
    {
#pragma unroll
      for (int hf = 0; hf < 2; ++hf) {
#pragma unroll
          for (int nt = 0; nt < 8; ++nt) { f32x4 acc = {0.f, 0.f, 0.f, 0.f};
#pragma unroll
              for (int ks = 0; ks < 4; ++ks) { const bf16x8 bq = *(const bf16x8*)(sk_s + (hf * 128 + 16 * nt + l15) * SK_LD + 32 * ks + 8 * lq); acc = MFMA16(a[hf][ks], bq, acc); }
              if (lq < 2) {
#pragma unroll
                  for (int r = 0; r < 4; ++r) sc_s[((wv * 2 + hf) * 8 + 4 * lq + r) * SC8_LD + 16 * nt + l15] = acc[r]; } } } }
    if (tb + 8 < tend) peer_qfrags(F, tb + 8, a);
    PK_BAR();
    { const int row = tid >> 2, sub = tid & 3; const float* rp = sc_s + row * SC8_LD;
      int top[16], v[16];
#pragma unroll
      for (int i = 0; i < 16; ++i) { const int key = 4 * i + sub; top[i] = (f2sort(rp[key]) & ~127) | (127 - key); }
      bitonic_sort_desc<16>(top);
#pragma unroll
      for (int i = 0; i < 16; ++i) { const int key = 4 * (16 + i) + sub; v[i] = (f2sort(rp[key]) & ~127) | (127 - key); }
      bitonic_sort_desc<16>(v);
      top16_merge(top, v);
#pragma unroll
      for (int sh = 1; sh < 4; sh <<= 1) {
#pragma unroll
          for (int i = 0; i < 16; ++i) v[i] = __shfl_xor(top[i], sh);
          top16_merge(top, v); }
      if (sub == 0) {
#pragma unroll
          for (int q = 0; q < 4; ++q) *(int __attribute__((ext_vector_type(4)))*)(tv_s + row * 16 + 4 * q) = (int __attribute__((ext_vector_type(4)))){top[4 * q], top[4 * q + 1], top[4 * q + 2], top[4 * q + 3]}; }
    }
    PK_BAR();
    if (tid < 256) { const int it = tid >> 2, qd = tid & 3, tl = it & 7, hd = it >> 3;
      const int* r1 = tv_s + ((hd * 2 + 0) * 8 + tl) * 16; const int* r2 = tv_s + ((hd * 2 + 1) * 8 + tl) * 16;
      int c[16];
      const v4u cw = *(const v4u*)(PK_CAND + qd * 16);
#pragma unroll
      for (int t = 0; t < 16; ++t) { const int ab = (int)((cw[t >> 2] >> (8 * (t & 3))) & 0xffu); const int abc = ab != 0xff ? ab : 0;
          const float sv = sort2f(r1[abc >> 4] & ~127) + sort2f(r2[abc & 15] & ~127); const int packed = (f2sort(sv) & ~255) | (255 - ab);
          c[t] = ab != 0xff ? packed : (int)0x80000000; }
      bitonic_sort_desc<16>(c);
#pragma unroll
      for (int sh = 1; sh < 4; sh <<= 1) { int oth[16];
#pragma unroll
          for (int i = 0; i < 16; ++i) oth[i] = __shfl_xor(c[i], sh);
          top16_merge(c, oth); }
      const int tok = tb + tl;
      if (tok < tend) {
          float ev[16], sum = 0.f; const float mx = sort2f(c[0] & ~255);
#pragma unroll
          for (int k = 0; k < 16; ++k) { ev[k] = __expf(sort2f(c[k] & ~255) - mx); sum += ev[k]; }
          const float inv = 1.0f / sum;
#pragma unroll
          for (int k = 0; k < 16; ++k) if ((k >> 2) == qd) { const int ab = 255 - (c[k] & 255); const int i1 = 127 - (r1[ab >> 4] & 127), i2 = 127 - (r2[ab & 15] & 127);
              IDX[(size_t)tok * 128 + hd * 16 + k] = i1 * 128 + i2; GW[(size_t)tok * 128 + hd * 16 + k] = ev[k] * inv; }
      }
    }
    PK_BAR();
}

__device__ __forceinline__ void peer_phase(Frame& F, int tok0, int tok1) {
    const unsigned char* U6 = F.ws + WS_EU; const unsigned char* V6 = F.ws + WS_EV; const float* SU = (const float*)(F.ws + WS_EU + 32 * MiB); const float* SV = (const float*)(F.ws + WS_EV + 32 * MiB);
    const float* X2 = (const float*)(F.ws + WS_X2); const float* RS2 = (const float*)(F.ws + WS_RS2); const int* IDX = (const int*)(F.ws + WS_IDX); const float* GW = (const float*)(F.ws + WS_GW);
    const int wv = F.wave, lane = F.lane, tid = F.tid;
    float* red_s = (float*)F.lds;
    float* ss_s = (float*)(F.lds + 131072);
    const f32x4 gfin = *(const f32x4*)(F.nfg + 4 * tid);
    f32x4 x3p = {0.f, 0.f, 0.f, 0.f}; int buf = 0;
#pragma unroll 1
    for (int m = tok0; m <= tok1; ++m) {
        if (m < tok1) {
            const int myidx = IDX[(size_t)m * 128 + wv * 16 + (lane & 15)]; float myg = GW[(size_t)m * 128 + wv * 16 + (lane & 15)];
            const float mysu = SU[myidx] * RS2[m]; myg *= SV[myidx];
            float hf[32];
#pragma unroll
            for (int j = 0; j < 8; ++j) { const f32x4 w = *(const f32x4*)(X2 + (size_t)m * DM + 256 * j + 4 * lane); hf[4 * j] = w.x; hf[4 * j + 1] = w.y; hf[4 * j + 2] = w.z; hf[4 * j + 3] = w.w; }
            float acc[32];
#pragma unroll
            for (int k = 0; k < 32; ++k) acc[k] = 0.f;
#pragma unroll 1
            for (int kg = 0; kg < 4; ++kg) {
                v4u ul4[4], vl4[4]; v2u ul2[4], vl2[4]; float gk[4], su[4];
#pragma unroll
                for (int kk = 0; kk < 4; ++kk) { const int ex = __shfl(myidx, kg * 4 + kk); gk[kk] = __shfl(myg, kg * 4 + kk); su[kk] = __shfl(mysu, kg * 4 + kk);
                    const unsigned char* ur = U6 + (size_t)ex * ROW6; const unsigned char* vr = V6 + (size_t)ex * ROW6;
                    ul4[kk] = *(const v4u*)(ur + 16 * lane); ul2[kk] = *(const v2u*)(ur + 1024 + 8 * lane); vl4[kk] = *(const v4u*)(vr + 16 * lane); vl2[kk] = *(const v2u*)(vr + 1024 + 8 * lane); }
#pragma unroll
                for (int kk = 0; kk < 4; ++kk) {
                    const v32f uf = __builtin_amdgcn_cvt_scalef32_pk32_f32_fp6((v6u){ul4[kk].x, ul4[kk].y, ul4[kk].z, ul4[kk].w, ul2[kk].x, ul2[kk].y}, 1.0f);
                    float dot = 0.f;
#pragma unroll
                    for (int k = 0; k < 32; ++k) dot += uf[k] * hf[k];
                    const float a = wave_sum(dot) * su[kk];
                    const float wgt = gk[kk] * (0.5f * a * (1.0f + erff(a * 0.70710678118654752f)));
                    const v32f vf = __builtin_amdgcn_cvt_scalef32_pk32_f32_fp6((v6u){vl4[kk].x, vl4[kk].y, vl4[kk].z, vl4[kk].w, vl2[kk].x, vl2[kk].y}, 1.0f);
#pragma unroll
                    for (int k = 0; k < 32; ++k) acc[k] += wgt * vf[k];
                }
            }
#pragma unroll
            for (int j = 0; j < 8; ++j) *(f32x4*)(red_s + (buf * 8 + wv) * 2048 + 256 * j + 4 * lane) = (f32x4){acc[4 * j], acc[4 * j + 1], acc[4 * j + 2], acc[4 * j + 3]};
        }
        __syncthreads();
        if (m > tok0) {
            float tot = 0.f;
#pragma unroll
            for (int w8 = 0; w8 < 8; ++w8) tot += ss_s[(buf ^ 1) * 8 + w8];
            const float rstd = 1.0f / sqrtf(tot * (1.0f / DM) + EPS);
            *(f32x4*)(F.out + OUT_Y + (size_t)(m - 1) * DM + 4 * tid) = x3p * rstd * gfin;
        }
        if (m < tok1) {
            f32x4 x3 = *(const f32x4*)(X2 + (size_t)m * DM + 4 * tid);
#pragma unroll
            for (int w8 = 0; w8 < 8; ++w8) x3 += *(const f32x4*)(red_s + (buf * 8 + w8) * 2048 + 4 * tid);
            const float ss = wave_sum((x3.x * x3.x + x3.y * x3.y) + (x3.z * x3.z + x3.w * x3.w));
            if (lane == 0) ss_s[buf * 8 + wv] = ss;
            x3p = x3;
        }
        buf ^= 1;
    }
    __syncthreads();
}
struct Args { const float* in[18]; float* out; unsigned char* ws; int ph_lo, ph_hi; };
__global__ void __launch_bounds__(NWAVES * 64, 2) mk_fwd(Args args) {
    extern __shared__ __attribute__((aligned(16))) unsigned char lds[];
    Frame F;
    F.lds = lds;
    F.tid = threadIdx.x; F.lane = F.tid & 63; F.wave = __builtin_amdgcn_readfirstlane(F.tid >> 6);
    F.G = gridDim.x; { const int bx = blockIdx.x; F.vcu = (F.G % 8 == 0) ? (bx % 8) * (F.G / 8) + bx / 8 : bx; }
    F.xp = args.in[0]; F.xs = args.in[1]; F.sgla = args.in[2]; F.sconv = args.in[3]; F.n1g = args.in[4]; F.win = args.in[5]; F.wau = args.in[6]; F.bal = args.in[7];
    F.gng = args.in[8]; F.cw = args.in[9]; F.cb = args.in[10]; F.wout = args.in[11]; F.n2g = args.in[12]; F.wq = args.in[13]; F.sk = args.in[14]; F.eu = args.in[15];
    F.ev = args.in[16]; F.nfg = args.in[17]; F.out = args.out; F.ws = args.ws;
    for (int u = F.tid; u < (LDS_BYTES - LDSCTL_OFF) / 4; u += NWAVES * 64) ((LAS unsigned*)((LAS unsigned char*)lds + LDSCTL_OFF))[u] = 0u;
    __syncthreads();
    gu32* ctl = (gu32*)(F.ws + WS_CTL);
    XcdBarrier bar; bar.bar = (unsigned*)(ctl + CW_BAR); bar.x = 0; bar.st = nullptr;
    if (N_LAUNCHES == 1) bar = xcd_barrier_post((unsigned*)(ctl + CW_BAR), (volatile LAS unsigned*)((LAS unsigned char*)lds + MISC_OFF) + 8);
    const int lo = args.ph_lo, hi = args.ph_hi;
#ifndef SKREP
#define SKREP 1
#endif
#ifndef PROBE_DBL
#define PROBE_DBL -1
#endif
#define IN(k) (lo <= (k) && (k) < hi)
#define REP(k) for (int rep_ = 0; rep_ < ((k) == PROBE_DBL ? 2 : 1); ++rep_)
#ifndef BAR_REP
#define BAR_REP 1
#endif
#define SEAM(k) do { if (IN(k) && IN((k) + 1)) for (int br_ = 0; br_ < BAR_REP; ++br_) xcd_barrier(bar); } while (0)
    const int gw = F.vcu * NWAVES + F.wave, NGW = F.G * NWAVES;
    const int tok0 = (int)(((long)F.vcu * TT) / F.G), tok1 = (int)(((long)(F.vcu + 1) * TT) / F.G);

    if (IN(0)) REP(0) { p0_prologue(F); __syncthreads(); }
    SEAM(0);
    if (IN(1)) REP(1) {
        pg8::Gemm g{(const pg8::bf16_t*)(F.ws + WS_XN), (const pg8::bf16_t*)(F.ws + WS_WINT), TP, NP, DM}; pg8::StaticOrder S; S.init(TP, NP, F.G, (int)blockIdx.x);
        pg8::EpiBf16<0> E{(pg8::bf16_t*)(F.ws + WS_P), PLD, nullptr, 0, 0, 1.f};
        pg8::gemm_phase<pg8::EpiBf16<0>, pg8::StaticOrder, true, true>((PG8_LAS unsigned char*)lds + RING_OFF, g, S, E);
#ifdef GEMM1_TWICE
        pg8::gemm_phase<pg8::EpiBf16<0>, pg8::StaticOrder, true, true>((PG8_LAS unsigned char*)lds + RING_OFF, g, S, E);
#endif
        { EpiSkBf16 Es{(bf16*)(F.ws + WS_P) + (size_t)TP * PLD, PLD, nullptr};
          for (int skr = 0; skr < SKREP; ++skr) for (int ng = F.vcu; ng < NP / 64; ng += F.G) skinny_gemm<4>(F, (const bf16*)(F.ws + WS_XN) + (size_t)TP * DM, (const bf16*)(F.ws + WS_WINT), 64 * ng, Es); }
    }
    SEAM(1);
    if (IN(2)) REP(2) { for (int u = F.vcu; u < 512; u += F.G) gla_prep_unit(F, u); }
    SEAM(2);
    if (IN(3)) REP(3) {
        if ((F.vcu & 1) == 0) { for (int g = F.vcu >> 1; g < 128; g += (F.G + 1) >> 1) gla_main_unit<4>(F, g >> 3, g & 7); }
        volatile LAS unsigned* qslot = (volatile LAS unsigned*)((LAS unsigned char*)lds + LDSCTL_OFF + 16);
        for (;;) {
            if (F.tid == 0) *qslot = __hip_atomic_fetch_add((unsigned*)(ctl + CW_QUEUE + 64 * rep_), 1u, __ATOMIC_RELAXED, __HIP_MEMORY_SCOPE_AGENT);
            __syncthreads();
            const unsigned u = *qslot;
            __syncthreads();
            if (u >= 512u) break;
            gla_sample_unit(F, (int)u);
        }
    }
    SEAM(3);
    if (IN(4)) REP(4) {
        bf16* MM = (bf16*)(F.ws + WS_MM);
        for (int g = gw; g < TP / 4; g += NGW) mixer_rows(F, 4 * g, 4);
        for (int n = gw; n < TS; n += NGW) mixer_rows(F, TP + n, 1);
        for (int m = TT + gw; m < MP; m += NGW) zero_row_bf16(MM + (size_t)m * DM, F.lane);
    }
    SEAM(4);
    if (IN(5)) REP(5) {
        pg8::Gemm g{(const pg8::bf16_t*)(F.ws + WS_MM), (const pg8::bf16_t*)(F.ws + WS_WOUTT), TP, DM, DM}; pg8::StaticOrder S; S.init(TP, DM, F.G, (int)blockIdx.x);
        pg8::EpiF32Res E{F.xp, (float*)(F.ws + WS_X2), (pg8::bf16_t*)(F.ws + WS_H2), (float*)(F.ws + WS_SSQ), DM};
        pg8::gemm_phase<pg8::EpiF32Res, pg8::StaticOrder, true, true>((PG8_LAS unsigned char*)lds + RING_OFF, g, S, E);
#ifdef GEMM2_TWICE
        pg8::gemm_phase<pg8::EpiF32Res, pg8::StaticOrder, true, true>((PG8_LAS unsigned char*)lds + RING_OFF, g, S, E);
#endif
        { EpiSkF32Res Es{F.xs, (float*)(F.ws + WS_X2) + (size_t)TP * DM, (bf16*)(F.ws + WS_H2) + (size_t)TP * DM, (float*)(F.ws + WS_SSQS)};
          for (int skr = 0; skr < SKREP; ++skr) for (int ng = F.vcu; ng < DM / 16; ng += F.G) skinny_gemm<1>(F, (const bf16*)(F.ws + WS_MM) + (size_t)TP * DM, (const bf16*)(F.ws + WS_WOUTT), 16 * ng, Es); }
    }
    SEAM(5);
    if (IN(6)) REP(6) {
        float* rs_s = (float*)(lds + 131072);
        float* rss_s = rs_s + 512;
        float* RS2 = (float*)(F.ws + WS_RS2);
        pg8::Gemm g{(const pg8::bf16_t*)(F.ws + WS_H2), (const pg8::bf16_t*)(F.ws + WS_WQT), TP, DM, DM}; pg8::StaticOrder S; S.init(TP, DM, F.G, (int)blockIdx.x);
        { pg8::Unit u0;
          if (S.next(0, u0) && F.tid < 256) { const int row = u0.pm * 256 + F.tid; const f32x4* p = (const f32x4*)((const float*)(F.ws + WS_SSQ) + (size_t)row * 32); f32x4 a4 = p[0];
#pragma unroll
              for (int i = 1; i < 8; ++i) a4 += p[i];
              const float rstd = 1.0f / sqrtf(((a4.x + a4.y) + (a4.z + a4.w)) * (1.0f / DM) + EPS); rs_s[F.tid] = rstd; if (u0.pn == 0) RS2[row] = rstd; }
          if (F.tid >= 256 && F.tid < 384 && F.vcu < DM / 16) { const int row = F.tid - 256; const f32x4* p = (const f32x4*)((const float*)(F.ws + WS_SSQS) + (size_t)row * 128); f32x4 a4 = p[0];
#pragma unroll
              for (int i = 1; i < 32; ++i) a4 += p[i];
              const float rstd = 1.0f / sqrtf(((a4.x + a4.y) + (a4.z + a4.w)) * (1.0f / DM) + EPS); rss_s[row] = rstd; if (F.vcu == 0) RS2[TP + row] = rstd; }
          __syncthreads(); }
        pg8::EpiBf16RowScale E{(pg8::bf16_t*)(F.ws + WS_QP), DM, rs_s};
        pg8::gemm_phase<pg8::EpiBf16RowScale, pg8::StaticOrder, true, true>((PG8_LAS unsigned char*)lds + RING_OFF, g, S, E);
#ifdef GEMM3_TWICE
        pg8::gemm_phase<pg8::EpiBf16RowScale, pg8::StaticOrder, true, true>((PG8_LAS unsigned char*)lds + RING_OFF, g, S, E);
#endif
        { EpiSkBf16 Es{(bf16*)(F.ws + WS_QP) + (size_t)TP * DM, DM, rss_s};
          for (int skr = 0; skr < SKREP; ++skr) for (int ng = F.vcu; ng < DM / 16; ng += F.G) skinny_gemm<1>(F, (const bf16*)(F.ws + WS_H2) + (size_t)TP * DM, (const bf16*)(F.ws + WS_WQT), 16 * ng, Es); }
    }
    SEAM(6);
    if (IN(7)) REP(7) { bf16x8 qa[2][4]; peer_qfrags(F, tok0, qa); peer_load_subkeys(F); for (int tb = tok0; tb < tok1; tb += 8) peer_topk_tile(F, tb, tok1, qa); __syncthreads(); }
    SEAM(7);
    if (IN(8)) REP(8) { peer_phase(F, tok0, tok1); }
#undef IN
#undef SEAM
}

extern "C" void kernel_launch(void* const* d_in, const int* in_sizes, int n_in, void* d_out, int out_size, void* d_ws, size_t ws_size, hipStream_t stream) {
    static int grid = 0;
    if (grid == 0) {
        if (n_in != 18 || ws_size < WS_END) { fprintf(stderr, "kernel_launch: expected 18 inputs and >= %zu bytes of workspace; got %d, %zu\n", (size_t)WS_END, n_in, ws_size); grid = -1; return; }
        int dev = 0, cus = 0;
        if (hipGetDevice(&dev) != hipSuccess || hipDeviceGetAttribute(&cus, hipDeviceAttributeMultiprocessorCount, dev) != hipSuccess) { grid = -1; return; }
        if (hipFuncSetAttribute((const void*)mk_fwd, hipFuncAttributeMaxDynamicSharedMemorySize, LDS_BYTES) != hipSuccess) { fprintf(stderr, "kernel_launch: hipFuncSetAttribute failed\n"); grid = -1; return; }
        (void)hipGetLastError();
        grid = cus;
    }
    if (grid < 0) return;
    (void)hipMemsetAsync((char*)d_ws + WS_CTL, 0, CTL_ZERO_BYTES, stream);
    Args a{};
    for (int i = 0; i < 18; ++i) a.in[i] = (const float*)d_in[i];
    a.out = (float*)d_out; a.ws = (unsigned char*)d_ws;
    if (N_LAUNCHES == 1) { a.ph_lo = 0; a.ph_hi = N_PHASES; hipLaunchKernelGGL(mk_fwd, dim3(grid), dim3(NWAVES * 64), LDS_BYTES, stream, a); }
    else { for (int li = 0; li < N_PHASES; ++li) { a.ph_lo = li; a.ph_hi = li + 1; hipLaunchKernelGGL(mk_fwd, dim3(grid), dim3(NWAVES * 64), LDS_BYTES, stream, a); } }
}
```

```cpp
#include <hip/hip_runtime.h>
#include <cstdio>
#include <cstdint>
#include <cmath>
#define MK_N_LAUNCHES 1
namespace pg8 {
#define PG8_LAS __attribute__((address_space(3)))
typedef unsigned short bf16_t;
typedef short bf16x8 __attribute__((ext_vector_type(8)));
typedef float f32x4 __attribute__((ext_vector_type(4)));
typedef unsigned u32x4 __attribute__((ext_vector_type(4)));
constexpr int BM = 256, BK = 64, HALF = 128, HTB = HALF * BK * 2  , STAGE_BYTES = 8 * HTB, NXCD = 8, WGM = 8;

__host__ __device__ __forceinline__ int lds_byte(int r, int c) { const int st = (r >> 4) * 2 + (c >> 5), rr = r & 15, cc = c & 31, ob = rr * 64 + cc * 2; return st * 1024 + (ob ^ (((ob >> 9) & 1) << 5)); }
__host__ __device__ __forceinline__ void stage_rc(int b, int& R, int& C) { const int st = b / 1024, sb = b % 1024, swz = sb ^ (((sb >> 9) & 1) << 5); R = (st >> 1) * 16 + swz / 64; C = (st & 1) * 32 + (swz % 64) / 2; }
__host__ __device__ __forceinline__ int perm32(int rho) { const int n = rho >> 4, i = rho & 15; return 8 * (i >> 2) + 4 * n + (i & 3); }

struct Unit { int pm, pn; };
struct Gemm { const bf16_t* A; const bf16_t* Bt; int M, N, K; };

struct StaticOrder {
    int nM, nN, nwg, G, c;
    __host__ __device__ void init(int M, int N, int G_, int c_) { nM = M / BM; nN = N / BM; nwg = nM * nN; G = G_; c = c_; }
    __host__ __device__ bool next(int i, Unit& u) const {
        const long L = (long)i * G + c; if (L >= nwg) return false;
        int wgid = (int)L; { const int q = nwg / NXCD, r = nwg % NXCD, xcd = wgid % NXCD, off = wgid / NXCD; wgid = (xcd < r ? xcd * (q + 1) : r * (q + 1) + (xcd - r) * q) + off; }
        const int nig = WGM * nN, gid = wgid / nig, fm = gid * WGM, gsz = (nM - fm) < WGM ? (nM - fm) : WGM;
        u.pm = fm + ((wgid % nig) % gsz); u.pn = (wgid % nig) / gsz; return true;
    }
    __device__ __forceinline__ void a_ready(const Unit&) const {}
    __device__ __forceinline__ void done(const Unit&) const {}
};

__device__ __forceinline__ unsigned cvt_pk_bf16(float lo, float hi) { unsigned r; asm volatile("v_cvt_pk_bf16_f32 %0, %1, %2" : "=v"(r) : "v"(lo), "v"(hi)); return r; }
typedef float f32x2 __attribute__((ext_vector_type(2)));
__device__ __forceinline__ f32x2 gelu_pk(f32x2 v) {
    const f32x2 av = __builtin_elementwise_abs(v), d = av * 0.2316418882f + 1.0f;
    f32x2 t; t.x = __builtin_amdgcn_rcpf(d.x); t.y = __builtin_amdgcn_rcpf(d.y);
    f32x2 q = t * 0.5307027145f + (-0.7265760135f); q = q * t + 0.7107068705f; q = q * t + (-0.142248368f); q = q * t + 0.127414796f; q = q * t;
    const f32x2 s = (v * v) * (-0.72134752044f);
    f32x2 e; e.x = __builtin_amdgcn_exp2f(s.x); e.y = __builtin_amdgcn_exp2f(s.y);
    const f32x2 m = v * (q * e), r = v - m;
    f32x2 o; o.x = v.x < 0.f ? m.x : r.x; o.y = v.y < 0.f ? m.y : r.y; return o;
}

template <int ACT  > struct EpiBf16 {
    static constexpr bool PERM = true, AFTER_DRAIN = false; static_assert(ACT == 0 || ACT == 1, "EpiBf16: ACT is 0 (none) or 1 (gelu_pk)");
    bf16_t* O; int ldc; const float* bias; int split_cols; size_t split_stride; float scale0;
    __device__ __forceinline__ void operator()(const f32x4 (&acc)[2][2][4][2], const Unit& u, int wr, int wc, int fr, int fq) const {
        const int row0 = u.pm * BM + wr * 64 + fr; int colt = u.pn * BM; bf16_t* base = O;
        float sc = 1.f; if (split_cols) { const int t = colt / split_cols; base += (size_t)t * split_stride; colt -= t * split_cols; if (t == 0) sc = scale0; }
        const int col0 = colt + wc * 32 + 8 * fq, bcol0 = u.pn * BM + wc * 32 + 8 * fq;
        f32x4 bv[2][2];
#pragma unroll
        for (int bj = 0; bj < 2; ++bj)
#pragma unroll
            for (int n = 0; n < 2; ++n) bv[bj][n] = bias ? *(const f32x4*)(bias + bcol0 + bj * HALF + 4 * n) : (f32x4){0.f, 0.f, 0.f, 0.f};
#pragma unroll
        for (int ai = 0; ai < 2; ++ai)
#pragma unroll
            for (int m = 0; m < 4; ++m) { bf16_t* rowp = base + (size_t)(row0 + ai * HALF + m * 16) * ldc + col0;
#pragma unroll
                for (int bj = 0; bj < 2; ++bj) { f32x4 v0 = acc[ai][bj][m][0] + bv[bj][0], v1 = acc[ai][bj][m][1] + bv[bj][1];
                    if (ACT == 1) { f32x2 a = gelu_pk((f32x2){v0[0], v0[1]}), b = gelu_pk((f32x2){v0[2], v0[3]}), c = gelu_pk((f32x2){v1[0], v1[1]}), d = gelu_pk((f32x2){v1[2], v1[3]});
                        v0 = (f32x4){a.x, a.y, b.x, b.y}; v1 = (f32x4){c.x, c.y, d.x, d.y}; }
                    v0 = v0 * sc; v1 = v1 * sc; u32x4 w; w.x = cvt_pk_bf16(v0[0], v0[1]); w.y = cvt_pk_bf16(v0[2], v0[3]); w.z = cvt_pk_bf16(v1[0], v1[1]); w.w = cvt_pk_bf16(v1[2], v1[3]);
                    __builtin_nontemporal_store(w, (u32x4*)(rowp + bj * HALF)); } }
    }
};
template <class Epi, class Sched, bool ALIGN_EPI = false, bool SP2 = false>
__device__ __forceinline__ void gemm_phase(PG8_LAS unsigned char* lds, const Gemm g, const Sched& S, const Epi& E) {
    const int tid = threadIdx.x, wid = __builtin_amdgcn_readfirstlane(tid >> 6), lane = tid & 63, wr = wid >> 2, wc = wid & 3, fr = lane & 15, fq = lane >> 4;
    const int K = g.K, nt = K / BK;
    unsigned voffA[2], voffB[2];
#pragma unroll
    for (int i = 0; i < 2; ++i) { int R, C; stage_rc(tid * 16 + i * 8192, R, C); const int Rb = Epi::PERM ? ((R & ~31) + perm32(R & 31)) : R;
        voffA[i] = (unsigned)(R * K + C) * 2u; voffB[i] = (unsigned)(Rb * K + C) * 2u; }
    const size_t kstep = (size_t)(BK * 2);
    const size_t hstep = (size_t)HALF * K * 2;
    const size_t tstep = 2 * hstep;
    const unsigned ldsw = (unsigned)wid * 1024u;
    const int aoff = lds_byte(wr * 64 + fr, fq * 8), boff = lds_byte(wc * 32 + fr, fq * 8);
#define PG8_SA(b, h) (((b) * 2 + (h)) * HTB)
#define PG8_SB(b, h) ((4 + (b) * 2 + (h)) * HTB)
#define PG8_STAGE(bufoff, gbase, voff) do { _Pragma("unroll") for (int _i = 0; _i < 2; ++_i) \
        __builtin_amdgcn_global_load_lds((const unsigned*)((const char*)(gbase) + (voff)[_i]), (PG8_LAS unsigned*)(lds + (bufoff) + ldsw + _i * 8192), 16, 0, 0); } while (0)
#define PG8_LDA(dst, b, h) do { _Pragma("unroll") for (int m = 0; m < 4; ++m) _Pragma("unroll") for (int k = 0; k < 2; ++k) dst[m][k] = *(const PG8_LAS bf16x8*)(lds + PG8_SA(b, h) + aoff + m * 2048 + k * 1024); } while (0)
#define PG8_LDB(dst, b, h) do { _Pragma("unroll") for (int n = 0; n < 2; ++n) _Pragma("unroll") for (int k = 0; k < 2; ++k) dst[n][k] = *(const PG8_LAS bf16x8*)(lds + PG8_SB(b, h) + boff + n * 2048 + k * 1024); } while (0)
#define PG8_MMA(ai, bj, At, Bt) do { __builtin_amdgcn_s_setprio(1); _Pragma("unroll") for (int m = 0; m < 4; ++m) _Pragma("unroll") for (int n = 0; n < 2; ++n) _Pragma("unroll") for (int k = 0; k < 2; ++k) \
        acc[ai][bj][m][n] = __builtin_amdgcn_mfma_f32_16x16x32_bf16(Bt[n][k], At[m][k], acc[ai][bj][m][n], 0, 0, 0); __builtin_amdgcn_s_setprio(0); } while (0)
#define PG8_WAIT_V(n) asm volatile("s_waitcnt vmcnt(" #n ")" ::: "memory")
#define PG8_WAIT_L(n) asm volatile("s_waitcnt lgkmcnt(" #n ")" ::: "memory")
#define PG8_BAR __builtin_amdgcn_s_barrier()
#define PG8_SCHED __builtin_amdgcn_sched_barrier(0)
    Unit cur, nxt; int ui = 0;
    if (!S.next(0, cur)) return;
    f32x4 acc[2][2][4][2];
#pragma unroll
    for (int a = 0; a < 2; ++a)
#pragma unroll
        for (int b = 0; b < 2; ++b)
#pragma unroll
            for (int m = 0; m < 4; ++m)
#pragma unroll
                for (int n = 0; n < 2; ++n) acc[a][b][m][n] = (f32x4){0.f, 0.f, 0.f, 0.f};
    bf16x8 At[4][2], B0[2][2], B1[2][2];
    const char* cA = (const char*)g.A + (size_t)cur.pm * tstep; const char* cB = (const char*)g.Bt + (size_t)cur.pn * tstep;
    S.a_ready(cur);
    if constexpr (SP2) {
        PG8_STAGE(PG8_SB(0, 0), cB, voffB); PG8_STAGE(PG8_SB(0, 1), cB + hstep, voffB); PG8_STAGE(PG8_SA(0, 0), cA, voffA); PG8_STAGE(PG8_SA(0, 1), cA + hstep, voffA);
        if (wr == 1) PG8_BAR;
        PG8_WAIT_V(2); PG8_BAR;
        PG8_STAGE(PG8_SB(1, 0), cB + kstep, voffB); PG8_STAGE(PG8_SA(1, 0), cA + kstep, voffA); PG8_STAGE(PG8_SB(1, 1), cB + hstep + kstep, voffB);
        PG8_WAIT_V(6); PG8_BAR;
    } else {
        PG8_STAGE(PG8_SB(0, 0), cB, voffB); PG8_STAGE(PG8_SA(0, 0), cA, voffA); PG8_STAGE(PG8_SB(0, 1), cB + hstep, voffB); PG8_STAGE(PG8_SA(0, 1), cA + hstep, voffA);
        if (wr == 1) PG8_BAR;
        PG8_WAIT_V(4); PG8_BAR;
        PG8_STAGE(PG8_SB(1, 0), cB + kstep, voffB); PG8_STAGE(PG8_SA(1, 0), cA + kstep, voffA); PG8_STAGE(PG8_SB(1, 1), cB + hstep + kstep, voffB);
        PG8_WAIT_V(6); PG8_BAR;
    }
    for (;;) {
        const bool has_next = S.next(ui + 1, nxt);
        const char* nA = has_next ? (const char*)g.A + (size_t)nxt.pm * tstep : cA; const char* nB = has_next ? (const char*)g.Bt + (size_t)nxt.pn * tstep : cB;
        for (int t = 0; t < nt; t += 2) {
            const bool last = (t == nt - 2);
            const char* a1 = cA + (size_t)(t + 1) * kstep;
            const char* a2 = last ? nA : cA + (size_t)(t + 2) * kstep; const char* b2 = last ? nB : cB + (size_t)(t + 2) * kstep;
            const char* a3 = a2 + kstep; const char* b3 = b2 + kstep;
            if (last && has_next) S.a_ready(nxt);
            if constexpr (SP2) {
            PG8_LDB(B0, 0, 0); PG8_LDB(B1, 0, 1); PG8_SCHED; PG8_LDA(At, 0, 0); PG8_STAGE(PG8_SA(1, 1), a1 + hstep, voffA);
            PG8_WAIT_V(8); PG8_WAIT_L(0); PG8_BAR; PG8_MMA(0, 0, At, B0); PG8_MMA(0, 1, At, B1); PG8_BAR; PG8_SCHED;
            PG8_LDA(At, 0, 1); PG8_STAGE(PG8_SB(0, 0), b2, voffB); PG8_STAGE(PG8_SB(0, 1), b2 + hstep, voffB); PG8_STAGE(PG8_SA(0, 0), a2, voffA);
            PG8_WAIT_V(8); PG8_WAIT_L(0); PG8_BAR; PG8_MMA(1, 0, At, B0); PG8_MMA(1, 1, At, B1); PG8_BAR; PG8_SCHED;
            PG8_LDB(B0, 1, 0); PG8_LDB(B1, 1, 1); PG8_SCHED; PG8_LDA(At, 1, 0); PG8_STAGE(PG8_SA(0, 1), a2 + hstep, voffA);
            PG8_WAIT_V(8); PG8_WAIT_L(0); PG8_BAR; PG8_MMA(0, 0, At, B0); PG8_MMA(0, 1, At, B1); PG8_BAR; PG8_SCHED;
            PG8_LDA(At, 1, 1); PG8_STAGE(PG8_SB(1, 0), b3, voffB); PG8_STAGE(PG8_SB(1, 1), b3 + hstep, voffB); PG8_STAGE(PG8_SA(1, 0), a3, voffA);
            PG8_WAIT_V(8); PG8_WAIT_L(0); PG8_BAR; PG8_MMA(1, 0, At, B0); PG8_MMA(1, 1, At, B1); PG8_BAR; PG8_SCHED;
            } else {
            PG8_LDB(B0, 0, 0); PG8_SCHED; PG8_LDA(At, 0, 0); PG8_STAGE(PG8_SA(1, 1), a1 + hstep, voffA);
            PG8_WAIT_L(8); PG8_BAR; PG8_WAIT_L(0); PG8_MMA(0, 0, At, B0); PG8_BAR; PG8_SCHED;
            PG8_LDB(B1, 0, 1); PG8_STAGE(PG8_SB(0, 0), b2, voffB);
            PG8_BAR; PG8_WAIT_L(0); PG8_MMA(0, 1, At, B1); PG8_BAR;
            PG8_LDA(At, 0, 1); PG8_STAGE(PG8_SA(0, 0), a2, voffA);
            PG8_BAR; PG8_WAIT_L(0); PG8_MMA(1, 0, At, B0); PG8_BAR; PG8_SCHED;
            PG8_STAGE(PG8_SB(0, 1), b2 + hstep, voffB);
            PG8_WAIT_V(6); PG8_BAR; PG8_MMA(1, 1, At, B1); PG8_BAR;
            PG8_LDB(B0, 1, 0); PG8_SCHED; PG8_LDA(At, 1, 0); PG8_STAGE(PG8_SA(0, 1), a2 + hstep, voffA);
            PG8_WAIT_L(8); PG8_BAR; PG8_WAIT_L(0); PG8_MMA(0, 0, At, B0); PG8_BAR; PG8_SCHED;
            PG8_LDB(B1, 1, 1); PG8_STAGE(PG8_SB(1, 0), b3, voffB);
            PG8_BAR; PG8_WAIT_L(0); PG8_MMA(0, 1, At, B1); PG8_BAR;
            PG8_LDA(At, 1, 1); PG8_STAGE(PG8_SA(1, 0), a3, voffA);
            PG8_BAR; PG8_WAIT_L(0); PG8_MMA(1, 0, At, B0); PG8_BAR; PG8_SCHED;
            PG8_STAGE(PG8_SB(1, 1), b3 + hstep, voffB);
            PG8_WAIT_V(6); PG8_BAR; PG8_MMA(1, 1, At, B1); PG8_BAR;
            }
        }
        if constexpr (ALIGN_EPI) { if (wr == 0) PG8_BAR; }
        if constexpr (!Epi::AFTER_DRAIN) { E(acc, cur, wr, wc, fr, fq); S.done(cur); }
        if (!has_next) break;
#pragma unroll
        for (int a = 0; a < 2; ++a)
#pragma unroll
            for (int b = 0; b < 2; ++b)
#pragma unroll
                for (int m = 0; m < 4; ++m)
#pragma unroll
                    for (int n = 0; n < 2; ++n) acc[a][b][m][n] = (f32x4){0.f, 0.f, 0.f, 0.f};
        cur = nxt; cA = nA; cB = nB; ++ui;
        if constexpr (ALIGN_EPI) { if (wr == 1) PG8_BAR; }
    }
    PG8_WAIT_V(0);
    if constexpr (!ALIGN_EPI) { if (wr == 0) PG8_BAR; }
    PG8_BAR;
    if constexpr (Epi::AFTER_DRAIN) { E.fused(acc, cur, wr, wc, fr, fq, lds, wid, lane); S.done(cur); }
#undef PG8_SA
#undef PG8_SB
#undef PG8_STAGE
#undef PG8_LDA
#undef PG8_LDB
#undef PG8_MMA
#undef PG8_WAIT_V
#undef PG8_WAIT_L
#undef PG8_BAR
#undef PG8_SCHED
}
}
namespace pg8 {
__device__ __forceinline__ unsigned f2bf_(float f) { unsigned u = __builtin_bit_cast(unsigned, f); return (u + 0x7fffu + ((u >> 16) & 1u)) >> 16; }
struct EpiF32Res {
    static constexpr bool PERM = false, AFTER_DRAIN = false;
    const float* xp; float* out; bf16_t* outb; float* ssq; int ldc;
    __device__ __forceinline__ void operator()(const f32x4 (&acc)[2][2][4][2], const Unit& u, int wr, int wc, int fr, int fq) const {
        const int col0 = u.pn * BM + wc * 32 + 4 * fq;
#pragma unroll
        for (int ai = 0; ai < 2; ++ai)
#pragma unroll
            for (int m = 0; m < 4; ++m) {
                const int row = u.pm * BM + ai * HALF + wr * 64 + m * 16 + fr;
                const float* src = xp + (size_t)row * ldc; float* dst = out + (size_t)row * ldc; bf16_t* dstb = outb + (size_t)row * ldc;
                float s = 0.f;
#pragma unroll
                for (int bj = 0; bj < 2; ++bj)
#pragma unroll
                    for (int n = 0; n < 2; ++n) { const int c = col0 + bj * HALF + n * 16; const f32x4 v = *(const f32x4*)(src + c) + acc[ai][bj][m][n]; *(f32x4*)(dst + c) = v;
                        s += (v[0] * v[0] + v[1] * v[1]) + (v[2] * v[2] + v[3] * v[3]);
                        unsigned w0 = f2bf_(v[0]) | (f2bf_(v[1]) << 16), w1 = f2bf_(v[2]) | (f2bf_(v[3]) << 16);
                        typedef unsigned u32x2 __attribute__((ext_vector_type(2))); *(u32x2*)(dstb + c) = (u32x2){w0, w1}; }
                s += __shfl_xor(s, 16); s += __shfl_xor(s, 32);
                if (fq == 0) ssq[(size_t)row * 32 + u.pn * 4 + wc] = s;
            }
    }
};
struct EpiBf16RowScale {
    static constexpr bool PERM = true, AFTER_DRAIN = false;
    bf16_t* O; int ldc; const float* rs;
    __device__ __forceinline__ void operator()(const f32x4 (&acc)[2][2][4][2], const Unit& u, int wr, int wc, int fr, int fq) const {
        const int row0 = u.pm * BM + wr * 64 + fr, col0 = u.pn * BM + wc * 32 + 8 * fq;
#pragma unroll
        for (int ai = 0; ai < 2; ++ai)
#pragma unroll
            for (int m = 0; m < 4; ++m) { const int rl = wr * 64 + fr + ai * HALF + m * 16; const float sc = rs[rl]; bf16_t* rowp = O + (size_t)(row0 + ai * HALF + m * 16) * ldc + col0;
#pragma unroll
                for (int bj = 0; bj < 2; ++bj) { const f32x4 v0 = acc[ai][bj][m][0] * sc, v1 = acc[ai][bj][m][1] * sc;
                    u32x4 w; w.x = cvt_pk_bf16(v0[0], v0[1]); w.y = cvt_pk_bf16(v0[2], v0[3]); w.z = cvt_pk_bf16(v1[0], v1[1]); w.w = cvt_pk_bf16(v1[2], v1[3]);
                    *(u32x4*)(rowp + bj * HALF) = w; } }
    }
};
}

#ifndef MK_N_LAUNCHES
#define MK_N_LAUNCHES 1
#endif
constexpr int N_PHASES = 9;
constexpr int N_LAUNCHES = MK_N_LAUNCHES;
constexpr int NWAVES = 8;

constexpr int DM = 2048;
constexpr int TP = 8192, TS = 128, TT = TP + TS;
constexpr int MP = 8448;
constexpr int NP = 16384;
constexpr int PLD = NP + 64;
constexpr int C_Q = 0, C_K = 1024, C_V = 2048, C_R = 4096, C_CB = 6144, C_CC = 8192, C_CX = 10240, C_GA = 12288, C_GB = 14336;
constexpr int DIN = 16400;
constexpr int NEXP = 16384;
constexpr float EPS = 1e-6f;

constexpr size_t MiB = 1u << 20;
constexpr size_t WS_CTL = 0, CTL_ZERO_BYTES = 1 * MiB;
constexpr size_t WS_WINT = 2 * MiB;
constexpr size_t WS_WOUTT = 68 * MiB;
constexpr size_t WS_WQT = 76 * MiB;
constexpr size_t WS_EU = 84 * MiB;
constexpr size_t WS_EV = 148 * MiB;
constexpr size_t WS_XN = 212 * MiB;
constexpr size_t WS_P = 246 * MiB;
constexpr size_t WS_QT = 516 * MiB;
constexpr size_t WS_KT = 532 * MiB;
constexpr size_t WS_VT = 548 * MiB;
constexpr size_t WS_ATT = 580 * MiB;
constexpr size_t WS_EBL = 584 * MiB;
constexpr size_t WS_SKB = 585 * MiB;
constexpr size_t WS_O = 586 * MiB;
constexpr size_t WS_MM = 620 * MiB;
constexpr size_t WS_X2 = 654 * MiB;
constexpr size_t WS_H2 = 720 * MiB;
constexpr size_t WS_SSQ = 799 * MiB;
constexpr size_t WS_QP = 754 * MiB;
constexpr size_t WS_IDX = 788 * MiB;
constexpr size_t WS_GW = 793 * MiB;
constexpr size_t WS_ALR = 798 * MiB;
constexpr size_t WS_SSQS = 799 * MiB + 1100 * 1024;
constexpr size_t WS_RS2 = 799 * MiB + 1200 * 1024;
constexpr size_t WS_END = 801 * MiB;
constexpr int CW_TMO = 0, CW_CODE = 1, CW_BAR = 4096, CW_QUEUE = 16384;

constexpr size_t OUT_Y = 0;
constexpr size_t OUT_GLAP = (size_t)TT * DM;
constexpr size_t OUT_CONVP = OUT_GLAP + (size_t)4 * 4 * 256 * 512;
constexpr size_t OUT_GLAS = OUT_CONVP + (size_t)4 * 2 * 2048;
constexpr size_t OUT_CONVS = OUT_GLAS + (size_t)128 * 4 * 256 * 512;

constexpr int LDS_BYTES = 163840;
constexpr int LDSCTL_OFF = 162816, MISC_OFF = LDSCTL_OFF + 320;
constexpr int RING_OFF = 0;

#define GAS __attribute__((address_space(1)))
#define LAS __attribute__((address_space(3)))
typedef unsigned short bf16;
typedef unsigned v4u __attribute__((ext_vector_type(4)));
typedef unsigned v2u __attribute__((ext_vector_type(2)));
typedef float f32x4 __attribute__((ext_vector_type(4)));
typedef short bf16x8 __attribute__((ext_vector_type(8)));
typedef GAS unsigned gu32;
typedef float v32f __attribute__((ext_vector_type(32)));
typedef float v16f __attribute__((ext_vector_type(16)));
typedef unsigned v6u __attribute__((ext_vector_type(6)));
constexpr int ROW6 = 1536;
#define RLX_AGENT __ATOMIC_RELAXED, __HIP_MEMORY_SCOPE_AGENT
#define LDS_WAIT() asm volatile("s_waitcnt lgkmcnt(0)" ::: "memory")
#define VM_WAIT() asm volatile("s_waitcnt vmcnt(0)" ::: "memory")
#define MFMA16(a, b, c) __builtin_amdgcn_mfma_f32_16x16x32_bf16((a), (b), (c), 0, 0, 0)
__device__ __forceinline__ unsigned f2bf(float f) { unsigned u = __builtin_bit_cast(unsigned, f); return (u + 0x7fffu + ((u >> 16) & 1u)) >> 16; }
__device__ __forceinline__ unsigned pk2(float lo, float hi) { return f2bf(lo) | (f2bf(hi) << 16); }
__device__ __forceinline__ float bf2f(unsigned b) { return __builtin_bit_cast(float, b << 16); }
__device__ __forceinline__ float bflo(unsigned w) { return __builtin_bit_cast(float, w << 16); }
__device__ __forceinline__ float bfhi(unsigned w) { return __builtin_bit_cast(float, w & 0xffff0000u); }
__device__ __forceinline__ void unpack8(const v4u w, float (&f)[8]) { f[0] = bflo(w.x); f[1] = bfhi(w.x); f[2] = bflo(w.y); f[3] = bfhi(w.y); f[4] = bflo(w.z); f[5] = bfhi(w.z); f[6] = bflo(w.w); f[7] = bfhi(w.w); }
__device__ __forceinline__ v4u pack8(const float (&f)[8]) { v4u w; w.x = pk2(f[0], f[1]); w.y = pk2(f[2], f[3]); w.z = pk2(f[4], f[5]); w.w = pk2(f[6], f[7]); return w; }
__device__ __forceinline__ float wave_sum(float v) {
#pragma unroll
    for (int o = 1; o < 64; o <<= 1) v += __shfl_xor(v, o);
    return v;
}
__device__ __forceinline__ float sigmoidf_(float x) { return 1.0f / (1.0f + __expf(-x)); }
#define XB_TMO      128
#define XB_XCNT(j)  (256  + 64 * (j))
#define XB_XSUB(j)  (1280 + 64 * (j))
#define XB_XGEN(j)  (2304 + 64 * (j))
#define XB_TOP      3328
#define XB_TOPGEN   3392
#define XCD_BAR_WORDS 3456
#define XB_SPIN_CAP (1u << 18)

__device__ __forceinline__ unsigned xb_ld(unsigned* p)              { return __hip_atomic_load(p, __ATOMIC_RELAXED, __HIP_MEMORY_SCOPE_AGENT); }
__device__ __forceinline__ unsigned xb_add(unsigned* p, unsigned v) { return __hip_atomic_fetch_add(p, v, __ATOMIC_RELAXED, __HIP_MEMORY_SCOPE_AGENT); }
__device__ __forceinline__ unsigned xb_xcc_id() { return (unsigned)__builtin_amdgcn_s_getreg((3 << 11) | 20) & 0xFu; }
#define XB_SPIN(cond, bar) do { unsigned _sp = 0; while (cond) { __builtin_amdgcn_s_sleep(1); \
    if ((++_sp & 255u) == 0u) { if (xb_ld(&(bar)[XB_TMO])) break; if (_sp > XB_SPIN_CAP) { atomicAdd(&(bar)[XB_TMO], 1u); break; } } } } while (0)

struct XcdBarrier {
    unsigned* bar; unsigned x;
    volatile LAS unsigned* st;
};

__device__ __forceinline__ XcdBarrier xcd_barrier_post(unsigned* bar, volatile LAS unsigned* st) {
    XcdBarrier b; b.bar = bar; b.x = xb_xcc_id(); b.st = st;
    if (threadIdx.x == 0) (void)xb_add(&bar[XB_XCNT(b.x)], 1u);
    return b;
}
__device__ __forceinline__ void xcd_barrier_complete(unsigned* bar, unsigned x, unsigned& nloc, unsigned& nx) {
    const unsigned G = gridDim.x * gridDim.y * gridDim.z;
    unsigned sum, cnt, mine, sp = 0u;
    for (;;) {
        sum = 0u; cnt = 0u; mine = 0u;
#pragma unroll
        for (unsigned j = 0; j < 16; ++j) { const unsigned c = xb_ld(&bar[XB_XCNT(j)]); sum += c; cnt += (c > 0u) ? 1u : 0u; mine = (j == x) ? c : mine; }
        if (sum == G) break;
        __builtin_amdgcn_s_sleep(1);
        if ((++sp & 255u) == 0u) { if (xb_ld(&bar[XB_TMO])) break; if (sp > XB_SPIN_CAP) { atomicAdd(&bar[XB_TMO], 1u); break; } }
    }
    nloc = mine > 0u ? mine : 1u; nx = cnt > 0u ? cnt : 1u;
}

__device__ __forceinline__ void xcd_barrier(const XcdBarrier& b) {
    asm volatile("s_waitcnt vmcnt(0)" ::: "memory");
    __syncthreads();
    if (threadIdx.x == 0) {
        unsigned* bar = b.bar;
        __builtin_amdgcn_s_waitcnt(0);
        unsigned nloc = b.st[0], nx = b.st[1];
        if (nloc == 0u) { xcd_barrier_complete(bar, b.x, nloc, nx); b.st[0] = nloc; b.st[1] = nx; }
        const unsigned old = xb_add(&bar[XB_XSUB(b.x)], 1u);
        const unsigned gen = old / nloc;
        if (old + 1u == (gen + 1u) * nloc) {
            __builtin_amdgcn_fence(__ATOMIC_RELEASE, "agent");
            asm volatile("s_waitcnt vmcnt(0)" ::: "memory");
            const unsigned og = xb_add(&bar[XB_TOP], 1u);
            const unsigned tg = og / nx;
            if (og + 1u == (tg + 1u) * nx) xb_add(&bar[XB_TOPGEN], 1u);
            else XB_SPIN(xb_ld(&bar[XB_TOPGEN]) == tg, bar);
            __builtin_amdgcn_fence(__ATOMIC_ACQUIRE, "agent");
            xb_add(&bar[XB_XGEN(b.x)], 1u);
            asm volatile("s_waitcnt vmcnt(0)" ::: "memory");
        } else {
            XB_SPIN(xb_ld(&bar[XB_XGEN(b.x)]) == gen, bar);
            __builtin_amdgcn_fence(__ATOMIC_ACQUIRE, "agent");
            asm volatile("s_waitcnt vmcnt(0)" ::: "memory");
        }
    }
    __syncthreads();
}
struct Frame {
    unsigned char* lds;
    int tid, lane, wave, vcu, G;
    const float *xp, *xs, *sgla, *sconv, *n1g, *win, *wau, *bal, *gng, *cw, *cb, *wout, *n2g, *wq, *sk, *eu, *ev, *nfg;
    float* out;
    unsigned char* ws;
};

__device__ __forceinline__ void p0_transpose_item(const float* W, int ldw, int src_col0, int k0, bf16* WT, int K, int dst_row0, float* scr, int lane, const float* kscale = nullptr) {
    const int n4 = lane & 15, kr = lane >> 4;
#pragma unroll 8
    for (int i = 0; i < 16; ++i) { const int kk = 4 * i + kr; f32x4 v = __builtin_nontemporal_load((const f32x4*)(W + (size_t)(k0 + kk) * ldw + src_col0 + 4 * n4)); if (kscale) v = v * kscale[k0 + kk];
        float* d = scr + kk * 65 + 4 * n4; d[0] = v.x; d[1] = v.y; d[2] = v.z; d[3] = v.w; }
    LDS_WAIT(); asm volatile("" ::: "memory");
    const int c = lane & 7, nr = lane >> 3;
#pragma unroll
    for (int j = 0; j < 8; ++j) { const int n = nr + 8 * j; const float* s = scr + (8 * c) * 65 + n;
        v4u o; o.x = pk2(s[0 * 65], s[1 * 65]); o.y = pk2(s[2 * 65], s[3 * 65]); o.z = pk2(s[4 * 65], s[5 * 65]); o.w = pk2(s[6 * 65], s[7 * 65]);
        *(v4u*)(WT + (size_t)(dst_row0 + n) * K + k0 + 8 * c) = o; }
    LDS_WAIT(); asm volatile("" ::: "memory");
}
__device__ __forceinline__ void rms_row_to_bf16(const float* xrow, const float* g, bf16* orow, int lane) {
    const f32x4* xr = (const f32x4*)xrow + lane; const f32x4* gr = (const f32x4*)g + lane;
    f32x4 v[8]; float s = 0.f;
#pragma unroll
    for (int j = 0; j < 8; ++j) { v[j] = __builtin_nontemporal_load(xr + 64 * j); s += (v[j].x * v[j].x + v[j].y * v[j].y) + (v[j].z * v[j].z + v[j].w * v[j].w); }
    const float rstd = 1.0f / sqrtf(wave_sum(s) * (1.0f / DM) + EPS);
    v2u* o8 = (v2u*)orow + lane;
#pragma unroll
    for (int j = 0; j < 8; ++j) { const f32x4 gg = gr[64 * j]; v2u w; w.x = pk2(v[j].x * rstd * gg.x, v[j].y * rstd * gg.y); w.y = pk2(v[j].z * rstd * gg.z, v[j].w * rstd * gg.w); o8[64 * j] = w; }
}
__device__ __forceinline__ void zero_row_bf16(bf16* orow, int lane) {
    v2u* o8 = (v2u*)orow + lane; const v2u z = {0u, 0u};
#pragma unroll
    for (int j = 0; j < 8; ++j) o8[64 * j] = z;
}
__device__ __forceinline__ void p0_prologue(Frame& F) {
    bf16* WINT = (bf16*)(F.ws + WS_WINT); bf16* WOUTT = (bf16*)(F.ws + WS_WOUTT); bf16* WQT = (bf16*)(F.ws + WS_WQT);
    float* scr = (float*)(F.lds + F.wave * 16640);
    const int gw = F.vcu * NWAVES + F.wave, NGW = F.G * NWAVES;
    constexpr int I_IN = 32 * 256, I_SQ = 32 * 32;
    for (int it = gw; it < I_IN + 2 * I_SQ; it += NGW) {
        int r = it;
        if (r < I_IN) { const int kb = r >> 8, nb = r & 255, n0 = 64 * nb; p0_transpose_item(F.win, DIN, n0 + (n0 >= 6144 ? 16 : 0), 64 * kb, WINT, DM, n0, scr, F.lane); continue; }
        r -= I_IN;
        if (r < I_SQ) { const int kb = r >> 5, nb = r & 31; p0_transpose_item(F.wout, DM, 64 * nb, 64 * kb, WOUTT, DM, 64 * nb, scr, F.lane); continue; }
        r -= I_SQ;
        { const int kb = r >> 5, nb = r & 31; p0_transpose_item(F.wq, DM, 64 * nb, 64 * kb, WQT, DM, 64 * nb, scr, F.lane, F.n2g); }
    }
    const size_t gt = (size_t)F.vcu * 512 + F.tid, NGT = (size_t)F.G * 512;
    { bf16* SKB = (bf16*)(F.ws + WS_SKB); for (size_t e = gt; e < (size_t)2 * 128 * 128; e += NGT) SKB[e] = (bf16)f2bf(F.sk[e]); }
    { unsigned char* U6 = F.ws + WS_EU; unsigned char* V6 = F.ws + WS_EV; float* SU = (float*)(F.ws + WS_EU + 32 * MiB); float* SV = (float*)(F.ws + WS_EV + 32 * MiB);
      for (int r = gw; r < 2 * NEXP; r += NGW) {
          const bool isv = r >= NEXP; const int row = isv ? r - NEXP : r;
          const float* src = (isv ? F.ev : F.eu) + (size_t)row * DM;
          f32x4 x[8]; float amax = 0.f;
#pragma unroll
          for (int j = 0; j < 8; ++j) { x[j] = __builtin_nontemporal_load((const f32x4*)(src + 256 * j + 4 * F.lane)); if (!isv) x[j] = x[j] * *(const f32x4*)(F.n2g + 256 * j + 4 * F.lane);
              amax = fmaxf(amax, fmaxf(fmaxf(fabsf(x[j].x), fabsf(x[j].y)), fmaxf(fabsf(x[j].z), fabsf(x[j].w)))); }
#pragma unroll
          for (int o = 1; o < 64; o <<= 1) amax = fmaxf(amax, __shfl_xor(amax, o));
          const float sc = amax > 0.f ? 7.5f / amax : 1.0f;
          v16f pa, pb;
#pragma unroll
          for (int j = 0; j < 8; ++j) { pa[2 * j] = x[j].x * sc; pb[2 * j] = x[j].y * sc; pa[2 * j + 1] = x[j].z * sc; pb[2 * j + 1] = x[j].w * sc; }
          const v6u p = __builtin_amdgcn_cvt_scalef32_2xpk16_fp6_f32(pa, pb, 1.0f);
          unsigned char* dst2 = (isv ? V6 : U6) + (size_t)row * ROW6;
          __builtin_nontemporal_store((v4u){p[0], p[1], p[2], p[3]}, (v4u*)(dst2 + 16 * F.lane)); __builtin_nontemporal_store((v2u){p[4], p[5]}, (v2u*)(dst2 + 1024 + 8 * F.lane));
          if (F.lane == 0) (isv ? SV : SU)[row] = amax > 0.f ? amax / 7.5f : 1.0f;
      } }
    __syncthreads();
    { bf16* wt_s = (bf16*)F.lds; constexpr int WLD = DM + 8;
      for (int k = F.tid; k < DM; k += 512) { const float* src = F.win + (size_t)k * DIN + 6144;
#pragma unroll
          for (int q = 0; q < 4; ++q) { const f32x4 w4 = *(const f32x4*)(src + 4 * q); wt_s[(4 * q + 0) * WLD + k] = (bf16)f2bf(w4.x); wt_s[(4 * q + 1) * WLD + k] = (bf16)f2bf(w4.y); wt_s[(4 * q + 2) * WLD + k] = (bf16)f2bf(w4.z); wt_s[(4 * q + 3) * WLD + k] = (bf16)f2bf(w4.w); } }
      bf16* XN = (bf16*)(F.ws + WS_XN); float* ALR = (float*)(F.ws + WS_ALR);
      const int r0 = (int)(((long)F.vcu * TT) / F.G), r1 = (int)(((long)(F.vcu + 1) * TT) / F.G);
      for (int m = r0 + F.wave; m < r1; m += NWAVES) rms_row_to_bf16(m < TP ? F.xp + (size_t)m * DM : F.xs + (size_t)(m - TP) * DM, F.n1g, XN + (size_t)m * DM, F.lane);
      for (int m = TT + gw; m < MP; m += NGW) zero_row_bf16(XN + (size_t)m * DM, F.lane);
      VM_WAIT(); __syncthreads();
      const int l15 = F.lane & 15, lq = F.lane >> 4;
      for (int t0 = r0 + 16 * F.wave; t0 < r1; t0 += 16 * NWAVES) {
          const int row = min(t0 + l15, r1 - 1);
          f32x4 acc = {0.f, 0.f, 0.f, 0.f};
#pragma unroll 8
          for (int ks = 0; ks < 64; ++ks) { const bf16x8 a = *(const bf16x8*)(XN + (size_t)row * DM + 32 * ks + 8 * lq); const bf16x8 bq = *(const bf16x8*)(wt_s + l15 * WLD + 32 * ks + 8 * lq); acc = MFMA16(a, bq, acc); }
#pragma unroll
          for (int r = 0; r < 4; ++r) { const int m = t0 + 4 * lq + r; if (m < r1) ALR[(size_t)m * 16 + l15] = acc[r]; }
      } }
}

template <int NT, class Epi>
__device__ __forceinline__ void skinny_gemm(Frame& F, const bf16* A, const bf16* Bt, int n0, const Epi& E) {
    constexpr int ROWS = NT * 16, NPC = (ROWS * 32 + 511) / 512, BLD = 264;
    bf16* Bs = (bf16*)F.lds;
    const int tid = F.tid, wv = F.wave, l15 = F.lane & 15, lq = F.lane >> 4;
    f32x4 acc[NT];
#pragma unroll
    for (int nt = 0; nt < NT; ++nt) acc[nt] = (f32x4){0.f, 0.f, 0.f, 0.f};
    const bf16* Arow = A + (size_t)(16 * wv + l15) * DM + 8 * lq;
    v4u bX[NPC], bY[NPC]; bf16x8 aX[8], aY[8];
#define SK_LOADB(BR, kc) do { _Pragma("unroll") for (int i = 0; i < NPC; ++i) { const int p = tid + 512 * i; if (p < ROWS * 32) BR[i] = *(const v4u*)(Bt + (size_t)(n0 + (p >> 5)) * DM + (kc) * 256 + 8 * (p & 31)); } } while (0)
#define SK_LOADA(AR, kc) do { _Pragma("unroll") for (int ks = 0; ks < 8; ++ks) AR[ks] = *(const bf16x8*)(Arow + (kc) * 256 + 32 * ks); } while (0)
#define SK_STOREB(BR, kc) do { bf16* Bn = Bs + ((kc) & 1) * ROWS * BLD; _Pragma("unroll") for (int i = 0; i < NPC; ++i) { const int p = tid + 512 * i; if (p < ROWS * 32) *(v4u*)(Bn + (p >> 5) * BLD + 8 * (p & 31)) = BR[i]; } } while (0)
#define SK_COMP(AR, kc) do { const bf16* Bc = Bs + ((kc) & 1) * ROWS * BLD; _Pragma("unroll") for (int ks = 0; ks < 8; ++ks) _Pragma("unroll") for (int nt = 0; nt < NT; ++nt) { \
        const bf16x8 bq = *(const bf16x8*)(Bc + (16 * nt + l15) * BLD + 32 * ks + 8 * lq); acc[nt] = MFMA16(AR[ks], bq, acc[nt]); } } while (0)
    SK_LOADB(bX, 0); SK_LOADA(aX, 0); SK_LOADB(bY, 1); SK_LOADA(aY, 1);
    SK_STOREB(bX, 0);
    __syncthreads();
#pragma unroll 1
    for (int kc = 0; kc < 8; kc += 2) {
        SK_LOADB(bX, kc + 2 < 8 ? kc + 2 : 7);
        SK_COMP(aX, kc); SK_LOADA(aX, kc + 2 < 8 ? kc + 2 : 7);
        SK_STOREB(bY, kc + 1);
        __syncthreads();
        SK_LOADB(bY, kc + 3 < 8 ? kc + 3 : 7);
        SK_COMP(aY, kc + 1); SK_LOADA(aY, kc + 3 < 8 ? kc + 3 : 7);
        SK_STOREB(bX, kc + 2);
        __syncthreads();
    }
#undef SK_LOADB
#undef SK_LOADA
#undef SK_STOREB
#undef SK_COMP
    E.template tile<NT>(acc, wv, l15, lq, n0);
}
struct EpiSkBf16 { bf16* out; int ldc; const float* rs;
    template <int NT> __device__ __forceinline__ void tile(const f32x4 (&acc)[NT], int wv, int l15, int lq, int n0) const {
#pragma unroll
        for (int r = 0; r < 4; ++r) { const int row = 16 * wv + 4 * lq + r; const float sc = rs ? rs[row] : 1.0f;
#pragma unroll
            for (int nt = 0; nt < NT; ++nt) out[(size_t)row * ldc + n0 + 16 * nt + l15] = (bf16)f2bf(acc[nt][r] * sc); } } };
struct EpiSkF32Res { const float* xs; float* out; bf16* outb; float* ssqs;
    template <int NT> __device__ __forceinline__ void tile(const f32x4 (&acc)[NT], int wv, int l15, int lq, int n0) const {
        static_assert(NT == 1, "one 16-column group");
#pragma unroll
        for (int r = 0; r < 4; ++r) { const int row = 16 * wv + 4 * lq + r; const size_t o = (size_t)row * DM + n0 + l15; const float v = xs[o] + acc[0][r]; out[o] = v; outb[o] = (bf16)f2bf(v);
            float s = v * v; s += __shfl_xor(s, 1); s += __shfl_xor(s, 2); s += __shfl_xor(s, 4); s += __shfl_xor(s, 8);
            if (l15 == 0) ssqs[row * 128 + (n0 >> 4)] = s; } } };

__device__ __forceinline__ float logsig(float x) { return fminf(x, 0.f) - __logf(1.0f + __expf(-fabsf(x))); }
__device__ __forceinline__ void gla_prep_unit(Frame& F, int u) {
    const bf16* P = (const bf16*)(F.ws + WS_P); bf16* QT = (bf16*)(F.ws + WS_QT); bf16* KT = (bf16*)(F.ws + WS_KT); bf16* VT = (bf16*)(F.ws + WS_VT);
    bf16* ATT = (bf16*)(F.ws + WS_ATT); float* EBL = (float*)(F.ws + WS_EBL);
    const int b = u >> 7, h = (u >> 5) & 3, c = u & 31, tid = F.tid;
    const int row0 = b * 2048 + c * 64;
    float* alr_s = (float*)F.lds;
    float* tot_s = (float*)(F.lds + 4096);
    bf16* q_s = (bf16*)(F.lds + 8192);
    bf16* k_s = q_s + 64 * 264;
    bf16* v_s = k_s + 64 * 264;
    bf16* a_s = v_s + 64 * 520;
    { v4u tq[4], tk[4], tv[8];
#pragma unroll
      for (int i = 0; i < 4; ++i) { const int p = tid + 512 * i, row = p >> 5, ch = p & 31; const bf16* src = P + (size_t)(row0 + row) * PLD + h * 256 + 8 * ch; tq[i] = __builtin_nontemporal_load((const v4u*)(src + C_Q)); tk[i] = __builtin_nontemporal_load((const v4u*)(src + C_K)); }
#pragma unroll
      for (int i = 0; i < 8; ++i) { const int p = tid + 512 * i, row = p >> 6, ch = p & 63; tv[i] = __builtin_nontemporal_load((const v4u*)(P + (size_t)(row0 + row) * PLD + C_V + h * 512 + 8 * ch)); }
      for (int e = tid; e < 1024; e += 512) alr_s[e] = ((const float*)(F.ws + WS_ALR))[(size_t)row0 * 16 + e];
#pragma unroll
      for (int i = 0; i < 4; ++i) { const int p = tid + 512 * i, row = p >> 5, ch = p & 31; *(v4u*)(q_s + row * 264 + 8 * ch) = tq[i]; *(v4u*)(k_s + row * 264 + 8 * ch) = tk[i]; }
#pragma unroll
      for (int i = 0; i < 8; ++i) { const int p = tid + 512 * i, row = p >> 6, ch = p & 63; *(v4u*)(v_s + row * 520 + 8 * ch) = tv[i]; } }
    const int d = tid & 255, half = tid >> 8;
    float w[16];
#pragma unroll
    for (int r = 0; r < 16; ++r) w[r] = F.wau[r * 1024 + h * 256 + d];
    const float bias = F.bal[h * 256 + d];
    __syncthreads();
    float bb[32]; float run = 0.f;
#pragma unroll
    for (int jj = 0; jj < 32; ++jj) { const int j = half * 32 + jj; float x = bias;
#pragma unroll
        for (int r = 0; r < 16; ++r) x += alr_s[j * 16 + r] * w[r];
        run += logsig(x) * 0.0625f; bb[jj] = run; }
    if (half == 0) tot_s[d] = run;
    __syncthreads();
    if (half == 1) { const float t = tot_s[d];
#pragma unroll
        for (int jj = 0; jj < 32; ++jj) bb[jj] += t; }
#pragma unroll
    for (int jj = 0; jj < 32; ++jj) { const int j = half * 32 + jj;
        const float qv = bf2f(q_s[j * 264 + d]), kv = bf2f(k_s[j * 264 + d]);
        const float e = __expf(bb[jj]), ei = __expf(-bb[jj]);
        q_s[j * 264 + d] = (bf16)f2bf(qv * 0.0625f * e); k_s[j * 264 + d] = (bf16)f2bf(kv * ei); }
    if (half == 1) EBL[u * 256 + d] = __expf(bb[31]);
    __syncthreads();
    { const int wv = F.wave, l15 = F.lane & 15, lq = F.lane >> 4, mi = wv >> 1;
#pragma unroll
      for (int nn = 0; nn < 2; ++nn) { const int ni = (wv & 1) * 2 + nn; f32x4 acc = {0.f, 0.f, 0.f, 0.f};
#pragma unroll
          for (int ks = 0; ks < 8; ++ks) { const bf16x8 a = *(const bf16x8*)(q_s + (16 * mi + l15) * 264 + 32 * ks + 8 * lq); const bf16x8 bq = *(const bf16x8*)(k_s + (16 * ni + l15) * 264 + 32 * ks + 8 * lq); acc = MFMA16(a, bq, acc); }
#pragma unroll
          for (int r = 0; r < 4; ++r) { const int i = 16 * mi + 4 * lq + r, jn = 16 * ni + l15; a_s[i * 72 + jn] = (bf16)f2bf(jn <= i ? acc[r] : 0.f); } } }
#pragma unroll
    for (int i = 0; i < 4; ++i) { const int p = tid + 512 * i, f = p >> 6, ln = p & 63, l15 = ln & 15, lq = ln >> 4;
        { const int mi = f >> 3, kh = (f >> 2) & 1, ks = f & 3; *(v4u*)(QT + (size_t)u * 16384 + (size_t)p * 8) = *(const v4u*)(q_s + (16 * mi + l15) * 264 + 128 * kh + 32 * ks + 8 * lq); }
        { const int wv2 = f >> 2, t2 = (f >> 1) & 1, ks = f & 1, dd = 32 * wv2 + 16 * t2 + l15, j0 = 32 * ks + 8 * lq; v4u o;
          o.x = (unsigned)k_s[(j0 + 0) * 264 + dd] | ((unsigned)k_s[(j0 + 1) * 264 + dd] << 16); o.y = (unsigned)k_s[(j0 + 2) * 264 + dd] | ((unsigned)k_s[(j0 + 3) * 264 + dd] << 16);
          o.z = (unsigned)k_s[(j0 + 4) * 264 + dd] | ((unsigned)k_s[(j0 + 5) * 264 + dd] << 16); o.w = (unsigned)k_s[(j0 + 6) * 264 + dd] | ((unsigned)k_s[(j0 + 7) * 264 + dd] << 16);
          *(v4u*)(KT + (size_t)u * 16384 + (size_t)p * 8) = o; } }
    __syncthreads();
    { const int p = tid, f = p >> 6, ln = p & 63, l15 = ln & 15, lq = ln >> 4, mi = f >> 1, kh = f & 1;
      *(v4u*)(ATT + (size_t)u * 4096 + (size_t)p * 8) = *(const v4u*)(a_s + (16 * mi + l15) * 72 + 32 * kh + 8 * lq); }
    { const int dv = tid; unsigned vp[32];
#pragma unroll
      for (int j = 0; j < 64; ++j) { const unsigned v = v_s[j * 520 + dv]; if (j & 1) vp[j >> 1] |= v << 16; else vp[j >> 1] = v; }
      v4u* dst = (v4u*)(VT + ((size_t)u * 512 + dv) * 64);
#pragma unroll
      for (int i = 0; i < 8; ++i) { v4u o; o.x = vp[4 * i]; o.y = vp[4 * i + 1]; o.z = vp[4 * i + 2]; o.w = vp[4 * i + 3]; dst[i] = o; } }
    __syncthreads();
}

__device__ __forceinline__ void gla_sample_unit(Frame& F, int u) {
    const bf16* P = (const bf16*)(F.ws + WS_P); bf16* O = (bf16*)(F.ws + WS_O);
    const int n = u >> 2, h = u & 3, tid = F.tid, lane = F.lane, wv = F.wave;
    const size_t m = (size_t)(TP + n);
    float* e_s = (float*)F.lds;
    float* qe_s = e_s + 256;
    float* k_s = qe_s + 256;
    float* v_s = k_s + 256;
    float* red_s = v_s + 512;
    float* op_s = red_s + 64;
    float part = 0.f;
    if (tid < 256) { const int d = tid; float x = F.bal[h * 256 + d];
#pragma unroll
        for (int r = 0; r < 16; ++r) x += ((const float*)(F.ws + WS_ALR))[m * 16 + r] * F.wau[r * 1024 + h * 256 + d];
        const float la = logsig(x) * 0.0625f, e = __expf(la);
        const float q = bf2f(P[m * PLD + C_Q + h * 256 + d]) * 0.0625f, k = bf2f(P[m * PLD + C_K + h * 256 + d]);
        e_s[d] = e; qe_s[d] = q * e; k_s[d] = k; part = q * k; }
    v_s[tid] = bf2f(P[m * PLD + C_V + h * 512 + tid]);
    part = wave_sum(part);
    if (lane == 0) red_s[wv] = part;
    __syncthreads();
    const float attn = (red_s[0] + red_s[1]) + (red_s[2] + red_s[3]);
    const float* Sin = F.sgla + ((size_t)(n * 4 + h) * 256) * 512; float* Sout = F.out + OUT_GLAS + ((size_t)(n * 4 + h) * 256) * 512;
    const f32x4 v0 = *(const f32x4*)(v_s + 4 * lane), v1 = *(const f32x4*)(v_s + 256 + 4 * lane);
    f32x4 o0 = {0.f, 0.f, 0.f, 0.f}, o1 = {0.f, 0.f, 0.f, 0.f};
#pragma unroll 1
    for (int g = 0; g < 4; ++g) {
        f32x4 s0[8], s1[8];
#pragma unroll
        for (int i = 0; i < 8; ++i) { const int d = 32 * wv + 8 * g + i; s0[i] = __builtin_nontemporal_load((const f32x4*)(Sin + (size_t)d * 512 + 4 * lane)); s1[i] = __builtin_nontemporal_load((const f32x4*)(Sin + (size_t)d * 512 + 256 + 4 * lane)); }
#pragma unroll
        for (int i = 0; i < 8; ++i) { const int d = 32 * wv + 8 * g + i; const float e = e_s[d], qe = qe_s[d], k = k_s[d];
            o0 += s0[i] * qe; o1 += s1[i] * qe;
            __builtin_nontemporal_store(s0[i] * e + v0 * k, (f32x4*)(Sout + (size_t)d * 512 + 4 * lane)); __builtin_nontemporal_store(s1[i] * e + v1 * k, (f32x4*)(Sout + (size_t)d * 512 + 256 + 4 * lane)); }
    }
    *(f32x4*)(op_s + wv * 512 + 4 * lane) = o0; *(f32x4*)(op_s + wv * 512 + 256 + 4 * lane) = o1;
    __syncthreads();
    { float o = attn * v_s[tid];
#pragma unroll
      for (int w8 = 0; w8 < 8; ++w8) o += op_s[w8 * 512 + tid];
      O[m * DM + h * 512 + tid] = (bf16)f2bf(o); }
    __syncthreads();
}

struct GlaRegs { bf16x8 kt[2][2], at, q[4]; v4u vpiece; float epiece; };
struct GlaOffs { unsigned l16, vt, eb; };
template <int NT>
__device__ __forceinline__ GlaOffs gla_offs(int lane, int tid) {
    const int tv = tid & (NT * 128 - 1); GlaOffs o;
    o.l16 = (unsigned)(lane * 16);
    o.vt = (unsigned)(((tv >> 3) * 64 + 8 * (tv & 7)) * 2);
    o.eb = (unsigned)((tid & 255) * 4);
    return o;
}
template <int NT>
__device__ __forceinline__ void gla_load(GlaRegs& R, const GlaOffs& o, const bf16* QT, const bf16* KT, const bf16* VT, const bf16* ATT, const float* EBL, int bh, int s, int c, int wv) {
    const size_t u = (size_t)bh * 32 + c;
    const char* pa = (const char*)(ATT + u * 4096) + wv * 1024; const char* pv = (const char*)(VT + (u * 512 + 16 * NT * s) * 64);
    const char* pq = (const char*)(QT + u * 16384) + wv * 4096; const char* pk = (const char*)(KT + u * 16384) + wv * 4096;
    R.at = *(const bf16x8*)(pa + o.l16);
    R.vpiece = *(const v4u*)(pv + o.vt);
    R.epiece = *(const float*)((const char*)(EBL + u * 256) + o.eb);
#pragma unroll
    for (int ks = 0; ks < 4; ++ks) R.q[ks] = *(const bf16x8*)(pq + o.l16 + 1024 * ks);
#pragma unroll
    for (int t = 0; t < 2; ++t)
#pragma unroll
        for (int ks = 0; ks < 2; ++ks) R.kt[t][ks] = *(const bf16x8*)(pk + o.l16 + 2048 * t + 1024 * ks);
}
constexpr int VT_LD = 72;
template <int NT>
__device__ __forceinline__ void gla_step(const GlaRegs& R, const float* ebs, f32x4 (&S)[2][NT], const bf16* vts, const bf16* STp, bf16* STn, float* xo, int wv, int lane, int l15, int lq) {
    const int mi = wv >> 1, kh = wv & 1;
#pragma unroll
    for (int nt = 0; nt < NT; ++nt) {
        f32x4 acc = {0.f, 0.f, 0.f, 0.f};
        { const bf16x8 vsel = *(const bf16x8*)(vts + (16 * nt + l15) * VT_LD + 32 * kh + 8 * lq); acc = MFMA16(R.at, vsel, acc); }
#pragma unroll
        for (int ks = 0; ks < 4; ++ks) { const bf16x8 sf = *(const bf16x8*)(STp + (16 * nt + l15) * 264 + 128 * kh + 32 * ks + 8 * lq); acc = MFMA16(R.q[ks], sf, acc); }
        *(f32x4*)(xo + (((mi * 2 + kh) * NT + nt) * 64 + lane) * 4) = acc;
    }
#pragma unroll
    for (int nt = 0; nt < NT; ++nt) {
        bf16x8 vt[2];
#pragma unroll
        for (int ks = 0; ks < 2; ++ks) vt[ks] = *(const bf16x8*)(vts + (16 * nt + l15) * VT_LD + 32 * ks + 8 * lq);
#pragma unroll
        for (int mt = 0; mt < 2; ++mt) {
#pragma unroll
            for (int ks = 0; ks < 2; ++ks) S[mt][nt] = MFMA16(R.kt[mt][ks], vt[ks], S[mt][nt]);
            S[mt][nt] = S[mt][nt] * *(const f32x4*)(ebs + 32 * wv + 16 * mt + 4 * lq);
            v2u w; w.x = pg8::cvt_pk_bf16(S[mt][nt][0], S[mt][nt][1]); w.y = pg8::cvt_pk_bf16(S[mt][nt][2], S[mt][nt][3]);
            *(v2u*)(STn + (16 * nt + l15) * 264 + 32 * wv + 16 * mt + 4 * lq) = w; } }
}
template <int NT>
__device__ __forceinline__ void gla_store_o(const float* xo, bf16* O, int b, int h, int s, int c, int wv, int lane, int l15, int lq) {
    const int mi = wv >> 1, kh = wv & 1;
#pragma unroll
    for (int n2 = 0; n2 < NT / 2; ++n2) { const int nt = kh * (NT / 2) + n2;
        const f32x4 t = *(const f32x4*)(xo + (((mi * 2 + 0) * NT + nt) * 64 + lane) * 4) + *(const f32x4*)(xo + (((mi * 2 + 1) * NT + nt) * 64 + lane) * 4);
        const unsigned p01 = pg8::cvt_pk_bf16(t[0], t[1]), p23 = pg8::cvt_pk_bf16(t[2], t[3]);
        bf16* dst = O + ((size_t)b * 2048 + 64 * c + 16 * mi + 4 * lq) * DM + h * 512 + 16 * NT * s + 16 * nt + l15;
        dst[0] = (bf16)(p01 & 0xffffu); dst[DM] = (bf16)(p01 >> 16); dst[2 * DM] = (bf16)(p23 & 0xffffu); dst[3 * DM] = (bf16)(p23 >> 16); }
}
#define GLA_BAR() do { asm volatile("s_waitcnt lgkmcnt(0)" ::: "memory"); __builtin_amdgcn_s_barrier(); asm volatile("" ::: "memory"); } while (0)
template <int NT>
__device__ __forceinline__ void gla_main_unit(Frame& F, int bh, int s) {
    const bf16* QT = (const bf16*)(F.ws + WS_QT); const bf16* KT = (const bf16*)(F.ws + WS_KT); const bf16* VT = (const bf16*)(F.ws + WS_VT);
    const bf16* ATT = (const bf16*)(F.ws + WS_ATT); const float* EBL = (const float*)(F.ws + WS_EBL); bf16* O = (bf16*)(F.ws + WS_O);
    const int b = bh >> 2, h = bh & 3, wv = F.wave, lane = F.lane, l15 = lane & 15, lq = lane >> 4, kh = wv & 1, tid = F.tid;
    constexpr int ST_ELEMS = NT * 16 * 264, XO_FLOATS = 8 * NT * 256, VTS_ELEMS = NT * 16 * VT_LD;
    bf16* ST = (bf16*)F.lds;
    float* XO = (float*)(F.lds + 2 * ST_ELEMS * 2);
    bf16* VTS = (bf16*)(F.lds + 2 * ST_ELEMS * 2 + 2 * XO_FLOATS * 4);
    float* EBS = (float*)(F.lds + 2 * ST_ELEMS * 2 + 2 * XO_FLOATS * 4 + 2 * VTS_ELEMS * 2);
    for (int e = tid; e < ST_ELEMS; e += 512) ((unsigned*)ST)[e] = 0u;
    f32x4 S[2][NT];
#pragma unroll
    for (int a = 0; a < 2; ++a)
#pragma unroll
        for (int c2 = 0; c2 < NT; ++c2) S[a][c2] = (f32x4){0.f, 0.f, 0.f, 0.f};
    const GlaOffs go = gla_offs<NT>(lane, tid);
    GlaRegs RA, RB, RC;
    gla_load<NT>(RA, go, QT, KT, VT, ATT, EBL, bh, s, 0, wv);
    gla_load<NT>(RB, go, QT, KT, VT, ATT, EBL, bh, s, 1, wv);
    if (tid < NT * 128) *(v4u*)(VTS + (tid >> 3) * VT_LD + 8 * (tid & 7)) = RA.vpiece;
    if (tid < 256) EBS[tid] = RA.epiece;
    __syncthreads();
#define GLA_ITER(c, RCUR, RNXT, RLD) do { if ((c) < 32) { \
            gla_load<NT>(RLD, go, QT, KT, VT, ATT, EBL, bh, s, (c) + 2 < 32 ? (c) + 2 : 31, wv); \
            gla_step<NT>(RCUR, EBS + ((c) & 1) * 256, S, VTS + ((c) & 1) * VTS_ELEMS, ST + ((c) & 1) * ST_ELEMS, ST + (((c) + 1) & 1) * ST_ELEMS, XO + ((c) & 1) * XO_FLOATS, wv, lane, l15, lq); \
            if ((c) > 0) gla_store_o<NT>(XO + (((c) + 1) & 1) * XO_FLOATS, O, b, h, s, (c) - 1, wv, lane, l15, lq); \
            if (tid < NT * 128) *(v4u*)(VTS + (((c) + 1) & 1) * VTS_ELEMS + (tid >> 3) * VT_LD + 8 * (tid & 7)) = RNXT.vpiece; \
            if (tid < 256) EBS[(((c) + 1) & 1) * 256 + tid] = RNXT.epiece; \
            GLA_BAR(); \
        } } while (0)
#pragma unroll 1
    for (int c = 0; c < 33; c += 3) { GLA_ITER(c, RA, RB, RC); GLA_ITER(c + 1, RB, RC, RA); GLA_ITER(c + 2, RC, RA, RB); }
#undef GLA_ITER
    gla_store_o<NT>(XO + (31 & 1) * XO_FLOATS, O, b, h, s, 31, wv, lane, l15, lq);
    int lq2 = lq; asm volatile("" : "+v"(lq2));
    float* So = F.out + OUT_GLAP + ((size_t)bh * 256) * 512;
#pragma unroll
    for (int mt = 0; mt < 2; ++mt)
#pragma unroll
        for (int nt = 0; nt < NT; ++nt)
#pragma unroll
            for (int r = 0; r < 4; ++r) So[(size_t)(32 * wv + 16 * mt + 4 * lq2 + r) * 512 + 16 * NT * s + 16 * nt + l15] = S[mt][nt][r];
    __syncthreads();
}

__device__ __forceinline__ void mixer_rows(Frame& F, int m0, int nr) {
    const bf16* P = (const bf16*)(F.ws + WS_P); const bf16* O = (const bf16*)(F.ws + WS_O); bf16* MM = (bf16*)(F.ws + WS_MM);
    const int lane = F.lane; const bool prompt = m0 < TP;
#pragma unroll 1
    for (int j = 0; j < 4; ++j) {
        const int col = 512 * j + 8 * lane;
        float u1[8], u2[8], gn[8], cbi[8], w0[8], w1[8], w2[8];
        { const f32x4 a = *(const f32x4*)(F.gng + col), b2 = *(const f32x4*)(F.gng + col + 4); gn[0] = a.x; gn[1] = a.y; gn[2] = a.z; gn[3] = a.w; gn[4] = b2.x; gn[5] = b2.y; gn[6] = b2.z; gn[7] = b2.w; }
        { const f32x4 a = *(const f32x4*)(F.cb + col), b2 = *(const f32x4*)(F.cb + col + 4); cbi[0] = a.x; cbi[1] = a.y; cbi[2] = a.z; cbi[3] = a.w; cbi[4] = b2.x; cbi[5] = b2.y; cbi[6] = b2.z; cbi[7] = b2.w; }
        { const f32x4 a = *(const f32x4*)(F.cw + col), b2 = *(const f32x4*)(F.cw + col + 4); w0[0] = a.x; w0[1] = a.y; w0[2] = a.z; w0[3] = a.w; w0[4] = b2.x; w0[5] = b2.y; w0[6] = b2.z; w0[7] = b2.w; }
        { const f32x4 a = *(const f32x4*)(F.cw + DM + col), b2 = *(const f32x4*)(F.cw + DM + col + 4); w1[0] = a.x; w1[1] = a.y; w1[2] = a.z; w1[3] = a.w; w1[4] = b2.x; w1[5] = b2.y; w1[6] = b2.z; w1[7] = b2.w; }
        { const f32x4 a = *(const f32x4*)(F.cw + 2 * DM + col), b2 = *(const f32x4*)(F.cw + 2 * DM + col + 4); w2[0] = a.x; w2[1] = a.y; w2[2] = a.z; w2[3] = a.w; w2[4] = b2.x; w2[5] = b2.y; w2[6] = b2.z; w2[7] = b2.w; }
        if (prompt) {
            const int t0 = m0 & 2047; const bf16* Pr = P + (size_t)m0 * PLD;
            if (t0 >= 1) { float a[8], b2[8]; unpack8(*(const v4u*)(Pr - PLD + C_CC + col), a); unpack8(*(const v4u*)(Pr - PLD + C_CX + col), b2);
#pragma unroll
                for (int e = 0; e < 8; ++e) u1[e] = a[e] * b2[e]; }
            else {
#pragma unroll
                for (int e = 0; e < 8; ++e) u1[e] = 0.f; }
            if (t0 >= 2) { float a[8], b2[8]; unpack8(*(const v4u*)(Pr - 2 * PLD + C_CC + col), a); unpack8(*(const v4u*)(Pr - 2 * PLD + C_CX + col), b2);
#pragma unroll
                for (int e = 0; e < 8; ++e) u2[e] = a[e] * b2[e]; }
            else {
#pragma unroll
                for (int e = 0; e < 8; ++e) u2[e] = 0.f; }
        } else {
            const int n = m0 - TP; const float* sc = F.sconv + (size_t)n * 2 * DM + col;
            const f32x4 a0 = *(const f32x4*)sc, a1 = *(const f32x4*)(sc + 4), b0 = *(const f32x4*)(sc + DM), b1 = *(const f32x4*)(sc + DM + 4);
            u2[0] = a0.x; u2[1] = a0.y; u2[2] = a0.z; u2[3] = a0.w; u2[4] = a1.x; u2[5] = a1.y; u2[6] = a1.z; u2[7] = a1.w;
            u1[0] = b0.x; u1[1] = b0.y; u1[2] = b0.z; u1[3] = b0.w; u1[4] = b1.x; u1[5] = b1.y; u1[6] = b1.z; u1[7] = b1.w;
        }
#pragma unroll 1
        for (int r = 0; r < nr; ++r) {
            const int m = m0 + r; const bf16* Pr = P + (size_t)m * PLD;
            float o[8], rr[8], cbv[8], cc[8], cx[8], ga[8], gb[8], u[8];
            unpack8(*(const v4u*)(O + (size_t)m * DM + col), o);
            unpack8(__builtin_nontemporal_load((const v4u*)(Pr + C_R + col)), rr); unpack8(__builtin_nontemporal_load((const v4u*)(Pr + C_CB + col)), cbv); unpack8(__builtin_nontemporal_load((const v4u*)(Pr + C_CC + col)), cc); unpack8(__builtin_nontemporal_load((const v4u*)(Pr + C_CX + col)), cx);
            unpack8(__builtin_nontemporal_load((const v4u*)(Pr + C_GA + col)), ga); unpack8(__builtin_nontemporal_load((const v4u*)(Pr + C_GB + col)), gb);
            float ss = 0.f;
#pragma unroll
            for (int e = 0; e < 8; ++e) ss += o[e] * o[e];
            const float rstd = 1.0f / sqrtf(wave_sum(ss) * (1.0f / 512.0f) + EPS);
#pragma unroll
            for (int e = 0; e < 8; ++e) u[e] = cc[e] * cx[e];
            if (prompt) { const int t = m & 2047;
                if (t >= 2046) { float* dst = F.out + OUT_CONVP + ((size_t)(m >> 11) * 2 + (t - 2046)) * DM + col;
                    *(f32x4*)dst = (f32x4){u[0], u[1], u[2], u[3]}; *(f32x4*)(dst + 4) = (f32x4){u[4], u[5], u[6], u[7]}; }
            } else { float* dst = F.out + OUT_CONVS + (size_t)(m - TP) * 2 * DM + col;
                *(f32x4*)dst = (f32x4){u1[0], u1[1], u1[2], u1[3]}; *(f32x4*)(dst + 4) = (f32x4){u1[4], u1[5], u1[6], u1[7]};
                *(f32x4*)(dst + DM) = (f32x4){u[0], u[1], u[2], u[3]}; *(f32x4*)(dst + DM + 4) = (f32x4){u[4], u[5], u[6], u[7]}; }
            float mv[8];
#pragma unroll
            for (int e = 0; e < 8; ++e) {
                const float ya = (rr[e] * sigmoidf_(rr[e])) * (o[e] * rstd * gn[e]);
                const float z = cbi[e] + w0[e] * u2[e] + w1[e] * u1[e] + w2[e] * u[e];
                mv[e] = sigmoidf_(ga[e]) * ya + sigmoidf_(gb[e]) * (cbv[e] * z);
                u2[e] = u1[e]; u1[e] = u[e];
            }
            *(v4u*)(MM + (size_t)m * DM + col) = pack8(mv);
        }
    }
}

constexpr int SC_LD = 130;
__device__ __forceinline__ int f2sort(float f) { const int b = __float_as_int(f); return b ^ ((b >> 31) & 0x7fffffff); }
__device__ __forceinline__ float sort2f(int s) { return __int_as_float(s ^ ((s >> 31) & 0x7fffffff)); }
#define CE_DESC(x, y) do { const int mx_ = max(x, y), mn_ = min(x, y); x = mx_; y = mn_; } while (0)
template <int N> __device__ __forceinline__ void bitonic_sort_desc(int (&a)[N]) {
#pragma unroll
    for (int k = 2; k <= N; k <<= 1)
#pragma unroll
        for (int j = k >> 1; j > 0; j >>= 1)
#pragma unroll
            for (int i = 0; i < N; ++i) { const int l = i ^ j; if (l > i) { if ((i & k) == 0) CE_DESC(a[i], a[l]); else CE_DESC(a[l], a[i]); } }
}
template <int N> __device__ __forceinline__ void bitonic_merge_desc(int (&a)[N]) {
#pragma unroll
    for (int j = N >> 1; j > 0; j >>= 1)
#pragma unroll
        for (int i = 0; i < N; ++i) { const int l = i ^ j; if (l > i) CE_DESC(a[i], a[l]); }
}
__device__ __forceinline__ void top16_merge(int (&a)[16], const int (&b)[16]) {
#pragma unroll
    for (int i = 0; i < 16; ++i) a[i] = max(a[i], b[15 - i]);
    bitonic_merge_desc<16>(a);
}
__device__ __attribute__((aligned(16))) const unsigned char PK_CAND[64] = {
    0x00, 0x01, 0x02, 0x03, 0x04, 0x05, 0x06, 0x07, 0x08, 0x09, 0x0a, 0x0b, 0x0c, 0x0d, 0x0e, 0x0f,
    0x10, 0x11, 0x12, 0x13, 0x14, 0x15, 0x16, 0x17, 0x20, 0x21, 0x22, 0x23, 0x24, 0x50, 0x51, 0xff,
    0x30, 0x31, 0x32, 0x33, 0x40, 0x41, 0x42, 0x60, 0x61, 0x70, 0x71, 0xff, 0xff, 0xff, 0xff, 0xff,
    0x80, 0x90, 0xa0, 0xb0, 0xc0, 0xd0, 0xe0, 0xf0, 0xff, 0xff, 0xff, 0xff, 0xff, 0xff, 0xff, 0xff};
constexpr int SC8_LD = 132, SK_LD = 136;
constexpr int SC8_BYTES = 128 * SC8_LD * 4, TV8_OFF = SC8_BYTES, SK_OFF = TV8_OFF + 128 * 16 * 4;
__device__ __forceinline__ void peer_load_subkeys(Frame& F) {
    const bf16* SKB = (const bf16*)(F.ws + WS_SKB); bf16* sk_s = (bf16*)(F.lds + SK_OFF);
    for (int e = F.tid; e < 256 * 16; e += 512) { const int row = e >> 4, ch = e & 15; *(v4u*)(sk_s + row * SK_LD + 8 * ch) = *(const v4u*)(SKB + (size_t)row * 128 + 8 * ch); }
    __syncthreads();
}
__device__ __forceinline__ void peer_qfrags(Frame& F, int tb, bf16x8 (&a)[2][4]) {
    const bf16* QP = (const bf16*)(F.ws + WS_QP); const int tok = min(tb + (F.lane & 7), TT - 1), lq = F.lane >> 4;
#pragma unroll
    for (int hf = 0; hf < 2; ++hf)
#pragma unroll
        for (int ks = 0; ks < 4; ++ks) a[hf][ks] = *(const bf16x8*)(QP + (size_t)tok * DM + F.wave * 256 + hf * 128 + 32 * ks + 8 * lq);
}
#define PK_BAR() do { asm volatile("s_waitcnt lgkmcnt(0)" ::: "memory"); __builtin_amdgcn_s_barrier(); asm volatile("" ::: "memory"); } while (0)
__device__ __forceinline__ void peer_topk_tile(Frame& F, int tb, int tend, bf16x8 (&a)[2][4]) {
    int* IDX = (int*)(F.ws + WS_IDX); float* GW = (float*)(F.ws + WS_GW);
    float* sc_s = (float*)F.lds;
    int* tv_s = (int*)(F.lds + TV8_OFF);
    const bf16* sk_s = (const bf16*)(F.lds + SK_OFF);
    const int wv = F.wave, lane = F.lane, l15 = lane & 15, lq = lane >> 4, tid = F.tid;
    {
#pragma unroll
      for (int hf = 0; hf < 2; ++hf) {
#pragma unroll
          for (int nt = 0; nt < 8; ++nt) { f32x4 acc = {0.f, 0.f, 0.f, 0.f};
#pragma unroll
              for (int ks = 0; ks < 4; ++ks) { const bf16x8 bq = *(const bf16x8*)(sk_s + (hf * 128 + 16 * nt + l15) * SK_LD + 32 * ks + 8 * lq); acc = MFMA16(a[hf][ks], bq, acc); }
              if (lq < 2) {
#pragma unroll
                  for (int r = 0; r < 4; ++r) sc_s[((wv * 2 + hf) * 8 + 4 * lq + r) * SC8_LD + 16 * nt + l15] = acc[r]; } } } }
    if (tb + 8 < tend) peer_qfrags(F, tb + 8, a);
    PK_BAR();
    { const int row = tid >> 2, sub = tid & 3; const float* rp = sc_s + row * SC8_LD;
      int top[16], v[16];
#pragma unroll
      for (int i = 0; i < 16; ++i) { const int key = 4 * i + sub; top[i] = (f2sort(rp[key]) & ~127) | (127 - key); }
      bitonic_sort_desc<16>(top);
#pragma unroll
      for (int i = 0; i < 16; ++i) { const int key = 4 * (16 + i) + sub; v[i] = (f2sort(rp[key]) & ~127) | (127 - key); }
      bitonic_sort_desc<16>(v);
      top16_merge(top, v);
#pragma unroll
      for (int sh = 1; sh < 4; sh <<= 1) {
#pragma unroll
          for (int i = 0; i < 16; ++i) v[i] = __shfl_xor(top[i], sh);
          top16_merge(top, v); }
      if (sub == 0) {
#pragma unroll
          for (int q = 0; q < 4; ++q) *(int __attribute__((ext_vector_type(4)))*)(tv_s + row * 16 + 4 * q) = (int __attribute__((ext_vector_type(4)))){top[4 * q], top[4 * q + 1], top[4 * q + 2], top[4 * q + 3]}; }
    }
    PK_BAR();
    if (tid < 256) { const int it = tid >> 2, qd = tid & 3, tl = it & 7, hd = it >> 3;
      const int* r1 = tv_s + ((hd * 2 + 0) * 8 + tl) * 16; const int* r2 = tv_s + ((hd * 2 + 1) * 8 + tl) * 16;
      int c[16];
      const v4u cw = *(const v4u*)(PK_CAND + qd * 16);
#pragma unroll
      for (int t = 0; t < 16; ++t) { const int ab = (int)((cw[t >> 2] >> (8 * (t & 3))) & 0xffu); const int abc = ab != 0xff ? ab : 0;
          const float sv = sort2f(r1[abc >> 4] & ~127) + sort2f(r2[abc & 15] & ~127); const int packed = (f2sort(sv) & ~255) | (255 - ab);
          c[t] = ab != 0xff ? packed : (int)0x80000000; }
      bitonic_sort_desc<16>(c);
#pragma unroll
      for (int sh = 1; sh < 4; sh <<= 1) { int oth[16];
#pragma unroll
          for (int i = 0; i < 16; ++i) oth[i] = __shfl_xor(c[i], sh);
          top16_merge(c, oth); }
      const int tok = tb + tl;
      if (tok < tend) {
          float ev[16], sum = 0.f; const float mx = sort2f(c[0] & ~255);
#pragma unroll
          for (int k = 0; k < 16; ++k) { ev[k] = __expf(sort2f(c[k] & ~255) - mx); sum += ev[k]; }
          const float inv = 1.0f / sum;
#pragma unroll
          for (int k = 0; k < 16; ++k) if ((k >> 2) == qd) { const int ab = 255 - (c[k] & 255); const int i1 = 127 - (r1[ab >> 4] & 127), i2 = 127 - (r2[ab & 15] & 127);
              IDX[(size_t)tok * 128 + hd * 16 + k] = i1 * 128 + i2; GW[(size_t)tok * 128 + hd * 16 + k] = ev[k] * inv; }
      }
    }
    PK_BAR();
}

__device__ __forceinline__ void peer_phase(Frame& F, int tok0, int tok1) {
    const unsigned char* U6 = F.ws + WS_EU; const unsigned char* V6 = F.ws + WS_EV; const float* SU = (const float*)(F.ws + WS_EU + 32 * MiB); const float* SV = (const float*)(F.ws + WS_EV + 32 * MiB);
    const float* X2 = (const float*)(F.ws + WS_X2); const float* RS2 = (const float*)(F.ws + WS_RS2); const int* IDX = (const int*)(F.ws + WS_IDX); const float* GW = (const float*)(F.ws + WS_GW);
    const int wv = F.wave, lane = F.lane, tid = F.tid;
    float* red_s = (float*)F.lds;
    float* ss_s = (float*)(F.lds + 131072);
    const f32x4 gfin = *(const f32x4*)(F.nfg + 4 * tid);
    f32x4 x3p = {0.f, 0.f, 0.f, 0.f}; int buf = 0;
#pragma unroll 1
    for (int m = tok0; m <= tok1; ++m) {
        if (m < tok1) {
            const int myidx = IDX[(size_t)m * 128 + wv * 16 + (lane & 15)]; float myg = GW[(size_t)m * 128 + wv * 16 + (lane & 15)];
            const float mysu = SU[myidx] * RS2[m]; myg *= SV[myidx];
            float hf[32];
#pragma unroll
            for (int j = 0; j < 8; ++j) { const f32x4 w = *(const f32x4*)(X2 + (size_t)m * DM + 256 * j + 4 * lane); hf[4 * j] = w.x; hf[4 * j + 1] = w.y; hf[4 * j + 2] = w.z; hf[4 * j + 3] = w.w; }
            float acc[32];
#pragma unroll
            for (int k = 0; k < 32; ++k) acc[k] = 0.f;
#pragma unroll 1
            for (int kg = 0; kg < 4; ++kg) {
                v4u ul4[4], vl4[4]; v2u ul2[4], vl2[4]; float gk[4], su[4];
#pragma unroll
                for (int kk = 0; kk < 4; ++kk) { const int ex = __shfl(myidx, kg * 4 + kk); gk[kk] = __shfl(myg, kg * 4 + kk); su[kk] = __shfl(mysu, kg * 4 + kk);
                    const unsigned char* ur = U6 + (size_t)ex * ROW6; const unsigned char* vr = V6 + (size_t)ex * ROW6;
                    ul4[kk] = *(const v4u*)(ur + 16 * lane); ul2[kk] = *(const v2u*)(ur + 1024 + 8 * lane); vl4[kk] = *(const v4u*)(vr + 16 * lane); vl2[kk] = *(const v2u*)(vr + 1024 + 8 * lane); }
#pragma unroll
                for (int kk = 0; kk < 4; ++kk) {
                    const v32f uf = __builtin_amdgcn_cvt_scalef32_pk32_f32_fp6((v6u){ul4[kk].x, ul4[kk].y, ul4[kk].z, ul4[kk].w, ul2[kk].x, ul2[kk].y}, 1.0f);
                    float dot = 0.f;
#pragma unroll
                    for (int k = 0; k < 32; ++k) dot += uf[k] * hf[k];
                    const float a = wave_sum(dot) * su[kk];
                    const float wgt = gk[kk] * (0.5f * a * (1.0f + erff(a * 0.70710678118654752f)));
                    const v32f vf = __builtin_amdgcn_cvt_scalef32_pk32_f32_fp6((v6u){vl4[kk].x, vl4[kk].y, vl4[kk].z, vl4[kk].w, vl2[kk].x, vl2[kk].y}, 1.0f);
#pragma unroll
                    for (int k = 0; k < 32; ++k) acc[k] += wgt * vf[k];
                }
            }
#pragma unroll
            for (int j = 0; j < 8; ++j) *(f32x4*)(red_s + (buf * 8 + wv) * 2048 + 256 * j + 4 * lane) = (f32x4){acc[4 * j], acc[4 * j + 1], acc[4 * j + 2], acc[4 * j + 3]};
        }
        __syncthreads();
        if (m > tok0) {
            float tot = 0.f;
#pragma unroll
            for (int w8 = 0; w8 < 8; ++w8) tot += ss_s[(buf ^ 1) * 8 + w8];
            const float rstd = 1.0f / sqrtf(tot * (1.0f / DM) + EPS);
            *(f32x4*)(F.out + OUT_Y + (size_t)(m - 1) * DM + 4 * tid) = x3p * rstd * gfin;
        }
        if (m < tok1) {
            f32x4 x3 = *(const f32x4*)(X2 + (size_t)m * DM + 4 * tid);
#pragma unroll
            for (int w8 = 0; w8 < 8; ++w8) x3 += *(const f32x4*)(red_s + (buf * 8 + w8) * 2048 + 4 * tid);
            const float ss = wave_sum((x3.x * x3.x + x3.y * x3.y) + (x3.z * x3.z + x3.w * x3.w));
            if (lane == 0) ss_s[buf * 8 + wv] = ss;
            x3p = x3;
        }
        buf ^= 1;
    }
    __syncthreads();
}
struct Args { const float* in[18]; float* out; unsigned char* ws; int ph_lo, ph_hi; };
__global__ void __launch_bounds__(NWAVES * 64, 2) mk_fwd(Args args) {
    extern __shared__ __attribute__((aligned(16))) unsigned char lds[];
    Frame F;
    F.lds = lds;
    F.tid = threadIdx.x; F.lane = F.tid & 63; F.wave = __builtin_amdgcn_readfirstlane(F.tid >> 6);
    F.G = gridDim.x; { const int bx = blockIdx.x; F.vcu = (F.G % 8 == 0) ? (bx % 8) * (F.G / 8) + bx / 8 : bx; }
    F.xp = args.in[0]; F.xs = args.in[1]; F.sgla = args.in[2]; F.sconv = args.in[3]; F.n1g = args.in[4]; F.win = args.in[5]; F.wau = args.in[6]; F.bal = args.in[7];
    F.gng = args.in[8]; F.cw = args.in[9]; F.cb = args.in[10]; F.wout = args.in[11]; F.n2g = args.in[12]; F.wq = args.in[13]; F.sk = args.in[14]; F.eu = args.in[15];
    F.ev = args.in[16]; F.nfg = args.in[17]; F.out = args.out; F.ws = args.ws;
    for (int u = F.tid; u < (LDS_BYTES - LDSCTL_OFF) / 4; u += NWAVES * 64) ((LAS unsigned*)((LAS unsigned char*)lds + LDSCTL_OFF))[u] = 0u;
    __syncthreads();
    gu32* ctl = (gu32*)(F.ws + WS_CTL);
    XcdBarrier bar; bar.bar = (unsigned*)(ctl + CW_BAR); bar.x = 0; bar.st = nullptr;
    if (N_LAUNCHES == 1) bar = xcd_barrier_post((unsigned*)(ctl + CW_BAR), (volatile LAS unsigned*)((LAS unsigned char*)lds + MISC_OFF) + 8);
    const int lo = args.ph_lo, hi = args.ph_hi;
#ifndef SKREP
#define SKREP 1
#endif
#ifndef PROBE_DBL
#define PROBE_DBL -1
#endif
#define IN(k) (lo <= (k) && (k) < hi)
#define REP(k) for (int rep_ = 0; rep_ < ((k) == PROBE_DBL ? 2 : 1); ++rep_)
#ifndef BAR_REP
#define BAR_REP 1
#endif
#define SEAM(k) do { if (IN(k) && IN((k) + 1)) for (int br_ = 0; br_ < BAR_REP; ++br_) xcd_barrier(bar); } while (0)
    const int gw = F.vcu * NWAVES + F.wave, NGW = F.G * NWAVES;
    const int tok0 = (int)(((long)F.vcu * TT) / F.G), tok1 = (int)(((long)(F.vcu + 1) * TT) / F.G);

    if (IN(0)) REP(0) { p0_prologue(F); __syncthreads(); }
    SEAM(0);
    if (IN(1)) REP(1) {
        pg8::Gemm g{(const pg8::bf16_t*)(F.ws + WS_XN), (const pg8::bf16_t*)(F.ws + WS_WINT), TP, NP, DM}; pg8::StaticOrder S; S.init(TP, NP, F.G, (int)blockIdx.x);
        pg8::EpiBf16<0> E{(pg8::bf16_t*)(F.ws + WS_P), PLD, nullptr, 0, 0, 1.f};
        pg8::gemm_phase<pg8::EpiBf16<0>, pg8::StaticOrder, true, true>((PG8_LAS unsigned char*)lds + RING_OFF, g, S, E);
#ifdef GEMM1_TWICE
        pg8::gemm_phase<pg8::EpiBf16<0>, pg8::StaticOrder, true, true>((PG8_LAS unsigned char*)lds + RING_OFF, g, S, E);
#endif
        { EpiSkBf16 Es{(bf16*)(F.ws + WS_P) + (size_t)TP * PLD, PLD, nullptr};
          for (int skr = 0; skr < SKREP; ++skr) for (int ng = F.vcu; ng < NP / 64; ng += F.G) skinny_gemm<4>(F, (const bf16*)(F.ws + WS_XN) + (size_t)TP * DM, (const bf16*)(F.ws + WS_WINT), 64 * ng, Es); }
    }
    SEAM(1);
    if (IN(2)) REP(2) { for (int u = F.vcu; u < 512; u += F.G) gla_prep_unit(F, u); }
    SEAM(2);
    if (IN(3)) REP(3) {
        if ((F.vcu & 1) == 0) { for (int g = F.vcu >> 1; g < 128; g += (F.G + 1) >> 1) gla_main_unit<4>(F, g >> 3, g & 7); }
        volatile LAS unsigned* qslot = (volatile LAS unsigned*)((LAS unsigned char*)lds + LDSCTL_OFF + 16);
#ifndef PROBE_STREAM
#define PROBE_STREAM 1
#endif
        for (int sr = 0; sr < PROBE_STREAM; ++sr) {
            if (sr > 0) xcd_barrier(bar);
            for (;;) {
                if (F.tid == 0) *qslot = __hip_atomic_fetch_add((unsigned*)(ctl + CW_QUEUE + 64 * (rep_ + 2 * sr)), 1u, __ATOMIC_RELAXED, __HIP_MEMORY_SCOPE_AGENT);
                __syncthreads();
                const unsigned u = *qslot;
                __syncthreads();
                if (u >= 512u) break;
                gla_sample_unit(F, (int)u);
            }
        }
    }
    SEAM(3);
    if (IN(4)) REP(4) {
        bf16* MM = (bf16*)(F.ws + WS_MM);
        for (int g = gw; g < TP / 4; g += NGW) mixer_rows(F, 4 * g, 4);
        for (int n = gw; n < TS; n += NGW) mixer_rows(F, TP + n, 1);
        for (int m = TT + gw; m < MP; m += NGW) zero_row_bf16(MM + (size_t)m * DM, F.lane);
    }
    SEAM(4);
    if (IN(5)) REP(5) {
        pg8::Gemm g{(const pg8::bf16_t*)(F.ws + WS_MM), (const pg8::bf16_t*)(F.ws + WS_WOUTT), TP, DM, DM}; pg8::StaticOrder S; S.init(TP, DM, F.G, (int)blockIdx.x);
        pg8::EpiF32Res E{F.xp, (float*)(F.ws + WS_X2), (pg8::bf16_t*)(F.ws + WS_H2), (float*)(F.ws + WS_SSQ), DM};
        pg8::gemm_phase<pg8::EpiF32Res, pg8::StaticOrder, true, true>((PG8_LAS unsigned char*)lds + RING_OFF, g, S, E);
#ifdef GEMM2_TWICE
        pg8::gemm_phase<pg8::EpiF32Res, pg8::StaticOrder, true, true>((PG8_LAS unsigned char*)lds + RING_OFF, g, S, E);
#endif
        { EpiSkF32Res Es{F.xs, (float*)(F.ws + WS_X2) + (size_t)TP * DM, (bf16*)(F.ws + WS_H2) + (size_t)TP * DM, (float*)(F.ws + WS_SSQS)};
          for (int skr = 0; skr < SKREP; ++skr) for (int ng = F.vcu; ng < DM / 16; ng += F.G) skinny_gemm<1>(F, (const bf16*)(F.ws + WS_MM) + (size_t)TP * DM, (const bf16*)(F.ws + WS_WOUTT), 16 * ng, Es); }
    }
    SEAM(5);
    if (IN(6)) REP(6) {
        float* rs_s = (float*)(lds + 131072);
        float* rss_s = rs_s + 512;
        float* RS2 = (float*)(F.ws + WS_RS2);
        pg8::Gemm g{(const pg8::bf16_t*)(F.ws + WS_H2), (const pg8::bf16_t*)(F.ws + WS_WQT), TP, DM, DM}; pg8::StaticOrder S; S.init(TP, DM, F.G, (int)blockIdx.x);
        { pg8::Unit u0;
          if (S.next(0, u0) && F.tid < 256) { const int row = u0.pm * 256 + F.tid; const f32x4* p = (const f32x4*)((const float*)(F.ws + WS_SSQ) + (size_t)row * 32); f32x4 a4 = p[0];
#pragma unroll
              for (int i = 1; i < 8; ++i) a4 += p[i];
              const float rstd = 1.0f / sqrtf(((a4.x + a4.y) + (a4.z + a4.w)) * (1.0f / DM) + EPS); rs_s[F.tid] = rstd; if (u0.pn == 0) RS2[row] = rstd; }
          if (F.tid >= 256 && F.tid < 384 && F.vcu < DM / 16) { const int row = F.tid - 256; const f32x4* p = (const f32x4*)((const float*)(F.ws + WS_SSQS) + (size_t)row * 128); f32x4 a4 = p[0];
#pragma unroll
              for (int i = 1; i < 32; ++i) a4 += p[i];
              const float rstd = 1.0f / sqrtf(((a4.x + a4.y) + (a4.z + a4.w)) * (1.0f / DM) + EPS); rss_s[row] = rstd; if (F.vcu == 0) RS2[TP + row] = rstd; }
          __syncthreads(); }
        pg8::EpiBf16RowScale E{(pg8::bf16_t*)(F.ws + WS_QP), DM, rs_s};
        pg8::gemm_phase<pg8::EpiBf16RowScale, pg8::StaticOrder, true, true>((PG8_LAS unsigned char*)lds + RING_OFF, g, S, E);
#ifdef GEMM3_TWICE
        pg8::gemm_phase<pg8::EpiBf16RowScale, pg8::StaticOrder, true, true>((PG8_LAS unsigned char*)lds + RING_OFF, g, S, E);
#endif
        { EpiSkBf16 Es{(bf16*)(F.ws + WS_QP) + (size_t)TP * DM, DM, rss_s};
          for (int skr = 0; skr < SKREP; ++skr) for (int ng = F.vcu; ng < DM / 16; ng += F.G) skinny_gemm<1>(F, (const bf16*)(F.ws + WS_H2) + (size_t)TP * DM, (const bf16*)(F.ws + WS_WQT), 16 * ng, Es); }
    }
    SEAM(6);
    if (IN(7)) REP(7) { bf16x8 qa[2][4]; peer_qfrags(F, tok0, qa); peer_load_subkeys(F); for (int tb = tok0; tb < tok1; tb += 8) peer_topk_tile(F, tb, tok1, qa); __syncthreads(); }
    SEAM(7);
    if (IN(8)) REP(8) { peer_phase(F, tok0, tok1); }
#undef IN
#undef SEAM
}

extern "C" void kernel_launch(void* const* d_in, const int* in_sizes, int n_in, void* d_out, int out_size, void* d_ws, size_t ws_size, hipStream_t stream) {
    static int grid = 0;
    if (grid == 0) {
        if (n_in != 18 || ws_size < WS_END) { fprintf(stderr, "kernel_launch: expected 18 inputs and >= %zu bytes of workspace; got %d, %zu\n", (size_t)WS_END, n_in, ws_size); grid = -1; return; }
        int dev = 0, cus = 0;
        if (hipGetDevice(&dev) != hipSuccess || hipDeviceGetAttribute(&cus, hipDeviceAttributeMultiprocessorCount, dev) != hipSuccess) { grid = -1; return; }
        if (hipFuncSetAttribute((const void*)mk_fwd, hipFuncAttributeMaxDynamicSharedMemorySize, LDS_BYTES) != hipSuccess) { fprintf(stderr, "kernel_launch: hipFuncSetAttribute failed\n"); grid = -1; return; }
        (void)hipGetLastError();
        grid = cus;
    }
    if (grid < 0) return;
    (void)hipMemsetAsync((char*)d_ws + WS_CTL, 0, CTL_ZERO_BYTES, stream);
    Args a{};
    for (int i = 0; i < 18; ++i) a.in[i] = (const float*)d_in[i];
    a.out = (float*)d_out; a.ws = (unsigned char*)d_ws;
    if (N_LAUNCHES == 1) { a.ph_lo = 0; a.ph_hi = N_PHASES; hipLaunchKernelGGL(mk_fwd, dim3(grid), dim3(NWAVES * 64), LDS_BYTES, stream, a); }
    else { for (int li = 0; li < N_PHASES; ++li) { a.ph_lo = li; a.ph_hi = li + 1; hipLaunchKernelGGL(mk_fwd, dim3(grid), dim3(NWAVES * 64), LDS_BYTES, stream, a); } }
}
```

```cpp
#include <hip/hip_runtime.h>
#include <cstdio>
#include <cstdint>
#include <cmath>
#define MK_N_LAUNCHES 1
namespace pg8 {
#define PG8_LAS __attribute__((address_space(3)))
typedef unsigned short bf16_t;
typedef short bf16x8 __attribute__((ext_vector_type(8)));
typedef float f32x4 __attribute__((ext_vector_type(4)));
typedef unsigned u32x4 __attribute__((ext_vector_type(4)));
constexpr int BM = 256, BK = 64, HALF = 128, HTB = HALF * BK * 2  , STAGE_BYTES = 8 * HTB, NXCD = 8;
#ifndef PG8_WGM
#define PG8_WGM 3
#endif
constexpr int WGM = PG8_WGM;

__host__ __device__ __forceinline__ int lds_byte(int r, int c) { const int st = (r >> 4) * 2 + (c >> 5), rr = r & 15, cc = c & 31, ob = rr * 64 + cc * 2; return st * 1024 + (ob ^ (((ob >> 9) & 1) << 5)); }
__host__ __device__ __forceinline__ void stage_rc(int b, int& R, int& C) { const int st = b / 1024, sb = b % 1024, swz = sb ^ (((sb >> 9) & 1) << 5); R = (st >> 1) * 16 + swz / 64; C = (st & 1) * 32 + (swz % 64) / 2; }
__host__ __device__ __forceinline__ int perm32(int rho) { const int n = rho >> 4, i = rho & 15; return 8 * (i >> 2) + 4 * n + (i & 3); }

struct Unit { int pm, pn; };
struct Gemm { const bf16_t* A; const bf16_t* Bt; int M, N, K; };

struct StaticOrder {
    int nM, nN, nwg, G, c, wgm;
    __host__ __device__ void init(int M, int N, int G_, int c_, int wgm_ = WGM) { nM = M / BM; nN = N / BM; nwg = nM * nN; G = G_; c = c_; wgm = wgm_; }
    __host__ __device__ bool next(int i, Unit& u) const {
        const long L = (long)i * G + c; if (L >= nwg) return false;
        int wgid = (int)L; if (wgm > 0) { const int q = nwg / NXCD, r = nwg % NXCD, xcd = wgid % NXCD, off = wgid / NXCD; wgid = (xcd < r ? xcd * (q + 1) : r * (q + 1) + (xcd - r) * q) + off; }
        const int wgm = this->wgm > 0 ? this->wgm : -this->wgm;
        const int nig = wgm * nN, gid = wgid / nig, fm = gid * wgm, gsz = (nM - fm) < wgm ? (nM - fm) : wgm;
        u.pm = fm + ((wgid % nig) % gsz); u.pn = (wgid % nig) / gsz; return true;
    }
    __device__ __forceinline__ void a_ready(const Unit&) const {}
    __device__ __forceinline__ void done(const Unit&) const {}
};

__device__ __forceinline__ unsigned cvt_pk_bf16(float lo, float hi) { unsigned r; asm volatile("v_cvt_pk_bf16_f32 %0, %1, %2" : "=v"(r) : "v"(lo), "v"(hi)); return r; }
typedef float f32x2 __attribute__((ext_vector_type(2)));
__device__ __forceinline__ f32x2 gelu_pk(f32x2 v) {
    const f32x2 av = __builtin_elementwise_abs(v), d = av * 0.2316418882f + 1.0f;
    f32x2 t; t.x = __builtin_amdgcn_rcpf(d.x); t.y = __builtin_amdgcn_rcpf(d.y);
    f32x2 q = t * 0.5307027145f + (-0.7265760135f); q = q * t + 0.7107068705f; q = q * t + (-0.142248368f); q = q * t + 0.127414796f; q = q * t;
    const f32x2 s = (v * v) * (-0.72134752044f);
    f32x2 e; e.x = __builtin_amdgcn_exp2f(s.x); e.y = __builtin_amdgcn_exp2f(s.y);
    const f32x2 m = v * (q * e), r = v - m;
    f32x2 o; o.x = v.x < 0.f ? m.x : r.x; o.y = v.y < 0.f ? m.y : r.y; return o;
}

template <int ACT  > struct EpiBf16 {
    static constexpr bool PERM = true, AFTER_DRAIN = false; static_assert(ACT == 0 || ACT == 1, "EpiBf16: ACT is 0 (none) or 1 (gelu_pk)");
    bf16_t* O; int ldc; const float* bias; int split_cols; size_t split_stride; float scale0;
    __device__ __forceinline__ void operator()(const f32x4 (&acc)[2][2][4][2], const Unit& u, int wr, int wc, int fr, int fq) const {
        const int row0 = u.pm * BM + wr * 64 + fr; int colt = u.pn * BM; bf16_t* base = O;
        float sc = 1.f; if (split_cols) { const int t = colt / split_cols; base += (size_t)t * split_stride; colt -= t * split_cols; if (t == 0) sc = scale0; }
        const int col0 = colt + wc * 32 + 8 * fq, bcol0 = u.pn * BM + wc * 32 + 8 * fq;
        f32x4 bv[2][2];
#pragma unroll
        for (int bj = 0; bj < 2; ++bj)
#pragma unroll
            for (int n = 0; n < 2; ++n) bv[bj][n] = bias ? *(const f32x4*)(bias + bcol0 + bj * HALF + 4 * n) : (f32x4){0.f, 0.f, 0.f, 0.f};
#pragma unroll
        for (int ai = 0; ai < 2; ++ai)
#pragma unroll
            for (int m = 0; m < 4; ++m) { bf16_t* rowp = base + (size_t)(row0 + ai * HALF + m * 16) * ldc + col0;
#pragma unroll
                for (int bj = 0; bj < 2; ++bj) { f32x4 v0 = acc[ai][bj][m][0] + bv[bj][0], v1 = acc[ai][bj][m][1] + bv[bj][1];
                    if (ACT == 1) { f32x2 a = gelu_pk((f32x2){v0[0], v0[1]}), b = gelu_pk((f32x2){v0[2], v0[3]}), c = gelu_pk((f32x2){v1[0], v1[1]}), d = gelu_pk((f32x2){v1[2], v1[3]});
                        v0 = (f32x4){a.x, a.y, b.x, b.y}; v1 = (f32x4){c.x, c.y, d.x, d.y}; }
                    v0 = v0 * sc; v1 = v1 * sc; u32x4 w; w.x = cvt_pk_bf16(v0[0], v0[1]); w.y = cvt_pk_bf16(v0[2], v0[3]); w.z = cvt_pk_bf16(v1[0], v1[1]); w.w = cvt_pk_bf16(v1[2], v1[3]);
                    __builtin_nontemporal_store(w, (u32x4*)(rowp + bj * HALF)); } }
    }
};
template <class Epi, class Sched, bool ALIGN_EPI = false, bool SP2 = false>
__device__ __forceinline__ void gemm_phase(PG8_LAS unsigned char* lds, const Gemm g, const Sched& S, const Epi& E) {
    const int tid = threadIdx.x, wid = __builtin_amdgcn_readfirstlane(tid >> 6), lane = tid & 63, wr = wid >> 2, wc = wid & 3, fr = lane & 15, fq = lane >> 4;
    const int K = g.K, nt = K / BK;
    unsigned voffA[2], voffB[2];
#pragma unroll
    for (int i = 0; i < 2; ++i) { int R, C; stage_rc(tid * 16 + i * 8192, R, C); const int Rb = Epi::PERM ? ((R & ~31) + perm32(R & 31)) : R;
        voffA[i] = (unsigned)(R * K + C) * 2u; voffB[i] = (unsigned)(Rb * K + C) * 2u; }
    const size_t kstep = (size_t)(BK * 2);
    const size_t hstep = (size_t)HALF * K * 2;
    const size_t tstep = 2 * hstep;
    const unsigned ldsw = (unsigned)wid * 1024u;
    const int aoff = lds_byte(wr * 64 + fr, fq * 8), boff = lds_byte(wc * 32 + fr, fq * 8);
#define PG8_SA(b, h) (((b) * 2 + (h)) * HTB)
#define PG8_SB(b, h) ((4 + (b) * 2 + (h)) * HTB)
#define PG8_STAGE(bufoff, gbase, voff) do { _Pragma("unroll") for (int _i = 0; _i < 2; ++_i) \
        __builtin_amdgcn_global_load_lds((const unsigned*)((const char*)(gbase) + (voff)[_i]), (PG8_LAS unsigned*)(lds + (bufoff) + ldsw + _i * 8192), 16, 0, 0); } while (0)
#define PG8_LDA(dst, b, h) do { _Pragma("unroll") for (int m = 0; m < 4; ++m) _Pragma("unroll") for (int k = 0; k < 2; ++k) dst[m][k] = *(const PG8_LAS bf16x8*)(lds + PG8_SA(b, h) + aoff + m * 2048 + k * 1024); } while (0)
#define PG8_LDB(dst, b, h) do { _Pragma("unroll") for (int n = 0; n < 2; ++n) _Pragma("unroll") for (int k = 0; k < 2; ++k) dst[n][k] = *(const PG8_LAS bf16x8*)(lds + PG8_SB(b, h) + boff + n * 2048 + k * 1024); } while (0)
#define PG8_MMA(ai, bj, At, Bt) do { __builtin_amdgcn_s_setprio(1); _Pragma("unroll") for (int m = 0; m < 4; ++m) _Pragma("unroll") for (int n = 0; n < 2; ++n) _Pragma("unroll") for (int k = 0; k < 2; ++k) \
        acc[ai][bj][m][n] = __builtin_amdgcn_mfma_f32_16x16x32_bf16(Bt[n][k], At[m][k], acc[ai][bj][m][n], 0, 0, 0); __builtin_amdgcn_s_setprio(0); } while (0)
#define PG8_WAIT_V(n) asm volatile("s_waitcnt vmcnt(" #n ")" ::: "memory")
#define PG8_WAIT_L(n) asm volatile("s_waitcnt lgkmcnt(" #n ")" ::: "memory")
#define PG8_BAR __builtin_amdgcn_s_barrier()
#define PG8_SCHED __builtin_amdgcn_sched_barrier(0)
    Unit cur, nxt; int ui = 0;
    if (!S.next(0, cur)) return;
    f32x4 acc[2][2][4][2];
#pragma unroll
    for (int a = 0; a < 2; ++a)
#pragma unroll
        for (int b = 0; b < 2; ++b)
#pragma unroll
            for (int m = 0; m < 4; ++m)
#pragma unroll
                for (int n = 0; n < 2; ++n) acc[a][b][m][n] = (f32x4){0.f, 0.f, 0.f, 0.f};
    bf16x8 At[4][2], B0[2][2], B1[2][2];
    const char* cA = (const char*)g.A + (size_t)cur.pm * tstep; const char* cB = (const char*)g.Bt + (size_t)cur.pn * tstep;
    S.a_ready(cur);
    if constexpr (SP2) {
        PG8_STAGE(PG8_SB(0, 0), cB, voffB); PG8_STAGE(PG8_SB(0, 1), cB + hstep, voffB); PG8_STAGE(PG8_SA(0, 0), cA, voffA); PG8_STAGE(PG8_SA(0, 1), cA + hstep, voffA);
        if (wr == 1) PG8_BAR;
        PG8_WAIT_V(2); PG8_BAR;
        PG8_STAGE(PG8_SB(1, 0), cB + kstep, voffB); PG8_STAGE(PG8_SA(1, 0), cA + kstep, voffA); PG8_STAGE(PG8_SB(1, 1), cB + hstep + kstep, voffB);
        PG8_WAIT_V(6); PG8_BAR;
    } else {
        PG8_STAGE(PG8_SB(0, 0), cB, voffB); PG8_STAGE(PG8_SA(0, 0), cA, voffA); PG8_STAGE(PG8_SB(0, 1), cB + hstep, voffB); PG8_STAGE(PG8_SA(0, 1), cA + hstep, voffA);
        if (wr == 1) PG8_BAR;
        PG8_WAIT_V(4); PG8_BAR;
        PG8_STAGE(PG8_SB(1, 0), cB + kstep, voffB); PG8_STAGE(PG8_SA(1, 0), cA + kstep, voffA); PG8_STAGE(PG8_SB(1, 1), cB + hstep + kstep, voffB);
        PG8_WAIT_V(6); PG8_BAR;
    }
    for (;;) {
        const bool has_next = S.next(ui + 1, nxt);
        const char* nA = has_next ? (const char*)g.A + (size_t)nxt.pm * tstep : cA; const char* nB = has_next ? (const char*)g.Bt + (size_t)nxt.pn * tstep : cB;
        for (int t = 0; t < nt; t += 2) {
            const bool last = (t == nt - 2);
            const char* a1 = cA + (size_t)(t + 1) * kstep;
            const char* a2 = last ? nA : cA + (size_t)(t + 2) * kstep; const char* b2 = last ? nB : cB + (size_t)(t + 2) * kstep;
            const char* a3 = a2 + kstep; const char* b3 = b2 + kstep;
            if (last && has_next) S.a_ready(nxt);
            if constexpr (SP2) {
            PG8_LDB(B0, 0, 0); PG8_LDB(B1, 0, 1); PG8_SCHED; PG8_LDA(At, 0, 0); PG8_STAGE(PG8_SA(1, 1), a1 + hstep, voffA);
            PG8_WAIT_V(8); PG8_WAIT_L(0); PG8_BAR; PG8_MMA(0, 0, At, B0); PG8_MMA(0, 1, At, B1); PG8_BAR; PG8_SCHED;
            PG8_LDA(At, 0, 1); PG8_STAGE(PG8_SB(0, 0), b2, voffB); PG8_STAGE(PG8_SB(0, 1), b2 + hstep, voffB); PG8_STAGE(PG8_SA(0, 0), a2, voffA);
            PG8_WAIT_V(8); PG8_WAIT_L(0); PG8_BAR; PG8_MMA(1, 0, At, B0); PG8_MMA(1, 1, At, B1); PG8_BAR; PG8_SCHED;
            PG8_LDB(B0, 1, 0); PG8_LDB(B1, 1, 1); PG8_SCHED; PG8_LDA(At, 1, 0); PG8_STAGE(PG8_SA(0, 1), a2 + hstep, voffA);
            PG8_WAIT_V(8); PG8_WAIT_L(0); PG8_BAR; PG8_MMA(0, 0, At, B0); PG8_MMA(0, 1, At, B1); PG8_BAR; PG8_SCHED;
            PG8_LDA(At, 1, 1); PG8_STAGE(PG8_SB(1, 0), b3, voffB); PG8_STAGE(PG8_SB(1, 1), b3 + hstep, voffB); PG8_STAGE(PG8_SA(1, 0), a3, voffA);
            PG8_WAIT_V(8); PG8_WAIT_L(0); PG8_BAR; PG8_MMA(1, 0, At, B0); PG8_MMA(1, 1, At, B1); PG8_BAR; PG8_SCHED;
            } else {
            PG8_LDB(B0, 0, 0); PG8_SCHED; PG8_LDA(At, 0, 0); PG8_STAGE(PG8_SA(1, 1), a1 + hstep, voffA);
            PG8_WAIT_L(8); PG8_BAR; PG8_WAIT_L(0); PG8_MMA(0, 0, At, B0); PG8_BAR; PG8_SCHED;
            PG8_LDB(B1, 0, 1); PG8_STAGE(PG8_SB(0, 0), b2, voffB);
            PG8_BAR; PG8_WAIT_L(0); PG8_MMA(0, 1, At, B1); PG8_BAR;
            PG8_LDA(At, 0, 1); PG8_STAGE(PG8_SA(0, 0), a2, voffA);
            PG8_BAR; PG8_WAIT_L(0); PG8_MMA(1, 0, At, B0); PG8_BAR; PG8_SCHED;
            PG8_STAGE(PG8_SB(0, 1), b2 + hstep, voffB);
            PG8_WAIT_V(6); PG8_BAR; PG8_MMA(1, 1, At, B1); PG8_BAR;
            PG8_LDB(B0, 1, 0); PG8_SCHED; PG8_LDA(At, 1, 0); PG8_STAGE(PG8_SA(0, 1), a2 + hstep, voffA);
            PG8_WAIT_L(8); PG8_BAR; PG8_WAIT_L(0); PG8_MMA(0, 0, At, B0); PG8_BAR; PG8_SCHED;
            PG8_LDB(B1, 1, 1); PG8_STAGE(PG8_SB(1, 0), b3, voffB);
            PG8_BAR; PG8_WAIT_L(0); PG8_MMA(0, 1, At, B1); PG8_BAR;
            PG8_LDA(At, 1, 1); PG8_STAGE(PG8_SA(1, 0), a3, voffA);
            PG8_BAR; PG8_WAIT_L(0); PG8_MMA(1, 0, At, B0); PG8_BAR; PG8_SCHED;
            PG8_STAGE(PG8_SB(1, 1), b3 + hstep, voffB);
            PG8_WAIT_V(6); PG8_BAR; PG8_MMA(1, 1, At, B1); PG8_BAR;
            }
        }
        if constexpr (ALIGN_EPI) { if (wr == 0) PG8_BAR; }
        if constexpr (!Epi::AFTER_DRAIN) { E(acc, cur, wr, wc, fr, fq); S.done(cur); }
        if (!has_next) break;
#pragma unroll
        for (int a = 0; a < 2; ++a)
#pragma unroll
            for (int b = 0; b < 2; ++b)
#pragma unroll
                for (int m = 0; m < 4; ++m)
#pragma unroll
                    for (int n = 0; n < 2; ++n) acc[a][b][m][n] = (f32x4){0.f, 0.f, 0.f, 0.f};
        cur = nxt; cA = nA; cB = nB; ++ui;
        if constexpr (ALIGN_EPI) { if (wr == 1) PG8_BAR; }
    }
    PG8_WAIT_V(0);
    if constexpr (!ALIGN_EPI) { if (wr == 0) PG8_BAR; }
    PG8_BAR;
    if constexpr (Epi::AFTER_DRAIN) { E.fused(acc, cur, wr, wc, fr, fq, lds, wid, lane); S.done(cur); }
#undef PG8_SA
#undef PG8_SB
#undef PG8_STAGE
#undef PG8_LDA
#undef PG8_LDB
#undef PG8_MMA
#undef PG8_WAIT_V
#undef PG8_WAIT_L
#undef PG8_BAR
#undef PG8_SCHED
}
}
namespace pg8 {
struct EpiF32Res {
    static constexpr bool PERM = false, AFTER_DRAIN = false;
    const float* xp; bf16_t* outb; float* ssq; int ldc;
    __device__ __forceinline__ void operator()(const f32x4 (&acc)[2][2][4][2], const Unit& u, int wr, int wc, int fr, int fq) const {
        const int col0 = u.pn * BM + wc * 32 + 4 * fq;
#pragma unroll
        for (int ai = 0; ai < 2; ++ai)
#pragma unroll
            for (int m = 0; m < 4; ++m) {
                const int row = u.pm * BM + ai * HALF + wr * 64 + m * 16 + fr;
                const float* src = xp + (size_t)row * ldc; bf16_t* dstb = outb + (size_t)row * ldc;
                float s = 0.f;
#pragma unroll
                for (int bj = 0; bj < 2; ++bj)
#pragma unroll
                    for (int n = 0; n < 2; ++n) { const int c = col0 + bj * HALF + n * 16; const f32x4 v = *(const f32x4*)(src + c) + acc[ai][bj][m][n];
                        s += (v[0] * v[0] + v[1] * v[1]) + (v[2] * v[2] + v[3] * v[3]);
                        typedef unsigned u32x2 __attribute__((ext_vector_type(2))); *(u32x2*)(dstb + c) = (u32x2){cvt_pk_bf16(v[0], v[1]), cvt_pk_bf16(v[2], v[3])}; }
                s += __shfl_xor(s, 16); s += __shfl_xor(s, 32);
                if (fq == 0) ssq[(size_t)row * 32 + u.pn * 4 + wc] = s;
            }
    }
};
struct EpiBf16RowScale {
    static constexpr bool PERM = true, AFTER_DRAIN = false;
    bf16_t* O; int ldc; const float* rs;
    __device__ __forceinline__ void operator()(const f32x4 (&acc)[2][2][4][2], const Unit& u, int wr, int wc, int fr, int fq) const {
        const int row0 = u.pm * BM + wr * 64 + fr, col0 = u.pn * BM + wc * 32 + 8 * fq;
#pragma unroll
        for (int ai = 0; ai < 2; ++ai)
#pragma unroll
            for (int m = 0; m < 4; ++m) { const int rl = wr * 64 + fr + ai * HALF + m * 16; const float sc = rs[rl]; bf16_t* rowp = O + (size_t)(row0 + ai * HALF + m * 16) * ldc + col0;
#pragma unroll
                for (int bj = 0; bj < 2; ++bj) { const f32x4 v0 = acc[ai][bj][m][0] * sc, v1 = acc[ai][bj][m][1] * sc;
                    u32x4 w; w.x = cvt_pk_bf16(v0[0], v0[1]); w.y = cvt_pk_bf16(v0[2], v0[3]); w.z = cvt_pk_bf16(v1[0], v1[1]); w.w = cvt_pk_bf16(v1[2], v1[3]);
                    *(u32x4*)(rowp + bj * HALF) = w; } }
    }
};
}

#ifndef MK_N_LAUNCHES
#define MK_N_LAUNCHES 1
#endif
constexpr int N_PHASES = 9;
constexpr int N_LAUNCHES = MK_N_LAUNCHES;
constexpr int NWAVES = 8;

constexpr int DM = 2048;
constexpr int TP = 8192, TS = 128, TT = TP + TS;
constexpr int MP = 8448;
constexpr int NP = 16384;
constexpr int PLD = NP + 64;
constexpr int C_Q = 0, C_K = 1024, C_V = 2048, C_R = 4096, C_CB = 6144, C_CC = 8192, C_CX = 10240, C_GA = 12288, C_GB = 14336;
constexpr int DIN = 16400;
constexpr int NEXP = 16384;
constexpr float EPS = 1e-6f;

constexpr size_t MiB = 1u << 20;
constexpr size_t WS_CTL = 0, CTL_ZERO_BYTES = 128 * 1024;
constexpr size_t WS_WINT = 2 * MiB;
constexpr size_t WS_WOUTT = 68 * MiB;
constexpr size_t WS_WQT = 76 * MiB;
constexpr size_t WS_EU = 84 * MiB;
constexpr size_t WS_EV = 148 * MiB;
constexpr size_t WS_XN = 212 * MiB;
constexpr size_t WS_P = 246 * MiB;
constexpr size_t WS_QT = 516 * MiB;
constexpr size_t WS_KT = 532 * MiB;
constexpr size_t WS_VT = 548 * MiB;
constexpr size_t WS_ATT = 580 * MiB;
constexpr size_t WS_EBL = 584 * MiB;
constexpr size_t WS_SKB = 585 * MiB;
constexpr size_t WS_O = 586 * MiB;
constexpr size_t WS_MM = 620 * MiB;
constexpr size_t WS_X2 = 654 * MiB;
constexpr size_t WS_H2 = 720 * MiB;
constexpr size_t WS_SSQ = 799 * MiB;
constexpr size_t WS_QP = 754 * MiB;
constexpr size_t WS_IDX = 788 * MiB;
constexpr size_t WS_GW = 793 * MiB;
constexpr size_t WS_ALR = 798 * MiB;
constexpr size_t WS_SSQS = 799 * MiB + 1100 * 1024;
constexpr size_t WS_RS2 = 799 * MiB + 1200 * 1024;
constexpr size_t WS_END = 801 * MiB;
constexpr int CW_TMO = 0, CW_CODE = 1, CW_BAR = 4096, CW_QUEUE = 16384;

constexpr size_t OUT_Y = 0;
constexpr size_t OUT_GLAP = (size_t)TT * DM;
constexpr size_t OUT_CONVP = OUT_GLAP + (size_t)4 * 4 * 256 * 512;
constexpr size_t OUT_GLAS = OUT_CONVP + (size_t)4 * 2 * 2048;
constexpr size_t OUT_CONVS = OUT_GLAS + (size_t)128 * 4 * 256 * 512;

constexpr int LDS_BYTES = 163840;
constexpr int LDSCTL_OFF = 162816, MISC_OFF = LDSCTL_OFF + 320;
constexpr int RING_OFF = 0;

#define GAS __attribute__((address_space(1)))
#define LAS __attribute__((address_space(3)))
typedef unsigned short bf16;
typedef unsigned v4u __attribute__((ext_vector_type(4)));
typedef unsigned v2u __attribute__((ext_vector_type(2)));
typedef float f32x4 __attribute__((ext_vector_type(4)));
typedef short bf16x8 __attribute__((ext_vector_type(8)));
typedef GAS unsigned gu32;
typedef float v32f __attribute__((ext_vector_type(32)));
typedef float v16f __attribute__((ext_vector_type(16)));
typedef float f32x2 __attribute__((ext_vector_type(2)));
typedef unsigned v6u __attribute__((ext_vector_type(6)));
constexpr int ROW6 = 1536, ROW4 = 1024;
#define RLX_AGENT __ATOMIC_RELAXED, __HIP_MEMORY_SCOPE_AGENT
#define LDS_WAIT() asm volatile("s_waitcnt lgkmcnt(0)" ::: "memory")
#define VM_WAIT() asm volatile("s_waitcnt vmcnt(0)" ::: "memory")
#define MFMA16(a, b, c) __builtin_amdgcn_mfma_f32_16x16x32_bf16((a), (b), (c), 0, 0, 0)
__device__ __forceinline__ unsigned f2bf(float f) { unsigned u = __builtin_bit_cast(unsigned, f); return (u + 0x7fffu + ((u >> 16) & 1u)) >> 16; }
__device__ __forceinline__ unsigned pk2(float lo, float hi) { return f2bf(lo) | (f2bf(hi) << 16); }
__device__ __forceinline__ float bf2f(unsigned b) { return __builtin_bit_cast(float, b << 16); }
__device__ __forceinline__ float bflo(unsigned w) { return __builtin_bit_cast(float, w << 16); }
__device__ __forceinline__ float bfhi(unsigned w) { return __builtin_bit_cast(float, w & 0xffff0000u); }
__device__ __forceinline__ void unpack8(const v4u w, float (&f)[8]) { f[0] = bflo(w.x); f[1] = bfhi(w.x); f[2] = bflo(w.y); f[3] = bfhi(w.y); f[4] = bflo(w.z); f[5] = bfhi(w.z); f[6] = bflo(w.w); f[7] = bfhi(w.w); }
__device__ __forceinline__ v4u pack8(const float (&f)[8]) { v4u w; w.x = pk2(f[0], f[1]); w.y = pk2(f[2], f[3]); w.z = pk2(f[4], f[5]); w.w = pk2(f[6], f[7]); return w; }
__device__ __forceinline__ float wave_sum(float v) {
#pragma unroll
    for (int o = 1; o < 64; o <<= 1) v += __shfl_xor(v, o);
    return v;
}
__device__ __forceinline__ float sigmoidf_(float x) { return 1.0f / (1.0f + __expf(-x)); }
__device__ __forceinline__ float wave_sum_dpp(float v) {
#define DPP_ADD_(ctrl, rmask) v += __builtin_bit_cast(float, __builtin_amdgcn_update_dpp(0, __builtin_bit_cast(int, v), ctrl, rmask, 0xF, false))
    DPP_ADD_(0xB1, 0xF);
    DPP_ADD_(0x4E, 0xF);
    DPP_ADD_(0x141, 0xF);
    DPP_ADD_(0x140, 0xF);
    DPP_ADD_(0x142, 0xA);
    DPP_ADD_(0x143, 0xC);
#undef DPP_ADD_
    return __builtin_bit_cast(float, __builtin_amdgcn_readlane(__builtin_bit_cast(int, v), 63));
}
__device__ __forceinline__ float gelu_erf(float v) {
    const float t = __builtin_amdgcn_rcpf(fabsf(v) * 0.2316418882f + 1.0f);
    float q = t * 0.5307027145f + (-0.7265760135f); q = q * t + 0.7107068705f; q = q * t + (-0.142248368f); q = q * t + 0.127414796f; q = q * t;
    const float e = __builtin_amdgcn_exp2f((v * v) * (-0.72134752044f));
    const float m = v * (q * e);
    return v < 0.f ? m : v - m;
}
#define XB_TMO      128
#define XB_XCNT(j)  (256  + 64 * (j))
#define XB_XSUB(j)  (1280 + 64 * (j))
#define XB_XGEN(j)  (2304 + 64 * (j))
#define XB_TOP      3328
#define XB_TOPGEN   3392
#define XCD_BAR_WORDS 3456
#define XB_SPIN_CAP (1u << 18)

__device__ __forceinline__ unsigned xb_ld(unsigned* p)              { return __hip_atomic_load(p, __ATOMIC_RELAXED, __HIP_MEMORY_SCOPE_AGENT); }
__device__ __forceinline__ unsigned xb_add(unsigned* p, unsigned v) { return __hip_atomic_fetch_add(p, v, __ATOMIC_RELAXED, __HIP_MEMORY_SCOPE_AGENT); }
__device__ __forceinline__ unsigned xb_xcc_id() { return (unsigned)__builtin_amdgcn_s_getreg((3 << 11) | 20) & 0xFu; }
#define XB_SPIN(cond, bar) do { unsigned _sp = 0; while (cond) { __builtin_amdgcn_s_sleep(1); \
    if ((++_sp & 255u) == 0u) { if (xb_ld(&(bar)[XB_TMO])) break; if (_sp > XB_SPIN_CAP) { atomicAdd(&(bar)[XB_TMO], 1u); break; } } } } while (0)

struct XcdBarrier {
    unsigned* bar; unsigned x;
    volatile LAS unsigned* st;
};

__device__ __forceinline__ XcdBarrier xcd_barrier_post(unsigned* bar, volatile LAS unsigned* st) {
    XcdBarrier b; b.bar = bar; b.x = xb_xcc_id(); b.st = st;
    if (threadIdx.x == 0) (void)xb_add(&bar[XB_XCNT(b.x)], 1u);
    return b;
}
__device__ __forceinline__ void xcd_barrier_complete(unsigned* bar, unsigned x, unsigned& nloc, unsigned& nx) {
    const unsigned G = gridDim.x * gridDim.y * gridDim.z;
    unsigned sum, cnt, mine, sp = 0u;
    for (;;) {
        sum = 0u; cnt = 0u; mine = 0u;
#pragma unroll
        for (unsigned j = 0; j < 16; ++j) { const unsigned c = xb_ld(&bar[XB_XCNT(j)]); sum += c; cnt += (c > 0u) ? 1u : 0u; mine = (j == x) ? c : mine; }
        if (sum == G) break;
        __builtin_amdgcn_s_sleep(1);
        if ((++sp & 255u) == 0u) { if (xb_ld(&bar[XB_TMO])) break; if (sp > XB_SPIN_CAP) { atomicAdd(&bar[XB_TMO], 1u); break; } }
    }
    nloc = mine > 0u ? mine : 1u; nx = cnt > 0u ? cnt : 1u;
}

__device__ __forceinline__ void xcd_barrier(const XcdBarrier& b) {
    asm volatile("s_waitcnt vmcnt(0)" ::: "memory");
    __syncthreads();
    if (threadIdx.x == 0) {
        unsigned* bar = b.bar;
        __builtin_amdgcn_s_waitcnt(0);
        unsigned nloc = b.st[0], nx = b.st[1];
        if (nloc == 0u) { xcd_barrier_complete(bar, b.x, nloc, nx); b.st[0] = nloc; b.st[1] = nx; }
        const unsigned old = xb_add(&bar[XB_XSUB(b.x)], 1u);
        const unsigned gen = old / nloc;
        if (old + 1u == (gen + 1u) * nloc) {
            __builtin_amdgcn_fence(__ATOMIC_RELEASE, "agent");
            asm volatile("s_waitcnt vmcnt(0)" ::: "memory");
            const unsigned og = xb_add(&bar[XB_TOP], 1u);
            const unsigned tg = og / nx;
            if (og + 1u == (tg + 1u) * nx) xb_add(&bar[XB_TOPGEN], 1u);
            else XB_SPIN(xb_ld(&bar[XB_TOPGEN]) == tg, bar);
            __builtin_amdgcn_fence(__ATOMIC_ACQUIRE, "agent");
            xb_add(&bar[XB_XGEN(b.x)], 1u);
            asm volatile("s_waitcnt vmcnt(0)" ::: "memory");
        } else {
            XB_SPIN(xb_ld(&bar[XB_XGEN(b.x)]) == gen, bar);
            __builtin_amdgcn_fence(__ATOMIC_ACQUIRE, "agent");
            asm volatile("s_waitcnt vmcnt(0)" ::: "memory");
        }
    }
    __syncthreads();
}
struct Frame {
    unsigned char* lds;
    int tid, lane, wave, vcu, G;
    const float *xp, *xs, *sgla, *sconv, *n1g, *win, *wau, *bal, *gng, *cw, *cb, *wout, *n2g, *wq, *sk, *eu, *ev, *nfg;
    float* out;
    unsigned char* ws;
};

__device__ __forceinline__ void p0_transpose_item(const float* W, int ldw, int src_col0, int k0, bf16* WT, int K, int dst_row0, float* scr, int lane, const float* kscale = nullptr) {
    const int n4 = lane & 15, kr = lane >> 4;
#pragma unroll 8
    for (int i = 0; i < 16; ++i) { const int kk = 4 * i + kr; f32x4 v = __builtin_nontemporal_load((const f32x4*)(W + (size_t)(k0 + kk) * ldw + src_col0 + 4 * n4)); if (kscale) v = v * kscale[k0 + kk];
        float* d = scr + kk * 65 + 4 * n4; d[0] = v.x; d[1] = v.y; d[2] = v.z; d[3] = v.w; }
    LDS_WAIT(); asm volatile("" ::: "memory");
    const int c = lane & 7, nr = lane >> 3;
#pragma unroll
    for (int j = 0; j < 8; ++j) { const int n = nr + 8 * j; const float* s = scr + (8 * c) * 65 + n;
        v4u o; o.x = pk2(s[0 * 65], s[1 * 65]); o.y = pk2(s[2 * 65], s[3 * 65]); o.z = pk2(s[4 * 65], s[5 * 65]); o.w = pk2(s[6 * 65], s[7 * 65]);
        *(v4u*)(WT + (size_t)(dst_row0 + n) * K + k0 + 8 * c) = o; }
    LDS_WAIT(); asm volatile("" ::: "memory");
}
__device__ __forceinline__ void rms_row_to_bf16(const float* xrow, const float* g, bf16* orow, int lane) {
    const f32x4* xr = (const f32x4*)xrow + lane; const f32x4* gr = (const f32x4*)g + lane;
    f32x4 v[8]; float s = 0.f;
#pragma unroll
    for (int j = 0; j < 8; ++j) { v[j] = __builtin_nontemporal_load(xr + 64 * j); s += (v[j].x * v[j].x + v[j].y * v[j].y) + (v[j].z * v[j].z + v[j].w * v[j].w); }
    const float rstd = 1.0f / sqrtf(wave_sum(s) * (1.0f / DM) + EPS);
    v2u* o8 = (v2u*)orow + lane;
#pragma unroll
    for (int j = 0; j < 8; ++j) { const f32x4 gg = gr[64 * j]; v2u w; w.x = pk2(v[j].x * rstd * gg.x, v[j].y * rstd * gg.y); w.y = pk2(v[j].z * rstd * gg.z, v[j].w * rstd * gg.w); o8[64 * j] = w; }
}
__device__ __forceinline__ void zero_row_bf16(bf16* orow, int lane) {
    v2u* o8 = (v2u*)orow + lane; const v2u z = {0u, 0u};
#pragma unroll
    for (int j = 0; j < 8; ++j) o8[64 * j] = z;
}
__device__ __forceinline__ void p0_prologue(Frame& F) {
    bf16* WINT = (bf16*)(F.ws + WS_WINT); bf16* WOUTT = (bf16*)(F.ws + WS_WOUTT); bf16* WQT = (bf16*)(F.ws + WS_WQT);
    float* scr = (float*)(F.lds + F.wave * 16640);
    const int gw = F.vcu * NWAVES + F.wave, NGW = F.G * NWAVES;
    constexpr int I_IN = 32 * 256, I_SQ = 32 * 32;
    for (int it = gw; it < I_IN + 2 * I_SQ; it += NGW) {
        int r = it;
        if (r < I_IN) { const int kb = r >> 8, nb = r & 255, n0 = 64 * nb; p0_transpose_item(F.win, DIN, n0 + (n0 >= 6144 ? 16 : 0), 64 * kb, WINT, DM, n0, scr, F.lane); continue; }
        r -= I_IN;
        if (r < I_SQ) { const int kb = r >> 5, nb = r & 31; p0_transpose_item(F.wout, DM, 64 * nb, 64 * kb, WOUTT, DM, 64 * nb, scr, F.lane); continue; }
        r -= I_SQ;
        { const int kb = r >> 5, nb = r & 31; p0_transpose_item(F.wq, DM, 64 * nb, 64 * kb, WQT, DM, 64 * nb, scr, F.lane, F.n2g); }
    }
    const size_t gt = (size_t)F.vcu * 512 + F.tid, NGT = (size_t)F.G * 512;
    { bf16* SKB = (bf16*)(F.ws + WS_SKB); for (size_t e = gt; e < (size_t)2 * 128 * 128; e += NGT) SKB[e] = (bf16)f2bf(F.sk[e]); }
    __syncthreads();
    { bf16* wt_s = (bf16*)F.lds; constexpr int WLD = DM + 8;
      for (int k = F.tid; k < DM; k += 512) { const float* src = F.win + (size_t)k * DIN + 6144;
#pragma unroll
          for (int q = 0; q < 4; ++q) { const f32x4 w4 = *(const f32x4*)(src + 4 * q); wt_s[(4 * q + 0) * WLD + k] = (bf16)f2bf(w4.x); wt_s[(4 * q + 1) * WLD + k] = (bf16)f2bf(w4.y); wt_s[(4 * q + 2) * WLD + k] = (bf16)f2bf(w4.z); wt_s[(4 * q + 3) * WLD + k] = (bf16)f2bf(w4.w); } }
      bf16* XN = (bf16*)(F.ws + WS_XN); float* ALR = (float*)(F.ws + WS_ALR);
      const int r0 = (int)(((long)F.vcu * TT) / F.G), r1 = (int)(((long)(F.vcu + 1) * TT) / F.G);
      for (int m = r0 + F.wave; m < r1; m += NWAVES) rms_row_to_bf16(m < TP ? F.xp + (size_t)m * DM : F.xs + (size_t)(m - TP) * DM, F.n1g, XN + (size_t)m * DM, F.lane);
      for (int m = TT + gw; m < MP; m += NGW) zero_row_bf16(XN + (size_t)m * DM, F.lane);
      VM_WAIT(); __syncthreads();
      const int l15 = F.lane & 15, lq = F.lane >> 4;
      for (int t0 = r0 + 16 * F.wave; t0 < r1; t0 += 16 * NWAVES) {
          const int row = min(t0 + l15, r1 - 1);
          f32x4 acc = {0.f, 0.f, 0.f, 0.f};
#pragma unroll 8
          for (int ks = 0; ks < 64; ++ks) { const bf16x8 a = *(const bf16x8*)(XN + (size_t)row * DM + 32 * ks + 8 * lq); const bf16x8 bq = *(const bf16x8*)(wt_s + l15 * WLD + 32 * ks + 8 * lq); acc = MFMA16(a, bq, acc); }
#pragma unroll
          for (int r = 0; r < 4; ++r) { const int m = t0 + 4 * lq + r; if (m < r1) ALR[(size_t)m * 16 + l15] = acc[r]; }
      } }
}

template <int NT, class Epi>
__device__ __forceinline__ void skinny_gemm(Frame& F, const bf16* A, const bf16* Bt, int n0, const Epi& E) {
    constexpr int ROWS = NT * 16, NPC = (ROWS * 32 + 511) / 512, BLD = 264;
    bf16* Bs = (bf16*)F.lds;
    const int tid = F.tid, wv = F.wave, l15 = F.lane & 15, lq = F.lane >> 4;
    f32x4 acc[NT];
#pragma unroll
    for (int nt = 0; nt < NT; ++nt) acc[nt] = (f32x4){0.f, 0.f, 0.f, 0.f};
    const bf16* Arow = A + (size_t)(16 * wv + l15) * DM + 8 * lq;
    v4u bX[NPC], bY[NPC]; bf16x8 aX[8], aY[8];
#define SK_LOADB(BR, kc) do { _Pragma("unroll") for (int i = 0; i < NPC; ++i) { const int p = tid + 512 * i; if (p < ROWS * 32) BR[i] = *(const v4u*)(Bt + (size_t)(n0 + (p >> 5)) * DM + (kc) * 256 + 8 * (p & 31)); } } while (0)
#define SK_LOADA(AR, kc) do { _Pragma("unroll") for (int ks = 0; ks < 8; ++ks) AR[ks] = *(const bf16x8*)(Arow + (kc) * 256 + 32 * ks); } while (0)
#define SK_STOREB(BR, kc) do { bf16* Bn = Bs + ((kc) & 1) * ROWS * BLD; _Pragma("unroll") for (int i = 0; i < NPC; ++i) { const int p = tid + 512 * i; if (p < ROWS * 32) *(v4u*)(Bn + (p >> 5) * BLD + 8 * (p & 31)) = BR[i]; } } while (0)
#define SK_COMP(AR, kc) do { const bf16* Bc = Bs + ((kc) & 1) * ROWS * BLD; _Pragma("unroll") for (int ks = 0; ks < 8; ++ks) _Pragma("unroll") for (int nt = 0; nt < NT; ++nt) { \
        const bf16x8 bq = *(const bf16x8*)(Bc + (16 * nt + l15) * BLD + 32 * ks + 8 * lq); acc[nt] = MFMA16(AR[ks], bq, acc[nt]); } } while (0)
    SK_LOADB(bX, 0); SK_LOADA(aX, 0); SK_LOADB(bY, 1); SK_LOADA(aY, 1);
    SK_STOREB(bX, 0);
    __syncthreads();
#pragma unroll 1
    for (int kc = 0; kc < 8; kc += 2) {
        SK_LOADB(bX, kc + 2 < 8 ? kc + 2 : 7);
        SK_COMP(aX, kc); SK_LOADA(aX, kc + 2 < 8 ? kc + 2 : 7);
        SK_STOREB(bY, kc + 1);
        __syncthreads();
        SK_LOADB(bY, kc + 3 < 8 ? kc + 3 : 7);
        SK_COMP(aY, kc + 1); SK_LOADA(aY, kc + 3 < 8 ? kc + 3 : 7);
        SK_STOREB(bX, kc + 2);
        __syncthreads();
    }
#undef SK_LOADB
#undef SK_LOADA
#undef SK_STOREB
#undef SK_COMP
    E.template tile<NT>(acc, wv, l15, lq, n0);
}
template <class Epi>
__device__ __forceinline__ void skinny_gemm16(Frame& F, const bf16* A, const bf16* Bt, int n0, int rh, const Epi& E) {
    constexpr int BLD = 264, BUF = 2 * 16 * BLD;
    bf16* Bs = (bf16*)F.lds; float* xs = (float*)(F.lds + 2 * BUF * 2);
    const int tid = F.tid, wv = F.wave, lane = F.lane, l15 = lane & 15, lq = lane >> 4, mt = wv & 3, kh = wv >> 2;
    f32x4 acc[1] = {(f32x4){0.f, 0.f, 0.f, 0.f}};
    const bf16* Arow = A + (size_t)(64 * rh + 16 * mt + l15) * DM + kh * 1024 + 8 * lq;
    v4u bX[2], bY[2]; bf16x8 aX[8], aY[8];
#define SK_LOADB(BR, kc) do { _Pragma("unroll") for (int i = 0; i < 2; ++i) { const int p = tid + 512 * i; BR[i] = *(const v4u*)(Bt + (size_t)(n0 + ((p >> 5) & 15)) * DM + (p >> 9) * 1024 + (kc) * 256 + 8 * (p & 31)); } } while (0)
#define SK_LOADA(AR, kc) do { _Pragma("unroll") for (int ks = 0; ks < 8; ++ks) AR[ks] = *(const bf16x8*)(Arow + (kc) * 256 + 32 * ks); } while (0)
#define SK_STOREB(BR, kc) do { bf16* Bn = Bs + ((kc) & 1) * BUF; _Pragma("unroll") for (int i = 0; i < 2; ++i) { const int p = tid + 512 * i; *(v4u*)(Bn + ((p >> 9) * 16 + ((p >> 5) & 15)) * BLD + 8 * (p & 31)) = BR[i]; } } while (0)
#define SK_COMP(AR, kc) do { const bf16* Bc = Bs + ((kc) & 1) * BUF + kh * 16 * BLD; _Pragma("unroll") for (int ks = 0; ks < 8; ++ks) { \
        const bf16x8 bq = *(const bf16x8*)(Bc + l15 * BLD + 32 * ks + 8 * lq); acc[0] = MFMA16(AR[ks], bq, acc[0]); } } while (0)
    SK_LOADB(bX, 0); SK_LOADA(aX, 0); SK_LOADB(bY, 1); SK_LOADA(aY, 1);
    SK_STOREB(bX, 0);
    __syncthreads();
#pragma unroll 1
    for (int kc = 0; kc < 4; kc += 2) {
        SK_LOADB(bX, kc + 2 < 4 ? kc + 2 : 3);
        SK_COMP(aX, kc); SK_LOADA(aX, kc + 2 < 4 ? kc + 2 : 3);
        SK_STOREB(bY, kc + 1);
        __syncthreads();
        SK_LOADB(bY, kc + 3 < 4 ? kc + 3 : 3);
        SK_COMP(aY, kc + 1); SK_LOADA(aY, kc + 3 < 4 ? kc + 3 : 3);
        SK_STOREB(bX, kc + 2);
        __syncthreads();
    }
#undef SK_LOADB
#undef SK_LOADA
#undef SK_STOREB
#undef SK_COMP
    if (kh) *(f32x4*)(xs + (mt * 64 + lane) * 4) = acc[0];
    __syncthreads();
    if (!kh) { acc[0] += *(const f32x4*)(xs + (mt * 64 + lane) * 4); E.template tile<1>(acc, 4 * rh + mt, l15, lq, n0); }
    __syncthreads();
}
struct EpiSkBf16 { bf16* out; int ldc; const float* rs;
    template <int NT> __device__ __forceinline__ void tile(const f32x4 (&acc)[NT], int wv, int l15, int lq, int n0) const {
#pragma unroll
        for (int r = 0; r < 4; ++r) { const int row = 16 * wv + 4 * lq + r; const float sc = rs ? rs[row] : 1.0f;
#pragma unroll
            for (int nt = 0; nt < NT; ++nt) out[(size_t)row * ldc + n0 + 16 * nt + l15] = (bf16)f2bf(acc[nt][r] * sc); } } };
struct EpiSkF32Res { const float* xs; bf16* outb; float* ssqs;
    template <int NT> __device__ __forceinline__ void tile(const f32x4 (&acc)[NT], int wv, int l15, int lq, int n0) const {
        static_assert(NT == 1, "one 16-column group");
#pragma unroll
        for (int r = 0; r < 4; ++r) { const int row = 16 * wv + 4 * lq + r; const size_t o = (size_t)row * DM + n0 + l15; const float v = xs[o] + acc[0][r]; outb[o] = (bf16)f2bf(v);
            float s = v * v; s += __shfl_xor(s, 1); s += __shfl_xor(s, 2); s += __shfl_xor(s, 4); s += __shfl_xor(s, 8);
            if (l15 == 0) ssqs[row * 128 + (n0 >> 4)] = s; } } };

__device__ __forceinline__ void convert_experts(Frame& F) {
    const int gw = F.vcu * NWAVES + F.wave, NGW = F.G * NWAVES;
    { unsigned char* U6 = F.ws + WS_EU; unsigned char* V6 = F.ws + WS_EV; float* SU = (float*)(F.ws + WS_EU + 32 * MiB); float* SV = (float*)(F.ws + WS_EV + 32 * MiB);
      for (int r0 = gw; r0 < 2 * NEXP; r0 += 2 * NGW) {
          f32x4 x[2][8];
#pragma unroll
          for (int q = 0; q < 2; ++q) { const int r = r0 + q * NGW; const bool isv = r >= NEXP; const int row = isv ? r - NEXP : r; const float* src = (isv ? F.ev : F.eu) + (size_t)row * DM;
#pragma unroll
              for (int j = 0; j < 8; ++j) x[q][j] = __builtin_nontemporal_load((const f32x4*)(src + 256 * j + 4 * F.lane)); }
#pragma unroll
          for (int q = 0; q < 2; ++q) { const int r = r0 + q * NGW; const bool isv = r >= NEXP; const int row = isv ? r - NEXP : r;
              float amax = 0.f;
#pragma unroll
              for (int j = 0; j < 8; ++j) { if (!isv) x[q][j] = x[q][j] * *(const f32x4*)(F.n2g + 256 * j + 4 * F.lane);
                  amax = fmaxf(amax, fmaxf(fmaxf(fabsf(x[q][j].x), fabsf(x[q][j].y)), fmaxf(fabsf(x[q][j].z), fabsf(x[q][j].w)))); }
#pragma unroll
              for (int o = 1; o < 64; o <<= 1) amax = fmaxf(amax, __shfl_xor(amax, o));
              if (!isv) {
                  const float sc = amax > 0.f ? 7.5f / amax : 1.0f;
                  v16f pa, pb;
#pragma unroll
                  for (int j = 0; j < 8; ++j) { pa[2 * j] = x[q][j].x * sc; pb[2 * j] = x[q][j].y * sc; pa[2 * j + 1] = x[q][j].z * sc; pb[2 * j + 1] = x[q][j].w * sc; }
                  const v6u p = __builtin_amdgcn_cvt_scalef32_2xpk16_fp6_f32(pa, pb, 1.0f);
                  unsigned char* dst2 = U6 + (size_t)row * ROW6;
                  __builtin_nontemporal_store((v4u){p[0], p[1], p[2], p[3]}, (v4u*)(dst2 + 16 * F.lane)); __builtin_nontemporal_store((v2u){p[4], p[5]}, (v2u*)(dst2 + 1024 + 8 * F.lane));
                  if (F.lane == 0) SU[row] = amax > 0.f ? amax / 7.5f : 1.0f;
              } else {
                  const float sc = amax > 0.f ? 6.0f / amax : 1.0f;
                  v4u p;
#pragma unroll
                  for (int d = 0; d < 4; ++d) { unsigned w = 0;
                      w = __builtin_amdgcn_cvt_scalef32_pk_fp4_f32(w, x[q][2 * d].x * sc, x[q][2 * d].y * sc, 1.0f, 0); w = __builtin_amdgcn_cvt_scalef32_pk_fp4_f32(w, x[q][2 * d].z * sc, x[q][2 * d].w * sc, 1.0f, 1);
                      w = __builtin_amdgcn_cvt_scalef32_pk_fp4_f32(w, x[q][2 * d + 1].x * sc, x[q][2 * d + 1].y * sc, 1.0f, 2); w = __builtin_amdgcn_cvt_scalef32_pk_fp4_f32(w, x[q][2 * d + 1].z * sc, x[q][2 * d + 1].w * sc, 1.0f, 3);
                      p[d] = w; }
                  __builtin_nontemporal_store(p, (v4u*)(V6 + (size_t)row * ROW4 + 16 * F.lane));
                  if (F.lane == 0) SV[row] = amax > 0.f ? amax / 6.0f : 1.0f;
              } }
      } }
}

__device__ __forceinline__ float logsig(float x) { return fminf(x, 0.f) - __logf(1.0f + __expf(-fabsf(x))); }
__device__ __forceinline__ void gla_prep_unit(Frame& F, int u) {
    const bf16* P = (const bf16*)(F.ws + WS_P); bf16* QT = (bf16*)(F.ws + WS_QT); bf16* KT = (bf16*)(F.ws + WS_KT); bf16* VT = (bf16*)(F.ws + WS_VT);
    bf16* ATT = (bf16*)(F.ws + WS_ATT); float* EBL = (float*)(F.ws + WS_EBL);
    const int b = u >> 7, h = (u >> 5) & 3, c = u & 31, tid = F.tid;
    const int row0 = b * 2048 + c * 64;
    float* alr_s = (float*)F.lds;
    float* tot_s = (float*)(F.lds + 4096);
    bf16* q_s = (bf16*)(F.lds + 8192);
    bf16* k_s = q_s + 64 * 264;
    bf16* v_s = k_s + 64 * 264;
    bf16* a_s = v_s + 64 * 520;
    { v4u tq[4], tk[4], tv[8];
#pragma unroll
      for (int i = 0; i < 4; ++i) { const int p = tid + 512 * i, row = p >> 5, ch = p & 31; const bf16* src = P + (size_t)(row0 + row) * PLD + h * 256 + 8 * ch; tq[i] = __builtin_nontemporal_load((const v4u*)(src + C_Q)); tk[i] = __builtin_nontemporal_load((const v4u*)(src + C_K)); }
#pragma unroll
      for (int i = 0; i < 8; ++i) { const int p = tid + 512 * i, row = p >> 6, ch = p & 63; tv[i] = __builtin_nontemporal_load((const v4u*)(P + (size_t)(row0 + row) * PLD + C_V + h * 512 + 8 * ch)); }
      for (int e = tid; e < 1024; e += 512) alr_s[e] = ((const float*)(F.ws + WS_ALR))[(size_t)row0 * 16 + e];
#pragma unroll
      for (int i = 0; i < 4; ++i) { const int p = tid + 512 * i, row = p >> 5, ch = p & 31; *(v4u*)(q_s + row * 264 + 8 * ch) = tq[i]; *(v4u*)(k_s + row * 264 + 8 * ch) = tk[i]; }
#pragma unroll
      for (int i = 0; i < 8; ++i) { const int p = tid + 512 * i, row = p >> 6, ch = p & 63; *(v4u*)(v_s + row * 520 + 8 * ch) = tv[i]; } }
    const int d = tid & 255, half = tid >> 8;
    float w[16];
#pragma unroll
    for (int r = 0; r < 16; ++r) w[r] = F.wau[r * 1024 + h * 256 + d];
    const float bias = F.bal[h * 256 + d];
    __syncthreads();
    float bb[32]; float run = 0.f;
#pragma unroll
    for (int jj = 0; jj < 32; ++jj) { const int j = half * 32 + jj; float x = bias;
#pragma unroll
        for (int r = 0; r < 16; ++r) x += alr_s[j * 16 + r] * w[r];
        run += logsig(x) * 0.0625f; bb[jj] = run; }
    if (half == 0) tot_s[d] = run;
    __syncthreads();
    if (half == 1) { const float t = tot_s[d];
#pragma unroll
        for (int jj = 0; jj < 32; ++jj) bb[jj] += t; }
#pragma unroll
    for (int jj = 0; jj < 32; ++jj) { const int j = half * 32 + jj;
        const float qv = bf2f(q_s[j * 264 + d]), kv = bf2f(k_s[j * 264 + d]);
        const float e = __expf(bb[jj]), ei = __expf(-bb[jj]);
        q_s[j * 264 + d] = (bf16)f2bf(qv * 0.0625f * e); k_s[j * 264 + d] = (bf16)f2bf(kv * ei); }
    if (half == 1) EBL[u * 256 + d] = __expf(bb[31]);
    __syncthreads();
    { const int wv = F.wave, l15 = F.lane & 15, lq = F.lane >> 4, mi = wv >> 1;
#pragma unroll
      for (int nn = 0; nn < 2; ++nn) { const int ni = (wv & 1) * 2 + nn; f32x4 acc = {0.f, 0.f, 0.f, 0.f};
#pragma unroll
          for (int ks = 0; ks < 8; ++ks) { const bf16x8 a = *(const bf16x8*)(q_s + (16 * mi + l15) * 264 + 32 * ks + 8 * lq); const bf16x8 bq = *(const bf16x8*)(k_s + (16 * ni + l15) * 264 + 32 * ks + 8 * lq); acc = MFMA16(a, bq, acc); }
#pragma unroll
          for (int r = 0; r < 4; ++r) { const int i = 16 * mi + 4 * lq + r, jn = 16 * ni + l15; a_s[i * 72 + jn] = (bf16)f2bf(jn <= i ? acc[r] : 0.f); } } }
#pragma unroll
    for (int i = 0; i < 4; ++i) { const int p = tid + 512 * i, f = p >> 6, ln = p & 63, l15 = ln & 15, lq = ln >> 4;
        { const int mi = f >> 3, kh = (f >> 2) & 1, ks = f & 3; *(v4u*)(QT + (size_t)u * 16384 + (size_t)p * 8) = *(const v4u*)(q_s + (16 * mi + l15) * 264 + 128 * kh + 32 * ks + 8 * lq); }
        { const int wv2 = f >> 2, t2 = (f >> 1) & 1, ks = f & 1, dd = 32 * wv2 + 16 * t2 + l15, j0 = 32 * ks + 8 * lq; v4u o;
          o.x = (unsigned)k_s[(j0 + 0) * 264 + dd] | ((unsigned)k_s[(j0 + 1) * 264 + dd] << 16); o.y = (unsigned)k_s[(j0 + 2) * 264 + dd] | ((unsigned)k_s[(j0 + 3) * 264 + dd] << 16);
          o.z = (unsigned)k_s[(j0 + 4) * 264 + dd] | ((unsigned)k_s[(j0 + 5) * 264 + dd] << 16); o.w = (unsigned)k_s[(j0 + 6) * 264 + dd] | ((unsigned)k_s[(j0 + 7) * 264 + dd] << 16);
          *(v4u*)(KT + (size_t)u * 16384 + (size_t)p * 8) = o; } }
    __syncthreads();
    { const int p = tid, f = p >> 6, ln = p & 63, l15 = ln & 15, lq = ln >> 4, mi = f >> 1, kh = f & 1;
      *(v4u*)(ATT + (size_t)u * 4096 + (size_t)p * 8) = *(const v4u*)(a_s + (16 * mi + l15) * 72 + 32 * kh + 8 * lq); }
    { const int dv = tid; unsigned vp[32];
#pragma unroll
      for (int j = 0; j < 64; ++j) { const unsigned v = v_s[j * 520 + dv]; if (j & 1) vp[j >> 1] |= v << 16; else vp[j >> 1] = v; }
      v4u* dst = (v4u*)(VT + ((size_t)u * 512 + dv) * 64);
#pragma unroll
      for (int i = 0; i < 8; ++i) { v4u o; o.x = vp[4 * i]; o.y = vp[4 * i + 1]; o.z = vp[4 * i + 2]; o.w = vp[4 * i + 3]; dst[i] = o; } }
    __syncthreads();
}

__device__ __forceinline__ void gla_sample_unit(Frame& F, int u) {
    const bf16* P = (const bf16*)(F.ws + WS_P); bf16* O = (bf16*)(F.ws + WS_O);
    const int n = u >> 2, h = u & 3, tid = F.tid, lane = F.lane, wv = F.wave;
    const size_t m = (size_t)(TP + n);
    float* e_s = (float*)F.lds;
    float* qe_s = e_s + 256;
    float* k_s = qe_s + 256;
    float* v_s = k_s + 256;
    float* red_s = v_s + 512;
    float* op_s = red_s + 64;
    float part = 0.f;
    if (tid < 256) { const int d = tid; float x = F.bal[h * 256 + d];
#pragma unroll
        for (int r = 0; r < 16; ++r) x += ((const float*)(F.ws + WS_ALR))[m * 16 + r] * F.wau[r * 1024 + h * 256 + d];
        const float la = logsig(x) * 0.0625f, e = __expf(la);
        const float q = bf2f(P[m * PLD + C_Q + h * 256 + d]) * 0.0625f, k = bf2f(P[m * PLD + C_K + h * 256 + d]);
        e_s[d] = e; qe_s[d] = q * e; k_s[d] = k; part = q * k; }
    v_s[tid] = bf2f(P[m * PLD + C_V + h * 512 + tid]);
    part = wave_sum(part);
    if (lane == 0) red_s[wv] = part;
    __syncthreads();
    const float attn = (red_s[0] + red_s[1]) + (red_s[2] + red_s[3]);
    const float* Sin = F.sgla + ((size_t)(n * 4 + h) * 256) * 512; float* Sout = F.out + OUT_GLAS + ((size_t)(n * 4 + h) * 256) * 512;
    const f32x4 v0 = *(const f32x4*)(v_s + 4 * lane), v1 = *(const f32x4*)(v_s + 256 + 4 * lane);
    f32x4 o0 = {0.f, 0.f, 0.f, 0.f}, o1 = {0.f, 0.f, 0.f, 0.f};
#pragma unroll 1
    for (int g = 0; g < 2; ++g) {
        f32x4 s0[16], s1[16];
#pragma unroll
        for (int i = 0; i < 16; ++i) { const int d = 32 * wv + 16 * g + i; s0[i] = __builtin_nontemporal_load((const f32x4*)(Sin + (size_t)d * 512 + 4 * lane)); s1[i] = __builtin_nontemporal_load((const f32x4*)(Sin + (size_t)d * 512 + 256 + 4 * lane)); }
#pragma unroll
        for (int i = 0; i < 16; ++i) { const int d = 32 * wv + 16 * g + i; const float e = e_s[d], qe = qe_s[d], k = k_s[d];
            o0 += s0[i] * qe; o1 += s1[i] * qe;
            __builtin_nontemporal_store(s0[i] * e + v0 * k, (f32x4*)(Sout + (size_t)d * 512 + 4 * lane)); __builtin_nontemporal_store(s1[i] * e + v1 * k, (f32x4*)(Sout + (size_t)d * 512 + 256 + 4 * lane)); }
    }
    *(f32x4*)(op_s + wv * 512 + 4 * lane) = o0; *(f32x4*)(op_s + wv * 512 + 256 + 4 * lane) = o1;
    __syncthreads();
    { float o = attn * v_s[tid];
#pragma unroll
      for (int w8 = 0; w8 < 8; ++w8) o += op_s[w8 * 512 + tid];
      O[m * DM + h * 512 + tid] = (bf16)f2bf(o); }
    __syncthreads();
}

struct GlaRegs { bf16x8 kt[2][2], at, q[4]; v4u vpiece; float epiece; };
struct GlaOffs { unsigned l16, vt, eb; };
template <int NT>
__device__ __forceinline__ GlaOffs gla_offs(int lane, int tid) {
    const int tv = tid & (NT * 128 - 1); GlaOffs o;
    o.l16 = (unsigned)(lane * 16);
    o.vt = (unsigned)(((tv >> 3) * 64 + 8 * (tv & 7)) * 2);
    o.eb = (unsigned)((tid & 255) * 4);
    return o;
}
template <int NT>
__device__ __forceinline__ void gla_load(GlaRegs& R, const GlaOffs& o, const bf16* QT, const bf16* KT, const bf16* VT, const bf16* ATT, const float* EBL, int bh, int s, int c, int wv) {
    const size_t u = (size_t)bh * 32 + c;
    const char* pa = (const char*)(ATT + u * 4096) + wv * 1024; const char* pv = (const char*)(VT + (u * 512 + 16 * NT * s) * 64);
    const char* pq = (const char*)(QT + u * 16384) + wv * 4096; const char* pk = (const char*)(KT + u * 16384) + wv * 4096;
    R.at = *(const bf16x8*)(pa + o.l16);
    R.vpiece = *(const v4u*)(pv + o.vt);
    R.epiece = *(const float*)((const char*)(EBL + u * 256) + o.eb);
#pragma unroll
    for (int ks = 0; ks < 4; ++ks) R.q[ks] = *(const bf16x8*)(pq + o.l16 + 1024 * ks);
#pragma unroll
    for (int t = 0; t < 2; ++t)
#pragma unroll
        for (int ks = 0; ks < 2; ++ks) R.kt[t][ks] = *(const bf16x8*)(pk + o.l16 + 2048 * t + 1024 * ks);
}
constexpr int VT_LD = 72;
template <int NT>
__device__ __forceinline__ void gla_step(const GlaRegs& R, const float* ebs, f32x4 (&S)[2][NT], const bf16* vts, const bf16* STp, bf16* STn, float* xo, int wv, int lane, int l15, int lq) {
    const int mi = wv >> 1, kh = wv & 1;
#pragma unroll
    for (int nt = 0; nt < NT; ++nt) {
        f32x4 acc = {0.f, 0.f, 0.f, 0.f};
        { const bf16x8 vsel = *(const bf16x8*)(vts + (16 * nt + l15) * VT_LD + 32 * kh + 8 * lq); acc = MFMA16(R.at, vsel, acc); }
#pragma unroll
        for (int ks = 0; ks < 4; ++ks) { const bf16x8 sf = *(const bf16x8*)(STp + (16 * nt + l15) * 264 + 128 * kh + 32 * ks + 8 * lq); acc = MFMA16(R.q[ks], sf, acc); }
        *(f32x4*)(xo + (((mi * 2 + kh) * NT + nt) * 64 + lane) * 4) = acc;
    }
#pragma unroll
    for (int nt = 0; nt < NT; ++nt) {
        bf16x8 vt[2];
#pragma unroll
        for (int ks = 0; ks < 2; ++ks) vt[ks] = *(const bf16x8*)(vts + (16 * nt + l15) * VT_LD + 32 * ks + 8 * lq);
#pragma unroll
        for (int mt = 0; mt < 2; ++mt) {
#pragma unroll
            for (int ks = 0; ks < 2; ++ks) S[mt][nt] = MFMA16(R.kt[mt][ks], vt[ks], S[mt][nt]);
            S[mt][nt] = S[mt][nt] * *(const f32x4*)(ebs + 32 * wv + 16 * mt + 4 * lq);
            v2u w; w.x = pg8::cvt_pk_bf16(S[mt][nt][0], S[mt][nt][1]); w.y = pg8::cvt_pk_bf16(S[mt][nt][2], S[mt][nt][3]);
            *(v2u*)(STn + (16 * nt + l15) * 264 + 32 * wv + 16 * mt + 4 * lq) = w; } }
}
template <int NT>
__device__ __forceinline__ void gla_store_o(const float* xo, bf16* O, int b, int h, int s, int c, int wv, int lane, int l15, int lq) {
    const int mi = wv >> 1, kh = wv & 1;
#pragma unroll
    for (int n2 = 0; n2 < NT / 2; ++n2) { const int nt = kh * (NT / 2) + n2;
        const f32x4 t = *(const f32x4*)(xo + (((mi * 2 + 0) * NT + nt) * 64 + lane) * 4) + *(const f32x4*)(xo + (((mi * 2 + 1) * NT + nt) * 64 + lane) * 4);
        const unsigned p01 = pg8::cvt_pk_bf16(t[0], t[1]), p23 = pg8::cvt_pk_bf16(t[2], t[3]);
        bf16* dst = O + ((size_t)b * 2048 + 64 * c + 16 * mi + 4 * lq) * DM + h * 512 + 16 * NT * s + 16 * nt + l15;
        dst[0] = (bf16)(p01 & 0xffffu); dst[DM] = (bf16)(p01 >> 16); dst[2 * DM] = (bf16)(p23 & 0xffffu); dst[3 * DM] = (bf16)(p23 >> 16); }
}
#define GLA_BAR() do { asm volatile("s_waitcnt lgkmcnt(0)" ::: "memory"); __builtin_amdgcn_s_barrier(); asm volatile("" ::: "memory"); } while (0)
template <int NT>
__device__ __forceinline__ void gla_main_unit(Frame& F, int bh, int s) {
    const bf16* QT = (const bf16*)(F.ws + WS_QT); const bf16* KT = (const bf16*)(F.ws + WS_KT); const bf16* VT = (const bf16*)(F.ws + WS_VT);
    const bf16* ATT = (const bf16*)(F.ws + WS_ATT); const float* EBL = (const float*)(F.ws + WS_EBL); bf16* O = (bf16*)(F.ws + WS_O);
    const int b = bh >> 2, h = bh & 3, wv = F.wave, lane = F.lane, l15 = lane & 15, lq = lane >> 4, kh = wv & 1, tid = F.tid;
    constexpr int ST_ELEMS = NT * 16 * 264, XO_FLOATS = 8 * NT * 256, VTS_ELEMS = NT * 16 * VT_LD;
    bf16* ST = (bf16*)F.lds;
    float* XO = (float*)(F.lds + 2 * ST_ELEMS * 2);
    bf16* VTS = (bf16*)(F.lds + 2 * ST_ELEMS * 2 + 2 * XO_FLOATS * 4);
    float* EBS = (float*)(F.lds + 2 * ST_ELEMS * 2 + 2 * XO_FLOATS * 4 + 2 * VTS_ELEMS * 2);
    for (int e = tid; e < ST_ELEMS; e += 512) ((unsigned*)ST)[e] = 0u;
    f32x4 S[2][NT];
#pragma unroll
    for (int a = 0; a < 2; ++a)
#pragma unroll
        for (int c2 = 0; c2 < NT; ++c2) S[a][c2] = (f32x4){0.f, 0.f, 0.f, 0.f};
    const GlaOffs go = gla_offs<NT>(lane, tid);
    GlaRegs RA, RB, RC;
    gla_load<NT>(RA, go, QT, KT, VT, ATT, EBL, bh, s, 0, wv);
    gla_load<NT>(RB, go, QT, KT, VT, ATT, EBL, bh, s, 1, wv);
    if (tid < NT * 128) *(v4u*)(VTS + (tid >> 3) * VT_LD + 8 * (tid & 7)) = RA.vpiece;
    if (tid < 256) EBS[tid] = RA.epiece;
    __syncthreads();
#define GLA_ITER(c, RCUR, RNXT, RLD) do { if ((c) < 32) { \
            gla_load<NT>(RLD, go, QT, KT, VT, ATT, EBL, bh, s, (c) + 2 < 32 ? (c) + 2 : 31, wv); \
            gla_step<NT>(RCUR, EBS + ((c) & 1) * 256, S, VTS + ((c) & 1) * VTS_ELEMS, ST + ((c) & 1) * ST_ELEMS, ST + (((c) + 1) & 1) * ST_ELEMS, XO + ((c) & 1) * XO_FLOATS, wv, lane, l15, lq); \
            if ((c) > 0) gla_store_o<NT>(XO + (((c) + 1) & 1) * XO_FLOATS, O, b, h, s, (c) - 1, wv, lane, l15, lq); \
            if (tid < NT * 128) *(v4u*)(VTS + (((c) + 1) & 1) * VTS_ELEMS + (tid >> 3) * VT_LD + 8 * (tid & 7)) = RNXT.vpiece; \
            if (tid < 256) EBS[(((c) + 1) & 1) * 256 + tid] = RNXT.epiece; \
            GLA_BAR(); \
        } } while (0)
#pragma unroll 1
    for (int c = 0; c < 33; c += 3) { GLA_ITER(c, RA, RB, RC); GLA_ITER(c + 1, RB, RC, RA); GLA_ITER(c + 2, RC, RA, RB); }
#undef GLA_ITER
    gla_store_o<NT>(XO + (31 & 1) * XO_FLOATS, O, b, h, s, 31, wv, lane, l15, lq);
    int lq2 = lq; asm volatile("" : "+v"(lq2));
    float* So = F.out + OUT_GLAP + ((size_t)bh * 256) * 512;
#pragma unroll
    for (int mt = 0; mt < 2; ++mt)
#pragma unroll
        for (int nt = 0; nt < NT; ++nt)
#pragma unroll
            for (int r = 0; r < 4; ++r) So[(size_t)(32 * wv + 16 * mt + 4 * lq2 + r) * 512 + 16 * NT * s + 16 * nt + l15] = S[mt][nt][r];
    __syncthreads();
}

template <int NR>
__device__ __forceinline__ void mixer_rows(Frame& F, int m0) {
    const bf16* P = (const bf16*)(F.ws + WS_P); const bf16* O = (const bf16*)(F.ws + WS_O); bf16* MM = (bf16*)(F.ws + WS_MM);
    const int lane = F.lane; const bool prompt = m0 < TP;
#pragma unroll 1
    for (int j = 0; j < 4; ++j) {
        const int col = 512 * j + 8 * lane;
        float u1[8], u2[8], gn[8], cbi[8], w0[8], w1[8], w2[8];
        { const f32x4 a = *(const f32x4*)(F.gng + col), b2 = *(const f32x4*)(F.gng + col + 4); gn[0] = a.x; gn[1] = a.y; gn[2] = a.z; gn[3] = a.w; gn[4] = b2.x; gn[5] = b2.y; gn[6] = b2.z; gn[7] = b2.w; }
        { const f32x4 a = *(const f32x4*)(F.cb + col), b2 = *(const f32x4*)(F.cb + col + 4); cbi[0] = a.x; cbi[1] = a.y; cbi[2] = a.z; cbi[3] = a.w; cbi[4] = b2.x; cbi[5] = b2.y; cbi[6] = b2.z; cbi[7] = b2.w; }
        { const f32x4 a = *(const f32x4*)(F.cw + col), b2 = *(const f32x4*)(F.cw + col + 4); w0[0] = a.x; w0[1] = a.y; w0[2] = a.z; w0[3] = a.w; w0[4] = b2.x; w0[5] = b2.y; w0[6] = b2.z; w0[7] = b2.w; }
        { const f32x4 a = *(const f32x4*)(F.cw + DM + col), b2 = *(const f32x4*)(F.cw + DM + col + 4); w1[0] = a.x; w1[1] = a.y; w1[2] = a.z; w1[3] = a.w; w1[4] = b2.x; w1[5] = b2.y; w1[6] = b2.z; w1[7] = b2.w; }
        { const f32x4 a = *(const f32x4*)(F.cw + 2 * DM + col), b2 = *(const f32x4*)(F.cw + 2 * DM + col + 4); w2[0] = a.x; w2[1] = a.y; w2[2] = a.z; w2[3] = a.w; w2[4] = b2.x; w2[5] = b2.y; w2[6] = b2.z; w2[7] = b2.w; }
        if (prompt) {
            const int t0 = m0 & 2047; const bf16* Pr = P + (size_t)m0 * PLD;
            if (t0 >= 1) { float a[8], b2[8]; unpack8(*(const v4u*)(Pr - PLD + C_CC + col), a); unpack8(*(const v4u*)(Pr - PLD + C_CX + col), b2);
#pragma unroll
                for (int e = 0; e < 8; ++e) u1[e] = a[e] * b2[e]; }
            else {
#pragma unroll
                for (int e = 0; e < 8; ++e) u1[e] = 0.f; }
            if (t0 >= 2) { float a[8], b2[8]; unpack8(*(const v4u*)(Pr - 2 * PLD + C_CC + col), a); unpack8(*(const v4u*)(Pr - 2 * PLD + C_CX + col), b2);
#pragma unroll
                for (int e = 0; e < 8; ++e) u2[e] = a[e] * b2[e]; }
            else {
#pragma unroll
                for (int e = 0; e < 8; ++e) u2[e] = 0.f; }
        } else {
            const int n = m0 - TP; const float* sc = F.sconv + (size_t)n * 2 * DM + col;
            const f32x4 a0 = *(const f32x4*)sc, a1 = *(const f32x4*)(sc + 4), b0 = *(const f32x4*)(sc + DM), b1 = *(const f32x4*)(sc + DM + 4);
            u2[0] = a0.x; u2[1] = a0.y; u2[2] = a0.z; u2[3] = a0.w; u2[4] = a1.x; u2[5] = a1.y; u2[6] = a1.z; u2[7] = a1.w;
            u1[0] = b0.x; u1[1] = b0.y; u1[2] = b0.z; u1[3] = b0.w; u1[4] = b1.x; u1[5] = b1.y; u1[6] = b1.z; u1[7] = b1.w;
        }
        v4u lo[NR], lr[NR], lcb[NR], lcc[NR], lcx[NR], lga[NR], lgb[NR];
#pragma unroll
        for (int r = 0; r < NR; ++r) { const int m = m0 + r; const bf16* Pr = P + (size_t)m * PLD;
            lo[r] = *(const v4u*)(O + (size_t)m * DM + col);
            lr[r] = __builtin_nontemporal_load((const v4u*)(Pr + C_R + col)); lcb[r] = __builtin_nontemporal_load((const v4u*)(Pr + C_CB + col)); lcc[r] = __builtin_nontemporal_load((const v4u*)(Pr + C_CC + col));
            lcx[r] = __builtin_nontemporal_load((const v4u*)(Pr + C_CX + col)); lga[r] = __builtin_nontemporal_load((const v4u*)(Pr + C_GA + col)); lgb[r] = __builtin_nontemporal_load((const v4u*)(Pr + C_GB + col)); }
#pragma unroll
        for (int r = 0; r < NR; ++r) {
            const int m = m0 + r;
            float o[8], rr[8], cbv[8], cc[8], cx[8], ga[8], gb[8], u[8];
            unpack8(lo[r], o); unpack8(lr[r], rr); unpack8(lcb[r], cbv); unpack8(lcc[r], cc); unpack8(lcx[r], cx); unpack8(lga[r], ga); unpack8(lgb[r], gb);
            float ss = 0.f;
#pragma unroll
            for (int e = 0; e < 8; ++e) ss += o[e] * o[e];
            const float rstd = 1.0f / sqrtf(wave_sum(ss) * (1.0f / 512.0f) + EPS);
#pragma unroll
            for (int e = 0; e < 8; ++e) u[e] = cc[e] * cx[e];
            if (prompt) { const int t = m & 2047;
                if (t >= 2046) { float* dst = F.out + OUT_CONVP + ((size_t)(m >> 11) * 2 + (t - 2046)) * DM + col;
                    *(f32x4*)dst = (f32x4){u[0], u[1], u[2], u[3]}; *(f32x4*)(dst + 4) = (f32x4){u[4], u[5], u[6], u[7]}; }
            } else { float* dst = F.out + OUT_CONVS + (size_t)(m - TP) * 2 * DM + col;
                *(f32x4*)dst = (f32x4){u1[0], u1[1], u1[2], u1[3]}; *(f32x4*)(dst + 4) = (f32x4){u1[4], u1[5], u1[6], u1[7]};
                *(f32x4*)(dst + DM) = (f32x4){u[0], u[1], u[2], u[3]}; *(f32x4*)(dst + DM + 4) = (f32x4){u[4], u[5], u[6], u[7]}; }
            float mv[8];
#pragma unroll
            for (int e = 0; e < 8; ++e) {
                const float ya = (rr[e] * sigmoidf_(rr[e])) * (o[e] * rstd * gn[e]);
                const float z = cbi[e] + w0[e] * u2[e] + w1[e] * u1[e] + w2[e] * u[e];
                mv[e] = sigmoidf_(ga[e]) * ya + sigmoidf_(gb[e]) * (cbv[e] * z);
                u2[e] = u1[e]; u1[e] = u[e];
            }
            *(v4u*)(MM + (size_t)m * DM + col) = pack8(mv);
        }
    }
}

constexpr int SC_LD = 130;
__device__ __forceinline__ int f2sort(float f) { const int b = __float_as_int(f); return b ^ ((b >> 31) & 0x7fffffff); }
__device__ __forceinline__ float sort2f(int s) { return __int_as_float(s ^ ((s >> 31) & 0x7fffffff)); }
#define CE_DESC(x, y) do { const int mx_ = max(x, y), mn_ = min(x, y); x = mx_; y = mn_; } while (0)
template <int N> __device__ __forceinline__ void bitonic_sort_desc(int (&a)[N]) {
#pragma unroll
    for (int k = 2; k <= N; k <<= 1)
#pragma unroll
        for (int j = k >> 1; j > 0; j >>= 1)
#pragma unroll
            for (int i = 0; i < N; ++i) { const int l = i ^ j; if (l > i) { if ((i & k) == 0) CE_DESC(a[i], a[l]); else CE_DESC(a[l], a[i]); } }
}
template <int N> __device__ __forceinline__ void bitonic_merge_desc(int (&a)[N]) {
#pragma unroll
    for (int j = N >> 1; j > 0; j >>= 1)
#pragma unroll
        for (int i = 0; i < N; ++i) { const int l = i ^ j; if (l > i) CE_DESC(a[i], a[l]); }
}
__device__ __forceinline__ void top16_merge(int (&a)[16], const int (&b)[16]) {
#pragma unroll
    for (int i = 0; i < 16; ++i) a[i] = max(a[i], b[15 - i]);
    bitonic_merge_desc<16>(a);
}
__device__ __attribute__((aligned(16))) const unsigned char PK_CAND[64] = {
    0x00, 0x01, 0x02, 0x03, 0x04, 0x05, 0x06, 0x07, 0x08, 0x09, 0x0a, 0x0b, 0x0c, 0x0d, 0x0e, 0x0f,
    0x10, 0x11, 0x12, 0x13, 0x14, 0x15, 0x16, 0x17, 0x20, 0x21, 0x22, 0x23, 0x24, 0x50, 0x51, 0xff,
    0x30, 0x31, 0x32, 0x33, 0x40, 0x41, 0x42, 0x60, 0x61, 0x70, 0x71, 0xff, 0xff, 0xff, 0xff, 0xff,
    0x80, 0x90, 0xa0, 0xb0, 0xc0, 0xd0, 0xe0, 0xf0, 0xff, 0xff, 0xff, 0xff, 0xff, 0xff, 0xff, 0xff};
constexpr int SC8_LD = 132, SK_LD = 136;
constexpr int SC8_BYTES = 128 * SC8_LD * 4, TV8_OFF = SC8_BYTES, SK_OFF = TV8_OFF + 128 * 16 * 4;
__device__ __forceinline__ void peer_load_subkeys(Frame& F) {
    const bf16* SKB = (const bf16*)(F.ws + WS_SKB); bf16* sk_s = (bf16*)(F.lds + SK_OFF);
    for (int e = F.tid; e < 256 * 16; e += 512) { const int row = e >> 4, ch = e & 15; *(v4u*)(sk_s + row * SK_LD + 8 * ch) = *(const v4u*)(SKB + (size_t)row * 128 + 8 * ch); }
    __syncthreads();
}
__device__ __forceinline__ void peer_qfrags(Frame& F, int tb, bf16x8 (&a)[2][4]) {
    const bf16* QP = (const bf16*)(F.ws + WS_QP); const int tok = min(tb + (F.lane & 7), TT - 1), lq = F.lane >> 4;
#pragma unroll
    for (int hf = 0; hf < 2; ++hf)
#pragma unroll
        for (int ks = 0; ks < 4; ++ks) a[hf][ks] = *(const bf16x8*)(QP + (size_t)tok * DM + F.wave * 256 + hf * 128 + 32 * ks + 8 * lq);
}
#define PK_BAR() do { asm volatile("s_waitcnt lgkmcnt(0)" ::: "memory"); __builtin_amdgcn_s_barrier(); asm volatile("" ::: "memory"); } while (0)
__device__ __forceinline__ void peer_topk_tile(Frame& F, int tb, int tend, bf16x8 (&a)[2][4]) {
    int* IDX = (int*)(F.ws + WS_IDX); float* GW = (float*)(F.ws + WS_GW);
    float* sc_s = (float*)F.lds;
    int* tv_s = (int*)(F.lds + TV8_OFF);
    const bf16* sk_s = (const bf16*)(F.lds + SK_OFF);
    const int wv = F.wave, lane = F.lane, l15 = lane & 15, lq = lane >> 4, tid = F.tid;
    {
#pragma unroll
      for (int hf = 0; hf < 2; ++hf) {
#pragma unroll
          for (int nt = 0; nt < 8; ++nt) { f32x4 acc = {0.f, 0.f, 0.f, 0.f};
#pragma unroll
              for (int ks = 0; ks < 4; ++ks) { const bf16x8 bq = *(const bf16x8*)(sk_s + (hf * 128 + 16 * nt + l15) * SK_LD + 32 * ks + 8 * lq); acc = MFMA16(a[hf][ks], bq, acc); }
              if (lq < 2) {
#pragma unroll
                  for (int r = 0; r < 4; ++r) sc_s[((wv * 2 + hf) * 8 + 4 * lq + r) * SC8_LD + 16 * nt + l15] = acc[r]; } } } }
    if (tb + 8 < tend) peer_qfrags(F, tb + 8, a);
    PK_BAR();
    { const int row = tid >> 2, sub = tid & 3; const float* rp = sc_s + row * SC8_LD;
      int top[16], v[16];
#pragma unroll
      for (int i = 0; i < 16; ++i) { const int key = 4 * i + sub; top[i] = (f2sort(rp[key]) & ~127) | (127 - key); }
      bitonic_sort_desc<16>(top);
#pragma unroll
      for (int i = 0; i < 16; ++i) { const int key = 4 * (16 + i) + sub; v[i] = (f2sort(rp[key]) & ~127) | (127 - key); }
      bitonic_sort_desc<16>(v);
      top16_merge(top, v);
#pragma unroll
      for (int sh = 1; sh < 4; sh <<= 1) {
#pragma unroll
          for (int i = 0; i < 16; ++i) v[i] = __shfl_xor(top[i], sh);
          top16_merge(top, v); }
      if (sub == 0) {
#pragma unroll
          for (int q = 0; q < 4; ++q) *(int __attribute__((ext_vector_type(4)))*)(tv_s + row * 16 + 4 * q) = (int __attribute__((ext_vector_type(4)))){top[4 * q], top[4 * q + 1], top[4 * q + 2], top[4 * q + 3]}; }
    }
    PK_BAR();
    if (tid < 256) { const int it = tid >> 2, qd = tid & 3, tl = it & 7, hd = it >> 3;
      const int* r1 = tv_s + ((hd * 2 + 0) * 8 + tl) * 16; const int* r2 = tv_s + ((hd * 2 + 1) * 8 + tl) * 16;
      int c[16];
      const v4u cw = *(const v4u*)(PK_CAND + qd * 16);
#pragma unroll
      for (int t = 0; t < 16; ++t) { const int ab = (int)((cw[t >> 2] >> (8 * (t & 3))) & 0xffu); const int abc = ab != 0xff ? ab : 0;
          const float sv = sort2f(r1[abc >> 4] & ~127) + sort2f(r2[abc & 15] & ~127); const int packed = (f2sort(sv) & ~255) | (255 - ab);
          c[t] = ab != 0xff ? packed : (int)0x80000000; }
      bitonic_sort_desc<16>(c);
#pragma unroll
      for (int sh = 1; sh < 4; sh <<= 1) { int oth[16];
#pragma unroll
          for (int i = 0; i < 16; ++i) oth[i] = __shfl_xor(c[i], sh);
          top16_merge(c, oth); }
      const int tok = tb + tl;
      if (tok < tend) {
          float ev[16], sum = 0.f; const float mx = sort2f(c[0] & ~255);
#pragma unroll
          for (int k = 0; k < 16; ++k) { ev[k] = __expf(sort2f(c[k] & ~255) - mx); sum += ev[k]; }
          const float inv = 1.0f / sum;
#pragma unroll
          for (int k = 0; k < 16; ++k) if ((k >> 2) == qd) { const int ab = 255 - (c[k] & 255); const int i1 = 127 - (r1[ab >> 4] & 127), i2 = 127 - (r2[ab & 15] & 127);
              IDX[(size_t)tok * 128 + hd * 16 + k] = i1 * 128 + i2; GW[(size_t)tok * 128 + hd * 16 + k] = ev[k] * inv; }
      }
    }
    PK_BAR();
}

__device__ __forceinline__ void peer_phase(Frame& F, int tok0, int tok1) {
    const unsigned char* U6 = F.ws + WS_EU; const unsigned char* V6 = F.ws + WS_EV; const float* SU = (const float*)(F.ws + WS_EU + 32 * MiB); const float* SV = (const float*)(F.ws + WS_EV + 32 * MiB);
    const bf16* X2 = (const bf16*)(F.ws + WS_H2); const float* RS2 = (const float*)(F.ws + WS_RS2); const int* IDX = (const int*)(F.ws + WS_IDX); const float* GW = (const float*)(F.ws + WS_GW);
    const int wv = F.wave, lane = F.lane, tid = F.tid;
    float* red_s = (float*)F.lds;
    float* ss_s = (float*)(F.lds + 131072);
    const f32x4 gfin = *(const f32x4*)(F.nfg + 4 * tid);
    f32x4 x3p = {0.f, 0.f, 0.f, 0.f}; int buf = 0;
#pragma unroll 1
    for (int m = tok0; m <= tok1; ++m) {
        if (m < tok1) {
            const int myidx = IDX[(size_t)m * 128 + wv * 16 + (lane & 15)]; float myg = GW[(size_t)m * 128 + wv * 16 + (lane & 15)];
            const float mysu = SU[myidx] * RS2[m]; myg *= SV[myidx];
            float hf[32];
#pragma unroll
            for (int j = 0; j < 8; ++j) { const v2u w = *(const v2u*)(X2 + (size_t)m * DM + 256 * j + 4 * lane); hf[4 * j] = bflo(w.x); hf[4 * j + 1] = bfhi(w.x); hf[4 * j + 2] = bflo(w.y); hf[4 * j + 3] = bfhi(w.y); }
            float acc[32];
#pragma unroll
            for (int k = 0; k < 32; ++k) acc[k] = 0.f;
#pragma unroll 1
            for (int kg = 0; kg < 4; ++kg) {
                v4u ul4[4], vl4[4]; v2u ul2[4]; float gk[4], su[4];
#pragma unroll
                for (int kk = 0; kk < 4; ++kk) { const int ex = __builtin_amdgcn_readlane(myidx, kg * 4 + kk); gk[kk] = __builtin_bit_cast(float, __builtin_amdgcn_readlane(__builtin_bit_cast(int, myg), kg * 4 + kk)); su[kk] = __builtin_bit_cast(float, __builtin_amdgcn_readlane(__builtin_bit_cast(int, mysu), kg * 4 + kk));
                    const unsigned char* ur = U6 + (size_t)ex * ROW6; const unsigned char* vr = V6 + (size_t)ex * ROW4;
                    ul4[kk] = *(const v4u*)(ur + 16 * lane); ul2[kk] = *(const v2u*)(ur + 1024 + 8 * lane); vl4[kk] = *(const v4u*)(vr + 16 * lane); }
#pragma unroll
                for (int kk = 0; kk < 4; ++kk) {
                    const v32f uf = __builtin_amdgcn_cvt_scalef32_pk32_f32_fp6((v6u){ul4[kk].x, ul4[kk].y, ul4[kk].z, ul4[kk].w, ul2[kk].x, ul2[kk].y}, 1.0f);
                    f32x2 d2a = {0.f, 0.f}, d2b = {0.f, 0.f};
#pragma unroll
                    for (int k = 0; k < 32; k += 4) { d2a += (f32x2){uf[k], uf[k + 1]} * (f32x2){hf[k], hf[k + 1]}; d2b += (f32x2){uf[k + 2], uf[k + 3]} * (f32x2){hf[k + 2], hf[k + 3]}; }
                    const float dot = (d2a.x + d2a.y) + (d2b.x + d2b.y);
                    const float a = wave_sum_dpp(dot) * su[kk];
                    const float wgt = gk[kk] * gelu_erf(a);
#pragma unroll
                    for (int d = 0; d < 4; ++d) {
                        const f32x2 v0 = __builtin_amdgcn_cvt_scalef32_pk_f32_fp4(vl4[kk][d], 1.0f, 0), v1 = __builtin_amdgcn_cvt_scalef32_pk_f32_fp4(vl4[kk][d], 1.0f, 1), v2 = __builtin_amdgcn_cvt_scalef32_pk_f32_fp4(vl4[kk][d], 1.0f, 2), v3 = __builtin_amdgcn_cvt_scalef32_pk_f32_fp4(vl4[kk][d], 1.0f, 3);
                        acc[8 * d] += wgt * v0.x; acc[8 * d + 1] += wgt * v0.y; acc[8 * d + 2] += wgt * v1.x; acc[8 * d + 3] += wgt * v1.y; acc[8 * d + 4] += wgt * v2.x; acc[8 * d + 5] += wgt * v2.y; acc[8 * d + 6] += wgt * v3.x; acc[8 * d + 7] += wgt * v3.y; }
                }
            }
#pragma unroll
            for (int j = 0; j < 8; ++j) *(f32x4*)(red_s + (buf * 8 + wv) * 2048 + 256 * j + 4 * lane) = (f32x4){acc[4 * j], acc[4 * j + 1], acc[4 * j + 2], acc[4 * j + 3]};
        }
        __syncthreads();
        if (m > tok0) {
            float tot = 0.f;
#pragma unroll
            for (int w8 = 0; w8 < 8; ++w8) tot += ss_s[(buf ^ 1) * 8 + w8];
            const float rstd = 1.0f / sqrtf(tot * (1.0f / DM) + EPS);
            *(f32x4*)(F.out + OUT_Y + (size_t)(m - 1) * DM + 4 * tid) = x3p * rstd * gfin;
        }
        if (m < tok1) {
            f32x4 x3; { const v2u w = *(const v2u*)(X2 + (size_t)m * DM + 4 * tid); x3 = (f32x4){bflo(w.x), bfhi(w.x), bflo(w.y), bfhi(w.y)}; }
#pragma unroll
            for (int w8 = 0; w8 < 8; ++w8) x3 += *(const f32x4*)(red_s + (buf * 8 + w8) * 2048 + 4 * tid);
            const float ss = wave_sum((x3.x * x3.x + x3.y * x3.y) + (x3.z * x3.z + x3.w * x3.w));
            if (lane == 0) ss_s[buf * 8 + wv] = ss;
            x3p = x3;
        }
        buf ^= 1;
    }
    __syncthreads();
}
struct Args { const float* in[18]; float* out; unsigned char* ws; int ph_lo, ph_hi; };
__global__ void __launch_bounds__(NWAVES * 64, 2) mk_fwd(Args args) {
    extern __shared__ __attribute__((aligned(16))) unsigned char lds[];
    Frame F;
    F.lds = lds;
    F.tid = threadIdx.x; F.lane = F.tid & 63; F.wave = __builtin_amdgcn_readfirstlane(F.tid >> 6);
    F.G = gridDim.x; { const int bx = blockIdx.x; F.vcu = (F.G % 8 == 0) ? (bx % 8) * (F.G / 8) + bx / 8 : bx; }
    F.xp = args.in[0]; F.xs = args.in[1]; F.sgla = args.in[2]; F.sconv = args.in[3]; F.n1g = args.in[4]; F.win = args.in[5]; F.wau = args.in[6]; F.bal = args.in[7];
    F.gng = args.in[8]; F.cw = args.in[9]; F.cb = args.in[10]; F.wout = args.in[11]; F.n2g = args.in[12]; F.wq = args.in[13]; F.sk = args.in[14]; F.eu = args.in[15];
    F.ev = args.in[16]; F.nfg = args.in[17]; F.out = args.out; F.ws = args.ws;
    for (int u = F.tid; u < (LDS_BYTES - LDSCTL_OFF) / 4; u += NWAVES * 64) ((LAS unsigned*)((LAS unsigned char*)lds + LDSCTL_OFF))[u] = 0u;
    __syncthreads();
    gu32* ctl = (gu32*)(F.ws + WS_CTL);
    XcdBarrier bar; bar.bar = (unsigned*)(ctl + CW_BAR); bar.x = 0; bar.st = nullptr;
    if (N_LAUNCHES == 1) bar = xcd_barrier_post((unsigned*)(ctl + CW_BAR), (volatile LAS unsigned*)((LAS unsigned char*)lds + MISC_OFF) + 8);
    const int lo = args.ph_lo, hi = args.ph_hi;
#ifdef PROBE_TIME_MAIN
    unsigned long long probe_dt_ = 0;
#endif
#ifndef G1_WGM
#define G1_WGM 3
#endif
#ifndef G23_WGM
#define G23_WGM 3
#endif
#ifndef G1_ALIGN
#define G1_ALIGN true
#endif
#ifndef G1_SP2
#define G1_SP2 true
#endif
#ifndef SKREP
#define SKREP 1
#endif
#ifndef PROBE_DBL
#define PROBE_DBL -1
#endif
#define IN(k) (lo <= (k) && (k) < hi)
#define REP(k) for (int rep_ = 0; rep_ < ((k) == PROBE_DBL ? 2 : 1); ++rep_)
#ifndef BAR_REP
#define BAR_REP 1
#endif
#ifndef PROBE_TIME_PHASE
#define PROBE_TIME_PHASE -1
#endif
    unsigned long long ptp_t0_ = 0, ptp_dt_ = 0;
#define PH_BEGIN(k) do { if ((k) == PROBE_TIME_PHASE) ptp_t0_ = __builtin_amdgcn_s_memrealtime(); } while (0)
#define SEAM(k) do { if (IN(k) && IN((k) + 1)) for (int br_ = 0; br_ < BAR_REP; ++br_) xcd_barrier(bar); if ((k) == PROBE_TIME_PHASE) ptp_dt_ = __builtin_amdgcn_s_memrealtime() - ptp_t0_; } while (0)
    const int gw = F.vcu * NWAVES + F.wave, NGW = F.G * NWAVES;
    const int tok0 = (int)(((long)F.vcu * TT) / F.G), tok1 = (int)(((long)(F.vcu + 1) * TT) / F.G);

    PH_BEGIN(0);
    if (IN(0)) REP(0) { p0_prologue(F); __syncthreads(); }
    SEAM(0);
    PH_BEGIN(1);
    if (IN(1)) REP(1) {
        pg8::Gemm g{(const pg8::bf16_t*)(F.ws + WS_XN), (const pg8::bf16_t*)(F.ws + WS_WINT), TP, NP, DM}; pg8::StaticOrder S; S.init(TP, NP, F.G, (int)blockIdx.x, G1_WGM);
        pg8::EpiBf16<0> E{(pg8::bf16_t*)(F.ws + WS_P), PLD, nullptr, 0, 0, 1.f};
        pg8::gemm_phase<pg8::EpiBf16<0>, pg8::StaticOrder, G1_ALIGN, G1_SP2>((PG8_LAS unsigned char*)lds + RING_OFF, g, S, E);
#ifdef GEMM1_TWICE
        pg8::gemm_phase<pg8::EpiBf16<0>, pg8::StaticOrder, G1_ALIGN, G1_SP2>((PG8_LAS unsigned char*)lds + RING_OFF, g, S, E);
#endif
        { EpiSkBf16 Es{(bf16*)(F.ws + WS_P) + (size_t)TP * PLD, PLD, nullptr};
          for (int skr = 0; skr < SKREP; ++skr) for (int ng = F.vcu; ng < NP / 64; ng += F.G) skinny_gemm<4>(F, (const bf16*)(F.ws + WS_XN) + (size_t)TP * DM, (const bf16*)(F.ws + WS_WINT), 64 * ng, Es); }
    }
    SEAM(1);
    PH_BEGIN(2);
    if (IN(2)) REP(2) {
        if (F.G == 256) { for (int i = 0; i < 2; ++i) gla_prep_unit(F, (F.vcu >> 4) * 32 + 2 * (F.vcu & 15) + i); }
        else { for (int u = F.vcu; u < 512; u += F.G) gla_prep_unit(F, u); }
        convert_experts(F);
    }
    SEAM(2);
    PH_BEGIN(3);
    if (IN(3)) REP(3) {
#ifdef PROBE_TIME_MAIN
        const unsigned long long tm0_ = __builtin_amdgcn_s_memrealtime();
#endif
        if ((F.vcu & 1) == 0) { for (int g = F.vcu >> 1; g < 128; g += (F.G + 1) >> 1) gla_main_unit<4>(F, g >> 3, g & 7); }
#ifdef PROBE_TIME_MAIN
        probe_dt_ = __builtin_amdgcn_s_memrealtime() - tm0_;
#endif
        volatile LAS unsigned* qslot = (volatile LAS unsigned*)((LAS unsigned char*)lds + LDSCTL_OFF + 16);
#ifndef PROBE_STREAM
#define PROBE_STREAM 1
#endif
        for (int sr = 0; sr < PROBE_STREAM; ++sr) {
            if (sr > 0) xcd_barrier(bar);
            for (;;) {
                if (F.tid == 0) *qslot = __hip_atomic_fetch_add((unsigned*)(ctl + CW_QUEUE + 64 * (rep_ + 2 * sr)), 1u, __ATOMIC_RELAXED, __HIP_MEMORY_SCOPE_AGENT);
                __syncthreads();
                const unsigned u = *qslot;
                __syncthreads();
                if (u >= 512u) break;
                gla_sample_unit(F, (int)u);
            }
        }
    }
    SEAM(3);
    PH_BEGIN(4);
    if (IN(4)) REP(4) {
        bf16* MM = (bf16*)(F.ws + WS_MM);
        for (int g = gw; g < TP / 4; g += NGW) mixer_rows<4>(F, 4 * g);
        for (int n = gw; n < TS; n += NGW) mixer_rows<1>(F, TP + n);
        for (int m = TT + gw; m < MP; m += NGW) zero_row_bf16(MM + (size_t)m * DM, F.lane);
    }
    SEAM(4);
    PH_BEGIN(5);
    if (IN(5)) REP(5) {
        pg8::Gemm g{(const pg8::bf16_t*)(F.ws + WS_MM), (const pg8::bf16_t*)(F.ws + WS_WOUTT), TP, DM, DM}; pg8::StaticOrder S; S.init(TP, DM, F.G, (int)blockIdx.x, G23_WGM);
        pg8::EpiF32Res E{F.xp, (pg8::bf16_t*)(F.ws + WS_H2), (float*)(F.ws + WS_SSQ), DM};
        pg8::gemm_phase<pg8::EpiF32Res, pg8::StaticOrder, true, true>((PG8_LAS unsigned char*)lds + RING_OFF, g, S, E);
#ifdef GEMM2_TWICE
        pg8::gemm_phase<pg8::EpiF32Res, pg8::StaticOrder, true, true>((PG8_LAS unsigned char*)lds + RING_OFF, g, S, E);
#endif
        { EpiSkF32Res Es{F.xs, (bf16*)(F.ws + WS_H2) + (size_t)TP * DM, (float*)(F.ws + WS_SSQS)};
          for (int skr = 0; skr < SKREP; ++skr) for (int un = F.vcu; un < DM / 8; un += F.G) skinny_gemm16(F, (const bf16*)(F.ws + WS_MM) + (size_t)TP * DM, (const bf16*)(F.ws + WS_WOUTT), 16 * (un >> 1), un & 1, Es); }
    }
    SEAM(5);
    PH_BEGIN(6);
    if (IN(6)) REP(6) {
        float* rs_s = (float*)(lds + 131072);
        float* rss_s = rs_s + 512;
        float* RS2 = (float*)(F.ws + WS_RS2);
        pg8::Gemm g{(const pg8::bf16_t*)(F.ws + WS_H2), (const pg8::bf16_t*)(F.ws + WS_WQT), TP, DM, DM}; pg8::StaticOrder S; S.init(TP, DM, F.G, (int)blockIdx.x, G23_WGM);
        { pg8::Unit u0;
          if (S.next(0, u0) && F.tid < 256) { const int row = u0.pm * 256 + F.tid; const f32x4* p = (const f32x4*)((const float*)(F.ws + WS_SSQ) + (size_t)row * 32); f32x4 a4 = p[0];
#pragma unroll
              for (int i = 1; i < 8; ++i) a4 += p[i];
              const float rstd = 1.0f / sqrtf(((a4.x + a4.y) + (a4.z + a4.w)) * (1.0f / DM) + EPS); rs_s[F.tid] = rstd; if (u0.pn == 0) RS2[row] = rstd; }
          if (F.tid >= 256 && F.tid < 384) { const int row = F.tid - 256; const f32x4* p = (const f32x4*)((const float*)(F.ws + WS_SSQS) + (size_t)row * 128); f32x4 a4 = p[0];
#pragma unroll
              for (int i = 1; i < 32; ++i) a4 += p[i];
              const float rstd = 1.0f / sqrtf(((a4.x + a4.y) + (a4.z + a4.w)) * (1.0f / DM) + EPS); rss_s[row] = rstd; if (F.vcu == 0) RS2[TP + row] = rstd; }
          __syncthreads(); }
        pg8::EpiBf16RowScale E{(pg8::bf16_t*)(F.ws + WS_QP), DM, rs_s};
        pg8::gemm_phase<pg8::EpiBf16RowScale, pg8::StaticOrder, true, true>((PG8_LAS unsigned char*)lds + RING_OFF, g, S, E);
#ifdef GEMM3_TWICE
        pg8::gemm_phase<pg8::EpiBf16RowScale, pg8::StaticOrder, true, true>((PG8_LAS unsigned char*)lds + RING_OFF, g, S, E);
#endif
        { EpiSkBf16 Es{(bf16*)(F.ws + WS_QP) + (size_t)TP * DM, DM, rss_s};
          for (int skr = 0; skr < SKREP; ++skr) for (int un = F.vcu; un < DM / 8; un += F.G) skinny_gemm16(F, (const bf16*)(F.ws + WS_H2) + (size_t)TP * DM, (const bf16*)(F.ws + WS_WQT), 16 * (un >> 1), un & 1, Es); }
    }
    SEAM(6);
    PH_BEGIN(7);
    if (IN(7)) REP(7) { bf16x8 qa[2][4]; peer_qfrags(F, tok0, qa); peer_load_subkeys(F); for (int tb = tok0; tb < tok1; tb += 8) peer_topk_tile(F, tb, tok1, qa); __syncthreads(); }
    SEAM(7);
    PH_BEGIN(8);
    if (IN(8)) REP(8) { peer_phase(F, tok0, tok1); }
    if (PROBE_TIME_PHASE == 8) ptp_dt_ = __builtin_amdgcn_s_memrealtime() - ptp_t0_;
    if (PROBE_TIME_PHASE >= 0 && F.vcu == 0) { const unsigned long long te_ = __builtin_amdgcn_s_memrealtime(); while (__builtin_amdgcn_s_memrealtime() - te_ < 9ull * ptp_dt_) __builtin_amdgcn_s_sleep(8); }
#ifdef PROBE_TIME_MAIN
    if (F.vcu == 0) { const unsigned long long te_ = __builtin_amdgcn_s_memrealtime(); while (__builtin_amdgcn_s_memrealtime() - te_ < 9ull * probe_dt_) __builtin_amdgcn_s_sleep(8); }
#endif
#undef IN
#undef SEAM
}

extern "C" void kernel_launch(void* const* d_in, const int* in_sizes, int n_in, void* d_out, int out_size, void* d_ws, size_t ws_size, hipStream_t stream) {
    static int grid = 0;
    if (grid == 0) {
        if (n_in != 18 || ws_size < WS_END) { fprintf(stderr, "kernel_launch: expected 18 inputs and >= %zu bytes of workspace; got %d, %zu\n", (size_t)WS_END, n_in, ws_size); grid = -1; return; }
        int dev = 0, cus = 0;
        if (hipGetDevice(&dev) != hipSuccess || hipDeviceGetAttribute(&cus, hipDeviceAttributeMultiprocessorCount, dev) != hipSuccess) { grid = -1; return; }
        if (hipFuncSetAttribute((const void*)mk_fwd, hipFuncAttributeMaxDynamicSharedMemorySize, LDS_BYTES) != hipSuccess) { fprintf(stderr, "kernel_launch: hipFuncSetAttribute failed\n"); grid = -1; return; }
        (void)hipGetLastError();
        grid = cus;
    }
    if (grid < 0) return;
    (void)hipMemsetAsync((char*)d_ws + WS_CTL, 0, CTL_ZERO_BYTES, stream);
    Args a{};
    for (int i = 0; i < 18; ++i) a.in[i] = (const float*)d_in[i];
    a.out = (float*)d_out; a.ws = (unsigned char*)d_ws;
    if (N_LAUNCHES == 1) { a.ph_lo = 0; a.ph_hi = N_PHASES; hipLaunchKernelGGL(mk_fwd, dim3(grid), dim3(NWAVES * 64), LDS_BYTES, stream, a); }
    else { for (int li = 0; li < N_PHASES; ++li) { a.ph_lo = li; a.ph_hi = li + 1; hipLaunchKernelGGL(mk_fwd, dim3(grid), dim3(NWAVES * 64), LDS_BYTES, stream, a); } }
}
```

```cpp
#include <hip/hip_runtime.h>
#include <cstdio>
#include <cstdint>
#include <cmath>
#define MK_N_LAUNCHES 1
namespace pg8 {
#define PG8_LAS __attribute__((address_space(3)))
typedef unsigned short bf16_t;
typedef short bf16x8 __attribute__((ext_vector_type(8)));
typedef float f32x4 __attribute__((ext_vector_type(4)));
typedef unsigned u32x4 __attribute__((ext_vector_type(4)));
constexpr int BM = 256, BK = 64, HALF = 128, HTB = HALF * BK * 2  , STAGE_BYTES = 8 * HTB, NXCD = 8;
#ifndef PG8_WGM
#define PG8_WGM 3
#endif
constexpr int WGM = PG8_WGM;

__host__ __device__ __forceinline__ int lds_byte(int r, int c) { const int st = (r >> 4) * 2 + (c >> 5), rr = r & 15, cc = c & 31, ob = rr * 64 + cc * 2; return st * 1024 + (ob ^ (((ob >> 9) & 1) << 5)); }
__host__ __device__ __forceinline__ void stage_rc(int b, int& R, int& C) { const int st = b / 1024, sb = b % 1024, swz = sb ^ (((sb >> 9) & 1) << 5); R = (st >> 1) * 16 + swz / 64; C = (st & 1) * 32 + (swz % 64) / 2; }
__host__ __device__ __forceinline__ int perm32(int rho) { const int n = rho >> 4, i = rho & 15; return 8 * (i >> 2) + 4 * n + (i & 3); }

struct Unit { int pm, pn; };
struct Gemm { const bf16_t* A; const bf16_t* Bt; int M, N, K; };

struct StaticOrder {
    int nM, nN, nwg, G, c, wgm;
    __host__ __device__ void init(int M, int N, int G_, int c_, int wgm_ = WGM) { nM = M / BM; nN = N / BM; nwg = nM * nN; G = G_; c = c_; wgm = wgm_; }
    __host__ __device__ bool next(int i, Unit& u) const {
        const long L = (long)i * G + c; if (L >= nwg) return false;
        int wgid = (int)L; if (wgm > 0) { const int q = nwg / NXCD, r = nwg % NXCD, xcd = wgid % NXCD, off = wgid / NXCD; wgid = (xcd < r ? xcd * (q + 1) : r * (q + 1) + (xcd - r) * q) + off; }
        const int wgm = this->wgm > 0 ? this->wgm : -this->wgm;
        const int nig = wgm * nN, gid = wgid / nig, fm = gid * wgm, gsz = (nM - fm) < wgm ? (nM - fm) : wgm;
        u.pm = fm + ((wgid % nig) % gsz); u.pn = (wgid % nig) / gsz; return true;
    }
    __device__ __forceinline__ void a_ready(const Unit&) const {}
    __device__ __forceinline__ void done(const Unit&) const {}
};

__device__ __forceinline__ unsigned cvt_pk_bf16(float lo, float hi) { unsigned r; asm volatile("v_cvt_pk_bf16_f32 %0, %1, %2" : "=v"(r) : "v"(lo), "v"(hi)); return r; }
typedef float f32x2 __attribute__((ext_vector_type(2)));
__device__ __forceinline__ f32x2 gelu_pk(f32x2 v) {
    const f32x2 av = __builtin_elementwise_abs(v), d = av * 0.2316418882f + 1.0f;
    f32x2 t; t.x = __builtin_amdgcn_rcpf(d.x); t.y = __builtin_amdgcn_rcpf(d.y);
    f32x2 q = t * 0.5307027145f + (-0.7265760135f); q = q * t + 0.7107068705f; q = q * t + (-0.142248368f); q = q * t + 0.127414796f; q = q * t;
    const f32x2 s = (v * v) * (-0.72134752044f);
    f32x2 e; e.x = __builtin_amdgcn_exp2f(s.x); e.y = __builtin_amdgcn_exp2f(s.y);
    const f32x2 m = v * (q * e), r = v - m;
    f32x2 o; o.x = v.x < 0.f ? m.x : r.x; o.y = v.y < 0.f ? m.y : r.y; return o;
}

template <int ACT  > struct EpiBf16 {
    static constexpr bool PERM = true, AFTER_DRAIN = false; static_assert(ACT == 0 || ACT == 1, "EpiBf16: ACT is 0 (none) or 1 (gelu_pk)");
    bf16_t* O; int ldc; const float* bias; int split_cols; size_t split_stride; float scale0;
    __device__ __forceinline__ void operator()(const f32x4 (&acc)[2][2][4][2], const Unit& u, int wr, int wc, int fr, int fq) const {
        const int row0 = u.pm * BM + wr * 64 + fr; int colt = u.pn * BM; bf16_t* base = O;
        float sc = 1.f; if (split_cols) { const int t = colt / split_cols; base += (size_t)t * split_stride; colt -= t * split_cols; if (t == 0) sc = scale0; }
        const int col0 = colt + wc * 32 + 8 * fq, bcol0 = u.pn * BM + wc * 32 + 8 * fq;
        f32x4 bv[2][2];
#pragma unroll
        for (int bj = 0; bj < 2; ++bj)
#pragma unroll
            for (int n = 0; n < 2; ++n) bv[bj][n] = bias ? *(const f32x4*)(bias + bcol0 + bj * HALF + 4 * n) : (f32x4){0.f, 0.f, 0.f, 0.f};
#pragma unroll
        for (int ai = 0; ai < 2; ++ai)
#pragma unroll
            for (int m = 0; m < 4; ++m) { bf16_t* rowp = base + (size_t)(row0 + ai * HALF + m * 16) * ldc + col0;
#pragma unroll
                for (int bj = 0; bj < 2; ++bj) { f32x4 v0 = acc[ai][bj][m][0] + bv[bj][0], v1 = acc[ai][bj][m][1] + bv[bj][1];
                    if (ACT == 1) { f32x2 a = gelu_pk((f32x2){v0[0], v0[1]}), b = gelu_pk((f32x2){v0[2], v0[3]}), c = gelu_pk((f32x2){v1[0], v1[1]}), d = gelu_pk((f32x2){v1[2], v1[3]});
                        v0 = (f32x4){a.x, a.y, b.x, b.y}; v1 = (f32x4){c.x, c.y, d.x, d.y}; }
                    v0 = v0 * sc; v1 = v1 * sc; u32x4 w; w.x = cvt_pk_bf16(v0[0], v0[1]); w.y = cvt_pk_bf16(v0[2], v0[3]); w.z = cvt_pk_bf16(v1[0], v1[1]); w.w = cvt_pk_bf16(v1[2], v1[3]);
                    __builtin_nontemporal_store(w, (u32x4*)(rowp + bj * HALF)); } }
    }
};
template <class Epi, class Sched, bool ALIGN_EPI = false, bool SP2 = false>
__device__ __forceinline__ void gemm_phase(PG8_LAS unsigned char* lds, const Gemm g, const Sched& S, const Epi& E) {
    const int tid = threadIdx.x, wid = __builtin_amdgcn_readfirstlane(tid >> 6), lane = tid & 63, wr = wid >> 2, wc = wid & 3, fr = lane & 15, fq = lane >> 4;
    const int K = g.K, nt = K / BK;
    unsigned voffA[2], voffB[2];
#pragma unroll
    for (int i = 0; i < 2; ++i) { int R, C; stage_rc(tid * 16 + i * 8192, R, C); const int Rb = Epi::PERM ? ((R & ~31) + perm32(R & 31)) : R;
        voffA[i] = (unsigned)(R * K + C) * 2u; voffB[i] = (unsigned)(Rb * K + C) * 2u; }
    const size_t kstep = (size_t)(BK * 2);
    const size_t hstep = (size_t)HALF * K * 2;
    const size_t tstep = 2 * hstep;
    const unsigned ldsw = (unsigned)wid * 1024u;
    const int aoff = lds_byte(wr * 64 + fr, fq * 8), boff = lds_byte(wc * 32 + fr, fq * 8);
#define PG8_SA(b, h) (((b) * 2 + (h)) * HTB)
#define PG8_SB(b, h) ((4 + (b) * 2 + (h)) * HTB)
#define PG8_STAGE(bufoff, gbase, voff) do { _Pragma("unroll") for (int _i = 0; _i < 2; ++_i) \
        __builtin_amdgcn_global_load_lds((const unsigned*)((const char*)(gbase) + (voff)[_i]), (PG8_LAS unsigned*)(lds + (bufoff) + ldsw + _i * 8192), 16, 0, 0); } while (0)
#define PG8_LDA(dst, b, h) do { _Pragma("unroll") for (int m = 0; m < 4; ++m) _Pragma("unroll") for (int k = 0; k < 2; ++k) dst[m][k] = *(const PG8_LAS bf16x8*)(lds + PG8_SA(b, h) + aoff + m * 2048 + k * 1024); } while (0)
#define PG8_LDB(dst, b, h) do { _Pragma("unroll") for (int n = 0; n < 2; ++n) _Pragma("unroll") for (int k = 0; k < 2; ++k) dst[n][k] = *(const PG8_LAS bf16x8*)(lds + PG8_SB(b, h) + boff + n * 2048 + k * 1024); } while (0)
#define PG8_MMA(ai, bj, At, Bt) do { __builtin_amdgcn_s_setprio(1); _Pragma("unroll") for (int m = 0; m < 4; ++m) _Pragma("unroll") for (int n = 0; n < 2; ++n) _Pragma("unroll") for (int k = 0; k < 2; ++k) \
        acc[ai][bj][m][n] = __builtin_amdgcn_mfma_f32_16x16x32_bf16(Bt[n][k], At[m][k], acc[ai][bj][m][n], 0, 0, 0); __builtin_amdgcn_s_setprio(0); } while (0)
#define PG8_WAIT_V(n) asm volatile("s_waitcnt vmcnt(" #n ")" ::: "memory")
#define PG8_WAIT_L(n) asm volatile("s_waitcnt lgkmcnt(" #n ")" ::: "memory")
#define PG8_BAR __builtin_amdgcn_s_barrier()
#define PG8_SCHED __builtin_amdgcn_sched_barrier(0)
    Unit cur, nxt; int ui = 0;
    if (!S.next(0, cur)) return;
    f32x4 acc[2][2][4][2];
#pragma unroll
    for (int a = 0; a < 2; ++a)
#pragma unroll
        for (int b = 0; b < 2; ++b)
#pragma unroll
            for (int m = 0; m < 4; ++m)
#pragma unroll
                for (int n = 0; n < 2; ++n) acc[a][b][m][n] = (f32x4){0.f, 0.f, 0.f, 0.f};
    bf16x8 At[4][2], B0[2][2], B1[2][2];
    const char* cA = (const char*)g.A + (size_t)cur.pm * tstep; const char* cB = (const char*)g.Bt + (size_t)cur.pn * tstep;
    S.a_ready(cur);
    if constexpr (SP2) {
        PG8_STAGE(PG8_SB(0, 0), cB, voffB); PG8_STAGE(PG8_SB(0, 1), cB + hstep, voffB); PG8_STAGE(PG8_SA(0, 0), cA, voffA); PG8_STAGE(PG8_SA(0, 1), cA + hstep, voffA);
        if (wr == 1) PG8_BAR;
        PG8_WAIT_V(2); PG8_BAR;
        PG8_STAGE(PG8_SB(1, 0), cB + kstep, voffB); PG8_STAGE(PG8_SA(1, 0), cA + kstep, voffA); PG8_STAGE(PG8_SB(1, 1), cB + hstep + kstep, voffB);
        PG8_WAIT_V(6); PG8_BAR;
    } else {
        PG8_STAGE(PG8_SB(0, 0), cB, voffB); PG8_STAGE(PG8_SA(0, 0), cA, voffA); PG8_STAGE(PG8_SB(0, 1), cB + hstep, voffB); PG8_STAGE(PG8_SA(0, 1), cA + hstep, voffA);
        if (wr == 1) PG8_BAR;
        PG8_WAIT_V(4); PG8_BAR;
        PG8_STAGE(PG8_SB(1, 0), cB + kstep, voffB); PG8_STAGE(PG8_SA(1, 0), cA + kstep, voffA); PG8_STAGE(PG8_SB(1, 1), cB + hstep + kstep, voffB);
        PG8_WAIT_V(6); PG8_BAR;
    }
    for (;;) {
        const bool has_next = S.next(ui + 1, nxt);
        const char* nA = has_next ? (const char*)g.A + (size_t)nxt.pm * tstep : cA; const char* nB = has_next ? (const char*)g.Bt + (size_t)nxt.pn * tstep : cB;
        for (int t = 0; t < nt; t += 2) {
            const bool last = (t == nt - 2);
            const char* a1 = cA + (size_t)(t + 1) * kstep;
            const char* a2 = last ? nA : cA + (size_t)(t + 2) * kstep; const char* b2 = last ? nB : cB + (size_t)(t + 2) * kstep;
            const char* a3 = a2 + kstep; const char* b3 = b2 + kstep;
            if (last && has_next) S.a_ready(nxt);
            if constexpr (SP2) {
            PG8_LDB(B0, 0, 0); PG8_LDB(B1, 0, 1); PG8_SCHED; PG8_LDA(At, 0, 0); PG8_STAGE(PG8_SA(1, 1), a1 + hstep, voffA);
            PG8_WAIT_V(8); PG8_WAIT_L(0); PG8_BAR; PG8_MMA(0, 0, At, B0); PG8_MMA(0, 1, At, B1); PG8_BAR; PG8_SCHED;
            PG8_LDA(At, 0, 1); PG8_STAGE(PG8_SB(0, 0), b2, voffB); PG8_STAGE(PG8_SB(0, 1), b2 + hstep, voffB); PG8_STAGE(PG8_SA(0, 0), a2, voffA);
            PG8_WAIT_V(8); PG8_WAIT_L(0); PG8_BAR; PG8_MMA(1, 0, At, B0); PG8_MMA(1, 1, At, B1); PG8_BAR; PG8_SCHED;
            PG8_LDB(B0, 1, 0); PG8_LDB(B1, 1, 1); PG8_SCHED; PG8_LDA(At, 1, 0); PG8_STAGE(PG8_SA(0, 1), a2 + hstep, voffA);
            PG8_WAIT_V(8); PG8_WAIT_L(0); PG8_BAR; PG8_MMA(0, 0, At, B0); PG8_MMA(0, 1, At, B1); PG8_BAR; PG8_SCHED;
            PG8_LDA(At, 1, 1); PG8_STAGE(PG8_SB(1, 0), b3, voffB); PG8_STAGE(PG8_SB(1, 1), b3 + hstep, voffB); PG8_STAGE(PG8_SA(1, 0), a3, voffA);
            PG8_WAIT_V(8); PG8_WAIT_L(0); PG8_BAR; PG8_MMA(1, 0, At, B0); PG8_MMA(1, 1, At, B1); PG8_BAR; PG8_SCHED;
            } else {
            PG8_LDB(B0, 0, 0); PG8_SCHED; PG8_LDA(At, 0, 0); PG8_STAGE(PG8_SA(1, 1), a1 + hstep, voffA);
            PG8_WAIT_L(8); PG8_BAR; PG8_WAIT_L(0); PG8_MMA(0, 0, At, B0); PG8_BAR; PG8_SCHED;
            PG8_LDB(B1, 0, 1); PG8_STAGE(PG8_SB(0, 0), b2, voffB);
            PG8_BAR; PG8_WAIT_L(0); PG8_MMA(0, 1, At, B1); PG8_BAR;
            PG8_LDA(At, 0, 1); PG8_STAGE(PG8_SA(0, 0), a2, voffA);
            PG8_BAR; PG8_WAIT_L(0); PG8_MMA(1, 0, At, B0); PG8_BAR; PG8_SCHED;
            PG8_STAGE(PG8_SB(0, 1), b2 + hstep, voffB);
            PG8_WAIT_V(6); PG8_BAR; PG8_MMA(1, 1, At, B1); PG8_BAR;
            PG8_LDB(B0, 1, 0); PG8_SCHED; PG8_LDA(At, 1, 0); PG8_STAGE(PG8_SA(0, 1), a2 + hstep, voffA);
            PG8_WAIT_L(8); PG8_BAR; PG8_WAIT_L(0); PG8_MMA(0, 0, At, B0); PG8_BAR; PG8_SCHED;
            PG8_LDB(B1, 1, 1); PG8_STAGE(PG8_SB(1, 0), b3, voffB);
            PG8_BAR; PG8_WAIT_L(0); PG8_MMA(0, 1, At, B1); PG8_BAR;
            PG8_LDA(At, 1, 1); PG8_STAGE(PG8_SA(1, 0), a3, voffA);
            PG8_BAR; PG8_WAIT_L(0); PG8_MMA(1, 0, At, B0); PG8_BAR; PG8_SCHED;
            PG8_STAGE(PG8_SB(1, 1), b3 + hstep, voffB);
            PG8_WAIT_V(6); PG8_BAR; PG8_MMA(1, 1, At, B1); PG8_BAR;
            }
        }
        if constexpr (ALIGN_EPI) { if (wr == 0) PG8_BAR; }
        if constexpr (!Epi::AFTER_DRAIN) { E(acc, cur, wr, wc, fr, fq); S.done(cur); }
        if (!has_next) break;
#pragma unroll
        for (int a = 0; a < 2; ++a)
#pragma unroll
            for (int b = 0; b < 2; ++b)
#pragma unroll
                for (int m = 0; m < 4; ++m)
#pragma unroll
                    for (int n = 0; n < 2; ++n) acc[a][b][m][n] = (f32x4){0.f, 0.f, 0.f, 0.f};
        cur = nxt; cA = nA; cB = nB; ++ui;
        if constexpr (ALIGN_EPI) { if (wr == 1) PG8_BAR; }
    }
    PG8_WAIT_V(0);
    if constexpr (!ALIGN_EPI) { if (wr == 0) PG8_BAR; }
    PG8_BAR;
    if constexpr (Epi::AFTER_DRAIN) { E.fused(acc, cur, wr, wc, fr, fq, lds, wid, lane); S.done(cur); }
#undef PG8_SA
#undef PG8_SB
#undef PG8_STAGE
#undef PG8_LDA
#undef PG8_LDB
#undef PG8_MMA
#undef PG8_WAIT_V
#undef PG8_WAIT_L
#undef PG8_BAR
#undef PG8_SCHED
}
}
namespace pg8 {
struct EpiF32Res {
    static constexpr bool PERM = false, AFTER_DRAIN = false;
    const float* xp; bf16_t* outb; float* ssq; int ldc;
    __device__ __forceinline__ void operator()(const f32x4 (&acc)[2][2][4][2], const Unit& u, int wr, int wc, int fr, int fq) const {
        const int col0 = u.pn * BM + wc * 32 + 4 * fq;
#pragma unroll
        for (int ai = 0; ai < 2; ++ai)
#pragma unroll
            for (int m = 0; m < 4; ++m) {
                const int row = u.pm * BM + ai * HALF + wr * 64 + m * 16 + fr;
                const float* src = xp + (size_t)row * ldc; bf16_t* dstb = outb + (size_t)row * ldc;
                float s = 0.f;
#pragma unroll
                for (int bj = 0; bj < 2; ++bj)
#pragma unroll
                    for (int n = 0; n < 2; ++n) { const int c = col0 + bj * HALF + n * 16; const f32x4 v = *(const f32x4*)(src + c) + acc[ai][bj][m][n];
                        s += (v[0] * v[0] + v[1] * v[1]) + (v[2] * v[2] + v[3] * v[3]);
                        typedef unsigned u32x2 __attribute__((ext_vector_type(2))); *(u32x2*)(dstb + c) = (u32x2){cvt_pk_bf16(v[0], v[1]), cvt_pk_bf16(v[2], v[3])}; }
                s += __shfl_xor(s, 16); s += __shfl_xor(s, 32);
                if (fq == 0) ssq[(size_t)row * 32 + u.pn * 4 + wc] = s;
            }
    }
};
struct EpiBf16RowScale {
    static constexpr bool PERM = true, AFTER_DRAIN = false;
    bf16_t* O; int ldc; const float* rs;
    __device__ __forceinline__ void operator()(const f32x4 (&acc)[2][2][4][2], const Unit& u, int wr, int wc, int fr, int fq) const {
        const int row0 = u.pm * BM + wr * 64 + fr, col0 = u.pn * BM + wc * 32 + 8 * fq;
#pragma unroll
        for (int ai = 0; ai < 2; ++ai)
#pragma unroll
            for (int m = 0; m < 4; ++m) { const int rl = wr * 64 + fr + ai * HALF + m * 16; const float sc = rs[rl]; bf16_t* rowp = O + (size_t)(row0 + ai * HALF + m * 16) * ldc + col0;
#pragma unroll
                for (int bj = 0; bj < 2; ++bj) { const f32x4 v0 = acc[ai][bj][m][0] * sc, v1 = acc[ai][bj][m][1] * sc;
                    u32x4 w; w.x = cvt_pk_bf16(v0[0], v0[1]); w.y = cvt_pk_bf16(v0[2], v0[3]); w.z = cvt_pk_bf16(v1[0], v1[1]); w.w = cvt_pk_bf16(v1[2], v1[3]);
                    *(u32x4*)(rowp + bj * HALF) = w; } }
    }
};
}

#ifndef MK_N_LAUNCHES
#define MK_N_LAUNCHES 1
#endif
constexpr int N_PHASES = 9;
constexpr int N_LAUNCHES = MK_N_LAUNCHES;
constexpr int NWAVES = 8;

constexpr int DM = 2048;
constexpr int TP = 8192, TS = 128, TT = TP + TS;
constexpr int MP = 8448;
constexpr int NP = 16384;
constexpr int PLD = NP + 64;
constexpr int C_Q = 0, C_K = 1024, C_V = 2048, C_R = 4096, C_CB = 6144, C_CC = 8192, C_CX = 10240, C_GA = 12288, C_GB = 14336;
constexpr int DIN = 16400;
constexpr int NEXP = 16384;
constexpr float EPS = 1e-6f;

constexpr size_t MiB = 1u << 20;
constexpr size_t WS_CTL = 0, CTL_ZERO_BYTES = 128 * 1024;
constexpr size_t WS_WINT = 2 * MiB;
constexpr size_t WS_WOUTT = 68 * MiB;
constexpr size_t WS_WQT = 76 * MiB;
constexpr size_t WS_EU = 84 * MiB;
constexpr size_t WS_EV = 148 * MiB;
constexpr size_t WS_XN = 212 * MiB;
constexpr size_t WS_P = 246 * MiB;
constexpr size_t WS_QT = 516 * MiB;
constexpr size_t WS_KT = 532 * MiB;
constexpr size_t WS_VT = 548 * MiB;
constexpr size_t WS_ATT = 580 * MiB;
constexpr size_t WS_EBL = 584 * MiB;
constexpr size_t WS_SKB = 585 * MiB;
constexpr size_t WS_O = 586 * MiB;
constexpr size_t WS_MM = 620 * MiB;
constexpr size_t WS_X2 = 654 * MiB;
constexpr size_t WS_H2 = 720 * MiB;
constexpr size_t WS_SSQ = 799 * MiB;
constexpr size_t WS_QP = 754 * MiB;
constexpr size_t WS_IDX = 788 * MiB;
constexpr size_t WS_GW = 793 * MiB;
constexpr size_t WS_ALR = 798 * MiB;
constexpr size_t WS_SSQS = 799 * MiB + 1100 * 1024;
constexpr size_t WS_RS2 = 799 * MiB + 1200 * 1024;
constexpr size_t WS_END = 801 * MiB;
constexpr int CW_TMO = 0, CW_CODE = 1, CW_BAR = 4096, CW_QUEUE = 16384;

constexpr size_t OUT_Y = 0;
constexpr size_t OUT_GLAP = (size_t)TT * DM;
constexpr size_t OUT_CONVP = OUT_GLAP + (size_t)4 * 4 * 256 * 512;
constexpr size_t OUT_GLAS = OUT_CONVP + (size_t)4 * 2 * 2048;
constexpr size_t OUT_CONVS = OUT_GLAS + (size_t)128 * 4 * 256 * 512;

constexpr int LDS_BYTES = 163840;
constexpr int LDSCTL_OFF = 162816, MISC_OFF = LDSCTL_OFF + 320;
constexpr int RING_OFF = 0;

#define GAS __attribute__((address_space(1)))
#define LAS __attribute__((address_space(3)))
typedef unsigned short bf16;
typedef unsigned v4u __attribute__((ext_vector_type(4)));
typedef unsigned v2u __attribute__((ext_vector_type(2)));
typedef float f32x4 __attribute__((ext_vector_type(4)));
typedef short bf16x8 __attribute__((ext_vector_type(8)));
typedef GAS unsigned gu32;
typedef float v32f __attribute__((ext_vector_type(32)));
typedef float v16f __attribute__((ext_vector_type(16)));
typedef float f32x2 __attribute__((ext_vector_type(2)));
typedef unsigned v6u __attribute__((ext_vector_type(6)));
constexpr int ROW6 = 1536, ROW4 = 1024;
#define RLX_AGENT __ATOMIC_RELAXED, __HIP_MEMORY_SCOPE_AGENT
#define LDS_WAIT() asm volatile("s_waitcnt lgkmcnt(0)" ::: "memory")
#define VM_WAIT() asm volatile("s_waitcnt vmcnt(0)" ::: "memory")
#define MFMA16(a, b, c) __builtin_amdgcn_mfma_f32_16x16x32_bf16((a), (b), (c), 0, 0, 0)
__device__ __forceinline__ unsigned f2bf(float f) { unsigned u = __builtin_bit_cast(unsigned, f); return (u + 0x7fffu + ((u >> 16) & 1u)) >> 16; }
__device__ __forceinline__ unsigned pk2(float lo, float hi) { return f2bf(lo) | (f2bf(hi) << 16); }
__device__ __forceinline__ float bf2f(unsigned b) { return __builtin_bit_cast(float, b << 16); }
__device__ __forceinline__ float bflo(unsigned w) { return __builtin_bit_cast(float, w << 16); }
__device__ __forceinline__ float bfhi(unsigned w) { return __builtin_bit_cast(float, w & 0xffff0000u); }
__device__ __forceinline__ void unpack8(const v4u w, float (&f)[8]) { f[0] = bflo(w.x); f[1] = bfhi(w.x); f[2] = bflo(w.y); f[3] = bfhi(w.y); f[4] = bflo(w.z); f[5] = bfhi(w.z); f[6] = bflo(w.w); f[7] = bfhi(w.w); }
__device__ __forceinline__ v4u pack8(const float (&f)[8]) { v4u w; w.x = pk2(f[0], f[1]); w.y = pk2(f[2], f[3]); w.z = pk2(f[4], f[5]); w.w = pk2(f[6], f[7]); return w; }
__device__ __forceinline__ float wave_sum(float v) {
#pragma unroll
    for (int o = 1; o < 64; o <<= 1) v += __shfl_xor(v, o);
    return v;
}
__device__ __forceinline__ float sigmoidf_(float x) { return 1.0f / (1.0f + __expf(-x)); }
__device__ __forceinline__ float wave_sum_dpp(float v) {
#define DPP_ADD_(ctrl, rmask) v += __builtin_bit_cast(float, __builtin_amdgcn_update_dpp(0, __builtin_bit_cast(int, v), ctrl, rmask, 0xF, false))
    DPP_ADD_(0xB1, 0xF);
    DPP_ADD_(0x4E, 0xF);
    DPP_ADD_(0x141, 0xF);
    DPP_ADD_(0x140, 0xF);
    DPP_ADD_(0x142, 0xA);
    DPP_ADD_(0x143, 0xC);
#undef DPP_ADD_
    return __builtin_bit_cast(float, __builtin_amdgcn_readlane(__builtin_bit_cast(int, v), 63));
}
__device__ __forceinline__ float gelu_erf(float v) {
    const float t = __builtin_amdgcn_rcpf(fabsf(v) * 0.2316418882f + 1.0f);
    float q = t * 0.5307027145f + (-0.7265760135f); q = q * t + 0.7107068705f; q = q * t + (-0.142248368f); q = q * t + 0.127414796f; q = q * t;
    const float e = __builtin_amdgcn_exp2f((v * v) * (-0.72134752044f));
    const float m = v * (q * e);
    return v < 0.f ? m : v - m;
}
#define XB_TMO      128
#define XB_XCNT(j)  (256  + 64 * (j))
#define XB_XSUB(j)  (1280 + 64 * (j))
#define XB_XGEN(j)  (2304 + 64 * (j))
#define XB_TOP      3328
#define XB_TOPGEN   3392
#define XCD_BAR_WORDS 3456
#define XB_SPIN_CAP (1u << 18)

__device__ __forceinline__ unsigned xb_ld(unsigned* p)              { return __hip_atomic_load(p, __ATOMIC_RELAXED, __HIP_MEMORY_SCOPE_AGENT); }
__device__ __forceinline__ unsigned xb_add(unsigned* p, unsigned v) { return __hip_atomic_fetch_add(p, v, __ATOMIC_RELAXED, __HIP_MEMORY_SCOPE_AGENT); }
__device__ __forceinline__ unsigned xb_xcc_id() { return (unsigned)__builtin_amdgcn_s_getreg((3 << 11) | 20) & 0xFu; }
#define XB_SPIN(cond, bar) do { unsigned _sp = 0; while (cond) { __builtin_amdgcn_s_sleep(1); \
    if ((++_sp & 255u) == 0u) { if (xb_ld(&(bar)[XB_TMO])) break; if (_sp > XB_SPIN_CAP) { atomicAdd(&(bar)[XB_TMO], 1u); break; } } } } while (0)

struct XcdBarrier {
    unsigned* bar; unsigned x;
    volatile LAS unsigned* st;
};

__device__ __forceinline__ XcdBarrier xcd_barrier_post(unsigned* bar, volatile LAS unsigned* st) {
    XcdBarrier b; b.bar = bar; b.x = xb_xcc_id(); b.st = st;
    if (threadIdx.x == 0) (void)xb_add(&bar[XB_XCNT(b.x)], 1u);
    return b;
}
__device__ __forceinline__ void xcd_barrier_complete(unsigned* bar, unsigned x, unsigned& nloc, unsigned& nx) {
    const unsigned G = gridDim.x * gridDim.y * gridDim.z;
    unsigned sum, cnt, mine, sp = 0u;
    for (;;) {
        sum = 0u; cnt = 0u; mine = 0u;
#pragma unroll
        for (unsigned j = 0; j < 16; ++j) { const unsigned c = xb_ld(&bar[XB_XCNT(j)]); sum += c; cnt += (c > 0u) ? 1u : 0u; mine = (j == x) ? c : mine; }
        if (sum == G) break;
        __builtin_amdgcn_s_sleep(1);
        if ((++sp & 255u) == 0u) { if (xb_ld(&bar[XB_TMO])) break; if (sp > XB_SPIN_CAP) { atomicAdd(&bar[XB_TMO], 1u); break; } }
    }
    nloc = mine > 0u ? mine : 1u; nx = cnt > 0u ? cnt : 1u;
}

__device__ __forceinline__ void xcd_barrier(const XcdBarrier& b) {
    asm volatile("s_waitcnt vmcnt(0)" ::: "memory");
    __syncthreads();
    if (threadIdx.x == 0) {
        unsigned* bar = b.bar;
        __builtin_amdgcn_s_waitcnt(0);
        unsigned nloc = b.st[0], nx = b.st[1];
        if (nloc == 0u) { xcd_barrier_complete(bar, b.x, nloc, nx); b.st[0] = nloc; b.st[1] = nx; }
        const unsigned old = xb_add(&bar[XB_XSUB(b.x)], 1u);
        const unsigned gen = old / nloc;
        if (old + 1u == (gen + 1u) * nloc) {
            __builtin_amdgcn_fence(__ATOMIC_RELEASE, "agent");
            asm volatile("s_waitcnt vmcnt(0)" ::: "memory");
            const unsigned og = xb_add(&bar[XB_TOP], 1u);
            const unsigned tg = og / nx;
            if (og + 1u == (tg + 1u) * nx) xb_add(&bar[XB_TOPGEN], 1u);
            else XB_SPIN(xb_ld(&bar[XB_TOPGEN]) == tg, bar);
            __builtin_amdgcn_fence(__ATOMIC_ACQUIRE, "agent");
            xb_add(&bar[XB_XGEN(b.x)], 1u);
            asm volatile("s_waitcnt vmcnt(0)" ::: "memory");
        } else {
            XB_SPIN(xb_ld(&bar[XB_XGEN(b.x)]) == gen, bar);
            __builtin_amdgcn_fence(__ATOMIC_ACQUIRE, "agent");
            asm volatile("s_waitcnt vmcnt(0)" ::: "memory");
        }
    }
    __syncthreads();
}
struct Frame {
    unsigned char* lds;
    int tid, lane, wave, vcu, G;
    const float *xp, *xs, *sgla, *sconv, *n1g, *win, *wau, *bal, *gng, *cw, *cb, *wout, *n2g, *wq, *sk, *eu, *ev, *nfg;
    float* out;
    unsigned char* ws;
};

__device__ __forceinline__ void p0_transpose_item(const float* W, int ldw, int src_col0, int k0, bf16* WT, int K, int dst_row0, float* scr, int lane, const float* kscale = nullptr) {
    const int n4 = lane & 15, kr = lane >> 4;
#pragma unroll 8
    for (int i = 0; i < 16; ++i) { const int kk = 4 * i + kr; f32x4 v = __builtin_nontemporal_load((const f32x4*)(W + (size_t)(k0 + kk) * ldw + src_col0 + 4 * n4)); if (kscale) v = v * kscale[k0 + kk];
        float* d = scr + kk * 65 + 4 * n4; d[0] = v.x; d[1] = v.y; d[2] = v.z; d[3] = v.w; }
    LDS_WAIT(); asm volatile("" ::: "memory");
    const int c = lane & 7, nr = lane >> 3;
#pragma unroll
    for (int j = 0; j < 8; ++j) { const int n = nr + 8 * j; const float* s = scr + (8 * c) * 65 + n;
        v4u o; o.x = pk2(s[0 * 65], s[1 * 65]); o.y = pk2(s[2 * 65], s[3 * 65]); o.z = pk2(s[4 * 65], s[5 * 65]); o.w = pk2(s[6 * 65], s[7 * 65]);
        *(v4u*)(WT + (size_t)(dst_row0 + n) * K + k0 + 8 * c) = o; }
    LDS_WAIT(); asm volatile("" ::: "memory");
}
__device__ __forceinline__ void rms_row_to_bf16(const float* xrow, const float* g, bf16* orow, int lane) {
    const f32x4* xr = (const f32x4*)xrow + lane; const f32x4* gr = (const f32x4*)g + lane;
    f32x4 v[8]; float s = 0.f;
#pragma unroll
    for (int j = 0; j < 8; ++j) { v[j] = __builtin_nontemporal_load(xr + 64 * j); s += (v[j].x * v[j].x + v[j].y * v[j].y) + (v[j].z * v[j].z + v[j].w * v[j].w); }
    const float rstd = 1.0f / sqrtf(wave_sum(s) * (1.0f / DM) + EPS);
    v2u* o8 = (v2u*)orow + lane;
#pragma unroll
    for (int j = 0; j < 8; ++j) { const f32x4 gg = gr[64 * j]; v2u w; w.x = pk2(v[j].x * rstd * gg.x, v[j].y * rstd * gg.y); w.y = pk2(v[j].z * rstd * gg.z, v[j].w * rstd * gg.w); o8[64 * j] = w; }
}
__device__ __forceinline__ void zero_row_bf16(bf16* orow, int lane) {
    v2u* o8 = (v2u*)orow + lane; const v2u z = {0u, 0u};
#pragma unroll
    for (int j = 0; j < 8; ++j) o8[64 * j] = z;
}
__device__ __forceinline__ void p0_prologue(Frame& F) {
    bf16* WINT = (bf16*)(F.ws + WS_WINT); bf16* WOUTT = (bf16*)(F.ws + WS_WOUTT); bf16* WQT = (bf16*)(F.ws + WS_WQT);
    float* scr = (float*)(F.lds + F.wave * 16640);
    const int gw = F.vcu * NWAVES + F.wave, NGW = F.G * NWAVES;
    constexpr int I_IN = 32 * 256, I_SQ = 32 * 32;
    for (int it = gw; it < I_IN + 2 * I_SQ; it += NGW) {
        int r = it;
        if (r < I_IN) { const int kb = r >> 8, nb = r & 255, n0 = 64 * nb; p0_transpose_item(F.win, DIN, n0 + (n0 >= 6144 ? 16 : 0), 64 * kb, WINT, DM, n0, scr, F.lane); continue; }
        r -= I_IN;
        if (r < I_SQ) { const int kb = r >> 5, nb = r & 31; p0_transpose_item(F.wout, DM, 64 * nb, 64 * kb, WOUTT, DM, 64 * nb, scr, F.lane); continue; }
        r -= I_SQ;
        { const int kb = r >> 5, nb = r & 31; p0_transpose_item(F.wq, DM, 64 * nb, 64 * kb, WQT, DM, 64 * nb, scr, F.lane, F.n2g); }
    }
    const size_t gt = (size_t)F.vcu * 512 + F.tid, NGT = (size_t)F.G * 512;
    { bf16* SKB = (bf16*)(F.ws + WS_SKB); for (size_t e = gt; e < (size_t)2 * 128 * 128; e += NGT) SKB[e] = (bf16)f2bf(F.sk[e]); }
    { unsigned char* U6 = F.ws + WS_EU; unsigned char* V6 = F.ws + WS_EV; float* SU = (float*)(F.ws + WS_EU + 32 * MiB); float* SV = (float*)(F.ws + WS_EV + 32 * MiB);
      for (int r0 = gw; r0 < 2 * NEXP; r0 += 2 * NGW) {
          f32x4 x[2][8];
#pragma unroll
          for (int q = 0; q < 2; ++q) { const int r = r0 + q * NGW; const bool isv = r >= NEXP; const int row = isv ? r - NEXP : r; const float* src = (isv ? F.ev : F.eu) + (size_t)row * DM;
#pragma unroll
              for (int j = 0; j < 8; ++j) x[q][j] = __builtin_nontemporal_load((const f32x4*)(src + 256 * j + 4 * F.lane)); }
#pragma unroll
          for (int q = 0; q < 2; ++q) { const int r = r0 + q * NGW; const bool isv = r >= NEXP; const int row = isv ? r - NEXP : r;
              float amax = 0.f;
#pragma unroll
              for (int j = 0; j < 8; ++j) { if (!isv) x[q][j] = x[q][j] * *(const f32x4*)(F.n2g + 256 * j + 4 * F.lane);
                  amax = fmaxf(amax, fmaxf(fmaxf(fabsf(x[q][j].x), fabsf(x[q][j].y)), fmaxf(fabsf(x[q][j].z), fabsf(x[q][j].w)))); }
#pragma unroll
              for (int o = 1; o < 64; o <<= 1) amax = fmaxf(amax, __shfl_xor(amax, o));
              if (!isv) {
                  const float sc = amax > 0.f ? 7.5f / amax : 1.0f;
                  v16f pa, pb;
#pragma unroll
                  for (int j = 0; j < 8; ++j) { pa[2 * j] = x[q][j].x * sc; pb[2 * j] = x[q][j].y * sc; pa[2 * j + 1] = x[q][j].z * sc; pb[2 * j + 1] = x[q][j].w * sc; }
                  const v6u p = __builtin_amdgcn_cvt_scalef32_2xpk16_fp6_f32(pa, pb, 1.0f);
                  unsigned char* dst2 = U6 + (size_t)row * ROW6;
                  __builtin_nontemporal_store((v4u){p[0], p[1], p[2], p[3]}, (v4u*)(dst2 + 16 * F.lane)); __builtin_nontemporal_store((v2u){p[4], p[5]}, (v2u*)(dst2 + 1024 + 8 * F.lane));
                  if (F.lane == 0) SU[row] = amax > 0.f ? amax / 7.5f : 1.0f;
              } else {
                  const float sc = amax > 0.f ? 6.0f / amax : 1.0f;
                  v4u p;
#pragma unroll
                  for (int d = 0; d < 4; ++d) { unsigned w = 0;
                      w = __builtin_amdgcn_cvt_scalef32_pk_fp4_f32(w, x[q][2 * d].x * sc, x[q][2 * d].y * sc, 1.0f, 0); w = __builtin_amdgcn_cvt_scalef32_pk_fp4_f32(w, x[q][2 * d].z * sc, x[q][2 * d].w * sc, 1.0f, 1);
                      w = __builtin_amdgcn_cvt_scalef32_pk_fp4_f32(w, x[q][2 * d + 1].x * sc, x[q][2 * d + 1].y * sc, 1.0f, 2); w = __builtin_amdgcn_cvt_scalef32_pk_fp4_f32(w, x[q][2 * d + 1].z * sc, x[q][2 * d + 1].w * sc, 1.0f, 3);
                      p[d] = w; }
                  __builtin_nontemporal_store(p, (v4u*)(V6 + (size_t)row * ROW4 + 16 * F.lane));
                  if (F.lane == 0) SV[row] = amax > 0.f ? amax / 6.0f : 1.0f;
              } }
      } }
    __syncthreads();
    { bf16* wt_s = (bf16*)F.lds; constexpr int WLD = DM + 8;
      for (int k = F.tid; k < DM; k += 512) { const float* src = F.win + (size_t)k * DIN + 6144;
#pragma unroll
          for (int q = 0; q < 4; ++q) { const f32x4 w4 = *(const f32x4*)(src + 4 * q); wt_s[(4 * q + 0) * WLD + k] = (bf16)f2bf(w4.x); wt_s[(4 * q + 1) * WLD + k] = (bf16)f2bf(w4.y); wt_s[(4 * q + 2) * WLD + k] = (bf16)f2bf(w4.z); wt_s[(4 * q + 3) * WLD + k] = (bf16)f2bf(w4.w); } }
      bf16* XN = (bf16*)(F.ws + WS_XN); float* ALR = (float*)(F.ws + WS_ALR);
      const int r0 = (int)(((long)F.vcu * TT) / F.G), r1 = (int)(((long)(F.vcu + 1) * TT) / F.G);
      for (int m = r0 + F.wave; m < r1; m += NWAVES) rms_row_to_bf16(m < TP ? F.xp + (size_t)m * DM : F.xs + (size_t)(m - TP) * DM, F.n1g, XN + (size_t)m * DM, F.lane);
      for (int m = TT + gw; m < MP; m += NGW) zero_row_bf16(XN + (size_t)m * DM, F.lane);
      VM_WAIT(); __syncthreads();
      const int l15 = F.lane & 15, lq = F.lane >> 4;
      for (int t0 = r0 + 16 * F.wave; t0 < r1; t0 += 16 * NWAVES) {
          const int row = min(t0 + l15, r1 - 1);
          f32x4 acc = {0.f, 0.f, 0.f, 0.f};
#pragma unroll 8
          for (int ks = 0; ks < 64; ++ks) { const bf16x8 a = *(const bf16x8*)(XN + (size_t)row * DM + 32 * ks + 8 * lq); const bf16x8 bq = *(const bf16x8*)(wt_s + l15 * WLD + 32 * ks + 8 * lq); acc = MFMA16(a, bq, acc); }
#pragma unroll
          for (int r = 0; r < 4; ++r) { const int m = t0 + 4 * lq + r; if (m < r1) ALR[(size_t)m * 16 + l15] = acc[r]; }
      } }
}

template <int NT, class Epi>
__device__ __forceinline__ void skinny_gemm(Frame& F, const bf16* A, const bf16* Bt, int n0, const Epi& E) {
    constexpr int ROWS = NT * 16, NPC = (ROWS * 32 + 511) / 512, BLD = 264;
    bf16* Bs = (bf16*)F.lds;
    const int tid = F.tid, wv = F.wave, l15 = F.lane & 15, lq = F.lane >> 4;
    f32x4 acc[NT];
#pragma unroll
    for (int nt = 0; nt < NT; ++nt) acc[nt] = (f32x4){0.f, 0.f, 0.f, 0.f};
    const bf16* Arow = A + (size_t)(16 * wv + l15) * DM + 8 * lq;
    v4u bX[NPC], bY[NPC]; bf16x8 aX[8], aY[8];
#define SK_LOADB(BR, kc) do { _Pragma("unroll") for (int i = 0; i < NPC; ++i) { const int p = tid + 512 * i; if (p < ROWS * 32) BR[i] = *(const v4u*)(Bt + (size_t)(n0 + (p >> 5)) * DM + (kc) * 256 + 8 * (p & 31)); } } while (0)
#define SK_LOADA(AR, kc) do { _Pragma("unroll") for (int ks = 0; ks < 8; ++ks) AR[ks] = *(const bf16x8*)(Arow + (kc) * 256 + 32 * ks); } while (0)
#define SK_STOREB(BR, kc) do { bf16* Bn = Bs + ((kc) & 1) * ROWS * BLD; _Pragma("unroll") for (int i = 0; i < NPC; ++i) { const int p = tid + 512 * i; if (p < ROWS * 32) *(v4u*)(Bn + (p >> 5) * BLD + 8 * (p & 31)) = BR[i]; } } while (0)
#define SK_COMP(AR, kc) do { const bf16* Bc = Bs + ((kc) & 1) * ROWS * BLD; _Pragma("unroll") for (int ks = 0; ks < 8; ++ks) _Pragma("unroll") for (int nt = 0; nt < NT; ++nt) { \
        const bf16x8 bq = *(const bf16x8*)(Bc + (16 * nt + l15) * BLD + 32 * ks + 8 * lq); acc[nt] = MFMA16(AR[ks], bq, acc[nt]); } } while (0)
    SK_LOADB(bX, 0); SK_LOADA(aX, 0); SK_LOADB(bY, 1); SK_LOADA(aY, 1);
    SK_STOREB(bX, 0);
    __syncthreads();
#pragma unroll 1
    for (int kc = 0; kc < 8; kc += 2) {
        SK_LOADB(bX, kc + 2 < 8 ? kc + 2 : 7);
        SK_COMP(aX, kc); SK_LOADA(aX, kc + 2 < 8 ? kc + 2 : 7);
        SK_STOREB(bY, kc + 1);
        __syncthreads();
        SK_LOADB(bY, kc + 3 < 8 ? kc + 3 : 7);
        SK_COMP(aY, kc + 1); SK_LOADA(aY, kc + 3 < 8 ? kc + 3 : 7);
        SK_STOREB(bX, kc + 2);
        __syncthreads();
    }
#undef SK_LOADB
#undef SK_LOADA
#undef SK_STOREB
#undef SK_COMP
    E.template tile<NT>(acc, wv, l15, lq, n0);
}
template <class Epi>
__device__ __forceinline__ void skinny_gemm16(Frame& F, const bf16* A, const bf16* Bt, int n0, int rh, const Epi& E) {
    constexpr int BLD = 264, BUF = 2 * 16 * BLD;
    bf16* Bs = (bf16*)F.lds; float* xs = (float*)(F.lds + 2 * BUF * 2);
    const int tid = F.tid, wv = F.wave, lane = F.lane, l15 = lane & 15, lq = lane >> 4, mt = wv & 3, kh = wv >> 2;
    f32x4 acc[1] = {(f32x4){0.f, 0.f, 0.f, 0.f}};
    const bf16* Arow = A + (size_t)(64 * rh + 16 * mt + l15) * DM + kh * 1024 + 8 * lq;
    v4u bX[2], bY[2]; bf16x8 aX[8], aY[8];
#define SK_LOADB(BR, kc) do { _Pragma("unroll") for (int i = 0; i < 2; ++i) { const int p = tid + 512 * i; BR[i] = *(const v4u*)(Bt + (size_t)(n0 + ((p >> 5) & 15)) * DM + (p >> 9) * 1024 + (kc) * 256 + 8 * (p & 31)); } } while (0)
#define SK_LOADA(AR, kc) do { _Pragma("unroll") for (int ks = 0; ks < 8; ++ks) AR[ks] = *(const bf16x8*)(Arow + (kc) * 256 + 32 * ks); } while (0)
#define SK_STOREB(BR, kc) do { bf16* Bn = Bs + ((kc) & 1) * BUF; _Pragma("unroll") for (int i = 0; i < 2; ++i) { const int p = tid + 512 * i; *(v4u*)(Bn + ((p >> 9) * 16 + ((p >> 5) & 15)) * BLD + 8 * (p & 31)) = BR[i]; } } while (0)
#define SK_COMP(AR, kc) do { const bf16* Bc = Bs + ((kc) & 1) * BUF + kh * 16 * BLD; _Pragma("unroll") for (int ks = 0; ks < 8; ++ks) { \
        const bf16x8 bq = *(const bf16x8*)(Bc + l15 * BLD + 32 * ks + 8 * lq); acc[0] = MFMA16(AR[ks], bq, acc[0]); } } while (0)
    SK_LOADB(bX, 0); SK_LOADA(aX, 0); SK_LOADB(bY, 1); SK_LOADA(aY, 1);
    SK_STOREB(bX, 0);
    __syncthreads();
#pragma unroll 1
    for (int kc = 0; kc < 4; kc += 2) {
        SK_LOADB(bX, kc + 2 < 4 ? kc + 2 : 3);
        SK_COMP(aX, kc); SK_LOADA(aX, kc + 2 < 4 ? kc + 2 : 3);
        SK_STOREB(bY, kc + 1);
        __syncthreads();
        SK_LOADB(bY, kc + 3 < 4 ? kc + 3 : 3);
        SK_COMP(aY, kc + 1); SK_LOADA(aY, kc + 3 < 4 ? kc + 3 : 3);
        SK_STOREB(bX, kc + 2);
        __syncthreads();
    }
#undef SK_LOADB
#undef SK_LOADA
#undef SK_STOREB
#undef SK_COMP
    if (kh) *(f32x4*)(xs + (mt * 64 + lane) * 4) = acc[0];
    __syncthreads();
    if (!kh) { acc[0] += *(const f32x4*)(xs + (mt * 64 + lane) * 4); E.template tile<1>(acc, 4 * rh + mt, l15, lq, n0); }
    __syncthreads();
}
struct EpiSkBf16 { bf16* out; int ldc; const float* rs;
    template <int NT> __device__ __forceinline__ void tile(const f32x4 (&acc)[NT], int wv, int l15, int lq, int n0) const {
#pragma unroll
        for (int r = 0; r < 4; ++r) { const int row = 16 * wv + 4 * lq + r; const float sc = rs ? rs[row] : 1.0f;
#pragma unroll
            for (int nt = 0; nt < NT; ++nt) out[(size_t)row * ldc + n0 + 16 * nt + l15] = (bf16)f2bf(acc[nt][r] * sc); } } };
struct EpiSkF32Res { const float* xs; bf16* outb; float* ssqs;
    template <int NT> __device__ __forceinline__ void tile(const f32x4 (&acc)[NT], int wv, int l15, int lq, int n0) const {
        static_assert(NT == 1, "one 16-column group");
#pragma unroll
        for (int r = 0; r < 4; ++r) { const int row = 16 * wv + 4 * lq + r; const size_t o = (size_t)row * DM + n0 + l15; const float v = xs[o] + acc[0][r]; outb[o] = (bf16)f2bf(v);
            float s = v * v; s += __shfl_xor(s, 1); s += __shfl_xor(s, 2); s += __shfl_xor(s, 4); s += __shfl_xor(s, 8);
            if (l15 == 0) ssqs[row * 128 + (n0 >> 4)] = s; } } };

__device__ __forceinline__ float logsig(float x) { return fminf(x, 0.f) - __logf(1.0f + __expf(-fabsf(x))); }
__device__ __forceinline__ void gla_prep_unit(Frame& F, int u) {
    const bf16* P = (const bf16*)(F.ws + WS_P); bf16* QT = (bf16*)(F.ws + WS_QT); bf16* KT = (bf16*)(F.ws + WS_KT); bf16* VT = (bf16*)(F.ws + WS_VT);
    bf16* ATT = (bf16*)(F.ws + WS_ATT); float* EBL = (float*)(F.ws + WS_EBL);
    const int b = u >> 7, h = (u >> 5) & 3, c = u & 31, tid = F.tid;
    const int row0 = b * 2048 + c * 64;
    float* alr_s = (float*)F.lds;
    float* tot_s = (float*)(F.lds + 4096);
    bf16* q_s = (bf16*)(F.lds + 8192);
    bf16* k_s = q_s + 64 * 264;
    bf16* v_s = k_s + 64 * 264;
    bf16* a_s = v_s + 64 * 520;
    { v4u tq[4], tk[4], tv[8];
#pragma unroll
      for (int i = 0; i < 4; ++i) { const int p = tid + 512 * i, row = p >> 5, ch = p & 31; const bf16* src = P + (size_t)(row0 + row) * PLD + h * 256 + 8 * ch; tq[i] = __builtin_nontemporal_load((const v4u*)(src + C_Q)); tk[i] = __builtin_nontemporal_load((const v4u*)(src + C_K)); }
#pragma unroll
      for (int i = 0; i < 8; ++i) { const int p = tid + 512 * i, row = p >> 6, ch = p & 63; tv[i] = __builtin_nontemporal_load((const v4u*)(P + (size_t)(row0 + row) * PLD + C_V + h * 512 + 8 * ch)); }
      for (int e = tid; e < 1024; e += 512) alr_s[e] = ((const float*)(F.ws + WS_ALR))[(size_t)row0 * 16 + e];
#pragma unroll
      for (int i = 0; i < 4; ++i) { const int p = tid + 512 * i, row = p >> 5, ch = p & 31; *(v4u*)(q_s + row * 264 + 8 * ch) = tq[i]; *(v4u*)(k_s + row * 264 + 8 * ch) = tk[i]; }
#pragma unroll
      for (int i = 0; i < 8; ++i) { const int p = tid + 512 * i, row = p >> 6, ch = p & 63; *(v4u*)(v_s + row * 520 + 8 * ch) = tv[i]; } }
    const int d = tid & 255, half = tid >> 8;
    float w[16];
#pragma unroll
    for (int r = 0; r < 16; ++r) w[r] = F.wau[r * 1024 + h * 256 + d];
    const float bias = F.bal[h * 256 + d];
    __syncthreads();
    float bb[32]; float run = 0.f;
#pragma unroll
    for (int jj = 0; jj < 32; ++jj) { const int j = half * 32 + jj; float x = bias;
#pragma unroll
        for (int r = 0; r < 16; ++r) x += alr_s[j * 16 + r] * w[r];
        run += logsig(x) * 0.0625f; bb[jj] = run; }
    if (half == 0) tot_s[d] = run;
    __syncthreads();
    if (half == 1) { const float t = tot_s[d];
#pragma unroll
        for (int jj = 0; jj < 32; ++jj) bb[jj] += t; }
#pragma unroll
    for (int jj = 0; jj < 32; ++jj) { const int j = half * 32 + jj;
        const float qv = bf2f(q_s[j * 264 + d]), kv = bf2f(k_s[j * 264 + d]);
        const float e = __expf(bb[jj]), ei = __expf(-bb[jj]);
        q_s[j * 264 + d] = (bf16)f2bf(qv * 0.0625f * e); k_s[j * 264 + d] = (bf16)f2bf(kv * ei); }
    if (half == 1) EBL[u * 256 + d] = __expf(bb[31]);
    __syncthreads();
    { const int wv = F.wave, l15 = F.lane & 15, lq = F.lane >> 4, mi = wv >> 1;
#pragma unroll
      for (int nn = 0; nn < 2; ++nn) { const int ni = (wv & 1) * 2 + nn; f32x4 acc = {0.f, 0.f, 0.f, 0.f};
#pragma unroll
          for (int ks = 0; ks < 8; ++ks) { const bf16x8 a = *(const bf16x8*)(q_s + (16 * mi + l15) * 264 + 32 * ks + 8 * lq); const bf16x8 bq = *(const bf16x8*)(k_s + (16 * ni + l15) * 264 + 32 * ks + 8 * lq); acc = MFMA16(a, bq, acc); }
#pragma unroll
          for (int r = 0; r < 4; ++r) { const int i = 16 * mi + 4 * lq + r, jn = 16 * ni + l15; a_s[i * 72 + jn] = (bf16)f2bf(jn <= i ? acc[r] : 0.f); } } }
#pragma unroll
    for (int i = 0; i < 4; ++i) { const int p = tid + 512 * i, f = p >> 6, ln = p & 63, l15 = ln & 15, lq = ln >> 4;
        { const int mi = f >> 3, kh = (f >> 2) & 1, ks = f & 3; *(v4u*)(QT + (size_t)u * 16384 + (size_t)p * 8) = *(const v4u*)(q_s + (16 * mi + l15) * 264 + 128 * kh + 32 * ks + 8 * lq); }
        { const int wv2 = f >> 2, t2 = (f >> 1) & 1, ks = f & 1, dd = 32 * wv2 + 16 * t2 + l15, j0 = 32 * ks + 8 * lq; v4u o;
          o.x = (unsigned)k_s[(j0 + 0) * 264 + dd] | ((unsigned)k_s[(j0 + 1) * 264 + dd] << 16); o.y = (unsigned)k_s[(j0 + 2) * 264 + dd] | ((unsigned)k_s[(j0 + 3) * 264 + dd] << 16);
          o.z = (unsigned)k_s[(j0 + 4) * 264 + dd] | ((unsigned)k_s[(j0 + 5) * 264 + dd] << 16); o.w = (unsigned)k_s[(j0 + 6) * 264 + dd] | ((unsigned)k_s[(j0 + 7) * 264 + dd] << 16);
          *(v4u*)(KT + (size_t)u * 16384 + (size_t)p * 8) = o; } }
    __syncthreads();
    { const int p = tid, f = p >> 6, ln = p & 63, l15 = ln & 15, lq = ln >> 4, mi = f >> 1, kh = f & 1;
      *(v4u*)(ATT + (size_t)u * 4096 + (size_t)p * 8) = *(const v4u*)(a_s + (16 * mi + l15) * 72 + 32 * kh + 8 * lq); }
    { const int dv = tid; unsigned vp[32];
#pragma unroll
      for (int j = 0; j < 64; ++j) { const unsigned v = v_s[j * 520 + dv]; if (j & 1) vp[j >> 1] |= v << 16; else vp[j >> 1] = v; }
      v4u* dst = (v4u*)(VT + ((size_t)u * 512 + dv) * 64);
#pragma unroll
      for (int i = 0; i < 8; ++i) { v4u o; o.x = vp[4 * i]; o.y = vp[4 * i + 1]; o.z = vp[4 * i + 2]; o.w = vp[4 * i + 3]; dst[i] = o; } }
    __syncthreads();
}

__device__ __forceinline__ void gla_sample_unit(Frame& F, int u) {
    const bf16* P = (const bf16*)(F.ws + WS_P); bf16* O = (bf16*)(F.ws + WS_O);
    const int n = u >> 2, h = u & 3, tid = F.tid, lane = F.lane, wv = F.wave;
    const size_t m = (size_t)(TP + n);
    float* e_s = (float*)F.lds;
    float* qe_s = e_s + 256;
    float* k_s = qe_s + 256;
    float* v_s = k_s + 256;
    float* red_s = v_s + 512;
    float* op_s = red_s + 64;
    float part = 0.f;
    if (tid < 256) { const int d = tid; float x = F.bal[h * 256 + d];
#pragma unroll
        for (int r = 0; r < 16; ++r) x += ((const float*)(F.ws + WS_ALR))[m * 16 + r] * F.wau[r * 1024 + h * 256 + d];
        const float la = logsig(x) * 0.0625f, e = __expf(la);
        const float q = bf2f(P[m * PLD + C_Q + h * 256 + d]) * 0.0625f, k = bf2f(P[m * PLD + C_K + h * 256 + d]);
        e_s[d] = e; qe_s[d] = q * e; k_s[d] = k; part = q * k; }
    v_s[tid] = bf2f(P[m * PLD + C_V + h * 512 + tid]);
    part = wave_sum(part);
    if (lane == 0) red_s[wv] = part;
    __syncthreads();
    const float attn = (red_s[0] + red_s[1]) + (red_s[2] + red_s[3]);
    const float* Sin = F.sgla + ((size_t)(n * 4 + h) * 256) * 512; float* Sout = F.out + OUT_GLAS + ((size_t)(n * 4 + h) * 256) * 512;
    const f32x4 v0 = *(const f32x4*)(v_s + 4 * lane), v1 = *(const f32x4*)(v_s + 256 + 4 * lane);
    f32x4 o0 = {0.f, 0.f, 0.f, 0.f}, o1 = {0.f, 0.f, 0.f, 0.f};
#pragma unroll 1
    for (int g = 0; g < 2; ++g) {
        f32x4 s0[16], s1[16];
#pragma unroll
        for (int i = 0; i < 16; ++i) { const int d = 32 * wv + 16 * g + i; s0[i] = __builtin_nontemporal_load((const f32x4*)(Sin + (size_t)d * 512 + 4 * lane)); s1[i] = __builtin_nontemporal_load((const f32x4*)(Sin + (size_t)d * 512 + 256 + 4 * lane)); }
#pragma unroll
        for (int i = 0; i < 16; ++i) { const int d = 32 * wv + 16 * g + i; const float e = e_s[d], qe = qe_s[d], k = k_s[d];
            o0 += s0[i] * qe; o1 += s1[i] * qe;
            __builtin_nontemporal_store(s0[i] * e + v0 * k, (f32x4*)(Sout + (size_t)d * 512 + 4 * lane)); __builtin_nontemporal_store(s1[i] * e + v1 * k, (f32x4*)(Sout + (size_t)d * 512 + 256 + 4 * lane)); }
    }
    *(f32x4*)(op_s + wv * 512 + 4 * lane) = o0; *(f32x4*)(op_s + wv * 512 + 256 + 4 * lane) = o1;
    __syncthreads();
    { float o = attn * v_s[tid];
#pragma unroll
      for (int w8 = 0; w8 < 8; ++w8) o += op_s[w8 * 512 + tid];
      O[m * DM + h * 512 + tid] = (bf16)f2bf(o); }
    __syncthreads();
}

struct GlaRegs { bf16x8 kt[2][2], at, q[4]; v4u vpiece; float epiece; };
struct GlaOffs { unsigned l16, vt, eb; };
template <int NT>
__device__ __forceinline__ GlaOffs gla_offs(int lane, int tid) {
    const int tv = tid & (NT * 128 - 1); GlaOffs o;
    o.l16 = (unsigned)(lane * 16);
    o.vt = (unsigned)(((tv >> 3) * 64 + 8 * (tv & 7)) * 2);
    o.eb = (unsigned)((tid & 255) * 4);
    return o;
}
template <int NT>
__device__ __forceinline__ void gla_load(GlaRegs& R, const GlaOffs& o, const bf16* QT, const bf16* KT, const bf16* VT, const bf16* ATT, const float* EBL, int bh, int s, int c, int wv) {
    const size_t u = (size_t)bh * 32 + c;
    const char* pa = (const char*)(ATT + u * 4096) + wv * 1024; const char* pv = (const char*)(VT + (u * 512 + 16 * NT * s) * 64);
    const char* pq = (const char*)(QT + u * 16384) + wv * 4096; const char* pk = (const char*)(KT + u * 16384) + wv * 4096;
    R.at = *(const bf16x8*)(pa + o.l16);
    R.vpiece = *(const v4u*)(pv + o.vt);
    R.epiece = *(const float*)((const char*)(EBL + u * 256) + o.eb);
#pragma unroll
    for (int ks = 0; ks < 4; ++ks) R.q[ks] = *(const bf16x8*)(pq + o.l16 + 1024 * ks);
#pragma unroll
    for (int t = 0; t < 2; ++t)
#pragma unroll
        for (int ks = 0; ks < 2; ++ks) R.kt[t][ks] = *(const bf16x8*)(pk + o.l16 + 2048 * t + 1024 * ks);
}
constexpr int VT_LD = 72;
template <int NT>
__device__ __forceinline__ void gla_step(const GlaRegs& R, const float* ebs, f32x4 (&S)[2][NT], const bf16* vts, const bf16* STp, bf16* STn, float* xo, int wv, int lane, int l15, int lq) {
    const int mi = wv >> 1, kh = wv & 1;
#pragma unroll
    for (int nt = 0; nt < NT; ++nt) {
        f32x4 acc = {0.f, 0.f, 0.f, 0.f};
        { const bf16x8 vsel = *(const bf16x8*)(vts + (16 * nt + l15) * VT_LD + 32 * kh + 8 * lq); acc = MFMA16(R.at, vsel, acc); }
#pragma unroll
        for (int ks = 0; ks < 4; ++ks) { const bf16x8 sf = *(const bf16x8*)(STp + (16 * nt + l15) * 264 + 128 * kh + 32 * ks + 8 * lq); acc = MFMA16(R.q[ks], sf, acc); }
        *(f32x4*)(xo + (((mi * 2 + kh) * NT + nt) * 64 + lane) * 4) = acc;
    }
#pragma unroll
    for (int nt = 0; nt < NT; ++nt) {
        bf16x8 vt[2];
#pragma unroll
        for (int ks = 0; ks < 2; ++ks) vt[ks] = *(const bf16x8*)(vts + (16 * nt + l15) * VT_LD + 32 * ks + 8 * lq);
#pragma unroll
        for (int mt = 0; mt < 2; ++mt) {
#pragma unroll
            for (int ks = 0; ks < 2; ++ks) S[mt][nt] = MFMA16(R.kt[mt][ks], vt[ks], S[mt][nt]);
            S[mt][nt] = S[mt][nt] * *(const f32x4*)(ebs + 32 * wv + 16 * mt + 4 * lq);
            v2u w; w.x = pg8::cvt_pk_bf16(S[mt][nt][0], S[mt][nt][1]); w.y = pg8::cvt_pk_bf16(S[mt][nt][2], S[mt][nt][3]);
            *(v2u*)(STn + (16 * nt + l15) * 264 + 32 * wv + 16 * mt + 4 * lq) = w; } }
}
template <int NT>
__device__ __forceinline__ void gla_store_o(const float* xo, bf16* O, int b, int h, int s, int c, int wv, int lane, int l15, int lq) {
    const int mi = wv >> 1, kh = wv & 1;
#pragma unroll
    for (int n2 = 0; n2 < NT / 2; ++n2) { const int nt = kh * (NT / 2) + n2;
        const f32x4 t = *(const f32x4*)(xo + (((mi * 2 + 0) * NT + nt) * 64 + lane) * 4) + *(const f32x4*)(xo + (((mi * 2 + 1) * NT + nt) * 64 + lane) * 4);
        const unsigned p01 = pg8::cvt_pk_bf16(t[0], t[1]), p23 = pg8::cvt_pk_bf16(t[2], t[3]);
        bf16* dst = O + ((size_t)b * 2048 + 64 * c + 16 * mi + 4 * lq) * DM + h * 512 + 16 * NT * s + 16 * nt + l15;
        dst[0] = (bf16)(p01 & 0xffffu); dst[DM] = (bf16)(p01 >> 16); dst[2 * DM] = (bf16)(p23 & 0xffffu); dst[3 * DM] = (bf16)(p23 >> 16); }
}
#define GLA_BAR() do { asm volatile("s_waitcnt lgkmcnt(0)" ::: "memory"); __builtin_amdgcn_s_barrier(); asm volatile("" ::: "memory"); } while (0)
template <int NT>
__device__ __forceinline__ void gla_main_unit(Frame& F, int bh, int s) {
    const bf16* QT = (const bf16*)(F.ws + WS_QT); const bf16* KT = (const bf16*)(F.ws + WS_KT); const bf16* VT = (const bf16*)(F.ws + WS_VT);
    const bf16* ATT = (const bf16*)(F.ws + WS_ATT); const float* EBL = (const float*)(F.ws + WS_EBL); bf16* O = (bf16*)(F.ws + WS_O);
    const int b = bh >> 2, h = bh & 3, wv = F.wave, lane = F.lane, l15 = lane & 15, lq = lane >> 4, kh = wv & 1, tid = F.tid;
    constexpr int ST_ELEMS = NT * 16 * 264, XO_FLOATS = 8 * NT * 256, VTS_ELEMS = NT * 16 * VT_LD;
    bf16* ST = (bf16*)F.lds;
    float* XO = (float*)(F.lds + 2 * ST_ELEMS * 2);
    bf16* VTS = (bf16*)(F.lds + 2 * ST_ELEMS * 2 + 2 * XO_FLOATS * 4);
    float* EBS = (float*)(F.lds + 2 * ST_ELEMS * 2 + 2 * XO_FLOATS * 4 + 2 * VTS_ELEMS * 2);
    for (int e = tid; e < ST_ELEMS; e += 512) ((unsigned*)ST)[e] = 0u;
    f32x4 S[2][NT];
#pragma unroll
    for (int a = 0; a < 2; ++a)
#pragma unroll
        for (int c2 = 0; c2 < NT; ++c2) S[a][c2] = (f32x4){0.f, 0.f, 0.f, 0.f};
    const GlaOffs go = gla_offs<NT>(lane, tid);
    GlaRegs RA, RB, RC;
    gla_load<NT>(RA, go, QT, KT, VT, ATT, EBL, bh, s, 0, wv);
    gla_load<NT>(RB, go, QT, KT, VT, ATT, EBL, bh, s, 1, wv);
    if (tid < NT * 128) *(v4u*)(VTS + (tid >> 3) * VT_LD + 8 * (tid & 7)) = RA.vpiece;
    if (tid < 256) EBS[tid] = RA.epiece;
    __syncthreads();
#define GLA_ITER(c, RCUR, RNXT, RLD) do { if ((c) < 32) { \
            gla_load<NT>(RLD, go, QT, KT, VT, ATT, EBL, bh, s, (c) + 2 < 32 ? (c) + 2 : 31, wv); \
            gla_step<NT>(RCUR, EBS + ((c) & 1) * 256, S, VTS + ((c) & 1) * VTS_ELEMS, ST + ((c) & 1) * ST_ELEMS, ST + (((c) + 1) & 1) * ST_ELEMS, XO + ((c) & 1) * XO_FLOATS, wv, lane, l15, lq); \
            if ((c) > 0) gla_store_o<NT>(XO + (((c) + 1) & 1) * XO_FLOATS, O, b, h, s, (c) - 1, wv, lane, l15, lq); \
            if (tid < NT * 128) *(v4u*)(VTS + (((c) + 1) & 1) * VTS_ELEMS + (tid >> 3) * VT_LD + 8 * (tid & 7)) = RNXT.vpiece; \
            if (tid < 256) EBS[(((c) + 1) & 1) * 256 + tid] = RNXT.epiece; \
            GLA_BAR(); \
        } } while (0)
#pragma unroll 1
    for (int c = 0; c < 33; c += 3) { GLA_ITER(c, RA, RB, RC); GLA_ITER(c + 1, RB, RC, RA); GLA_ITER(c + 2, RC, RA, RB); }
#undef GLA_ITER
    gla_store_o<NT>(XO + (31 & 1) * XO_FLOATS, O, b, h, s, 31, wv, lane, l15, lq);
    int lq2 = lq; asm volatile("" : "+v"(lq2));
    float* So = F.out + OUT_GLAP + ((size_t)bh * 256) * 512;
#pragma unroll
    for (int mt = 0; mt < 2; ++mt)
#pragma unroll
        for (int nt = 0; nt < NT; ++nt)
#pragma unroll
            for (int r = 0; r < 4; ++r) So[(size_t)(32 * wv + 16 * mt + 4 * lq2 + r) * 512 + 16 * NT * s + 16 * nt + l15] = S[mt][nt][r];
    __syncthreads();
}

template <int NR>
__device__ __forceinline__ void mixer_rows(Frame& F, int m0, int j) {
    const bf16* P = (const bf16*)(F.ws + WS_P); const bf16* O = (const bf16*)(F.ws + WS_O); bf16* MM = (bf16*)(F.ws + WS_MM);
    const int lane = F.lane; const bool prompt = m0 < TP;
    {
        const int col = 512 * j + 8 * lane;
        float u1[8], u2[8], gn[8], cbi[8], w0[8], w1[8], w2[8];
        { const f32x4 a = *(const f32x4*)(F.gng + col), b2 = *(const f32x4*)(F.gng + col + 4); gn[0] = a.x; gn[1] = a.y; gn[2] = a.z; gn[3] = a.w; gn[4] = b2.x; gn[5] = b2.y; gn[6] = b2.z; gn[7] = b2.w; }
        { const f32x4 a = *(const f32x4*)(F.cb + col), b2 = *(const f32x4*)(F.cb + col + 4); cbi[0] = a.x; cbi[1] = a.y; cbi[2] = a.z; cbi[3] = a.w; cbi[4] = b2.x; cbi[5] = b2.y; cbi[6] = b2.z; cbi[7] = b2.w; }
        { const f32x4 a = *(const f32x4*)(F.cw + col), b2 = *(const f32x4*)(F.cw + col + 4); w0[0] = a.x; w0[1] = a.y; w0[2] = a.z; w0[3] = a.w; w0[4] = b2.x; w0[5] = b2.y; w0[6] = b2.z; w0[7] = b2.w; }
        { const f32x4 a = *(const f32x4*)(F.cw + DM + col), b2 = *(const f32x4*)(F.cw + DM + col + 4); w1[0] = a.x; w1[1] = a.y; w1[2] = a.z; w1[3] = a.w; w1[4] = b2.x; w1[5] = b2.y; w1[6] = b2.z; w1[7] = b2.w; }
        { const f32x4 a = *(const f32x4*)(F.cw + 2 * DM + col), b2 = *(const f32x4*)(F.cw + 2 * DM + col + 4); w2[0] = a.x; w2[1] = a.y; w2[2] = a.z; w2[3] = a.w; w2[4] = b2.x; w2[5] = b2.y; w2[6] = b2.z; w2[7] = b2.w; }
        if (prompt) {
            const int t0 = m0 & 2047; const bf16* Pr = P + (size_t)m0 * PLD;
            if (t0 >= 1) { float a[8], b2[8]; unpack8(*(const v4u*)(Pr - PLD + C_CC + col), a); unpack8(*(const v4u*)(Pr - PLD + C_CX + col), b2);
#pragma unroll
                for (int e = 0; e < 8; ++e) u1[e] = a[e] * b2[e]; }
            else {
#pragma unroll
                for (int e = 0; e < 8; ++e) u1[e] = 0.f; }
            if (t0 >= 2) { float a[8], b2[8]; unpack8(*(const v4u*)(Pr - 2 * PLD + C_CC + col), a); unpack8(*(const v4u*)(Pr - 2 * PLD + C_CX + col), b2);
#pragma unroll
                for (int e = 0; e < 8; ++e) u2[e] = a[e] * b2[e]; }
            else {
#pragma unroll
                for (int e = 0; e < 8; ++e) u2[e] = 0.f; }
        } else {
            const int n = m0 - TP; const float* sc = F.sconv + (size_t)n * 2 * DM + col;
            const f32x4 a0 = *(const f32x4*)sc, a1 = *(const f32x4*)(sc + 4), b0 = *(const f32x4*)(sc + DM), b1 = *(const f32x4*)(sc + DM + 4);
            u2[0] = a0.x; u2[1] = a0.y; u2[2] = a0.z; u2[3] = a0.w; u2[4] = a1.x; u2[5] = a1.y; u2[6] = a1.z; u2[7] = a1.w;
            u1[0] = b0.x; u1[1] = b0.y; u1[2] = b0.z; u1[3] = b0.w; u1[4] = b1.x; u1[5] = b1.y; u1[6] = b1.z; u1[7] = b1.w;
        }
        v4u lo[NR], lr[NR], lcb[NR], lcc[NR], lcx[NR], lga[NR], lgb[NR];
#pragma unroll
        for (int r = 0; r < NR; ++r) { const int m = m0 + r; const bf16* Pr = P + (size_t)m * PLD;
            lo[r] = *(const v4u*)(O + (size_t)m * DM + col);
            lr[r] = __builtin_nontemporal_load((const v4u*)(Pr + C_R + col)); lcb[r] = __builtin_nontemporal_load((const v4u*)(Pr + C_CB + col)); lcc[r] = __builtin_nontemporal_load((const v4u*)(Pr + C_CC + col));
            lcx[r] = __builtin_nontemporal_load((const v4u*)(Pr + C_CX + col)); lga[r] = __builtin_nontemporal_load((const v4u*)(Pr + C_GA + col)); lgb[r] = __builtin_nontemporal_load((const v4u*)(Pr + C_GB + col)); }
#pragma unroll
        for (int r = 0; r < NR; ++r) {
            const int m = m0 + r;
            float o[8], rr[8], cbv[8], cc[8], cx[8], ga[8], gb[8], u[8];
            unpack8(lo[r], o); unpack8(lr[r], rr); unpack8(lcb[r], cbv); unpack8(lcc[r], cc); unpack8(lcx[r], cx); unpack8(lga[r], ga); unpack8(lgb[r], gb);
            float ss = 0.f;
#pragma unroll
            for (int e = 0; e < 8; ++e) ss += o[e] * o[e];
            const float rstd = 1.0f / sqrtf(wave_sum(ss) * (1.0f / 512.0f) + EPS);
#pragma unroll
            for (int e = 0; e < 8; ++e) u[e] = cc[e] * cx[e];
            if (prompt) { const int t = m & 2047;
                if (t >= 2046) { float* dst = F.out + OUT_CONVP + ((size_t)(m >> 11) * 2 + (t - 2046)) * DM + col;
                    *(f32x4*)dst = (f32x4){u[0], u[1], u[2], u[3]}; *(f32x4*)(dst + 4) = (f32x4){u[4], u[5], u[6], u[7]}; }
            } else { float* dst = F.out + OUT_CONVS + (size_t)(m - TP) * 2 * DM + col;
                *(f32x4*)dst = (f32x4){u1[0], u1[1], u1[2], u1[3]}; *(f32x4*)(dst + 4) = (f32x4){u1[4], u1[5], u1[6], u1[7]};
                *(f32x4*)(dst + DM) = (f32x4){u[0], u[1], u[2], u[3]}; *(f32x4*)(dst + DM + 4) = (f32x4){u[4], u[5], u[6], u[7]}; }
            float mv[8];
#pragma unroll
            for (int e = 0; e < 8; ++e) {
                const float ya = (rr[e] * sigmoidf_(rr[e])) * (o[e] * rstd * gn[e]);
                const float z = cbi[e] + w0[e] * u2[e] + w1[e] * u1[e] + w2[e] * u[e];
                mv[e] = sigmoidf_(ga[e]) * ya + sigmoidf_(gb[e]) * (cbv[e] * z);
                u2[e] = u1[e]; u1[e] = u[e];
            }
            *(v4u*)(MM + (size_t)m * DM + col) = pack8(mv);
        }
    }
}

constexpr int SC_LD = 130;
__device__ __forceinline__ int f2sort(float f) { const int b = __float_as_int(f); return b ^ ((b >> 31) & 0x7fffffff); }
__device__ __forceinline__ float sort2f(int s) { return __int_as_float(s ^ ((s >> 31) & 0x7fffffff)); }
#define CE_DESC(x, y) do { const int mx_ = max(x, y), mn_ = min(x, y); x = mx_; y = mn_; } while (0)
template <int N> __device__ __forceinline__ void bitonic_sort_desc(int (&a)[N]) {
#pragma unroll
    for (int k = 2; k <= N; k <<= 1)
#pragma unroll
        for (int j = k >> 1; j > 0; j >>= 1)
#pragma unroll
            for (int i = 0; i < N; ++i) { const int l = i ^ j; if (l > i) { if ((i & k) == 0) CE_DESC(a[i], a[l]); else CE_DESC(a[l], a[i]); } }
}
template <int N> __device__ __forceinline__ void bitonic_merge_desc(int (&a)[N]) {
#pragma unroll
    for (int j = N >> 1; j > 0; j >>= 1)
#pragma unroll
        for (int i = 0; i < N; ++i) { const int l = i ^ j; if (l > i) CE_DESC(a[i], a[l]); }
}
__device__ __forceinline__ void top16_merge(int (&a)[16], const int (&b)[16]) {
#pragma unroll
    for (int i = 0; i < 16; ++i) a[i] = max(a[i], b[15 - i]);
    bitonic_merge_desc<16>(a);
}
__device__ __attribute__((aligned(16))) const unsigned char PK_CAND[64] = {
    0x00, 0x01, 0x02, 0x03, 0x04, 0x05, 0x06, 0x07, 0x08, 0x09, 0x0a, 0x0b, 0x0c, 0x0d, 0x0e, 0x0f,
    0x10, 0x11, 0x12, 0x13, 0x14, 0x15, 0x16, 0x17, 0x20, 0x21, 0x22, 0x23, 0x24, 0x50, 0x51, 0xff,
    0x30, 0x31, 0x32, 0x33, 0x40, 0x41, 0x42, 0x60, 0x61, 0x70, 0x71, 0xff, 0xff, 0xff, 0xff, 0xff,
    0x80, 0x90, 0xa0, 0xb0, 0xc0, 0xd0, 0xe0, 0xf0, 0xff, 0xff, 0xff, 0xff, 0xff, 0xff, 0xff, 0xff};
constexpr int SC8_LD = 132, SK_LD = 136;
constexpr int SC8_BYTES = 128 * SC8_LD * 4, TV8_OFF = SC8_BYTES, SK_OFF = TV8_OFF + 128 * 16 * 4;
__device__ __forceinline__ void peer_load_subkeys(Frame& F) {
    const bf16* SKB = (const bf16*)(F.ws + WS_SKB); bf16* sk_s = (bf16*)(F.lds + SK_OFF);
    for (int e = F.tid; e < 256 * 16; e += 512) { const int row = e >> 4, ch = e & 15; *(v4u*)(sk_s + row * SK_LD + 8 * ch) = *(const v4u*)(SKB + (size_t)row * 128 + 8 * ch); }
    __syncthreads();
}
__device__ __forceinline__ void peer_qfrags(Frame& F, int tb, bf16x8 (&a)[2][4]) {
    const bf16* QP = (const bf16*)(F.ws + WS_QP); const int tok = min(tb + (F.lane & 7), TT - 1), lq = F.lane >> 4;
#pragma unroll
    for (int hf = 0; hf < 2; ++hf)
#pragma unroll
        for (int ks = 0; ks < 4; ++ks) a[hf][ks] = *(const bf16x8*)(QP + (size_t)tok * DM + F.wave * 256 + hf * 128 + 32 * ks + 8 * lq);
}
#define PK_BAR() do { asm volatile("s_waitcnt lgkmcnt(0)" ::: "memory"); __builtin_amdgcn_s_barrier(); asm volatile("" ::: "memory"); } while (0)
__device__ __forceinline__ void peer_topk_tile(Frame& F, int tb, int tend, bf16x8 (&a)[2][4]) {
    int* IDX = (int*)(F.ws + WS_IDX); float* GW = (float*)(F.ws + WS_GW);
    float* sc_s = (float*)F.lds;
    int* tv_s = (int*)(F.lds + TV8_OFF);
    const bf16* sk_s = (const bf16*)(F.lds + SK_OFF);
    const int wv = F.wave, lane = F.lane, l15 = lane & 15, lq = lane >> 4, tid = F.tid;
    {
#pragma unroll
      for (int hf = 0; hf < 2; ++hf) {
#pragma unroll
          for (int nt = 0; nt < 8; ++nt) { f32x4 acc = {0.f, 0.f, 0.f, 0.f};
#pragma unroll
              for (int ks = 0; ks < 4; ++ks) { const bf16x8 bq = *(const bf16x8*)(sk_s + (hf * 128 + 16 * nt + l15) * SK_LD + 32 * ks + 8 * lq); acc = MFMA16(a[hf][ks], bq, acc); }
              if (lq < 2) {
#pragma unroll
                  for (int r = 0; r < 4; ++r) sc_s[((wv * 2 + hf) * 8 + 4 * lq + r) * SC8_LD + 16 * nt + l15] = acc[r]; } } } }
    if (tb + 8 < tend) peer_qfrags(F, tb + 8, a);
    PK_BAR();
    { const int row = tid >> 2, sub = tid & 3; const float* rp = sc_s + row * SC8_LD;
      int top[16], v[16];
#pragma unroll
      for (int i = 0; i < 16; ++i) { const int key = 4 * i + sub; top[i] = (f2sort(rp[key]) & ~127) | (127 - key); }
      bitonic_sort_desc<16>(top);
#pragma unroll
      for (int i = 0; i < 16; ++i) { const int key = 4 * (16 + i) + sub; v[i] = (f2sort(rp[key]) & ~127) | (127 - key); }
      bitonic_sort_desc<16>(v);
      top16_merge(top, v);
#pragma unroll
      for (int sh = 1; sh < 4; sh <<= 1) {
#pragma unroll
          for (int i = 0; i < 16; ++i) v[i] = __shfl_xor(top[i], sh);
          top16_merge(top, v); }
      if (sub == 0) {
#pragma unroll
          for (int q = 0; q < 4; ++q) *(int __attribute__((ext_vector_type(4)))*)(tv_s + row * 16 + 4 * q) = (int __attribute__((ext_vector_type(4)))){top[4 * q], top[4 * q + 1], top[4 * q + 2], top[4 * q + 3]}; }
    }
    PK_BAR();
    if (tid < 256) { const int it = tid >> 2, qd = tid & 3, tl = it & 7, hd = it >> 3;
      const int* r1 = tv_s + ((hd * 2 + 0) * 8 + tl) * 16; const int* r2 = tv_s + ((hd * 2 + 1) * 8 + tl) * 16;
      int c[16];
      const v4u cw = *(const v4u*)(PK_CAND + qd * 16);
#pragma unroll
      for (int t = 0; t < 16; ++t) { const int ab = (int)((cw[t >> 2] >> (8 * (t & 3))) & 0xffu); const int abc = ab != 0xff ? ab : 0;
          const float sv = sort2f(r1[abc >> 4] & ~127) + sort2f(r2[abc & 15] & ~127); const int packed = (f2sort(sv) & ~255) | (255 - ab);
          c[t] = ab != 0xff ? packed : (int)0x80000000; }
      bitonic_sort_desc<16>(c);
#pragma unroll
      for (int sh = 1; sh < 4; sh <<= 1) { int oth[16];
#pragma unroll
          for (int i = 0; i < 16; ++i) oth[i] = __shfl_xor(c[i], sh);
          top16_merge(c, oth); }
      const int tok = tb + tl;
      if (tok < tend) {
          float ev[16], sum = 0.f; const float mx = sort2f(c[0] & ~255);
#pragma unroll
          for (int k = 0; k < 16; ++k) { ev[k] = __expf(sort2f(c[k] & ~255) - mx); sum += ev[k]; }
          const float inv = 1.0f / sum;
#pragma unroll
          for (int k = 0; k < 16; ++k) if ((k >> 2) == qd) { const int ab = 255 - (c[k] & 255); const int i1 = 127 - (r1[ab >> 4] & 127), i2 = 127 - (r2[ab & 15] & 127);
              IDX[(size_t)tok * 128 + hd * 16 + k] = i1 * 128 + i2; GW[(size_t)tok * 128 + hd * 16 + k] = ev[k] * inv; }
      }
    }
    PK_BAR();
}

__device__ __forceinline__ void peer_phase(Frame& F, int tok0, int tok1) {
    const unsigned char* U6 = F.ws + WS_EU; const unsigned char* V6 = F.ws + WS_EV; const float* SU = (const float*)(F.ws + WS_EU + 32 * MiB); const float* SV = (const float*)(F.ws + WS_EV + 32 * MiB);
    const bf16* X2 = (const bf16*)(F.ws + WS_H2); const float* RS2 = (const float*)(F.ws + WS_RS2); const int* IDX = (const int*)(F.ws + WS_IDX); const float* GW = (const float*)(F.ws + WS_GW);
    const int wv = F.wave, lane = F.lane, tid = F.tid;
    float* red_s = (float*)F.lds;
    float* ss_s = (float*)(F.lds + 131072);
    const f32x4 gfin = *(const f32x4*)(F.nfg + 4 * tid);
    f32x4 x3p = {0.f, 0.f, 0.f, 0.f}; int buf = 0;
#pragma unroll 1
    for (int m = tok0; m <= tok1; ++m) {
        if (m < tok1) {
            const int myidx = IDX[(size_t)m * 128 + wv * 16 + (lane & 15)]; float myg = GW[(size_t)m * 128 + wv * 16 + (lane & 15)];
            const float mysu = SU[myidx] * RS2[m]; myg *= SV[myidx];
            float hf[32];
#pragma unroll
            for (int j = 0; j < 8; ++j) { const v2u w = *(const v2u*)(X2 + (size_t)m * DM + 256 * j + 4 * lane); hf[4 * j] = bflo(w.x); hf[4 * j + 1] = bfhi(w.x); hf[4 * j + 2] = bflo(w.y); hf[4 * j + 3] = bfhi(w.y); }
            float acc[32];
#pragma unroll
            for (int k = 0; k < 32; ++k) acc[k] = 0.f;
#pragma unroll 1
            for (int kg = 0; kg < 4; ++kg) {
                v4u ul4[4], vl4[4]; v2u ul2[4]; float gk[4], su[4];
#pragma unroll
                for (int kk = 0; kk < 4; ++kk) { const int ex = __builtin_amdgcn_readlane(myidx, kg * 4 + kk); gk[kk] = __builtin_bit_cast(float, __builtin_amdgcn_readlane(__builtin_bit_cast(int, myg), kg * 4 + kk)); su[kk] = __builtin_bit_cast(float, __builtin_amdgcn_readlane(__builtin_bit_cast(int, mysu), kg * 4 + kk));
                    const unsigned char* ur = U6 + (size_t)ex * ROW6; const unsigned char* vr = V6 + (size_t)ex * ROW4;
                    ul4[kk] = *(const v4u*)(ur + 16 * lane); ul2[kk] = *(const v2u*)(ur + 1024 + 8 * lane); vl4[kk] = *(const v4u*)(vr + 16 * lane); }
#pragma unroll
                for (int kk = 0; kk < 4; ++kk) {
                    const v32f uf = __builtin_amdgcn_cvt_scalef32_pk32_f32_fp6((v6u){ul4[kk].x, ul4[kk].y, ul4[kk].z, ul4[kk].w, ul2[kk].x, ul2[kk].y}, 1.0f);
                    f32x2 d2a = {0.f, 0.f}, d2b = {0.f, 0.f};
#pragma unroll
                    for (int k = 0; k < 32; k += 4) { d2a += (f32x2){uf[k], uf[k + 1]} * (f32x2){hf[k], hf[k + 1]}; d2b += (f32x2){uf[k + 2], uf[k + 3]} * (f32x2){hf[k + 2], hf[k + 3]}; }
                    const float dot = (d2a.x + d2a.y) + (d2b.x + d2b.y);
                    const float a = wave_sum_dpp(dot) * su[kk];
                    const float wgt = gk[kk] * gelu_erf(a);
#pragma unroll
                    for (int d = 0; d < 4; ++d) {
                        const f32x2 v0 = __builtin_amdgcn_cvt_scalef32_pk_f32_fp4(vl4[kk][d], 1.0f, 0), v1 = __builtin_amdgcn_cvt_scalef32_pk_f32_fp4(vl4[kk][d], 1.0f, 1), v2 = __builtin_amdgcn_cvt_scalef32_pk_f32_fp4(vl4[kk][d], 1.0f, 2), v3 = __builtin_amdgcn_cvt_scalef32_pk_f32_fp4(vl4[kk][d], 1.0f, 3);
                        acc[8 * d] += wgt * v0.x; acc[8 * d + 1] += wgt * v0.y; acc[8 * d + 2] += wgt * v1.x; acc[8 * d + 3] += wgt * v1.y; acc[8 * d + 4] += wgt * v2.x; acc[8 * d + 5] += wgt * v2.y; acc[8 * d + 6] += wgt * v3.x; acc[8 * d + 7] += wgt * v3.y; }
                }
            }
#pragma unroll
            for (int j = 0; j < 8; ++j) *(f32x4*)(red_s + (buf * 8 + wv) * 2048 + 256 * j + 4 * lane) = (f32x4){acc[4 * j], acc[4 * j + 1], acc[4 * j + 2], acc[4 * j + 3]};
        }
        __syncthreads();
        if (m > tok0) {
            float tot = 0.f;
#pragma unroll
            for (int w8 = 0; w8 < 8; ++w8) tot += ss_s[(buf ^ 1) * 8 + w8];
            const float rstd = 1.0f / sqrtf(tot * (1.0f / DM) + EPS);
            *(f32x4*)(F.out + OUT_Y + (size_t)(m - 1) * DM + 4 * tid) = x3p * rstd * gfin;
        }
        if (m < tok1) {
            f32x4 x3; { const v2u w = *(const v2u*)(X2 + (size_t)m * DM + 4 * tid); x3 = (f32x4){bflo(w.x), bfhi(w.x), bflo(w.y), bfhi(w.y)}; }
#pragma unroll
            for (int w8 = 0; w8 < 8; ++w8) x3 += *(const f32x4*)(red_s + (buf * 8 + w8) * 2048 + 4 * tid);
            const float ss = wave_sum((x3.x * x3.x + x3.y * x3.y) + (x3.z * x3.z + x3.w * x3.w));
            if (lane == 0) ss_s[buf * 8 + wv] = ss;
            x3p = x3;
        }
        buf ^= 1;
    }
    __syncthreads();
}
struct Args { const float* in[18]; float* out; unsigned char* ws; int ph_lo, ph_hi; };
__global__ void __launch_bounds__(NWAVES * 64, 2) mk_fwd(Args args) {
    extern __shared__ __attribute__((aligned(16))) unsigned char lds[];
    Frame F;
    F.lds = lds;
    F.tid = threadIdx.x; F.lane = F.tid & 63; F.wave = __builtin_amdgcn_readfirstlane(F.tid >> 6);
    F.G = gridDim.x; { const int bx = blockIdx.x; F.vcu = (F.G % 8 == 0) ? (bx % 8) * (F.G / 8) + bx / 8 : bx; }
    F.xp = args.in[0]; F.xs = args.in[1]; F.sgla = args.in[2]; F.sconv = args.in[3]; F.n1g = args.in[4]; F.win = args.in[5]; F.wau = args.in[6]; F.bal = args.in[7];
    F.gng = args.in[8]; F.cw = args.in[9]; F.cb = args.in[10]; F.wout = args.in[11]; F.n2g = args.in[12]; F.wq = args.in[13]; F.sk = args.in[14]; F.eu = args.in[15];
    F.ev = args.in[16]; F.nfg = args.in[17]; F.out = args.out; F.ws = args.ws;
    for (int u = F.tid; u < (LDS_BYTES - LDSCTL_OFF) / 4; u += NWAVES * 64) ((LAS unsigned*)((LAS unsigned char*)lds + LDSCTL_OFF))[u] = 0u;
    __syncthreads();
    gu32* ctl = (gu32*)(F.ws + WS_CTL);
    XcdBarrier bar; bar.bar = (unsigned*)(ctl + CW_BAR); bar.x = 0; bar.st = nullptr;
    if (N_LAUNCHES == 1) bar = xcd_barrier_post((unsigned*)(ctl + CW_BAR), (volatile LAS unsigned*)((LAS unsigned char*)lds + MISC_OFF) + 8);
    const int lo = args.ph_lo, hi = args.ph_hi;
#ifdef PROBE_TIME_MAIN
    unsigned long long probe_dt_ = 0;
#endif
#ifndef G1_WGM
#define G1_WGM 3
#endif
#ifndef G23_WGM
#define G23_WGM 3
#endif
#ifndef G1_ALIGN
#define G1_ALIGN true
#endif
#ifndef G1_SP2
#define G1_SP2 true
#endif
#ifndef SKREP
#define SKREP 1
#endif
#ifndef PROBE_DBL
#define PROBE_DBL -1
#endif
#define IN(k) (lo <= (k) && (k) < hi)
#define REP(k) for (int rep_ = 0; rep_ < ((k) == PROBE_DBL ? 2 : 1); ++rep_)
#ifndef BAR_REP
#define BAR_REP 1
#endif
#ifndef PROBE_TIME_PHASE
#define PROBE_TIME_PHASE -1
#endif
    unsigned long long ptp_t0_ = 0, ptp_dt_ = 0;
#define PH_BEGIN(k) do { if ((k) == PROBE_TIME_PHASE) ptp_t0_ = __builtin_amdgcn_s_memrealtime(); } while (0)
#define SEAM(k) do { if (IN(k) && IN((k) + 1)) for (int br_ = 0; br_ < BAR_REP; ++br_) xcd_barrier(bar); if ((k) == PROBE_TIME_PHASE) ptp_dt_ = __builtin_amdgcn_s_memrealtime() - ptp_t0_; } while (0)
    const int gw = F.vcu * NWAVES + F.wave, NGW = F.G * NWAVES;
    const int tok0 = (int)(((long)F.vcu * TT) / F.G), tok1 = (int)(((long)(F.vcu + 1) * TT) / F.G);

    PH_BEGIN(0);
    if (IN(0)) REP(0) { p0_prologue(F); __syncthreads(); }
    SEAM(0);
    PH_BEGIN(1);
    if (IN(1)) REP(1) {
        pg8::Gemm g{(const pg8::bf16_t*)(F.ws + WS_XN), (const pg8::bf16_t*)(F.ws + WS_WINT), TP, NP, DM}; pg8::StaticOrder S; S.init(TP, NP, F.G, (int)blockIdx.x, G1_WGM);
        pg8::EpiBf16<0> E{(pg8::bf16_t*)(F.ws + WS_P), PLD, nullptr, 0, 0, 1.f};
        pg8::gemm_phase<pg8::EpiBf16<0>, pg8::StaticOrder, G1_ALIGN, G1_SP2>((PG8_LAS unsigned char*)lds + RING_OFF, g, S, E);
#ifdef GEMM1_TWICE
        pg8::gemm_phase<pg8::EpiBf16<0>, pg8::StaticOrder, G1_ALIGN, G1_SP2>((PG8_LAS unsigned char*)lds + RING_OFF, g, S, E);
#endif
        { EpiSkBf16 Es{(bf16*)(F.ws + WS_P) + (size_t)TP * PLD, PLD, nullptr};
          for (int skr = 0; skr < SKREP; ++skr) for (int ng = F.vcu; ng < NP / 64; ng += F.G) skinny_gemm<4>(F, (const bf16*)(F.ws + WS_XN) + (size_t)TP * DM, (const bf16*)(F.ws + WS_WINT), 64 * ng, Es); }
    }
    SEAM(1);
    PH_BEGIN(2);
    if (IN(2)) REP(2) {
        if (F.G == 256) { for (int i = 0; i < 2; ++i) gla_prep_unit(F, (F.vcu >> 4) * 32 + 2 * (F.vcu & 15) + i); }
        else { for (int u = F.vcu; u < 512; u += F.G) gla_prep_unit(F, u); }
    }
    SEAM(2);
    PH_BEGIN(3);
    if (IN(3)) REP(3) {
#ifdef PROBE_TIME_MAIN
        const unsigned long long tm0_ = __builtin_amdgcn_s_memrealtime();
#endif
        if ((F.vcu & 1) == 0) { for (int g = F.vcu >> 1; g < 128; g += (F.G + 1) >> 1) gla_main_unit<4>(F, g >> 3, g & 7); }
#ifdef PROBE_TIME_MAIN
        probe_dt_ = __builtin_amdgcn_s_memrealtime() - tm0_;
#endif
        volatile LAS unsigned* qslot = (volatile LAS unsigned*)((LAS unsigned char*)lds + LDSCTL_OFF + 16);
#ifndef PROBE_STREAM
#define PROBE_STREAM 1
#endif
        for (int sr = 0; sr < PROBE_STREAM; ++sr) {
            if (sr > 0) xcd_barrier(bar);
            for (;;) {
                if (F.tid == 0) *qslot = __hip_atomic_fetch_add((unsigned*)(ctl + CW_QUEUE + 64 * (rep_ + 2 * sr)), 1u, __ATOMIC_RELAXED, __HIP_MEMORY_SCOPE_AGENT);
                __syncthreads();
                const unsigned u = *qslot;
                __syncthreads();
                if (u >= 512u) break;
                gla_sample_unit(F, (int)u);
            }
        }
    }
    SEAM(3);
    PH_BEGIN(4);
    if (IN(4)) REP(4) {
        bf16* MM = (bf16*)(F.ws + WS_MM);
        for (int it = gw; it < TP; it += NGW) mixer_rows<4>(F, 4 * (it >> 2), it & 3);
        for (int it = gw; it < 4 * TS; it += NGW) mixer_rows<1>(F, TP + (it >> 2), it & 3);
        for (int m = TT + gw; m < MP; m += NGW) zero_row_bf16(MM + (size_t)m * DM, F.lane);
    }
    SEAM(4);
    PH_BEGIN(5);
    if (IN(5)) REP(5) {
        pg8::Gemm g{(const pg8::bf16_t*)(F.ws + WS_MM), (const pg8::bf16_t*)(F.ws + WS_WOUTT), TP, DM, DM}; pg8::StaticOrder S; S.init(TP, DM, F.G, (int)blockIdx.x, G23_WGM);
        pg8::EpiF32Res E{F.xp, (pg8::bf16_t*)(F.ws + WS_H2), (float*)(F.ws + WS_SSQ), DM};
        pg8::gemm_phase<pg8::EpiF32Res, pg8::StaticOrder, true, true>((PG8_LAS unsigned char*)lds + RING_OFF, g, S, E);
#ifdef GEMM2_TWICE
        pg8::gemm_phase<pg8::EpiF32Res, pg8::StaticOrder, true, true>((PG8_LAS unsigned char*)lds + RING_OFF, g, S, E);
#endif
        { EpiSkF32Res Es{F.xs, (bf16*)(F.ws + WS_H2) + (size_t)TP * DM, (float*)(F.ws + WS_SSQS)};
          for (int skr = 0; skr < SKREP; ++skr) for (int un = F.vcu; un < DM / 8; un += F.G) skinny_gemm16(F, (const bf16*)(F.ws + WS_MM) + (size_t)TP * DM, (const bf16*)(F.ws + WS_WOUTT), 16 * (un >> 1), un & 1, Es); }
    }
    SEAM(5);
    PH_BEGIN(6);
    if (IN(6)) REP(6) {
        float* rs_s = (float*)(lds + 131072);
        float* rss_s = rs_s + 512;
        float* RS2 = (float*)(F.ws + WS_RS2);
        pg8::Gemm g{(const pg8::bf16_t*)(F.ws + WS_H2), (const pg8::bf16_t*)(F.ws + WS_WQT), TP, DM, DM}; pg8::StaticOrder S; S.init(TP, DM, F.G, (int)blockIdx.x, G23_WGM);
        { pg8::Unit u0;
          if (S.next(0, u0) && F.tid < 256) { const int row = u0.pm * 256 + F.tid; const f32x4* p = (const f32x4*)((const float*)(F.ws + WS_SSQ) + (size_t)row * 32); f32x4 a4 = p[0];
#pragma unroll
              for (int i = 1; i < 8; ++i) a4 += p[i];
              const float rstd = 1.0f / sqrtf(((a4.x + a4.y) + (a4.z + a4.w)) * (1.0f / DM) + EPS); rs_s[F.tid] = rstd; if (u0.pn == 0) RS2[row] = rstd; }
          if (F.tid >= 256 && F.tid < 384) { const int row = F.tid - 256; const f32x4* p = (const f32x4*)((const float*)(F.ws + WS_SSQS) + (size_t)row * 128); f32x4 a4 = p[0];
#pragma unroll
              for (int i = 1; i < 32; ++i) a4 += p[i];
              const float rstd = 1.0f / sqrtf(((a4.x + a4.y) + (a4.z + a4.w)) * (1.0f / DM) + EPS); rss_s[row] = rstd; if (F.vcu == 0) RS2[TP + row] = rstd; }
          __syncthreads(); }
        pg8::EpiBf16RowScale E{(pg8::bf16_t*)(F.ws + WS_QP), DM, rs_s};
        pg8::gemm_phase<pg8::EpiBf16RowScale, pg8::StaticOrder, true, true>((PG8_LAS unsigned char*)lds + RING_OFF, g, S, E);
#ifdef GEMM3_TWICE
        pg8::gemm_phase<pg8::EpiBf16RowScale, pg8::StaticOrder, true, true>((PG8_LAS unsigned char*)lds + RING_OFF, g, S, E);
#endif
        { EpiSkBf16 Es{(bf16*)(F.ws + WS_QP) + (size_t)TP * DM, DM, rss_s};
          for (int skr = 0; skr < SKREP; ++skr) for (int un = F.vcu; un < DM / 8; un += F.G) skinny_gemm16(F, (const bf16*)(F.ws + WS_H2) + (size_t)TP * DM, (const bf16*)(F.ws + WS_WQT), 16 * (un >> 1), un & 1, Es); }
    }
    SEAM(6);
    PH_BEGIN(7);
    if (IN(7)) REP(7) { bf16x8 qa[2][4]; peer_qfrags(F, tok0, qa); peer_load_subkeys(F); for (int tb = tok0; tb < tok1; tb += 8) peer_topk_tile(F, tb, tok1, qa); __syncthreads(); }
    SEAM(7);
    PH_BEGIN(8);
    if (IN(8)) REP(8) { peer_phase(F, tok0, tok1); }
    if (PROBE_TIME_PHASE == 8) ptp_dt_ = __builtin_amdgcn_s_memrealtime() - ptp_t0_;
    if (PROBE_TIME_PHASE >= 0 && F.vcu == 0) { const unsigned long long te_ = __builtin_amdgcn_s_memrealtime(); while (__builtin_amdgcn_s_memrealtime() - te_ < 9ull * ptp_dt_) __builtin_amdgcn_s_sleep(8); }
#ifdef PROBE_TIME_MAIN
    if (F.vcu == 0) { const unsigned long long te_ = __builtin_amdgcn_s_memrealtime(); while (__builtin_amdgcn_s_memrealtime() - te_ < 9ull * probe_dt_) __builtin_amdgcn_s_sleep(8); }
#endif
#undef IN
#undef SEAM
}

extern "C" void kernel_launch(void* const* d_in, const int* in_sizes, int n_in, void* d_out, int out_size, void* d_ws, size_t ws_size, hipStream_t stream) {
    static int grid = 0;
    if (grid == 0) {
        if (n_in != 18 || ws_size < WS_END) { fprintf(stderr, "kernel_launch: expected 18 inputs and >= %zu bytes of workspace; got %d, %zu\n", (size_t)WS_END, n_in, ws_size); grid = -1; return; }
        int dev = 0, cus = 0;
        if (hipGetDevice(&dev) != hipSuccess || hipDeviceGetAttribute(&cus, hipDeviceAttributeMultiprocessorCount, dev) != hipSuccess) { grid = -1; return; }
        if (hipFuncSetAttribute((const void*)mk_fwd, hipFuncAttributeMaxDynamicSharedMemorySize, LDS_BYTES) != hipSuccess) { fprintf(stderr, "kernel_launch: hipFuncSetAttribute failed\n"); grid = -1; return; }
        (void)hipGetLastError();
        grid = cus;
    }
    if (grid < 0) return;
    (void)hipMemsetAsync((char*)d_ws + WS_CTL, 0, CTL_ZERO_BYTES, stream);
    Args a{};
    for (int i = 0; i < 18; ++i) a.in[i] = (const float*)d_in[i];
    a.out = (float*)d_out; a.ws = (unsigned char*)d_ws;
    if (N_LAUNCHES == 1) { a.ph_lo = 0; a.ph_hi = N_PHASES; hipLaunchKernelGGL(mk_fwd, dim3(grid), dim3(NWAVES * 64), LDS_BYTES, stream, a); }
    else { for (int li = 0; li < N_PHASES; ++li) { a.ph_lo = li; a.ph_hi = li + 1; hipLaunchKernelGGL(mk_fwd, dim3(grid), dim3(NWAVES * 64), LDS_BYTES, stream, a); } }
}
```

```cpp
#include <hip/hip_runtime.h>
#include <cstdio>
#include <cstdint>
#include <cmath>
#define MK_N_LAUNCHES 1
namespace pg8 {
#define PG8_LAS __attribute__((address_space(3)))
typedef unsigned short bf16_t;
typedef short bf16x8 __attribute__((ext_vector_type(8)));
typedef float f32x4 __attribute__((ext_vector_type(4)));
typedef unsigned u32x4 __attribute__((ext_vector_type(4)));
constexpr int BM = 256, BK = 64, HALF = 128, HTB = HALF * BK * 2  , STAGE_BYTES = 8 * HTB, NXCD = 8;
#ifndef PG8_WGM
#define PG8_WGM 3
#endif
constexpr int WGM = PG8_WGM;

__host__ __device__ __forceinline__ int lds_byte(int r, int c) { const int st = (r >> 4) * 2 + (c >> 5), rr = r & 15, cc = c & 31, ob = rr * 64 + cc * 2; return st * 1024 + (ob ^ (((ob >> 9) & 1) << 5)); }
__host__ __device__ __forceinline__ void stage_rc(int b, int& R, int& C) { const int st = b / 1024, sb = b % 1024, swz = sb ^ (((sb >> 9) & 1) << 5); R = (st >> 1) * 16 + swz / 64; C = (st & 1) * 32 + (swz % 64) / 2; }
__host__ __device__ __forceinline__ int perm32(int rho) { const int n = rho >> 4, i = rho & 15; return 8 * (i >> 2) + 4 * n + (i & 3); }

struct Unit { int pm, pn; };
struct Gemm { const bf16_t* A; const bf16_t* Bt; int M, N, K; };

struct StaticOrder {
    int nM, nN, nwg, G, c, wgm;
    __host__ __device__ void init(int M, int N, int G_, int c_, int wgm_ = WGM) { nM = M / BM; nN = N / BM; nwg = nM * nN; G = G_; c = c_; wgm = wgm_; }
    __host__ __device__ bool next(int i, Unit& u) const {
        const long L = (long)i * G + c; if (L >= nwg) return false;
        int wgid = (int)L; if (wgm > 0) { const int q = nwg / NXCD, r = nwg % NXCD, xcd = wgid % NXCD, off = wgid / NXCD; wgid = (xcd < r ? xcd * (q + 1) : r * (q + 1) + (xcd - r) * q) + off; }
        const int wgm = this->wgm > 0 ? this->wgm : -this->wgm;
        const int nig = wgm * nN, gid = wgid / nig, fm = gid * wgm, gsz = (nM - fm) < wgm ? (nM - fm) : wgm;
        u.pm = fm + ((wgid % nig) % gsz); u.pn = (wgid % nig) / gsz; return true;
    }
    __device__ __forceinline__ void a_ready(const Unit&) const {}
    __device__ __forceinline__ void done(const Unit&) const {}
};

__device__ __forceinline__ unsigned cvt_pk_bf16(float lo, float hi) { unsigned r; asm volatile("v_cvt_pk_bf16_f32 %0, %1, %2" : "=v"(r) : "v"(lo), "v"(hi)); return r; }
typedef float f32x2 __attribute__((ext_vector_type(2)));
__device__ __forceinline__ f32x2 gelu_pk(f32x2 v) {
    const f32x2 av = __builtin_elementwise_abs(v), d = av * 0.2316418882f + 1.0f;
    f32x2 t; t.x = __builtin_amdgcn_rcpf(d.x); t.y = __builtin_amdgcn_rcpf(d.y);
    f32x2 q = t * 0.5307027145f + (-0.7265760135f); q = q * t + 0.7107068705f; q = q * t + (-0.142248368f); q = q * t + 0.127414796f; q = q * t;
    const f32x2 s = (v * v) * (-0.72134752044f);
    f32x2 e; e.x = __builtin_amdgcn_exp2f(s.x); e.y = __builtin_amdgcn_exp2f(s.y);
    const f32x2 m = v * (q * e), r = v - m;
    f32x2 o; o.x = v.x < 0.f ? m.x : r.x; o.y = v.y < 0.f ? m.y : r.y; return o;
}

template <int ACT  > struct EpiBf16 {
    static constexpr bool PERM = true, AFTER_DRAIN = false; static_assert(ACT == 0 || ACT == 1, "EpiBf16: ACT is 0 (none) or 1 (gelu_pk)");
    bf16_t* O; int ldc; const float* bias; int split_cols; size_t split_stride; float scale0;
    __device__ __forceinline__ void operator()(const f32x4 (&acc)[2][2][4][2], const Unit& u, int wr, int wc, int fr, int fq) const {
        const int row0 = u.pm * BM + wr * 64 + fr; int colt = u.pn * BM; bf16_t* base = O;
        float sc = 1.f; if (split_cols) { const int t = colt / split_cols; base += (size_t)t * split_stride; colt -= t * split_cols; if (t == 0) sc = scale0; }
        const int col0 = colt + wc * 32 + 8 * fq, bcol0 = u.pn * BM + wc * 32 + 8 * fq;
        f32x4 bv[2][2];
#pragma unroll
        for (int bj = 0; bj < 2; ++bj)
#pragma unroll
            for (int n = 0; n < 2; ++n) bv[bj][n] = bias ? *(const f32x4*)(bias + bcol0 + bj * HALF + 4 * n) : (f32x4){0.f, 0.f, 0.f, 0.f};
#pragma unroll
        for (int ai = 0; ai < 2; ++ai)
#pragma unroll
            for (int m = 0; m < 4; ++m) { bf16_t* rowp = base + (size_t)(row0 + ai * HALF + m * 16) * ldc + col0;
#pragma unroll
                for (int bj = 0; bj < 2; ++bj) { f32x4 v0 = acc[ai][bj][m][0] + bv[bj][0], v1 = acc[ai][bj][m][1] + bv[bj][1];
                    if (ACT == 1) { f32x2 a = gelu_pk((f32x2){v0[0], v0[1]}), b = gelu_pk((f32x2){v0[2], v0[3]}), c = gelu_pk((f32x2){v1[0], v1[1]}), d = gelu_pk((f32x2){v1[2], v1[3]});
                        v0 = (f32x4){a.x, a.y, b.x, b.y}; v1 = (f32x4){c.x, c.y, d.x, d.y}; }
                    v0 = v0 * sc; v1 = v1 * sc; u32x4 w; w.x = cvt_pk_bf16(v0[0], v0[1]); w.y = cvt_pk_bf16(v0[2], v0[3]); w.z = cvt_pk_bf16(v1[0], v1[1]); w.w = cvt_pk_bf16(v1[2], v1[3]);
                    __builtin_nontemporal_store(w, (u32x4*)(rowp + bj * HALF)); } }
    }
};
template <class Epi, class Sched, bool ALIGN_EPI = false, bool SP2 = false>
__device__ __forceinline__ void gemm_phase(PG8_LAS unsigned char* lds, const Gemm g, const Sched& S, const Epi& E) {
    const int tid = threadIdx.x, wid = __builtin_amdgcn_readfirstlane(tid >> 6), lane = tid & 63, wr = wid >> 2, wc = wid & 3, fr = lane & 15, fq = lane >> 4;
    const int K = g.K, nt = K / BK;
    unsigned voffA[2], voffB[2];
#pragma unroll
    for (int i = 0; i < 2; ++i) { int R, C; stage_rc(tid * 16 + i * 8192, R, C); const int Rb = Epi::PERM ? ((R & ~31) + perm32(R & 31)) : R;
        voffA[i] = (unsigned)(R * K + C) * 2u; voffB[i] = (unsigned)(Rb * K + C) * 2u; }
    const size_t kstep = (size_t)(BK * 2);
    const size_t hstep = (size_t)HALF * K * 2;
    const size_t tstep = 2 * hstep;
    const unsigned ldsw = (unsigned)wid * 1024u;
    const int aoff = lds_byte(wr * 64 + fr, fq * 8), boff = lds_byte(wc * 32 + fr, fq * 8);
#define PG8_SA(b, h) (((b) * 2 + (h)) * HTB)
#define PG8_SB(b, h) ((4 + (b) * 2 + (h)) * HTB)
#define PG8_STAGE(bufoff, gbase, voff) do { _Pragma("unroll") for (int _i = 0; _i < 2; ++_i) \
        __builtin_amdgcn_global_load_lds((const unsigned*)((const char*)(gbase) + (voff)[_i]), (PG8_LAS unsigned*)(lds + (bufoff) + ldsw + _i * 8192), 16, 0, 0); } while (0)
#define PG8_LDA(dst, b, h) do { _Pragma("unroll") for (int m = 0; m < 4; ++m) _Pragma("unroll") for (int k = 0; k < 2; ++k) dst[m][k] = *(const PG8_LAS bf16x8*)(lds + PG8_SA(b, h) + aoff + m * 2048 + k * 1024); } while (0)
#define PG8_LDB(dst, b, h) do { _Pragma("unroll") for (int n = 0; n < 2; ++n) _Pragma("unroll") for (int k = 0; k < 2; ++k) dst[n][k] = *(const PG8_LAS bf16x8*)(lds + PG8_SB(b, h) + boff + n * 2048 + k * 1024); } while (0)
#define PG8_MMA(ai, bj, At, Bt) do { __builtin_amdgcn_s_setprio(1); _Pragma("unroll") for (int m = 0; m < 4; ++m) _Pragma("unroll") for (int n = 0; n < 2; ++n) _Pragma("unroll") for (int k = 0; k < 2; ++k) \
        acc[ai][bj][m][n] = __builtin_amdgcn_mfma_f32_16x16x32_bf16(Bt[n][k], At[m][k], acc[ai][bj][m][n], 0, 0, 0); __builtin_amdgcn_s_setprio(0); } while (0)
#define PG8_WAIT_V(n) asm volatile("s_waitcnt vmcnt(" #n ")" ::: "memory")
#define PG8_WAIT_L(n) asm volatile("s_waitcnt lgkmcnt(" #n ")" ::: "memory")
#define PG8_BAR __builtin_amdgcn_s_barrier()
#define PG8_SCHED __builtin_amdgcn_sched_barrier(0)
    Unit cur, nxt; int ui = 0;
    if (!S.next(0, cur)) return;
    f32x4 acc[2][2][4][2];
#pragma unroll
    for (int a = 0; a < 2; ++a)
#pragma unroll
        for (int b = 0; b < 2; ++b)
#pragma unroll
            for (int m = 0; m < 4; ++m)
#pragma unroll
                for (int n = 0; n < 2; ++n) acc[a][b][m][n] = (f32x4){0.f, 0.f, 0.f, 0.f};
    bf16x8 At[4][2], B0[2][2], B1[2][2];
    const char* cA = (const char*)g.A + (size_t)cur.pm * tstep; const char* cB = (const char*)g.Bt + (size_t)cur.pn * tstep;
    S.a_ready(cur);
    if constexpr (SP2) {
        PG8_STAGE(PG8_SB(0, 0), cB, voffB); PG8_STAGE(PG8_SB(0, 1), cB + hstep, voffB); PG8_STAGE(PG8_SA(0, 0), cA, voffA); PG8_STAGE(PG8_SA(0, 1), cA + hstep, voffA);
        if (wr == 1) PG8_BAR;
        PG8_WAIT_V(2); PG8_BAR;
        PG8_STAGE(PG8_SB(1, 0), cB + kstep, voffB); PG8_STAGE(PG8_SA(1, 0), cA + kstep, voffA); PG8_STAGE(PG8_SB(1, 1), cB + hstep + kstep, voffB);
        PG8_WAIT_V(6); PG8_BAR;
    } else {
        PG8_STAGE(PG8_SB(0, 0), cB, voffB); PG8_STAGE(PG8_SA(0, 0), cA, voffA); PG8_STAGE(PG8_SB(0, 1), cB + hstep, voffB); PG8_STAGE(PG8_SA(0, 1), cA + hstep, voffA);
        if (wr == 1) PG8_BAR;
        PG8_WAIT_V(4); PG8_BAR;
        PG8_STAGE(PG8_SB(1, 0), cB + kstep, voffB); PG8_STAGE(PG8_SA(1, 0), cA + kstep, voffA); PG8_STAGE(PG8_SB(1, 1), cB + hstep + kstep, voffB);
        PG8_WAIT_V(6); PG8_BAR;
    }
    for (;;) {
        const bool has_next = S.next(ui + 1, nxt);
        const char* nA = has_next ? (const char*)g.A + (size_t)nxt.pm * tstep : cA; const char* nB = has_next ? (const char*)g.Bt + (size_t)nxt.pn * tstep : cB;
        for (int t = 0; t < nt; t += 2) {
            const bool last = (t == nt - 2);
            const char* a1 = cA + (size_t)(t + 1) * kstep;
            const char* a2 = last ? nA : cA + (size_t)(t + 2) * kstep; const char* b2 = last ? nB : cB + (size_t)(t + 2) * kstep;
            const char* a3 = a2 + kstep; const char* b3 = b2 + kstep;
            if (last && has_next) S.a_ready(nxt);
            if constexpr (SP2) {
            PG8_LDB(B0, 0, 0); PG8_LDB(B1, 0, 1); PG8_SCHED; PG8_LDA(At, 0, 0); PG8_STAGE(PG8_SA(1, 1), a1 + hstep, voffA);
            PG8_WAIT_V(8); PG8_WAIT_L(0); PG8_BAR; PG8_MMA(0, 0, At, B0); PG8_MMA(0, 1, At, B1); PG8_BAR; PG8_SCHED;
            PG8_LDA(At, 0, 1); PG8_STAGE(PG8_SB(0, 0), b2, voffB); PG8_STAGE(PG8_SB(0, 1), b2 + hstep, voffB); PG8_STAGE(PG8_SA(0, 0), a2, voffA);
            PG8_WAIT_V(8); PG8_WAIT_L(0); PG8_BAR; PG8_MMA(1, 0, At, B0); PG8_MMA(1, 1, At, B1); PG8_BAR; PG8_SCHED;
            PG8_LDB(B0, 1, 0); PG8_LDB(B1, 1, 1); PG8_SCHED; PG8_LDA(At, 1, 0); PG8_STAGE(PG8_SA(0, 1), a2 + hstep, voffA);
            PG8_WAIT_V(8); PG8_WAIT_L(0); PG8_BAR; PG8_MMA(0, 0, At, B0); PG8_MMA(0, 1, At, B1); PG8_BAR; PG8_SCHED;
            PG8_LDA(At, 1, 1); PG8_STAGE(PG8_SB(1, 0), b3, voffB); PG8_STAGE(PG8_SB(1, 1), b3 + hstep, voffB); PG8_STAGE(PG8_SA(1, 0), a3, voffA);
            PG8_WAIT_V(8); PG8_WAIT_L(0); PG8_BAR; PG8_MMA(1, 0, At, B0); PG8_MMA(1, 1, At, B1); PG8_BAR; PG8_SCHED;
            } else {
            PG8_LDB(B0, 0, 0); PG8_SCHED; PG8_LDA(At, 0, 0); PG8_STAGE(PG8_SA(1, 1), a1 + hstep, voffA);
            PG8_WAIT_L(8); PG8_BAR; PG8_WAIT_L(0); PG8_MMA(0, 0, At, B0); PG8_BAR; PG8_SCHED;
            PG8_LDB(B1, 0, 1); PG8_STAGE(PG8_SB(0, 0), b2, voffB);
            PG8_BAR; PG8_WAIT_L(0); PG8_MMA(0, 1, At, B1); PG8_BAR;
            PG8_LDA(At, 0, 1); PG8_STAGE(PG8_SA(0, 0), a2, voffA);
            PG8_BAR; PG8_WAIT_L(0); PG8_MMA(1, 0, At, B0); PG8_BAR; PG8_SCHED;
            PG8_STAGE(PG8_SB(0, 1), b2 + hstep, voffB);
            PG8_WAIT_V(6); PG8_BAR; PG8_MMA(1, 1, At, B1); PG8_BAR;
            PG8_LDB(B0, 1, 0); PG8_SCHED; PG8_LDA(At, 1, 0); PG8_STAGE(PG8_SA(0, 1), a2 + hstep, voffA);
            PG8_WAIT_L(8); PG8_BAR; PG8_WAIT_L(0); PG8_MMA(0, 0, At, B0); PG8_BAR; PG8_SCHED;
            PG8_LDB(B1, 1, 1); PG8_STAGE(PG8_SB(1, 0), b3, voffB);
            PG8_BAR; PG8_WAIT_L(0); PG8_MMA(0, 1, At, B1); PG8_BAR;
            PG8_LDA(At, 1, 1); PG8_STAGE(PG8_SA(1, 0), a3, voffA);
            PG8_BAR; PG8_WAIT_L(0); PG8_MMA(1, 0, At, B0); PG8_BAR; PG8_SCHED;
            PG8_STAGE(PG8_SB(1, 1), b3 + hstep, voffB);
            PG8_WAIT_V(6); PG8_BAR; PG8_MMA(1, 1, At, B1); PG8_BAR;
            }
        }
        if constexpr (ALIGN_EPI) { if (wr == 0) PG8_BAR; }
        if constexpr (!Epi::AFTER_DRAIN) { E(acc, cur, wr, wc, fr, fq); S.done(cur); }
        if (!has_next) break;
#pragma unroll
        for (int a = 0; a < 2; ++a)
#pragma unroll
            for (int b = 0; b < 2; ++b)
#pragma unroll
                for (int m = 0; m < 4; ++m)
#pragma unroll
                    for (int n = 0; n < 2; ++n) acc[a][b][m][n] = (f32x4){0.f, 0.f, 0.f, 0.f};
        cur = nxt; cA = nA; cB = nB; ++ui;
        if constexpr (ALIGN_EPI) { if (wr == 1) PG8_BAR; }
    }
    PG8_WAIT_V(0);
    if constexpr (!ALIGN_EPI) { if (wr == 0) PG8_BAR; }
    PG8_BAR;
    if constexpr (Epi::AFTER_DRAIN) { E.fused(acc, cur, wr, wc, fr, fq, lds, wid, lane); S.done(cur); }
#undef PG8_SA
#undef PG8_SB
#undef PG8_STAGE
#undef PG8_LDA
#undef PG8_LDB
#undef PG8_MMA
#undef PG8_WAIT_V
#undef PG8_WAIT_L
#undef PG8_BAR
#undef PG8_SCHED
}
}
namespace pg8 {
struct EpiF32Res {
    static constexpr bool PERM = false, AFTER_DRAIN = false;
    const float* xp; bf16_t* outb; float* ssq; int ldc;
    __device__ __forceinline__ void operator()(const f32x4 (&acc)[2][2][4][2], const Unit& u, int wr, int wc, int fr, int fq) const {
        const int col0 = u.pn * BM + wc * 32 + 4 * fq;
#pragma unroll
        for (int ai = 0; ai < 2; ++ai)
#pragma unroll
            for (int m = 0; m < 4; ++m) {
                const int row = u.pm * BM + ai * HALF + wr * 64 + m * 16 + fr;
                const float* src = xp + (size_t)row * ldc; bf16_t* dstb = outb + (size_t)row * ldc;
                float s = 0.f;
#pragma unroll
                for (int bj = 0; bj < 2; ++bj)
#pragma unroll
                    for (int n = 0; n < 2; ++n) { const int c = col0 + bj * HALF + n * 16; const f32x4 v = *(const f32x4*)(src + c) + acc[ai][bj][m][n];
                        s += (v[0] * v[0] + v[1] * v[1]) + (v[2] * v[2] + v[3] * v[3]);
                        typedef unsigned u32x2 __attribute__((ext_vector_type(2))); *(u32x2*)(dstb + c) = (u32x2){cvt_pk_bf16(v[0], v[1]), cvt_pk_bf16(v[2], v[3])}; }
                s += __shfl_xor(s, 16); s += __shfl_xor(s, 32);
                if (fq == 0) ssq[(size_t)row * 32 + u.pn * 4 + wc] = s;
            }
    }
};
struct EpiBf16RowScale {
    static constexpr bool PERM = true, AFTER_DRAIN = false;
    bf16_t* O; int ldc; const float* rs;
    __device__ __forceinline__ void operator()(const f32x4 (&acc)[2][2][4][2], const Unit& u, int wr, int wc, int fr, int fq) const {
        const int row0 = u.pm * BM + wr * 64 + fr, col0 = u.pn * BM + wc * 32 + 8 * fq;
#pragma unroll
        for (int ai = 0; ai < 2; ++ai)
#pragma unroll
            for (int m = 0; m < 4; ++m) { const int rl = wr * 64 + fr + ai * HALF + m * 16; const float sc = rs[rl]; bf16_t* rowp = O + (size_t)(row0 + ai * HALF + m * 16) * ldc + col0;
#pragma unroll
                for (int bj = 0; bj < 2; ++bj) { const f32x4 v0 = acc[ai][bj][m][0] * sc, v1 = acc[ai][bj][m][1] * sc;
                    u32x4 w; w.x = cvt_pk_bf16(v0[0], v0[1]); w.y = cvt_pk_bf16(v0[2], v0[3]); w.z = cvt_pk_bf16(v1[0], v1[1]); w.w = cvt_pk_bf16(v1[2], v1[3]);
                    *(u32x4*)(rowp + bj * HALF) = w; } }
    }
};
}

#ifndef MK_N_LAUNCHES
#define MK_N_LAUNCHES 1
#endif
constexpr int N_PHASES = 9;
constexpr int N_LAUNCHES = MK_N_LAUNCHES;
constexpr int NWAVES = 8;

constexpr int DM = 2048;
constexpr int TP = 8192, TS = 128, TT = TP + TS;
constexpr int MP = 8448;
constexpr int NP = 16384;
constexpr int PLD = NP + 64;
constexpr int C_Q = 0, C_K = 1024, C_V = 2048, C_R = 4096, C_CB = 6144, C_CC = 8192, C_CX = 10240, C_GA = 12288, C_GB = 14336;
constexpr int DIN = 16400;
constexpr int NEXP = 16384;
constexpr float EPS = 1e-6f;

constexpr size_t MiB = 1u << 20;
constexpr size_t WS_CTL = 0, CTL_ZERO_BYTES = 128 * 1024;
constexpr size_t WS_WINT = 2 * MiB;
constexpr size_t WS_WOUTT = 68 * MiB;
constexpr size_t WS_WQT = 76 * MiB;
constexpr size_t WS_EU = 84 * MiB;
constexpr size_t WS_EV = 148 * MiB;
constexpr size_t WS_XN = 212 * MiB;
constexpr size_t WS_P = 246 * MiB;
constexpr size_t WS_QT = 516 * MiB;
constexpr size_t WS_KT = 532 * MiB;
constexpr size_t WS_VT = 548 * MiB;
constexpr size_t WS_ATT = 580 * MiB;
constexpr size_t WS_EBL = 584 * MiB;
constexpr size_t WS_SKB = 585 * MiB;
constexpr size_t WS_O = 586 * MiB;
constexpr size_t WS_MM = 620 * MiB;
constexpr size_t WS_X2 = 654 * MiB;
constexpr size_t WS_H2 = 720 * MiB;
constexpr size_t WS_SSQ = 799 * MiB;
constexpr size_t WS_QP = 754 * MiB;
constexpr size_t WS_IDX = 788 * MiB;
constexpr size_t WS_GW = 793 * MiB;
constexpr size_t WS_ALR = 798 * MiB;
constexpr size_t WS_SSQS = 799 * MiB + 1100 * 1024;
constexpr size_t WS_RS2 = 799 * MiB + 1200 * 1024;
constexpr size_t WS_END = 801 * MiB;
constexpr int CW_TMO = 0, CW_CODE = 1, CW_BAR = 4096, CW_QUEUE = 16384;

constexpr size_t OUT_Y = 0;
constexpr size_t OUT_GLAP = (size_t)TT * DM;
constexpr size_t OUT_CONVP = OUT_GLAP + (size_t)4 * 4 * 256 * 512;
constexpr size_t OUT_GLAS = OUT_CONVP + (size_t)4 * 2 * 2048;
constexpr size_t OUT_CONVS = OUT_GLAS + (size_t)128 * 4 * 256 * 512;

constexpr int LDS_BYTES = 163840;
constexpr int LDSCTL_OFF = 162816, MISC_OFF = LDSCTL_OFF + 320;
constexpr int RING_OFF = 0;

#define GAS __attribute__((address_space(1)))
#define LAS __attribute__((address_space(3)))
typedef unsigned short bf16;
typedef unsigned v4u __attribute__((ext_vector_type(4)));
typedef unsigned v2u __attribute__((ext_vector_type(2)));
typedef float f32x4 __attribute__((ext_vector_type(4)));
typedef short bf16x8 __attribute__((ext_vector_type(8)));
typedef GAS unsigned gu32;
typedef float v32f __attribute__((ext_vector_type(32)));
typedef float v16f __attribute__((ext_vector_type(16)));
typedef float f32x2 __attribute__((ext_vector_type(2)));
typedef unsigned v6u __attribute__((ext_vector_type(6)));
constexpr int ROW6 = 1536, ROW4 = 1024;
#define RLX_AGENT __ATOMIC_RELAXED, __HIP_MEMORY_SCOPE_AGENT
#define LDS_WAIT() asm volatile("s_waitcnt lgkmcnt(0)" ::: "memory")
#define VM_WAIT() asm volatile("s_waitcnt vmcnt(0)" ::: "memory")
#define MFMA16(a, b, c) __builtin_amdgcn_mfma_f32_16x16x32_bf16((a), (b), (c), 0, 0, 0)
__device__ __forceinline__ unsigned f2bf(float f) { unsigned u = __builtin_bit_cast(unsigned, f); return (u + 0x7fffu + ((u >> 16) & 1u)) >> 16; }
__device__ __forceinline__ unsigned pk2(float lo, float hi) { return f2bf(lo) | (f2bf(hi) << 16); }
__device__ __forceinline__ float bf2f(unsigned b) { return __builtin_bit_cast(float, b << 16); }
__device__ __forceinline__ float bflo(unsigned w) { return __builtin_bit_cast(float, w << 16); }
__device__ __forceinline__ float bfhi(unsigned w) { return __builtin_bit_cast(float, w & 0xffff0000u); }
__device__ __forceinline__ void unpack8(const v4u w, float (&f)[8]) { f[0] = bflo(w.x); f[1] = bfhi(w.x); f[2] = bflo(w.y); f[3] = bfhi(w.y); f[4] = bflo(w.z); f[5] = bfhi(w.z); f[6] = bflo(w.w); f[7] = bfhi(w.w); }
__device__ __forceinline__ v4u pack8(const float (&f)[8]) { v4u w; w.x = pk2(f[0], f[1]); w.y = pk2(f[2], f[3]); w.z = pk2(f[4], f[5]); w.w = pk2(f[6], f[7]); return w; }
__device__ __forceinline__ float wave_sum(float v) {
#pragma unroll
    for (int o = 1; o < 64; o <<= 1) v += __shfl_xor(v, o);
    return v;
}
__device__ __forceinline__ float sigmoidf_(float x) { return 1.0f / (1.0f + __expf(-x)); }
__device__ __forceinline__ float wave_sum_dpp(float v) {
#define DPP_ADD_(ctrl, rmask) v += __builtin_bit_cast(float, __builtin_amdgcn_update_dpp(0, __builtin_bit_cast(int, v), ctrl, rmask, 0xF, false))
    DPP_ADD_(0xB1, 0xF);
    DPP_ADD_(0x4E, 0xF);
    DPP_ADD_(0x141, 0xF);
    DPP_ADD_(0x140, 0xF);
    DPP_ADD_(0x142, 0xA);
    DPP_ADD_(0x143, 0xC);
#undef DPP_ADD_
    return __builtin_bit_cast(float, __builtin_amdgcn_readlane(__builtin_bit_cast(int, v), 63));
}
__device__ __forceinline__ float gelu_erf(float v) {
    const float t = __builtin_amdgcn_rcpf(fabsf(v) * 0.2316418882f + 1.0f);
    float q = t * 0.5307027145f + (-0.7265760135f); q = q * t + 0.7107068705f; q = q * t + (-0.142248368f); q = q * t + 0.127414796f; q = q * t;
    const float e = __builtin_amdgcn_exp2f((v * v) * (-0.72134752044f));
    const float m = v * (q * e);
    return v < 0.f ? m : v - m;
}
#define XB_TMO      128
#define XB_XCNT(j)  (256  + 64 * (j))
#define XB_XSUB(j)  (1280 + 64 * (j))
#define XB_XGEN(j)  (2304 + 64 * (j))
#define XB_TOP      3328
#define XB_TOPGEN   3392
#define XCD_BAR_WORDS 3456
#define XB_SPIN_CAP (1u << 18)

__device__ __forceinline__ unsigned xb_ld(unsigned* p)              { return __hip_atomic_load(p, __ATOMIC_RELAXED, __HIP_MEMORY_SCOPE_AGENT); }
__device__ __forceinline__ unsigned xb_add(unsigned* p, unsigned v) { return __hip_atomic_fetch_add(p, v, __ATOMIC_RELAXED, __HIP_MEMORY_SCOPE_AGENT); }
__device__ __forceinline__ unsigned xb_xcc_id() { return (unsigned)__builtin_amdgcn_s_getreg((3 << 11) | 20) & 0xFu; }
#define XB_SPIN(cond, bar) do { unsigned _sp = 0; while (cond) { __builtin_amdgcn_s_sleep(1); \
    if ((++_sp & 255u) == 0u) { if (xb_ld(&(bar)[XB_TMO])) break; if (_sp > XB_SPIN_CAP) { atomicAdd(&(bar)[XB_TMO], 1u); break; } } } } while (0)

struct XcdBarrier {
    unsigned* bar; unsigned x;
    volatile LAS unsigned* st;
};

__device__ __forceinline__ XcdBarrier xcd_barrier_post(unsigned* bar, volatile LAS unsigned* st) {
    XcdBarrier b; b.bar = bar; b.x = xb_xcc_id(); b.st = st;
    if (threadIdx.x == 0) (void)xb_add(&bar[XB_XCNT(b.x)], 1u);
    return b;
}
__device__ __forceinline__ void xcd_barrier_complete(unsigned* bar, unsigned x, unsigned& nloc, unsigned& nx) {
    const unsigned G = gridDim.x * gridDim.y * gridDim.z;
    unsigned sum, cnt, mine, sp = 0u;
    for (;;) {
        sum = 0u; cnt = 0u; mine = 0u;
#pragma unroll
        for (unsigned j = 0; j < 16; ++j) { const unsigned c = xb_ld(&bar[XB_XCNT(j)]); sum += c; cnt += (c > 0u) ? 1u : 0u; mine = (j == x) ? c : mine; }
        if (sum == G) break;
        __builtin_amdgcn_s_sleep(1);
        if ((++sp & 255u) == 0u) { if (xb_ld(&bar[XB_TMO])) break; if (sp > XB_SPIN_CAP) { atomicAdd(&bar[XB_TMO], 1u); break; } }
    }
    nloc = mine > 0u ? mine : 1u; nx = cnt > 0u ? cnt : 1u;
}

__device__ __forceinline__ void xcd_barrier(const XcdBarrier& b) {
    asm volatile("s_waitcnt vmcnt(0)" ::: "memory");
    __syncthreads();
    if (threadIdx.x == 0) {
        unsigned* bar = b.bar;
        __builtin_amdgcn_s_waitcnt(0);
        unsigned nloc = b.st[0], nx = b.st[1];
        if (nloc == 0u) { xcd_barrier_complete(bar, b.x, nloc, nx); b.st[0] = nloc; b.st[1] = nx; }
        const unsigned old = xb_add(&bar[XB_XSUB(b.x)], 1u);
        const unsigned gen = old / nloc;
        if (old + 1u == (gen + 1u) * nloc) {
            __builtin_amdgcn_fence(__ATOMIC_RELEASE, "agent");
            asm volatile("s_waitcnt vmcnt(0)" ::: "memory");
            const unsigned og = xb_add(&bar[XB_TOP], 1u);
            const unsigned tg = og / nx;
            if (og + 1u == (tg + 1u) * nx) xb_add(&bar[XB_TOPGEN], 1u);
            else XB_SPIN(xb_ld(&bar[XB_TOPGEN]) == tg, bar);
            __builtin_amdgcn_fence(__ATOMIC_ACQUIRE, "agent");
            xb_add(&bar[XB_XGEN(b.x)], 1u);
            asm volatile("s_waitcnt vmcnt(0)" ::: "memory");
        } else {
            XB_SPIN(xb_ld(&bar[XB_XGEN(b.x)]) == gen, bar);
            __builtin_amdgcn_fence(__ATOMIC_ACQUIRE, "agent");
            asm volatile("s_waitcnt vmcnt(0)" ::: "memory");
        }
    }
    __syncthreads();
}
struct Frame {
    unsigned char* lds;
    int tid, lane, wave, vcu, G;
    const float *xp, *xs, *sgla, *sconv, *n1g, *win, *wau, *bal, *gng, *cw, *cb, *wout, *n2g, *wq, *sk, *eu, *ev, *nfg;
    float* out;
    unsigned char* ws;
};

__device__ __forceinline__ void p0_transpose_item(const float* W, int ldw, int src_col0, int k0, bf16* WT, int K, int dst_row0, float* scr, int lane, const float* kscale = nullptr) {
    const int n4 = lane & 15, kr = lane >> 4;
#pragma unroll 8
    for (int i = 0; i < 16; ++i) { const int kk = 4 * i + kr; f32x4 v = __builtin_nontemporal_load((const f32x4*)(W + (size_t)(k0 + kk) * ldw + src_col0 + 4 * n4)); if (kscale) v = v * kscale[k0 + kk];
        float* d = scr + kk * 65 + 4 * n4; d[0] = v.x; d[1] = v.y; d[2] = v.z; d[3] = v.w; }
    LDS_WAIT(); asm volatile("" ::: "memory");
    const int c = lane & 7, nr = lane >> 3;
#pragma unroll
    for (int j = 0; j < 8; ++j) { const int n = nr + 8 * j; const float* s = scr + (8 * c) * 65 + n;
        v4u o; o.x = pk2(s[0 * 65], s[1 * 65]); o.y = pk2(s[2 * 65], s[3 * 65]); o.z = pk2(s[4 * 65], s[5 * 65]); o.w = pk2(s[6 * 65], s[7 * 65]);
        *(v4u*)(WT + (size_t)(dst_row0 + n) * K + k0 + 8 * c) = o; }
    LDS_WAIT(); asm volatile("" ::: "memory");
}
__device__ __forceinline__ void rms_row_to_bf16(const float* xrow, const float* g, bf16* orow, int lane) {
    const f32x4* xr = (const f32x4*)xrow + lane; const f32x4* gr = (const f32x4*)g + lane;
    f32x4 v[8]; float s = 0.f;
#pragma unroll
    for (int j = 0; j < 8; ++j) { v[j] = __builtin_nontemporal_load(xr + 64 * j); s += (v[j].x * v[j].x + v[j].y * v[j].y) + (v[j].z * v[j].z + v[j].w * v[j].w); }
    const float rstd = 1.0f / sqrtf(wave_sum(s) * (1.0f / DM) + EPS);
    v2u* o8 = (v2u*)orow + lane;
#pragma unroll
    for (int j = 0; j < 8; ++j) { const f32x4 gg = gr[64 * j]; v2u w; w.x = pk2(v[j].x * rstd * gg.x, v[j].y * rstd * gg.y); w.y = pk2(v[j].z * rstd * gg.z, v[j].w * rstd * gg.w); o8[64 * j] = w; }
}
__device__ __forceinline__ void zero_row_bf16(bf16* orow, int lane) {
    v2u* o8 = (v2u*)orow + lane; const v2u z = {0u, 0u};
#pragma unroll
    for (int j = 0; j < 8; ++j) o8[64 * j] = z;
}
__device__ __forceinline__ void p0_prologue(Frame& F) {
    bf16* WINT = (bf16*)(F.ws + WS_WINT); bf16* WOUTT = (bf16*)(F.ws + WS_WOUTT); bf16* WQT = (bf16*)(F.ws + WS_WQT);
    float* scr = (float*)(F.lds + F.wave * 16640);
    const int gw = F.vcu * NWAVES + F.wave, NGW = F.G * NWAVES;
    constexpr int I_IN = 32 * 256, I_SQ = 32 * 32;
    for (int it = gw; it < I_IN + 2 * I_SQ; it += NGW) {
        int r = it;
        if (r < I_IN) { const int kb = r >> 8, nb = r & 255, n0 = 64 * nb; p0_transpose_item(F.win, DIN, n0 + (n0 >= 6144 ? 16 : 0), 64 * kb, WINT, DM, n0, scr, F.lane); continue; }
        r -= I_IN;
        if (r < I_SQ) { const int kb = r >> 5, nb = r & 31; p0_transpose_item(F.wout, DM, 64 * nb, 64 * kb, WOUTT, DM, 64 * nb, scr, F.lane); continue; }
        r -= I_SQ;
        { const int kb = r >> 5, nb = r & 31; p0_transpose_item(F.wq, DM, 64 * nb, 64 * kb, WQT, DM, 64 * nb, scr, F.lane, F.n2g); }
    }
    const size_t gt = (size_t)F.vcu * 512 + F.tid, NGT = (size_t)F.G * 512;
    { bf16* SKB = (bf16*)(F.ws + WS_SKB); for (size_t e = gt; e < (size_t)2 * 128 * 128; e += NGT) SKB[e] = (bf16)f2bf(F.sk[e]); }
    { unsigned char* U6 = F.ws + WS_EU; unsigned char* V6 = F.ws + WS_EV; float* SU = (float*)(F.ws + WS_EU + 32 * MiB); float* SV = (float*)(F.ws + WS_EV + 32 * MiB);
      for (int r0 = gw; r0 < 2 * NEXP; r0 += 2 * NGW) {
          f32x4 x[2][8];
#pragma unroll
          for (int q = 0; q < 2; ++q) { const int r = r0 + q * NGW; const bool isv = r >= NEXP; const int row = isv ? r - NEXP : r; const float* src = (isv ? F.ev : F.eu) + (size_t)row * DM;
#pragma unroll
              for (int j = 0; j < 8; ++j) x[q][j] = __builtin_nontemporal_load((const f32x4*)(src + 256 * j + 4 * F.lane)); }
#pragma unroll
          for (int q = 0; q < 2; ++q) { const int r = r0 + q * NGW; const bool isv = r >= NEXP; const int row = isv ? r - NEXP : r;
              float amax = 0.f;
#pragma unroll
              for (int j = 0; j < 8; ++j) { if (!isv) x[q][j] = x[q][j] * *(const f32x4*)(F.n2g + 256 * j + 4 * F.lane);
                  amax = fmaxf(amax, fmaxf(fmaxf(fabsf(x[q][j].x), fabsf(x[q][j].y)), fmaxf(fabsf(x[q][j].z), fabsf(x[q][j].w)))); }
#pragma unroll
              for (int o = 1; o < 64; o <<= 1) amax = fmaxf(amax, __shfl_xor(amax, o));
              if (!isv) {
                  const float sc = amax > 0.f ? 7.5f / amax : 1.0f;
                  v16f pa, pb;
#pragma unroll
                  for (int j = 0; j < 8; ++j) { pa[2 * j] = x[q][j].x * sc; pb[2 * j] = x[q][j].y * sc; pa[2 * j + 1] = x[q][j].z * sc; pb[2 * j + 1] = x[q][j].w * sc; }
                  const v6u p = __builtin_amdgcn_cvt_scalef32_2xpk16_fp6_f32(pa, pb, 1.0f);
                  unsigned char* dst2 = U6 + (size_t)row * ROW6;
                  __builtin_nontemporal_store((v4u){p[0], p[1], p[2], p[3]}, (v4u*)(dst2 + 16 * F.lane)); __builtin_nontemporal_store((v2u){p[4], p[5]}, (v2u*)(dst2 + 1024 + 8 * F.lane));
                  if (F.lane == 0) SU[row] = amax > 0.f ? amax / 7.5f : 1.0f;
              } else {
                  const float sc = amax > 0.f ? 6.0f / amax : 1.0f;
                  v4u p;
#pragma unroll
                  for (int d = 0; d < 4; ++d) { unsigned w = 0;
                      w = __builtin_amdgcn_cvt_scalef32_pk_fp4_f32(w, x[q][2 * d].x * sc, x[q][2 * d].y * sc, 1.0f, 0); w = __builtin_amdgcn_cvt_scalef32_pk_fp4_f32(w, x[q][2 * d].z * sc, x[q][2 * d].w * sc, 1.0f, 1);
                      w = __builtin_amdgcn_cvt_scalef32_pk_fp4_f32(w, x[q][2 * d + 1].x * sc, x[q][2 * d + 1].y * sc, 1.0f, 2); w = __builtin_amdgcn_cvt_scalef32_pk_fp4_f32(w, x[q][2 * d + 1].z * sc, x[q][2 * d + 1].w * sc, 1.0f, 3);
                      p[d] = w; }
                  __builtin_nontemporal_store(p, (v4u*)(V6 + (size_t)row * ROW4 + 16 * F.lane));
                  if (F.lane == 0) SV[row] = amax > 0.f ? amax / 6.0f : 1.0f;
              } }
      } }
    __syncthreads();
    { bf16* wt_s = (bf16*)F.lds; constexpr int WLD = DM + 8;
      for (int k = F.tid; k < DM; k += 512) { const float* src = F.win + (size_t)k * DIN + 6144;
#pragma unroll
          for (int q = 0; q < 4; ++q) { const f32x4 w4 = *(const f32x4*)(src + 4 * q); wt_s[(4 * q + 0) * WLD + k] = (bf16)f2bf(w4.x); wt_s[(4 * q + 1) * WLD + k] = (bf16)f2bf(w4.y); wt_s[(4 * q + 2) * WLD + k] = (bf16)f2bf(w4.z); wt_s[(4 * q + 3) * WLD + k] = (bf16)f2bf(w4.w); } }
      bf16* XN = (bf16*)(F.ws + WS_XN); float* ALR = (float*)(F.ws + WS_ALR);
      const int r0 = (int)(((long)F.vcu * TT) / F.G), r1 = (int)(((long)(F.vcu + 1) * TT) / F.G);
      for (int m = r0 + F.wave; m < r1; m += NWAVES) rms_row_to_bf16(m < TP ? F.xp + (size_t)m * DM : F.xs + (size_t)(m - TP) * DM, F.n1g, XN + (size_t)m * DM, F.lane);
      for (int m = TT + gw; m < MP; m += NGW) zero_row_bf16(XN + (size_t)m * DM, F.lane);
      VM_WAIT(); __syncthreads();
      const int l15 = F.lane & 15, lq = F.lane >> 4;
      for (int t0 = r0 + 16 * F.wave; t0 < r1; t0 += 16 * NWAVES) {
          const int row = min(t0 + l15, r1 - 1);
          f32x4 acc = {0.f, 0.f, 0.f, 0.f};
#pragma unroll 8
          for (int ks = 0; ks < 64; ++ks) { const bf16x8 a = *(const bf16x8*)(XN + (size_t)row * DM + 32 * ks + 8 * lq); const bf16x8 bq = *(const bf16x8*)(wt_s + l15 * WLD + 32 * ks + 8 * lq); acc = MFMA16(a, bq, acc); }
#pragma unroll
          for (int r = 0; r < 4; ++r) { const int m = t0 + 4 * lq + r; if (m < r1) ALR[(size_t)m * 16 + l15] = acc[r]; }
      } }
}

template <int NT, class Epi>
__device__ __forceinline__ void skinny_gemm(Frame& F, const bf16* A, const bf16* Bt, int n0, const Epi& E) {
    constexpr int ROWS = NT * 16, NPC = (ROWS * 32 + 511) / 512, BLD = 264;
    bf16* Bs = (bf16*)F.lds;
    const int tid = F.tid, wv = F.wave, l15 = F.lane & 15, lq = F.lane >> 4;
    f32x4 acc[NT];
#pragma unroll
    for (int nt = 0; nt < NT; ++nt) acc[nt] = (f32x4){0.f, 0.f, 0.f, 0.f};
    const bf16* Arow = A + (size_t)(16 * wv + l15) * DM + 8 * lq;
    v4u bX[NPC], bY[NPC]; bf16x8 aX[8], aY[8];
#define SK_LOADB(BR, kc) do { _Pragma("unroll") for (int i = 0; i < NPC; ++i) { const int p = tid + 512 * i; if (p < ROWS * 32) BR[i] = *(const v4u*)(Bt + (size_t)(n0 + (p >> 5)) * DM + (kc) * 256 + 8 * (p & 31)); } } while (0)
#define SK_LOADA(AR, kc) do { _Pragma("unroll") for (int ks = 0; ks < 8; ++ks) AR[ks] = *(const bf16x8*)(Arow + (kc) * 256 + 32 * ks); } while (0)
#define SK_STOREB(BR, kc) do { bf16* Bn = Bs + ((kc) & 1) * ROWS * BLD; _Pragma("unroll") for (int i = 0; i < NPC; ++i) { const int p = tid + 512 * i; if (p < ROWS * 32) *(v4u*)(Bn + (p >> 5) * BLD + 8 * (p & 31)) = BR[i]; } } while (0)
#define SK_COMP(AR, kc) do { const bf16* Bc = Bs + ((kc) & 1) * ROWS * BLD; _Pragma("unroll") for (int ks = 0; ks < 8; ++ks) _Pragma("unroll") for (int nt = 0; nt < NT; ++nt) { \
        const bf16x8 bq = *(const bf16x8*)(Bc + (16 * nt + l15) * BLD + 32 * ks + 8 * lq); acc[nt] = MFMA16(AR[ks], bq, acc[nt]); } } while (0)
    SK_LOADB(bX, 0); SK_LOADA(aX, 0); SK_LOADB(bY, 1); SK_LOADA(aY, 1);
    SK_STOREB(bX, 0);
    __syncthreads();
#pragma unroll 1
    for (int kc = 0; kc < 8; kc += 2) {
        SK_LOADB(bX, kc + 2 < 8 ? kc + 2 : 7);
        SK_COMP(aX, kc); SK_LOADA(aX, kc + 2 < 8 ? kc + 2 : 7);
        SK_STOREB(bY, kc + 1);
        __syncthreads();
        SK_LOADB(bY, kc + 3 < 8 ? kc + 3 : 7);
        SK_COMP(aY, kc + 1); SK_LOADA(aY, kc + 3 < 8 ? kc + 3 : 7);
        SK_STOREB(bX, kc + 2);
        __syncthreads();
    }
#undef SK_LOADB
#undef SK_LOADA
#undef SK_STOREB
#undef SK_COMP
    E.template tile<NT>(acc, wv, l15, lq, n0);
}
template <class Epi>
__device__ __forceinline__ void skinny_gemm16(Frame& F, const bf16* A, const bf16* Bt, int n0, int rh, const Epi& E) {
    constexpr int BLD = 264, BUF = 2 * 16 * BLD;
    bf16* Bs = (bf16*)F.lds; float* xs = (float*)(F.lds + 2 * BUF * 2);
    const int tid = F.tid, wv = F.wave, lane = F.lane, l15 = lane & 15, lq = lane >> 4, mt = wv & 3, kh = wv >> 2;
    f32x4 acc[1] = {(f32x4){0.f, 0.f, 0.f, 0.f}};
    const bf16* Arow = A + (size_t)(64 * rh + 16 * mt + l15) * DM + kh * 1024 + 8 * lq;
    v4u bX[2], bY[2]; bf16x8 aX[8], aY[8];
#define SK_LOADB(BR, kc) do { _Pragma("unroll") for (int i = 0; i < 2; ++i) { const int p = tid + 512 * i; BR[i] = *(const v4u*)(Bt + (size_t)(n0 + ((p >> 5) & 15)) * DM + (p >> 9) * 1024 + (kc) * 256 + 8 * (p & 31)); } } while (0)
#define SK_LOADA(AR, kc) do { _Pragma("unroll") for (int ks = 0; ks < 8; ++ks) AR[ks] = *(const bf16x8*)(Arow + (kc) * 256 + 32 * ks); } while (0)
#define SK_STOREB(BR, kc) do { bf16* Bn = Bs + ((kc) & 1) * BUF; _Pragma("unroll") for (int i = 0; i < 2; ++i) { const int p = tid + 512 * i; *(v4u*)(Bn + ((p >> 9) * 16 + ((p >> 5) & 15)) * BLD + 8 * (p & 31)) = BR[i]; } } while (0)
#define SK_COMP(AR, kc) do { const bf16* Bc = Bs + ((kc) & 1) * BUF + kh * 16 * BLD; _Pragma("unroll") for (int ks = 0; ks < 8; ++ks) { \
        const bf16x8 bq = *(const bf16x8*)(Bc + l15 * BLD + 32 * ks + 8 * lq); acc[0] = MFMA16(AR[ks], bq, acc[0]); } } while (0)
    SK_LOADB(bX, 0); SK_LOADA(aX, 0); SK_LOADB(bY, 1); SK_LOADA(aY, 1);
    SK_STOREB(bX, 0);
    __syncthreads();
#pragma unroll 1
    for (int kc = 0; kc < 4; kc += 2) {
        SK_LOADB(bX, kc + 2 < 4 ? kc + 2 : 3);
        SK_COMP(aX, kc); SK_LOADA(aX, kc + 2 < 4 ? kc + 2 : 3);
        SK_STOREB(bY, kc + 1);
        __syncthreads();
        SK_LOADB(bY, kc + 3 < 4 ? kc + 3 : 3);
        SK_COMP(aY, kc + 1); SK_LOADA(aY, kc + 3 < 4 ? kc + 3 : 3);
        SK_STOREB(bX, kc + 2);
        __syncthreads();
    }
#undef SK_LOADB
#undef SK_LOADA
#undef SK_STOREB
#undef SK_COMP
    if (kh) *(f32x4*)(xs + (mt * 64 + lane) * 4) = acc[0];
    __syncthreads();
    if (!kh) { acc[0] += *(const f32x4*)(xs + (mt * 64 + lane) * 4); E.template tile<1>(acc, 4 * rh + mt, l15, lq, n0); }
    __syncthreads();
}
struct EpiSkBf16 { bf16* out; int ldc; const float* rs;
    template <int NT> __device__ __forceinline__ void tile(const f32x4 (&acc)[NT], int wv, int l15, int lq, int n0) const {
#pragma unroll
        for (int r = 0; r < 4; ++r) { const int row = 16 * wv + 4 * lq + r; const float sc = rs ? rs[row] : 1.0f;
#pragma unroll
            for (int nt = 0; nt < NT; ++nt) out[(size_t)row * ldc + n0 + 16 * nt + l15] = (bf16)f2bf(acc[nt][r] * sc); } } };
struct EpiSkF32Res { const float* xs; bf16* outb; float* ssqs;
    template <int NT> __device__ __forceinline__ void tile(const f32x4 (&acc)[NT], int wv, int l15, int lq, int n0) const {
        static_assert(NT == 1, "one 16-column group");
#pragma unroll
        for (int r = 0; r < 4; ++r) { const int row = 16 * wv + 4 * lq + r; const size_t o = (size_t)row * DM + n0 + l15; const float v = xs[o] + acc[0][r]; outb[o] = (bf16)f2bf(v);
            float s = v * v; s += __shfl_xor(s, 1); s += __shfl_xor(s, 2); s += __shfl_xor(s, 4); s += __shfl_xor(s, 8);
            if (l15 == 0) ssqs[row * 128 + (n0 >> 4)] = s; } } };

__device__ __forceinline__ float logsig(float x) { return fminf(x, 0.f) - __logf(1.0f + __expf(-fabsf(x))); }
__device__ __forceinline__ void gla_prep_unit(Frame& F, int u) {
    const bf16* P = (const bf16*)(F.ws + WS_P); bf16* QT = (bf16*)(F.ws + WS_QT); bf16* KT = (bf16*)(F.ws + WS_KT); bf16* VT = (bf16*)(F.ws + WS_VT);
    bf16* ATT = (bf16*)(F.ws + WS_ATT); float* EBL = (float*)(F.ws + WS_EBL);
    const int b = u >> 7, h = (u >> 5) & 3, c = u & 31, tid = F.tid;
    const int row0 = b * 2048 + c * 64;
    float* alr_s = (float*)F.lds;
    float* tot_s = (float*)(F.lds + 4096);
    bf16* q_s = (bf16*)(F.lds + 8192);
    bf16* k_s = q_s + 64 * 264;
    bf16* v_s = k_s + 64 * 264;
    bf16* a_s = v_s + 64 * 520;
    { v4u tq[4], tk[4], tv[8];
#pragma unroll
      for (int i = 0; i < 4; ++i) { const int p = tid + 512 * i, row = p >> 5, ch = p & 31; const bf16* src = P + (size_t)(row0 + row) * PLD + h * 256 + 8 * ch; tq[i] = __builtin_nontemporal_load((const v4u*)(src + C_Q)); tk[i] = __builtin_nontemporal_load((const v4u*)(src + C_K)); }
#pragma unroll
      for (int i = 0; i < 8; ++i) { const int p = tid + 512 * i, row = p >> 6, ch = p & 63; tv[i] = __builtin_nontemporal_load((const v4u*)(P + (size_t)(row0 + row) * PLD + C_V + h * 512 + 8 * ch)); }
      for (int e = tid; e < 1024; e += 512) alr_s[e] = ((const float*)(F.ws + WS_ALR))[(size_t)row0 * 16 + e];
#pragma unroll
      for (int i = 0; i < 4; ++i) { const int p = tid + 512 * i, row = p >> 5, ch = p & 31; *(v4u*)(q_s + row * 264 + 8 * ch) = tq[i]; *(v4u*)(k_s + row * 264 + 8 * ch) = tk[i]; }
#pragma unroll
      for (int i = 0; i < 8; ++i) { const int p = tid + 512 * i, row = p >> 6, ch = p & 63; *(v4u*)(v_s + row * 520 + 8 * ch) = tv[i]; } }
    const int d = tid & 255, half = tid >> 8;
    float w[16];
#pragma unroll
    for (int r = 0; r < 16; ++r) w[r] = F.wau[r * 1024 + h * 256 + d];
    const float bias = F.bal[h * 256 + d];
    __syncthreads();
    float bb[32]; float run = 0.f;
#pragma unroll
    for (int jj = 0; jj < 32; ++jj) { const int j = half * 32 + jj; float x = bias;
#pragma unroll
        for (int r = 0; r < 16; ++r) x += alr_s[j * 16 + r] * w[r];
        run += logsig(x) * 0.0625f; bb[jj] = run; }
    if (half == 0) tot_s[d] = run;
    __syncthreads();
    if (half == 1) { const float t = tot_s[d];
#pragma unroll
        for (int jj = 0; jj < 32; ++jj) bb[jj] += t; }
#pragma unroll
    for (int jj = 0; jj < 32; ++jj) { const int j = half * 32 + jj;
        const float qv = bf2f(q_s[j * 264 + d]), kv = bf2f(k_s[j * 264 + d]);
        const float e = __expf(bb[jj]), ei = __expf(-bb[jj]);
        q_s[j * 264 + d] = (bf16)f2bf(qv * 0.0625f * e); k_s[j * 264 + d] = (bf16)f2bf(kv * ei); }
    if (half == 1) EBL[u * 256 + d] = __expf(bb[31]);
    __syncthreads();
    { const int wv = F.wave, l15 = F.lane & 15, lq = F.lane >> 4, mi = wv >> 1;
#pragma unroll
      for (int nn = 0; nn < 2; ++nn) { const int ni = (wv & 1) * 2 + nn; f32x4 acc = {0.f, 0.f, 0.f, 0.f};
#pragma unroll
          for (int ks = 0; ks < 8; ++ks) { const bf16x8 a = *(const bf16x8*)(q_s + (16 * mi + l15) * 264 + 32 * ks + 8 * lq); const bf16x8 bq = *(const bf16x8*)(k_s + (16 * ni + l15) * 264 + 32 * ks + 8 * lq); acc = MFMA16(a, bq, acc); }
#pragma unroll
          for (int r = 0; r < 4; ++r) { const int i = 16 * mi + 4 * lq + r, jn = 16 * ni + l15; a_s[i * 72 + jn] = (bf16)f2bf(jn <= i ? acc[r] : 0.f); } } }
#pragma unroll
    for (int i = 0; i < 4; ++i) { const int p = tid + 512 * i, f = p >> 6, ln = p & 63, l15 = ln & 15, lq = ln >> 4;
        { const int mi = f >> 3, kh = (f >> 2) & 1, ks = f & 3; *(v4u*)(QT + (size_t)u * 16384 + (size_t)p * 8) = *(const v4u*)(q_s + (16 * mi + l15) * 264 + 128 * kh + 32 * ks + 8 * lq); }
        { const int wv2 = f >> 2, t2 = (f >> 1) & 1, ks = f & 1, dd = 32 * wv2 + 16 * t2 + l15, j0 = 32 * ks + 8 * lq; v4u o;
          o.x = (unsigned)k_s[(j0 + 0) * 264 + dd] | ((unsigned)k_s[(j0 + 1) * 264 + dd] << 16); o.y = (unsigned)k_s[(j0 + 2) * 264 + dd] | ((unsigned)k_s[(j0 + 3) * 264 + dd] << 16);
          o.z = (unsigned)k_s[(j0 + 4) * 264 + dd] | ((unsigned)k_s[(j0 + 5) * 264 + dd] << 16); o.w = (unsigned)k_s[(j0 + 6) * 264 + dd] | ((unsigned)k_s[(j0 + 7) * 264 + dd] << 16);
          *(v4u*)(KT + (size_t)u * 16384 + (size_t)p * 8) = o; } }
    __syncthreads();
    { const int p = tid, f = p >> 6, ln = p & 63, l15 = ln & 15, lq = ln >> 4, mi = f >> 1, kh = f & 1;
      *(v4u*)(ATT + (size_t)u * 4096 + (size_t)p * 8) = *(const v4u*)(a_s + (16 * mi + l15) * 72 + 32 * kh + 8 * lq); }
    { const int dv = tid; unsigned vp[32];
#pragma unroll
      for (int j = 0; j < 64; ++j) { const unsigned v = v_s[j * 520 + dv]; if (j & 1) vp[j >> 1] |= v << 16; else vp[j >> 1] = v; }
      v4u* dst = (v4u*)(VT + ((size_t)u * 512 + dv) * 64);
#pragma unroll
      for (int i = 0; i < 8; ++i) { v4u o; o.x = vp[4 * i]; o.y = vp[4 * i + 1]; o.z = vp[4 * i + 2]; o.w = vp[4 * i + 3]; dst[i] = o; } }
    __syncthreads();
}

__device__ __forceinline__ void gla_sample_unit(Frame& F, int u) {
    const bf16* P = (const bf16*)(F.ws + WS_P); bf16* O = (bf16*)(F.ws + WS_O);
    const int n = u >> 2, h = u & 3, tid = F.tid, lane = F.lane, wv = F.wave;
    const size_t m = (size_t)(TP + n);
    float* e_s = (float*)F.lds;
    float* qe_s = e_s + 256;
    float* k_s = qe_s + 256;
    float* v_s = k_s + 256;
    float* red_s = v_s + 512;
    float* op_s = red_s + 64;
    float part = 0.f;
    if (tid < 256) { const int d = tid; float x = F.bal[h * 256 + d];
#pragma unroll
        for (int r = 0; r < 16; ++r) x += ((const float*)(F.ws + WS_ALR))[m * 16 + r] * F.wau[r * 1024 + h * 256 + d];
        const float la = logsig(x) * 0.0625f, e = __expf(la);
        const float q = bf2f(P[m * PLD + C_Q + h * 256 + d]) * 0.0625f, k = bf2f(P[m * PLD + C_K + h * 256 + d]);
        e_s[d] = e; qe_s[d] = q * e; k_s[d] = k; part = q * k; }
    v_s[tid] = bf2f(P[m * PLD + C_V + h * 512 + tid]);
    part = wave_sum(part);
    if (lane == 0) red_s[wv] = part;
    __syncthreads();
    const float attn = (red_s[0] + red_s[1]) + (red_s[2] + red_s[3]);
    const float* Sin = F.sgla + ((size_t)(n * 4 + h) * 256) * 512; float* Sout = F.out + OUT_GLAS + ((size_t)(n * 4 + h) * 256) * 512;
    const f32x4 v0 = *(const f32x4*)(v_s + 4 * lane), v1 = *(const f32x4*)(v_s + 256 + 4 * lane);
    f32x4 o0 = {0.f, 0.f, 0.f, 0.f}, o1 = {0.f, 0.f, 0.f, 0.f};
#pragma unroll 1
    for (int g = 0; g < 2; ++g) {
        f32x4 s0[16], s1[16];
#pragma unroll
        for (int i = 0; i < 16; ++i) { const int d = 32 * wv + 16 * g + i; s0[i] = __builtin_nontemporal_load((const f32x4*)(Sin + (size_t)d * 512 + 4 * lane)); s1[i] = __builtin_nontemporal_load((const f32x4*)(Sin + (size_t)d * 512 + 256 + 4 * lane)); }
#pragma unroll
        for (int i = 0; i < 16; ++i) { const int d = 32 * wv + 16 * g + i; const float e = e_s[d], qe = qe_s[d], k = k_s[d];
            o0 += s0[i] * qe; o1 += s1[i] * qe;
            __builtin_nontemporal_store(s0[i] * e + v0 * k, (f32x4*)(Sout + (size_t)d * 512 + 4 * lane)); __builtin_nontemporal_store(s1[i] * e + v1 * k, (f32x4*)(Sout + (size_t)d * 512 + 256 + 4 * lane)); }
    }
    *(f32x4*)(op_s + wv * 512 + 4 * lane) = o0; *(f32x4*)(op_s + wv * 512 + 256 + 4 * lane) = o1;
    __syncthreads();
    { float o = attn * v_s[tid];
#pragma unroll
      for (int w8 = 0; w8 < 8; ++w8) o += op_s[w8 * 512 + tid];
      O[m * DM + h * 512 + tid] = (bf16)f2bf(o); }
    __syncthreads();
}

struct GlaRegs { bf16x8 kt[2][2], at, q[4]; v4u vpiece; float epiece; };
struct GlaOffs { unsigned l16, vt, eb; };
template <int NT>
__device__ __forceinline__ GlaOffs gla_offs(int lane, int tid) {
    const int tv = tid & (NT * 128 - 1); GlaOffs o;
    o.l16 = (unsigned)(lane * 16);
    o.vt = (unsigned)(((tv >> 3) * 64 + 8 * (tv & 7)) * 2);
    o.eb = (unsigned)((tid & 255) * 4);
    return o;
}
template <int NT>
__device__ __forceinline__ void gla_load(GlaRegs& R, const GlaOffs& o, const bf16* QT, const bf16* KT, const bf16* VT, const bf16* ATT, const float* EBL, int bh, int s, int c, int wv) {
    const size_t u = (size_t)bh * 32 + c;
    const char* pa = (const char*)(ATT + u * 4096) + wv * 1024; const char* pv = (const char*)(VT + (u * 512 + 16 * NT * s) * 64);
    const char* pq = (const char*)(QT + u * 16384) + wv * 4096; const char* pk = (const char*)(KT + u * 16384) + wv * 4096;
    R.at = *(const bf16x8*)(pa + o.l16);
    R.vpiece = *(const v4u*)(pv + o.vt);
    R.epiece = *(const float*)((const char*)(EBL + u * 256) + o.eb);
#pragma unroll
    for (int ks = 0; ks < 4; ++ks) R.q[ks] = *(const bf16x8*)(pq + o.l16 + 1024 * ks);
#pragma unroll
    for (int t = 0; t < 2; ++t)
#pragma unroll
        for (int ks = 0; ks < 2; ++ks) R.kt[t][ks] = *(const bf16x8*)(pk + o.l16 + 2048 * t + 1024 * ks);
}
constexpr int VT_LD = 72;
template <int NT>
__device__ __forceinline__ void gla_step(const GlaRegs& R, const float* ebs, f32x4 (&S)[2][NT], const bf16* vts, const bf16* STp, bf16* STn, float* xo, int wv, int lane, int l15, int lq) {
    const int mi = wv >> 1, kh = wv & 1;
#pragma unroll
    for (int nt = 0; nt < NT; ++nt) {
        f32x4 acc = {0.f, 0.f, 0.f, 0.f};
        { const bf16x8 vsel = *(const bf16x8*)(vts + (16 * nt + l15) * VT_LD + 32 * kh + 8 * lq); acc = MFMA16(R.at, vsel, acc); }
#pragma unroll
        for (int ks = 0; ks < 4; ++ks) { const bf16x8 sf = *(const bf16x8*)(STp + (16 * nt + l15) * 264 + 128 * kh + 32 * ks + 8 * lq); acc = MFMA16(R.q[ks], sf, acc); }
        *(f32x4*)(xo + (((mi * 2 + kh) * NT + nt) * 64 + lane) * 4) = acc;
    }
#pragma unroll
    for (int nt = 0; nt < NT; ++nt) {
        bf16x8 vt[2];
#pragma unroll
        for (int ks = 0; ks < 2; ++ks) vt[ks] = *(const bf16x8*)(vts + (16 * nt + l15) * VT_LD + 32 * ks + 8 * lq);
#pragma unroll
        for (int mt = 0; mt < 2; ++mt) {
#pragma unroll
            for (int ks = 0; ks < 2; ++ks) S[mt][nt] = MFMA16(R.kt[mt][ks], vt[ks], S[mt][nt]);
            S[mt][nt] = S[mt][nt] * *(const f32x4*)(ebs + 32 * wv + 16 * mt + 4 * lq);
            v2u w; w.x = pg8::cvt_pk_bf16(S[mt][nt][0], S[mt][nt][1]); w.y = pg8::cvt_pk_bf16(S[mt][nt][2], S[mt][nt][3]);
            *(v2u*)(STn + (16 * nt + l15) * 264 + 32 * wv + 16 * mt + 4 * lq) = w; } }
}
template <int NT>
__device__ __forceinline__ void gla_store_o(const float* xo, bf16* O, int b, int h, int s, int c, int wv, int lane, int l15, int lq) {
    const int mi = wv >> 1, kh = wv & 1;
#pragma unroll
    for (int n2 = 0; n2 < NT / 2; ++n2) { const int nt = kh * (NT / 2) + n2;
        const f32x4 t = *(const f32x4*)(xo + (((mi * 2 + 0) * NT + nt) * 64 + lane) * 4) + *(const f32x4*)(xo + (((mi * 2 + 1) * NT + nt) * 64 + lane) * 4);
        const unsigned p01 = pg8::cvt_pk_bf16(t[0], t[1]), p23 = pg8::cvt_pk_bf16(t[2], t[3]);
        bf16* dst = O + ((size_t)b * 2048 + 64 * c + 16 * mi + 4 * lq) * DM + h * 512 + 16 * NT * s + 16 * nt + l15;
        dst[0] = (bf16)(p01 & 0xffffu); dst[DM] = (bf16)(p01 >> 16); dst[2 * DM] = (bf16)(p23 & 0xffffu); dst[3 * DM] = (bf16)(p23 >> 16); }
}
#define GLA_BAR() do { asm volatile("s_waitcnt lgkmcnt(0)" ::: "memory"); __builtin_amdgcn_s_barrier(); asm volatile("" ::: "memory"); } while (0)
template <int NT>
__device__ __forceinline__ void gla_main_unit(Frame& F, int bh, int s) {
    const bf16* QT = (const bf16*)(F.ws + WS_QT); const bf16* KT = (const bf16*)(F.ws + WS_KT); const bf16* VT = (const bf16*)(F.ws + WS_VT);
    const bf16* ATT = (const bf16*)(F.ws + WS_ATT); const float* EBL = (const float*)(F.ws + WS_EBL); bf16* O = (bf16*)(F.ws + WS_O);
    const int b = bh >> 2, h = bh & 3, wv = F.wave, lane = F.lane, l15 = lane & 15, lq = lane >> 4, kh = wv & 1, tid = F.tid;
    constexpr int ST_ELEMS = NT * 16 * 264, XO_FLOATS = 8 * NT * 256, VTS_ELEMS = NT * 16 * VT_LD;
    bf16* ST = (bf16*)F.lds;
    float* XO = (float*)(F.lds + 2 * ST_ELEMS * 2);
    bf16* VTS = (bf16*)(F.lds + 2 * ST_ELEMS * 2 + 2 * XO_FLOATS * 4);
    float* EBS = (float*)(F.lds + 2 * ST_ELEMS * 2 + 2 * XO_FLOATS * 4 + 2 * VTS_ELEMS * 2);
    for (int e = tid; e < ST_ELEMS; e += 512) ((unsigned*)ST)[e] = 0u;
    f32x4 S[2][NT];
#pragma unroll
    for (int a = 0; a < 2; ++a)
#pragma unroll
        for (int c2 = 0; c2 < NT; ++c2) S[a][c2] = (f32x4){0.f, 0.f, 0.f, 0.f};
    const GlaOffs go = gla_offs<NT>(lane, tid);
    GlaRegs RA, RB, RC;
    gla_load<NT>(RA, go, QT, KT, VT, ATT, EBL, bh, s, 0, wv);
    gla_load<NT>(RB, go, QT, KT, VT, ATT, EBL, bh, s, 1, wv);
    if (tid < NT * 128) *(v4u*)(VTS + (tid >> 3) * VT_LD + 8 * (tid & 7)) = RA.vpiece;
    if (tid < 256) EBS[tid] = RA.epiece;
    __syncthreads();
#define GLA_ITER(c, RCUR, RNXT, RLD) do { if ((c) < 32) { \
            gla_load<NT>(RLD, go, QT, KT, VT, ATT, EBL, bh, s, (c) + 2 < 32 ? (c) + 2 : 31, wv); \
            gla_step<NT>(RCUR, EBS + ((c) & 1) * 256, S, VTS + ((c) & 1) * VTS_ELEMS, ST + ((c) & 1) * ST_ELEMS, ST + (((c) + 1) & 1) * ST_ELEMS, XO + ((c) & 1) * XO_FLOATS, wv, lane, l15, lq); \
            if ((c) > 0) gla_store_o<NT>(XO + (((c) + 1) & 1) * XO_FLOATS, O, b, h, s, (c) - 1, wv, lane, l15, lq); \
            if (tid < NT * 128) *(v4u*)(VTS + (((c) + 1) & 1) * VTS_ELEMS + (tid >> 3) * VT_LD + 8 * (tid & 7)) = RNXT.vpiece; \
            if (tid < 256) EBS[(((c) + 1) & 1) * 256 + tid] = RNXT.epiece; \
            GLA_BAR(); \
        } } while (0)
#pragma unroll 1
    for (int c = 0; c < 33; c += 3) { GLA_ITER(c, RA, RB, RC); GLA_ITER(c + 1, RB, RC, RA); GLA_ITER(c + 2, RC, RA, RB); }
#undef GLA_ITER
    gla_store_o<NT>(XO + (31 & 1) * XO_FLOATS, O, b, h, s, 31, wv, lane, l15, lq);
    int lq2 = lq; asm volatile("" : "+v"(lq2));
    float* So = F.out + OUT_GLAP + ((size_t)bh * 256) * 512;
#pragma unroll
    for (int mt = 0; mt < 2; ++mt)
#pragma unroll
        for (int nt = 0; nt < NT; ++nt)
#pragma unroll
            for (int r = 0; r < 4; ++r) So[(size_t)(32 * wv + 16 * mt + 4 * lq2 + r) * 512 + 16 * NT * s + 16 * nt + l15] = S[mt][nt][r];
    __syncthreads();
}

template <int NR>
__device__ __forceinline__ void mixer_rows(Frame& F, int m0, int j) {
    const bf16* P = (const bf16*)(F.ws + WS_P); const bf16* O = (const bf16*)(F.ws + WS_O); bf16* MM = (bf16*)(F.ws + WS_MM);
    const int lane = F.lane; const bool prompt = m0 < TP;
    {
        const int col = 512 * j + 8 * lane;
        float u1[8], u2[8], gn[8], cbi[8], w0[8], w1[8], w2[8];
        { const f32x4 a = *(const f32x4*)(F.gng + col), b2 = *(const f32x4*)(F.gng + col + 4); gn[0] = a.x; gn[1] = a.y; gn[2] = a.z; gn[3] = a.w; gn[4] = b2.x; gn[5] = b2.y; gn[6] = b2.z; gn[7] = b2.w; }
        { const f32x4 a = *(const f32x4*)(F.cb + col), b2 = *(const f32x4*)(F.cb + col + 4); cbi[0] = a.x; cbi[1] = a.y; cbi[2] = a.z; cbi[3] = a.w; cbi[4] = b2.x; cbi[5] = b2.y; cbi[6] = b2.z; cbi[7] = b2.w; }
        { const f32x4 a = *(const f32x4*)(F.cw + col), b2 = *(const f32x4*)(F.cw + col + 4); w0[0] = a.x; w0[1] = a.y; w0[2] = a.z; w0[3] = a.w; w0[4] = b2.x; w0[5] = b2.y; w0[6] = b2.z; w0[7] = b2.w; }
        { const f32x4 a = *(const f32x4*)(F.cw + DM + col), b2 = *(const f32x4*)(F.cw + DM + col + 4); w1[0] = a.x; w1[1] = a.y; w1[2] = a.z; w1[3] = a.w; w1[4] = b2.x; w1[5] = b2.y; w1[6] = b2.z; w1[7] = b2.w; }
        { const f32x4 a = *(const f32x4*)(F.cw + 2 * DM + col), b2 = *(const f32x4*)(F.cw + 2 * DM + col + 4); w2[0] = a.x; w2[1] = a.y; w2[2] = a.z; w2[3] = a.w; w2[4] = b2.x; w2[5] = b2.y; w2[6] = b2.z; w2[7] = b2.w; }
        if (prompt) {
            const int t0 = m0 & 2047; const bf16* Pr = P + (size_t)m0 * PLD;
            if (t0 >= 1) { float a[8], b2[8]; unpack8(*(const v4u*)(Pr - PLD + C_CC + col), a); unpack8(*(const v4u*)(Pr - PLD + C_CX + col), b2);
#pragma unroll
                for (int e = 0; e < 8; ++e) u1[e] = a[e] * b2[e]; }
            else {
#pragma unroll
                for (int e = 0; e < 8; ++e) u1[e] = 0.f; }
            if (t0 >= 2) { float a[8], b2[8]; unpack8(*(const v4u*)(Pr - 2 * PLD + C_CC + col), a); unpack8(*(const v4u*)(Pr - 2 * PLD + C_CX + col), b2);
#pragma unroll
                for (int e = 0; e < 8; ++e) u2[e] = a[e] * b2[e]; }
            else {
#pragma unroll
                for (int e = 0; e < 8; ++e) u2[e] = 0.f; }
        } else {
            const int n = m0 - TP; const float* sc = F.sconv + (size_t)n * 2 * DM + col;
            const f32x4 a0 = *(const f32x4*)sc, a1 = *(const f32x4*)(sc + 4), b0 = *(const f32x4*)(sc + DM), b1 = *(const f32x4*)(sc + DM + 4);
            u2[0] = a0.x; u2[1] = a0.y; u2[2] = a0.z; u2[3] = a0.w; u2[4] = a1.x; u2[5] = a1.y; u2[6] = a1.z; u2[7] = a1.w;
            u1[0] = b0.x; u1[1] = b0.y; u1[2] = b0.z; u1[3] = b0.w; u1[4] = b1.x; u1[5] = b1.y; u1[6] = b1.z; u1[7] = b1.w;
        }
        v4u lo[NR], lr[NR], lcb[NR], lcc[NR], lcx[NR], lga[NR], lgb[NR];
#pragma unroll
        for (int r = 0; r < NR; ++r) { const int m = m0 + r; const bf16* Pr = P + (size_t)m * PLD;
            lo[r] = *(const v4u*)(O + (size_t)m * DM + col);
            lr[r] = __builtin_nontemporal_load((const v4u*)(Pr + C_R + col)); lcb[r] = __builtin_nontemporal_load((const v4u*)(Pr + C_CB + col)); lcc[r] = __builtin_nontemporal_load((const v4u*)(Pr + C_CC + col));
            lcx[r] = __builtin_nontemporal_load((const v4u*)(Pr + C_CX + col)); lga[r] = __builtin_nontemporal_load((const v4u*)(Pr + C_GA + col)); lgb[r] = __builtin_nontemporal_load((const v4u*)(Pr + C_GB + col)); }
#pragma unroll
        for (int r = 0; r < NR; ++r) {
            const int m = m0 + r;
            float o[8], rr[8], cbv[8], cc[8], cx[8], ga[8], gb[8], u[8];
            unpack8(lo[r], o); unpack8(lr[r], rr); unpack8(lcb[r], cbv); unpack8(lcc[r], cc); unpack8(lcx[r], cx); unpack8(lga[r], ga); unpack8(lgb[r], gb);
            float ss = 0.f;
#pragma unroll
            for (int e = 0; e < 8; ++e) ss += o[e] * o[e];
            const float rstd = 1.0f / sqrtf(wave_sum(ss) * (1.0f / 512.0f) + EPS);
#pragma unroll
            for (int e = 0; e < 8; ++e) u[e] = cc[e] * cx[e];
            if (prompt) { const int t = m & 2047;
                if (t >= 2046) { float* dst = F.out + OUT_CONVP + ((size_t)(m >> 11) * 2 + (t - 2046)) * DM + col;
                    *(f32x4*)dst = (f32x4){u[0], u[1], u[2], u[3]}; *(f32x4*)(dst + 4) = (f32x4){u[4], u[5], u[6], u[7]}; }
            } else { float* dst = F.out + OUT_CONVS + (size_t)(m - TP) * 2 * DM + col;
                *(f32x4*)dst = (f32x4){u1[0], u1[1], u1[2], u1[3]}; *(f32x4*)(dst + 4) = (f32x4){u1[4], u1[5], u1[6], u1[7]};
                *(f32x4*)(dst + DM) = (f32x4){u[0], u[1], u[2], u[3]}; *(f32x4*)(dst + DM + 4) = (f32x4){u[4], u[5], u[6], u[7]}; }
            float mv[8];
#pragma unroll
            for (int e = 0; e < 8; ++e) {
                const float ya = (rr[e] * sigmoidf_(rr[e])) * (o[e] * rstd * gn[e]);
                const float z = cbi[e] + w0[e] * u2[e] + w1[e] * u1[e] + w2[e] * u[e];
                mv[e] = sigmoidf_(ga[e]) * ya + sigmoidf_(gb[e]) * (cbv[e] * z);
                u2[e] = u1[e]; u1[e] = u[e];
            }
            *(v4u*)(MM + (size_t)m * DM + col) = pack8(mv);
        }
    }
}

constexpr int SC_LD = 130;
__device__ __forceinline__ int f2sort(float f) { const int b = __float_as_int(f); return b ^ ((b >> 31) & 0x7fffffff); }
__device__ __forceinline__ float sort2f(int s) { return __int_as_float(s ^ ((s >> 31) & 0x7fffffff)); }
#define CE_DESC(x, y) do { const int mx_ = max(x, y), mn_ = min(x, y); x = mx_; y = mn_; } while (0)
template <int N> __device__ __forceinline__ void bitonic_sort_desc(int (&a)[N]) {
#pragma unroll
    for (int k = 2; k <= N; k <<= 1)
#pragma unroll
        for (int j = k >> 1; j > 0; j >>= 1)
#pragma unroll
            for (int i = 0; i < N; ++i) { const int l = i ^ j; if (l > i) { if ((i & k) == 0) CE_DESC(a[i], a[l]); else CE_DESC(a[l], a[i]); } }
}
template <int N> __device__ __forceinline__ void bitonic_merge_desc(int (&a)[N]) {
#pragma unroll
    for (int j = N >> 1; j > 0; j >>= 1)
#pragma unroll
        for (int i = 0; i < N; ++i) { const int l = i ^ j; if (l > i) CE_DESC(a[i], a[l]); }
}
__device__ __forceinline__ void top16_merge(int (&a)[16], const int (&b)[16]) {
#pragma unroll
    for (int i = 0; i < 16; ++i) a[i] = max(a[i], b[15 - i]);
    bitonic_merge_desc<16>(a);
}
__device__ __attribute__((aligned(16))) const unsigned char PK_CAND[64] = {
    0x00, 0x01, 0x02, 0x03, 0x04, 0x05, 0x06, 0x07, 0x08, 0x09, 0x0a, 0x0b, 0x0c, 0x0d, 0x0e, 0x0f,
    0x10, 0x11, 0x12, 0x13, 0x14, 0x15, 0x16, 0x17, 0x20, 0x21, 0x22, 0x23, 0x24, 0x50, 0x51, 0xff,
    0x30, 0x31, 0x32, 0x33, 0x40, 0x41, 0x42, 0x60, 0x61, 0x70, 0x71, 0xff, 0xff, 0xff, 0xff, 0xff,
    0x80, 0x90, 0xa0, 0xb0, 0xc0, 0xd0, 0xe0, 0xf0, 0xff, 0xff, 0xff, 0xff, 0xff, 0xff, 0xff, 0xff};
constexpr int SC8_LD = 132, SK_LD = 136;
constexpr int SC8_BYTES = 128 * SC8_LD * 4, TV8_OFF = SC8_BYTES, SK_OFF = TV8_OFF + 128 * 16 * 4;
__device__ __forceinline__ void peer_load_subkeys(Frame& F) {
    const bf16* SKB = (const bf16*)(F.ws + WS_SKB); bf16* sk_s = (bf16*)(F.lds + SK_OFF);
    for (int e = F.tid; e < 256 * 16; e += 512) { const int row = e >> 4, ch = e & 15; *(v4u*)(sk_s + row * SK_LD + 8 * ch) = *(const v4u*)(SKB + (size_t)row * 128 + 8 * ch); }
    __syncthreads();
}
__device__ __forceinline__ void peer_qfrags(Frame& F, int tb, bf16x8 (&a)[2][4]) {
    const bf16* QP = (const bf16*)(F.ws + WS_QP); const int tok = min(tb + (F.lane & 7), TT - 1), lq = F.lane >> 4;
#pragma unroll
    for (int hf = 0; hf < 2; ++hf)
#pragma unroll
        for (int ks = 0; ks < 4; ++ks) a[hf][ks] = *(const bf16x8*)(QP + (size_t)tok * DM + F.wave * 256 + hf * 128 + 32 * ks + 8 * lq);
}
#define PK_BAR() do { asm volatile("s_waitcnt lgkmcnt(0)" ::: "memory"); __builtin_amdgcn_s_barrier(); asm volatile("" ::: "memory"); } while (0)
__device__ __forceinline__ void peer_topk_tile(Frame& F, int tb, int tend, bf16x8 (&a)[2][4]) {
    int* IDX = (int*)(F.ws + WS_IDX); float* GW = (float*)(F.ws + WS_GW);
    float* sc_s = (float*)F.lds;
    int* tv_s = (int*)(F.lds + TV8_OFF);
    const bf16* sk_s = (const bf16*)(F.lds + SK_OFF);
    const int wv = F.wave, lane = F.lane, l15 = lane & 15, lq = lane >> 4, tid = F.tid;
    {
#pragma unroll
      for (int hf = 0; hf < 2; ++hf) {
#pragma unroll
          for (int nt = 0; nt < 8; ++nt) { f32x4 acc = {0.f, 0.f, 0.f, 0.f};
#pragma unroll
              for (int ks = 0; ks < 4; ++ks) { const bf16x8 bq = *(const bf16x8*)(sk_s + (hf * 128 + 16 * nt + l15) * SK_LD + 32 * ks + 8 * lq); acc = MFMA16(a[hf][ks], bq, acc); }
              if (lq < 2) {
#pragma unroll
                  for (int r = 0; r < 4; ++r) sc_s[((wv * 2 + hf) * 8 + 4 * lq + r) * SC8_LD + 16 * nt + l15] = acc[r]; } } } }
    if (tb + 8 < tend) peer_qfrags(F, tb + 8, a);
    PK_BAR();
    { const int row = tid >> 2, sub = tid & 3; const float* rp = sc_s + row * SC8_LD;
      int top[16], v[16];
#pragma unroll
      for (int i = 0; i < 16; ++i) { const int key = 4 * i + sub; top[i] = (f2sort(rp[key]) & ~127) | (127 - key); }
      bitonic_sort_desc<16>(top);
#pragma unroll
      for (int i = 0; i < 16; ++i) { const int key = 4 * (16 + i) + sub; v[i] = (f2sort(rp[key]) & ~127) | (127 - key); }
      bitonic_sort_desc<16>(v);
      top16_merge(top, v);
#pragma unroll
      for (int sh = 1; sh < 4; sh <<= 1) {
#pragma unroll
          for (int i = 0; i < 16; ++i) v[i] = sh == 1 ? __builtin_amdgcn_update_dpp(0, top[i], 0xB1, 0xF, 0xF, true) : __builtin_amdgcn_update_dpp(0, top[i], 0x4E, 0xF, 0xF, true);
          top16_merge(top, v); }
      if (sub == 0) {
#pragma unroll
          for (int q = 0; q < 4; ++q) *(int __attribute__((ext_vector_type(4)))*)(tv_s + row * 16 + 4 * q) = (int __attribute__((ext_vector_type(4)))){top[4 * q], top[4 * q + 1], top[4 * q + 2], top[4 * q + 3]}; }
    }
    PK_BAR();
    if (tid < 256) { const int it = tid >> 2, qd = tid & 3, tl = it & 7, hd = it >> 3;
      const int* r1 = tv_s + ((hd * 2 + 0) * 8 + tl) * 16; const int* r2 = tv_s + ((hd * 2 + 1) * 8 + tl) * 16;
      int c[16];
      const v4u cw = *(const v4u*)(PK_CAND + qd * 16);
#pragma unroll
      for (int t = 0; t < 16; ++t) { const int ab = (int)((cw[t >> 2] >> (8 * (t & 3))) & 0xffu); const int abc = ab != 0xff ? ab : 0;
          const float sv = sort2f(r1[abc >> 4] & ~127) + sort2f(r2[abc & 15] & ~127); const int packed = (f2sort(sv) & ~255) | (255 - ab);
          c[t] = ab != 0xff ? packed : (int)0x80000000; }
      bitonic_sort_desc<16>(c);
#pragma unroll
      for (int sh = 1; sh < 4; sh <<= 1) { int oth[16];
#pragma unroll
          for (int i = 0; i < 16; ++i) oth[i] = sh == 1 ? __builtin_amdgcn_update_dpp(0, c[i], 0xB1, 0xF, 0xF, true) : __builtin_amdgcn_update_dpp(0, c[i], 0x4E, 0xF, 0xF, true);
          top16_merge(c, oth); }
      const int tok = tb + tl;
      if (tok < tend) {
          float ev[16], sum = 0.f; const float mx = sort2f(c[0] & ~255);
#pragma unroll
          for (int k = 0; k < 16; ++k) { ev[k] = __expf(sort2f(c[k] & ~255) - mx); sum += ev[k]; }
          const float inv = 1.0f / sum;
#pragma unroll
          for (int k = 0; k < 16; ++k) if ((k >> 2) == qd) { const int ab = 255 - (c[k] & 255); const int i1 = 127 - (r1[ab >> 4] & 127), i2 = 127 - (r2[ab & 15] & 127);
              IDX[(size_t)tok * 128 + hd * 16 + k] = i1 * 128 + i2; GW[(size_t)tok * 128 + hd * 16 + k] = ev[k] * inv; }
      }
    }
    PK_BAR();
}

__device__ __forceinline__ void peer_phase(Frame& F, int tok0, int tok1) {
    const unsigned char* U6 = F.ws + WS_EU; const unsigned char* V6 = F.ws + WS_EV; const float* SU = (const float*)(F.ws + WS_EU + 32 * MiB); const float* SV = (const float*)(F.ws + WS_EV + 32 * MiB);
    const bf16* X2 = (const bf16*)(F.ws + WS_H2); const float* RS2 = (const float*)(F.ws + WS_RS2); const int* IDX = (const int*)(F.ws + WS_IDX); const float* GW = (const float*)(F.ws + WS_GW);
    const int wv = F.wave, lane = F.lane, tid = F.tid;
    float* red_s = (float*)F.lds;
    float* ss_s = (float*)(F.lds + 131072);
    const f32x4 gfin = *(const f32x4*)(F.nfg + 4 * tid);
    f32x4 x3p = {0.f, 0.f, 0.f, 0.f}; int buf = 0;
#pragma unroll 1
    for (int m = tok0; m <= tok1; ++m) {
        if (m < tok1) {
            const int myidx = IDX[(size_t)m * 128 + wv * 16 + (lane & 15)]; float myg = GW[(size_t)m * 128 + wv * 16 + (lane & 15)];
            const float mysu = SU[myidx] * RS2[m]; myg *= SV[myidx];
            float hf[32];
#pragma unroll
            for (int j = 0; j < 8; ++j) { const v2u w = *(const v2u*)(X2 + (size_t)m * DM + 256 * j + 4 * lane); hf[4 * j] = bflo(w.x); hf[4 * j + 1] = bfhi(w.x); hf[4 * j + 2] = bflo(w.y); hf[4 * j + 3] = bfhi(w.y); }
            float acc[32];
#pragma unroll
            for (int k = 0; k < 32; ++k) acc[k] = 0.f;
#pragma unroll 1
            for (int kg = 0; kg < 4; ++kg) {
                v4u ul4[4], vl4[4]; v2u ul2[4]; float gk[4], su[4];
#pragma unroll
                for (int kk = 0; kk < 4; ++kk) { const int ex = __builtin_amdgcn_readlane(myidx, kg * 4 + kk); gk[kk] = __builtin_bit_cast(float, __builtin_amdgcn_readlane(__builtin_bit_cast(int, myg), kg * 4 + kk)); su[kk] = __builtin_bit_cast(float, __builtin_amdgcn_readlane(__builtin_bit_cast(int, mysu), kg * 4 + kk));
                    const unsigned char* ur = U6 + (size_t)ex * ROW6; const unsigned char* vr = V6 + (size_t)ex * ROW4;
                    ul4[kk] = *(const v4u*)(ur + 16 * lane); ul2[kk] = *(const v2u*)(ur + 1024 + 8 * lane); vl4[kk] = *(const v4u*)(vr + 16 * lane); }
#pragma unroll
                for (int kk = 0; kk < 4; ++kk) {
                    const v32f uf = __builtin_amdgcn_cvt_scalef32_pk32_f32_fp6((v6u){ul4[kk].x, ul4[kk].y, ul4[kk].z, ul4[kk].w, ul2[kk].x, ul2[kk].y}, 1.0f);
                    f32x2 d2a = {0.f, 0.f}, d2b = {0.f, 0.f};
#pragma unroll
                    for (int k = 0; k < 32; k += 4) { d2a += (f32x2){uf[k], uf[k + 1]} * (f32x2){hf[k], hf[k + 1]}; d2b += (f32x2){uf[k + 2], uf[k + 3]} * (f32x2){hf[k + 2], hf[k + 3]}; }
                    const float dot = (d2a.x + d2a.y) + (d2b.x + d2b.y);
                    const float a = wave_sum_dpp(dot) * su[kk];
                    const float wgt = gk[kk] * gelu_erf(a);
#pragma unroll
                    for (int d = 0; d < 4; ++d) {
                        const f32x2 v0 = __builtin_amdgcn_cvt_scalef32_pk_f32_fp4(vl4[kk][d], 1.0f, 0), v1 = __builtin_amdgcn_cvt_scalef32_pk_f32_fp4(vl4[kk][d], 1.0f, 1), v2 = __builtin_amdgcn_cvt_scalef32_pk_f32_fp4(vl4[kk][d], 1.0f, 2), v3 = __builtin_amdgcn_cvt_scalef32_pk_f32_fp4(vl4[kk][d], 1.0f, 3);
                        acc[8 * d] += wgt * v0.x; acc[8 * d + 1] += wgt * v0.y; acc[8 * d + 2] += wgt * v1.x; acc[8 * d + 3] += wgt * v1.y; acc[8 * d + 4] += wgt * v2.x; acc[8 * d + 5] += wgt * v2.y; acc[8 * d + 6] += wgt * v3.x; acc[8 * d + 7] += wgt * v3.y; }
                }
            }
#pragma unroll
            for (int j = 0; j < 8; ++j) *(f32x4*)(red_s + (buf * 8 + wv) * 2048 + 256 * j + 4 * lane) = (f32x4){acc[4 * j], acc[4 * j + 1], acc[4 * j + 2], acc[4 * j + 3]};
        }
        __syncthreads();
        if (m > tok0) {
            float tot = 0.f;
#pragma unroll
            for (int w8 = 0; w8 < 8; ++w8) tot += ss_s[(buf ^ 1) * 8 + w8];
            const float rstd = 1.0f / sqrtf(tot * (1.0f / DM) + EPS);
            *(f32x4*)(F.out + OUT_Y + (size_t)(m - 1) * DM + 4 * tid) = x3p * rstd * gfin;
        }
        if (m < tok1) {
            f32x4 x3; { const v2u w = *(const v2u*)(X2 + (size_t)m * DM + 4 * tid); x3 = (f32x4){bflo(w.x), bfhi(w.x), bflo(w.y), bfhi(w.y)}; }
#pragma unroll
            for (int w8 = 0; w8 < 8; ++w8) x3 += *(const f32x4*)(red_s + (buf * 8 + w8) * 2048 + 4 * tid);
            const float ss = wave_sum((x3.x * x3.x + x3.y * x3.y) + (x3.z * x3.z + x3.w * x3.w));
            if (lane == 0) ss_s[buf * 8 + wv] = ss;
            x3p = x3;
        }
        buf ^= 1;
    }
    __syncthreads();
}
struct Args { const float* in[18]; float* out; unsigned char* ws; int ph_lo, ph_hi; };
__global__ void __launch_bounds__(NWAVES * 64, 2) mk_fwd(Args args) {
    extern __shared__ __attribute__((aligned(16))) unsigned char lds[];
    Frame F;
    F.lds = lds;
    F.tid = threadIdx.x; F.lane = F.tid & 63; F.wave = __builtin_amdgcn_readfirstlane(F.tid >> 6);
    F.G = gridDim.x; { const int bx = blockIdx.x; F.vcu = (F.G % 8 == 0) ? (bx % 8) * (F.G / 8) + bx / 8 : bx; }
    F.xp = args.in[0]; F.xs = args.in[1]; F.sgla = args.in[2]; F.sconv = args.in[3]; F.n1g = args.in[4]; F.win = args.in[5]; F.wau = args.in[6]; F.bal = args.in[7];
    F.gng = args.in[8]; F.cw = args.in[9]; F.cb = args.in[10]; F.wout = args.in[11]; F.n2g = args.in[12]; F.wq = args.in[13]; F.sk = args.in[14]; F.eu = args.in[15];
    F.ev = args.in[16]; F.nfg = args.in[17]; F.out = args.out; F.ws = args.ws;
    for (int u = F.tid; u < (LDS_BYTES - LDSCTL_OFF) / 4; u += NWAVES * 64) ((LAS unsigned*)((LAS unsigned char*)lds + LDSCTL_OFF))[u] = 0u;
    __syncthreads();
    gu32* ctl = (gu32*)(F.ws + WS_CTL);
    XcdBarrier bar; bar.bar = (unsigned*)(ctl + CW_BAR); bar.x = 0; bar.st = nullptr;
    if (N_LAUNCHES == 1) bar = xcd_barrier_post((unsigned*)(ctl + CW_BAR), (volatile LAS unsigned*)((LAS unsigned char*)lds + MISC_OFF) + 8);
    const int lo = args.ph_lo, hi = args.ph_hi;
#ifdef PROBE_TIME_MAIN
    unsigned long long probe_dt_ = 0;
#endif
#ifndef G1_WGM
#define G1_WGM 3
#endif
#ifndef G23_WGM
#define G23_WGM 3
#endif
#ifndef G1_ALIGN
#define G1_ALIGN true
#endif
#ifndef G1_SP2
#define G1_SP2 true
#endif
#ifndef SKREP
#define SKREP 1
#endif
#ifndef PROBE_DBL
#define PROBE_DBL -1
#endif
#define IN(k) (lo <= (k) && (k) < hi)
#define REP(k) for (int rep_ = 0; rep_ < ((k) == PROBE_DBL ? 2 : 1); ++rep_)
#ifndef BAR_REP
#define BAR_REP 1
#endif
#ifndef PROBE_TIME_PHASE
#define PROBE_TIME_PHASE -1
#endif
    unsigned long long ptp_t0_ = 0, ptp_dt_ = 0;
#define PH_BEGIN(k) do { if ((k) == PROBE_TIME_PHASE) ptp_t0_ = __builtin_amdgcn_s_memrealtime(); } while (0)
#define SEAM(k) do { if (IN(k) && IN((k) + 1)) for (int br_ = 0; br_ < BAR_REP; ++br_) xcd_barrier(bar); if ((k) == PROBE_TIME_PHASE) ptp_dt_ = __builtin_amdgcn_s_memrealtime() - ptp_t0_; } while (0)
    const int gw = F.vcu * NWAVES + F.wave, NGW = F.G * NWAVES;
    const int tok0 = (int)(((long)F.vcu * TT) / F.G), tok1 = (int)(((long)(F.vcu + 1) * TT) / F.G);

    PH_BEGIN(0);
    if (IN(0)) REP(0) { p0_prologue(F); __syncthreads(); }
    SEAM(0);
    PH_BEGIN(1);
    if (IN(1)) REP(1) {
        pg8::Gemm g{(const pg8::bf16_t*)(F.ws + WS_XN), (const pg8::bf16_t*)(F.ws + WS_WINT), TP, NP, DM}; pg8::StaticOrder S; S.init(TP, NP, F.G, (int)blockIdx.x, G1_WGM);
        pg8::EpiBf16<0> E{(pg8::bf16_t*)(F.ws + WS_P), PLD, nullptr, 0, 0, 1.f};
        pg8::gemm_phase<pg8::EpiBf16<0>, pg8::StaticOrder, G1_ALIGN, G1_SP2>((PG8_LAS unsigned char*)lds + RING_OFF, g, S, E);
#ifdef GEMM1_TWICE
        pg8::gemm_phase<pg8::EpiBf16<0>, pg8::StaticOrder, G1_ALIGN, G1_SP2>((PG8_LAS unsigned char*)lds + RING_OFF, g, S, E);
#endif
        { EpiSkBf16 Es{(bf16*)(F.ws + WS_P) + (size_t)TP * PLD, PLD, nullptr};
          for (int skr = 0; skr < SKREP; ++skr) for (int ng = F.vcu; ng < NP / 64; ng += F.G) skinny_gemm<4>(F, (const bf16*)(F.ws + WS_XN) + (size_t)TP * DM, (const bf16*)(F.ws + WS_WINT), 64 * ng, Es); }
    }
    SEAM(1);
    PH_BEGIN(2);
    if (IN(2)) REP(2) {
        if (F.G == 256) { for (int i = 0; i < 2; ++i) gla_prep_unit(F, (F.vcu >> 4) * 32 + 2 * (F.vcu & 15) + i); }
        else { for (int u = F.vcu; u < 512; u += F.G) gla_prep_unit(F, u); }
    }
    SEAM(2);
    PH_BEGIN(3);
    if (IN(3)) REP(3) {
#ifdef PROBE_TIME_MAIN
        const unsigned long long tm0_ = __builtin_amdgcn_s_memrealtime();
#endif
        if ((F.vcu & 1) == 0) { for (int g = F.vcu >> 1; g < 128; g += (F.G + 1) >> 1) gla_main_unit<4>(F, g >> 3, g & 7); }
#ifdef PROBE_TIME_MAIN
        probe_dt_ = __builtin_amdgcn_s_memrealtime() - tm0_;
#endif
        volatile LAS unsigned* qslot = (volatile LAS unsigned*)((LAS unsigned char*)lds + LDSCTL_OFF + 16);
#ifndef PROBE_STREAM
#define PROBE_STREAM 1
#endif
        for (int sr = 0; sr < PROBE_STREAM; ++sr) {
            if (sr > 0) xcd_barrier(bar);
            for (;;) {
                if (F.tid == 0) *qslot = __hip_atomic_fetch_add((unsigned*)(ctl + CW_QUEUE + 64 * (rep_ + 2 * sr)), 1u, __ATOMIC_RELAXED, __HIP_MEMORY_SCOPE_AGENT);
                __syncthreads();
                const unsigned u = *qslot;
                __syncthreads();
                if (u >= 512u) break;
                gla_sample_unit(F, (int)u);
            }
        }
    }
    SEAM(3);
    PH_BEGIN(4);
    if (IN(4)) REP(4) {
        bf16* MM = (bf16*)(F.ws + WS_MM);
        for (int it = gw; it < TP; it += NGW) mixer_rows<4>(F, 4 * (it >> 2), it & 3);
        for (int it = gw; it < 4 * TS; it += NGW) mixer_rows<1>(F, TP + (it >> 2), it & 3);
        for (int m = TT + gw; m < MP; m += NGW) zero_row_bf16(MM + (size_t)m * DM, F.lane);
    }
    SEAM(4);
    PH_BEGIN(5);
    if (IN(5)) REP(5) {
        pg8::Gemm g{(const pg8::bf16_t*)(F.ws + WS_MM), (const pg8::bf16_t*)(F.ws + WS_WOUTT), TP, DM, DM}; pg8::StaticOrder S; S.init(TP, DM, F.G, (int)blockIdx.x, G23_WGM);
        pg8::EpiF32Res E{F.xp, (pg8::bf16_t*)(F.ws + WS_H2), (float*)(F.ws + WS_SSQ), DM};
        pg8::gemm_phase<pg8::EpiF32Res, pg8::StaticOrder, true, true>((PG8_LAS unsigned char*)lds + RING_OFF, g, S, E);
#ifdef GEMM2_TWICE
        pg8::gemm_phase<pg8::EpiF32Res, pg8::StaticOrder, true, true>((PG8_LAS unsigned char*)lds + RING_OFF, g, S, E);
#endif
        { EpiSkF32Res Es{F.xs, (bf16*)(F.ws + WS_H2) + (size_t)TP * DM, (float*)(F.ws + WS_SSQS)};
          for (int skr = 0; skr < SKREP; ++skr) for (int un = F.vcu; un < DM / 8; un += F.G) skinny_gemm16(F, (const bf16*)(F.ws + WS_MM) + (size_t)TP * DM, (const bf16*)(F.ws + WS_WOUTT), 16 * (un >> 1), un & 1, Es); }
    }
    SEAM(5);
    PH_BEGIN(6);
    if (IN(6)) REP(6) {
        float* rs_s = (float*)(lds + 131072);
        float* rss_s = rs_s + 512;
        float* RS2 = (float*)(F.ws + WS_RS2);
        pg8::Gemm g{(const pg8::bf16_t*)(F.ws + WS_H2), (const pg8::bf16_t*)(F.ws + WS_WQT), TP, DM, DM}; pg8::StaticOrder S; S.init(TP, DM, F.G, (int)blockIdx.x, G23_WGM);
        { pg8::Unit u0;
          if (S.next(0, u0) && F.tid < 256) { const int row = u0.pm * 256 + F.tid; const f32x4* p = (const f32x4*)((const float*)(F.ws + WS_SSQ) + (size_t)row * 32); f32x4 a4 = p[0];
#pragma unroll
              for (int i = 1; i < 8; ++i) a4 += p[i];
              const float rstd = 1.0f / sqrtf(((a4.x + a4.y) + (a4.z + a4.w)) * (1.0f / DM) + EPS); rs_s[F.tid] = rstd; if (u0.pn == 0) RS2[row] = rstd; }
          if (F.tid >= 256 && F.tid < 384) { const int row = F.tid - 256; const f32x4* p = (const f32x4*)((const float*)(F.ws + WS_SSQS) + (size_t)row * 128); f32x4 a4 = p[0];
#pragma unroll
              for (int i = 1; i < 32; ++i) a4 += p[i];
              const float rstd = 1.0f / sqrtf(((a4.x + a4.y) + (a4.z + a4.w)) * (1.0f / DM) + EPS); rss_s[row] = rstd; if (F.vcu == 0) RS2[TP + row] = rstd; }
          __syncthreads(); }
        pg8::EpiBf16RowScale E{(pg8::bf16_t*)(F.ws + WS_QP), DM, rs_s};
        pg8::gemm_phase<pg8::EpiBf16RowScale, pg8::StaticOrder, true, true>((PG8_LAS unsigned char*)lds + RING_OFF, g, S, E);
#ifdef GEMM3_TWICE
        pg8::gemm_phase<pg8::EpiBf16RowScale, pg8::StaticOrder, true, true>((PG8_LAS unsigned char*)lds + RING_OFF, g, S, E);
#endif
        { EpiSkBf16 Es{(bf16*)(F.ws + WS_QP) + (size_t)TP * DM, DM, rss_s};
          for (int skr = 0; skr < SKREP; ++skr) for (int un = F.vcu; un < DM / 8; un += F.G) skinny_gemm16(F, (const bf16*)(F.ws + WS_H2) + (size_t)TP * DM, (const bf16*)(F.ws + WS_WQT), 16 * (un >> 1), un & 1, Es); }
    }
    SEAM(6);
    PH_BEGIN(7);
    if (IN(7)) REP(7) { bf16x8 qa[2][4]; peer_qfrags(F, tok0, qa); peer_load_subkeys(F); for (int tb = tok0; tb < tok1; tb += 8) peer_topk_tile(F, tb, tok1, qa); __syncthreads(); }
    SEAM(7);
    PH_BEGIN(8);
    if (IN(8)) REP(8) { peer_phase(F, tok0, tok1); }
    if (PROBE_TIME_PHASE == 8) ptp_dt_ = __builtin_amdgcn_s_memrealtime() - ptp_t0_;
    if (PROBE_TIME_PHASE >= 0 && F.vcu == 0) { const unsigned long long te_ = __builtin_amdgcn_s_memrealtime(); while (__builtin_amdgcn_s_memrealtime() - te_ < 9ull * ptp_dt_) __builtin_amdgcn_s_sleep(8); }
#ifdef PROBE_TIME_MAIN
    if (F.vcu == 0) { const unsigned long long te_ = __builtin_amdgcn_s_memrealtime(); while (__builtin_amdgcn_s_memrealtime() - te_ < 9ull * probe_dt_) __builtin_amdgcn_s_sleep(8); }
#endif
#undef IN
#undef SEAM
}

extern "C" void kernel_launch(void* const* d_in, const int* in_sizes, int n_in, void* d_out, int out_size, void* d_ws, size_t ws_size, hipStream_t stream) {
    static int grid = 0;
    if (grid == 0) {
        if (n_in != 18 || ws_size < WS_END) { fprintf(stderr, "kernel_launch: expected 18 inputs and >= %zu bytes of workspace; got %d, %zu\n", (size_t)WS_END, n_in, ws_size); grid = -1; return; }
        int dev = 0, cus = 0;
        if (hipGetDevice(&dev) != hipSuccess || hipDeviceGetAttribute(&cus, hipDeviceAttributeMultiprocessorCount, dev) != hipSuccess) { grid = -1; return; }
        if (hipFuncSetAttribute((const void*)mk_fwd, hipFuncAttributeMaxDynamicSharedMemorySize, LDS_BYTES) != hipSuccess) { fprintf(stderr, "kernel_launch: hipFuncSetAttribute failed\n"); grid = -1; return; }
        (void)hipGetLastError();
        grid = cus;
    }
    if (grid < 0) return;
    (void)hipMemsetAsync((char*)d_ws + WS_CTL, 0, CTL_ZERO_BYTES, stream);
    Args a{};
    for (int i = 0; i < 18; ++i) a.in[i] = (const float*)d_in[i];
    a.out = (float*)d_out; a.ws = (unsigned char*)d_ws;
    if (N_LAUNCHES == 1) { a.ph_lo = 0; a.ph_hi = N_PHASES; hipLaunchKernelGGL(mk_fwd, dim3(grid), dim3(NWAVES * 64), LDS_BYTES, stream, a); }
    else { for (int li = 0; li < N_PHASES; ++li) { a.ph_lo = li; a.ph_hi = li + 1; hipLaunchKernelGGL(mk_fwd, dim3(grid), dim3(NWAVES * 64), LDS_BYTES, stream, a); } }
}
```

```cpp
#include <hip/hip_runtime.h>
#include <cstdio>
#include <cstdint>
#include <cmath>
#define MK_N_LAUNCHES 1
namespace pg8 {
#define PG8_LAS __attribute__((address_space(3)))
typedef unsigned short bf16_t;
typedef short bf16x8 __attribute__((ext_vector_type(8)));
typedef float f32x4 __attribute__((ext_vector_type(4)));
typedef unsigned u32x4 __attribute__((ext_vector_type(4)));
constexpr int BM = 256, BK = 64, HALF = 128, HTB = HALF * BK * 2  , STAGE_BYTES = 8 * HTB, NXCD = 8;
#ifndef PG8_WGM
#define PG8_WGM 3
#endif
constexpr int WGM = PG8_WGM;

__host__ __device__ __forceinline__ int lds_byte(int r, int c) { const int st = (r >> 4) * 2 + (c >> 5), rr = r & 15, cc = c & 31, ob = rr * 64 + cc * 2; return st * 1024 + (ob ^ (((ob >> 9) & 1) << 5)); }
__host__ __device__ __forceinline__ void stage_rc(int b, int& R, int& C) { const int st = b / 1024, sb = b % 1024, swz = sb ^ (((sb >> 9) & 1) << 5); R = (st >> 1) * 16 + swz / 64; C = (st & 1) * 32 + (swz % 64) / 2; }
__host__ __device__ __forceinline__ int perm32(int rho) { const int n = rho >> 4, i = rho & 15; return 8 * (i >> 2) + 4 * n + (i & 3); }

struct Unit { int pm, pn; };
struct Gemm { const bf16_t* A; const bf16_t* Bt; int M, N, K; };

struct StaticOrder {
    int nM, nN, nwg, G, c, wgm;
    __host__ __device__ void init(int M, int N, int G_, int c_, int wgm_ = WGM) { nM = M / BM; nN = N / BM; nwg = nM * nN; G = G_; c = c_; wgm = wgm_; }
    __host__ __device__ bool next(int i, Unit& u) const {
        const long L = (long)i * G + c; if (L >= nwg) return false;
        int wgid = (int)L; if (wgm > 0) { const int q = nwg / NXCD, r = nwg % NXCD, xcd = wgid % NXCD, off = wgid / NXCD; wgid = (xcd < r ? xcd * (q + 1) : r * (q + 1) + (xcd - r) * q) + off; }
        const int wgm = this->wgm > 0 ? this->wgm : -this->wgm;
        const int nig = wgm * nN, gid = wgid / nig, fm = gid * wgm, gsz = (nM - fm) < wgm ? (nM - fm) : wgm;
        u.pm = fm + ((wgid % nig) % gsz); u.pn = (wgid % nig) / gsz; return true;
    }
    __device__ __forceinline__ void a_ready(const Unit&) const {}
    __device__ __forceinline__ void done(const Unit&) const {}
};

__device__ __forceinline__ unsigned cvt_pk_bf16(float lo, float hi) { unsigned r; asm volatile("v_cvt_pk_bf16_f32 %0, %1, %2" : "=v"(r) : "v"(lo), "v"(hi)); return r; }
typedef float f32x2 __attribute__((ext_vector_type(2)));
__device__ __forceinline__ f32x2 gelu_pk(f32x2 v) {
    const f32x2 av = __builtin_elementwise_abs(v), d = av * 0.2316418882f + 1.0f;
    f32x2 t; t.x = __builtin_amdgcn_rcpf(d.x); t.y = __builtin_amdgcn_rcpf(d.y);
    f32x2 q = t * 0.5307027145f + (-0.7265760135f); q = q * t + 0.7107068705f; q = q * t + (-0.142248368f); q = q * t + 0.127414796f; q = q * t;
    const f32x2 s = (v * v) * (-0.72134752044f);
    f32x2 e; e.x = __builtin_amdgcn_exp2f(s.x); e.y = __builtin_amdgcn_exp2f(s.y);
    const f32x2 m = v * (q * e), r = v - m;
    f32x2 o; o.x = v.x < 0.f ? m.x : r.x; o.y = v.y < 0.f ? m.y : r.y; return o;
}

template <int ACT  > struct EpiBf16 {
    static constexpr bool PERM = true, AFTER_DRAIN = false; static_assert(ACT == 0 || ACT == 1, "EpiBf16: ACT is 0 (none) or 1 (gelu_pk)");
    bf16_t* O; int ldc; const float* bias; int split_cols; size_t split_stride; float scale0;
    __device__ __forceinline__ void operator()(const f32x4 (&acc)[2][2][4][2], const Unit& u, int wr, int wc, int fr, int fq) const {
        const int row0 = u.pm * BM + wr * 64 + fr; int colt = u.pn * BM; bf16_t* base = O;
        float sc = 1.f; if (split_cols) { const int t = colt / split_cols; base += (size_t)t * split_stride; colt -= t * split_cols; if (t == 0) sc = scale0; }
        const int col0 = colt + wc * 32 + 8 * fq, bcol0 = u.pn * BM + wc * 32 + 8 * fq;
        f32x4 bv[2][2];
#pragma unroll
        for (int bj = 0; bj < 2; ++bj)
#pragma unroll
            for (int n = 0; n < 2; ++n) bv[bj][n] = bias ? *(const f32x4*)(bias + bcol0 + bj * HALF + 4 * n) : (f32x4){0.f, 0.f, 0.f, 0.f};
#pragma unroll
        for (int ai = 0; ai < 2; ++ai)
#pragma unroll
            for (int m = 0; m < 4; ++m) { bf16_t* rowp = base + (size_t)(row0 + ai * HALF + m * 16) * ldc + col0;
#pragma unroll
                for (int bj = 0; bj < 2; ++bj) { f32x4 v0 = acc[ai][bj][m][0] + bv[bj][0], v1 = acc[ai][bj][m][1] + bv[bj][1];
                    if (ACT == 1) { f32x2 a = gelu_pk((f32x2){v0[0], v0[1]}), b = gelu_pk((f32x2){v0[2], v0[3]}), c = gelu_pk((f32x2){v1[0], v1[1]}), d = gelu_pk((f32x2){v1[2], v1[3]});
                        v0 = (f32x4){a.x, a.y, b.x, b.y}; v1 = (f32x4){c.x, c.y, d.x, d.y}; }
                    v0 = v0 * sc; v1 = v1 * sc; u32x4 w; w.x = cvt_pk_bf16(v0[0], v0[1]); w.y = cvt_pk_bf16(v0[2], v0[3]); w.z = cvt_pk_bf16(v1[0], v1[1]); w.w = cvt_pk_bf16(v1[2], v1[3]);
                    __builtin_nontemporal_store(w, (u32x4*)(rowp + bj * HALF)); } }
    }
};
template <class Epi, class Sched, bool ALIGN_EPI = false, bool SP2 = false>
__device__ __forceinline__ void gemm_phase(PG8_LAS unsigned char* lds, const Gemm g, const Sched& S, const Epi& E) {
    const int tid = threadIdx.x, wid = __builtin_amdgcn_readfirstlane(tid >> 6), lane = tid & 63, wr = wid >> 2, wc = wid & 3, fr = lane & 15, fq = lane >> 4;
    const int K = g.K, nt = K / BK;
    unsigned voffA[2], voffB[2];
#pragma unroll
    for (int i = 0; i < 2; ++i) { int R, C; stage_rc(tid * 16 + i * 8192, R, C); const int Rb = Epi::PERM ? ((R & ~31) + perm32(R & 31)) : R;
        voffA[i] = (unsigned)(R * K + C) * 2u; voffB[i] = (unsigned)(Rb * K + C) * 2u; }
    const size_t kstep = (size_t)(BK * 2);
    const size_t hstep = (size_t)HALF * K * 2;
    const size_t tstep = 2 * hstep;
    const unsigned ldsw = (unsigned)wid * 1024u;
    const int aoff = lds_byte(wr * 64 + fr, fq * 8), boff = lds_byte(wc * 32 + fr, fq * 8);
#define PG8_SA(b, h) (((b) * 2 + (h)) * HTB)
#define PG8_SB(b, h) ((4 + (b) * 2 + (h)) * HTB)
#define PG8_STAGE(bufoff, gbase, voff) do { _Pragma("unroll") for (int _i = 0; _i < 2; ++_i) \
        __builtin_amdgcn_global_load_lds((const unsigned*)((const char*)(gbase) + (voff)[_i]), (PG8_LAS unsigned*)(lds + (bufoff) + ldsw + _i * 8192), 16, 0, 0); } while (0)
#define PG8_LDA(dst, b, h) do { _Pragma("unroll") for (int m = 0; m < 4; ++m) _Pragma("unroll") for (int k = 0; k < 2; ++k) dst[m][k] = *(const PG8_LAS bf16x8*)(lds + PG8_SA(b, h) + aoff + m * 2048 + k * 1024); } while (0)
#define PG8_LDB(dst, b, h) do { _Pragma("unroll") for (int n = 0; n < 2; ++n) _Pragma("unroll") for (int k = 0; k < 2; ++k) dst[n][k] = *(const PG8_LAS bf16x8*)(lds + PG8_SB(b, h) + boff + n * 2048 + k * 1024); } while (0)
#define PG8_MMA(ai, bj, At, Bt) do { __builtin_amdgcn_s_setprio(1); _Pragma("unroll") for (int m = 0; m < 4; ++m) _Pragma("unroll") for (int n = 0; n < 2; ++n) _Pragma("unroll") for (int k = 0; k < 2; ++k) \
        acc[ai][bj][m][n] = __builtin_amdgcn_mfma_f32_16x16x32_bf16(Bt[n][k], At[m][k], acc[ai][bj][m][n], 0, 0, 0); __builtin_amdgcn_s_setprio(0); } while (0)
#define PG8_WAIT_V(n) asm volatile("s_waitcnt vmcnt(" #n ")" ::: "memory")
#define PG8_WAIT_L(n) asm volatile("s_waitcnt lgkmcnt(" #n ")" ::: "memory")
#define PG8_BAR __builtin_amdgcn_s_barrier()
#define PG8_SCHED __builtin_amdgcn_sched_barrier(0)
    Unit cur, nxt; int ui = 0;
    if (!S.next(0, cur)) return;
    f32x4 acc[2][2][4][2];
#pragma unroll
    for (int a = 0; a < 2; ++a)
#pragma unroll
        for (int b = 0; b < 2; ++b)
#pragma unroll
            for (int m = 0; m < 4; ++m)
#pragma unroll
                for (int n = 0; n < 2; ++n) acc[a][b][m][n] = (f32x4){0.f, 0.f, 0.f, 0.f};
    bf16x8 At[4][2], B0[2][2], B1[2][2];
    const char* cA = (const char*)g.A + (size_t)cur.pm * tstep; const char* cB = (const char*)g.Bt + (size_t)cur.pn * tstep;
    S.a_ready(cur);
    if constexpr (SP2) {
        PG8_STAGE(PG8_SB(0, 0), cB, voffB); PG8_STAGE(PG8_SB(0, 1), cB + hstep, voffB); PG8_STAGE(PG8_SA(0, 0), cA, voffA); PG8_STAGE(PG8_SA(0, 1), cA + hstep, voffA);
        if (wr == 1) PG8_BAR;
        PG8_WAIT_V(2); PG8_BAR;
        PG8_STAGE(PG8_SB(1, 0), cB + kstep, voffB); PG8_STAGE(PG8_SA(1, 0), cA + kstep, voffA); PG8_STAGE(PG8_SB(1, 1), cB + hstep + kstep, voffB);
        PG8_WAIT_V(6); PG8_BAR;
    } else {
        PG8_STAGE(PG8_SB(0, 0), cB, voffB); PG8_STAGE(PG8_SA(0, 0), cA, voffA); PG8_STAGE(PG8_SB(0, 1), cB + hstep, voffB); PG8_STAGE(PG8_SA(0, 1), cA + hstep, voffA);
        if (wr == 1) PG8_BAR;
        PG8_WAIT_V(4); PG8_BAR;
        PG8_STAGE(PG8_SB(1, 0), cB + kstep, voffB); PG8_STAGE(PG8_SA(1, 0), cA + kstep, voffA); PG8_STAGE(PG8_SB(1, 1), cB + hstep + kstep, voffB);
        PG8_WAIT_V(6); PG8_BAR;
    }
    for (;;) {
        const bool has_next = S.next(ui + 1, nxt);
        const char* nA = has_next ? (const char*)g.A + (size_t)nxt.pm * tstep : cA; const char* nB = has_next ? (const char*)g.Bt + (size_t)nxt.pn * tstep : cB;
        for (int t = 0; t < nt; t += 2) {
            const bool last = (t == nt - 2);
            const char* a1 = cA + (size_t)(t + 1) * kstep;
            const char* a2 = last ? nA : cA + (size_t)(t + 2) * kstep; const char* b2 = last ? nB : cB + (size_t)(t + 2) * kstep;
            const char* a3 = a2 + kstep; const char* b3 = b2 + kstep;
            if (last && has_next) S.a_ready(nxt);
            if constexpr (SP2) {
            PG8_LDB(B0, 0, 0); PG8_LDB(B1, 0, 1); PG8_SCHED; PG8_LDA(At, 0, 0); PG8_STAGE(PG8_SA(1, 1), a1 + hstep, voffA);
            PG8_WAIT_V(8); PG8_WAIT_L(0); PG8_BAR; PG8_MMA(0, 0, At, B0); PG8_MMA(0, 1, At, B1); PG8_BAR; PG8_SCHED;
            PG8_LDA(At, 0, 1); PG8_STAGE(PG8_SB(0, 0), b2, voffB); PG8_STAGE(PG8_SB(0, 1), b2 + hstep, voffB); PG8_STAGE(PG8_SA(0, 0), a2, voffA);
            PG8_WAIT_V(8); PG8_WAIT_L(0); PG8_BAR; PG8_MMA(1, 0, At, B0); PG8_MMA(1, 1, At, B1); PG8_BAR; PG8_SCHED;
            PG8_LDB(B0, 1, 0); PG8_LDB(B1, 1, 1); PG8_SCHED; PG8_LDA(At, 1, 0); PG8_STAGE(PG8_SA(0, 1), a2 + hstep, voffA);
            PG8_WAIT_V(8); PG8_WAIT_L(0); PG8_BAR; PG8_MMA(0, 0, At, B0); PG8_MMA(0, 1, At, B1); PG8_BAR; PG8_SCHED;
            PG8_LDA(At, 1, 1); PG8_STAGE(PG8_SB(1, 0), b3, voffB); PG8_STAGE(PG8_SB(1, 1), b3 + hstep, voffB); PG8_STAGE(PG8_SA(1, 0), a3, voffA);
            PG8_WAIT_V(8); PG8_WAIT_L(0); PG8_BAR; PG8_MMA(1, 0, At, B0); PG8_MMA(1, 1, At, B1); PG8_BAR; PG8_SCHED;
            } else {
            PG8_LDB(B0, 0, 0); PG8_SCHED; PG8_LDA(At, 0, 0); PG8_STAGE(PG8_SA(1, 1), a1 + hstep, voffA);
            PG8_WAIT_L(8); PG8_BAR; PG8_WAIT_L(0); PG8_MMA(0, 0, At, B0); PG8_BAR; PG8_SCHED;
            PG8_LDB(B1, 0, 1); PG8_STAGE(PG8_SB(0, 0), b2, voffB);
            PG8_BAR; PG8_WAIT_L(0); PG8_MMA(0, 1, At, B1); PG8_BAR;
            PG8_LDA(At, 0, 1); PG8_STAGE(PG8_SA(0, 0), a2, voffA);
            PG8_BAR; PG8_WAIT_L(0); PG8_MMA(1, 0, At, B0); PG8_BAR; PG8_SCHED;
            PG8_STAGE(PG8_SB(0, 1), b2 + hstep, voffB);
            PG8_WAIT_V(6); PG8_BAR; PG8_MMA(1, 1, At, B1); PG8_BAR;
            PG8_LDB(B0, 1, 0); PG8_SCHED; PG8_LDA(At, 1, 0); PG8_STAGE(PG8_SA(0, 1), a2 + hstep, voffA);
            PG8_WAIT_L(8); PG8_BAR; PG8_WAIT_L(0); PG8_MMA(0, 0, At, B0); PG8_BAR; PG8_SCHED;
            PG8_LDB(B1, 1, 1); PG8_STAGE(PG8_SB(1, 0), b3, voffB);
            PG8_BAR; PG8_WAIT_L(0); PG8_MMA(0, 1, At, B1); PG8_BAR;
            PG8_LDA(At, 1, 1); PG8_STAGE(PG8_SA(1, 0), a3, voffA);
            PG8_BAR; PG8_WAIT_L(0); PG8_MMA(1, 0, At, B0); PG8_BAR; PG8_SCHED;
            PG8_STAGE(PG8_SB(1, 1), b3 + hstep, voffB);
            PG8_WAIT_V(6); PG8_BAR; PG8_MMA(1, 1, At, B1); PG8_BAR;
            }
        }
        if constexpr (ALIGN_EPI) { if (wr == 0) PG8_BAR; }
        if constexpr (!Epi::AFTER_DRAIN) { E(acc, cur, wr, wc, fr, fq); S.done(cur); }
        if (!has_next) break;
#pragma unroll
        for (int a = 0; a < 2; ++a)
#pragma unroll
            for (int b = 0; b < 2; ++b)
#pragma unroll
                for (int m = 0; m < 4; ++m)
#pragma unroll
                    for (int n = 0; n < 2; ++n) acc[a][b][m][n] = (f32x4){0.f, 0.f, 0.f, 0.f};
        cur = nxt; cA = nA; cB = nB; ++ui;
        if constexpr (ALIGN_EPI) { if (wr == 1) PG8_BAR; }
    }
    PG8_WAIT_V(0);
    if constexpr (!ALIGN_EPI) { if (wr == 0) PG8_BAR; }
    PG8_BAR;
    if constexpr (Epi::AFTER_DRAIN) { E.fused(acc, cur, wr, wc, fr, fq, lds, wid, lane); S.done(cur); }
#undef PG8_SA
#undef PG8_SB
#undef PG8_STAGE
#undef PG8_LDA
#undef PG8_LDB
#undef PG8_MMA
#undef PG8_WAIT_V
#undef PG8_WAIT_L
#undef PG8_BAR
#undef PG8_SCHED
}
}
#ifndef XP_WAIT_STORES
#define XP_WAIT_STORES 1
#endif
#ifndef QP_NT
#define QP_NT 0
#endif
#ifndef PE_RED_BF16
#define PE_RED_BF16 0
#endif
#ifndef XP_NR
#define XP_NR 2
#endif
#ifndef X_NT
#define X_NT 1
#endif
#ifndef H2_NT
#define H2_NT 0
#endif
struct XTrip { const float* eu; const float* ev; const float* n2g; unsigned char* ws; int gw, ngw; };
typedef float xt_f32x4 __attribute__((ext_vector_type(4)));
__device__ __forceinline__ void expert_trip(const XTrip& X, int trip, int lane);
__device__ __forceinline__ void expert_trip_load(const XTrip& X, int trip, int lane, xt_f32x4 (&x)[XP_NR][8]);
__device__ __forceinline__ void expert_trip_conv(const XTrip& X, int trip, int lane, xt_f32x4 (&x)[XP_NR][8]);
namespace pg8 {
struct EpiF32Res {
    static constexpr bool PERM = false, AFTER_DRAIN = false;
    const float* xp; bf16_t* outb; float* ssq; int ldc;
    __device__ __forceinline__ void operator()(const f32x4 (&acc)[2][2][4][2], const Unit& u, int wr, int wc, int fr, int fq) const {
        const int col0 = u.pn * BM + wc * 32 + 4 * fq;
#pragma unroll
        for (int ai = 0; ai < 2; ++ai) {
            f32x4 xv[4][2][2];
#pragma unroll
            for (int m = 0; m < 4; ++m) { const float* src = xp + (size_t)(u.pm * BM + ai * HALF + wr * 64 + m * 16 + fr) * ldc;
#pragma unroll
                for (int bj = 0; bj < 2; ++bj)
#pragma unroll
                    for (int n = 0; n < 2; ++n) xv[m][bj][n] = X_NT ? __builtin_nontemporal_load((const f32x4*)(src + col0 + bj * HALF + n * 16)) : *(const f32x4*)(src + col0 + bj * HALF + n * 16); }
#pragma unroll
            for (int m = 0; m < 4; ++m) {
                const int row = u.pm * BM + ai * HALF + wr * 64 + m * 16 + fr;
                bf16_t* dstb = outb + (size_t)row * ldc;
                float s = 0.f;
#pragma unroll
                for (int bj = 0; bj < 2; ++bj)
#pragma unroll
                    for (int n = 0; n < 2; ++n) { const int c = col0 + bj * HALF + n * 16; const f32x4 v = xv[m][bj][n] + acc[ai][bj][m][n];
                        s += (v[0] * v[0] + v[1] * v[1]) + (v[2] * v[2] + v[3] * v[3]);
                        typedef unsigned u32x2 __attribute__((ext_vector_type(2))); if (H2_NT) __builtin_nontemporal_store((u32x2){cvt_pk_bf16(v[0], v[1]), cvt_pk_bf16(v[2], v[3])}, (u32x2*)(dstb + c)); else *(u32x2*)(dstb + c) = (u32x2){cvt_pk_bf16(v[0], v[1]), cvt_pk_bf16(v[2], v[3])}; }
                s += __shfl_xor(s, 16); s += __shfl_xor(s, 32);
                if (fq == 0) ssq[(size_t)row * 32 + u.pn * 4 + wc] = s;
            }
        }
    }
};
struct EpiG1 {
    static constexpr bool PERM = true, AFTER_DRAIN = false;
    bf16_t* O; int ldc; XTrip X; mutable int trip;
    __device__ __forceinline__ static float sig(float x) { return __builtin_amdgcn_rcpf(1.0f + __expf(-x)); }
    __device__ __forceinline__ void operator()(const f32x4 (&acc)[2][2][4][2], const Unit& u, int wr, int wc, int fr, int fq) const {
        const int row0 = u.pm * BM + wr * 64 + fr;
#if XP_IN_GEMM1 == 2
        xt_f32x4 xrows[XP_NR][8]; expert_trip_load(X, trip, fr + 16 * fq, xrows);
#endif
        if (u.pn < 16) {
            const int col0 = u.pn * BM + wc * 32 + 8 * fq;
#pragma unroll
            for (int ai = 0; ai < 2; ++ai)
#pragma unroll
                for (int m = 0; m < 4; ++m) { bf16_t* rowp = O + (size_t)(row0 + ai * HALF + m * 16) * ldc + col0;
#pragma unroll
                    for (int bj = 0; bj < 2; ++bj) { const f32x4 v0 = acc[ai][bj][m][0], v1 = acc[ai][bj][m][1];
                        u32x4 w; w.x = cvt_pk_bf16(v0[0], v0[1]); w.y = cvt_pk_bf16(v0[2], v0[3]); w.z = cvt_pk_bf16(v1[0], v1[1]); w.w = cvt_pk_bf16(v1[2], v1[3]);
                        __builtin_nontemporal_store(w, (u32x4*)(rowp + bj * HALF)); } }
        } else {
            const int T = u.pn - 16, type = T >> 4, col0 = 4096 + 128 * T + wc * 32 + 8 * fq;
#pragma unroll
            for (int ai = 0; ai < 2; ++ai)
#pragma unroll
                for (int m = 0; m < 4; ++m) { float o[8];
#pragma unroll
                    for (int n = 0; n < 2; ++n)
#pragma unroll
                        for (int i = 0; i < 4; ++i) { const float a = acc[ai][0][m][n][i], b2 = acc[ai][1][m][n][i];
                            o[4 * n + i] = type == 0 ? a * sig(a) * sig(b2) : type == 1 ? a * sig(b2) : a * b2; }
                    u32x4 w; w.x = cvt_pk_bf16(o[0], o[1]); w.y = cvt_pk_bf16(o[2], o[3]); w.z = cvt_pk_bf16(o[4], o[5]); w.w = cvt_pk_bf16(o[6], o[7]);
                    __builtin_nontemporal_store(w, (u32x4*)(O + (size_t)(row0 + ai * HALF + m * 16) * ldc + col0)); }
        }
#if XP_IN_GEMM1
#if XP_IN_GEMM1 == 2
        expert_trip_conv(X, trip, fr + 16 * fq, xrows); ++trip;
#else
        expert_trip(X, trip, fr + 16 * fq); ++trip;
#endif
#if XP_WAIT_STORES
        asm volatile("s_waitcnt vmcnt(0)" ::: "memory");
#endif
#endif
    }
};

struct EpiBf16RowScale {
    static constexpr bool PERM = true, AFTER_DRAIN = false;
    bf16_t* O; int ldc; const float* rs;
    __device__ __forceinline__ void operator()(const f32x4 (&acc)[2][2][4][2], const Unit& u, int wr, int wc, int fr, int fq) const {
        const int row0 = u.pm * BM + wr * 64 + fr, col0 = u.pn * BM + wc * 32 + 8 * fq;
#pragma unroll
        for (int ai = 0; ai < 2; ++ai)
#pragma unroll
            for (int m = 0; m < 4; ++m) { const int rl = wr * 64 + fr + ai * HALF + m * 16; const float sc = rs[rl]; bf16_t* rowp = O + (size_t)(row0 + ai * HALF + m * 16) * ldc + col0;
#pragma unroll
                for (int bj = 0; bj < 2; ++bj) { const f32x4 v0 = acc[ai][bj][m][0] * sc, v1 = acc[ai][bj][m][1] * sc;
                    u32x4 w; w.x = cvt_pk_bf16(v0[0], v0[1]); w.y = cvt_pk_bf16(v0[2], v0[3]); w.z = cvt_pk_bf16(v1[0], v1[1]); w.w = cvt_pk_bf16(v1[2], v1[3]);
#if QP_NT
                    __builtin_nontemporal_store(w, (u32x4*)(rowp + bj * HALF)); } }
#else
                    *(u32x4*)(rowp + bj * HALF) = w; } }
#endif
    }
};
}

#ifndef MK_N_LAUNCHES
#define MK_N_LAUNCHES 1
#endif
constexpr int N_PHASES = 9;
constexpr int N_LAUNCHES = MK_N_LAUNCHES;
constexpr int NWAVES = 8;

constexpr int DM = 2048;
constexpr int TP = 8192, TS = 128, TT = TP + TS;
constexpr int MP = 8448;
constexpr int NP = 16384;
constexpr int PLD = 10240 + 64;
constexpr int C_Q = 0, C_K = 1024, C_V = 2048, C_GR = 4096, C_CBG = 6144, C_U = 8192;
constexpr int PSLD = NP + 64;
__host__ __device__ constexpr int ps_col(int type, int second, int ch) { return 4096 + ((type * 16 + (ch >> 7)) << 8) + (second << 7) + (ch & 127); }
constexpr int DIN = 16400;
constexpr int NEXP = 16384;
constexpr float EPS = 1e-6f;

constexpr size_t MiB = 1u << 20;
constexpr size_t WS_CTL = 0, CTL_ZERO_BYTES = 128 * 1024;
constexpr size_t WS_WINT = 2 * MiB;
constexpr size_t WS_WOUTT = 68 * MiB;
constexpr size_t WS_WQT = 76 * MiB;
constexpr size_t WS_EU = 84 * MiB;
constexpr size_t WS_EV = 148 * MiB;
constexpr size_t WS_XN = 212 * MiB;
constexpr size_t WS_P = 246 * MiB;
constexpr size_t WS_PS = 446 * MiB;
constexpr size_t WS_QT = 516 * MiB;
constexpr size_t WS_KT = 532 * MiB;
constexpr size_t WS_VT = 548 * MiB;
constexpr size_t WS_ATT = 580 * MiB;
constexpr size_t WS_EBL = 584 * MiB;
constexpr size_t WS_SKB = 585 * MiB;
constexpr size_t WS_O = 586 * MiB;
constexpr size_t WS_MM = 620 * MiB;
constexpr size_t WS_X2 = 654 * MiB;
constexpr size_t WS_H2 = 720 * MiB;
constexpr size_t WS_SSQ = 799 * MiB;
constexpr size_t WS_QP = 754 * MiB;
constexpr size_t WS_IDX = 788 * MiB;
constexpr size_t WS_GW = 793 * MiB;
constexpr size_t WS_ALR = 798 * MiB;
constexpr size_t WS_SSQS = 799 * MiB + 1100 * 1024;
constexpr size_t WS_RS2 = 799 * MiB + 1200 * 1024;
constexpr size_t WS_END = 801 * MiB;
constexpr int CW_TMO = 0, CW_CODE = 1, CW_BAR = 4096, CW_QUEUE = 16384;

constexpr size_t OUT_Y = 0;
constexpr size_t OUT_GLAP = (size_t)TT * DM;
constexpr size_t OUT_CONVP = OUT_GLAP + (size_t)4 * 4 * 256 * 512;
constexpr size_t OUT_GLAS = OUT_CONVP + (size_t)4 * 2 * 2048;
constexpr size_t OUT_CONVS = OUT_GLAS + (size_t)128 * 4 * 256 * 512;

constexpr int LDS_BYTES = 163840;
constexpr int LDSCTL_OFF = 162816, MISC_OFF = LDSCTL_OFF + 320;
constexpr int RING_OFF = 0;

#define GAS __attribute__((address_space(1)))
#define LAS __attribute__((address_space(3)))
typedef unsigned short bf16;
typedef unsigned v4u __attribute__((ext_vector_type(4)));
typedef unsigned v2u __attribute__((ext_vector_type(2)));
typedef float f32x4 __attribute__((ext_vector_type(4)));
typedef short bf16x8 __attribute__((ext_vector_type(8)));
typedef GAS unsigned gu32;
typedef float v32f __attribute__((ext_vector_type(32)));
typedef float v16f __attribute__((ext_vector_type(16)));
typedef float f32x2 __attribute__((ext_vector_type(2)));
typedef unsigned v6u __attribute__((ext_vector_type(6)));
#ifndef EU_FP4
#define EU_FP4 1
#endif
#ifndef PE_DEPTH
#define PE_DEPTH 2
#endif
#ifndef PE_MFMA
#define PE_MFMA 1
#endif
#ifndef PE_VDEPTH
#define PE_VDEPTH 8
#endif
#ifndef XP_IN_GEMM1
#define XP_IN_GEMM1 1
#endif
#ifndef PE_INTERLEAVE
#define PE_INTERLEAVE 0
#endif
constexpr int ROW6 = 1536, ROW4 = 1024;
#define RLX_AGENT __ATOMIC_RELAXED, __HIP_MEMORY_SCOPE_AGENT
#define LDS_WAIT() asm volatile("s_waitcnt lgkmcnt(0)" ::: "memory")
#define VM_WAIT() asm volatile("s_waitcnt vmcnt(0)" ::: "memory")
#define MFMA16(a, b, c) __builtin_amdgcn_mfma_f32_16x16x32_bf16((a), (b), (c), 0, 0, 0)
__device__ __forceinline__ unsigned f2bf(float f) { unsigned u = __builtin_bit_cast(unsigned, f); return (u + 0x7fffu + ((u >> 16) & 1u)) >> 16; }
__device__ __forceinline__ unsigned pk2(float lo, float hi) { return f2bf(lo) | (f2bf(hi) << 16); }
__device__ __forceinline__ float bf2f(unsigned b) { return __builtin_bit_cast(float, b << 16); }
__device__ __forceinline__ float bflo(unsigned w) { return __builtin_bit_cast(float, w << 16); }
__device__ __forceinline__ float bfhi(unsigned w) { return __builtin_bit_cast(float, w & 0xffff0000u); }
__device__ __forceinline__ void unpack8(const v4u w, float (&f)[8]) { f[0] = bflo(w.x); f[1] = bfhi(w.x); f[2] = bflo(w.y); f[3] = bfhi(w.y); f[4] = bflo(w.z); f[5] = bfhi(w.z); f[6] = bflo(w.w); f[7] = bfhi(w.w); }
__device__ __forceinline__ v4u pack8(const float (&f)[8]) { v4u w; w.x = pk2(f[0], f[1]); w.y = pk2(f[2], f[3]); w.z = pk2(f[4], f[5]); w.w = pk2(f[6], f[7]); return w; }
__device__ __forceinline__ float wave_sum(float v) {
#pragma unroll
    for (int o = 1; o < 64; o <<= 1) v += __shfl_xor(v, o);
    return v;
}
__device__ __forceinline__ float sigmoidf_(float x) { return 1.0f / (1.0f + __expf(-x)); }
__device__ __forceinline__ float wave_sum_dpp(float v) {
#define DPP_ADD_(ctrl, rmask) v += __builtin_bit_cast(float, __builtin_amdgcn_update_dpp(0, __builtin_bit_cast(int, v), ctrl, rmask, 0xF, false))
    DPP_ADD_(0xB1, 0xF);
    DPP_ADD_(0x4E, 0xF);
    DPP_ADD_(0x141, 0xF);
    DPP_ADD_(0x140, 0xF);
    DPP_ADD_(0x142, 0xA);
    DPP_ADD_(0x143, 0xC);
#undef DPP_ADD_
    return __builtin_bit_cast(float, __builtin_amdgcn_readlane(__builtin_bit_cast(int, v), 63));
}
__device__ __forceinline__ float gelu_erf(float v) {
    const float t = __builtin_amdgcn_rcpf(fabsf(v) * 0.2316418882f + 1.0f);
    float q = t * 0.5307027145f + (-0.7265760135f); q = q * t + 0.7107068705f; q = q * t + (-0.142248368f); q = q * t + 0.127414796f; q = q * t;
    const float e = __builtin_amdgcn_exp2f((v * v) * (-0.72134752044f));
    const float m = v * (q * e);
    return v < 0.f ? m : v - m;
}
#define XB_TMO      128
#define XB_XCNT(j)  (256  + 64 * (j))
#define XB_XSUB(j)  (1280 + 64 * (j))
#define XB_XGEN(j)  (2304 + 64 * (j))
#define XB_TOP      3328
#define XB_TOPGEN   3392
#define XCD_BAR_WORDS 3456
#define XB_SPIN_CAP (1u << 18)

__device__ __forceinline__ unsigned xb_ld(unsigned* p)              { return __hip_atomic_load(p, __ATOMIC_RELAXED, __HIP_MEMORY_SCOPE_AGENT); }
__device__ __forceinline__ unsigned xb_add(unsigned* p, unsigned v) { return __hip_atomic_fetch_add(p, v, __ATOMIC_RELAXED, __HIP_MEMORY_SCOPE_AGENT); }
__device__ __forceinline__ unsigned xb_xcc_id() { return (unsigned)__builtin_amdgcn_s_getreg((3 << 11) | 20) & 0xFu; }
#define XB_SPIN(cond, bar) do { unsigned _sp = 0; while (cond) { __builtin_amdgcn_s_sleep(1); \
    if ((++_sp & 255u) == 0u) { if (xb_ld(&(bar)[XB_TMO])) break; if (_sp > XB_SPIN_CAP) { atomicAdd(&(bar)[XB_TMO], 1u); break; } } } } while (0)

struct XcdBarrier {
    unsigned* bar; unsigned x;
    volatile LAS unsigned* st;
};

__device__ __forceinline__ XcdBarrier xcd_barrier_post(unsigned* bar, volatile LAS unsigned* st) {
    XcdBarrier b; b.bar = bar; b.x = xb_xcc_id(); b.st = st;
    if (threadIdx.x == 0) (void)xb_add(&bar[XB_XCNT(b.x)], 1u);
    return b;
}
__device__ __forceinline__ void xcd_barrier_complete(unsigned* bar, unsigned x, unsigned& nloc, unsigned& nx) {
    const unsigned G = gridDim.x * gridDim.y * gridDim.z;
    unsigned sum, cnt, mine, sp = 0u;
    for (;;) {
        sum = 0u; cnt = 0u; mine = 0u;
#pragma unroll
        for (unsigned j = 0; j < 16; ++j) { const unsigned c = xb_ld(&bar[XB_XCNT(j)]); sum += c; cnt += (c > 0u) ? 1u : 0u; mine = (j == x) ? c : mine; }
        if (sum == G) break;
        __builtin_amdgcn_s_sleep(1);
        if ((++sp & 255u) == 0u) { if (xb_ld(&bar[XB_TMO])) break; if (sp > XB_SPIN_CAP) { atomicAdd(&bar[XB_TMO], 1u); break; } }
    }
    nloc = mine > 0u ? mine : 1u; nx = cnt > 0u ? cnt : 1u;
}

__device__ __forceinline__ void xcd_barrier(const XcdBarrier& b) {
    asm volatile("s_waitcnt vmcnt(0)" ::: "memory");
    __syncthreads();
    if (threadIdx.x == 0) {
        unsigned* bar = b.bar;
        __builtin_amdgcn_s_waitcnt(0);
        unsigned nloc = b.st[0], nx = b.st[1];
        if (nloc == 0u) { xcd_barrier_complete(bar, b.x, nloc, nx); b.st[0] = nloc; b.st[1] = nx; }
        const unsigned old = xb_add(&bar[XB_XSUB(b.x)], 1u);
        const unsigned gen = old / nloc;
        if (old + 1u == (gen + 1u) * nloc) {
            __builtin_amdgcn_fence(__ATOMIC_RELEASE, "agent");
            asm volatile("s_waitcnt vmcnt(0)" ::: "memory");
            const unsigned og = xb_add(&bar[XB_TOP], 1u);
            const unsigned tg = og / nx;
            if (og + 1u == (tg + 1u) * nx) xb_add(&bar[XB_TOPGEN], 1u);
            else XB_SPIN(xb_ld(&bar[XB_TOPGEN]) == tg, bar);
            __builtin_amdgcn_fence(__ATOMIC_ACQUIRE, "agent");
            xb_add(&bar[XB_XGEN(b.x)], 1u);
            asm volatile("s_waitcnt vmcnt(0)" ::: "memory");
        } else {
            XB_SPIN(xb_ld(&bar[XB_XGEN(b.x)]) == gen, bar);
            __builtin_amdgcn_fence(__ATOMIC_ACQUIRE, "agent");
            asm volatile("s_waitcnt vmcnt(0)" ::: "memory");
        }
    }
    __syncthreads();
}
#define PK_BAR() do { asm volatile("s_waitcnt lgkmcnt(0)" ::: "memory"); __builtin_amdgcn_s_barrier(); asm volatile("" ::: "memory"); } while (0)
struct Frame {
    unsigned char* lds;
    int tid, lane, wave, vcu, G;
    const float *xp, *xs, *sgla, *sconv, *n1g, *win, *wau, *bal, *gng, *cw, *cb, *wout, *n2g, *wq, *sk, *eu, *ev, *nfg;
    float* out;
    unsigned char* ws;
};

__device__ __forceinline__ void p0_transpose_item(const float* W, int ldw, int src_col0, int k0, bf16* WT, int K, int dst_row0, float* scr, int lane, const float* kscale = nullptr) {
    const int n4 = lane & 15, kr = lane >> 4;
#pragma unroll 8
    for (int i = 0; i < 16; ++i) { const int kk = 4 * i + kr; f32x4 v = __builtin_nontemporal_load((const f32x4*)(W + (size_t)(k0 + kk) * ldw + src_col0 + 4 * n4)); if (kscale) v = v * kscale[k0 + kk];
        float* d = scr + kk * 65 + 4 * n4; d[0] = v.x; d[1] = v.y; d[2] = v.z; d[3] = v.w; }
    LDS_WAIT(); asm volatile("" ::: "memory");
    const int c = lane & 7, nr = lane >> 3;
#pragma unroll
    for (int j = 0; j < 8; ++j) { const int n = nr + 8 * j; const float* s = scr + (8 * c) * 65 + n;
        v4u o; o.x = pk2(s[0 * 65], s[1 * 65]); o.y = pk2(s[2 * 65], s[3 * 65]); o.z = pk2(s[4 * 65], s[5 * 65]); o.w = pk2(s[6 * 65], s[7 * 65]);
        *(v4u*)(WT + (size_t)(dst_row0 + n) * K + k0 + 8 * c) = o; }
    LDS_WAIT(); asm volatile("" ::: "memory");
}
__device__ __forceinline__ void rms_row_to_bf16(const float* xrow, const float* g, bf16* orow, int lane) {
    const f32x4* xr = (const f32x4*)xrow + lane; const f32x4* gr = (const f32x4*)g + lane;
    f32x4 v[8]; float s = 0.f;
#pragma unroll
    for (int j = 0; j < 8; ++j) { v[j] = __builtin_nontemporal_load(xr + 64 * j); s += (v[j].x * v[j].x + v[j].y * v[j].y) + (v[j].z * v[j].z + v[j].w * v[j].w); }
    const float rstd = 1.0f / sqrtf(wave_sum_dpp(s) * (1.0f / DM) + EPS);
    v2u* o8 = (v2u*)orow + lane;
#pragma unroll
    for (int j = 0; j < 8; ++j) { const f32x4 gg = gr[64 * j]; v2u w; w.x = pk2(v[j].x * rstd * gg.x, v[j].y * rstd * gg.y); w.y = pk2(v[j].z * rstd * gg.z, v[j].w * rstd * gg.w); o8[64 * j] = w; }
}
__device__ __forceinline__ void rms_row2_to_bf16(const float* xrow0, const float* xrow1, const float* g, bf16* orow0, bf16* orow1, int lane) {
    const f32x4* xa = (const f32x4*)xrow0 + lane; const f32x4* xb = (const f32x4*)xrow1 + lane; const f32x4* gr = (const f32x4*)g + lane;
    f32x4 va[8], vb[8]; float sa = 0.f, sb = 0.f;
#pragma unroll
    for (int j = 0; j < 8; ++j) va[j] = __builtin_nontemporal_load(xa + 64 * j);
#pragma unroll
    for (int j = 0; j < 8; ++j) vb[j] = __builtin_nontemporal_load(xb + 64 * j);
#pragma unroll
    for (int j = 0; j < 8; ++j) sa += (va[j].x * va[j].x + va[j].y * va[j].y) + (va[j].z * va[j].z + va[j].w * va[j].w);
#pragma unroll
    for (int j = 0; j < 8; ++j) sb += (vb[j].x * vb[j].x + vb[j].y * vb[j].y) + (vb[j].z * vb[j].z + vb[j].w * vb[j].w);
    const float ra = 1.0f / sqrtf(wave_sum_dpp(sa) * (1.0f / DM) + EPS), rb = 1.0f / sqrtf(wave_sum_dpp(sb) * (1.0f / DM) + EPS);
    v2u* oa = (v2u*)orow0 + lane; v2u* ob = (v2u*)orow1 + lane;
#pragma unroll
    for (int j = 0; j < 8; ++j) { const f32x4 gg = gr[64 * j]; v2u w; w.x = pk2(va[j].x * ra * gg.x, va[j].y * ra * gg.y); w.y = pk2(va[j].z * ra * gg.z, va[j].w * ra * gg.w); oa[64 * j] = w;
        v2u w2; w2.x = pk2(vb[j].x * rb * gg.x, vb[j].y * rb * gg.y); w2.y = pk2(vb[j].z * rb * gg.z, vb[j].w * rb * gg.w); ob[64 * j] = w2; }
}
__device__ __forceinline__ void zero_row_bf16(bf16* orow, int lane) {
    v2u* o8 = (v2u*)orow + lane; const v2u z = {0u, 0u};
#pragma unroll
    for (int j = 0; j < 8; ++j) o8[64 * j] = z;
}
__device__ __forceinline__ void expert_trip_load(const XTrip& X, int trip, int lane_, f32x4 (&x)[XP_NR][8]) {
    const int NGW = X.ngw; const int r0 = X.gw + trip * XP_NR * NGW;
    if (r0 >= 2 * NEXP) return;
    struct { const float* eu; const float* ev; int lane; } F{X.eu, X.ev, lane_};
#pragma unroll
          for (int q = 0; q < XP_NR; ++q) { const int r = r0 + q * NGW; if (r >= 2 * NEXP) continue; const bool isv = r >= NEXP; const int row = isv ? r - NEXP : r; const float* src = (isv ? F.ev : F.eu) + (size_t)row * DM;
#pragma unroll
              for (int j = 0; j < 8; ++j) x[q][j] = __builtin_nontemporal_load((const f32x4*)(src + 256 * j + 4 * F.lane)); }
}
__device__ __forceinline__ void expert_trip_conv(const XTrip& X, int trip, int lane_, f32x4 (&x)[XP_NR][8]) {
    const int NGW = X.ngw; const int r0 = X.gw + trip * XP_NR * NGW;
    if (r0 >= 2 * NEXP) return;
    unsigned char* U6 = X.ws + WS_EU; unsigned char* V6 = X.ws + WS_EV; float* SU = (float*)(X.ws + WS_EU + 32 * MiB); float* SV = (float*)(X.ws + WS_EV + 32 * MiB);
    struct { const float* n2g; int lane; } F{X.n2g, lane_};
#pragma unroll
          for (int q = 0; q < XP_NR; ++q) { const int r = r0 + q * NGW; if (r >= 2 * NEXP) continue; const bool isv = r >= NEXP; const int row = isv ? r - NEXP : r;
              float amax = 0.f;
#pragma unroll
              for (int j = 0; j < 8; ++j) { if (!isv) x[q][j] = x[q][j] * *(const f32x4*)(F.n2g + 256 * j + 4 * F.lane);
                  amax = fmaxf(amax, fmaxf(fmaxf(fabsf(x[q][j].x), fabsf(x[q][j].y)), fmaxf(fabsf(x[q][j].z), fabsf(x[q][j].w)))); }
#pragma unroll
              for (int o = 1; o < 64; o <<= 1) amax = fmaxf(amax, __shfl_xor(amax, o));
              if (!isv && !EU_FP4) {
                  const float sc = amax > 0.f ? 7.5f / amax : 1.0f;
                  v16f pa, pb;
#pragma unroll
                  for (int j = 0; j < 8; ++j) { pa[2 * j] = x[q][j].x * sc; pb[2 * j] = x[q][j].y * sc; pa[2 * j + 1] = x[q][j].z * sc; pb[2 * j + 1] = x[q][j].w * sc; }
                  const v6u p = __builtin_amdgcn_cvt_scalef32_2xpk16_fp6_f32(pa, pb, 1.0f);
                  unsigned char* dst2 = U6 + (size_t)row * ROW6;
                  __builtin_nontemporal_store((v4u){p[0], p[1], p[2], p[3]}, (v4u*)(dst2 + 16 * F.lane)); __builtin_nontemporal_store((v2u){p[4], p[5]}, (v2u*)(dst2 + 1024 + 8 * F.lane));
                  if (F.lane == 0) SU[row] = amax > 0.f ? amax / 7.5f : 1.0f;
              } else {
                  const float sc = amax > 0.f ? 6.0f / amax : 1.0f;
                  v4u p;
#pragma unroll
                  for (int d = 0; d < 4; ++d) { unsigned w = 0;
                      w = __builtin_amdgcn_cvt_scalef32_pk_fp4_f32(w, x[q][2 * d].x * sc, x[q][2 * d].y * sc, 1.0f, 0); w = __builtin_amdgcn_cvt_scalef32_pk_fp4_f32(w, x[q][2 * d].z * sc, x[q][2 * d].w * sc, 1.0f, 1);
                      w = __builtin_amdgcn_cvt_scalef32_pk_fp4_f32(w, x[q][2 * d + 1].x * sc, x[q][2 * d + 1].y * sc, 1.0f, 2); w = __builtin_amdgcn_cvt_scalef32_pk_fp4_f32(w, x[q][2 * d + 1].z * sc, x[q][2 * d + 1].w * sc, 1.0f, 3);
                      p[d] = w; }
                  if (PE_MFMA && !isv) {
#pragma unroll
                      for (int j = 0; j < 8; ++j) *(unsigned short*)(U6 + (size_t)row * ROW4 + 128 * j + 2 * F.lane) = (unsigned short)(p[j >> 1] >> (16 * (j & 1)));
                  } else
                  __builtin_nontemporal_store(p, (v4u*)((isv ? V6 : U6) + (size_t)row * ROW4 + 16 * F.lane));
                  if (F.lane == 0) (isv ? SV : SU)[row] = amax > 0.f ? amax / 6.0f : 1.0f;
              } }
}
__device__ __forceinline__ void expert_trip(const XTrip& X, int trip, int lane_) { f32x4 x[XP_NR][8]; expert_trip_load(X, trip, lane_, x); expert_trip_conv(X, trip, lane_, x); }
__device__ __forceinline__ void p0_prologue(Frame& F) {
    bf16* WINT = (bf16*)(F.ws + WS_WINT); bf16* WOUTT = (bf16*)(F.ws + WS_WOUTT); bf16* WQT = (bf16*)(F.ws + WS_WQT);
    float* scr = (float*)(F.lds + F.wave * 16640);
    const int gw = F.vcu * NWAVES + F.wave, NGW = F.G * NWAVES;
    { bf16* XN = (bf16*)(F.ws + WS_XN); const int r0 = (int)(((long)F.vcu * TT) / F.G), r1 = (int)(((long)(F.vcu + 1) * TT) / F.G);
      { int m = r0 + F.wave;
        for (; m + NWAVES < r1; m += 2 * NWAVES) { const int m2 = m + NWAVES;
            rms_row2_to_bf16(m < TP ? F.xp + (size_t)m * DM : F.xs + (size_t)(m - TP) * DM, m2 < TP ? F.xp + (size_t)m2 * DM : F.xs + (size_t)(m2 - TP) * DM, F.n1g, XN + (size_t)m * DM, XN + (size_t)m2 * DM, F.lane); }
        if (m < r1) rms_row_to_bf16(m < TP ? F.xp + (size_t)m * DM : F.xs + (size_t)(m - TP) * DM, F.n1g, XN + (size_t)m * DM, F.lane); }
      for (int m = TT + gw; m < MP; m += NGW) zero_row_bf16(XN + (size_t)m * DM, F.lane);
    }
    constexpr int I_IN = 32 * 256, I_SQ = 32 * 32;
    for (int it = gw; it < I_IN + 2 * I_SQ; it += NGW) {
        int r = it;
        if (r < I_IN) { const int kb = r >> 8, nb = r & 255, n0 = 64 * nb; int src = n0;
            if (n0 >= 4096) { const int T = (n0 - 4096) >> 8, type = T >> 4, t = T & 15, w0 = n0 & 255;
                const int first = type == 0 ? 4096 : type == 1 ? 6160 : 8208, second = type == 0 ? 12304 : type == 1 ? 14352 : 10256;
                src = (w0 < 128 ? first : second) + 128 * t + (w0 & 127); }
            p0_transpose_item(F.win, DIN, src, 64 * kb, WINT, DM, n0, scr, F.lane); continue; }
        r -= I_IN;
        if (r < I_SQ) { const int kb = r >> 5, nb = r & 31; p0_transpose_item(F.wout, DM, 64 * nb, 64 * kb, WOUTT, DM, 64 * nb, scr, F.lane); continue; }
        r -= I_SQ;
        { const int kb = r >> 5, nb = r & 31; p0_transpose_item(F.wq, DM, 64 * nb, 64 * kb, WQT, DM, 64 * nb, scr, F.lane, F.n2g); }
    }
    const size_t gt = (size_t)F.vcu * 512 + F.tid, NGT = (size_t)F.G * 512;
    { bf16* SKB = (bf16*)(F.ws + WS_SKB); for (size_t e = gt; e < (size_t)2 * 128 * 128; e += NGT) SKB[e] = (bf16)f2bf(F.sk[e]); }
#if !XP_IN_GEMM1
    { XTrip X{F.eu, F.ev, F.n2g, F.ws, gw, NGW}; for (int t = 0; gw + t * XP_NR * NGW < 2 * NEXP; ++t) expert_trip(X, t, F.lane); }
#endif
    __syncthreads();
    { bf16* wt_s = (bf16*)F.lds; constexpr int WLD = DM + 8;
      for (int k = F.tid; k < DM; k += 512) { const float* src = F.win + (size_t)k * DIN + 6144;
#pragma unroll
          for (int q = 0; q < 4; ++q) { const f32x4 w4 = *(const f32x4*)(src + 4 * q); wt_s[(4 * q + 0) * WLD + k] = (bf16)f2bf(w4.x); wt_s[(4 * q + 1) * WLD + k] = (bf16)f2bf(w4.y); wt_s[(4 * q + 2) * WLD + k] = (bf16)f2bf(w4.z); wt_s[(4 * q + 3) * WLD + k] = (bf16)f2bf(w4.w); } }
      bf16* XN = (bf16*)(F.ws + WS_XN); float* ALR = (float*)(F.ws + WS_ALR);
      const int r0 = (int)(((long)F.vcu * TT) / F.G), r1 = (int)(((long)(F.vcu + 1) * TT) / F.G);
      VM_WAIT(); __syncthreads();
      const int l15 = F.lane & 15, lq = F.lane >> 4;
      { float* part_s = (float*)(F.lds + 16 * WLD * 2 + 256);
        for (int rb = r0; rb < r1; rb += 48) {
        f32x4 acc3[3];
#pragma unroll
        for (int t = 0; t < 3; ++t) { const int row = min(rb + 16 * t + l15, r1 - 1); acc3[t] = (f32x4){0.f, 0.f, 0.f, 0.f};
#pragma unroll
            for (int ks = 0; ks < 8; ++ks) { const int k0 = 256 * F.wave + 32 * ks + 8 * lq; const bf16x8 a = *(const bf16x8*)(XN + (size_t)row * DM + k0); const bf16x8 bq = *(const bf16x8*)(wt_s + l15 * WLD + k0); acc3[t] = MFMA16(a, bq, acc3[t]); } }
#pragma unroll
        for (int t = 0; t < 3; ++t) *(f32x4*)(part_s + ((F.wave * 3 + t) * 64 + F.lane) * 4) = acc3[t];
        __syncthreads();
        for (int e = F.tid; e < 3 * 64; e += 512) { f32x4 sum = {0.f, 0.f, 0.f, 0.f};
#pragma unroll
            for (int w8 = 0; w8 < 8; ++w8) sum += *(const f32x4*)(part_s + ((w8 * 3 + (e >> 6)) * 64 + (e & 63)) * 4);
            const int t = e >> 6, ln = e & 63, c15 = ln & 15, q4 = ln >> 4;
#pragma unroll
            for (int r = 0; r < 4; ++r) { const int m = rb + 16 * t + 4 * q4 + r; if (m < r1) ALR[(size_t)m * 16 + c15] = sum[r]; } }
        __syncthreads(); }
      } }
}

template <int NT, class Epi>
__device__ __forceinline__ void skinny_gemm(Frame& F, const bf16* A, const bf16* Bt, int n0, const Epi& E) {
    constexpr int ROWS = NT * 16, NPC = (ROWS * 32 + 511) / 512, BLD = 264;
    bf16* Bs = (bf16*)F.lds;
    const int tid = F.tid, wv = F.wave, l15 = F.lane & 15, lq = F.lane >> 4;
    f32x4 acc[NT];
#pragma unroll
    for (int nt = 0; nt < NT; ++nt) acc[nt] = (f32x4){0.f, 0.f, 0.f, 0.f};
    const bf16* Arow = A + (size_t)(16 * wv + l15) * DM + 8 * lq;
    v4u bX[NPC], bY[NPC]; bf16x8 aX[8], aY[8];
#define SK_LOADB(BR, kc) do { _Pragma("unroll") for (int i = 0; i < NPC; ++i) { const int p = tid + 512 * i; if (p < ROWS * 32) BR[i] = *(const v4u*)(Bt + (size_t)(n0 + (p >> 5)) * DM + (kc) * 256 + 8 * (p & 31)); } } while (0)
#define SK_LOADA(AR, kc) do { _Pragma("unroll") for (int ks = 0; ks < 8; ++ks) AR[ks] = *(const bf16x8*)(Arow + (kc) * 256 + 32 * ks); } while (0)
#define SK_STOREB(BR, kc) do { bf16* Bn = Bs + ((kc) & 1) * ROWS * BLD; _Pragma("unroll") for (int i = 0; i < NPC; ++i) { const int p = tid + 512 * i; if (p < ROWS * 32) *(v4u*)(Bn + (p >> 5) * BLD + 8 * (p & 31)) = BR[i]; } } while (0)
#define SK_COMP(AR, kc) do { const bf16* Bc = Bs + ((kc) & 1) * ROWS * BLD; _Pragma("unroll") for (int ks = 0; ks < 8; ++ks) _Pragma("unroll") for (int nt = 0; nt < NT; ++nt) { \
        const bf16x8 bq = *(const bf16x8*)(Bc + (16 * nt + l15) * BLD + 32 * ks + 8 * lq); acc[nt] = MFMA16(AR[ks], bq, acc[nt]); } } while (0)
    SK_LOADB(bX, 0); SK_LOADA(aX, 0); SK_LOADB(bY, 1); SK_LOADA(aY, 1);
    SK_STOREB(bX, 0);
    __syncthreads();
#pragma unroll 1
    for (int kc = 0; kc < 8; kc += 2) {
        SK_LOADB(bX, kc + 2 < 8 ? kc + 2 : 7);
        SK_COMP(aX, kc); SK_LOADA(aX, kc + 2 < 8 ? kc + 2 : 7);
        SK_STOREB(bY, kc + 1);
        __syncthreads();
        SK_LOADB(bY, kc + 3 < 8 ? kc + 3 : 7);
        SK_COMP(aY, kc + 1); SK_LOADA(aY, kc + 3 < 8 ? kc + 3 : 7);
        SK_STOREB(bX, kc + 2);
        __syncthreads();
    }
#undef SK_LOADB
#undef SK_LOADA
#undef SK_STOREB
#undef SK_COMP
    E.template tile<NT>(acc, wv, l15, lq, n0);
}
template <class Epi>
__device__ __forceinline__ void skinny_gemm16(Frame& F, const bf16* A, const bf16* Bt, int n0, int rh, const Epi& E) {
    constexpr int BLD = 1024 + 8;
    bf16* Bs = (bf16*)F.lds; float* xs = (float*)(F.lds + 2 * 16 * BLD * 2);
    const int tid = F.tid, wv = F.wave, lane = F.lane, l15 = lane & 15, lq = lane >> 4, mt = wv & 3, kh = wv >> 2;
    const bf16* Arow = A + (size_t)(64 * rh + 16 * mt + l15) * DM + kh * 1024 + 8 * lq;
    v4u bR[8]; bf16x8 aR[32];
#pragma unroll
    for (int i = 0; i < 8; ++i) { const int p = tid + 512 * i; bR[i] = *(const v4u*)(Bt + (size_t)(n0 + (p >> 8)) * DM + 8 * (p & 255)); }
#pragma unroll
    for (int ks = 0; ks < 32; ++ks) aR[ks] = *(const bf16x8*)(Arow + 32 * ks);
#pragma unroll
    for (int i = 0; i < 8; ++i) { const int p = tid + 512 * i, row = p >> 8, k8 = p & 255; *(v4u*)(Bs + ((k8 >> 7) * 16 + row) * BLD + 8 * (k8 & 127)) = bR[i]; }
    __syncthreads();
    f32x4 acc[1] = {(f32x4){0.f, 0.f, 0.f, 0.f}}; f32x4 acc2 = {0.f, 0.f, 0.f, 0.f};
    const bf16* Bc = Bs + (kh * 16 + l15) * BLD + 8 * lq;
#pragma unroll
    for (int ks = 0; ks < 32; ks += 2) { acc[0] = MFMA16(aR[ks], *(const bf16x8*)(Bc + 32 * ks), acc[0]); acc2 = MFMA16(aR[ks + 1], *(const bf16x8*)(Bc + 32 * (ks + 1)), acc2); }
    acc[0] += acc2;
    if (kh) *(f32x4*)(xs + (mt * 64 + lane) * 4) = acc[0];
    __syncthreads();
    if (!kh) { acc[0] += *(const f32x4*)(xs + (mt * 64 + lane) * 4); E.template tile<1>(acc, 4 * rh + mt, l15, lq, n0); }
    __syncthreads();
}
struct EpiSkBf16 { bf16* out; int ldc; const float* rs;
    template <int NT> __device__ __forceinline__ void tile(const f32x4 (&acc)[NT], int wv, int l15, int lq, int n0) const {
#pragma unroll
        for (int r = 0; r < 4; ++r) { const int row = 16 * wv + 4 * lq + r; const float sc = rs ? rs[row] : 1.0f;
#pragma unroll
            for (int nt = 0; nt < NT; ++nt) out[(size_t)row * ldc + n0 + 16 * nt + l15] = (bf16)f2bf(acc[nt][r] * sc); } } };
struct EpiSkF32Res { const float* xs; bf16* outb; float* ssqs;
    template <int NT> __device__ __forceinline__ void tile(const f32x4 (&acc)[NT], int wv, int l15, int lq, int n0) const {
        static_assert(NT == 1, "one 16-column group");
#pragma unroll
        for (int r = 0; r < 4; ++r) { const int row = 16 * wv + 4 * lq + r; const size_t o = (size_t)row * DM + n0 + l15; const float v = xs[o] + acc[0][r]; outb[o] = (bf16)f2bf(v);
            float s = v * v; s += __shfl_xor(s, 1); s += __shfl_xor(s, 2); s += __shfl_xor(s, 4); s += __shfl_xor(s, 8);
            if (l15 == 0) ssqs[row * 128 + (n0 >> 4)] = s; } } };

__device__ __forceinline__ float logsig(float x) { return fminf(x, 0.f) - __logf(1.0f + __expf(-fabsf(x))); }
__device__ __forceinline__ void gla_prep_load(Frame& F, int u, v4u (&tq)[4], v4u (&tk)[4]) {
    const bf16* P = (const bf16*)(F.ws + WS_P);
    const int b = u >> 7, h = (u >> 5) & 3, c = u & 31, tid = F.tid;
    const int row0 = b * 2048 + c * 64;
#pragma unroll
      for (int i = 0; i < 4; ++i) { const int p = tid + 512 * i, row = p >> 5, ch = p & 31; const bf16* src = P + (size_t)(row0 + row) * PLD + h * 256 + 8 * ch; tq[i] = __builtin_nontemporal_load((const v4u*)(src + C_Q)); tk[i] = __builtin_nontemporal_load((const v4u*)(src + C_K)); }
}
__device__ __forceinline__ void gla_prep_unit(Frame& F, int u, const v4u (&tq)[4], const v4u (&tk)[4]) {
    const bf16* P = (const bf16*)(F.ws + WS_P); bf16* QT = (bf16*)(F.ws + WS_QT); bf16* KT = (bf16*)(F.ws + WS_KT);
    bf16* ATT = (bf16*)(F.ws + WS_ATT); float* EBL = (float*)(F.ws + WS_EBL);
    const int b = u >> 7, h = (u >> 5) & 3, c = u & 31, tid = F.tid;
    const int row0 = b * 2048 + c * 64;
    float* alr_s = (float*)F.lds;
    float* tot_s = (float*)(F.lds + 4096);
    bf16* q_s = (bf16*)(F.lds + 8192);
    bf16* k_s = q_s + 64 * 264;
    bf16* a_s = k_s + 64 * 264;
    {
      for (int e = tid; e < 1024; e += 512) alr_s[e] = ((const float*)(F.ws + WS_ALR))[(size_t)row0 * 16 + e];
#pragma unroll
      for (int i = 0; i < 4; ++i) { const int p = tid + 512 * i, row = p >> 5, ch = p & 31; *(v4u*)(q_s + row * 264 + 8 * ch) = tq[i]; *(v4u*)(k_s + row * 264 + 8 * ch) = tk[i]; }
    }
    const int d = tid & 255, half = tid >> 8;
    float w[16];
#pragma unroll
    for (int r = 0; r < 16; ++r) w[r] = F.wau[r * 1024 + h * 256 + d];
    const float bias = F.bal[h * 256 + d];
    __syncthreads();
    float bb[32]; float run = 0.f;
#pragma unroll
    for (int jj = 0; jj < 32; ++jj) { const int j = half * 32 + jj; float x = bias;
#pragma unroll
        for (int r = 0; r < 16; ++r) x += alr_s[j * 16 + r] * w[r];
        run += logsig(x) * 0.0625f; bb[jj] = run; }
    if (half == 0) tot_s[d] = run;
    __syncthreads();
    if (half == 1) { const float t = tot_s[d];
#pragma unroll
        for (int jj = 0; jj < 32; ++jj) bb[jj] += t; }
#pragma unroll
    for (int jj = 0; jj < 32; ++jj) { const int j = half * 32 + jj;
        const float qv = bf2f(q_s[j * 264 + d]), kv = bf2f(k_s[j * 264 + d]);
        const float e = __expf(bb[jj]), ei = __expf(-bb[jj]);
        q_s[j * 264 + d] = (bf16)f2bf(qv * 0.0625f * e); k_s[j * 264 + d] = (bf16)f2bf(kv * ei); }
    if (half == 1) EBL[u * 256 + d] = __expf(bb[31]);
    __syncthreads();
    { const int wv = F.wave, l15 = F.lane & 15, lq = F.lane >> 4, mi = wv >> 1;
#pragma unroll
      for (int nn = 0; nn < 2; ++nn) { const int ni = (wv & 1) * 2 + nn; f32x4 acc = {0.f, 0.f, 0.f, 0.f};
#pragma unroll
          for (int ks = 0; ks < 8; ++ks) { const bf16x8 a = *(const bf16x8*)(q_s + (16 * mi + l15) * 264 + 32 * ks + 8 * lq); const bf16x8 bq = *(const bf16x8*)(k_s + (16 * ni + l15) * 264 + 32 * ks + 8 * lq); acc = MFMA16(a, bq, acc); }
#pragma unroll
          for (int r = 0; r < 4; ++r) { const int i = 16 * mi + 4 * lq + r, jn = 16 * ni + l15; a_s[i * 72 + jn] = (bf16)f2bf(jn <= i ? acc[r] : 0.f); } } }
#pragma unroll
    for (int i = 0; i < 4; ++i) { const int p = tid + 512 * i, f = p >> 6, ln = p & 63, l15 = ln & 15, lq = ln >> 4;
        { const int mi = f >> 3, kh = (f >> 2) & 1, ks = f & 3; *(v4u*)(QT + (size_t)u * 16384 + (size_t)p * 8) = *(const v4u*)(q_s + (16 * mi + l15) * 264 + 128 * kh + 32 * ks + 8 * lq); }
        { const int wv2 = f >> 2, t2 = (f >> 1) & 1, ks = f & 1, dd = 32 * wv2 + 16 * t2 + l15, j0 = 32 * ks + 8 * lq; v4u o;
          o.x = (unsigned)k_s[(j0 + 0) * 264 + dd] | ((unsigned)k_s[(j0 + 1) * 264 + dd] << 16); o.y = (unsigned)k_s[(j0 + 2) * 264 + dd] | ((unsigned)k_s[(j0 + 3) * 264 + dd] << 16);
          o.z = (unsigned)k_s[(j0 + 4) * 264 + dd] | ((unsigned)k_s[(j0 + 5) * 264 + dd] << 16); o.w = (unsigned)k_s[(j0 + 6) * 264 + dd] | ((unsigned)k_s[(j0 + 7) * 264 + dd] << 16);
          *(v4u*)(KT + (size_t)u * 16384 + (size_t)p * 8) = o; } }
    PK_BAR();
    { const int p = tid, f = p >> 6, ln = p & 63, l15 = ln & 15, lq = ln >> 4, mi = f >> 1, kh = f & 1;
      *(v4u*)(ATT + (size_t)u * 4096 + (size_t)p * 8) = *(const v4u*)(a_s + (16 * mi + l15) * 72 + 32 * kh + 8 * lq); }
    PK_BAR();
}

__device__ __forceinline__ void gla_sample_unit(Frame& F, int u) {
    const bf16* P = (const bf16*)(F.ws + WS_P); bf16* O = (bf16*)(F.ws + WS_O);
    const int n = u >> 2, h = u & 3, tid = F.tid, lane = F.lane, wv = F.wave;
    const size_t m = (size_t)(TP + n); const bf16* PSr = (const bf16*)(F.ws + WS_PS) + (size_t)n * PSLD;
    float* e_s = (float*)F.lds;
    float* qe_s = e_s + 256;
    float* k_s = qe_s + 256;
    float* v_s = k_s + 256;
    float* red_s = v_s + 512;
    float* op_s = red_s + 64;
    float part = 0.f;
    if (tid < 256) { const int d = tid; float x = F.bal[h * 256 + d];
#pragma unroll
        for (int r = 0; r < 16; ++r) x += ((const float*)(F.ws + WS_ALR))[m * 16 + r] * F.wau[r * 1024 + h * 256 + d];
        const float la = logsig(x) * 0.0625f, e = __expf(la);
        const float q = bf2f(PSr[C_Q + h * 256 + d]) * 0.0625f, k = bf2f(PSr[C_K + h * 256 + d]);
        e_s[d] = e; qe_s[d] = q * e; k_s[d] = k; part = q * k; }
    v_s[tid] = bf2f(PSr[C_V + h * 512 + tid]);
    part = wave_sum_dpp(part);
    if (lane == 0) red_s[wv] = part;
    __syncthreads();
    const float attn = (red_s[0] + red_s[1]) + (red_s[2] + red_s[3]);
    const float* Sin = F.sgla + ((size_t)(n * 4 + h) * 256) * 512; float* Sout = F.out + OUT_GLAS + ((size_t)(n * 4 + h) * 256) * 512;
    const f32x4 v0 = *(const f32x4*)(v_s + 4 * lane), v1 = *(const f32x4*)(v_s + 256 + 4 * lane);
    f32x4 o0 = {0.f, 0.f, 0.f, 0.f}, o1 = {0.f, 0.f, 0.f, 0.f};
#pragma unroll 1
    for (int g = 0; g < 2; ++g) {
        f32x4 s0[16], s1[16];
#pragma unroll
        for (int i = 0; i < 16; ++i) { const int d = 32 * wv + 16 * g + i; s0[i] = __builtin_nontemporal_load((const f32x4*)(Sin + (size_t)d * 512 + 4 * lane)); s1[i] = __builtin_nontemporal_load((const f32x4*)(Sin + (size_t)d * 512 + 256 + 4 * lane)); }
#pragma unroll
        for (int i = 0; i < 16; ++i) { const int d = 32 * wv + 16 * g + i; const float e = e_s[d], qe = qe_s[d], k = k_s[d];
            o0 += s0[i] * qe; o1 += s1[i] * qe;
            __builtin_nontemporal_store(s0[i] * e + v0 * k, (f32x4*)(Sout + (size_t)d * 512 + 4 * lane)); __builtin_nontemporal_store(s1[i] * e + v1 * k, (f32x4*)(Sout + (size_t)d * 512 + 256 + 4 * lane)); }
    }
    *(f32x4*)(op_s + wv * 512 + 4 * lane) = o0; *(f32x4*)(op_s + wv * 512 + 256 + 4 * lane) = o1;
    __syncthreads();
    { float o = attn * v_s[tid];
#pragma unroll
      for (int w8 = 0; w8 < 8; ++w8) o += op_s[w8 * 512 + tid];
      O[m * DM + h * 512 + tid] = (bf16)f2bf(o); }
    __syncthreads();
}

struct GlaRegs { bf16x8 kt[2][2], at, q[4]; v4u vpiece; float epiece; };
struct GlaOffs { unsigned l16, vt, eb; };
template <int NT>
__device__ __forceinline__ GlaOffs gla_offs(int lane, int tid) {
    const int tv = tid & (NT * 128 - 1); GlaOffs o;
    o.l16 = (unsigned)(lane * 16);
    o.vt = (unsigned)(((tv / (2 * NT)) * PLD + 8 * (tv % (2 * NT))) * 2);
    o.eb = (unsigned)((tid & 255) * 4);
    return o;
}
template <int NT>
__device__ __forceinline__ void gla_load(GlaRegs& R, const GlaOffs& o, const bf16* QT, const bf16* KT, const bf16* VT, const bf16* ATT, const float* EBL, int bh, int s, int c, int wv) {
    const size_t u = (size_t)bh * 32 + c;
    const char* pa = (const char*)(ATT + u * 4096) + wv * 1024; const char* pv = (const char*)(VT + ((size_t)(bh >> 2) * 2048 + 64 * c) * PLD + C_V + (bh & 3) * 512 + 16 * NT * s);
    const char* pq = (const char*)(QT + u * 16384) + wv * 4096; const char* pk = (const char*)(KT + u * 16384) + wv * 4096;
    R.at = *(const bf16x8*)(pa + o.l16);
    R.vpiece = *(const v4u*)(pv + o.vt);
    R.epiece = *(const float*)((const char*)(EBL + u * 256) + o.eb);
#pragma unroll
    for (int ks = 0; ks < 4; ++ks) R.q[ks] = *(const bf16x8*)(pq + o.l16 + 1024 * ks);
#pragma unroll
    for (int t = 0; t < 2; ++t)
#pragma unroll
        for (int ks = 0; ks < 2; ++ks) R.kt[t][ks] = *(const bf16x8*)(pk + o.l16 + 2048 * t + 1024 * ks);
}
constexpr int VT_LD = 72;
template <int NT>
__device__ __forceinline__ void gla_vt_store(bf16* vts, const v4u piece, int tid) {
    const int j = tid / (2 * NT), d0 = 8 * (tid % (2 * NT));
#pragma unroll
    for (int q = 0; q < 4; ++q) { vts[(d0 + 2 * q) * VT_LD + j] = (bf16)(piece[q] & 0xffffu); vts[(d0 + 2 * q + 1) * VT_LD + j] = (bf16)(piece[q] >> 16); }
}
template <int NT>
__device__ __forceinline__ void gla_step(const GlaRegs& R, const float* ebs, f32x4 (&S)[2][NT], const bf16* vts, const bf16* STp, bf16* STn, float* xo, int wv, int lane, int l15, int lq) {
    const int mi = wv >> 1, kh = wv & 1;
#pragma unroll
    for (int nt = 0; nt < NT; ++nt) {
        f32x4 acc = {0.f, 0.f, 0.f, 0.f};
        { const bf16x8 vsel = *(const bf16x8*)(vts + (16 * nt + l15) * VT_LD + 32 * kh + 8 * lq); acc = MFMA16(R.at, vsel, acc); }
#pragma unroll
        for (int ks = 0; ks < 4; ++ks) { const bf16x8 sf = *(const bf16x8*)(STp + (16 * nt + l15) * 264 + 128 * kh + 32 * ks + 8 * lq); acc = MFMA16(R.q[ks], sf, acc); }
        *(f32x4*)(xo + (((mi * 2 + kh) * NT + nt) * 64 + lane) * 4) = acc;
    }
#pragma unroll
    for (int nt = 0; nt < NT; ++nt) {
        bf16x8 vt[2];
#pragma unroll
        for (int ks = 0; ks < 2; ++ks) vt[ks] = *(const bf16x8*)(vts + (16 * nt + l15) * VT_LD + 32 * ks + 8 * lq);
#pragma unroll
        for (int mt = 0; mt < 2; ++mt) {
#pragma unroll
            for (int ks = 0; ks < 2; ++ks) S[mt][nt] = MFMA16(R.kt[mt][ks], vt[ks], S[mt][nt]);
            S[mt][nt] = S[mt][nt] * *(const f32x4*)(ebs + 32 * wv + 16 * mt + 4 * lq);
            v2u w; w.x = pg8::cvt_pk_bf16(S[mt][nt][0], S[mt][nt][1]); w.y = pg8::cvt_pk_bf16(S[mt][nt][2], S[mt][nt][3]);
            *(v2u*)(STn + (16 * nt + l15) * 264 + 32 * wv + 16 * mt + 4 * lq) = w; } }
}
template <int NT>
__device__ __forceinline__ void gla_store_o(const float* xo, bf16* O, int b, int h, int s, int c, int wv, int lane, int l15, int lq) {
    const int mi = wv >> 1, kh = wv & 1;
#pragma unroll
    for (int n2 = 0; n2 < NT / 2; ++n2) { const int nt = kh * (NT / 2) + n2;
        const f32x4 t = *(const f32x4*)(xo + (((mi * 2 + 0) * NT + nt) * 64 + lane) * 4) + *(const f32x4*)(xo + (((mi * 2 + 1) * NT + nt) * 64 + lane) * 4);
        const unsigned p01 = pg8::cvt_pk_bf16(t[0], t[1]), p23 = pg8::cvt_pk_bf16(t[2], t[3]);
        bf16* dst = O + ((size_t)b * 2048 + 64 * c + 16 * mi + 4 * lq) * DM + h * 512 + 16 * NT * s + 16 * nt + l15;
        dst[0] = (bf16)(p01 & 0xffffu); dst[DM] = (bf16)(p01 >> 16); dst[2 * DM] = (bf16)(p23 & 0xffffu); dst[3 * DM] = (bf16)(p23 >> 16); }
}
#define GLA_BAR() do { asm volatile("s_waitcnt lgkmcnt(0)" ::: "memory"); __builtin_amdgcn_s_barrier(); asm volatile("" ::: "memory"); } while (0)
template <int NT>
__device__ __forceinline__ void gla_main_unit(Frame& F, int bh, int s) {
    const bf16* QT = (const bf16*)(F.ws + WS_QT); const bf16* KT = (const bf16*)(F.ws + WS_KT); const bf16* VT = (const bf16*)(F.ws + WS_P);
    const bf16* ATT = (const bf16*)(F.ws + WS_ATT); const float* EBL = (const float*)(F.ws + WS_EBL); bf16* O = (bf16*)(F.ws + WS_O);
    const int b = bh >> 2, h = bh & 3, wv = F.wave, lane = F.lane, l15 = lane & 15, lq = lane >> 4, kh = wv & 1, tid = F.tid;
    constexpr int ST_ELEMS = NT * 16 * 264, XO_FLOATS = 8 * NT * 256, VTS_ELEMS = NT * 16 * VT_LD;
    bf16* ST = (bf16*)F.lds;
    float* XO = (float*)(F.lds + 2 * ST_ELEMS * 2);
    bf16* VTS = (bf16*)(F.lds + 2 * ST_ELEMS * 2 + 2 * XO_FLOATS * 4);
    float* EBS = (float*)(F.lds + 2 * ST_ELEMS * 2 + 2 * XO_FLOATS * 4 + 2 * VTS_ELEMS * 2);
    for (int e = tid; e < ST_ELEMS; e += 512) ((unsigned*)ST)[e] = 0u;
    f32x4 S[2][NT];
#pragma unroll
    for (int a = 0; a < 2; ++a)
#pragma unroll
        for (int c2 = 0; c2 < NT; ++c2) S[a][c2] = (f32x4){0.f, 0.f, 0.f, 0.f};
    const GlaOffs go = gla_offs<NT>(lane, tid);
    GlaRegs RA, RB, RC;
    gla_load<NT>(RA, go, QT, KT, VT, ATT, EBL, bh, s, 0, wv);
    gla_load<NT>(RB, go, QT, KT, VT, ATT, EBL, bh, s, 1, wv);
    if (tid < NT * 128) gla_vt_store<NT>(VTS, RA.vpiece, tid);
    if (tid < 256) EBS[tid] = RA.epiece;
    __syncthreads();
#define GLA_ITER(c, RCUR, RNXT, RLD) do { if ((c) < 32) { \
            gla_load<NT>(RLD, go, QT, KT, VT, ATT, EBL, bh, s, (c) + 2 < 32 ? (c) + 2 : 31, wv); \
            gla_step<NT>(RCUR, EBS + ((c) & 1) * 256, S, VTS + ((c) & 1) * VTS_ELEMS, ST + ((c) & 1) * ST_ELEMS, ST + (((c) + 1) & 1) * ST_ELEMS, XO + ((c) & 1) * XO_FLOATS, wv, lane, l15, lq); \
            if ((c) > 0) gla_store_o<NT>(XO + (((c) + 1) & 1) * XO_FLOATS, O, b, h, s, (c) - 1, wv, lane, l15, lq); \
            if (tid < NT * 128) gla_vt_store<NT>(VTS + (((c) + 1) & 1) * VTS_ELEMS, RNXT.vpiece, tid); \
            if (tid < 256) EBS[(((c) + 1) & 1) * 256 + tid] = RNXT.epiece; \
            GLA_BAR(); \
        } } while (0)
#pragma unroll 1
    for (int c = 0; c < 33; c += 3) { GLA_ITER(c, RA, RB, RC); GLA_ITER(c + 1, RB, RC, RA); GLA_ITER(c + 2, RC, RA, RB); }
#undef GLA_ITER
    gla_store_o<NT>(XO + (31 & 1) * XO_FLOATS, O, b, h, s, 31, wv, lane, l15, lq);
    int lq2 = lq; asm volatile("" : "+v"(lq2));
    float* So = F.out + OUT_GLAP + ((size_t)bh * 256) * 512;
#pragma unroll
    for (int mt = 0; mt < 2; ++mt)
#pragma unroll
        for (int nt = 0; nt < NT; ++nt)
#pragma unroll
            for (int r = 0; r < 4; ++r) So[(size_t)(32 * wv + 16 * mt + 4 * lq2 + r) * 512 + 16 * NT * s + 16 * nt + l15] = S[mt][nt][r];
    __syncthreads();
}

__device__ __forceinline__ void ld8f(const float* p, float (&f)[8]) { const f32x4 a = *(const f32x4*)p, b = *(const f32x4*)(p + 4); f[0] = a.x; f[1] = a.y; f[2] = a.z; f[3] = a.w; f[4] = b.x; f[5] = b.y; f[6] = b.z; f[7] = b.w; }
struct MixIn { v4u lo[4], lgr[4], lcbg[4], lu[4], pu1, pu2; };
__device__ __forceinline__ void mixer_prompt_load(Frame& F, int m0, int j, MixIn& I) {
    const bf16* P = (const bf16*)(F.ws + WS_P); const bf16* O = (const bf16*)(F.ws + WS_O);
    const int col = 512 * j + 8 * F.lane, t0 = m0 & 2047;
    const bf16* Pr0 = P + (size_t)m0 * PLD;
    I.pu1 = (v4u){0u, 0u, 0u, 0u}; I.pu2 = (v4u){0u, 0u, 0u, 0u};
    if (t0 >= 1) I.pu1 = *(const v4u*)(Pr0 - PLD + C_U + col);
    if (t0 >= 2) I.pu2 = *(const v4u*)(Pr0 - 2 * PLD + C_U + col);
#pragma unroll
    for (int r = 0; r < 4; ++r) { const int m = m0 + r; const bf16* Pr = P + (size_t)m * PLD;
        I.lo[r] = *(const v4u*)(O + (size_t)m * DM + col);
        I.lgr[r] = __builtin_nontemporal_load((const v4u*)(Pr + C_GR + col)); I.lcbg[r] = __builtin_nontemporal_load((const v4u*)(Pr + C_CBG + col)); I.lu[r] = *(const v4u*)(Pr + C_U + col); }
}
__device__ __forceinline__ void mixer_prompt_run(Frame& F, int m0, int j, const MixIn& I) {
    bf16* MM = (bf16*)(F.ws + WS_MM);
    const int lane = F.lane, col = 512 * j + 8 * lane;
    float u1[8], u2[8], gn[8], cbi[8], w0[8], w1[8], w2[8];
    ld8f(F.gng + col, gn); ld8f(F.cb + col, cbi); ld8f(F.cw + col, w0); ld8f(F.cw + DM + col, w1); ld8f(F.cw + 2 * DM + col, w2);
    unpack8(I.pu1, u1); unpack8(I.pu2, u2);
#pragma unroll
    for (int r = 0; r < 4; ++r) {
        const int m = m0 + r, t = m & 2047;
        float o[8], gr[8], cbg[8], u[8];
        unpack8(I.lo[r], o); unpack8(I.lgr[r], gr); unpack8(I.lcbg[r], cbg); unpack8(I.lu[r], u);
        float ss = 0.f;
#pragma unroll
        for (int e = 0; e < 8; ++e) ss += o[e] * o[e];
        const float rstd = 1.0f / sqrtf(wave_sum_dpp(ss) * (1.0f / 512.0f) + EPS);
        if (t >= 2046) { float* dst = F.out + OUT_CONVP + ((size_t)(m >> 11) * 2 + (t - 2046)) * DM + col;
            *(f32x4*)dst = (f32x4){u[0], u[1], u[2], u[3]}; *(f32x4*)(dst + 4) = (f32x4){u[4], u[5], u[6], u[7]}; }
        float mv[8];
#pragma unroll
        for (int e = 0; e < 8; ++e) {
            const float z = cbi[e] + w0[e] * u2[e] + w1[e] * u1[e] + w2[e] * u[e];
            mv[e] = gr[e] * (o[e] * rstd * gn[e]) + cbg[e] * z;
            u2[e] = u1[e]; u1[e] = u[e];
        }
        *(v4u*)(MM + (size_t)m * DM + col) = pack8(mv);
    }
}
__device__ __forceinline__ void mixer_sample_row(Frame& F, int n, int j) {
    const bf16* PSr = (const bf16*)(F.ws + WS_PS) + (size_t)n * PSLD; const bf16* O = (const bf16*)(F.ws + WS_O); bf16* MM = (bf16*)(F.ws + WS_MM);
    const int lane = F.lane, col = 512 * j + 8 * lane, m = TP + n;
    float u1[8], u2[8], gn[8], cbi[8], w0[8], w1[8], w2[8];
    ld8f(F.gng + col, gn); ld8f(F.cb + col, cbi); ld8f(F.cw + col, w0); ld8f(F.cw + DM + col, w1); ld8f(F.cw + 2 * DM + col, w2);
    { const float* sc = F.sconv + (size_t)n * 2 * DM + col; ld8f(sc, u2); ld8f(sc + DM, u1); }
    float o[8], rr[8], cbv[8], cc[8], cx[8], ga[8], gb[8], u[8];
    unpack8(*(const v4u*)(O + (size_t)m * DM + col), o);
    unpack8(*(const v4u*)(PSr + ps_col(0, 0, col)), rr); unpack8(*(const v4u*)(PSr + ps_col(0, 1, col)), ga); unpack8(*(const v4u*)(PSr + ps_col(1, 0, col)), cbv); unpack8(*(const v4u*)(PSr + ps_col(1, 1, col)), gb);
    unpack8(*(const v4u*)(PSr + ps_col(2, 0, col)), cc); unpack8(*(const v4u*)(PSr + ps_col(2, 1, col)), cx);
    float ss = 0.f;
#pragma unroll
    for (int e = 0; e < 8; ++e) ss += o[e] * o[e];
    const float rstd = 1.0f / sqrtf(wave_sum_dpp(ss) * (1.0f / 512.0f) + EPS);
#pragma unroll
    for (int e = 0; e < 8; ++e) u[e] = cc[e] * cx[e];
    { float* dst = F.out + OUT_CONVS + (size_t)n * 2 * DM + col;
      *(f32x4*)dst = (f32x4){u1[0], u1[1], u1[2], u1[3]}; *(f32x4*)(dst + 4) = (f32x4){u1[4], u1[5], u1[6], u1[7]};
      *(f32x4*)(dst + DM) = (f32x4){u[0], u[1], u[2], u[3]}; *(f32x4*)(dst + DM + 4) = (f32x4){u[4], u[5], u[6], u[7]}; }
    float mv[8];
#pragma unroll
    for (int e = 0; e < 8; ++e) {
        const float ya = (rr[e] * sigmoidf_(rr[e])) * (o[e] * rstd * gn[e]);
        const float z = cbi[e] + w0[e] * u2[e] + w1[e] * u1[e] + w2[e] * u[e];
        mv[e] = sigmoidf_(ga[e]) * ya + sigmoidf_(gb[e]) * (cbv[e] * z);
    }
    *(v4u*)(MM + (size_t)m * DM + col) = pack8(mv);
}

constexpr int SC_LD = 130;
__device__ __forceinline__ int f2sort(float f) { const int b = __float_as_int(f); return b ^ ((b >> 31) & 0x7fffffff); }
__device__ __forceinline__ float sort2f(int s) { return __int_as_float(s ^ ((s >> 31) & 0x7fffffff)); }
#define CE_DESC(x, y) do { const int mx_ = max(x, y), mn_ = min(x, y); x = mx_; y = mn_; } while (0)
template <int N> __device__ __forceinline__ void bitonic_sort_desc(int (&a)[N]) {
#pragma unroll
    for (int k = 2; k <= N; k <<= 1)
#pragma unroll
        for (int j = k >> 1; j > 0; j >>= 1)
#pragma unroll
            for (int i = 0; i < N; ++i) { const int l = i ^ j; if (l > i) { if ((i & k) == 0) CE_DESC(a[i], a[l]); else CE_DESC(a[l], a[i]); } }
}
template <int N> __device__ __forceinline__ void bitonic_merge_desc(int (&a)[N]) {
#pragma unroll
    for (int j = N >> 1; j > 0; j >>= 1)
#pragma unroll
        for (int i = 0; i < N; ++i) { const int l = i ^ j; if (l > i) CE_DESC(a[i], a[l]); }
}
__device__ __forceinline__ void top16_merge(int (&a)[16], const int (&b)[16]) {
#pragma unroll
    for (int i = 0; i < 16; ++i) a[i] = max(a[i], b[15 - i]);
    bitonic_merge_desc<16>(a);
}
__device__ __attribute__((aligned(16))) const unsigned char PK_CAND[64] = {
    0x00, 0x01, 0x02, 0x03, 0x04, 0x05, 0x06, 0x07, 0x08, 0x09, 0x0a, 0x0b, 0x0c, 0x0d, 0x0e, 0x0f,
    0x10, 0x11, 0x12, 0x13, 0x14, 0x15, 0x16, 0x17, 0x20, 0x21, 0x22, 0x23, 0x24, 0x50, 0x51, 0xff,
    0x30, 0x31, 0x32, 0x33, 0x40, 0x41, 0x42, 0x60, 0x61, 0x70, 0x71, 0xff, 0xff, 0xff, 0xff, 0xff,
    0x80, 0x90, 0xa0, 0xb0, 0xc0, 0xd0, 0xe0, 0xf0, 0xff, 0xff, 0xff, 0xff, 0xff, 0xff, 0xff, 0xff};
constexpr int SC8_LD = 132, SK_LD = 136;
constexpr int SC8_BYTES = 128 * SC8_LD * 4, TV8_OFF = SC8_BYTES, SK_OFF = TV8_OFF + 128 * 16 * 4;
__device__ __forceinline__ void peer_load_subkeys(Frame& F) {
    const bf16* SKB = (const bf16*)(F.ws + WS_SKB); bf16* sk_s = (bf16*)(F.lds + SK_OFF);
    for (int e = F.tid; e < 256 * 16; e += 512) { const int row = e >> 4, ch = e & 15; *(v4u*)(sk_s + row * SK_LD + 8 * ch) = *(const v4u*)(SKB + (size_t)row * 128 + 8 * ch); }
    __syncthreads();
}
__device__ __forceinline__ void peer_qfrags(Frame& F, int tb, bf16x8 (&a)[2][4]) {
    const bf16* QP = (const bf16*)(F.ws + WS_QP); const int tok = min(tb + (F.lane & 7), TT - 1), lq = F.lane >> 4;
#pragma unroll
    for (int hf = 0; hf < 2; ++hf)
#pragma unroll
        for (int ks = 0; ks < 4; ++ks) a[hf][ks] = *(const bf16x8*)(QP + (size_t)tok * DM + F.wave * 256 + hf * 128 + 32 * ks + 8 * lq);
}
__device__ __forceinline__ void peer_topk_tile(Frame& F, int tb, int tend, bf16x8 (&a)[2][4]) {
    int* IDX = (int*)(F.ws + WS_IDX); float* GW = (float*)(F.ws + WS_GW);
    float* sc_s = (float*)F.lds;
    int* tv_s = (int*)(F.lds + TV8_OFF);
    const bf16* sk_s = (const bf16*)(F.lds + SK_OFF);
    const int wv = F.wave, lane = F.lane, l15 = lane & 15, lq = lane >> 4, tid = F.tid;
    {
#pragma unroll
      for (int hf = 0; hf < 2; ++hf) {
#pragma unroll
          for (int nt = 0; nt < 8; ++nt) { f32x4 acc = {0.f, 0.f, 0.f, 0.f};
#pragma unroll
              for (int ks = 0; ks < 4; ++ks) { const bf16x8 bq = *(const bf16x8*)(sk_s + (hf * 128 + 16 * nt + l15) * SK_LD + 32 * ks + 8 * lq); acc = MFMA16(a[hf][ks], bq, acc); }
              if (lq < 2) {
#pragma unroll
                  for (int r = 0; r < 4; ++r) sc_s[((wv * 2 + hf) * 8 + 4 * lq + r) * SC8_LD + 16 * nt + l15] = acc[r]; } } } }
    if (tb + 8 < tend) peer_qfrags(F, tb + 8, a);
    PK_BAR();
    { const int row = tid >> 2, sub = tid & 3; const float* rp = sc_s + row * SC8_LD;
      int top[16], v[16];
#pragma unroll
      for (int i = 0; i < 16; ++i) { const int key = 4 * i + sub; top[i] = (f2sort(rp[key]) & ~127) | (127 - key); }
      bitonic_sort_desc<16>(top);
#pragma unroll
      for (int i = 0; i < 16; ++i) { const int key = 4 * (16 + i) + sub; v[i] = (f2sort(rp[key]) & ~127) | (127 - key); }
      bitonic_sort_desc<16>(v);
      top16_merge(top, v);
#pragma unroll
      for (int sh = 1; sh < 4; sh <<= 1) {
#pragma unroll
          for (int i = 0; i < 16; ++i) v[i] = sh == 1 ? __builtin_amdgcn_update_dpp(0, top[i], 0xB1, 0xF, 0xF, true) : __builtin_amdgcn_update_dpp(0, top[i], 0x4E, 0xF, 0xF, true);
          top16_merge(top, v); }
      if (sub == 0) {
#pragma unroll
          for (int q = 0; q < 4; ++q) *(int __attribute__((ext_vector_type(4)))*)(tv_s + row * 16 + 4 * q) = (int __attribute__((ext_vector_type(4)))){top[4 * q], top[4 * q + 1], top[4 * q + 2], top[4 * q + 3]}; }
    }
    PK_BAR();
    if (tid < 256) { const int it = tid >> 2, qd = tid & 3, tl = it & 7, hd = it >> 3;
      const int* r1 = tv_s + ((hd * 2 + 0) * 8 + tl) * 16; const int* r2 = tv_s + ((hd * 2 + 1) * 8 + tl) * 16;
      int c[16];
      const v4u cw = *(const v4u*)(PK_CAND + qd * 16);
#pragma unroll
      for (int t = 0; t < 16; ++t) { const int ab = (int)((cw[t >> 2] >> (8 * (t & 3))) & 0xffu); const int abc = ab != 0xff ? ab : 0;
          const float sv = sort2f(r1[abc >> 4] & ~127) + sort2f(r2[abc & 15] & ~127); const int packed = (f2sort(sv) & ~255) | (255 - ab);
          c[t] = ab != 0xff ? packed : (int)0x80000000; }
      bitonic_sort_desc<16>(c);
#pragma unroll
      for (int sh = 1; sh < 4; sh <<= 1) { int oth[16];
#pragma unroll
          for (int i = 0; i < 16; ++i) oth[i] = sh == 1 ? __builtin_amdgcn_update_dpp(0, c[i], 0xB1, 0xF, 0xF, true) : __builtin_amdgcn_update_dpp(0, c[i], 0x4E, 0xF, 0xF, true);
          top16_merge(c, oth); }
      const int tok = tb + tl;
      if (tok < tend) {
          float ev[16], sum = 0.f; const float mx = sort2f(c[0] & ~255);
#pragma unroll
          for (int k = 0; k < 16; ++k) { ev[k] = __expf(sort2f(c[k] & ~255) - mx); sum += ev[k]; }
          const float inv = 1.0f / sum;
#pragma unroll
          for (int k = 0; k < 16; ++k) if ((k >> 2) == qd) { const int ab = 255 - (c[k] & 255); const int i1 = 127 - (r1[ab >> 4] & 127), i2 = 127 - (r2[ab & 15] & 127);
              IDX[(size_t)tok * 128 + hd * 16 + k] = i1 * 128 + i2; GW[(size_t)tok * 128 + hd * 16 + k] = ev[k] * inv; }
      }
    }
    PK_BAR();
}

#if PE_MFMA
typedef int v8i_ __attribute__((ext_vector_type(8)));
__device__ __forceinline__ void peer_phase(Frame& F, int tok0, int tok1) {
    const unsigned char* U4T = F.ws + WS_EU; const unsigned char* V4T = F.ws + WS_EV; const float* SU = (const float*)(F.ws + WS_EU + 32 * MiB); const float* SV = (const float*)(F.ws + WS_EV + 32 * MiB);
    const bf16* X2 = (const bf16*)(F.ws + WS_H2); const float* RS2 = (const float*)(F.ws + WS_RS2); const int* IDX = (const int*)(F.ws + WS_IDX); const float* GW = (const float*)(F.ws + WS_GW);
    const int wv = F.wave, lane = F.lane, tid = F.tid, l15 = lane & 15, lq = lane >> 4;
    float* red_s = (float*)F.lds;
    float* ss_s = (float*)(F.lds + 131072);
    unsigned char* hp = F.lds + 131072 + 256;
    if (tok0 >= tok1) return;
    const f32x4 gfin = *(const f32x4*)(F.nfg + 4 * tid);
    f32x4 x3p = {0.f, 0.f, 0.f, 0.f}; int buf = 0;
#define PE_PLANES(xw, rs8, pb) do { const float f0 = bflo(xw.x) * (rs8), f1 = bfhi(xw.x) * (rs8), f2 = bflo(xw.y) * (rs8), f3 = bfhi(xw.y) * (rs8); \
        int hi_ = 0; hi_ = __builtin_amdgcn_cvt_pk_fp8_f32(f0, f1, hi_, false); hi_ = __builtin_amdgcn_cvt_pk_fp8_f32(f2, f3, hi_, true); \
        const float r0 = (f0 - __builtin_amdgcn_cvt_f32_fp8(hi_, 0)) * 16.f, r1 = (f1 - __builtin_amdgcn_cvt_f32_fp8(hi_, 1)) * 16.f, r2 = (f2 - __builtin_amdgcn_cvt_f32_fp8(hi_, 2)) * 16.f, r3 = (f3 - __builtin_amdgcn_cvt_f32_fp8(hi_, 3)) * 16.f; \
        int lo_ = 0; lo_ = __builtin_amdgcn_cvt_pk_fp8_f32(r0, r1, lo_, false); lo_ = __builtin_amdgcn_cvt_pk_fp8_f32(r2, r3, lo_, true); \
        *(int*)(hp + ((pb) * 2 + 0) * 2048 + 4 * tid) = hi_; *(int*)(hp + ((pb) * 2 + 1) * 2048 + 4 * tid) = lo_; } while (0)
    int idx_c = IDX[(size_t)tok0 * 128 + wv * 16 + l15];
    float g_c = GW[(size_t)tok0 * 128 + wv * 16 + l15] * SV[idx_c], su_c = SU[idx_c] * 0.125f;
    v2u xw_c = *(const v2u*)(X2 + (size_t)tok0 * DM + 4 * tid);
    { const float rs8 = RS2[tok0] * 8.0f; PE_PLANES(xw_c, rs8, tok0 & 1); }
#if PE_VDEPTH == 16
    v4u U[16], V[16];
#else
    v4u U[16], V[8];
#endif
#pragma unroll
    for (int s2 = 0; s2 < 16; ++s2) U[s2] = *(const v4u*)(U4T + (size_t)idx_c * ROW4 + 16 * lq + 64 * s2);
#pragma unroll
    for (int e = 0; e < PE_VDEPTH; ++e) V[e] = *(const v4u*)(V4T + (size_t)__builtin_amdgcn_readlane(idx_c, e) * ROW4 + 16 * lane);
    int idx_n; float gw_n;
    { const int t1 = min(tok0 + 1, tok1 - 1); idx_n = IDX[(size_t)t1 * 128 + wv * 16 + l15]; gw_n = GW[(size_t)t1 * 128 + wv * 16 + l15]; }
    v2u xw_l = xw_c;
    PK_BAR();
#pragma unroll 1
    for (int m = tok0; m <= tok1; ++m) {
        if (m < tok1) {
            const int mn = min(m + 1, tok1 - 1), mnn = min(m + 2, tok1 - 1);
            const float su_l = SU[idx_n], sv_l = SV[idx_n], rs_l = RS2[mn];
            xw_l = *(const v2u*)(X2 + (size_t)mn * DM + 4 * tid);
            const int idx_l = IDX[(size_t)mnn * 128 + wv * 16 + l15]; const float gw_l = GW[(size_t)mnn * 128 + wv * 16 + l15];
            f32x4 c4[4] = {(f32x4){0.f, 0.f, 0.f, 0.f}, (f32x4){0.f, 0.f, 0.f, 0.f}, (f32x4){0.f, 0.f, 0.f, 0.f}, (f32x4){0.f, 0.f, 0.f, 0.f}};
            const unsigned char* hb = hp + (((m & 1) * 2 + (l15 & 1)) * 2048) + 16 * lq;
            const unsigned char* un = U4T + (size_t)idx_n * ROW4 + 16 * lq;
            v4u b0 = *(const v4u*)(hb), b1 = *(const v4u*)(hb + 64);
#pragma unroll
            for (int s2 = 0; s2 < 16; ++s2) {
                v4u n0 = b0, n1 = b1;
                if (s2 < 15) { n0 = *(const v4u*)(hb + 128 * (s2 + 1)); n1 = *(const v4u*)(hb + 128 * (s2 + 1) + 64); }
                c4[s2 & 3] = __builtin_amdgcn_mfma_scale_f32_16x16x128_f8f6f4((v8i_){(int)U[s2].x, (int)U[s2].y, (int)U[s2].z, (int)U[s2].w, 0, 0, 0, 0}, (v8i_){(int)b0.x, (int)b0.y, (int)b0.z, (int)b0.w, (int)b1.x, (int)b1.y, (int)b1.z, (int)b1.w}, c4[s2 & 3], 4, 0, 0, 0x7f7f7f7f, 0, 0x7f7f7f7f);
                b0 = n0; b1 = n1;
            }
#pragma unroll
            for (int s2 = 0; s2 < 16; ++s2) U[s2] = *(const v4u*)(un + 64 * s2);
            const f32x4 c = (c4[0] + c4[1]) + (c4[2] + c4[3]);
            float wgt[4];
#pragma unroll
            for (int r = 0; r < 4; ++r) { const float lo = __builtin_bit_cast(float, __builtin_amdgcn_update_dpp(0, __builtin_bit_cast(int, c[r]), 0xB1, 0xF, 0xF, true));
                const float su_e = __shfl(su_c, 4 * lq + r), g_e = __shfl(g_c, 4 * lq + r);
                wgt[r] = g_e * gelu_erf((c[r] + 0.0625f * lo) * su_e); }
            float acc[32];
#pragma unroll
            for (int k = 0; k < 32; ++k) acc[k] = 0.f;
#pragma unroll
            for (int e = 0; e < 16; ++e) {
                const float w_e = __builtin_bit_cast(float, __builtin_amdgcn_readlane(__builtin_bit_cast(int, wgt[e & 3]), 16 * (e >> 2)));
#pragma unroll
                for (int d = 0; d < 4; ++d) {
                    const f32x2 v0 = __builtin_amdgcn_cvt_scalef32_pk_f32_fp4(V[e & (PE_VDEPTH - 1)][d], 1.0f, 0), v1 = __builtin_amdgcn_cvt_scalef32_pk_f32_fp4(V[e & (PE_VDEPTH - 1)][d], 1.0f, 1), v2 = __builtin_amdgcn_cvt_scalef32_pk_f32_fp4(V[e & (PE_VDEPTH - 1)][d], 1.0f, 2), v3 = __builtin_amdgcn_cvt_scalef32_pk_f32_fp4(V[e & (PE_VDEPTH - 1)][d], 1.0f, 3);
                    acc[8 * d] += w_e * v0.x; acc[8 * d + 1] += w_e * v0.y; acc[8 * d + 2] += w_e * v1.x; acc[8 * d + 3] += w_e * v1.y; acc[8 * d + 4] += w_e * v2.x; acc[8 * d + 5] += w_e * v2.y; acc[8 * d + 6] += w_e * v3.x; acc[8 * d + 7] += w_e * v3.y; }
#if PE_VDEPTH == 16
                V[e] = *(const v4u*)(V4T + (size_t)__builtin_amdgcn_readlane(idx_n, e) * ROW4 + 16 * lane);
#else
                V[e & 7] = *(const v4u*)(V4T + (size_t)(e < 8 ? __builtin_amdgcn_readlane(idx_c, e + 8) : __builtin_amdgcn_readlane(idx_n, e - 8)) * ROW4 + 16 * lane);
#endif
                asm volatile("" : "+v"(acc[0]), "+v"(acc[1]), "+v"(acc[2]), "+v"(acc[3]), "+v"(acc[4]), "+v"(acc[5]), "+v"(acc[6]), "+v"(acc[7]), "+v"(acc[8]), "+v"(acc[9]), "+v"(acc[10]), "+v"(acc[11]), "+v"(acc[12]), "+v"(acc[13]), "+v"(acc[14]), "+v"(acc[15]));
                asm volatile("" : "+v"(acc[16]), "+v"(acc[17]), "+v"(acc[18]), "+v"(acc[19]), "+v"(acc[20]), "+v"(acc[21]), "+v"(acc[22]), "+v"(acc[23]), "+v"(acc[24]), "+v"(acc[25]), "+v"(acc[26]), "+v"(acc[27]), "+v"(acc[28]), "+v"(acc[29]), "+v"(acc[30]), "+v"(acc[31]));
            }
            { const float rs8 = rs_l * 8.0f; PE_PLANES(xw_l, rs8, (m + 1) & 1); }
            idx_c = idx_n; g_c = gw_n * sv_l; su_c = su_l * 0.125f; idx_n = idx_l; gw_n = gw_l;
#pragma unroll
            for (int j = 0; j < 8; ++j) *(f32x4*)(red_s + (buf * 8 + wv) * 2048 + 256 * j + 4 * lane) = (f32x4){acc[4 * j], acc[4 * j + 1], acc[4 * j + 2], acc[4 * j + 3]};
        }
        PK_BAR();
        if (m > tok0) {
            float tot = 0.f;
#pragma unroll
            for (int w8 = 0; w8 < 8; ++w8) tot += ss_s[(buf ^ 1) * 8 + w8];
            const float rstd = 1.0f / sqrtf(tot * (1.0f / DM) + EPS);
            *(f32x4*)(F.out + OUT_Y + (size_t)(m - 1) * DM + 4 * tid) = x3p * rstd * gfin;
        }
        if (m < tok1) {
            f32x4 x3 = (f32x4){bflo(xw_c.x), bfhi(xw_c.x), bflo(xw_c.y), bfhi(xw_c.y)};
#pragma unroll
            for (int w8 = 0; w8 < 8; ++w8) x3 += *(const f32x4*)(red_s + (buf * 8 + w8) * 2048 + 4 * tid);
            const float ss = wave_sum_dpp((x3.x * x3.x + x3.y * x3.y) + (x3.z * x3.z + x3.w * x3.w));
            if (lane == 0) ss_s[buf * 8 + wv] = ss;
            x3p = x3;
        }
        xw_c = xw_l;
        buf ^= 1;
    }
#undef PE_PLANES
    __syncthreads();
}
#else
__device__ __forceinline__ void peer_phase(Frame& F, int tok0, int tok1) {
    const unsigned char* U6 = F.ws + WS_EU; const unsigned char* V6 = F.ws + WS_EV; const float* SU = (const float*)(F.ws + WS_EU + 32 * MiB); const float* SV = (const float*)(F.ws + WS_EV + 32 * MiB);
    const bf16* X2 = (const bf16*)(F.ws + WS_H2); const float* RS2 = (const float*)(F.ws + WS_RS2); const int* IDX = (const int*)(F.ws + WS_IDX); const float* GW = (const float*)(F.ws + WS_GW);
    const int wv = F.wave, lane = F.lane, tid = F.tid;
    float* red_s = (float*)F.lds;
    float* ss_s = (float*)(F.lds + 131072);
    const f32x4 gfin = *(const f32x4*)(F.nfg + 4 * tid);
    f32x4 x3p = {0.f, 0.f, 0.f, 0.f}; int buf = 0;
#pragma unroll 1
    for (int m = tok0; m <= tok1; ++m) {
        if (m < tok1) {
            const int myidx = IDX[(size_t)m * 128 + wv * 16 + (lane & 15)]; float myg = GW[(size_t)m * 128 + wv * 16 + (lane & 15)];
            const float mysu = SU[myidx] * RS2[m]; myg *= SV[myidx];
            float hf[32];
#pragma unroll
            for (int j = 0; j < 8; ++j) { const v2u w = *(const v2u*)(X2 + (size_t)m * DM + 256 * j + 4 * lane); hf[4 * j] = bflo(w.x); hf[4 * j + 1] = bfhi(w.x); hf[4 * j + 2] = bflo(w.y); hf[4 * j + 3] = bfhi(w.y); }
            float acc[32];
#pragma unroll
            for (int k = 0; k < 32; ++k) acc[k] = 0.f;
            v4u uA4[2], vA4[2], uB4[2], vB4[2]; v2u uA2[2], uB2[2];
#define PE_LOAD(U4, U2, V4, g) do { _Pragma("unroll") for (int kk = 0; kk < 2; ++kk) { const int ex = __builtin_amdgcn_readlane(myidx, (g) * 2 + kk); \
                const unsigned char* ur = U6 + (size_t)ex * (EU_FP4 ? ROW4 : ROW6); const unsigned char* vr = V6 + (size_t)ex * ROW4; \
                U4[kk] = *(const v4u*)(ur + 16 * lane); if (!EU_FP4) U2[kk] = *(const v2u*)(ur + 1024 + 8 * lane); V4[kk] = *(const v4u*)(vr + 16 * lane); } } while (0)
#define PE_COMP(U4, U2, V4, g) do { _Pragma("unroll") for (int kk = 0; kk < 2; ++kk) { \
                const float gk_ = __builtin_bit_cast(float, __builtin_amdgcn_readlane(__builtin_bit_cast(int, myg), (g) * 2 + kk)), su_ = __builtin_bit_cast(float, __builtin_amdgcn_readlane(__builtin_bit_cast(int, mysu), (g) * 2 + kk)); \
                f32x2 d2a = {0.f, 0.f}, d2b = {0.f, 0.f}; \
                if (EU_FP4) { _Pragma("unroll") for (int d = 0; d < 4; ++d) { \
                    const f32x2 u0 = __builtin_amdgcn_cvt_scalef32_pk_f32_fp4(U4[kk][d], 1.0f, 0), u1 = __builtin_amdgcn_cvt_scalef32_pk_f32_fp4(U4[kk][d], 1.0f, 1), u2 = __builtin_amdgcn_cvt_scalef32_pk_f32_fp4(U4[kk][d], 1.0f, 2), u3 = __builtin_amdgcn_cvt_scalef32_pk_f32_fp4(U4[kk][d], 1.0f, 3); \
                    d2a += u0 * (f32x2){hf[8 * d], hf[8 * d + 1]}; d2b += u1 * (f32x2){hf[8 * d + 2], hf[8 * d + 3]}; d2a += u2 * (f32x2){hf[8 * d + 4], hf[8 * d + 5]}; d2b += u3 * (f32x2){hf[8 * d + 6], hf[8 * d + 7]}; } \
                } else { const v32f uf = __builtin_amdgcn_cvt_scalef32_pk32_f32_fp6((v6u){U4[kk].x, U4[kk].y, U4[kk].z, U4[kk].w, U2[kk].x, U2[kk].y}, 1.0f); \
                _Pragma("unroll") for (int k = 0; k < 32; k += 4) { d2a += (f32x2){uf[k], uf[k + 1]} * (f32x2){hf[k], hf[k + 1]}; d2b += (f32x2){uf[k + 2], uf[k + 3]} * (f32x2){hf[k + 2], hf[k + 3]}; } } \
                const float a_ = wave_sum_dpp((d2a.x + d2a.y) + (d2b.x + d2b.y)) * su_; const float wgt = gk_ * gelu_erf(a_); \
                _Pragma("unroll") for (int d = 0; d < 4; ++d) { \
                    const f32x2 v0 = __builtin_amdgcn_cvt_scalef32_pk_f32_fp4(V4[kk][d], 1.0f, 0), v1 = __builtin_amdgcn_cvt_scalef32_pk_f32_fp4(V4[kk][d], 1.0f, 1), v2 = __builtin_amdgcn_cvt_scalef32_pk_f32_fp4(V4[kk][d], 1.0f, 2), v3 = __builtin_amdgcn_cvt_scalef32_pk_f32_fp4(V4[kk][d], 1.0f, 3); \
                    acc[8 * d] += wgt * v0.x; acc[8 * d + 1] += wgt * v0.y; acc[8 * d + 2] += wgt * v1.x; acc[8 * d + 3] += wgt * v1.y; acc[8 * d + 4] += wgt * v2.x; acc[8 * d + 5] += wgt * v2.y; acc[8 * d + 6] += wgt * v3.x; acc[8 * d + 7] += wgt * v3.y; } } } while (0)
#if PE_DEPTH == 3
            v4u uC4[2], vC4[2]; v2u uC2[2];
            PE_LOAD(uA4, uA2, vA4, 0); PE_LOAD(uB4, uB2, vB4, 1);
#pragma unroll 1
            for (int g = 0; g < 6; g += 3) {
                PE_LOAD(uC4, uC2, vC4, g + 2); __builtin_amdgcn_sched_barrier(0); PE_COMP(uA4, uA2, vA4, g); __builtin_amdgcn_sched_barrier(0);
                PE_LOAD(uA4, uA2, vA4, g + 3); __builtin_amdgcn_sched_barrier(0); PE_COMP(uB4, uB2, vB4, g + 1); __builtin_amdgcn_sched_barrier(0);
                PE_LOAD(uB4, uB2, vB4, g + 4); __builtin_amdgcn_sched_barrier(0); PE_COMP(uC4, uC2, vC4, g + 2); __builtin_amdgcn_sched_barrier(0);
            }
            PE_COMP(uA4, uA2, vA4, 6); __builtin_amdgcn_sched_barrier(0);
            PE_COMP(uB4, uB2, vB4, 7);
#else
            PE_LOAD(uA4, uA2, vA4, 0);
#pragma unroll 1
            for (int g = 0; g < 8; g += 2) {
                PE_LOAD(uB4, uB2, vB4, g + 1);
                PE_COMP(uA4, uA2, vA4, g);
                if (g + 2 < 8) PE_LOAD(uA4, uA2, vA4, g + 2);
                PE_COMP(uB4, uB2, vB4, g + 1);
            }
#endif
#undef PE_LOAD
#undef PE_COMP
#pragma unroll
            for (int j = 0; j < 8; ++j) *(f32x4*)(red_s + (buf * 8 + wv) * 2048 + 256 * j + 4 * lane) = (f32x4){acc[4 * j], acc[4 * j + 1], acc[4 * j + 2], acc[4 * j + 3]};
        }
        PK_BAR();
        if (m > tok0) {
            float tot = 0.f;
#pragma unroll
            for (int w8 = 0; w8 < 8; ++w8) tot += ss_s[(buf ^ 1) * 8 + w8];
            const float rstd = 1.0f / sqrtf(tot * (1.0f / DM) + EPS);
            *(f32x4*)(F.out + OUT_Y + (size_t)(m - 1) * DM + 4 * tid) = x3p * rstd * gfin;
        }
        if (m < tok1) {
            f32x4 x3; { const v2u w = *(const v2u*)(X2 + (size_t)m * DM + 4 * tid); x3 = (f32x4){bflo(w.x), bfhi(w.x), bflo(w.y), bfhi(w.y)}; }
#pragma unroll
            for (int w8 = 0; w8 < 8; ++w8) x3 += *(const f32x4*)(red_s + (buf * 8 + w8) * 2048 + 4 * tid);
            const float ss = wave_sum_dpp((x3.x * x3.x + x3.y * x3.y) + (x3.z * x3.z + x3.w * x3.w));
            if (lane == 0) ss_s[buf * 8 + wv] = ss;
            x3p = x3;
        }
        buf ^= 1;
    }
    __syncthreads();
}
#endif
struct Args { const float* in[18]; float* out; unsigned char* ws; int ph_lo, ph_hi; };
__global__ void __launch_bounds__(NWAVES * 64, 2) mk_fwd(Args args) {
    extern __shared__ __attribute__((aligned(16))) unsigned char lds[];
    Frame F;
    F.lds = lds;
    F.tid = threadIdx.x; F.lane = F.tid & 63; F.wave = __builtin_amdgcn_readfirstlane(F.tid >> 6);
    F.G = gridDim.x; { const int bx = blockIdx.x; F.vcu = (F.G % 8 == 0) ? (bx % 8) * (F.G / 8) + bx / 8 : bx; }
    F.xp = args.in[0]; F.xs = args.in[1]; F.sgla = args.in[2]; F.sconv = args.in[3]; F.n1g = args.in[4]; F.win = args.in[5]; F.wau = args.in[6]; F.bal = args.in[7];
    F.gng = args.in[8]; F.cw = args.in[9]; F.cb = args.in[10]; F.wout = args.in[11]; F.n2g = args.in[12]; F.wq = args.in[13]; F.sk = args.in[14]; F.eu = args.in[15];
    F.ev = args.in[16]; F.nfg = args.in[17]; F.out = args.out; F.ws = args.ws;
    for (int u = F.tid; u < (LDS_BYTES - LDSCTL_OFF) / 4; u += NWAVES * 64) ((LAS unsigned*)((LAS unsigned char*)lds + LDSCTL_OFF))[u] = 0u;
    __syncthreads();
    gu32* ctl = (gu32*)(F.ws + WS_CTL);
    XcdBarrier bar; bar.bar = (unsigned*)(ctl + CW_BAR); bar.x = 0; bar.st = nullptr;
    if (N_LAUNCHES == 1) bar = xcd_barrier_post((unsigned*)(ctl + CW_BAR), (volatile LAS unsigned*)((LAS unsigned char*)lds + MISC_OFF) + 8);
    const int lo = args.ph_lo, hi = args.ph_hi;
#ifdef PROBE_TIME_MAIN
    unsigned long long probe_dt_ = 0;
#endif
#ifndef G1_WGM
#define G1_WGM 3
#endif
#ifndef G23_WGM
#define G23_WGM 3
#endif
#ifndef G23_ALIGN
#define G23_ALIGN true
#endif
#ifndef G23_SP2
#define G23_SP2 true
#endif
#ifndef G1_ALIGN
#define G1_ALIGN true
#endif
#ifndef G1_SP2
#define G1_SP2 true
#endif
#ifndef SKREP
#define SKREP 1
#endif
#ifndef PROBE_DBL
#define PROBE_DBL -1
#endif
#define IN(k) (lo <= (k) && (k) < hi)
#define REP(k) for (int rep_ = 0; rep_ < ((k) == PROBE_DBL ? 2 : 1); ++rep_)
#ifndef BAR_REP
#define BAR_REP 1
#endif
#ifndef PROBE_TIME_PHASE
#define PROBE_TIME_PHASE -1
#endif
    unsigned long long ptp_t0_ = 0, ptp_dt_ = 0;
#define PH_BEGIN(k) do { if ((k) == PROBE_TIME_PHASE) ptp_t0_ = __builtin_amdgcn_s_memrealtime(); } while (0)
#define SEAM(k) do { if (IN(k) && IN((k) + 1)) for (int br_ = 0; br_ < BAR_REP; ++br_) xcd_barrier(bar); if ((k) == PROBE_TIME_PHASE) ptp_dt_ = __builtin_amdgcn_s_memrealtime() - ptp_t0_; } while (0)
    const int gw = F.vcu * NWAVES + F.wave, NGW = F.G * NWAVES;
    const int tok0 = (int)(((long)F.vcu * TT) / F.G), tok1 = (int)(((long)(F.vcu + 1) * TT) / F.G);

    PH_BEGIN(0);
    if (IN(0)) REP(0) { p0_prologue(F); __syncthreads(); }
    SEAM(0);
    PH_BEGIN(1);
    if (IN(1)) REP(1) {
        pg8::Gemm g{(const pg8::bf16_t*)(F.ws + WS_XN), (const pg8::bf16_t*)(F.ws + WS_WINT), TP, NP, DM}; pg8::StaticOrder S; S.init(TP, NP, F.G, (int)blockIdx.x, G1_WGM);
        pg8::EpiG1 E{(pg8::bf16_t*)(F.ws + WS_P), PLD, XTrip{F.eu, F.ev, F.n2g, F.ws, gw, NGW}, 0};
        pg8::gemm_phase<pg8::EpiG1, pg8::StaticOrder, G1_ALIGN, G1_SP2>((PG8_LAS unsigned char*)lds + RING_OFF, g, S, E);
#ifdef GEMM1_TWICE
        pg8::gemm_phase<pg8::EpiG1, pg8::StaticOrder, G1_ALIGN, G1_SP2>((PG8_LAS unsigned char*)lds + RING_OFF, g, S, E);
#endif
#if XP_IN_GEMM1
        for (int t = E.trip; gw + t * XP_NR * NGW < 2 * NEXP; ++t) expert_trip(E.X, t, F.lane);
#endif
        { EpiSkBf16 Es{(bf16*)(F.ws + WS_PS), PSLD, nullptr};
          for (int skr = 0; skr < SKREP; ++skr) for (int ng = F.vcu; ng < NP / 64; ng += F.G) skinny_gemm<4>(F, (const bf16*)(F.ws + WS_XN) + (size_t)TP * DM, (const bf16*)(F.ws + WS_WINT), 64 * ng, Es); }
    }
    SEAM(1);
    PH_BEGIN(2);
    if (IN(2)) REP(2) {
        if (F.G == 256) { const int u0 = (F.vcu >> 4) * 32 + 2 * (F.vcu & 15); v4u qa_[4], ka_[4], qb_[4], kb_[4];
            gla_prep_load(F, u0, qa_, ka_); gla_prep_load(F, u0 + 1, qb_, kb_); gla_prep_unit(F, u0, qa_, ka_); gla_prep_unit(F, u0 + 1, qb_, kb_); }
        else { for (int u = F.vcu; u < 512; u += F.G) { v4u qa_[4], ka_[4]; gla_prep_load(F, u, qa_, ka_); gla_prep_unit(F, u, qa_, ka_); } }
    }
    SEAM(2);
    PH_BEGIN(3);
    if (IN(3)) REP(3) {
#ifdef PROBE_TIME_MAIN
        const unsigned long long tm0_ = __builtin_amdgcn_s_memrealtime();
#endif
        if ((F.vcu & 1) == 0) { for (int g = F.vcu >> 1; g < 128; g += (F.G + 1) >> 1) gla_main_unit<4>(F, g >> 3, g & 7); }
#ifdef PROBE_TIME_MAIN
        probe_dt_ = __builtin_amdgcn_s_memrealtime() - tm0_;
#endif
        volatile LAS unsigned* qslot = (volatile LAS unsigned*)((LAS unsigned char*)lds + LDSCTL_OFF + 16);
#ifndef PROBE_STREAM
#define PROBE_STREAM 1
#endif
        for (int sr = 0; sr < PROBE_STREAM; ++sr) {
            if (sr > 0) xcd_barrier(bar);
            for (;;) {
                if (F.tid == 0) *qslot = __hip_atomic_fetch_add((unsigned*)(ctl + CW_QUEUE + 64 * (rep_ + 2 * sr)), 1u, __ATOMIC_RELAXED, __HIP_MEMORY_SCOPE_AGENT);
                __syncthreads();
                const unsigned u = *qslot;
                __syncthreads();
                if (u >= 512u) break;
                gla_sample_unit(F, (int)u);
            }
        }
    }
    SEAM(3);
    PH_BEGIN(4);
    if (IN(4)) REP(4) {
        bf16* MM = (bf16*)(F.ws + WS_MM);
        for (int it = gw; it < TP; it += 2 * NGW) {
            const int it2 = it + NGW; const bool two = it2 < TP;
            MixIn Ia, Ib; mixer_prompt_load(F, 4 * (it >> 2), it & 3, Ia); if (two) mixer_prompt_load(F, 4 * (it2 >> 2), it2 & 3, Ib);
            mixer_prompt_run(F, 4 * (it >> 2), it & 3, Ia); if (two) mixer_prompt_run(F, 4 * (it2 >> 2), it2 & 3, Ib); }
        for (int it = gw; it < 4 * TS; it += NGW) mixer_sample_row(F, it >> 2, it & 3);
        for (int m = TT + gw; m < MP; m += NGW) zero_row_bf16(MM + (size_t)m * DM, F.lane);
    }
    SEAM(4);
    PH_BEGIN(5);
    if (IN(5)) REP(5) {
        pg8::Gemm g{(const pg8::bf16_t*)(F.ws + WS_MM), (const pg8::bf16_t*)(F.ws + WS_WOUTT), TP, DM, DM}; pg8::StaticOrder S; S.init(TP, DM, F.G, (int)blockIdx.x, G23_WGM);
        pg8::EpiF32Res E{F.xp, (pg8::bf16_t*)(F.ws + WS_H2), (float*)(F.ws + WS_SSQ), DM};
        pg8::gemm_phase<pg8::EpiF32Res, pg8::StaticOrder, G23_ALIGN, G23_SP2>((PG8_LAS unsigned char*)lds + RING_OFF, g, S, E);
#ifdef GEMM2_TWICE
        pg8::gemm_phase<pg8::EpiF32Res, pg8::StaticOrder, G23_ALIGN, G23_SP2>((PG8_LAS unsigned char*)lds + RING_OFF, g, S, E);
#endif
        { EpiSkF32Res Es{F.xs, (bf16*)(F.ws + WS_H2) + (size_t)TP * DM, (float*)(F.ws + WS_SSQS)};
          for (int skr = 0; skr < SKREP; ++skr) for (int un = F.vcu; un < DM / 8; un += F.G) skinny_gemm16(F, (const bf16*)(F.ws + WS_MM) + (size_t)TP * DM, (const bf16*)(F.ws + WS_WOUTT), 16 * (un >> 1), un & 1, Es); }
    }
    SEAM(5);
    PH_BEGIN(6);
    if (IN(6)) REP(6) {
        float* rs_s = (float*)(lds + 131072);
        float* rss_s = rs_s + 512;
        float* RS2 = (float*)(F.ws + WS_RS2);
        pg8::Gemm g{(const pg8::bf16_t*)(F.ws + WS_H2), (const pg8::bf16_t*)(F.ws + WS_WQT), TP, DM, DM}; pg8::StaticOrder S; S.init(TP, DM, F.G, (int)blockIdx.x, G23_WGM);
        { pg8::Unit u0;
          if (S.next(0, u0) && F.tid < 256) { const int row = u0.pm * 256 + F.tid; const f32x4* p = (const f32x4*)((const float*)(F.ws + WS_SSQ) + (size_t)row * 32); f32x4 a4 = p[0];
#pragma unroll
              for (int i = 1; i < 8; ++i) a4 += p[i];
              const float rstd = 1.0f / sqrtf(((a4.x + a4.y) + (a4.z + a4.w)) * (1.0f / DM) + EPS); rs_s[F.tid] = rstd; if (u0.pn == 0) RS2[row] = rstd; }
          if (F.tid >= 256 && F.tid < 384) { const int row = F.tid - 256; const f32x4* p = (const f32x4*)((const float*)(F.ws + WS_SSQS) + (size_t)row * 128); f32x4 a4 = p[0];
#pragma unroll
              for (int i = 1; i < 32; ++i) a4 += p[i];
              const float rstd = 1.0f / sqrtf(((a4.x + a4.y) + (a4.z + a4.w)) * (1.0f / DM) + EPS); rss_s[row] = rstd; if (F.vcu == 0) RS2[TP + row] = rstd; }
          __syncthreads(); }
        pg8::EpiBf16RowScale E{(pg8::bf16_t*)(F.ws + WS_QP), DM, rs_s};
        pg8::gemm_phase<pg8::EpiBf16RowScale, pg8::StaticOrder, G23_ALIGN, G23_SP2>((PG8_LAS unsigned char*)lds + RING_OFF, g, S, E);
#ifdef GEMM3_TWICE
        pg8::gemm_phase<pg8::EpiBf16RowScale, pg8::StaticOrder, G23_ALIGN, G23_SP2>((PG8_LAS unsigned char*)lds + RING_OFF, g, S, E);
#endif
        { EpiSkBf16 Es{(bf16*)(F.ws + WS_QP) + (size_t)TP * DM, DM, rss_s};
          for (int skr = 0; skr < SKREP; ++skr) for (int un = F.vcu; un < DM / 8; un += F.G) skinny_gemm16(F, (const bf16*)(F.ws + WS_H2) + (size_t)TP * DM, (const bf16*)(F.ws + WS_WQT), 16 * (un >> 1), un & 1, Es); }
    }
    SEAM(6);
    PH_BEGIN(7);
#if PE_INTERLEAVE
    if (IN(7)) {
        const int ob = 2 * (F.vcu & 3); int done = tok0;
        for (int tb = tok0; tb < tok1; tb += 8) {
            { bf16x8 qa[2][4]; peer_qfrags(F, tb, qa); peer_load_subkeys(F); peer_topk_tile(F, tb, tok1, qa); }
            VM_WAIT(); __syncthreads();
            const int upto = (tb + 8 >= tok1) ? tok1 : (tb + 8 - ob);
            if (upto > done) { peer_phase(F, done, upto); done = upto; }
        }
    }
#else
#ifdef PROBE_HALFCU
    const int ptok0 = (F.vcu & 1) ? 0 : tok0, ptok1 = (F.vcu & 1) ? 0 : (int)(((long)(F.vcu + 2) * TT) / F.G);
#define tok0 ptok0
#define tok1 ptok1
#endif
    if (IN(7)) REP(7) { bf16x8 qa[2][4]; peer_qfrags(F, tok0, qa); peer_load_subkeys(F); for (int tb = tok0; tb < tok1; tb += 8) peer_topk_tile(F, tb, tok1, qa); __syncthreads(); }
    if (IN(7) && IN(8)) { VM_WAIT(); __syncthreads(); if (7 == PROBE_TIME_PHASE) ptp_dt_ = __builtin_amdgcn_s_memrealtime() - ptp_t0_; }
    PH_BEGIN(8);
    if (IN(8)) REP(8) { peer_phase(F, tok0, tok1); }
#endif
#ifdef PROBE_HALFCU
#undef tok0
#undef tok1
#endif
    if (PROBE_TIME_PHASE == 8) ptp_dt_ = __builtin_amdgcn_s_memrealtime() - ptp_t0_;
    if (PROBE_TIME_PHASE >= 0 && F.vcu == 0) { const unsigned long long te_ = __builtin_amdgcn_s_memrealtime(); while (__builtin_amdgcn_s_memrealtime() - te_ < 9ull * ptp_dt_) __builtin_amdgcn_s_sleep(8); }
#ifdef PROBE_TIME_MAIN
    if (F.vcu == 0) { const unsigned long long te_ = __builtin_amdgcn_s_memrealtime(); while (__builtin_amdgcn_s_memrealtime() - te_ < 9ull * probe_dt_) __builtin_amdgcn_s_sleep(8); }
#endif
#undef IN
#undef SEAM
}

extern "C" void kernel_launch(void* const* d_in, const int* in_sizes, int n_in, void* d_out, int out_size, void* d_ws, size_t ws_size, hipStream_t stream) {
    static int grid = 0;
    if (grid == 0) {
        if (n_in != 18 || ws_size < WS_END) { fprintf(stderr, "kernel_launch: expected 18 inputs and >= %zu bytes of workspace; got %d, %zu\n", (size_t)WS_END, n_in, ws_size); grid = -1; return; }
        int dev = 0, cus = 0;
        if (hipGetDevice(&dev) != hipSuccess || hipDeviceGetAttribute(&cus, hipDeviceAttributeMultiprocessorCount, dev) != hipSuccess) { grid = -1; return; }
        if (hipFuncSetAttribute((const void*)mk_fwd, hipFuncAttributeMaxDynamicSharedMemorySize, LDS_BYTES) != hipSuccess) { fprintf(stderr, "kernel_launch: hipFuncSetAttribute failed\n"); grid = -1; return; }
        (void)hipGetLastError();
        grid = cus;
    }
    if (grid < 0) return;
    (void)hipMemsetAsync((char*)d_ws + WS_CTL, 0, CTL_ZERO_BYTES, stream);
    Args a{};
    for (int i = 0; i < 18; ++i) a.in[i] = (const float*)d_in[i];
    a.out = (float*)d_out; a.ws = (unsigned char*)d_ws;
    if (N_LAUNCHES == 1) { a.ph_lo = 0; a.ph_hi = N_PHASES; hipLaunchKernelGGL(mk_fwd, dim3(grid), dim3(NWAVES * 64), LDS_BYTES, stream, a); }
    else { for (int li = 0; li < N_PHASES; ++li) { a.ph_lo = li; a.ph_hi = li + 1; hipLaunchKernelGGL(mk_fwd, dim3(grid), dim3(NWAVES * 64), LDS_BYTES, stream, a); } }
}
```
